# Optimizing an MI355X kernel written in HIP

```python
import jax, jax.numpy as jnp
from jax import lax
import numpy as np

D_MODEL = 1024
BATCH = 8
SEQ = 4096
DEPTH = 2

N_MIXERS = 2
N_GLA = (DEPTH + 1) // 2
N_NSA = DEPTH // 2
NORM_EPS = 1e-6
ROPE_THETA = 10000.0
NEG = -1e30
BIG = 1e9

GLA_HEADS = 4
GLA_DK = D_MODEL // 2 // GLA_HEADS
GLA_DV = D_MODEL // GLA_HEADS
GLA_QK = GLA_HEADS * GLA_DK
GLA_V = GLA_HEADS * GLA_DV
GLA_GATE_RANK = 16
GLA_GATE_NORMALIZER = 16.0
GLA_CHUNK = 64
GLA_IN = 2 * GLA_QK + GLA_V + GLA_GATE_RANK + GLA_V

NSA_HEADS = 16
NSA_GROUPS = 4
NSA_HPG = NSA_HEADS // NSA_GROUPS
NSA_DH = D_MODEL // NSA_HEADS
NSA_Q = NSA_HEADS * NSA_DH
NSA_KV = NSA_GROUPS * NSA_DH
CMP_BLOCK = 32
CMP_STRIDE = 16
CMP_HIDDEN = 256
SEL_BLOCK = 64
SEL_TOP = 16
WINDOW = 512
Q_BLOCK = 64
NSA_IN = NSA_Q + 6 * NSA_KV + 3 * NSA_HEADS + NSA_Q

kernel_name = "hybrid_gla_nsa_sandwich"


def rms_norm(x, g):
    xf = x.astype(jnp.float32)
    y = xf * lax.rsqrt(jnp.mean(xf * xf, axis=-1, keepdims=True) + NORM_EPS)
    return (y * g.astype(jnp.float32)).astype(x.dtype)


def rope(x, positions):
    dh = x.shape[-1]
    inv = ROPE_THETA ** (-jnp.arange(0, dh, 2, dtype=jnp.float32) / dh)
    ang = positions.astype(jnp.float32)[..., None] * inv
    cos = jnp.cos(ang)[:, :, None, :]
    sin = jnp.sin(ang)[:, :, None, :]
    x1, x2 = jnp.split(x, 2, axis=-1)
    return jnp.concatenate([x1 * cos - x2 * sin, x2 * cos + x1 * sin], axis=-1)


def gla_chunked(q, k, v, g):
    B, H, S, dk = q.shape
    dv = v.shape[-1]
    C = GLA_CHUNK
    N = S // C
    q = q.reshape(B, H, N, C, dk)
    k = k.reshape(B, H, N, C, dk)
    v = v.reshape(B, H, N, C, dv)
    b = jnp.cumsum(g.reshape(B, H, N, C, dk), axis=3)
    b_last = b[:, :, :, -1:]
    q_e = q * jnp.exp(b)
    k_e = k * jnp.exp(-b)
    k_d = k * jnp.exp(b_last - b)
    causal = jnp.tril(jnp.ones((C, C), dtype=bool))
    a = jnp.where(causal, jnp.einsum('bhnid,bhnjd->bhnij', q_e, k_e), 0.0)
    o_intra = jnp.einsum('bhnij,bhnjv->bhniv', a, v)

    def step(state, xs):
        qe, kd, vc, dec = xs
        o = jnp.einsum('bhcd,bhdv->bhcv', qe, state)
        state = dec[..., None] * state + jnp.einsum('bhcd,bhcv->bhdv', kd, vc)
        return state, o

    xs = (jnp.moveaxis(q_e, 2, 0), jnp.moveaxis(k_d, 2, 0), jnp.moveaxis(v, 2, 0),
          jnp.moveaxis(jnp.exp(b_last[:, :, :, 0]), 2, 0))
    _, o_inter = lax.scan(step, jnp.zeros((B, H, dk, dv), jnp.float32), xs)
    return (o_intra + jnp.moveaxis(o_inter, 0, 2)).reshape(B, H, S, dv)


def gla_mixer(h, w_in, w_gk_up, b_gk, head_norm, w_out):
    B, S, _ = h.shape
    p = (h @ w_in).astype(jnp.float32)
    q, k, v, glr, z = jnp.split(p, [GLA_QK, 2 * GLA_QK, 2 * GLA_QK + GLA_V,
                                    2 * GLA_QK + GLA_V + GLA_GATE_RANK], axis=-1)
    gk = jax.nn.log_sigmoid(glr @ w_gk_up.astype(jnp.float32) + b_gk.astype(jnp.float32)) / GLA_GATE_NORMALIZER

    def heads(t, d):
        return t.reshape(B, S, GLA_HEADS, d).transpose(0, 2, 1, 3)

    o = gla_chunked(heads(q, GLA_DK) * GLA_DK ** -0.5, heads(k, GLA_DK),
                    heads(v, GLA_DV), heads(gk, GLA_DK))
    o = rms_norm(o, head_norm)
    o = o.transpose(0, 2, 1, 3).reshape(B, S, GLA_V) * jax.nn.silu(z)
    return o @ w_out.astype(jnp.float32)


def compress(t, pe, w1, w2):
    B, S, G, DH = t.shape
    r = CMP_BLOCK // CMP_STRIDE
    nc = (S - CMP_BLOCK) // CMP_STRIDE + 1
    pieces = t.reshape(B, S // CMP_STRIDE, CMP_STRIDE, G, DH)
    blocks = jnp.concatenate([pieces[:, i:i + nc] for i in range(r)], axis=2)
    blocks = blocks + pe.astype(jnp.float32)[None, None, :, None, :]
    flat = blocks.transpose(0, 3, 1, 2, 4).reshape(B, G, nc, CMP_BLOCK * DH)
    return jax.nn.silu(flat @ w1.astype(jnp.float32)) @ w2.astype(jnp.float32)


def nsa_mixer(h, positions, w_in, b_gate, pe_k, pe_v, ck_w1, ck_w2, cv_w1, cv_w2, w_out):
    B, S, _ = h.shape
    G, HPG, DH = NSA_GROUPS, NSA_HPG, NSA_DH
    p = (h @ w_in).astype(jnp.float32)
    splits = [NSA_Q + i * NSA_KV for i in range(7)] + [NSA_Q + 6 * NSA_KV + 3 * NSA_HEADS]
    q, kc, vc, ks, vs, kw, vw, gl, z = jnp.split(p, splits, axis=-1)

    q = rope(q.reshape(B, S, NSA_HEADS, DH), positions) * DH ** -0.5
    kc = rope(kc.reshape(B, S, G, DH), positions)
    ks = rope(ks.reshape(B, S, G, DH), positions)
    kw = rope(kw.reshape(B, S, G, DH), positions)
    vc = vc.reshape(B, S, G, DH)
    vs = vs.reshape(B, S, G, DH)
    vw = vw.reshape(B, S, G, DH)

    kcmp = compress(kc, pe_k, ck_w1, ck_w2)
    vcmp = compress(vc, pe_v, cv_w1, cv_w2)
    nc = kcmp.shape[2]
    ns = S // SEL_BLOCK
    nq = S // Q_BLOCK
    n_top = min(SEL_TOP, ns)

    ksb = ks.reshape(B, ns, SEL_BLOCK, G, DH).transpose(0, 3, 1, 2, 4)
    vsb = vs.reshape(B, ns, SEL_BLOCK, G, DH).transpose(0, 3, 1, 2, 4)
    pad = ((0, 0), (0, 0), (WINDOW, 0), (0, 0))
    kwp = jnp.pad(kw.transpose(0, 2, 1, 3), pad)
    vwp = jnp.pad(vw.transpose(0, 2, 1, 3), pad)

    cmp_start = jnp.arange(nc) * CMP_STRIDE
    cmp_end = cmp_start + CMP_BLOCK - 1
    sel_start = jnp.arange(ns) * SEL_BLOCK
    overlap = ((cmp_start[:, None] < sel_start[None, :] + SEL_BLOCK) &
               (cmp_start[:, None] + CMP_BLOCK > sel_start[None, :])).astype(jnp.float32)
    jb = jnp.arange(ns)
    bidx = jnp.arange(B)[:, None, None, None]
    gidx = jnp.arange(G)[None, :, None, None]

    qblocks = q.reshape(B, nq, Q_BLOCK, G, HPG, DH).transpose(1, 0, 3, 4, 2, 5)

    def block(args):
        n, qb = args
        t = n * Q_BLOCK + jnp.arange(Q_BLOCK)
        s = jnp.einsum('bghtd,bgcd->bghtc', qb, kcmp)
        valid = cmp_end[None, :] <= t[:, None]
        pc = jax.nn.softmax(jnp.where(valid, s, NEG), axis=-1)
        pc = jnp.where(jnp.any(valid, axis=-1)[:, None], pc, 0.0)
        o_c = jnp.einsum('bghtc,bgcd->bghtd', pc, vcmp)
        imp = jnp.einsum('bghtc,cj->bgtj', pc, overlap)
        cur = (t // SEL_BLOCK)[:, None]
        forced = (jb[None] == 0) | (jb[None] == cur) | (jb[None] == cur - 1)
        causal_blk = sel_start[None, :] <= t[:, None]
        imp = jnp.where(forced, BIG, jnp.where(causal_blk, imp, NEG))
        _, idx = lax.top_k(imp, n_top)
        k_sel = ksb[bidx, gidx, idx]
        v_sel = vsb[bidx, gidx, idx]
        pos = idx[..., None] * SEL_BLOCK + jnp.arange(SEL_BLOCK)
        smask = (pos <= t[:, None, None])[:, :, None]
        s = jnp.where(smask, jnp.einsum('bghtd,bgtksd->bghtks', qb, k_sel), NEG)
        ps = jax.nn.softmax(s.reshape(B, G, HPG, Q_BLOCK, n_top * SEL_BLOCK), axis=-1).reshape(s.shape)
        o_s = jnp.einsum('bghtks,bgtksd->bghtd', ps, v_sel)
        kwin = lax.dynamic_slice_in_dim(kwp, n * Q_BLOCK, WINDOW + Q_BLOCK, axis=2)
        vwin = lax.dynamic_slice_in_dim(vwp, n * Q_BLOCK, WINDOW + Q_BLOCK, axis=2)
        wpos = n * Q_BLOCK - WINDOW + jnp.arange(WINDOW + Q_BLOCK)
        dlt = t[:, None] - wpos[None, :]
        wmask = (dlt >= 0) & (dlt < WINDOW) & (wpos[None, :] >= 0)
        s = jnp.where(wmask, jnp.einsum('bghtd,bgsd->bghts', qb, kwin), NEG)
        o_w = jnp.einsum('bghts,bgsd->bghtd', jax.nn.softmax(s, axis=-1), vwin)
        return jnp.stack([o_c, o_s, o_w], axis=0)

    out = lax.map(block, (jnp.arange(nq), qblocks))
    out = out.transpose(2, 0, 5, 3, 4, 1, 6).reshape(B, S, NSA_HEADS, 3, DH)
    gates = jax.nn.sigmoid(gl + b_gate.astype(jnp.float32)).reshape(B, S, NSA_HEADS, 3)
    o = jnp.einsum('bshc,bshcd->bshd', gates, out).reshape(B, S, NSA_Q) * jax.nn.silu(z)
    return o @ w_out.astype(jnp.float32)


def setup_inputs(seed: int = 0) -> dict:
    key = jax.random.key(seed)
    ks = jax.random.split(key, 20)
    nrm = jax.random.normal
    f32 = jnp.float32
    return {
        "x": nrm(ks[0], (BATCH, SEQ, D_MODEL), f32),
        "positions": jnp.broadcast_to(jnp.arange(SEQ, dtype=jnp.int32), (BATCH, SEQ)),
        "pre_norm": 1.0 + 0.05 * nrm(ks[1], (DEPTH, D_MODEL), f32),
        "post_norm": 1.0 + 0.05 * nrm(ks[2], (DEPTH, D_MODEL), f32),
        "gla_w_in": nrm(ks[3], (N_GLA, D_MODEL, GLA_IN), f32) * D_MODEL ** -0.5,
        "gla_w_gk_up": nrm(ks[4], (N_GLA, GLA_GATE_RANK, GLA_QK), f32) * GLA_GATE_RANK ** -0.5,
        "gla_b_gk": 0.02 * nrm(ks[5], (N_GLA, GLA_QK), f32),
        "gla_head_norm": 1.0 + 0.05 * nrm(ks[6], (N_GLA, GLA_DV), f32),
        "gla_w_out": nrm(ks[7], (N_GLA, GLA_V, D_MODEL), f32) * GLA_V ** -0.5,
        "nsa_w_in": nrm(ks[8], (N_NSA, D_MODEL, NSA_IN), f32) * D_MODEL ** -0.5,
        "nsa_b_gate": 0.02 * nrm(ks[9], (N_NSA, 3 * NSA_HEADS), f32),
        "nsa_pe_k": 0.02 * nrm(ks[10], (N_NSA, CMP_BLOCK, NSA_DH), f32),
        "nsa_pe_v": 0.02 * nrm(ks[11], (N_NSA, CMP_BLOCK, NSA_DH), f32),
        "nsa_ck_w1": nrm(ks[12], (N_NSA, CMP_BLOCK * NSA_DH, CMP_HIDDEN), f32) * (CMP_BLOCK * NSA_DH) ** -0.5,
        "nsa_ck_w2": nrm(ks[13], (N_NSA, CMP_HIDDEN, NSA_DH), f32) * CMP_HIDDEN ** -0.5,
        "nsa_cv_w1": nrm(ks[14], (N_NSA, CMP_BLOCK * NSA_DH, CMP_HIDDEN), f32) * (CMP_BLOCK * NSA_DH) ** -0.5,
        "nsa_cv_w2": nrm(ks[15], (N_NSA, CMP_HIDDEN, NSA_DH), f32) * CMP_HIDDEN ** -0.5,
        "nsa_w_out": nrm(ks[16], (N_NSA, NSA_Q, D_MODEL), f32) * NSA_Q ** -0.5,
    }


def reference(x, positions, pre_norm, post_norm, gla_w_in, gla_w_gk_up, gla_b_gk, gla_head_norm,
              gla_w_out, nsa_w_in, nsa_b_gate, nsa_pe_k, nsa_pe_v, nsa_ck_w1, nsa_ck_w2,
              nsa_cv_w1, nsa_cv_w2, nsa_w_out):
    for i in range(DEPTH):
        h = rms_norm(x, pre_norm[i])
        j = i // N_MIXERS
        if i % N_MIXERS == 0:
            y = gla_mixer(h, gla_w_in[j], gla_w_gk_up[j], gla_b_gk[j], gla_head_norm[j], gla_w_out[j])
        else:
            y = nsa_mixer(h, positions, nsa_w_in[j], nsa_b_gate[j], nsa_pe_k[j], nsa_pe_v[j],
                          nsa_ck_w1[j], nsa_ck_w2[j], nsa_cv_w1[j], nsa_cv_w2[j], nsa_w_out[j])
        x = x + rms_norm(y.astype(x.dtype), post_norm[i])
    return x
```

```cpp
#include <hip/hip_runtime.h>
#include <hip/hip_cooperative_groups.h>
#include <cstdio>
#include <cstdint>
namespace cg = cooperative_groups;

typedef _Float16 half_t;
typedef _Float16 half8 __attribute__((ext_vector_type(8)));

#ifndef MEGA
#define MEGA 0
#endif

constexpr int T_TOK = 32768, DM = 1024, SEQ = 4096, NBATCH = 8;
constexpr int GLA_IN = 3088, NSA_IN = 3632;
constexpr int NC = 255;
constexpr float EPS = 1e-6f;
constexpr int NTHREADS = 256;
constexpr int SMEM_FLOATS = 27 * 1024;

struct Params {
  const float* x; const int* pos; const float* pre_norm; const float* post_norm;
  const float* gla_w_in; const float* gla_w_gk_up; const float* gla_b_gk; const float* gla_head_norm; const float* gla_w_out;
  const float* nsa_w_in; const float* nsa_b_gate; const float* nsa_pe_k; const float* nsa_pe_v;
  const float* ck_w1; const float* ck_w2; const float* cv_w1; const float* cv_w2; const float* nsa_w_out;
  float* out;
  half_t* p; float* y; float* o; float* bcum; float* rstd; float* kcmp; float* vcmp; float* ropetab;
};

__device__ __forceinline__ float wave_sum(float v) {
#pragma unroll
  for (int o = 32; o > 0; o >>= 1) v += __shfl_xor(v, o);
  return v;
}
__device__ __forceinline__ float wave_max(float v) {
#pragma unroll
  for (int o = 32; o > 0; o >>= 1) v = fmaxf(v, __shfl_xor(v, o));
  return v;
}
__device__ __forceinline__ float siluf(float v) { return v / (1.f + expf(-v)); }
__device__ __forceinline__ float sigmoidf(float v) { return 1.f / (1.f + expf(-v)); }
__device__ __forceinline__ float logsigmoidf(float u) { return fminf(u, 0.f) - log1pf(expf(-fabsf(u))); }

__device__ void ph_rstd(const float* src, float* rstd) {
  const int lane = threadIdx.x & 63, w = threadIdx.x >> 6;
  for (int row = blockIdx.x * 4 + w; row < T_TOK; row += gridDim.x * 4) {
    const float4* r = (const float4*)(src + (size_t)row * DM);
    float ss = 0.f;
#pragma unroll
    for (int i = 0; i < 4; ++i) { float4 v = r[lane + 64 * i]; ss += v.x * v.x + v.y * v.y + v.z * v.z + v.w * v.w; }
    ss = wave_sum(ss);
    if (lane == 0) rstd[row] = rsqrtf(ss * (1.f / DM) + EPS);
  }
}
__device__ void ph_ropetab(const Params& P) {
  for (int idx = blockIdx.x * NTHREADS + threadIdx.x; idx < T_TOK * 32; idx += gridDim.x * NTHREADS) {
    const int t = idx >> 5, i = idx & 31;
    const float inv = powf(10000.f, -(float)(2 * i) / 64.f);
    const float ang = (float)P.pos[t] * inv;
    float s, c; sincosf(ang, &s, &c);
    P.ropetab[t * 64 + i] = c; P.ropetab[t * 64 + 32 + i] = s;
  }
}

template <typename OutT>
__device__ void ph_gemm(const float* A, const float* rs, const float* gam, const float* W, OutT* C, int M, int N, int K, float* sm) {
  const int ntn = (N + 63) / 64, ntm = M / 64, ntiles = ntm * ntn;
  float(*As)[65] = (float(*)[65])sm;
  float(*Ws)[65] = (float(*)[65])(sm + 16 * 65);
  const int tid = threadIdx.x, tx = tid & 15, ty = tid >> 4;
  for (int tile = blockIdx.x; tile < ntiles; tile += gridDim.x) {
    const int tm = tile / ntn, tn = tile % ntn;
    float acc[4][4];
#pragma unroll
    for (int i = 0; i < 4; ++i)
#pragma unroll
      for (int j = 0; j < 4; ++j) acc[i][j] = 0.f;
#pragma unroll 1
    for (int k0 = 0; k0 < K; k0 += 16) {
#pragma unroll
      for (int r = 0; r < 4; ++r) {
        const int idx = tid + r * 256;
        { const int m = idx >> 4, k = idx & 15; const int gm = tm * 64 + m;
          float v = A[(size_t)gm * K + k0 + k];
          if (rs) v *= rs[gm];
          if (gam) v *= gam[k0 + k];
          As[k][m] = v; }
        { const int k = idx >> 6, n = idx & 63; const int gn = tn * 64 + n;
          Ws[k][n] = gn < N ? W[(size_t)(k0 + k) * N + gn] : 0.f; }
      }
      __syncthreads();
#pragma unroll 2
      for (int k = 0; k < 16; ++k) {
        float a[4], w[4];
#pragma unroll
        for (int i = 0; i < 4; ++i) a[i] = As[k][ty * 4 + i];
#pragma unroll
        for (int j = 0; j < 4; ++j) w[j] = Ws[k][tx * 4 + j];
#pragma unroll
        for (int i = 0; i < 4; ++i)
#pragma unroll
          for (int j = 0; j < 4; ++j) acc[i][j] += a[i] * w[j];
      }
      __syncthreads();
    }
#pragma unroll
    for (int i = 0; i < 4; ++i)
#pragma unroll
      for (int j = 0; j < 4; ++j) {
        const int gm = tm * 64 + ty * 4 + i, gn = tn * 64 + tx * 4 + j;
        if (gn < N) C[(size_t)gm * N + gn] = (OutT)acc[i][j];
      }
  }
}

__device__ void ph_bcum(const Params& P, float* sm) {
  float(*glr)[16] = (float(*)[16])sm;
  const int tid = threadIdx.x;
  for (int item = blockIdx.x; item < T_TOK / 64; item += gridDim.x) {
    const int t0 = item * 64;
    __syncthreads();
    for (int idx = tid; idx < 64 * 16; idx += NTHREADS) {
      const int i = idx >> 4, r = idx & 15;
      glr[i][r] = (float)P.p[(size_t)(t0 + i) * GLA_IN + 2048 + r];
    }
    __syncthreads();
    for (int ch = tid; ch < 512; ch += NTHREADS) {
      float w[16];
#pragma unroll
      for (int r = 0; r < 16; ++r) w[r] = P.gla_w_gk_up[r * 512 + ch];
      const float bb = P.gla_b_gk[ch];
      float cum = 0.f;
      for (int i = 0; i < 64; ++i) {
        float u = bb;
#pragma unroll
        for (int r = 0; r < 16; ++r) u += glr[i][r] * w[r];
        cum += logsigmoidf(u) * (1.f / 16.f);
        P.bcum[(size_t)(t0 + i) * 512 + ch] = cum;
      }
    }
  }
}

__device__ void ph_gla(const Params& P, float* sm) {
  float(*qe)[129] = (float(*)[129])sm;
  float(*kb)[129] = (float(*)[129])(sm + 64 * 129);
  float(*vv)[32] = (float(*)[32])(sm + 2 * 64 * 129);
  float(*aa)[65] = (float(*)[65])(sm + 2 * 64 * 129 + 2048);
  float(*S)[32] = (float(*)[32])(sm + 2 * 64 * 129 + 2048 + 64 * 65);
  float* dec = sm + 2 * 64 * 129 + 2048 + 64 * 65 + 4096;
  const int tid = threadIdx.x;
  const float scale = 0.08838834764831845f;
  for (int item = blockIdx.x; item < NBATCH * 4 * 8; item += gridDim.x) {
    const int b = item >> 5, h = (item >> 3) & 3, vs = item & 7;
    __syncthreads();
    for (int idx = tid; idx < 128 * 32; idx += NTHREADS) S[idx >> 5][idx & 31] = 0.f;
    for (int n = 0; n < 64; ++n) {
      const int t0 = b * SEQ + n * 64;
      __syncthreads();
      for (int idx = tid; idx < 64 * 128; idx += NTHREADS) {
        const int i = idx >> 7, d = idx & 127;
        const float bq = P.bcum[(size_t)(t0 + i) * 512 + h * 128 + d];
        const float q = (float)P.p[(size_t)(t0 + i) * GLA_IN + h * 128 + d];
        const float k = (float)P.p[(size_t)(t0 + i) * GLA_IN + 512 + h * 128 + d];
        qe[i][d] = q * scale * expf(bq);
        kb[i][d] = k * expf(-bq);
      }
      for (int idx = tid; idx < 64 * 32; idx += NTHREADS) {
        const int i = idx >> 5, c = idx & 31;
        vv[i][c] = (float)P.p[(size_t)(t0 + i) * GLA_IN + 1024 + h * 256 + vs * 32 + c];
      }
      if (tid < 128) dec[tid] = expf(P.bcum[(size_t)(t0 + 63) * 512 + h * 128 + tid]);
      __syncthreads();
      for (int idx = tid; idx < 64 * 64; idx += NTHREADS) {
        const int i = idx >> 6, j = idx & 63;
        float s = 0.f;
        if (j <= i) { for (int d = 0; d < 128; ++d) s += qe[i][d] * kb[j][d]; }
        aa[i][j] = s;
      }
      __syncthreads();
      {
        const int c = tid & 31, ig = tid >> 5;
        float acc[8];
#pragma unroll
        for (int ii = 0; ii < 8; ++ii) acc[ii] = 0.f;
        for (int j = 0; j < 64; ++j) {
          const float v = vv[j][c];
#pragma unroll
          for (int ii = 0; ii < 8; ++ii) acc[ii] += aa[ig * 8 + ii][j] * v;
        }
        for (int d = 0; d < 128; ++d) {
          const float s = S[d][c];
#pragma unroll
          for (int ii = 0; ii < 8; ++ii) acc[ii] += qe[ig * 8 + ii][d] * s;
        }
#pragma unroll
        for (int ii = 0; ii < 8; ++ii) P.o[(size_t)(t0 + ig * 8 + ii) * DM + h * 256 + vs * 32 + c] = acc[ii];
      }
      __syncthreads();
      {
        const int c = tid & 31, dg = tid >> 5;
        float acc[16];
#pragma unroll
        for (int dd = 0; dd < 16; ++dd) acc[dd] = 0.f;
        for (int cc = 0; cc < 64; ++cc) {
          const float v = vv[cc][c];
#pragma unroll
          for (int dd = 0; dd < 16; ++dd) acc[dd] += kb[cc][dg * 16 + dd] * v;
        }
#pragma unroll
        for (int dd = 0; dd < 16; ++dd) { const int d = dg * 16 + dd; S[d][c] = dec[d] * (S[d][c] + acc[dd]); }
      }
    }
  }
}

__device__ void ph_gla_post(const Params& P) {
  const int lane = threadIdx.x & 63, h = threadIdx.x >> 6;
  for (int t = blockIdx.x; t < T_TOK; t += gridDim.x) {
    float4* op = (float4*)(P.o + (size_t)t * DM + h * 256) + lane;
    float4 v = *op;
    float ss = wave_sum(v.x * v.x + v.y * v.y + v.z * v.z + v.w * v.w);
    const float r = rsqrtf(ss * (1.f / 256.f) + EPS);
    const float4 hn = ((const float4*)P.gla_head_norm)[lane];
    const half_t* z = P.p + (size_t)t * GLA_IN + 2064 + h * 256 + lane * 4;
    v.x = v.x * r * hn.x * siluf((float)z[0]);
    v.y = v.y * r * hn.y * siluf((float)z[1]);
    v.z = v.z * r * hn.z * siluf((float)z[2]);
    v.w = v.w * r * hn.w * siluf((float)z[3]);
    *op = v;
  }
}

__device__ void ph_post(const float* base, const float* y, const float* g, float* dst, float* rstd_out) {
  const int lane = threadIdx.x & 63, w = threadIdx.x >> 6;
  for (int row = blockIdx.x * 4 + w; row < T_TOK; row += gridDim.x * 4) {
    const float4* yr = (const float4*)(y + (size_t)row * DM);
    const float4* br = (const float4*)(base + (size_t)row * DM);
    float4* dr = (float4*)(dst + (size_t)row * DM);
    float4 v[4]; float ss = 0.f;
#pragma unroll
    for (int i = 0; i < 4; ++i) { v[i] = yr[lane + 64 * i]; ss += v[i].x * v[i].x + v[i].y * v[i].y + v[i].z * v[i].z + v[i].w * v[i].w; }
    ss = wave_sum(ss);
    const float r = rsqrtf(ss * (1.f / DM) + EPS);
    float s2 = 0.f;
#pragma unroll
    for (int i = 0; i < 4; ++i) {
      const float4 gg = ((const float4*)g)[lane + 64 * i];
      const float4 bb = br[lane + 64 * i];
      float4 o;
      o.x = bb.x + v[i].x * r * gg.x; o.y = bb.y + v[i].y * r * gg.y; o.z = bb.z + v[i].z * r * gg.z; o.w = bb.w + v[i].w * r * gg.w;
      s2 += o.x * o.x + o.y * o.y + o.z * o.z + o.w * o.w;
      dr[lane + 64 * i] = o;
    }
    if (rstd_out) { s2 = wave_sum(s2); if (lane == 0) rstd_out[row] = rsqrtf(s2 * (1.f / DM) + EPS); }
  }
}

__device__ void ph_rope(const Params& P) {
  const size_t total = (size_t)T_TOK * 28 * 32;
  for (size_t idx = (size_t)blockIdx.x * NTHREADS + threadIdx.x; idx < total; idx += (size_t)gridDim.x * NTHREADS) {
    const int i = idx & 31; const int slot = (idx >> 5) % 28; const int t = idx / (28 * 32);
    int col; float sc = 1.f;
    if (slot < 16) { col = slot * 64; sc = 0.125f; }
    else if (slot < 20) col = 1024 + (slot - 16) * 64;
    else if (slot < 24) col = 1536 + (slot - 20) * 64;
    else col = 2048 + (slot - 24) * 64;
    half_t* pp = P.p + (size_t)t * NSA_IN + col;
    const float c = P.ropetab[t * 64 + i], s = P.ropetab[t * 64 + 32 + i];
    const float x1 = (float)pp[i], x2 = (float)pp[32 + i];
    pp[i] = (half_t)((x1 * c - x2 * s) * sc);
    pp[32 + i] = (half_t)((x2 * c + x1 * s) * sc);
  }
}

__device__ void ph_compress(const Params& P, float* sm) {
  float* blk = sm;
  float* hid = sm + 2048;
  const int tid = threadIdx.x;
  const int nitems = 2 * NBATCH * 4 * NC;
  for (int item = blockIdx.x; item < nitems; item += gridDim.x) {
    const int which = item / (NBATCH * 4 * NC);
    const int rem = item % (NBATCH * 4 * NC);
    const int bg = rem / NC, c = rem % NC;
    const int b = bg >> 2, g = bg & 3;
    const float* pe = which ? P.nsa_pe_v : P.nsa_pe_k;
    const float* w1 = which ? P.cv_w1 : P.ck_w1;
    const float* w2 = which ? P.cv_w2 : P.ck_w2;
    float* dst = which ? P.vcmp : P.kcmp;
    const int col0 = which ? 1280 : 1024;
    __syncthreads();
    for (int idx = tid; idx < 2048; idx += NTHREADS) {
      const int l = idx >> 6, d = idx & 63;
      blk[idx] = (float)P.p[(size_t)(b * SEQ + 16 * c + l) * NSA_IN + col0 + g * 64 + d] + pe[idx];
    }
    __syncthreads();
    {
      float h = 0.f;
      for (int i = 0; i < 2048; ++i) h += blk[i] * w1[(size_t)i * 256 + tid];
      hid[tid] = siluf(h);
    }
    __syncthreads();
    if (tid < 64) {
      float o = 0.f;
      for (int j = 0; j < 256; ++j) o += hid[j] * w2[j * 64 + tid];
      dst[((size_t)bg * NC + c) * 64 + tid] = o;
    }
  }
}

__device__ __forceinline__ float dot64h(const float* q, const half_t* k) {
  float s = 0.f;
#pragma unroll
  for (int v = 0; v < 8; ++v) {
    const half8 kv = *(const half8*)(k + v * 8);
#pragma unroll
    for (int e = 0; e < 8; ++e) s += q[v * 8 + e] * (float)kv[e];
  }
  return s;
}
__device__ void ph_attn(const Params& P, float* sm) {
  float(*qs)[64] = (float(*)[64])sm;
  float(*pcs)[256] = (float(*)[256])(sm + 256);
  float(*ps)[1024] = (float(*)[1024])(sm + 256 + 1024);
  int* sel = (int*)(sm + 256 + 1024 + 4096);
  const int tid = threadIdx.x, lane = tid & 63, h = tid >> 6;
  const float NEGINF = -INFINITY;
  for (int item = blockIdx.x; item < T_TOK * 4; item += gridDim.x) {
    const int g = item & 3, t = item >> 2;
    const int b = t >> 12, tpos = t & 4095, cur = tpos >> 6;
    const int hd = g * 4 + h;
    const half_t* prow = P.p + (size_t)t * NSA_IN;
    __syncthreads();
    qs[h][lane] = (float)prow[hd * 64 + lane];
    __syncthreads();
    const int nvalid = tpos >= 31 ? min(NC, (tpos - 31) / 16 + 1) : 0;
    const float* kc = P.kcmp + (size_t)(b * 4 + g) * NC * 64;
    const float* vc = P.vcmp + (size_t)(b * 4 + g) * NC * 64;
    float sc[4]; float m = NEGINF;
#pragma unroll
    for (int r = 0; r < 4; ++r) {
      const int c = lane + 64 * r;
      float s = NEGINF;
      if (c < nvalid) { s = 0.f; for (int d = 0; d < 64; ++d) s += qs[h][d] * kc[c * 64 + d]; }
      sc[r] = s; m = fmaxf(m, s);
    }
    m = wave_max(m);
    float l = 0.f;
#pragma unroll
    for (int r = 0; r < 4; ++r) { sc[r] = (lane + 64 * r < nvalid) ? expf(sc[r] - m) : 0.f; l += sc[r]; }
    l = wave_sum(l);
    const float invl = nvalid > 0 ? 1.f / l : 0.f;
#pragma unroll
    for (int r = 0; r < 4; ++r) pcs[h][lane + 64 * r] = sc[r] * invl;
    __syncthreads();
    float oc = 0.f;
    for (int c = 0; c < nvalid; ++c) oc += pcs[h][c] * vc[c * 64 + lane];
    if (h == 0) {
      const int j = lane;
      float imp = 0.f;
#pragma unroll
      for (int cc = -1; cc <= 3; ++cc) {
        const int c = 4 * j + cc;
        if (c >= 0 && c < NC) imp += pcs[0][c] + pcs[1][c] + pcs[2][c] + pcs[3][c];
      }
      const bool forced = (j == 0) || (j == cur) || (j == cur - 1);
      if (forced) imp = 1e9f; else if (j > cur) imp = -1e30f;
      for (int r = 0; r < 16; ++r) {
        float bv = imp; int bi = j;
#pragma unroll
        for (int o = 32; o > 0; o >>= 1) {
          const float ov = __shfl_xor(bv, o); const int oi = __shfl_xor(bi, o);
          if (ov > bv || (ov == bv && oi < bi)) { bv = ov; bi = oi; }
        }
        if (lane == 0) sel[r] = bi;
        if (j == bi) imp = -INFINITY;
      }
    }
    __syncthreads();
    float osel;
    {
      float s16[16]; float mm = NEGINF;
#pragma unroll
      for (int r = 0; r < 16; ++r) {
        const int j = sel[r]; const int key = j * 64 + lane;
        float s = NEGINF;
        if (j <= cur && key <= tpos) s = dot64h(qs[h], P.p + (size_t)(b * SEQ + key) * NSA_IN + 1536 + g * 64);
        s16[r] = s; mm = fmaxf(mm, s);
      }
      mm = wave_max(mm);
      float ll = 0.f;
#pragma unroll
      for (int r = 0; r < 16; ++r) { const float e = (s16[r] == NEGINF) ? 0.f : expf(s16[r] - mm); s16[r] = e; ll += e; }
      ll = wave_sum(ll);
      const float il = 1.f / ll;
#pragma unroll
      for (int r = 0; r < 16; ++r) ps[h][r * 64 + lane] = s16[r] * il;
      __syncthreads();
      float acc = 0.f;
      for (int r = 0; r < 16; ++r) {
        const int j = sel[r];
        if (j > cur) continue;
        const half_t* vb = P.p + (size_t)(b * SEQ + j * 64) * NSA_IN + 1792 + g * 64 + lane;
        for (int kk = 0; kk < 64; ++kk) acc += ps[h][r * 64 + kk] * (float)vb[(size_t)kk * NSA_IN];
      }
      osel = acc;
    }
    __syncthreads();
    float owin;
    {
      float s8[8]; float mm = NEGINF;
#pragma unroll
      for (int r = 0; r < 8; ++r) {
        const int wpos = tpos - 511 + lane + 64 * r;
        float s = NEGINF;
        if (wpos >= 0) s = dot64h(qs[h], P.p + (size_t)(b * SEQ + wpos) * NSA_IN + 2048 + g * 64);
        s8[r] = s; mm = fmaxf(mm, s);
      }
      mm = wave_max(mm);
      float ll = 0.f;
#pragma unroll
      for (int r = 0; r < 8; ++r) { const float e = (s8[r] == NEGINF) ? 0.f : expf(s8[r] - mm); s8[r] = e; ll += e; }
      ll = wave_sum(ll);
      const float il = 1.f / ll;
#pragma unroll
      for (int r = 0; r < 8; ++r) ps[h][r * 64 + lane] = s8[r] * il;
      __syncthreads();
      float acc = 0.f;
      const int w0 = tpos - 511;
      for (int k = (w0 < 0 ? -w0 : 0); k < 512; ++k) {
        acc += ps[h][k] * (float)P.p[(size_t)(b * SEQ + w0 + k) * NSA_IN + 2304 + g * 64 + lane];
      }
      owin = acc;
    }
    const float g0 = sigmoidf((float)prow[2560 + hd * 3 + 0] + P.nsa_b_gate[hd * 3 + 0]);
    const float g1 = sigmoidf((float)prow[2560 + hd * 3 + 1] + P.nsa_b_gate[hd * 3 + 1]);
    const float g2 = sigmoidf((float)prow[2560 + hd * 3 + 2] + P.nsa_b_gate[hd * 3 + 2]);
    const float z = (float)prow[2608 + hd * 64 + lane];
    P.o[(size_t)t * DM + hd * 64 + lane] = (g0 * oc + g1 * osel + g2 * owin) * siluf(z);
  }
}

constexpr int NPHASES = 13;
__device__ __forceinline__ void run_phase(int ph, const Params& P, float* sm) {
  switch (ph) {
    case 0: ph_rstd(P.x, P.rstd); ph_ropetab(P); break;
    case 1: ph_gemm<half_t>(P.x, P.rstd, P.pre_norm, P.gla_w_in, P.p, T_TOK, GLA_IN, DM, sm); break;
    case 2: ph_bcum(P, sm); break;
    case 3: ph_gla(P, sm); break;
    case 4: ph_gla_post(P); break;
    case 5: ph_gemm<float>(P.o, nullptr, nullptr, P.gla_w_out, P.y, T_TOK, DM, DM, sm); break;
    case 6: ph_post(P.x, P.y, P.post_norm, P.out, P.rstd); break;
    case 7: ph_gemm<half_t>(P.out, P.rstd, P.pre_norm + DM, P.nsa_w_in, P.p, T_TOK, NSA_IN, DM, sm); break;
    case 8: ph_rope(P); break;
    case 9: ph_compress(P, sm); break;
    case 10: ph_attn(P, sm); break;
    case 11: ph_gemm<float>(P.o, nullptr, nullptr, P.nsa_w_out, P.y, T_TOK, DM, DM, sm); break;
    case 12: ph_post(P.out, P.y, P.post_norm + DM, P.out, nullptr); break;
  }
}

template <int PH>
__global__ void __launch_bounds__(NTHREADS) k_phase(Params P) {
  __shared__ float sm[SMEM_FLOATS];
  run_phase(PH, P, sm);
}
template <int PH>
static void launch_phases(const Params& P, hipStream_t stream) {
  hipLaunchKernelGGL(k_phase<PH>, dim3(2048), dim3(NTHREADS), 0, stream, P);
  if constexpr (PH + 1 < NPHASES) launch_phases<PH + 1>(P, stream);
}

__global__ void __launch_bounds__(NTHREADS) k_mega(Params P) {
  __shared__ float sm[SMEM_FLOATS];
  cg::grid_group grid = cg::this_grid();
  for (int ph = 0; ph < NPHASES; ++ph) {
    run_phase(ph, P, sm);
    if (ph + 1 < NPHASES) grid.sync();
  }
}

extern "C" void kernel_launch(void* const* d_in, const int* in_sizes, int n_in, void* d_out, int out_size, void* d_ws, size_t ws_size,
                              hipStream_t stream) {
  Params P{};
  P.x = (const float*)d_in[0]; P.pos = (const int*)d_in[1]; P.pre_norm = (const float*)d_in[2]; P.post_norm = (const float*)d_in[3];
  P.gla_w_in = (const float*)d_in[4]; P.gla_w_gk_up = (const float*)d_in[5]; P.gla_b_gk = (const float*)d_in[6];
  P.gla_head_norm = (const float*)d_in[7]; P.gla_w_out = (const float*)d_in[8];
  P.nsa_w_in = (const float*)d_in[9]; P.nsa_b_gate = (const float*)d_in[10]; P.nsa_pe_k = (const float*)d_in[11]; P.nsa_pe_v = (const float*)d_in[12];
  P.ck_w1 = (const float*)d_in[13]; P.ck_w2 = (const float*)d_in[14]; P.cv_w1 = (const float*)d_in[15]; P.cv_w2 = (const float*)d_in[16];
  P.nsa_w_out = (const float*)d_in[17];
  P.out = (float*)d_out;
  char* ws = (char*)d_ws;
  const size_t MB = 1024 * 1024;
  P.p = (half_t*)(ws);
  P.y = (float*)(ws);
  P.o = (float*)(ws + 240 * MB);
  P.bcum = (float*)(ws + 368 * MB);
  P.rstd = (float*)(ws + 432 * MB);
  P.kcmp = (float*)(ws + 433 * MB);
  P.vcmp = (float*)(ws + 436 * MB);
  P.ropetab = (float*)(ws + 439 * MB);
  if (ws_size < 448 * MB) { fprintf(stderr, "ws too small: %zu\n", ws_size); return; }
#if MEGA
  static int grid_blocks = 0;
  if (!grid_blocks) {
    int dev = 0, cus = 0, per_cu = 0;
    hipGetDevice(&dev);
    hipDeviceGetAttribute(&cus, hipDeviceAttributeMultiprocessorCount, dev);
    hipOccupancyMaxActiveBlocksPerMultiprocessor(&per_cu, k_mega, NTHREADS, 0);
    if (per_cu < 1) per_cu = 1;
    grid_blocks = cus * per_cu;
  }
  void* args[] = {&P};
  hipError_t e = hipLaunchCooperativeKernel((void*)k_mega, dim3(grid_blocks), dim3(NTHREADS), args, 0, stream);
  if (e != hipSuccess) fprintf(stderr, "cooperative launch failed: %s (grid %d)\n", hipGetErrorString(e), grid_blocks);
#else
  launch_phases<0>(P, stream);
#endif
}
```

```cpp
#include <hip/hip_runtime.h>
#include <hip/hip_cooperative_groups.h>
#include <cstdio>
#include <cstdint>
namespace cg = cooperative_groups;

typedef _Float16 half_t;
typedef _Float16 half8 __attribute__((ext_vector_type(8)));

#ifndef MEGA
#define MEGA 1
#endif

constexpr int T_TOK = 32768, DM = 1024, SEQ = 4096, NBATCH = 8;
constexpr int GLA_IN = 3088, NSA_IN = 3632;
constexpr int NC = 255;
constexpr float EPS = 1e-6f;
constexpr int NTHREADS = 256;
constexpr int SMEM_FLOATS = 27 * 1024;

struct Params {
  const float* x; const int* pos; const float* pre_norm; const float* post_norm;
  const float* gla_w_in; const float* gla_w_gk_up; const float* gla_b_gk; const float* gla_head_norm; const float* gla_w_out;
  const float* nsa_w_in; const float* nsa_b_gate; const float* nsa_pe_k; const float* nsa_pe_v;
  const float* ck_w1; const float* ck_w2; const float* cv_w1; const float* cv_w2; const float* nsa_w_out;
  float* out;
  half_t* p; float* y; float* o; float* bcum; float* rstd; float* kcmp; float* vcmp; float* ropetab;
};

__device__ __forceinline__ float wave_sum(float v) {
#pragma unroll
  for (int o = 32; o > 0; o >>= 1) v += __shfl_xor(v, o);
  return v;
}
__device__ __forceinline__ float wave_max(float v) {
#pragma unroll
  for (int o = 32; o > 0; o >>= 1) v = fmaxf(v, __shfl_xor(v, o));
  return v;
}
__device__ __forceinline__ float siluf(float v) { return v / (1.f + expf(-v)); }
__device__ __forceinline__ float sigmoidf(float v) { return 1.f / (1.f + expf(-v)); }
__device__ __forceinline__ float logsigmoidf(float u) { return fminf(u, 0.f) - log1pf(expf(-fabsf(u))); }

__device__ void ph_rstd(const float* src, float* rstd) {
  const int lane = threadIdx.x & 63, w = threadIdx.x >> 6;
  for (int row = blockIdx.x * 4 + w; row < T_TOK; row += gridDim.x * 4) {
    const float4* r = (const float4*)(src + (size_t)row * DM);
    float ss = 0.f;
#pragma unroll
    for (int i = 0; i < 4; ++i) { float4 v = r[lane + 64 * i]; ss += v.x * v.x + v.y * v.y + v.z * v.z + v.w * v.w; }
    ss = wave_sum(ss);
    if (lane == 0) rstd[row] = rsqrtf(ss * (1.f / DM) + EPS);
  }
}
__device__ void ph_ropetab(const Params& P) {
  for (int idx = blockIdx.x * NTHREADS + threadIdx.x; idx < T_TOK * 32; idx += gridDim.x * NTHREADS) {
    const int t = idx >> 5, i = idx & 31;
    const float inv = powf(10000.f, -(float)(2 * i) / 64.f);
    const float ang = (float)P.pos[t] * inv;
    float s, c; sincosf(ang, &s, &c);
    P.ropetab[t * 64 + i] = c; P.ropetab[t * 64 + 32 + i] = s;
  }
}

template <typename OutT>
__device__ void ph_gemm(const float* A, const float* rs, const float* gam, const float* W, OutT* C, int M, int N, int K, float* sm) {
  const int ntn = (N + 63) / 64, ntm = M / 64, ntiles = ntm * ntn;
  float(*As)[65] = (float(*)[65])sm;
  float(*Ws)[65] = (float(*)[65])(sm + 16 * 65);
  const int tid = threadIdx.x, tx = tid & 15, ty = tid >> 4;
  for (int tile = blockIdx.x; tile < ntiles; tile += gridDim.x) {
    const int tm = tile / ntn, tn = tile % ntn;
    float acc[4][4];
#pragma unroll
    for (int i = 0; i < 4; ++i)
#pragma unroll
      for (int j = 0; j < 4; ++j) acc[i][j] = 0.f;
#pragma unroll 1
    for (int k0 = 0; k0 < K; k0 += 16) {
#pragma unroll
      for (int r = 0; r < 4; ++r) {
        const int idx = tid + r * 256;
        { const int m = idx >> 4, k = idx & 15; const int gm = tm * 64 + m;
          float v = A[(size_t)gm * K + k0 + k];
          if (rs) v *= rs[gm];
          if (gam) v *= gam[k0 + k];
          As[k][m] = v; }
        { const int k = idx >> 6, n = idx & 63; const int gn = tn * 64 + n;
          Ws[k][n] = gn < N ? W[(size_t)(k0 + k) * N + gn] : 0.f; }
      }
      __syncthreads();
#pragma unroll 2
      for (int k = 0; k < 16; ++k) {
        float a[4], w[4];
#pragma unroll
        for (int i = 0; i < 4; ++i) a[i] = As[k][ty * 4 + i];
#pragma unroll
        for (int j = 0; j < 4; ++j) w[j] = Ws[k][tx * 4 + j];
#pragma unroll
        for (int i = 0; i < 4; ++i)
#pragma unroll
          for (int j = 0; j < 4; ++j) acc[i][j] += a[i] * w[j];
      }
      __syncthreads();
    }
#pragma unroll
    for (int i = 0; i < 4; ++i)
#pragma unroll
      for (int j = 0; j < 4; ++j) {
        const int gm = tm * 64 + ty * 4 + i, gn = tn * 64 + tx * 4 + j;
        if (gn < N) C[(size_t)gm * N + gn] = (OutT)acc[i][j];
      }
  }
}

__device__ void ph_bcum(const Params& P, float* sm) {
  float(*glr)[16] = (float(*)[16])sm;
  const int tid = threadIdx.x;
  for (int item = blockIdx.x; item < T_TOK / 64; item += gridDim.x) {
    const int t0 = item * 64;
    __syncthreads();
    for (int idx = tid; idx < 64 * 16; idx += NTHREADS) {
      const int i = idx >> 4, r = idx & 15;
      glr[i][r] = (float)P.p[(size_t)(t0 + i) * GLA_IN + 2048 + r];
    }
    __syncthreads();
    for (int ch = tid; ch < 512; ch += NTHREADS) {
      float w[16];
#pragma unroll
      for (int r = 0; r < 16; ++r) w[r] = P.gla_w_gk_up[r * 512 + ch];
      const float bb = P.gla_b_gk[ch];
      float cum = 0.f;
      for (int i = 0; i < 64; ++i) {
        float u = bb;
#pragma unroll
        for (int r = 0; r < 16; ++r) u += glr[i][r] * w[r];
        cum += logsigmoidf(u) * (1.f / 16.f);
        P.bcum[(size_t)(t0 + i) * 512 + ch] = cum;
      }
    }
  }
}

__device__ void ph_gla(const Params& P, float* sm) {
  float(*qe)[129] = (float(*)[129])sm;
  float(*kb)[129] = (float(*)[129])(sm + 64 * 129);
  float(*vv)[32] = (float(*)[32])(sm + 2 * 64 * 129);
  float(*aa)[65] = (float(*)[65])(sm + 2 * 64 * 129 + 2048);
  float(*S)[32] = (float(*)[32])(sm + 2 * 64 * 129 + 2048 + 64 * 65);
  float* dec = sm + 2 * 64 * 129 + 2048 + 64 * 65 + 4096;
  const int tid = threadIdx.x;
  const float scale = 0.08838834764831845f;
  for (int item = blockIdx.x; item < NBATCH * 4 * 8; item += gridDim.x) {
    const int b = item >> 5, h = (item >> 3) & 3, vs = item & 7;
    __syncthreads();
    for (int idx = tid; idx < 128 * 32; idx += NTHREADS) S[idx >> 5][idx & 31] = 0.f;
    for (int n = 0; n < 64; ++n) {
      const int t0 = b * SEQ + n * 64;
      __syncthreads();
      for (int idx = tid; idx < 64 * 128; idx += NTHREADS) {
        const int i = idx >> 7, d = idx & 127;
        const float bq = P.bcum[(size_t)(t0 + i) * 512 + h * 128 + d];
        const float q = (float)P.p[(size_t)(t0 + i) * GLA_IN + h * 128 + d];
        const float k = (float)P.p[(size_t)(t0 + i) * GLA_IN + 512 + h * 128 + d];
        qe[i][d] = q * scale * expf(bq);
        kb[i][d] = k * expf(-bq);
      }
      for (int idx = tid; idx < 64 * 32; idx += NTHREADS) {
        const int i = idx >> 5, c = idx & 31;
        vv[i][c] = (float)P.p[(size_t)(t0 + i) * GLA_IN + 1024 + h * 256 + vs * 32 + c];
      }
      if (tid < 128) dec[tid] = expf(P.bcum[(size_t)(t0 + 63) * 512 + h * 128 + tid]);
      __syncthreads();
      for (int idx = tid; idx < 64 * 64; idx += NTHREADS) {
        const int i = idx >> 6, j = idx & 63;
        float s = 0.f;
        if (j <= i) { for (int d = 0; d < 128; ++d) s += qe[i][d] * kb[j][d]; }
        aa[i][j] = s;
      }
      __syncthreads();
      {
        const int c = tid & 31, ig = tid >> 5;
        float acc[8];
#pragma unroll
        for (int ii = 0; ii < 8; ++ii) acc[ii] = 0.f;
        for (int j = 0; j < 64; ++j) {
          const float v = vv[j][c];
#pragma unroll
          for (int ii = 0; ii < 8; ++ii) acc[ii] += aa[ig * 8 + ii][j] * v;
        }
        for (int d = 0; d < 128; ++d) {
          const float s = S[d][c];
#pragma unroll
          for (int ii = 0; ii < 8; ++ii) acc[ii] += qe[ig * 8 + ii][d] * s;
        }
#pragma unroll
        for (int ii = 0; ii < 8; ++ii) P.o[(size_t)(t0 + ig * 8 + ii) * DM + h * 256 + vs * 32 + c] = acc[ii];
      }
      __syncthreads();
      {
        const int c = tid & 31, dg = tid >> 5;
        float acc[16];
#pragma unroll
        for (int dd = 0; dd < 16; ++dd) acc[dd] = 0.f;
        for (int cc = 0; cc < 64; ++cc) {
          const float v = vv[cc][c];
#pragma unroll
          for (int dd = 0; dd < 16; ++dd) acc[dd] += kb[cc][dg * 16 + dd] * v;
        }
#pragma unroll
        for (int dd = 0; dd < 16; ++dd) { const int d = dg * 16 + dd; S[d][c] = dec[d] * (S[d][c] + acc[dd]); }
      }
    }
  }
}

__device__ void ph_gla_post(const Params& P) {
  const int lane = threadIdx.x & 63, h = threadIdx.x >> 6;
  for (int t = blockIdx.x; t < T_TOK; t += gridDim.x) {
    float4* op = (float4*)(P.o + (size_t)t * DM + h * 256) + lane;
    float4 v = *op;
    float ss = wave_sum(v.x * v.x + v.y * v.y + v.z * v.z + v.w * v.w);
    const float r = rsqrtf(ss * (1.f / 256.f) + EPS);
    const float4 hn = ((const float4*)P.gla_head_norm)[lane];
    const half_t* z = P.p + (size_t)t * GLA_IN + 2064 + h * 256 + lane * 4;
    v.x = v.x * r * hn.x * siluf((float)z[0]);
    v.y = v.y * r * hn.y * siluf((float)z[1]);
    v.z = v.z * r * hn.z * siluf((float)z[2]);
    v.w = v.w * r * hn.w * siluf((float)z[3]);
    *op = v;
  }
}

__device__ void ph_post(const float* base, const float* y, const float* g, float* dst, float* rstd_out) {
  const int lane = threadIdx.x & 63, w = threadIdx.x >> 6;
  for (int row = blockIdx.x * 4 + w; row < T_TOK; row += gridDim.x * 4) {
    const float4* yr = (const float4*)(y + (size_t)row * DM);
    const float4* br = (const float4*)(base + (size_t)row * DM);
    float4* dr = (float4*)(dst + (size_t)row * DM);
    float4 v[4]; float ss = 0.f;
#pragma unroll
    for (int i = 0; i < 4; ++i) { v[i] = yr[lane + 64 * i]; ss += v[i].x * v[i].x + v[i].y * v[i].y + v[i].z * v[i].z + v[i].w * v[i].w; }
    ss = wave_sum(ss);
    const float r = rsqrtf(ss * (1.f / DM) + EPS);
    float s2 = 0.f;
#pragma unroll
    for (int i = 0; i < 4; ++i) {
      const float4 gg = ((const float4*)g)[lane + 64 * i];
      const float4 bb = br[lane + 64 * i];
      float4 o;
      o.x = bb.x + v[i].x * r * gg.x; o.y = bb.y + v[i].y * r * gg.y; o.z = bb.z + v[i].z * r * gg.z; o.w = bb.w + v[i].w * r * gg.w;
      s2 += o.x * o.x + o.y * o.y + o.z * o.z + o.w * o.w;
      dr[lane + 64 * i] = o;
    }
    if (rstd_out) { s2 = wave_sum(s2); if (lane == 0) rstd_out[row] = rsqrtf(s2 * (1.f / DM) + EPS); }
  }
}

__device__ void ph_rope(const Params& P) {
  const size_t total = (size_t)T_TOK * 28 * 32;
  for (size_t idx = (size_t)blockIdx.x * NTHREADS + threadIdx.x; idx < total; idx += (size_t)gridDim.x * NTHREADS) {
    const int i = idx & 31; const int slot = (idx >> 5) % 28; const int t = idx / (28 * 32);
    int col; float sc = 1.f;
    if (slot < 16) { col = slot * 64; sc = 0.125f; }
    else if (slot < 20) col = 1024 + (slot - 16) * 64;
    else if (slot < 24) col = 1536 + (slot - 20) * 64;
    else col = 2048 + (slot - 24) * 64;
    half_t* pp = P.p + (size_t)t * NSA_IN + col;
    const float c = P.ropetab[t * 64 + i], s = P.ropetab[t * 64 + 32 + i];
    const float x1 = (float)pp[i], x2 = (float)pp[32 + i];
    pp[i] = (half_t)((x1 * c - x2 * s) * sc);
    pp[32 + i] = (half_t)((x2 * c + x1 * s) * sc);
  }
}

__device__ void ph_compress(const Params& P, float* sm) {
  float* blk = sm;
  float* hid = sm + 2048;
  const int tid = threadIdx.x;
  const int nitems = 2 * NBATCH * 4 * NC;
  for (int item = blockIdx.x; item < nitems; item += gridDim.x) {
    const int which = item / (NBATCH * 4 * NC);
    const int rem = item % (NBATCH * 4 * NC);
    const int bg = rem / NC, c = rem % NC;
    const int b = bg >> 2, g = bg & 3;
    const float* pe = which ? P.nsa_pe_v : P.nsa_pe_k;
    const float* w1 = which ? P.cv_w1 : P.ck_w1;
    const float* w2 = which ? P.cv_w2 : P.ck_w2;
    float* dst = which ? P.vcmp : P.kcmp;
    const int col0 = which ? 1280 : 1024;
    __syncthreads();
    for (int idx = tid; idx < 2048; idx += NTHREADS) {
      const int l = idx >> 6, d = idx & 63;
      blk[idx] = (float)P.p[(size_t)(b * SEQ + 16 * c + l) * NSA_IN + col0 + g * 64 + d] + pe[idx];
    }
    __syncthreads();
    {
      float h = 0.f;
      for (int i = 0; i < 2048; ++i) h += blk[i] * w1[(size_t)i * 256 + tid];
      hid[tid] = siluf(h);
    }
    __syncthreads();
    if (tid < 64) {
      float o = 0.f;
      for (int j = 0; j < 256; ++j) o += hid[j] * w2[j * 64 + tid];
      dst[((size_t)bg * NC + c) * 64 + tid] = o;
    }
  }
}

__device__ __forceinline__ float dot64h(const float* q, const half_t* k) {
  float s = 0.f;
#pragma unroll
  for (int v = 0; v < 8; ++v) {
    const half8 kv = *(const half8*)(k + v * 8);
#pragma unroll
    for (int e = 0; e < 8; ++e) s += q[v * 8 + e] * (float)kv[e];
  }
  return s;
}
__device__ void ph_attn(const Params& P, float* sm) {
  float(*qs)[64] = (float(*)[64])sm;
  float(*pcs)[256] = (float(*)[256])(sm + 256);
  float(*ps)[1024] = (float(*)[1024])(sm + 256 + 1024);
  int* sel = (int*)(sm + 256 + 1024 + 4096);
  const int tid = threadIdx.x, lane = tid & 63, h = tid >> 6;
  const float NEGINF = -INFINITY;
  for (int item = blockIdx.x; item < T_TOK * 4; item += gridDim.x) {
    const int g = item & 3, t = item >> 2;
    const int b = t >> 12, tpos = t & 4095, cur = tpos >> 6;
    const int hd = g * 4 + h;
    const half_t* prow = P.p + (size_t)t * NSA_IN;
    __syncthreads();
    qs[h][lane] = (float)prow[hd * 64 + lane];
    __syncthreads();
    const int nvalid = tpos >= 31 ? min(NC, (tpos - 31) / 16 + 1) : 0;
    const float* kc = P.kcmp + (size_t)(b * 4 + g) * NC * 64;
    const float* vc = P.vcmp + (size_t)(b * 4 + g) * NC * 64;
    float sc[4]; float m = NEGINF;
#pragma unroll
    for (int r = 0; r < 4; ++r) {
      const int c = lane + 64 * r;
      float s = NEGINF;
      if (c < nvalid) { s = 0.f; for (int d = 0; d < 64; ++d) s += qs[h][d] * kc[c * 64 + d]; }
      sc[r] = s; m = fmaxf(m, s);
    }
    m = wave_max(m);
    float l = 0.f;
#pragma unroll
    for (int r = 0; r < 4; ++r) { sc[r] = (lane + 64 * r < nvalid) ? expf(sc[r] - m) : 0.f; l += sc[r]; }
    l = wave_sum(l);
    const float invl = nvalid > 0 ? 1.f / l : 0.f;
#pragma unroll
    for (int r = 0; r < 4; ++r) pcs[h][lane + 64 * r] = sc[r] * invl;
    __syncthreads();
    float oc = 0.f;
    for (int c = 0; c < nvalid; ++c) oc += pcs[h][c] * vc[c * 64 + lane];
    if (h == 0) {
      const int j = lane;
      float imp = 0.f;
#pragma unroll
      for (int cc = -1; cc <= 3; ++cc) {
        const int c = 4 * j + cc;
        if (c >= 0 && c < NC) imp += pcs[0][c] + pcs[1][c] + pcs[2][c] + pcs[3][c];
      }
      const bool forced = (j == 0) || (j == cur) || (j == cur - 1);
      if (forced) imp = 1e9f; else if (j > cur) imp = -1e30f;
      for (int r = 0; r < 16; ++r) {
        float bv = imp; int bi = j;
#pragma unroll
        for (int o = 32; o > 0; o >>= 1) {
          const float ov = __shfl_xor(bv, o); const int oi = __shfl_xor(bi, o);
          if (ov > bv || (ov == bv && oi < bi)) { bv = ov; bi = oi; }
        }
        if (lane == 0) sel[r] = bi;
        if (j == bi) imp = -INFINITY;
      }
    }
    __syncthreads();
    float osel;
    {
      float s16[16]; float mm = NEGINF;
#pragma unroll
      for (int r = 0; r < 16; ++r) {
        const int j = sel[r]; const int key = j * 64 + lane;
        float s = NEGINF;
        if (j <= cur && key <= tpos) s = dot64h(qs[h], P.p + (size_t)(b * SEQ + key) * NSA_IN + 1536 + g * 64);
        s16[r] = s; mm = fmaxf(mm, s);
      }
      mm = wave_max(mm);
      float ll = 0.f;
#pragma unroll
      for (int r = 0; r < 16; ++r) { const float e = (s16[r] == NEGINF) ? 0.f : expf(s16[r] - mm); s16[r] = e; ll += e; }
      ll = wave_sum(ll);
      const float il = 1.f / ll;
#pragma unroll
      for (int r = 0; r < 16; ++r) ps[h][r * 64 + lane] = s16[r] * il;
      __syncthreads();
      float acc = 0.f;
      for (int r = 0; r < 16; ++r) {
        const int j = sel[r];
        if (j > cur) continue;
        const half_t* vb = P.p + (size_t)(b * SEQ + j * 64) * NSA_IN + 1792 + g * 64 + lane;
        for (int kk = 0; kk < 64; ++kk) acc += ps[h][r * 64 + kk] * (float)vb[(size_t)kk * NSA_IN];
      }
      osel = acc;
    }
    __syncthreads();
    float owin;
    {
      float s8[8]; float mm = NEGINF;
#pragma unroll
      for (int r = 0; r < 8; ++r) {
        const int wpos = tpos - 511 + lane + 64 * r;
        float s = NEGINF;
        if (wpos >= 0) s = dot64h(qs[h], P.p + (size_t)(b * SEQ + wpos) * NSA_IN + 2048 + g * 64);
        s8[r] = s; mm = fmaxf(mm, s);
      }
      mm = wave_max(mm);
      float ll = 0.f;
#pragma unroll
      for (int r = 0; r < 8; ++r) { const float e = (s8[r] == NEGINF) ? 0.f : expf(s8[r] - mm); s8[r] = e; ll += e; }
      ll = wave_sum(ll);
      const float il = 1.f / ll;
#pragma unroll
      for (int r = 0; r < 8; ++r) ps[h][r * 64 + lane] = s8[r] * il;
      __syncthreads();
      float acc = 0.f;
      const int w0 = tpos - 511;
      for (int k = (w0 < 0 ? -w0 : 0); k < 512; ++k) {
        acc += ps[h][k] * (float)P.p[(size_t)(b * SEQ + w0 + k) * NSA_IN + 2304 + g * 64 + lane];
      }
      owin = acc;
    }
    const float g0 = sigmoidf((float)prow[2560 + hd * 3 + 0] + P.nsa_b_gate[hd * 3 + 0]);
    const float g1 = sigmoidf((float)prow[2560 + hd * 3 + 1] + P.nsa_b_gate[hd * 3 + 1]);
    const float g2 = sigmoidf((float)prow[2560 + hd * 3 + 2] + P.nsa_b_gate[hd * 3 + 2]);
    const float z = (float)prow[2608 + hd * 64 + lane];
    P.o[(size_t)t * DM + hd * 64 + lane] = (g0 * oc + g1 * osel + g2 * owin) * siluf(z);
  }
}

constexpr int NPHASES = 13;
__device__ __forceinline__ void run_phase(int ph, const Params& P, float* sm) {
  switch (ph) {
    case 0: ph_rstd(P.x, P.rstd); ph_ropetab(P); break;
    case 1: ph_gemm<half_t>(P.x, P.rstd, P.pre_norm, P.gla_w_in, P.p, T_TOK, GLA_IN, DM, sm); break;
    case 2: ph_bcum(P, sm); break;
    case 3: ph_gla(P, sm); break;
    case 4: ph_gla_post(P); break;
    case 5: ph_gemm<float>(P.o, nullptr, nullptr, P.gla_w_out, P.y, T_TOK, DM, DM, sm); break;
    case 6: ph_post(P.x, P.y, P.post_norm, P.out, P.rstd); break;
    case 7: ph_gemm<half_t>(P.out, P.rstd, P.pre_norm + DM, P.nsa_w_in, P.p, T_TOK, NSA_IN, DM, sm); break;
    case 8: ph_rope(P); break;
    case 9: ph_compress(P, sm); break;
    case 10: ph_attn(P, sm); break;
    case 11: ph_gemm<float>(P.o, nullptr, nullptr, P.nsa_w_out, P.y, T_TOK, DM, DM, sm); break;
    case 12: ph_post(P.out, P.y, P.post_norm + DM, P.out, nullptr); break;
  }
}

template <int PH>
__global__ void __launch_bounds__(NTHREADS) k_phase(Params P) {
  __shared__ float sm[SMEM_FLOATS];
  run_phase(PH, P, sm);
}
template <int PH>
static void launch_phases(const Params& P, hipStream_t stream) {
  hipLaunchKernelGGL(k_phase<PH>, dim3(2048), dim3(NTHREADS), 0, stream, P);
  if constexpr (PH + 1 < NPHASES) launch_phases<PH + 1>(P, stream);
}

__global__ void __launch_bounds__(NTHREADS) k_mega(Params P) {
  __shared__ float sm[SMEM_FLOATS];
  cg::grid_group grid = cg::this_grid();
  for (int ph = 0; ph < NPHASES; ++ph) {
    run_phase(ph, P, sm);
    if (ph + 1 < NPHASES) grid.sync();
  }
}

extern "C" void kernel_launch(void* const* d_in, const int* in_sizes, int n_in, void* d_out, int out_size, void* d_ws, size_t ws_size,
                              hipStream_t stream) {
  Params P{};
  P.x = (const float*)d_in[0]; P.pos = (const int*)d_in[1]; P.pre_norm = (const float*)d_in[2]; P.post_norm = (const float*)d_in[3];
  P.gla_w_in = (const float*)d_in[4]; P.gla_w_gk_up = (const float*)d_in[5]; P.gla_b_gk = (const float*)d_in[6];
  P.gla_head_norm = (const float*)d_in[7]; P.gla_w_out = (const float*)d_in[8];
  P.nsa_w_in = (const float*)d_in[9]; P.nsa_b_gate = (const float*)d_in[10]; P.nsa_pe_k = (const float*)d_in[11]; P.nsa_pe_v = (const float*)d_in[12];
  P.ck_w1 = (const float*)d_in[13]; P.ck_w2 = (const float*)d_in[14]; P.cv_w1 = (const float*)d_in[15]; P.cv_w2 = (const float*)d_in[16];
  P.nsa_w_out = (const float*)d_in[17];
  P.out = (float*)d_out;
  char* ws = (char*)d_ws;
  const size_t MB = 1024 * 1024;
  P.p = (half_t*)(ws);
  P.y = (float*)(ws);
  P.o = (float*)(ws + 240 * MB);
  P.bcum = (float*)(ws + 368 * MB);
  P.rstd = (float*)(ws + 432 * MB);
  P.kcmp = (float*)(ws + 433 * MB);
  P.vcmp = (float*)(ws + 436 * MB);
  P.ropetab = (float*)(ws + 439 * MB);
  if (ws_size < 448 * MB) { fprintf(stderr, "ws too small: %zu\n", ws_size); return; }
#if MEGA
  static int grid_blocks = 0;
  if (!grid_blocks) {
    int dev = 0, cus = 0, per_cu = 0;
    hipGetDevice(&dev);
    hipDeviceGetAttribute(&cus, hipDeviceAttributeMultiprocessorCount, dev);
    hipOccupancyMaxActiveBlocksPerMultiprocessor(&per_cu, k_mega, NTHREADS, 0);
    if (per_cu < 1) per_cu = 1;
    grid_blocks = cus * per_cu;
  }
  void* args[] = {&P};
  hipError_t e = hipLaunchCooperativeKernel((void*)k_mega, dim3(grid_blocks), dim3(NTHREADS), args, 0, stream);
  if (e != hipSuccess) fprintf(stderr, "cooperative launch failed: %s (grid %d)\n", hipGetErrorString(e), grid_blocks);
#else
  launch_phases<0>(P, stream);
#endif
}
```

```cpp
#include <hip/hip_runtime.h>
#include <hip/hip_cooperative_groups.h>
#include <cstdio>
#include <cstdint>
namespace cg = cooperative_groups;

typedef _Float16 half_t;
typedef _Float16 half8 __attribute__((ext_vector_type(8)));
typedef _Float16 half4 __attribute__((ext_vector_type(4)));
typedef float f32x4 __attribute__((ext_vector_type(4)));

#ifndef MEGA
#define MEGA 1
#endif

constexpr int T_TOK = 32768, DM = 1024, SEQ = 4096, NBATCH = 8;
constexpr int GLA_IN = 3088, NSA_IN = 3632;
constexpr int LD0 = 3200, LD1 = 3712;
constexpr int NC = 255;
constexpr float EPS = 1e-6f;
constexpr int NTHREADS = 256;
constexpr int SMEM_BYTES = 108 * 1024;

struct Params {
  const float* x; const int* pos; const float* pre_norm; const float* post_norm;
  const float* gla_w_in; const float* gla_w_gk_up; const float* gla_b_gk; const float* gla_head_norm; const float* gla_w_out;
  const float* nsa_w_in; const float* nsa_b_gate; const float* nsa_pe_k; const float* nsa_pe_v;
  const float* ck_w1; const float* ck_w2; const float* cv_w1; const float* cv_w2; const float* nsa_w_out;
  float* out;
  half_t* p; half_t* y; half_t* og; float* bcum; float* rstd; float* kcmp; float* vcmp; float* ropetab;
  half_t* xh; half_t* W0t; half_t* Wo0t; half_t* W1t; half_t* Wo1t;
};

__device__ __forceinline__ float wave_sum(float v) {
#pragma unroll
  for (int o = 32; o > 0; o >>= 1) v += __shfl_xor(v, o);
  return v;
}
__device__ __forceinline__ float wave_max(float v) {
#pragma unroll
  for (int o = 32; o > 0; o >>= 1) v = fmaxf(v, __shfl_xor(v, o));
  return v;
}
__device__ __forceinline__ float siluf(float v) { return v / (1.f + expf(-v)); }
__device__ __forceinline__ float sigmoidf(float v) { return 1.f / (1.f + expf(-v)); }
__device__ __forceinline__ float logsigmoidf(float u) { return fminf(u, 0.f) - log1pf(expf(-fabsf(u))); }

__device__ void ph_xh_rstd(const float* src, half_t* xh, float* rstd) {
  const int lane = threadIdx.x & 63, w = threadIdx.x >> 6;
  for (int row = blockIdx.x * 4 + w; row < T_TOK; row += gridDim.x * 4) {
    const float4* r = (const float4*)(src + (size_t)row * DM);
    half4* xr = (half4*)(xh + (size_t)row * DM);
    float ss = 0.f;
#pragma unroll
    for (int i = 0; i < 4; ++i) {
      const float4 v = r[lane + 64 * i];
      ss += v.x * v.x + v.y * v.y + v.z * v.z + v.w * v.w;
      half4 hv; hv[0] = (half_t)v.x; hv[1] = (half_t)v.y; hv[2] = (half_t)v.z; hv[3] = (half_t)v.w;
      xr[lane + 64 * i] = hv;
    }
    ss = wave_sum(ss);
    if (lane == 0) rstd[row] = rsqrtf(ss * (1.f / DM) + EPS);
  }
}
__device__ void ph_ropetab(const Params& P) {
  for (int idx = blockIdx.x * NTHREADS + threadIdx.x; idx < T_TOK * 32; idx += gridDim.x * NTHREADS) {
    const int t = idx >> 5, i = idx & 31;
    const float inv = powf(10000.f, -(float)(2 * i) / 64.f);
    const float ang = (float)P.pos[t] * inv;
    float s, c; sincosf(ang, &s, &c);
    P.ropetab[t * 64 + i] = c; P.ropetab[t * 64 + 32 + i] = s;
  }
}
__device__ __forceinline__ int orig_col(int n, int mode) {
  if (mode == 0) {
    if (n < 2048) return n;
    if (n < 3072) return n + 16;
    if (n < 3088) return n - 1024;
    return -1;
  } else if (mode == 1) {
    if (n < 2560) return n;
    if (n < 3584) return n + 48;
    if (n < 3632) return n - 1024;
    return -1;
  }
  return n;
}
__device__ void prep_wT(const float* W, int ldw, const float* gamma, half_t* Wt, int Npad, int K, int mode, float* sm) {
  float(*tile)[65] = (float(*)[65])sm;
  const int tid = threadIdx.x;
  const int ntn = Npad / 64, ntk = K / 64;
  for (int t = blockIdx.x; t < ntn * ntk; t += gridDim.x) {
    const int n0 = (t / ntk) * 64, k0 = (t % ntk) * 64;
    __syncthreads();
#pragma unroll 4
    for (int r = 0; r < 16; ++r) {
      const int idx = tid + r * 256, kk = idx >> 6, nn = idx & 63;
      const int on = orig_col(n0 + nn, mode);
      float v = 0.f;
      if (on >= 0) { v = W[(size_t)(k0 + kk) * ldw + on]; if (gamma) v *= gamma[k0 + kk]; }
      tile[kk][nn] = v;
    }
    __syncthreads();
#pragma unroll 4
    for (int r = 0; r < 16; ++r) {
      const int idx = tid + r * 256, nn = idx >> 6, kk = idx & 63;
      Wt[(size_t)(n0 + nn) * K + k0 + kk] = (half_t)tile[kk][nn];
    }
  }
}

struct EpiStore {
  half_t* C; int ldc; const float* rowscale;
  __device__ __forceinline__ void operator()(const f32x4 (&acc)[4][4], int tok0, int col0, int lane) const {
    const int r15 = lane & 15, q = lane >> 4;
#pragma unroll
    for (int m = 0; m < 4; ++m) {
      const int tok = tok0 + m * 16 + r15;
      const float s = rowscale ? rowscale[tok] : 1.f;
#pragma unroll
      for (int n = 0; n < 4; ++n) {
        const f32x4 v = acc[m][n] * s;
        half4 hv; hv[0] = (half_t)v[0]; hv[1] = (half_t)v[1]; hv[2] = (half_t)v[2]; hv[3] = (half_t)v[3];
        *(half4*)(C + (size_t)tok * ldc + col0 + n * 16 + 4 * q) = hv;
      }
    }
  }
};
struct EpiRope {
  half_t* C; int ldc; const float* rowscale; const float* ropetab;
  __device__ __forceinline__ void operator()(const f32x4 (&acc)[4][4], int tok0, int col0, int lane) const {
    const int r15 = lane & 15, q = lane >> 4;
    const int grp = col0 >> 6;
    const bool is_q = grp < 16;
    const bool roped = is_q || (grp >= 16 && grp < 20) || (grp >= 24 && grp < 28) || (grp >= 32 && grp < 36);
    const float sc = is_q ? 0.125f : 1.f;
#pragma unroll
    for (int m = 0; m < 4; ++m) {
      const int tok = tok0 + m * 16 + r15;
      const float s = rowscale[tok];
      if (roped) {
#pragma unroll
        for (int n = 0; n < 2; ++n) {
          const f32x4 cs = *(const f32x4*)(ropetab + (size_t)tok * 64 + n * 16 + 4 * q);
          const f32x4 sn = *(const f32x4*)(ropetab + (size_t)tok * 64 + 32 + n * 16 + 4 * q);
          const f32x4 x1 = acc[m][n] * s, x2 = acc[m][n + 2] * s;
          const f32x4 o1 = (x1 * cs - x2 * sn) * sc, o2 = (x2 * cs + x1 * sn) * sc;
          half4 h1, h2;
#pragma unroll
          for (int e = 0; e < 4; ++e) { h1[e] = (half_t)o1[e]; h2[e] = (half_t)o2[e]; }
          *(half4*)(C + (size_t)tok * ldc + col0 + n * 16 + 4 * q) = h1;
          *(half4*)(C + (size_t)tok * ldc + col0 + (n + 2) * 16 + 4 * q) = h2;
        }
      } else {
#pragma unroll
        for (int n = 0; n < 4; ++n) {
          const f32x4 v = acc[m][n] * s;
          half4 hv; hv[0] = (half_t)v[0]; hv[1] = (half_t)v[1]; hv[2] = (half_t)v[2]; hv[3] = (half_t)v[3];
          *(half4*)(C + (size_t)tok * ldc + col0 + n * 16 + 4 * q) = hv;
        }
      }
    }
  }
};

template <class Epi>
__device__ void gemm_mfma(const half_t* __restrict__ A, int lda, const half_t* __restrict__ Bt, int M, int Npad, int K, const Epi& epi, char* smem) {
  const int tid = threadIdx.x, lane = tid & 63, wave = tid >> 6, wr = wave >> 1, wc = wave & 1;
  const int r15 = lane & 15, q = lane >> 4;
  const int NT = Npad / 128, MT = M / 128;
  const int xcd = blockIdx.x & 7, slot = blockIdx.x >> 3, nslots = gridDim.x >> 3;
  const int mt_per_xcd = MT / 8;
  const int ntl = mt_per_xcd * NT;
  const int nk = K / 64;
  const int lrow = tid >> 3, lch = tid & 7;
  const int wofs = lrow * 128 + ((lch ^ ((lrow >> 1) & 7)) << 4);
  const int a_rd = (wr * 64 + r15) * 128, b_rd = (wc * 64 + r15) * 128;
  const int swz = r15 >> 1;
  for (int lt = slot; lt < ntl; lt += nslots) {
    const int grp = lt / (8 * NT), within = lt % (8 * NT);
    const int nt = within >> 3, mt = xcd * mt_per_xcd + grp * 8 + (within & 7);
    const half_t* Ag = A + (size_t)(mt * 128 + lrow) * lda + lch * 8;
    const half_t* Bg = Bt + (size_t)(nt * 128 + lrow) * K + lch * 8;
    f32x4 acc[4][4];
#pragma unroll
    for (int m = 0; m < 4; ++m)
#pragma unroll
      for (int n = 0; n < 4; ++n) acc[m][n] = (f32x4){0.f, 0.f, 0.f, 0.f};
    uint4 ra0, ra1, ra2, ra3, rb0, rb1, rb2, rb3;
#define GLOAD(KOFF) \
    ra0 = *(const uint4*)(Ag + (KOFF)); ra1 = *(const uint4*)(Ag + (size_t)32 * lda + (KOFF)); \
    ra2 = *(const uint4*)(Ag + (size_t)64 * lda + (KOFF)); ra3 = *(const uint4*)(Ag + (size_t)96 * lda + (KOFF)); \
    rb0 = *(const uint4*)(Bg + (KOFF)); rb1 = *(const uint4*)(Bg + (size_t)32 * K + (KOFF)); \
    rb2 = *(const uint4*)(Bg + (size_t)64 * K + (KOFF)); rb3 = *(const uint4*)(Bg + (size_t)96 * K + (KOFF));
#define LSTORE(BUF) { char* wb_ = smem + (BUF) * 32768 + wofs; \
    *(uint4*)(wb_) = ra0; *(uint4*)(wb_ + 4096) = ra1; *(uint4*)(wb_ + 8192) = ra2; *(uint4*)(wb_ + 12288) = ra3; \
    *(uint4*)(wb_ + 16384) = rb0; *(uint4*)(wb_ + 20480) = rb1; *(uint4*)(wb_ + 24576) = rb2; *(uint4*)(wb_ + 28672) = rb3; }
    GLOAD(0)
    LSTORE(0)
    __syncthreads();
#pragma unroll 1
    for (int kt = 0; kt < nk; ++kt) {
      const int cur = kt & 1;
      const bool more = kt + 1 < nk;
      if (more) { GLOAD((kt + 1) * 64) }
      const char* cA = smem + cur * 32768 + a_rd;
      const char* cB = smem + cur * 32768 + 16384 + b_rd;
#pragma unroll
      for (int s = 0; s < 2; ++s) {
        half8 af[4], bf[4];
        const int co = ((4 * s + q) ^ swz) << 4;
#pragma unroll
        for (int m = 0; m < 4; ++m) af[m] = *(const half8*)(cA + m * 2048 + co);
#pragma unroll
        for (int n = 0; n < 4; ++n) bf[n] = *(const half8*)(cB + n * 2048 + co);
#pragma unroll
        for (int m = 0; m < 4; ++m)
#pragma unroll
          for (int n = 0; n < 4; ++n) acc[m][n] = __builtin_amdgcn_mfma_f32_16x16x32_f16(bf[n], af[m], acc[m][n], 0, 0, 0);
      }
      if (more) LSTORE(cur ^ 1)
      __syncthreads();
    }
#undef GLOAD
#undef LSTORE
    epi(acc, mt * 128 + wr * 64, nt * 128 + wc * 64, lane);
  }
}

__device__ void ph_bcum(const Params& P, float* sm) {
  float(*glr)[16] = (float(*)[16])sm;
  const int tid = threadIdx.x;
  for (int item = blockIdx.x; item < T_TOK / 64; item += gridDim.x) {
    const int t0 = item * 64;
    __syncthreads();
    for (int idx = tid; idx < 64 * 16; idx += NTHREADS) {
      const int i = idx >> 4, r = idx & 15;
      glr[i][r] = (float)P.p[(size_t)(t0 + i) * LD0 + 3072 + r];
    }
    __syncthreads();
    for (int ch = tid; ch < 512; ch += NTHREADS) {
      float w[16];
#pragma unroll
      for (int r = 0; r < 16; ++r) w[r] = P.gla_w_gk_up[r * 512 + ch];
      const float bb = P.gla_b_gk[ch];
      float cum = 0.f;
      for (int i = 0; i < 64; ++i) {
        float u = bb;
#pragma unroll
        for (int r = 0; r < 16; ++r) u += glr[i][r] * w[r];
        cum += logsigmoidf(u) * (1.f / 16.f);
        P.bcum[(size_t)(t0 + i) * 512 + ch] = cum;
      }
    }
  }
}

__device__ void ph_gla(const Params& P, float* sm) {
  float(*qe)[129] = (float(*)[129])sm;
  float(*kb)[129] = (float(*)[129])(sm + 64 * 129);
  float(*vv)[32] = (float(*)[32])(sm + 2 * 64 * 129);
  float(*aa)[65] = (float(*)[65])(sm + 2 * 64 * 129 + 2048);
  float(*S)[32] = (float(*)[32])(sm + 2 * 64 * 129 + 2048 + 64 * 65);
  float* dec = sm + 2 * 64 * 129 + 2048 + 64 * 65 + 4096;
  const int tid = threadIdx.x;
  const float scale = 0.08838834764831845f;
  for (int item = blockIdx.x; item < NBATCH * 4 * 8; item += gridDim.x) {
    const int b = item >> 5, h = (item >> 3) & 3, vs = item & 7;
    __syncthreads();
    for (int idx = tid; idx < 128 * 32; idx += NTHREADS) S[idx >> 5][idx & 31] = 0.f;
    for (int n = 0; n < 64; ++n) {
      const int t0 = b * SEQ + n * 64;
      __syncthreads();
      for (int idx = tid; idx < 64 * 128; idx += NTHREADS) {
        const int i = idx >> 7, d = idx & 127;
        const float bq = P.bcum[(size_t)(t0 + i) * 512 + h * 128 + d];
        const float q = (float)P.p[(size_t)(t0 + i) * LD0 + h * 128 + d];
        const float k = (float)P.p[(size_t)(t0 + i) * LD0 + 512 + h * 128 + d];
        qe[i][d] = q * scale * expf(bq);
        kb[i][d] = k * expf(-bq);
      }
      for (int idx = tid; idx < 64 * 32; idx += NTHREADS) {
        const int i = idx >> 5, c = idx & 31;
        vv[i][c] = (float)P.p[(size_t)(t0 + i) * LD0 + 1024 + h * 256 + vs * 32 + c];
      }
      if (tid < 128) dec[tid] = expf(P.bcum[(size_t)(t0 + 63) * 512 + h * 128 + tid]);
      __syncthreads();
      for (int idx = tid; idx < 64 * 64; idx += NTHREADS) {
        const int i = idx >> 6, j = idx & 63;
        float s = 0.f;
        if (j <= i) { for (int d = 0; d < 128; ++d) s += qe[i][d] * kb[j][d]; }
        aa[i][j] = s;
      }
      __syncthreads();
      {
        const int c = tid & 31, ig = tid >> 5;
        float acc[8];
#pragma unroll
        for (int ii = 0; ii < 8; ++ii) acc[ii] = 0.f;
        for (int j = 0; j < 64; ++j) {
          const float v = vv[j][c];
#pragma unroll
          for (int ii = 0; ii < 8; ++ii) acc[ii] += aa[ig * 8 + ii][j] * v;
        }
        for (int d = 0; d < 128; ++d) {
          const float s = S[d][c];
#pragma unroll
          for (int ii = 0; ii < 8; ++ii) acc[ii] += qe[ig * 8 + ii][d] * s;
        }
#pragma unroll
        for (int ii = 0; ii < 8; ++ii) P.og[(size_t)(t0 + ig * 8 + ii) * DM + h * 256 + vs * 32 + c] = (half_t)acc[ii];
      }
      __syncthreads();
      {
        const int c = tid & 31, dg = tid >> 5;
        float acc[16];
#pragma unroll
        for (int dd = 0; dd < 16; ++dd) acc[dd] = 0.f;
        for (int cc = 0; cc < 64; ++cc) {
          const float v = vv[cc][c];
#pragma unroll
          for (int dd = 0; dd < 16; ++dd) acc[dd] += kb[cc][dg * 16 + dd] * v;
        }
#pragma unroll
        for (int dd = 0; dd < 16; ++dd) { const int d = dg * 16 + dd; S[d][c] = dec[d] * (S[d][c] + acc[dd]); }
      }
    }
  }
}

__device__ void ph_gla_post(const Params& P) {
  const int lane = threadIdx.x & 63, h = threadIdx.x >> 6;
  for (int t = blockIdx.x; t < T_TOK; t += gridDim.x) {
    half4* op = (half4*)(P.og + (size_t)t * DM + h * 256) + lane;
    const half4 hv = *op;
    float v0 = (float)hv[0], v1 = (float)hv[1], v2 = (float)hv[2], v3 = (float)hv[3];
    const float ss = wave_sum(v0 * v0 + v1 * v1 + v2 * v2 + v3 * v3);
    const float r = rsqrtf(ss * (1.f / 256.f) + EPS);
    const float4 hn = ((const float4*)P.gla_head_norm)[lane];
    const half4 z = *((const half4*)(P.p + (size_t)t * LD0 + 2048 + h * 256) + lane);
    half4 o;
    o[0] = (half_t)(v0 * r * hn.x * siluf((float)z[0]));
    o[1] = (half_t)(v1 * r * hn.y * siluf((float)z[1]));
    o[2] = (half_t)(v2 * r * hn.z * siluf((float)z[2]));
    o[3] = (half_t)(v3 * r * hn.w * siluf((float)z[3]));
    *op = o;
  }
}

__device__ void ph_post(const float* base, const half_t* y, const float* g, float* dst, half_t* dsth, float* rstd_out) {
  const int lane = threadIdx.x & 63, w = threadIdx.x >> 6;
  for (int row = blockIdx.x * 4 + w; row < T_TOK; row += gridDim.x * 4) {
    const half4* yr = (const half4*)(y + (size_t)row * DM);
    const float4* br = (const float4*)(base + (size_t)row * DM);
    float4* dr = (float4*)(dst + (size_t)row * DM);
    float4 v[4]; float ss = 0.f;
#pragma unroll
    for (int i = 0; i < 4; ++i) {
      const half4 hv = yr[lane + 64 * i];
      v[i].x = (float)hv[0]; v[i].y = (float)hv[1]; v[i].z = (float)hv[2]; v[i].w = (float)hv[3];
      ss += v[i].x * v[i].x + v[i].y * v[i].y + v[i].z * v[i].z + v[i].w * v[i].w;
    }
    ss = wave_sum(ss);
    const float r = rsqrtf(ss * (1.f / DM) + EPS);
    float s2 = 0.f;
#pragma unroll
    for (int i = 0; i < 4; ++i) {
      const float4 gg = ((const float4*)g)[lane + 64 * i];
      const float4 bb = br[lane + 64 * i];
      float4 o;
      o.x = bb.x + v[i].x * r * gg.x; o.y = bb.y + v[i].y * r * gg.y; o.z = bb.z + v[i].z * r * gg.z; o.w = bb.w + v[i].w * r * gg.w;
      s2 += o.x * o.x + o.y * o.y + o.z * o.z + o.w * o.w;
      dr[lane + 64 * i] = o;
      if (dsth) {
        half4 hv; hv[0] = (half_t)o.x; hv[1] = (half_t)o.y; hv[2] = (half_t)o.z; hv[3] = (half_t)o.w;
        ((half4*)(dsth + (size_t)row * DM))[lane + 64 * i] = hv;
      }
    }
    if (rstd_out) { s2 = wave_sum(s2); if (lane == 0) rstd_out[row] = rsqrtf(s2 * (1.f / DM) + EPS); }
  }
}

__device__ void ph_compress(const Params& P, float* sm) {
  float* blk = sm;
  float* hid = sm + 2048;
  const int tid = threadIdx.x;
  const int nitems = 2 * NBATCH * 4 * NC;
  for (int item = blockIdx.x; item < nitems; item += gridDim.x) {
    const int which = item / (NBATCH * 4 * NC);
    const int rem = item % (NBATCH * 4 * NC);
    const int bg = rem / NC, c = rem % NC;
    const int b = bg >> 2, g = bg & 3;
    const float* pe = which ? P.nsa_pe_v : P.nsa_pe_k;
    const float* w1 = which ? P.cv_w1 : P.ck_w1;
    const float* w2 = which ? P.cv_w2 : P.ck_w2;
    float* dst = which ? P.vcmp : P.kcmp;
    const int col0 = which ? 1280 : 1024;
    __syncthreads();
    for (int idx = tid; idx < 2048; idx += NTHREADS) {
      const int l = idx >> 6, d = idx & 63;
      blk[idx] = (float)P.p[(size_t)(b * SEQ + 16 * c + l) * LD1 + col0 + g * 64 + d] + pe[idx];
    }
    __syncthreads();
    {
      float h = 0.f;
      for (int i = 0; i < 2048; ++i) h += blk[i] * w1[(size_t)i * 256 + tid];
      hid[tid] = siluf(h);
    }
    __syncthreads();
    if (tid < 64) {
      float o = 0.f;
      for (int j = 0; j < 256; ++j) o += hid[j] * w2[j * 64 + tid];
      dst[((size_t)bg * NC + c) * 64 + tid] = o;
    }
  }
}

__device__ __forceinline__ float dot64h(const float* q, const half_t* k) {
  float s = 0.f;
#pragma unroll
  for (int v = 0; v < 8; ++v) {
    const half8 kv = *(const half8*)(k + v * 8);
#pragma unroll
    for (int e = 0; e < 8; ++e) s += q[v * 8 + e] * (float)kv[e];
  }
  return s;
}
__device__ void ph_attn(const Params& P, float* sm) {
  float(*qs)[64] = (float(*)[64])sm;
  float(*pcs)[256] = (float(*)[256])(sm + 256);
  float(*ps)[1024] = (float(*)[1024])(sm + 256 + 1024);
  int* sel = (int*)(sm + 256 + 1024 + 4096);
  const int tid = threadIdx.x, lane = tid & 63, h = tid >> 6;
  const float NEGINF = -INFINITY;
  for (int item = blockIdx.x; item < T_TOK * 4; item += gridDim.x) {
    const int g = item & 3, t = item >> 2;
    const int b = t >> 12, tpos = t & 4095, cur = tpos >> 6;
    const int hd = g * 4 + h;
    const half_t* prow = P.p + (size_t)t * LD1;
    __syncthreads();
    qs[h][lane] = (float)prow[hd * 64 + lane];
    __syncthreads();
    const int nvalid = tpos >= 31 ? min(NC, (tpos - 31) / 16 + 1) : 0;
    const float* kc = P.kcmp + (size_t)(b * 4 + g) * NC * 64;
    const float* vc = P.vcmp + (size_t)(b * 4 + g) * NC * 64;
    float sc[4]; float m = NEGINF;
#pragma unroll
    for (int r = 0; r < 4; ++r) {
      const int c = lane + 64 * r;
      float s = NEGINF;
      if (c < nvalid) { s = 0.f; for (int d = 0; d < 64; ++d) s += qs[h][d] * kc[c * 64 + d]; }
      sc[r] = s; m = fmaxf(m, s);
    }
    m = wave_max(m);
    float l = 0.f;
#pragma unroll
    for (int r = 0; r < 4; ++r) { sc[r] = (lane + 64 * r < nvalid) ? expf(sc[r] - m) : 0.f; l += sc[r]; }
    l = wave_sum(l);
    const float invl = nvalid > 0 ? 1.f / l : 0.f;
#pragma unroll
    for (int r = 0; r < 4; ++r) pcs[h][lane + 64 * r] = sc[r] * invl;
    __syncthreads();
    float oc = 0.f;
    for (int c = 0; c < nvalid; ++c) oc += pcs[h][c] * vc[c * 64 + lane];
    if (h == 0) {
      const int j = lane;
      float imp = 0.f;
#pragma unroll
      for (int cc = -1; cc <= 3; ++cc) {
        const int c = 4 * j + cc;
        if (c >= 0 && c < NC) imp += pcs[0][c] + pcs[1][c] + pcs[2][c] + pcs[3][c];
      }
      const bool forced = (j == 0) || (j == cur) || (j == cur - 1);
      if (forced) imp = 1e9f; else if (j > cur) imp = -1e30f;
      for (int r = 0; r < 16; ++r) {
        float bv = imp; int bi = j;
#pragma unroll
        for (int o = 32; o > 0; o >>= 1) {
          const float ov = __shfl_xor(bv, o); const int oi = __shfl_xor(bi, o);
          if (ov > bv || (ov == bv && oi < bi)) { bv = ov; bi = oi; }
        }
        if (lane == 0) sel[r] = bi;
        if (j == bi) imp = -INFINITY;
      }
    }
    __syncthreads();
    float osel;
    {
      float s16[16]; float mm = NEGINF;
#pragma unroll
      for (int r = 0; r < 16; ++r) {
        const int j = sel[r]; const int key = j * 64 + lane;
        float s = NEGINF;
        if (j <= cur && key <= tpos) s = dot64h(qs[h], P.p + (size_t)(b * SEQ + key) * LD1 + 1536 + g * 64);
        s16[r] = s; mm = fmaxf(mm, s);
      }
      mm = wave_max(mm);
      float ll = 0.f;
#pragma unroll
      for (int r = 0; r < 16; ++r) { const float e = (s16[r] == NEGINF) ? 0.f : expf(s16[r] - mm); s16[r] = e; ll += e; }
      ll = wave_sum(ll);
      const float il = 1.f / ll;
#pragma unroll
      for (int r = 0; r < 16; ++r) ps[h][r * 64 + lane] = s16[r] * il;
      __syncthreads();
      float acc = 0.f;
      for (int r = 0; r < 16; ++r) {
        const int j = sel[r];
        if (j > cur) continue;
        const half_t* vb = P.p + (size_t)(b * SEQ + j * 64) * LD1 + 1792 + g * 64 + lane;
        for (int kk = 0; kk < 64; ++kk) acc += ps[h][r * 64 + kk] * (float)vb[(size_t)kk * LD1];
      }
      osel = acc;
    }
    __syncthreads();
    float owin;
    {
      float s8[8]; float mm = NEGINF;
#pragma unroll
      for (int r = 0; r < 8; ++r) {
        const int wpos = tpos - 511 + lane + 64 * r;
        float s = NEGINF;
        if (wpos >= 0) s = dot64h(qs[h], P.p + (size_t)(b * SEQ + wpos) * LD1 + 2048 + g * 64);
        s8[r] = s; mm = fmaxf(mm, s);
      }
      mm = wave_max(mm);
      float ll = 0.f;
#pragma unroll
      for (int r = 0; r < 8; ++r) { const float e = (s8[r] == NEGINF) ? 0.f : expf(s8[r] - mm); s8[r] = e; ll += e; }
      ll = wave_sum(ll);
      const float il = 1.f / ll;
#pragma unroll
      for (int r = 0; r < 8; ++r) ps[h][r * 64 + lane] = s8[r] * il;
      __syncthreads();
      float acc = 0.f;
      const int w0 = tpos - 511;
      for (int k = (w0 < 0 ? -w0 : 0); k < 512; ++k) {
        acc += ps[h][k] * (float)P.p[(size_t)(b * SEQ + w0 + k) * LD1 + 2304 + g * 64 + lane];
      }
      owin = acc;
    }
    const float g0 = sigmoidf((float)prow[3584 + hd * 3 + 0] + P.nsa_b_gate[hd * 3 + 0]);
    const float g1 = sigmoidf((float)prow[3584 + hd * 3 + 1] + P.nsa_b_gate[hd * 3 + 1]);
    const float g2 = sigmoidf((float)prow[3584 + hd * 3 + 2] + P.nsa_b_gate[hd * 3 + 2]);
    const float z = (float)prow[2560 + hd * 64 + lane];
    P.og[(size_t)t * DM + hd * 64 + lane] = (half_t)((g0 * oc + g1 * osel + g2 * owin) * siluf(z));
  }
}

constexpr int NPHASES = 12;
__device__ __forceinline__ void run_phase(int ph, const Params& P, char* smem) {
  float* sm = (float*)smem;
  switch (ph) {
    case 0:
      ph_xh_rstd(P.x, P.xh, P.rstd); ph_ropetab(P);
      prep_wT(P.gla_w_in, GLA_IN, P.pre_norm, P.W0t, LD0, DM, 0, sm);
      prep_wT(P.gla_w_out, DM, nullptr, P.Wo0t, DM, DM, 2, sm);
      prep_wT(P.nsa_w_in, NSA_IN, P.pre_norm + DM, P.W1t, LD1, DM, 1, sm);
      prep_wT(P.nsa_w_out, DM, nullptr, P.Wo1t, DM, DM, 2, sm);
      break;
    case 1: gemm_mfma(P.xh, DM, P.W0t, T_TOK, LD0, DM, EpiStore{P.p, LD0, P.rstd}, smem); break;
    case 2: ph_bcum(P, sm); break;
    case 3: ph_gla(P, sm); break;
    case 4: ph_gla_post(P); break;
    case 5: gemm_mfma(P.og, DM, P.Wo0t, T_TOK, DM, DM, EpiStore{P.y, DM, nullptr}, smem); break;
    case 6: ph_post(P.x, P.y, P.post_norm, P.out, P.xh, P.rstd); break;
    case 7: gemm_mfma(P.xh, DM, P.W1t, T_TOK, LD1, DM, EpiRope{P.p, LD1, P.rstd, P.ropetab}, smem); break;
    case 8: ph_compress(P, sm); break;
    case 9: ph_attn(P, sm); break;
    case 10: gemm_mfma(P.og, DM, P.Wo1t, T_TOK, DM, DM, EpiStore{P.y, DM, nullptr}, smem); break;
    case 11: ph_post(P.out, P.y, P.post_norm + DM, P.out, nullptr, nullptr); break;
  }
}

template <int PH>
__global__ void __launch_bounds__(NTHREADS) k_phase(Params P) {
  __shared__ __attribute__((aligned(16))) char smem[SMEM_BYTES];
  run_phase(PH, P, smem);
}
template <int PH>
static void launch_phases(const Params& P, hipStream_t stream) {
  hipLaunchKernelGGL(k_phase<PH>, dim3(2048), dim3(NTHREADS), 0, stream, P);
  if constexpr (PH + 1 < NPHASES) launch_phases<PH + 1>(P, stream);
}

__global__ void __launch_bounds__(NTHREADS) k_mega(Params P) {
  __shared__ __attribute__((aligned(16))) char smem[SMEM_BYTES];
  cg::grid_group grid = cg::this_grid();
  for (int ph = 0; ph < NPHASES; ++ph) {
    run_phase(ph, P, smem);
    if (ph + 1 < NPHASES) grid.sync();
  }
}

extern "C" void kernel_launch(void* const* d_in, const int* in_sizes, int n_in, void* d_out, int out_size, void* d_ws, size_t ws_size,
                              hipStream_t stream) {
  Params P{};
  P.x = (const float*)d_in[0]; P.pos = (const int*)d_in[1]; P.pre_norm = (const float*)d_in[2]; P.post_norm = (const float*)d_in[3];
  P.gla_w_in = (const float*)d_in[4]; P.gla_w_gk_up = (const float*)d_in[5]; P.gla_b_gk = (const float*)d_in[6];
  P.gla_head_norm = (const float*)d_in[7]; P.gla_w_out = (const float*)d_in[8];
  P.nsa_w_in = (const float*)d_in[9]; P.nsa_b_gate = (const float*)d_in[10]; P.nsa_pe_k = (const float*)d_in[11]; P.nsa_pe_v = (const float*)d_in[12];
  P.ck_w1 = (const float*)d_in[13]; P.ck_w2 = (const float*)d_in[14]; P.cv_w1 = (const float*)d_in[15]; P.cv_w2 = (const float*)d_in[16];
  P.nsa_w_out = (const float*)d_in[17];
  P.out = (float*)d_out;
  char* ws = (char*)d_ws;
  const size_t MB = 1024 * 1024;
  P.W0t = (half_t*)(ws);
  P.Wo0t = (half_t*)(ws + 7 * MB);
  P.W1t = (half_t*)(ws + 9 * MB);
  P.Wo1t = (half_t*)(ws + 17 * MB);
  P.xh = (half_t*)(ws + 24 * MB);
  P.p = (half_t*)(ws + 88 * MB);
  P.y = (half_t*)(ws + 88 * MB);
  P.og = (half_t*)(ws + 320 * MB);
  P.bcum = (float*)(ws + 384 * MB);
  P.rstd = (float*)(ws + 448 * MB);
  P.kcmp = (float*)(ws + 449 * MB);
  P.vcmp = (float*)(ws + 452 * MB);
  P.ropetab = (float*)(ws + 455 * MB);
  if (ws_size < 464 * MB) { fprintf(stderr, "ws too small: %zu\n", ws_size); return; }
#if MEGA
  static int grid_blocks = 0;
  if (!grid_blocks) {
    int dev = 0, cus = 0, per_cu = 0;
    hipGetDevice(&dev);
    hipDeviceGetAttribute(&cus, hipDeviceAttributeMultiprocessorCount, dev);
    hipOccupancyMaxActiveBlocksPerMultiprocessor(&per_cu, k_mega, NTHREADS, 0);
    if (per_cu < 1) per_cu = 1;
    if (per_cu > 2) per_cu = 2;
    grid_blocks = cus * per_cu;
  }
  void* args[] = {&P};
  hipError_t e = hipLaunchCooperativeKernel((void*)k_mega, dim3(grid_blocks), dim3(NTHREADS), args, 0, stream);
  if (e != hipSuccess) fprintf(stderr, "cooperative launch failed: %s (grid %d)\n", hipGetErrorString(e), grid_blocks);
#else
  launch_phases<0>(P, stream);
#endif
}
```

```cpp
#include <hip/hip_runtime.h>
#include <hip/hip_cooperative_groups.h>
#include <cstdio>
#include <cstdint>
namespace cg = cooperative_groups;

typedef _Float16 half_t;
typedef _Float16 half8 __attribute__((ext_vector_type(8)));
typedef _Float16 half4 __attribute__((ext_vector_type(4)));
typedef float f32x4 __attribute__((ext_vector_type(4)));

#ifndef MEGA
#define MEGA 1
#endif

constexpr int T_TOK = 32768, DM = 1024, SEQ = 4096, NBATCH = 8;
constexpr int GLA_IN = 3088, NSA_IN = 3632;
constexpr int LD0 = 3200, LD1 = 3712;
constexpr int NC = 255;
constexpr float EPS = 1e-6f;
constexpr int NTHREADS = 256;
constexpr int SMEM_BYTES = 64 * 1024;

struct Params {
  const float* x; const int* pos; const float* pre_norm; const float* post_norm;
  const float* gla_w_in; const float* gla_w_gk_up; const float* gla_b_gk; const float* gla_head_norm; const float* gla_w_out;
  const float* nsa_w_in; const float* nsa_b_gate; const float* nsa_pe_k; const float* nsa_pe_v;
  const float* ck_w1; const float* ck_w2; const float* cv_w1; const float* cv_w2; const float* nsa_w_out;
  float* out;
  half_t* p; half_t* y; half_t* og; float* bcum; float* rstd; half_t* kcmp; half_t* vcmp; float* ropetab;
  half_t* xh; half_t* W0t; half_t* Wo0t; half_t* W1t; half_t* Wo1t;
  half_t* cw1t; half_t* cw2t; float* cbias; half_t* hid;
};

__device__ __forceinline__ int opaque_tid() { int t = threadIdx.x; asm volatile("" : "+v"(t)); return t; }
__device__ __forceinline__ float wave_sum(float v) {
#pragma unroll
  for (int o = 32; o > 0; o >>= 1) v += __shfl_xor(v, o);
  return v;
}
__device__ __forceinline__ float wave_max(float v) {
#pragma unroll
  for (int o = 32; o > 0; o >>= 1) v = fmaxf(v, __shfl_xor(v, o));
  return v;
}
typedef __attribute__((address_space(3))) void lds_void;
typedef __attribute__((address_space(1))) const void gbl_void;
typedef short s16x4 __attribute__((vector_size(8)));
typedef __attribute__((address_space(3))) s16x4 lds_s16x4;
__device__ __forceinline__ half4 tr_read4(const char* p) {
  const s16x4 v = __builtin_amdgcn_ds_read_tr16_b64_v4i16((lds_s16x4*)(p));
  return __builtin_bit_cast(half4, v);
}
constexpr float LOG2E = 1.4426950408889634f;
__device__ __forceinline__ float siluf(float v) { return v / (1.f + expf(-v)); }
__device__ __forceinline__ float sigmoidf(float v) { return 1.f / (1.f + expf(-v)); }
__device__ __forceinline__ float logsigmoidf(float u) { return fminf(u, 0.f) - log1pf(expf(-fabsf(u))); }

__device__ void ph_xh_rstd(const float* src, half_t* xh, float* rstd) {
  const int tid_ = opaque_tid(); const int lane = tid_ & 63, w = tid_ >> 6;
  for (int row = blockIdx.x * 4 + w; row < T_TOK; row += gridDim.x * 4) {
    const float4* r = (const float4*)(src + (size_t)row * DM);
    half4* xr = (half4*)(xh + (size_t)row * DM);
    float ss = 0.f;
#pragma unroll
    for (int i = 0; i < 4; ++i) {
      const float4 v = r[lane + 64 * i];
      ss += v.x * v.x + v.y * v.y + v.z * v.z + v.w * v.w;
      half4 hv; hv[0] = (half_t)v.x; hv[1] = (half_t)v.y; hv[2] = (half_t)v.z; hv[3] = (half_t)v.w;
      xr[lane + 64 * i] = hv;
    }
    ss = wave_sum(ss);
    if (lane == 0) rstd[row] = rsqrtf(ss * (1.f / DM) + EPS);
  }
}
__device__ void ph_ropetab(const Params& P) {
  for (int idx = blockIdx.x * NTHREADS + opaque_tid(); idx < T_TOK * 32; idx += gridDim.x * NTHREADS) {
    const int t = idx >> 5, i = idx & 31;
    const float inv = powf(10000.f, -(float)(2 * i) / 64.f);
    const float ang = (float)P.pos[t] * inv;
    float s, c; sincosf(ang, &s, &c);
    P.ropetab[t * 64 + i] = c; P.ropetab[t * 64 + 32 + i] = s;
  }
}
__device__ __forceinline__ int orig_col(int n, int mode) {
  if (mode == 0) {
    if (n < 2048) return n;
    if (n < 3072) return n + 16;
    if (n < 3088) return n - 1024;
    return -1;
  } else if (mode == 1) {
    if (n < 2560) return n;
    if (n < 3584) return n + 48;
    if (n < 3632) return n - 1024;
    return -1;
  }
  if (mode == 4) return n < 64 ? n : -1;
  return n;
}
__device__ void prep_wT(const float* W, int ldw, const float* gamma, half_t* Wt, int Npad, int K, int mode, float* sm) {
  float(*tile)[65] = (float(*)[65])sm;
  const int tid = opaque_tid();
  const int ntn = Npad / 64, ntk = K / 64;
  for (int t = blockIdx.x; t < ntn * ntk; t += gridDim.x) {
    const int n0 = (t / ntk) * 64, k0 = (t % ntk) * 64;
    __syncthreads();
#pragma unroll 4
    for (int r = 0; r < 16; ++r) {
      const int idx = tid + r * 256, kk = idx >> 6, nn = idx & 63;
      const int on = orig_col(n0 + nn, mode);
      float v = 0.f;
      if (on >= 0) { v = W[(size_t)(k0 + kk) * ldw + on]; if (gamma) v *= gamma[k0 + kk]; }
      tile[kk][nn] = v;
    }
    __syncthreads();
#pragma unroll 4
    for (int r = 0; r < 16; ++r) {
      const int idx = tid + r * 256, nn = idx >> 6, kk = idx & 63;
      Wt[(size_t)(n0 + nn) * K + k0 + kk] = (half_t)tile[kk][nn];
    }
  }
}

__device__ void prep_cbias(const Params& P) {
  if (blockIdx.x < 2) {
    const int which = blockIdx.x, j = opaque_tid();
    const float* pe = which ? P.nsa_pe_v : P.nsa_pe_k;
    const float* w1 = which ? P.cv_w1 : P.ck_w1;
    float a = 0.f;
    for (int k = 0; k < 2048; ++k) a += pe[k] * w1[(size_t)k * 256 + j];
    P.cbias[which * 256 + j] = a;
  }
}

struct EpiStore {
  half_t* C; int ldc; const float* rowscale;
  __device__ __forceinline__ void operator()(const f32x4 (&acc)[4][4], int tok0, int col0, int lane) const {
    const int r15 = lane & 15, q = lane >> 4;
#pragma unroll
    for (int m = 0; m < 4; ++m) {
      const int tok = tok0 + m * 16 + r15;
      const float s = rowscale ? rowscale[tok] : 1.f;
#pragma unroll
      for (int n = 0; n < 4; ++n) {
        const f32x4 v = acc[m][n] * s;
        half4 hv; hv[0] = (half_t)v[0]; hv[1] = (half_t)v[1]; hv[2] = (half_t)v[2]; hv[3] = (half_t)v[3];
        *(half4*)(C + (size_t)tok * ldc + col0 + n * 16 + 4 * q) = hv;
      }
    }
  }
};
struct EpiRope {
  half_t* C; int ldc; const float* rowscale; const float* ropetab;
  __device__ __forceinline__ void operator()(const f32x4 (&acc)[4][4], int tok0, int col0, int lane) const {
    const int r15 = lane & 15, q = lane >> 4;
    const int grp = col0 >> 6;
    const bool is_q = grp < 16;
    const bool roped = is_q || (grp >= 16 && grp < 20) || (grp >= 24 && grp < 28) || (grp >= 32 && grp < 36);
    const float sc = is_q ? 0.125f : 1.f;
#pragma unroll
    for (int m = 0; m < 4; ++m) {
      const int tok = tok0 + m * 16 + r15;
      const float s = rowscale[tok];
      if (roped) {
#pragma unroll
        for (int n = 0; n < 2; ++n) {
          const f32x4 cs = *(const f32x4*)(ropetab + (size_t)tok * 64 + n * 16 + 4 * q);
          const f32x4 sn = *(const f32x4*)(ropetab + (size_t)tok * 64 + 32 + n * 16 + 4 * q);
          const f32x4 x1 = acc[m][n] * s, x2 = acc[m][n + 2] * s;
          const f32x4 o1 = (x1 * cs - x2 * sn) * sc, o2 = (x2 * cs + x1 * sn) * sc;
          half4 h1, h2;
#pragma unroll
          for (int e = 0; e < 4; ++e) { h1[e] = (half_t)o1[e]; h2[e] = (half_t)o2[e]; }
          *(half4*)(C + (size_t)tok * ldc + col0 + n * 16 + 4 * q) = h1;
          *(half4*)(C + (size_t)tok * ldc + col0 + (n + 2) * 16 + 4 * q) = h2;
        }
      } else {
#pragma unroll
        for (int n = 0; n < 4; ++n) {
          const f32x4 v = acc[m][n] * s;
          half4 hv; hv[0] = (half_t)v[0]; hv[1] = (half_t)v[1]; hv[2] = (half_t)v[2]; hv[3] = (half_t)v[3];
          *(half4*)(C + (size_t)tok * ldc + col0 + n * 16 + 4 * q) = hv;
        }
      }
    }
  }
};

struct EpiCmpHid {
  half_t* hid; const float* bias;
  __device__ __forceinline__ void operator()(const f32x4 (&acc)[4][4], int tok0, int col0, int lane) const {
    const int r15 = lane & 15, q = lane >> 4;
    const int which = tok0 >> 13;
#pragma unroll
    for (int n = 0; n < 4; ++n) {
      const f32x4 bv = *(const f32x4*)(bias + which * 256 + col0 + n * 16 + 4 * q);
#pragma unroll
      for (int m = 0; m < 4; ++m) {
        const int row = tok0 + m * 16 + r15;
        const f32x4 v = acc[m][n] + bv;
        half4 hv; hv[0] = (half_t)siluf(v[0]); hv[1] = (half_t)siluf(v[1]); hv[2] = (half_t)siluf(v[2]); hv[3] = (half_t)siluf(v[3]);
        *(half4*)(hid + (size_t)row * 256 + col0 + n * 16 + 4 * q) = hv;
      }
    }
  }
};
struct EpiCmpOut {
  half_t* kcmp; half_t* vcmp;
  __device__ __forceinline__ void operator()(const f32x4 (&acc)[4][4], int tok0, int col0, int lane) const {
    if (col0 >= 64) return;
    const int r15 = lane & 15, q = lane >> 4;
#pragma unroll
    for (int m = 0; m < 4; ++m) {
      const int row = tok0 + m * 16 + r15;
      const int which = row >> 13, r = row & 8191;
      half_t* dst = (which ? vcmp : kcmp) + (size_t)r * 64;
      const bool dead = (r & 255) == 255;
#pragma unroll
      for (int n = 0; n < 4; ++n) {
        const f32x4 v = acc[m][n];
        half4 hv; hv[0] = (half_t)v[0]; hv[1] = (half_t)v[1]; hv[2] = (half_t)v[2]; hv[3] = (half_t)v[3];
        if (dead) hv = (half4){(half_t)0.f, (half_t)0.f, (half_t)0.f, (half_t)0.f};
        *(half4*)(dst + n * 16 + 4 * q) = hv;
      }
    }
  }
};

struct SrcPlain {
  const half_t* A; int lda; const half_t* Bt; int K;
  __device__ __forceinline__ void get(int mt, int nt, const half_t*& Ag, const half_t*& Bg, size_t& a_rs, int& a_ks) const {
    Ag = A + (size_t)mt * 128 * lda; Bg = Bt + (size_t)nt * 128 * K; a_rs = lda; a_ks = 64;
  }
};
struct SrcCmp1 {
  const half_t* p1; const half_t* w1t;
  __device__ __forceinline__ void get(int mt, int nt, const half_t*& Ag, const half_t*& Bg, size_t& a_rs, int& a_ks) const {
    const int which = mt >> 6, m = mt & 63, bg = m >> 1, c0 = (m & 1) * 128, b = bg >> 2, g = bg & 3;
    Ag = p1 + (size_t)(b * SEQ + 16 * c0) * LD1 + (which ? 1280 : 1024) + g * 64;
    Bg = w1t + (size_t)which * 256 * 2048 + (size_t)nt * 128 * 2048; a_rs = (size_t)16 * LD1; a_ks = LD1;
  }
};
struct SrcCmp2 {
  const half_t* hid; const half_t* w2t;
  __device__ __forceinline__ void get(int mt, int nt, const half_t*& Ag, const half_t*& Bg, size_t& a_rs, int& a_ks) const {
    Ag = hid + (size_t)mt * 128 * 256; Bg = w2t + (size_t)(mt >> 6) * 128 * 256; a_rs = 256; a_ks = 64;
  }
};

template <class Src, class Epi>
__device__ void gemm_mfma(const Src& src, int M, int Npad, int K, const Epi& epi, char* smem) {
  const int tid = opaque_tid(), lane = tid & 63, wave = tid >> 6, wr = wave >> 1, wc = wave & 1;
  const int r15 = lane & 15, q = lane >> 4;
  const int NT = Npad / 128, MT = M / 128;
  const int xcd = blockIdx.x & 7, slot = blockIdx.x >> 3, nslots = gridDim.x >> 3;
  const int mt_per_xcd = MT / 8;
  const int ntl = mt_per_xcd * NT;
  const int nk = K / 64;
  const int lrow = tid >> 3, lch = tid & 7;
  const int wofs = lrow * 128 + ((lch ^ ((lrow >> 1) & 7)) << 4);
  const int a_rd = (wr * 64 + r15) * 128, b_rd = (wc * 64 + r15) * 128;
  const int swz = r15 >> 1;
  for (int lt = slot; lt < ntl; lt += nslots) {
    const int grp = lt / (8 * NT), within = lt % (8 * NT);
    const int nt = within >> 3, mt = xcd * mt_per_xcd + grp * 8 + (within & 7);
    const half_t* Ag; const half_t* Bg; size_t lda; int a_ks;
    src.get(mt, nt, Ag, Bg, lda, a_ks);
    Ag += (size_t)lrow * lda + lch * 8;
    Bg += (size_t)lrow * K + lch * 8;
    f32x4 acc[4][4];
#pragma unroll
    for (int m = 0; m < 4; ++m)
#pragma unroll
      for (int n = 0; n < 4; ++n) acc[m][n] = (f32x4){0.f, 0.f, 0.f, 0.f};
    uint4 ra0, ra1, ra2, ra3, rb0, rb1, rb2, rb3;
#define GLOAD(KOFF, BOFF) \
    ra0 = *(const uint4*)(Ag + (KOFF)); ra1 = *(const uint4*)(Ag + (size_t)32 * lda + (KOFF)); \
    ra2 = *(const uint4*)(Ag + (size_t)64 * lda + (KOFF)); ra3 = *(const uint4*)(Ag + (size_t)96 * lda + (KOFF)); \
    rb0 = *(const uint4*)(Bg + (BOFF)); rb1 = *(const uint4*)(Bg + (size_t)32 * K + (BOFF)); \
    rb2 = *(const uint4*)(Bg + (size_t)64 * K + (BOFF)); rb3 = *(const uint4*)(Bg + (size_t)96 * K + (BOFF));
#define LSTORE(BUF) { char* wb_ = smem + (BUF) * 32768 + wofs; \
    *(uint4*)(wb_) = ra0; *(uint4*)(wb_ + 4096) = ra1; *(uint4*)(wb_ + 8192) = ra2; *(uint4*)(wb_ + 12288) = ra3; \
    *(uint4*)(wb_ + 16384) = rb0; *(uint4*)(wb_ + 20480) = rb1; *(uint4*)(wb_ + 24576) = rb2; *(uint4*)(wb_ + 28672) = rb3; }
    GLOAD(0, 0)
    LSTORE(0)
    __syncthreads();
#pragma unroll 1
    for (int kt = 0; kt < nk; ++kt) {
      const int cur = kt & 1;
      const bool more = kt + 1 < nk;
      if (more) { GLOAD((size_t)(kt + 1) * a_ks, (kt + 1) * 64) }
      const char* cA = smem + cur * 32768 + a_rd;
      const char* cB = smem + cur * 32768 + 16384 + b_rd;
#pragma unroll
      for (int s = 0; s < 2; ++s) {
        half8 af[4], bf[4];
        const int co = ((4 * s + q) ^ swz) << 4;
#pragma unroll
        for (int m = 0; m < 4; ++m) af[m] = *(const half8*)(cA + m * 2048 + co);
#pragma unroll
        for (int n = 0; n < 4; ++n) bf[n] = *(const half8*)(cB + n * 2048 + co);
#pragma unroll
        for (int m = 0; m < 4; ++m)
#pragma unroll
          for (int n = 0; n < 4; ++n) acc[m][n] = __builtin_amdgcn_mfma_f32_16x16x32_f16(bf[n], af[m], acc[m][n], 0, 0, 0);
      }
      if (more) LSTORE(cur ^ 1)
      __syncthreads();
    }
#undef GLOAD
#undef LSTORE
    epi(acc, mt * 128 + wr * 64, nt * 128 + wc * 64, lane);
  }
}

__device__ void ph_bcum(const Params& P, float* sm) {
  float(*glr)[16] = (float(*)[16])sm;
  const int tid = opaque_tid();
  for (int item = blockIdx.x; item < T_TOK / 64; item += gridDim.x) {
    const int t0 = item * 64;
    __syncthreads();
    for (int idx = tid; idx < 64 * 16; idx += NTHREADS) {
      const int i = idx >> 4, r = idx & 15;
      glr[i][r] = (float)P.p[(size_t)(t0 + i) * LD0 + 3072 + r];
    }
    __syncthreads();
    for (int ch = tid; ch < 512; ch += NTHREADS) {
      float w[16];
#pragma unroll
      for (int r = 0; r < 16; ++r) w[r] = P.gla_w_gk_up[r * 512 + ch];
      const float bb = P.gla_b_gk[ch];
      float cum = 0.f;
      for (int i = 0; i < 64; ++i) {
        float u = bb;
#pragma unroll
        for (int r = 0; r < 16; ++r) u += glr[i][r] * w[r];
        cum += logsigmoidf(u) * (1.f / 16.f);
        P.bcum[(size_t)(t0 + i) * 512 + ch] = cum;
      }
    }
  }
}

constexpr int GLA_QE = 0, GLA_KE = 16384, GLA_V = 32768, GLA_DEC = 40960;
__device__ void ph_gla_mfma(const Params& P, char* smem) {
  const int tid = opaque_tid(), lane = tid & 63, wave = tid >> 6, r15 = lane & 15, q = lane >> 4;
  const int tok_l = tid >> 2, dq = tid & 3;
  const int qp = r15 >> 2, pp = lane & 3;
  const float scale = 0.08838834764831845f;
  const int fxv = ((2 * q + (qp >> 1)) & 3) << 1;
  const int v_rd = (4 * q + qp) * 128 + 8 * (pp & 1) + (((2 * wave) ^ fxv) << 4) + ((pp >> 1) << 4);
  const int fk = ((4 * (q & 1) + qp) & 7) << 1;
  const int ke_tr = (4 * q + qp) * 256 + 8 * (pp & 1) + ((pp >> 1) << 4);
  for (int item = blockIdx.x; item < NBATCH * 4 * 4; item += gridDim.x) {
    const int b = item >> 4, h = (item >> 2) & 3, vs = item & 3;
    f32x4 S[8];
#pragma unroll
    for (int df = 0; df < 8; ++df) S[df] = (f32x4){0.f, 0.f, 0.f, 0.f};
    uint4 rq0, rq1, rq2, rq3, rk0, rk1, rk2, rk3, rv0, rv1;
    f32x4 rb0, rb1, rb2, rb3, rb4, rb5, rb6, rb7;
#define G_LOAD(N) { const size_t t_ = (size_t)(b * SEQ + (N) * 64 + tok_l); \
    const half_t* qp_ = P.p + t_ * LD0 + h * 128 + dq * 8; const half_t* kp_ = qp_ + 512; \
    rq0 = *(const uint4*)(qp_); rq1 = *(const uint4*)(qp_ + 32); rq2 = *(const uint4*)(qp_ + 64); rq3 = *(const uint4*)(qp_ + 96); \
    rk0 = *(const uint4*)(kp_); rk1 = *(const uint4*)(kp_ + 32); rk2 = *(const uint4*)(kp_ + 64); rk3 = *(const uint4*)(kp_ + 96); \
    const float* bp_ = P.bcum + t_ * 512 + h * 128 + dq * 8; \
    rb0 = *(const f32x4*)(bp_); rb1 = *(const f32x4*)(bp_ + 4); rb2 = *(const f32x4*)(bp_ + 32); rb3 = *(const f32x4*)(bp_ + 36); \
    rb4 = *(const f32x4*)(bp_ + 64); rb5 = *(const f32x4*)(bp_ + 68); rb6 = *(const f32x4*)(bp_ + 96); rb7 = *(const f32x4*)(bp_ + 100); \
    const half_t* vp_ = P.p + t_ * LD0 + 1024 + h * 256 + vs * 64 + dq * 8; rv0 = *(const uint4*)(vp_); rv1 = *(const uint4*)(vp_ + 32); }
#define G_PREP(I, RQ, RK, RBA, RBB) { const int ci = (I) * 4 + dq; \
    const half8 qh = __builtin_bit_cast(half8, RQ), kh = __builtin_bit_cast(half8, RK); half8 qo, ko; \
    _Pragma("unroll") for (int e = 0; e < 8; ++e) { const float bb = e < 4 ? RBA[e] : RBB[e - 4]; const float ex = exp2f(bb * LOG2E); \
      qo[e] = (half_t)((float)qh[e] * scale * ex); ko[e] = (half_t)((float)kh[e] * __builtin_amdgcn_rcpf(ex)); \
      if (tok_l == 63) ((float*)(smem + GLA_DEC))[ci * 8 + e] = ex; } \
    *(half8*)(smem + GLA_QE + tok_l * 256 + ((ci ^ (tok_l & 15)) << 4)) = qo; \
    *(half8*)(smem + GLA_KE + tok_l * 256 + ((ci ^ ((tok_l & 7) << 1)) << 4)) = ko; }
    G_LOAD(0)
#pragma unroll 1
    for (int n = 0; n < 64; ++n) {
      __syncthreads();
      G_PREP(0, rq0, rk0, rb0, rb1)
      G_PREP(1, rq1, rk1, rb2, rb3)
      G_PREP(2, rq2, rk2, rb4, rb5)
      G_PREP(3, rq3, rk3, rb6, rb7)
      {
        const int vsw = ((tok_l >> 1) & 3) << 1;
        *(uint4*)(smem + GLA_V + tok_l * 128 + (((dq) ^ vsw) << 4)) = rv0;
        *(uint4*)(smem + GLA_V + tok_l * 128 + (((4 + dq) ^ vsw) << 4)) = rv1;
      }
      __syncthreads();
      if (n + 1 < 64) G_LOAD(n + 1)
      f32x4 aT[4][4];
#pragma unroll
      for (int kf = 0; kf < 4; ++kf)
#pragma unroll
        for (int tf = 0; tf < 4; ++tf) aT[kf][tf] = (f32x4){0.f, 0.f, 0.f, 0.f};
#pragma unroll
      for (int ks = 0; ks < 4; ++ks) {
        half8 kef[4], qef[4];
#pragma unroll
        for (int f = 0; f < 4; ++f) {
          kef[f] = *(const half8*)(smem + GLA_KE + (16 * f + r15) * 256 + (((4 * ks + q) ^ ((r15 & 7) << 1)) << 4));
          qef[f] = *(const half8*)(smem + GLA_QE + (16 * f + r15) * 256 + (((4 * ks + q) ^ r15) << 4));
        }
#pragma unroll
        for (int kf = 0; kf < 4; ++kf)
#pragma unroll
          for (int tf = kf; tf < 4; ++tf) aT[kf][tf] = __builtin_amdgcn_mfma_f32_16x16x32_f16(kef[kf], qef[tf], aT[kf][tf], 0, 0, 0);
      }
#pragma unroll
      for (int f = 0; f < 4; ++f)
#pragma unroll
        for (int r = 0; r < 4; ++r) if (4 * q + r > r15) aT[f][f][r] = 0.f;
      half8 vf[2];
#pragma unroll
      for (int ks2 = 0; ks2 < 2; ++ks2) {
        const half4 va = tr_read4(smem + GLA_V + v_rd + ks2 * 4096);
        const half4 vb = tr_read4(smem + GLA_V + v_rd + ks2 * 4096 + 2048);
#pragma unroll
        for (int e = 0; e < 4; ++e) { vf[ks2][e] = va[e]; vf[ks2][4 + e] = vb[e]; }
      }
      f32x4 o[4];
#pragma unroll
      for (int tf = 0; tf < 4; ++tf) o[tf] = (f32x4){0.f, 0.f, 0.f, 0.f};
#pragma unroll
      for (int ks2 = 0; ks2 < 2; ++ks2)
#pragma unroll
        for (int tf = 2 * ks2; tf < 4; ++tf) {
          half8 pk;
#pragma unroll
          for (int r = 0; r < 4; ++r) { pk[r] = (half_t)aT[2 * ks2][tf][r]; pk[4 + r] = (half_t)aT[2 * ks2 + 1][tf][r]; }
          o[tf] = __builtin_amdgcn_mfma_f32_16x16x32_f16(vf[ks2], pk, o[tf], 0, 0, 0);
        }
#pragma unroll
      for (int ks = 0; ks < 4; ++ks) {
        half8 sf;
#pragma unroll
        for (int r = 0; r < 4; ++r) { sf[r] = (half_t)S[2 * ks][r]; sf[4 + r] = (half_t)S[2 * ks + 1][r]; }
#pragma unroll
        for (int tf = 0; tf < 4; ++tf) {
          const int row = 16 * tf + r15;
          const half4 qa = *(const half4*)(smem + GLA_QE + row * 256 + (((4 * ks + (q >> 1)) ^ r15) << 4) + (q & 1) * 8);
          const half4 qb = *(const half4*)(smem + GLA_QE + row * 256 + (((4 * ks + 2 + (q >> 1)) ^ r15) << 4) + (q & 1) * 8);
          half8 qv;
#pragma unroll
          for (int e = 0; e < 4; ++e) { qv[e] = qa[e]; qv[4 + e] = qb[e]; }
          o[tf] = __builtin_amdgcn_mfma_f32_16x16x32_f16(sf, qv, o[tf], 0, 0, 0);
        }
      }
      {
        const size_t t0 = (size_t)(b * SEQ + n * 64);
#pragma unroll
        for (int tf = 0; tf < 4; ++tf) {
          half4 hv; hv[0] = (half_t)o[tf][0]; hv[1] = (half_t)o[tf][1]; hv[2] = (half_t)o[tf][2]; hv[3] = (half_t)o[tf][3];
          *(half4*)(P.og + (t0 + 16 * tf + r15) * DM + h * 256 + vs * 64 + 16 * wave + 4 * q) = hv;
        }
      }
#pragma unroll
      for (int df = 0; df < 8; ++df) {
#pragma unroll
        for (int ks2 = 0; ks2 < 2; ++ks2) {
          const int co = ((2 * df) ^ fk) << 4;
          const half4 ka = tr_read4(smem + GLA_KE + ke_tr + co + ks2 * 8192);
          const half4 kb = tr_read4(smem + GLA_KE + ke_tr + co + ks2 * 8192 + 4096);
          half8 kt;
#pragma unroll
          for (int e = 0; e < 4; ++e) { kt[e] = ka[e]; kt[4 + e] = kb[e]; }
          S[df] = __builtin_amdgcn_mfma_f32_16x16x32_f16(kt, vf[ks2], S[df], 0, 0, 0);
        }
        const f32x4 dc = *(const f32x4*)(smem + GLA_DEC + (16 * df + 4 * q) * 4);
        S[df] *= dc;
      }
    }
#undef G_LOAD
#undef G_PREP
  }
}

__device__ void ph_gla_post(const Params& P) {
  const int tid_ = opaque_tid(); const int lane = tid_ & 63, h = tid_ >> 6;
  for (int t = blockIdx.x; t < T_TOK; t += gridDim.x) {
    half4* op = (half4*)(P.og + (size_t)t * DM + h * 256) + lane;
    const half4 hv = *op;
    float v0 = (float)hv[0], v1 = (float)hv[1], v2 = (float)hv[2], v3 = (float)hv[3];
    const float ss = wave_sum(v0 * v0 + v1 * v1 + v2 * v2 + v3 * v3);
    const float r = rsqrtf(ss * (1.f / 256.f) + EPS);
    const float4 hn = ((const float4*)P.gla_head_norm)[lane];
    const half4 z = *((const half4*)(P.p + (size_t)t * LD0 + 2048 + h * 256) + lane);
    half4 o;
    o[0] = (half_t)(v0 * r * hn.x * siluf((float)z[0]));
    o[1] = (half_t)(v1 * r * hn.y * siluf((float)z[1]));
    o[2] = (half_t)(v2 * r * hn.z * siluf((float)z[2]));
    o[3] = (half_t)(v3 * r * hn.w * siluf((float)z[3]));
    *op = o;
  }
}

__device__ void ph_post(const float* base, const half_t* y, const float* g, float* dst, half_t* dsth, float* rstd_out) {
  const int tid_ = opaque_tid(); const int lane = tid_ & 63, w = tid_ >> 6;
  for (int row = blockIdx.x * 4 + w; row < T_TOK; row += gridDim.x * 4) {
    const half4* yr = (const half4*)(y + (size_t)row * DM);
    const float4* br = (const float4*)(base + (size_t)row * DM);
    float4* dr = (float4*)(dst + (size_t)row * DM);
    float4 v[4]; float ss = 0.f;
#pragma unroll
    for (int i = 0; i < 4; ++i) {
      const half4 hv = yr[lane + 64 * i];
      v[i].x = (float)hv[0]; v[i].y = (float)hv[1]; v[i].z = (float)hv[2]; v[i].w = (float)hv[3];
      ss += v[i].x * v[i].x + v[i].y * v[i].y + v[i].z * v[i].z + v[i].w * v[i].w;
    }
    ss = wave_sum(ss);
    const float r = rsqrtf(ss * (1.f / DM) + EPS);
    float s2 = 0.f;
#pragma unroll
    for (int i = 0; i < 4; ++i) {
      const float4 gg = ((const float4*)g)[lane + 64 * i];
      const float4 bb = br[lane + 64 * i];
      float4 o;
      o.x = bb.x + v[i].x * r * gg.x; o.y = bb.y + v[i].y * r * gg.y; o.z = bb.z + v[i].z * r * gg.z; o.w = bb.w + v[i].w * r * gg.w;
      s2 += o.x * o.x + o.y * o.y + o.z * o.z + o.w * o.w;
      dr[lane + 64 * i] = o;
      if (dsth) {
        half4 hv; hv[0] = (half_t)o.x; hv[1] = (half_t)o.y; hv[2] = (half_t)o.z; hv[3] = (half_t)o.w;
        ((half4*)(dsth + (size_t)row * DM))[lane + 64 * i] = hv;
      }
    }
    if (rstd_out) { s2 = wave_sum(s2); if (lane == 0) rstd_out[row] = rsqrtf(s2 * (1.f / DM) + EPS); }
  }
}

constexpr int ATT_K = 0, ATT_V = 16384, ATT_IMP = 32768, ATT_SELM = 32768 + 64 * 65 * 4;

template <int MODE>
__device__ __forceinline__ void attn_branch(char* smem, const half_t* kbase, const half_t* vbase, int ld, int tile_lo, int tile_hi, int n,
                                            const half8 (&qf)[4][2], float (&m)[4], float (&l)[4], f32x4 (&o)[4][4],
                                            const unsigned long long (&selm)[4]) {
  int tid = threadIdx.x; asm volatile("" : "+v"(tid));
  const int lane = tid & 63, r15 = lane & 15, q = lane >> 4;
  const int lrow = tid >> 3, lch = tid & 7;
  const int k_rd = r15 * 128, kswz = r15 >> 1;
  const int qp = r15 >> 2, pp = lane & 3;
  const int fx = ((2 * q + (qp >> 1)) & 3) << 1;
  const int v_rd = (4 * q + qp) * 128 + 8 * (pp & 1) + ((pp >> 1) << 4);
  unsigned int* impu = (unsigned int*)(smem + ATT_IMP);
  const int ksrc = (lch ^ ((lrow >> 1) & 7)) * 8, vsrc = (lch ^ (((lrow >> 1) & 3) << 1)) * 8;
  const int wbase = (tid >> 6) * 1024;
#define A_GLOAD(TI, BUF) { const half_t* kp_ = kbase + (size_t)((TI) * 64 + lrow) * ld + ksrc; \
    __builtin_amdgcn_global_load_lds((gbl_void*)kp_, (lds_void*)(smem + ATT_K + (BUF) * 8192 + wbase), 16, 0, 0); \
    __builtin_amdgcn_global_load_lds((gbl_void*)(kp_ + (size_t)32 * ld), (lds_void*)(smem + ATT_K + (BUF) * 8192 + 4096 + wbase), 16, 0, 0); \
    if (MODE != 0) { const half_t* vp_ = vbase + (size_t)((TI) * 64 + lrow) * ld + vsrc; \
      __builtin_amdgcn_global_load_lds((gbl_void*)vp_, (lds_void*)(smem + ATT_V + (BUF) * 8192 + wbase), 16, 0, 0); \
      __builtin_amdgcn_global_load_lds((gbl_void*)(vp_ + (size_t)32 * ld), (lds_void*)(smem + ATT_V + (BUF) * 8192 + 4096 + wbase), 16, 0, 0); } }
  A_GLOAD(tile_lo, 0)
  __syncthreads();
#pragma unroll 1
  for (int ti = tile_lo; ti <= tile_hi; ++ti) {
    const int cur = (ti - tile_lo) & 1;
    if (ti < tile_hi) A_GLOAD(ti + 1, cur ^ 1)
    const char* kb = smem + ATT_K + cur * 8192 + k_rd;
    const char* vb = smem + ATT_V + cur * 8192 + v_rd;
    bool need_mask;
    if (MODE <= 1) need_mask = (ti * 64 + 63 > 4 * n - 2);
    else if (MODE == 2) need_mask = true;
    else need_mask = (ti == n) || (ti == n - 8);
#pragma unroll
    for (int tp = 0; tp < 2; ++tp) {
      f32x4 s[4][2];
#pragma unroll
      for (int kf = 0; kf < 4; ++kf)
#pragma unroll
        for (int t2 = 0; t2 < 2; ++t2) s[kf][t2] = (f32x4){0.f, 0.f, 0.f, 0.f};
#pragma unroll
      for (int ks = 0; ks < 2; ++ks) {
        const int co = ((4 * ks + q) ^ kswz) << 4;
#pragma unroll
        for (int kf = 0; kf < 4; ++kf) {
          const half8 kfr = *(const half8*)(kb + kf * 2048 + co);
#pragma unroll
          for (int t2 = 0; t2 < 2; ++t2) s[kf][t2] = __builtin_amdgcn_mfma_f32_16x16x32_f16(kfr, qf[2 * tp + t2][ks], s[kf][t2], 0, 0, 0);
        }
      }
      __builtin_amdgcn_sched_barrier(0);
      if (need_mask) {
#pragma unroll
        for (int t2 = 0; t2 < 2; ++t2) {
          const int tf = 2 * tp + t2;
          const int tok = tf * 16 + r15;
          int lo = 0, hi = 63;
          if (MODE <= 1) { hi = 4 * n + ((tok - 31) >> 4) - ti * 64; }
          else if (MODE == 2) { if (!((selm[tf] >> ti) & 1ull)) hi = -1; else if (ti == n) hi = tok; }
          else { if (ti == n) hi = tok; else lo = tok + 1; }
#pragma unroll
          for (int kf = 0; kf < 4; ++kf)
#pragma unroll
            for (int r = 0; r < 4; ++r) {
              const int kk = kf * 16 + 4 * q + r;
              if (kk < lo || kk > hi) s[kf][t2][r] = -INFINITY;
            }
        }
      }
      half8 pf[2][2];
#pragma unroll
      for (int t2 = 0; t2 < 2; ++t2) {
        const int tf = 2 * tp + t2;
        float mb, scale_p = 1.f;
        if (MODE == 1) {
          mb = m[tf] * LOG2E; scale_p = l[tf];
        } else {
          float tm = s[0][t2][0];
#pragma unroll
          for (int kf = 0; kf < 4; ++kf)
#pragma unroll
            for (int r = 0; r < 4; ++r) tm = fmaxf(tm, s[kf][t2][r]);
          tm = fmaxf(tm, __shfl_xor(tm, 16));
          tm = fmaxf(tm, __shfl_xor(tm, 32));
          const float mn = fmaxf(m[tf], tm);
          const float alpha = exp2f((m[tf] - mn) * LOG2E);
          m[tf] = mn; mb = mn * LOG2E;
          l[tf] *= alpha;
          if (MODE >= 2) {
#pragma unroll
            for (int df = 0; df < 4; ++df) o[df][tf] *= alpha;
          }
        }
        float lsum = 0.f;
#pragma unroll
        for (int kf = 0; kf < 4; ++kf) {
#pragma unroll
          for (int r = 0; r < 4; ++r) {
            float pv = exp2f(fmaf(s[kf][t2][r], LOG2E, -mb));
            if (MODE == 1) pv *= scale_p;
            s[kf][t2][r] = pv; lsum += pv;
          }
        }
        if (MODE != 1) l[tf] += lsum;
        if (MODE == 1) {
          const int tok = tf * 16 + r15;
#pragma unroll
          for (int kf = 0; kf < 4; ++kf) {
            const int j = 16 * ti + 4 * kf + q;
            const unsigned int u0 = (unsigned int)(s[kf][t2][0] * 134217728.f + 0.5f), u1 = (unsigned int)(s[kf][t2][1] * 134217728.f + 0.5f);
            const unsigned int u2 = (unsigned int)(s[kf][t2][2] * 134217728.f + 0.5f), u3 = (unsigned int)(s[kf][t2][3] * 134217728.f + 0.5f);
            if (j < 64) {
              atomicAdd(&impu[tok * 65 + j], u0 + u1 + u2 + u3);
              atomicAdd(&impu[tok * 65 + j + 1], u3);
            }
          }
        }
        if (MODE != 0) {
#pragma unroll
          for (int ks = 0; ks < 2; ++ks) {
            half8 pk;
#pragma unroll
            for (int r = 0; r < 4; ++r) { pk[r] = (half_t)s[2 * ks][t2][r]; pk[4 + r] = (half_t)s[2 * ks + 1][t2][r]; }
            pf[t2][ks] = pk;
          }
        }
      }
      __builtin_amdgcn_sched_barrier(0);
      if (MODE != 0) {
#pragma unroll
        for (int df = 0; df < 4; ++df) {
          const int vo = ((2 * df) ^ fx) << 4;
#pragma unroll
          for (int ks = 0; ks < 2; ++ks) {
            const half4 va = tr_read4(vb + vo + ks * 4096);
            const half4 vb2 = tr_read4(vb + vo + ks * 4096 + 2048);
            half8 vf;
#pragma unroll
            for (int e = 0; e < 4; ++e) { vf[e] = va[e]; vf[4 + e] = vb2[e]; }
#pragma unroll
            for (int t2 = 0; t2 < 2; ++t2) o[df][2 * tp + t2] = __builtin_amdgcn_mfma_f32_16x16x32_f16(vf, pf[t2][ks], o[df][2 * tp + t2], 0, 0, 0);
          }
        }
      }
      __builtin_amdgcn_sched_barrier(0);
    }
    __syncthreads();
  }
#undef A_GLOAD
}

__device__ void ph_attn_mfma(const Params& P, char* smem) {
  const int tid = opaque_tid(), lane = tid & 63, wave = tid >> 6, r15 = lane & 15, q = lane >> 4;
  unsigned int* impu = (unsigned int*)(smem + ATT_IMP);
  unsigned long long* selmask = (unsigned long long*)(smem + ATT_SELM);
  const int G = gridDim.x, nrounds = (2048 + G - 1) / G;
  for (int rd = 0; rd < nrounds; ++rd) {
    const int idx = rd * G + ((rd & 1) ? (G - 1 - (int)blockIdx.x) : (int)blockIdx.x);
    if (idx >= 2048) continue;
    const int n = 63 - (idx >> 5), bg = idx & 31, b = bg >> 2, g = bg & 3;
    const int hd = g * 4 + (opaque_tid() >> 6);
    const int t0 = b * SEQ + n * 64;
    half8 qf[4][2];
#pragma unroll
    for (int tf = 0; tf < 4; ++tf)
#pragma unroll
      for (int ks = 0; ks < 2; ++ks) qf[tf][ks] = *(const half8*)(P.p + (size_t)(t0 + tf * 16 + r15) * LD1 + hd * 64 + 32 * ks + 8 * q);
    { const int tz = opaque_tid(); for (int i = tz; i < 64 * 65; i += NTHREADS) impu[i] = 0u; }
    float m[4], l[4]; f32x4 o[4][4]; unsigned long long selm[4] = {0ull, 0ull, 0ull, 0ull};
#pragma unroll
    for (int tf = 0; tf < 4; ++tf) { m[tf] = -1e30f; l[tf] = 0.f; }
#pragma unroll
    for (int df = 0; df < 4; ++df)
#pragma unroll
      for (int tf = 0; tf < 4; ++tf) o[df][tf] = (f32x4){0.f, 0.f, 0.f, 0.f};
    const half_t* kc = P.kcmp + (size_t)bg * 256 * 64;
    const half_t* vc = P.vcmp + (size_t)bg * 256 * 64;
    const int nct = (4 * n + 2) / 64;
    attn_branch<0>(smem, kc, vc, 64, 0, nct, n, qf, m, l, o, selm);
#pragma unroll
    for (int tf = 0; tf < 4; ++tf) {
      float lt = l[tf];
      lt += __shfl_xor(lt, 16); lt += __shfl_xor(lt, 32);
      l[tf] = lt > 0.f ? 1.f / lt : 0.f;
    }
    attn_branch<1>(smem, kc, vc, 64, 0, nct, n, qf, m, l, o, selm);
    {
      int tbase = t0 + r15; asm volatile("" : "+v"(tbase));
#pragma unroll
      for (int tf = 0; tf < 4; ++tf) {
        const size_t tok = (size_t)(tbase + tf * 16);
        const float gc = sigmoidf((float)P.p[tok * LD1 + 3584 + hd * 3 + 0] + P.nsa_b_gate[hd * 3 + 0]);
#pragma unroll
        for (int df = 0; df < 4; ++df) {
          const f32x4 v = o[df][tf] * gc;
          half4 hv; hv[0] = (half_t)v[0]; hv[1] = (half_t)v[1]; hv[2] = (half_t)v[2]; hv[3] = (half_t)v[3];
          *(half4*)(P.og + tok * DM + hd * 64 + df * 16 + 4 * q) = hv;
        }
      }
    }
    {
      int tid2 = threadIdx.x; asm volatile("" : "+v"(tid2));
      const int tok = tid2 >> 2, part = tid2 & 3;
      unsigned long long msk;
      if (n + 1 <= 16) {
        msk = (1ull << (n + 1)) - 1ull;
      } else {
        unsigned int bits = 0;
#pragma clang loop unroll(disable) vectorize(disable)
        for (int jj = 0; jj < 16; ++jj) {
          const int j = part * 16 + jj;
          if (j >= 1 && j <= n - 2) {
            const unsigned int v = impu[tok * 65 + j];
            int rank = 0;
#pragma clang loop unroll(disable) vectorize(disable)
            for (int j2 = 1; j2 <= n - 2; ++j2) {
              const unsigned int v2 = impu[tok * 65 + j2];
              rank += (v2 > v || (v2 == v && j2 < j)) ? 1 : 0;
            }
            if (rank < 13) bits |= 1u << jj;
          }
        }
        msk = (unsigned long long)bits << (16 * part);
        msk |= __shfl_xor(msk, 1);
        msk |= __shfl_xor(msk, 2);
        msk |= 1ull | (1ull << n) | (1ull << (n - 1));
      }
      if (part == 0) selmask[tok] = msk;
    }
    __syncthreads();
#pragma unroll
    for (int tf = 0; tf < 4; ++tf) selm[tf] = selmask[tf * 16 + r15];
#pragma unroll
    for (int tf = 0; tf < 4; ++tf) { m[tf] = -1e30f; l[tf] = 0.f; }
#pragma unroll
    for (int df = 0; df < 4; ++df)
#pragma unroll
      for (int tf = 0; tf < 4; ++tf) o[df][tf] = (f32x4){0.f, 0.f, 0.f, 0.f};
    attn_branch<2>(smem, P.p + (size_t)b * SEQ * LD1 + 1536 + g * 64, P.p + (size_t)b * SEQ * LD1 + 1792 + g * 64, LD1, 0, n, n, qf, m, l, o, selm);
    {
      int tbase = t0 + r15; asm volatile("" : "+v"(tbase));
#pragma unroll
      for (int tf = 0; tf < 4; ++tf) {
        const size_t tok = (size_t)(tbase + tf * 16);
        float lt = l[tf];
        lt += __shfl_xor(lt, 16); lt += __shfl_xor(lt, 32);
        const float gs = sigmoidf((float)P.p[tok * LD1 + 3584 + hd * 3 + 1] + P.nsa_b_gate[hd * 3 + 1]) / lt;
#pragma unroll
        for (int df = 0; df < 4; ++df) {
          half4* dst = (half4*)(P.og + tok * DM + hd * 64 + df * 16 + 4 * q);
          const half4 pv = *dst;
          const f32x4 v = o[df][tf] * gs;
          half4 hv; hv[0] = (half_t)(v[0] + (float)pv[0]); hv[1] = (half_t)(v[1] + (float)pv[1]); hv[2] = (half_t)(v[2] + (float)pv[2]); hv[3] = (half_t)(v[3] + (float)pv[3]);
          *dst = hv;
        }
      }
    }
#pragma unroll
    for (int tf = 0; tf < 4; ++tf) { m[tf] = -1e30f; l[tf] = 0.f; }
#pragma unroll
    for (int df = 0; df < 4; ++df)
#pragma unroll
      for (int tf = 0; tf < 4; ++tf) o[df][tf] = (f32x4){0.f, 0.f, 0.f, 0.f};
    attn_branch<3>(smem, P.p + (size_t)b * SEQ * LD1 + 2048 + g * 64, P.p + (size_t)b * SEQ * LD1 + 2304 + g * 64, LD1, (n > 8 ? n - 8 : 0), n, n, qf, m, l, o, selm);
    {
      int tbase = t0 + r15; asm volatile("" : "+v"(tbase));
#pragma unroll
      for (int tf = 0; tf < 4; ++tf) {
        const size_t tok = (size_t)(tbase + tf * 16);
        float lt = l[tf];
        lt += __shfl_xor(lt, 16); lt += __shfl_xor(lt, 32);
        const float gw = sigmoidf((float)P.p[tok * LD1 + 3584 + hd * 3 + 2] + P.nsa_b_gate[hd * 3 + 2]) / lt;
#pragma unroll
        for (int df = 0; df < 4; ++df) {
          half4* dst = (half4*)(P.og + tok * DM + hd * 64 + df * 16 + 4 * q);
          const half4 pv = *dst;
          const half4 z = *(const half4*)(P.p + tok * LD1 + 2560 + hd * 64 + df * 16 + 4 * q);
          const f32x4 v = o[df][tf] * gw;
          half4 hv;
#pragma unroll
          for (int e = 0; e < 4; ++e) hv[e] = (half_t)((v[e] + (float)pv[e]) * siluf((float)z[e]));
          *dst = hv;
        }
      }
    }
  }
}

constexpr int NPHASES = 13;
__device__ __forceinline__ void run_phase(int ph, const Params& P, char* smem) {
  float* sm = (float*)smem;
  switch (ph) {
    case 0:
      ph_xh_rstd(P.x, P.xh, P.rstd); ph_ropetab(P); prep_cbias(P);
      prep_wT(P.gla_w_in, GLA_IN, P.pre_norm, P.W0t, LD0, DM, 0, sm);
      prep_wT(P.gla_w_out, DM, nullptr, P.Wo0t, DM, DM, 2, sm);
      prep_wT(P.nsa_w_in, NSA_IN, P.pre_norm + DM, P.W1t, LD1, DM, 1, sm);
      prep_wT(P.nsa_w_out, DM, nullptr, P.Wo1t, DM, DM, 2, sm);
      prep_wT(P.ck_w1, 256, nullptr, P.cw1t, 256, 2048, 2, sm);
      prep_wT(P.cv_w1, 256, nullptr, P.cw1t + 256 * 2048, 256, 2048, 2, sm);
      prep_wT(P.ck_w2, 64, nullptr, P.cw2t, 128, 256, 4, sm);
      prep_wT(P.cv_w2, 64, nullptr, P.cw2t + 128 * 256, 128, 256, 4, sm);
      break;
    case 1: gemm_mfma(SrcPlain{P.xh, DM, P.W0t, DM}, T_TOK, LD0, DM, EpiStore{P.p, LD0, P.rstd}, smem); break;
    case 2: ph_bcum(P, sm); break;
    case 3: ph_gla_mfma(P, smem); break;
    case 4: ph_gla_post(P); break;
    case 5: gemm_mfma(SrcPlain{P.og, DM, P.Wo0t, DM}, T_TOK, DM, DM, EpiStore{P.y, DM, nullptr}, smem); break;
    case 6: ph_post(P.x, P.y, P.post_norm, P.out, P.xh, P.rstd); break;
    case 7: gemm_mfma(SrcPlain{P.xh, DM, P.W1t, DM}, T_TOK, LD1, DM, EpiRope{P.p, LD1, P.rstd, P.ropetab}, smem); break;
    case 8: gemm_mfma(SrcCmp1{P.p, P.cw1t}, 16384, 256, 2048, EpiCmpHid{P.hid, P.cbias}, smem); break;
    case 9: gemm_mfma(SrcCmp2{P.hid, P.cw2t}, 16384, 128, 256, EpiCmpOut{P.kcmp, P.vcmp}, smem); break;
    case 10: ph_attn_mfma(P, smem); break;
    case 11: gemm_mfma(SrcPlain{P.og, DM, P.Wo1t, DM}, T_TOK, DM, DM, EpiStore{P.y, DM, nullptr}, smem); break;
    case 12: ph_post(P.out, P.y, P.post_norm + DM, P.out, nullptr, nullptr); break;
  }
}

template <int PH>
__global__ void __launch_bounds__(NTHREADS, 2) k_phase(Params P) {
  __shared__ __attribute__((aligned(16))) char smem[SMEM_BYTES];
  run_phase(PH, P, smem);
}
template <int PH>
static void launch_phases(const Params& P, hipStream_t stream) {
  hipLaunchKernelGGL(k_phase<PH>, dim3(2048), dim3(NTHREADS), 0, stream, P);
  if constexpr (PH + 1 < NPHASES) launch_phases<PH + 1>(P, stream);
}

#if MEGA
__global__ void __launch_bounds__(NTHREADS, 2) k_mega(Params P) {
  __shared__ __attribute__((aligned(16))) char smem[SMEM_BYTES];
  cg::grid_group grid = cg::this_grid();
  run_phase(0, P, smem); grid.sync();
  run_phase(1, P, smem); grid.sync();
  run_phase(2, P, smem); grid.sync();
  run_phase(3, P, smem); grid.sync();
  run_phase(4, P, smem); grid.sync();
  run_phase(5, P, smem); grid.sync();
  run_phase(6, P, smem); grid.sync();
  run_phase(7, P, smem); grid.sync();
  run_phase(8, P, smem); grid.sync();
  run_phase(9, P, smem); grid.sync();
  run_phase(10, P, smem); grid.sync();
  run_phase(11, P, smem); grid.sync();
  run_phase(12, P, smem);
}
#endif

extern "C" void kernel_launch(void* const* d_in, const int* in_sizes, int n_in, void* d_out, int out_size, void* d_ws, size_t ws_size,
                              hipStream_t stream) {
  Params P{};
  P.x = (const float*)d_in[0]; P.pos = (const int*)d_in[1]; P.pre_norm = (const float*)d_in[2]; P.post_norm = (const float*)d_in[3];
  P.gla_w_in = (const float*)d_in[4]; P.gla_w_gk_up = (const float*)d_in[5]; P.gla_b_gk = (const float*)d_in[6];
  P.gla_head_norm = (const float*)d_in[7]; P.gla_w_out = (const float*)d_in[8];
  P.nsa_w_in = (const float*)d_in[9]; P.nsa_b_gate = (const float*)d_in[10]; P.nsa_pe_k = (const float*)d_in[11]; P.nsa_pe_v = (const float*)d_in[12];
  P.ck_w1 = (const float*)d_in[13]; P.ck_w2 = (const float*)d_in[14]; P.cv_w1 = (const float*)d_in[15]; P.cv_w2 = (const float*)d_in[16];
  P.nsa_w_out = (const float*)d_in[17];
  P.out = (float*)d_out;
  char* ws = (char*)d_ws;
  const size_t MB = 1024 * 1024;
  P.W0t = (half_t*)(ws);
  P.Wo0t = (half_t*)(ws + 7 * MB);
  P.W1t = (half_t*)(ws + 9 * MB);
  P.Wo1t = (half_t*)(ws + 17 * MB);
  P.xh = (half_t*)(ws + 24 * MB);
  P.p = (half_t*)(ws + 88 * MB);
  P.y = (half_t*)(ws + 88 * MB);
  P.og = (half_t*)(ws + 320 * MB);
  P.bcum = (float*)(ws + 384 * MB);
  P.rstd = (float*)(ws + 448 * MB);
  P.kcmp = (half_t*)(ws + 449 * MB);
  P.vcmp = (half_t*)(ws + 452 * MB);
  P.ropetab = (float*)(ws + 455 * MB);
  P.cw1t = (half_t*)(ws + 19 * MB);
  P.cw2t = (half_t*)(ws + 21 * MB);
  P.cbias = (float*)(ws + 22 * MB);
  P.hid = (half_t*)(ws + 464 * MB);
  if (ws_size < 473 * MB) { fprintf(stderr, "ws too small: %zu\n", ws_size); return; }
#if MEGA
  static int grid_blocks = 0;
  if (!grid_blocks) {
    int dev = 0, cus = 0, per_cu = 0;
    hipGetDevice(&dev);
    hipDeviceGetAttribute(&cus, hipDeviceAttributeMultiprocessorCount, dev);
    hipOccupancyMaxActiveBlocksPerMultiprocessor(&per_cu, k_mega, NTHREADS, 0);
    if (per_cu < 1) per_cu = 1;
    if (per_cu > 2) per_cu = 2;
    grid_blocks = cus * per_cu;
  }
  void* args[] = {&P};
  hipError_t e = hipLaunchCooperativeKernel((void*)k_mega, dim3(grid_blocks), dim3(NTHREADS), args, 0, stream);
  if (e != hipSuccess) fprintf(stderr, "cooperative launch failed: %s (grid %d)\n", hipGetErrorString(e), grid_blocks);
#else
  launch_phases<0>(P, stream);
#endif
}
```

```cpp
#include <hip/hip_runtime.h>
#include <hip/hip_cooperative_groups.h>
#include <cstdio>
#include <cstdint>
namespace cg = cooperative_groups;

typedef _Float16 half_t;
typedef _Float16 half8 __attribute__((ext_vector_type(8)));
typedef _Float16 half4 __attribute__((ext_vector_type(4)));
typedef float f32x4 __attribute__((ext_vector_type(4)));

#ifndef MEGA
#define MEGA 1
#endif

constexpr int T_TOK = 32768, DM = 1024, SEQ = 4096, NBATCH = 8;
constexpr int GLA_IN = 3088, NSA_IN = 3632;
constexpr int LD0 = 3200, LD1 = 3712;
constexpr int NC = 255;
constexpr float EPS = 1e-6f;
constexpr int NTHREADS = 256;
constexpr int SMEM_BYTES = 64 * 1024;

struct Params {
  const float* x; const int* pos; const float* pre_norm; const float* post_norm;
  const float* gla_w_in; const float* gla_w_gk_up; const float* gla_b_gk; const float* gla_head_norm; const float* gla_w_out;
  const float* nsa_w_in; const float* nsa_b_gate; const float* nsa_pe_k; const float* nsa_pe_v;
  const float* ck_w1; const float* ck_w2; const float* cv_w1; const float* cv_w2; const float* nsa_w_out;
  float* out;
  half_t* p; half_t* y; half_t* og; float* bcum; float* rstd; half_t* kcmp; half_t* vcmp; float* ropetab;
  half_t* xh; half_t* W0t; half_t* Wo0t; half_t* W1t; half_t* Wo1t;
  half_t* cw1t; half_t* cw2t; float* cbias; half_t* hid;
  float* cbias_part; unsigned* bar; long long use_cg_sync;
};

__device__ __forceinline__ int opaque_tid() { int t = threadIdx.x; asm volatile("" : "+v"(t)); return t; }
__device__ __forceinline__ float wave_sum(float v) {
#pragma unroll
  for (int o = 32; o > 0; o >>= 1) v += __shfl_xor(v, o);
  return v;
}
__device__ __forceinline__ float wave_max(float v) {
#pragma unroll
  for (int o = 32; o > 0; o >>= 1) v = fmaxf(v, __shfl_xor(v, o));
  return v;
}
typedef __attribute__((address_space(3))) void lds_void;
typedef __attribute__((address_space(1))) const void gbl_void;
typedef short s16x4 __attribute__((vector_size(8)));
typedef __attribute__((address_space(3))) s16x4 lds_s16x4;
__device__ __forceinline__ half4 tr_read4(const char* p) {
  const s16x4 v = __builtin_amdgcn_ds_read_tr16_b64_v4i16((lds_s16x4*)(p));
  return __builtin_bit_cast(half4, v);
}
constexpr float LOG2E = 1.4426950408889634f;
__device__ __forceinline__ float siluf(float v) { return v / (1.f + expf(-v)); }
__device__ __forceinline__ float sigmoidf(float v) { return 1.f / (1.f + expf(-v)); }
__device__ __forceinline__ float logsigmoidf(float u) { return fminf(u, 0.f) - log1pf(expf(-fabsf(u))); }

__device__ __forceinline__ void fast_barrier(unsigned* bar, unsigned& round) {
  asm volatile("s_waitcnt vmcnt(0) lgkmcnt(0)" ::: "memory");
  __syncthreads();
  round += 1;
  if (threadIdx.x == 0) {
    __builtin_amdgcn_fence(__ATOMIC_RELEASE, "agent");
    asm volatile("s_waitcnt vmcnt(0)" ::: "memory");
    const unsigned ngroups = gridDim.x >> 4;
    const unsigned old = __hip_atomic_fetch_add(bar + 64 + 64 * (blockIdx.x >> 4), 1u, __ATOMIC_RELAXED, __HIP_MEMORY_SCOPE_AGENT);
    if (old + 1 == round * 16u) __hip_atomic_fetch_add(bar, 1u, __ATOMIC_RELAXED, __HIP_MEMORY_SCOPE_AGENT);
    const unsigned target = round * ngroups;
    while (__hip_atomic_load(bar, __ATOMIC_RELAXED, __HIP_MEMORY_SCOPE_AGENT) < target) __builtin_amdgcn_s_sleep(1);
    __builtin_amdgcn_fence(__ATOMIC_ACQUIRE, "agent");
    asm volatile("s_waitcnt vmcnt(0)" ::: "memory");
  }
  __syncthreads();
}

__device__ void ph_xh_rstd(const float* src, half_t* xh, float* rstd) {
  const int tid_ = opaque_tid(); const int lane = tid_ & 63, w = tid_ >> 6;
  for (int row = blockIdx.x * 4 + w; row < T_TOK; row += gridDim.x * 4) {
    const float4* r = (const float4*)(src + (size_t)row * DM);
    half4* xr = (half4*)(xh + (size_t)row * DM);
    float ss = 0.f;
#pragma unroll
    for (int i = 0; i < 4; ++i) {
      const float4 v = r[lane + 64 * i];
      ss += v.x * v.x + v.y * v.y + v.z * v.z + v.w * v.w;
      half4 hv; hv[0] = (half_t)v.x; hv[1] = (half_t)v.y; hv[2] = (half_t)v.z; hv[3] = (half_t)v.w;
      xr[lane + 64 * i] = hv;
    }
    ss = wave_sum(ss);
    if (lane == 0) rstd[row] = rsqrtf(ss * (1.f / DM) + EPS);
  }
}
__device__ void ph_ropetab(const Params& P) {
  for (int idx = blockIdx.x * NTHREADS + opaque_tid(); idx < T_TOK * 32; idx += gridDim.x * NTHREADS) {
    const int t = idx >> 5, i = idx & 31;
    const float inv = powf(10000.f, -(float)(2 * i) / 64.f);
    const float ang = (float)P.pos[t] * inv;
    float s, c; sincosf(ang, &s, &c);
    P.ropetab[t * 64 + i] = c; P.ropetab[t * 64 + 32 + i] = s;
  }
}
__device__ __forceinline__ int orig_col(int n, int mode) {
  if (mode == 0) {
    if (n < 2048) return n;
    if (n < 3072) return n + 16;
    if (n < 3088) return n - 1024;
    return -1;
  } else if (mode == 1) {
    if (n < 2560) return n;
    if (n < 3584) return n + 48;
    if (n < 3632) return n - 1024;
    return -1;
  }
  if (mode == 4) return n < 64 ? n : -1;
  return n;
}
__device__ void prep_wT(const float* W, int ldw, const float* gamma, half_t* Wt, int Npad, int K, int mode, float* sm) {
  float(*tile)[65] = (float(*)[65])sm;
  const int tid = opaque_tid();
  const int ntn = Npad / 64, ntk = K / 64;
  for (int t = blockIdx.x; t < ntn * ntk; t += gridDim.x) {
    const int n0 = (t / ntk) * 64, k0 = (t % ntk) * 64;
    __syncthreads();
#pragma unroll 4
    for (int r = 0; r < 16; ++r) {
      const int idx = tid + r * 256, kk = idx >> 6, nn = idx & 63;
      const int on = orig_col(n0 + nn, mode);
      float v = 0.f;
      if (on >= 0) { v = W[(size_t)(k0 + kk) * ldw + on]; if (gamma) v *= gamma[k0 + kk]; }
      tile[kk][nn] = v;
    }
    __syncthreads();
#pragma unroll 4
    for (int r = 0; r < 16; ++r) {
      const int idx = tid + r * 256, nn = idx >> 6, kk = idx & 63;
      Wt[(size_t)(n0 + nn) * K + k0 + kk] = (half_t)tile[kk][nn];
    }
  }
}

__device__ void prep_cbias_part(const Params& P) {
  for (int idx = blockIdx.x * NTHREADS + opaque_tid(); idx < 2 * 32 * 256; idx += gridDim.x * NTHREADS) {
    const int j = idx & 255, ks = (idx >> 8) & 31, which = idx >> 13;
    const float* pe = which ? P.nsa_pe_v : P.nsa_pe_k;
    const float* w1 = which ? P.cv_w1 : P.ck_w1;
    float a = 0.f;
#pragma unroll 8
    for (int k = ks * 64; k < ks * 64 + 64; ++k) a += pe[k] * w1[(size_t)k * 256 + j];
    P.cbias_part[idx] = a;
  }
}
__device__ void prep_cbias_reduce(const Params& P) {
  if (blockIdx.x < 2) {
    const int which = blockIdx.x, j = opaque_tid();
    float a = 0.f;
    for (int ks = 0; ks < 32; ++ks) a += P.cbias_part[(which * 32 + ks) * 256 + j];
    P.cbias[which * 256 + j] = a;
  }
}

struct EpiStore {
  half_t* C; int ldc; const float* rowscale;
  __device__ __forceinline__ void operator()(const f32x4 (&acc)[4][4], int tok0, int col0, int lane) const {
    const int r15 = lane & 15, q = lane >> 4;
#pragma unroll
    for (int m = 0; m < 4; ++m) {
      const int tok = tok0 + m * 16 + r15;
      const float s = rowscale ? rowscale[tok] : 1.f;
#pragma unroll
      for (int n = 0; n < 4; ++n) {
        const f32x4 v = acc[m][n] * s;
        half4 hv; hv[0] = (half_t)v[0]; hv[1] = (half_t)v[1]; hv[2] = (half_t)v[2]; hv[3] = (half_t)v[3];
        *(half4*)(C + (size_t)tok * ldc + col0 + n * 16 + 4 * q) = hv;
      }
    }
  }
};
struct EpiRope {
  half_t* C; int ldc; const float* rowscale; const float* ropetab;
  __device__ __forceinline__ void operator()(const f32x4 (&acc)[4][4], int tok0, int col0, int lane) const {
    const int r15 = lane & 15, q = lane >> 4;
    const int grp = col0 >> 6;
    const bool is_q = grp < 16;
    const bool roped = is_q || (grp >= 16 && grp < 20) || (grp >= 24 && grp < 28) || (grp >= 32 && grp < 36);
    const float sc = is_q ? 0.125f : 1.f;
#pragma unroll
    for (int m = 0; m < 4; ++m) {
      const int tok = tok0 + m * 16 + r15;
      const float s = rowscale[tok];
      if (roped) {
#pragma unroll
        for (int n = 0; n < 2; ++n) {
          const f32x4 cs = *(const f32x4*)(ropetab + (size_t)tok * 64 + n * 16 + 4 * q);
          const f32x4 sn = *(const f32x4*)(ropetab + (size_t)tok * 64 + 32 + n * 16 + 4 * q);
          const f32x4 x1 = acc[m][n] * s, x2 = acc[m][n + 2] * s;
          const f32x4 o1 = (x1 * cs - x2 * sn) * sc, o2 = (x2 * cs + x1 * sn) * sc;
          half4 h1, h2;
#pragma unroll
          for (int e = 0; e < 4; ++e) { h1[e] = (half_t)o1[e]; h2[e] = (half_t)o2[e]; }
          *(half4*)(C + (size_t)tok * ldc + col0 + n * 16 + 4 * q) = h1;
          *(half4*)(C + (size_t)tok * ldc + col0 + (n + 2) * 16 + 4 * q) = h2;
        }
      } else {
#pragma unroll
        for (int n = 0; n < 4; ++n) {
          const f32x4 v = acc[m][n] * s;
          half4 hv; hv[0] = (half_t)v[0]; hv[1] = (half_t)v[1]; hv[2] = (half_t)v[2]; hv[3] = (half_t)v[3];
          *(half4*)(C + (size_t)tok * ldc + col0 + n * 16 + 4 * q) = hv;
        }
      }
    }
  }
};

struct EpiCmpHid {
  half_t* hid; const float* bias;
  __device__ __forceinline__ void operator()(const f32x4 (&acc)[4][4], int tok0, int col0, int lane) const {
    const int r15 = lane & 15, q = lane >> 4;
    const int which = tok0 >> 13;
#pragma unroll
    for (int n = 0; n < 4; ++n) {
      const f32x4 bv = *(const f32x4*)(bias + which * 256 + col0 + n * 16 + 4 * q);
#pragma unroll
      for (int m = 0; m < 4; ++m) {
        const int row = tok0 + m * 16 + r15;
        const f32x4 v = acc[m][n] + bv;
        half4 hv; hv[0] = (half_t)siluf(v[0]); hv[1] = (half_t)siluf(v[1]); hv[2] = (half_t)siluf(v[2]); hv[3] = (half_t)siluf(v[3]);
        *(half4*)(hid + (size_t)row * 256 + col0 + n * 16 + 4 * q) = hv;
      }
    }
  }
};
struct EpiCmpOut {
  half_t* kcmp; half_t* vcmp;
  __device__ __forceinline__ void operator()(const f32x4 (&acc)[4][4], int tok0, int col0, int lane) const {
    if (col0 >= 64) return;
    const int r15 = lane & 15, q = lane >> 4;
#pragma unroll
    for (int m = 0; m < 4; ++m) {
      const int row = tok0 + m * 16 + r15;
      const int which = row >> 13, r = row & 8191;
      half_t* dst = (which ? vcmp : kcmp) + (size_t)r * 64;
      const bool dead = (r & 255) == 255;
#pragma unroll
      for (int n = 0; n < 4; ++n) {
        const f32x4 v = acc[m][n];
        half4 hv; hv[0] = (half_t)v[0]; hv[1] = (half_t)v[1]; hv[2] = (half_t)v[2]; hv[3] = (half_t)v[3];
        if (dead) hv = (half4){(half_t)0.f, (half_t)0.f, (half_t)0.f, (half_t)0.f};
        *(half4*)(dst + n * 16 + 4 * q) = hv;
      }
    }
  }
};

struct SrcPlain {
  const half_t* A; int lda; const half_t* Bt; int K;
  __device__ __forceinline__ void get(int mt, int nt, const half_t*& Ag, const half_t*& Bg, size_t& a_rs, int& a_ks) const {
    Ag = A + (size_t)mt * 128 * lda; Bg = Bt + (size_t)nt * 128 * K; a_rs = lda; a_ks = 64;
  }
};
struct SrcCmp1 {
  const half_t* p1; const half_t* w1t;
  __device__ __forceinline__ void get(int mt, int nt, const half_t*& Ag, const half_t*& Bg, size_t& a_rs, int& a_ks) const {
    const int which = mt >> 6, m = mt & 63, bg = m >> 1, c0 = (m & 1) * 128, b = bg >> 2, g = bg & 3;
    Ag = p1 + (size_t)(b * SEQ + 16 * c0) * LD1 + (which ? 1280 : 1024) + g * 64;
    Bg = w1t + (size_t)which * 256 * 2048 + (size_t)nt * 128 * 2048; a_rs = (size_t)16 * LD1; a_ks = LD1;
  }
};
struct SrcCmp2 {
  const half_t* hid; const half_t* w2t;
  __device__ __forceinline__ void get(int mt, int nt, const half_t*& Ag, const half_t*& Bg, size_t& a_rs, int& a_ks) const {
    Ag = hid + (size_t)mt * 128 * 256; Bg = w2t + (size_t)(mt >> 6) * 128 * 256; a_rs = 256; a_ks = 64;
  }
};

template <class Src, class Epi>
__device__ void gemm_mfma(const Src& src, int M, int Npad, int K, const Epi& epi, char* smem) {
  const int tid = opaque_tid(), lane = tid & 63, wave = tid >> 6, wr = wave >> 1, wc = wave & 1;
  const int r15 = lane & 15, q = lane >> 4;
  const int NT = Npad / 128, MT = M / 128;
  const int xcd = blockIdx.x & 7, slot = blockIdx.x >> 3, nslots = gridDim.x >> 3;
  const int mt_per_xcd = MT / 8;
  const int ntl = mt_per_xcd * NT;
  const int nk = K / 64;
  const int lrow = tid >> 3, lch = tid & 7;
  const int wofs = lrow * 128 + ((lch ^ ((lrow >> 1) & 7)) << 4);
  const int a_rd = (wr * 64 + r15) * 128, b_rd = (wc * 64 + r15) * 128;
  const int swz = r15 >> 1;
  for (int lt = slot; lt < ntl; lt += nslots) {
    const int grp = lt / (8 * NT), within = lt % (8 * NT);
    const int nt = within >> 3, mt = xcd * mt_per_xcd + grp * 8 + (within & 7);
    const half_t* Ag; const half_t* Bg; size_t lda; int a_ks;
    src.get(mt, nt, Ag, Bg, lda, a_ks);
    Ag += (size_t)lrow * lda + lch * 8;
    Bg += (size_t)lrow * K + lch * 8;
    f32x4 acc[4][4];
#pragma unroll
    for (int m = 0; m < 4; ++m)
#pragma unroll
      for (int n = 0; n < 4; ++n) acc[m][n] = (f32x4){0.f, 0.f, 0.f, 0.f};
    uint4 ra0, ra1, ra2, ra3, rb0, rb1, rb2, rb3;
#define GLOAD(KOFF, BOFF) \
    ra0 = *(const uint4*)(Ag + (KOFF)); ra1 = *(const uint4*)(Ag + (size_t)32 * lda + (KOFF)); \
    ra2 = *(const uint4*)(Ag + (size_t)64 * lda + (KOFF)); ra3 = *(const uint4*)(Ag + (size_t)96 * lda + (KOFF)); \
    rb0 = *(const uint4*)(Bg + (BOFF)); rb1 = *(const uint4*)(Bg + (size_t)32 * K + (BOFF)); \
    rb2 = *(const uint4*)(Bg + (size_t)64 * K + (BOFF)); rb3 = *(const uint4*)(Bg + (size_t)96 * K + (BOFF));
#define LSTORE(BUF) { char* wb_ = smem + (BUF) * 32768 + wofs; \
    *(uint4*)(wb_) = ra0; *(uint4*)(wb_ + 4096) = ra1; *(uint4*)(wb_ + 8192) = ra2; *(uint4*)(wb_ + 12288) = ra3; \
    *(uint4*)(wb_ + 16384) = rb0; *(uint4*)(wb_ + 20480) = rb1; *(uint4*)(wb_ + 24576) = rb2; *(uint4*)(wb_ + 28672) = rb3; }
    GLOAD(0, 0)
    LSTORE(0)
    __syncthreads();
#pragma unroll 1
    for (int kt = 0; kt < nk; ++kt) {
      const int cur = kt & 1;
      const bool more = kt + 1 < nk;
      if (more) { GLOAD((size_t)(kt + 1) * a_ks, (kt + 1) * 64) }
      const char* cA = smem + cur * 32768 + a_rd;
      const char* cB = smem + cur * 32768 + 16384 + b_rd;
#pragma unroll
      for (int s = 0; s < 2; ++s) {
        half8 af[4], bf[4];
        const int co = ((4 * s + q) ^ swz) << 4;
#pragma unroll
        for (int m = 0; m < 4; ++m) af[m] = *(const half8*)(cA + m * 2048 + co);
#pragma unroll
        for (int n = 0; n < 4; ++n) bf[n] = *(const half8*)(cB + n * 2048 + co);
#pragma unroll
        for (int m = 0; m < 4; ++m)
#pragma unroll
          for (int n = 0; n < 4; ++n) acc[m][n] = __builtin_amdgcn_mfma_f32_16x16x32_f16(bf[n], af[m], acc[m][n], 0, 0, 0);
      }
      if (more) LSTORE(cur ^ 1)
      __syncthreads();
    }
#undef GLOAD
#undef LSTORE
    epi(acc, mt * 128 + wr * 64, nt * 128 + wc * 64, lane);
  }
}

__device__ void ph_bcum(const Params& P, float* sm) {
  float(*glr)[16] = (float(*)[16])sm;
  const int tid = opaque_tid();
  for (int item = blockIdx.x; item < T_TOK / 64; item += gridDim.x) {
    const int t0 = item * 64;
    __syncthreads();
    for (int idx = tid; idx < 64 * 16; idx += NTHREADS) {
      const int i = idx >> 4, r = idx & 15;
      glr[i][r] = (float)P.p[(size_t)(t0 + i) * LD0 + 3072 + r];
    }
    __syncthreads();
    for (int ch = tid; ch < 512; ch += NTHREADS) {
      float w[16];
#pragma unroll
      for (int r = 0; r < 16; ++r) w[r] = P.gla_w_gk_up[r * 512 + ch];
      const float bb = P.gla_b_gk[ch];
      float cum = 0.f;
      for (int i = 0; i < 64; ++i) {
        float u = bb;
#pragma unroll
        for (int r = 0; r < 16; ++r) u += glr[i][r] * w[r];
        cum += logsigmoidf(u) * (1.f / 16.f);
        P.bcum[(size_t)(t0 + i) * 512 + ch] = cum;
      }
    }
  }
}

constexpr int GLA_QE = 0, GLA_KE = 16384, GLA_V = 32768, GLA_DEC = 40960;
__device__ void ph_gla_mfma(const Params& P, char* smem) {
  const int tid = opaque_tid(), lane = tid & 63, wave = tid >> 6, r15 = lane & 15, q = lane >> 4;
  const int tok_l = tid >> 2, dq = tid & 3;
  const int qp = r15 >> 2, pp = lane & 3;
  const float scale = 0.08838834764831845f;
  const int fxv = ((2 * q + (qp >> 1)) & 3) << 1;
  const int v_rd = (4 * q + qp) * 128 + 8 * (pp & 1) + (((2 * wave) ^ fxv) << 4) + ((pp >> 1) << 4);
  const int fk = ((4 * (q & 1) + qp) & 7) << 1;
  const int ke_tr = (4 * q + qp) * 256 + 8 * (pp & 1) + ((pp >> 1) << 4);
  for (int item = blockIdx.x; item < NBATCH * 4 * 4; item += gridDim.x) {
    const int b = item >> 4, h = (item >> 2) & 3, vs = item & 3;
    f32x4 S[8];
#pragma unroll
    for (int df = 0; df < 8; ++df) S[df] = (f32x4){0.f, 0.f, 0.f, 0.f};
    uint4 rq0, rq1, rq2, rq3, rk0, rk1, rk2, rk3, rv0, rv1;
    f32x4 rb0, rb1, rb2, rb3, rb4, rb5, rb6, rb7;
#define G_LOAD(N) { const size_t t_ = (size_t)(b * SEQ + (N) * 64 + tok_l); \
    const half_t* qp_ = P.p + t_ * LD0 + h * 128 + dq * 8; const half_t* kp_ = qp_ + 512; \
    rq0 = *(const uint4*)(qp_); rq1 = *(const uint4*)(qp_ + 32); rq2 = *(const uint4*)(qp_ + 64); rq3 = *(const uint4*)(qp_ + 96); \
    rk0 = *(const uint4*)(kp_); rk1 = *(const uint4*)(kp_ + 32); rk2 = *(const uint4*)(kp_ + 64); rk3 = *(const uint4*)(kp_ + 96); \
    const float* bp_ = P.bcum + t_ * 512 + h * 128 + dq * 8; \
    rb0 = *(const f32x4*)(bp_); rb1 = *(const f32x4*)(bp_ + 4); rb2 = *(const f32x4*)(bp_ + 32); rb3 = *(const f32x4*)(bp_ + 36); \
    rb4 = *(const f32x4*)(bp_ + 64); rb5 = *(const f32x4*)(bp_ + 68); rb6 = *(const f32x4*)(bp_ + 96); rb7 = *(const f32x4*)(bp_ + 100); \
    const half_t* vp_ = P.p + t_ * LD0 + 1024 + h * 256 + vs * 64 + dq * 8; rv0 = *(const uint4*)(vp_); rv1 = *(const uint4*)(vp_ + 32); }
#define G_PREP(I, RQ, RK, RBA, RBB) { const int ci = (I) * 4 + dq; \
    const half8 qh = __builtin_bit_cast(half8, RQ), kh = __builtin_bit_cast(half8, RK); half8 qo, ko; \
    _Pragma("unroll") for (int e = 0; e < 8; ++e) { const float bb = e < 4 ? RBA[e] : RBB[e - 4]; const float ex = exp2f(bb * LOG2E); \
      qo[e] = (half_t)((float)qh[e] * scale * ex); ko[e] = (half_t)((float)kh[e] * __builtin_amdgcn_rcpf(ex)); \
      if (tok_l == 63) ((float*)(smem + GLA_DEC))[ci * 8 + e] = ex; } \
    *(half8*)(smem + GLA_QE + tok_l * 256 + ((ci ^ (tok_l & 15)) << 4)) = qo; \
    *(half8*)(smem + GLA_KE + tok_l * 256 + ((ci ^ ((tok_l & 7) << 1)) << 4)) = ko; }
    G_LOAD(0)
#pragma unroll 1
    for (int n = 0; n < 64; ++n) {
      __syncthreads();
      G_PREP(0, rq0, rk0, rb0, rb1)
      G_PREP(1, rq1, rk1, rb2, rb3)
      G_PREP(2, rq2, rk2, rb4, rb5)
      G_PREP(3, rq3, rk3, rb6, rb7)
      {
        const int vsw = ((tok_l >> 1) & 3) << 1;
        *(uint4*)(smem + GLA_V + tok_l * 128 + (((dq) ^ vsw) << 4)) = rv0;
        *(uint4*)(smem + GLA_V + tok_l * 128 + (((4 + dq) ^ vsw) << 4)) = rv1;
      }
      __syncthreads();
      if (n + 1 < 64) G_LOAD(n + 1)
      f32x4 aT[4][4];
#pragma unroll
      for (int kf = 0; kf < 4; ++kf)
#pragma unroll
        for (int tf = 0; tf < 4; ++tf) aT[kf][tf] = (f32x4){0.f, 0.f, 0.f, 0.f};
#pragma unroll
      for (int ks = 0; ks < 4; ++ks) {
        half8 kef[4], qef[4];
#pragma unroll
        for (int f = 0; f < 4; ++f) {
          kef[f] = *(const half8*)(smem + GLA_KE + (16 * f + r15) * 256 + (((4 * ks + q) ^ ((r15 & 7) << 1)) << 4));
          qef[f] = *(const half8*)(smem + GLA_QE + (16 * f + r15) * 256 + (((4 * ks + q) ^ r15) << 4));
        }
#pragma unroll
        for (int kf = 0; kf < 4; ++kf)
#pragma unroll
          for (int tf = kf; tf < 4; ++tf) aT[kf][tf] = __builtin_amdgcn_mfma_f32_16x16x32_f16(kef[kf], qef[tf], aT[kf][tf], 0, 0, 0);
      }
#pragma unroll
      for (int f = 0; f < 4; ++f)
#pragma unroll
        for (int r = 0; r < 4; ++r) if (4 * q + r > r15) aT[f][f][r] = 0.f;
      half8 vf[2];
#pragma unroll
      for (int ks2 = 0; ks2 < 2; ++ks2) {
        const half4 va = tr_read4(smem + GLA_V + v_rd + ks2 * 4096);
        const half4 vb = tr_read4(smem + GLA_V + v_rd + ks2 * 4096 + 2048);
#pragma unroll
        for (int e = 0; e < 4; ++e) { vf[ks2][e] = va[e]; vf[ks2][4 + e] = vb[e]; }
      }
      f32x4 o[4];
#pragma unroll
      for (int tf = 0; tf < 4; ++tf) o[tf] = (f32x4){0.f, 0.f, 0.f, 0.f};
#pragma unroll
      for (int ks2 = 0; ks2 < 2; ++ks2)
#pragma unroll
        for (int tf = 2 * ks2; tf < 4; ++tf) {
          half8 pk;
#pragma unroll
          for (int r = 0; r < 4; ++r) { pk[r] = (half_t)aT[2 * ks2][tf][r]; pk[4 + r] = (half_t)aT[2 * ks2 + 1][tf][r]; }
          o[tf] = __builtin_amdgcn_mfma_f32_16x16x32_f16(vf[ks2], pk, o[tf], 0, 0, 0);
        }
#pragma unroll
      for (int ks = 0; ks < 4; ++ks) {
        half8 sf;
#pragma unroll
        for (int r = 0; r < 4; ++r) { sf[r] = (half_t)S[2 * ks][r]; sf[4 + r] = (half_t)S[2 * ks + 1][r]; }
#pragma unroll
        for (int tf = 0; tf < 4; ++tf) {
          const int row = 16 * tf + r15;
          const half4 qa = *(const half4*)(smem + GLA_QE + row * 256 + (((4 * ks + (q >> 1)) ^ r15) << 4) + (q & 1) * 8);
          const half4 qb = *(const half4*)(smem + GLA_QE + row * 256 + (((4 * ks + 2 + (q >> 1)) ^ r15) << 4) + (q & 1) * 8);
          half8 qv;
#pragma unroll
          for (int e = 0; e < 4; ++e) { qv[e] = qa[e]; qv[4 + e] = qb[e]; }
          o[tf] = __builtin_amdgcn_mfma_f32_16x16x32_f16(sf, qv, o[tf], 0, 0, 0);
        }
      }
      {
        const size_t t0 = (size_t)(b * SEQ + n * 64);
#pragma unroll
        for (int tf = 0; tf < 4; ++tf) {
          half4 hv; hv[0] = (half_t)o[tf][0]; hv[1] = (half_t)o[tf][1]; hv[2] = (half_t)o[tf][2]; hv[3] = (half_t)o[tf][3];
          *(half4*)(P.og + (t0 + 16 * tf + r15) * DM + h * 256 + vs * 64 + 16 * wave + 4 * q) = hv;
        }
      }
#pragma unroll
      for (int df = 0; df < 8; ++df) {
#pragma unroll
        for (int ks2 = 0; ks2 < 2; ++ks2) {
          const int co = ((2 * df) ^ fk) << 4;
          const half4 ka = tr_read4(smem + GLA_KE + ke_tr + co + ks2 * 8192);
          const half4 kb = tr_read4(smem + GLA_KE + ke_tr + co + ks2 * 8192 + 4096);
          half8 kt;
#pragma unroll
          for (int e = 0; e < 4; ++e) { kt[e] = ka[e]; kt[4 + e] = kb[e]; }
          S[df] = __builtin_amdgcn_mfma_f32_16x16x32_f16(kt, vf[ks2], S[df], 0, 0, 0);
        }
        const f32x4 dc = *(const f32x4*)(smem + GLA_DEC + (16 * df + 4 * q) * 4);
        S[df] *= dc;
      }
    }
#undef G_LOAD
#undef G_PREP
  }
}

__device__ void ph_gla_post(const Params& P) {
  const int tid_ = opaque_tid(); const int lane = tid_ & 63, h = tid_ >> 6;
  for (int t = blockIdx.x; t < T_TOK; t += gridDim.x) {
    half4* op = (half4*)(P.og + (size_t)t * DM + h * 256) + lane;
    const half4 hv = *op;
    float v0 = (float)hv[0], v1 = (float)hv[1], v2 = (float)hv[2], v3 = (float)hv[3];
    const float ss = wave_sum(v0 * v0 + v1 * v1 + v2 * v2 + v3 * v3);
    const float r = rsqrtf(ss * (1.f / 256.f) + EPS);
    const float4 hn = ((const float4*)P.gla_head_norm)[lane];
    const half4 z = *((const half4*)(P.p + (size_t)t * LD0 + 2048 + h * 256) + lane);
    half4 o;
    o[0] = (half_t)(v0 * r * hn.x * siluf((float)z[0]));
    o[1] = (half_t)(v1 * r * hn.y * siluf((float)z[1]));
    o[2] = (half_t)(v2 * r * hn.z * siluf((float)z[2]));
    o[3] = (half_t)(v3 * r * hn.w * siluf((float)z[3]));
    *op = o;
  }
}

__device__ void ph_post(const float* base, const half_t* y, const float* g, float* dst, half_t* dsth, float* rstd_out) {
  const int tid_ = opaque_tid(); const int lane = tid_ & 63, w = tid_ >> 6;
  for (int row = blockIdx.x * 4 + w; row < T_TOK; row += gridDim.x * 4) {
    const half4* yr = (const half4*)(y + (size_t)row * DM);
    const float4* br = (const float4*)(base + (size_t)row * DM);
    float4* dr = (float4*)(dst + (size_t)row * DM);
    float4 v[4]; float ss = 0.f;
#pragma unroll
    for (int i = 0; i < 4; ++i) {
      const half4 hv = yr[lane + 64 * i];
      v[i].x = (float)hv[0]; v[i].y = (float)hv[1]; v[i].z = (float)hv[2]; v[i].w = (float)hv[3];
      ss += v[i].x * v[i].x + v[i].y * v[i].y + v[i].z * v[i].z + v[i].w * v[i].w;
    }
    ss = wave_sum(ss);
    const float r = rsqrtf(ss * (1.f / DM) + EPS);
    float s2 = 0.f;
#pragma unroll
    for (int i = 0; i < 4; ++i) {
      const float4 gg = ((const float4*)g)[lane + 64 * i];
      const float4 bb = br[lane + 64 * i];
      float4 o;
      o.x = bb.x + v[i].x * r * gg.x; o.y = bb.y + v[i].y * r * gg.y; o.z = bb.z + v[i].z * r * gg.z; o.w = bb.w + v[i].w * r * gg.w;
      s2 += o.x * o.x + o.y * o.y + o.z * o.z + o.w * o.w;
      dr[lane + 64 * i] = o;
      if (dsth) {
        half4 hv; hv[0] = (half_t)o.x; hv[1] = (half_t)o.y; hv[2] = (half_t)o.z; hv[3] = (half_t)o.w;
        ((half4*)(dsth + (size_t)row * DM))[lane + 64 * i] = hv;
      }
    }
    if (rstd_out) { s2 = wave_sum(s2); if (lane == 0) rstd_out[row] = rsqrtf(s2 * (1.f / DM) + EPS); }
  }
}

constexpr int ATT_K = 0, ATT_V = 16384, ATT_IMP = 32768, ATT_SELM = 32768 + 64 * 65 * 4;

template <int MODE>
__device__ __forceinline__ void attn_branch(char* smem, const half_t* kbase, const half_t* vbase, int ld, int tile_lo, int tile_hi, int n,
                                            const half8 (&qf)[4][2], float (&m)[4], float (&l)[4], f32x4 (&o)[4][4],
                                            const unsigned long long (&selm)[4]) {
  int tid = threadIdx.x; asm volatile("" : "+v"(tid));
  const int lane = tid & 63, r15 = lane & 15, q = lane >> 4;
  const int lrow = tid >> 3, lch = tid & 7;
  const int k_rd = r15 * 128, kswz = r15 >> 1;
  const int qp = r15 >> 2, pp = lane & 3;
  const int fx = ((2 * q + (qp >> 1)) & 3) << 1;
  const int v_rd = (4 * q + qp) * 128 + 8 * (pp & 1) + ((pp >> 1) << 4);
  unsigned int* impu = (unsigned int*)(smem + ATT_IMP);
  const int ksrc = (lch ^ ((lrow >> 1) & 7)) * 8, vsrc = (lch ^ (((lrow >> 1) & 3) << 1)) * 8;
  const int wbase = (tid >> 6) * 1024;
#define A_GLOAD(TI, BUF) { const half_t* kp_ = kbase + (size_t)((TI) * 64 + lrow) * ld + ksrc; \
    __builtin_amdgcn_global_load_lds((gbl_void*)kp_, (lds_void*)(smem + ATT_K + (BUF) * 8192 + wbase), 16, 0, 0); \
    __builtin_amdgcn_global_load_lds((gbl_void*)(kp_ + (size_t)32 * ld), (lds_void*)(smem + ATT_K + (BUF) * 8192 + 4096 + wbase), 16, 0, 0); \
    if (MODE != 0) { const half_t* vp_ = vbase + (size_t)((TI) * 64 + lrow) * ld + vsrc; \
      __builtin_amdgcn_global_load_lds((gbl_void*)vp_, (lds_void*)(smem + ATT_V + (BUF) * 8192 + wbase), 16, 0, 0); \
      __builtin_amdgcn_global_load_lds((gbl_void*)(vp_ + (size_t)32 * ld), (lds_void*)(smem + ATT_V + (BUF) * 8192 + 4096 + wbase), 16, 0, 0); } }
  A_GLOAD(tile_lo, 0)
  __syncthreads();
#pragma unroll 1
  for (int ti = tile_lo; ti <= tile_hi; ++ti) {
    const int cur = (ti - tile_lo) & 1;
    if (ti < tile_hi) A_GLOAD(ti + 1, cur ^ 1)
    const char* kb = smem + ATT_K + cur * 8192 + k_rd;
    const char* vb = smem + ATT_V + cur * 8192 + v_rd;
    bool need_mask;
    if (MODE <= 1) need_mask = (ti * 64 + 63 > 4 * n - 2);
    else if (MODE == 2) need_mask = true;
    else need_mask = (ti == n) || (ti == n - 8);
#pragma unroll
    for (int tp = 0; tp < 2; ++tp) {
      f32x4 s[4][2];
#pragma unroll
      for (int kf = 0; kf < 4; ++kf)
#pragma unroll
        for (int t2 = 0; t2 < 2; ++t2) s[kf][t2] = (f32x4){0.f, 0.f, 0.f, 0.f};
#pragma unroll
      for (int ks = 0; ks < 2; ++ks) {
        const int co = ((4 * ks + q) ^ kswz) << 4;
#pragma unroll
        for (int kf = 0; kf < 4; ++kf) {
          const half8 kfr = *(const half8*)(kb + kf * 2048 + co);
#pragma unroll
          for (int t2 = 0; t2 < 2; ++t2) s[kf][t2] = __builtin_amdgcn_mfma_f32_16x16x32_f16(kfr, qf[2 * tp + t2][ks], s[kf][t2], 0, 0, 0);
        }
      }
      __builtin_amdgcn_sched_barrier(0);
      if (need_mask) {
#pragma unroll
        for (int t2 = 0; t2 < 2; ++t2) {
          const int tf = 2 * tp + t2;
          const int tok = tf * 16 + r15;
          int lo = 0, hi = 63;
          if (MODE <= 1) { hi = 4 * n + ((tok - 31) >> 4) - ti * 64; }
          else if (MODE == 2) { if (!((selm[tf] >> ti) & 1ull)) hi = -1; else if (ti == n) hi = tok; }
          else { if (ti == n) hi = tok; else lo = tok + 1; }
#pragma unroll
          for (int kf = 0; kf < 4; ++kf)
#pragma unroll
            for (int r = 0; r < 4; ++r) {
              const int kk = kf * 16 + 4 * q + r;
              if (kk < lo || kk > hi) s[kf][t2][r] = -INFINITY;
            }
        }
      }
      half8 pf[2][2];
#pragma unroll
      for (int t2 = 0; t2 < 2; ++t2) {
        const int tf = 2 * tp + t2;
        float mb, scale_p = 1.f;
        if (MODE == 1) {
          mb = m[tf] * LOG2E; scale_p = l[tf];
        } else {
          float tm = s[0][t2][0];
#pragma unroll
          for (int kf = 0; kf < 4; ++kf)
#pragma unroll
            for (int r = 0; r < 4; ++r) tm = fmaxf(tm, s[kf][t2][r]);
          tm = fmaxf(tm, __shfl_xor(tm, 16));
          tm = fmaxf(tm, __shfl_xor(tm, 32));
          const float mn = fmaxf(m[tf], tm);
          const float alpha = exp2f((m[tf] - mn) * LOG2E);
          m[tf] = mn; mb = mn * LOG2E;
          l[tf] *= alpha;
          if (MODE >= 2) {
#pragma unroll
            for (int df = 0; df < 4; ++df) o[df][tf] *= alpha;
          }
        }
        float lsum = 0.f;
#pragma unroll
        for (int kf = 0; kf < 4; ++kf) {
#pragma unroll
          for (int r = 0; r < 4; ++r) {
            float pv = exp2f(fmaf(s[kf][t2][r], LOG2E, -mb));
            if (MODE == 1) pv *= scale_p;
            s[kf][t2][r] = pv; lsum += pv;
          }
        }
        if (MODE != 1) l[tf] += lsum;
        if (MODE == 1) {
          const int tok = tf * 16 + r15;
#pragma unroll
          for (int kf = 0; kf < 4; ++kf) {
            const int j = 16 * ti + 4 * kf + q;
            const unsigned int u0 = (unsigned int)(s[kf][t2][0] * 134217728.f + 0.5f), u1 = (unsigned int)(s[kf][t2][1] * 134217728.f + 0.5f);
            const unsigned int u2 = (unsigned int)(s[kf][t2][2] * 134217728.f + 0.5f), u3 = (unsigned int)(s[kf][t2][3] * 134217728.f + 0.5f);
            if (j < 64) {
              atomicAdd(&impu[tok * 65 + j], u0 + u1 + u2 + u3);
              atomicAdd(&impu[tok * 65 + j + 1], u3);
            }
          }
        }
        if (MODE != 0) {
#pragma unroll
          for (int ks = 0; ks < 2; ++ks) {
            half8 pk;
#pragma unroll
            for (int r = 0; r < 4; ++r) { pk[r] = (half_t)s[2 * ks][t2][r]; pk[4 + r] = (half_t)s[2 * ks + 1][t2][r]; }
            pf[t2][ks] = pk;
          }
        }
      }
      __builtin_amdgcn_sched_barrier(0);
      if (MODE != 0) {
#pragma unroll
        for (int df = 0; df < 4; ++df) {
          const int vo = ((2 * df) ^ fx) << 4;
#pragma unroll
          for (int ks = 0; ks < 2; ++ks) {
            const half4 va = tr_read4(vb + vo + ks * 4096);
            const half4 vb2 = tr_read4(vb + vo + ks * 4096 + 2048);
            half8 vf;
#pragma unroll
            for (int e = 0; e < 4; ++e) { vf[e] = va[e]; vf[4 + e] = vb2[e]; }
#pragma unroll
            for (int t2 = 0; t2 < 2; ++t2) o[df][2 * tp + t2] = __builtin_amdgcn_mfma_f32_16x16x32_f16(vf, pf[t2][ks], o[df][2 * tp + t2], 0, 0, 0);
          }
        }
      }
      __builtin_amdgcn_sched_barrier(0);
    }
    __syncthreads();
  }
#undef A_GLOAD
}

__device__ void ph_attn_mfma(const Params& P, char* smem) {
  const int tid = opaque_tid(), lane = tid & 63, wave = tid >> 6, r15 = lane & 15, q = lane >> 4;
  unsigned int* impu = (unsigned int*)(smem + ATT_IMP);
  unsigned long long* selmask = (unsigned long long*)(smem + ATT_SELM);
  const int G = gridDim.x, nrounds = (2048 + G - 1) / G;
  for (int rd = 0; rd < nrounds; ++rd) {
    const int idx = rd * G + ((rd & 1) ? (G - 1 - (int)blockIdx.x) : (int)blockIdx.x);
    if (idx >= 2048) continue;
    const int n = 63 - (idx >> 5), bg = idx & 31, b = bg >> 2, g = bg & 3;
    const int hd = g * 4 + (opaque_tid() >> 6);
    const int t0 = b * SEQ + n * 64;
    half8 qf[4][2];
#pragma unroll
    for (int tf = 0; tf < 4; ++tf)
#pragma unroll
      for (int ks = 0; ks < 2; ++ks) qf[tf][ks] = *(const half8*)(P.p + (size_t)(t0 + tf * 16 + r15) * LD1 + hd * 64 + 32 * ks + 8 * q);
    { const int tz = opaque_tid(); for (int i = tz; i < 64 * 65; i += NTHREADS) impu[i] = 0u; }
    float m[4], l[4]; f32x4 o[4][4]; unsigned long long selm[4] = {0ull, 0ull, 0ull, 0ull};
#pragma unroll
    for (int tf = 0; tf < 4; ++tf) { m[tf] = -1e30f; l[tf] = 0.f; }
#pragma unroll
    for (int df = 0; df < 4; ++df)
#pragma unroll
      for (int tf = 0; tf < 4; ++tf) o[df][tf] = (f32x4){0.f, 0.f, 0.f, 0.f};
    const half_t* kc = P.kcmp + (size_t)bg * 256 * 64;
    const half_t* vc = P.vcmp + (size_t)bg * 256 * 64;
    const int nct = (4 * n + 2) / 64;
    attn_branch<0>(smem, kc, vc, 64, 0, nct, n, qf, m, l, o, selm);
#pragma unroll
    for (int tf = 0; tf < 4; ++tf) {
      float lt = l[tf];
      lt += __shfl_xor(lt, 16); lt += __shfl_xor(lt, 32);
      l[tf] = lt > 0.f ? 1.f / lt : 0.f;
    }
    attn_branch<1>(smem, kc, vc, 64, 0, nct, n, qf, m, l, o, selm);
    {
      int tbase = t0 + r15; asm volatile("" : "+v"(tbase));
#pragma unroll
      for (int tf = 0; tf < 4; ++tf) {
        const size_t tok = (size_t)(tbase + tf * 16);
        const float gc = sigmoidf((float)P.p[tok * LD1 + 3584 + hd * 3 + 0] + P.nsa_b_gate[hd * 3 + 0]);
#pragma unroll
        for (int df = 0; df < 4; ++df) {
          const f32x4 v = o[df][tf] * gc;
          half4 hv; hv[0] = (half_t)v[0]; hv[1] = (half_t)v[1]; hv[2] = (half_t)v[2]; hv[3] = (half_t)v[3];
          *(half4*)(P.og + tok * DM + hd * 64 + df * 16 + 4 * q) = hv;
        }
      }
    }
    {
      int tid2 = threadIdx.x; asm volatile("" : "+v"(tid2));
      const int tok = tid2 >> 2, part = tid2 & 3;
      unsigned long long msk;
      if (n + 1 <= 16) {
        msk = (1ull << (n + 1)) - 1ull;
      } else {
        unsigned int bits = 0;
#pragma clang loop unroll(disable) vectorize(disable)
        for (int jj = 0; jj < 16; ++jj) {
          const int j = part * 16 + jj;
          if (j >= 1 && j <= n - 2) {
            const unsigned int v = impu[tok * 65 + j];
            int rank = 0;
#pragma clang loop unroll(disable) vectorize(disable)
            for (int j2 = 1; j2 <= n - 2; ++j2) {
              const unsigned int v2 = impu[tok * 65 + j2];
              rank += (v2 > v || (v2 == v && j2 < j)) ? 1 : 0;
            }
            if (rank < 13) bits |= 1u << jj;
          }
        }
        msk = (unsigned long long)bits << (16 * part);
        msk |= __shfl_xor(msk, 1);
        msk |= __shfl_xor(msk, 2);
        msk |= 1ull | (1ull << n) | (1ull << (n - 1));
      }
      if (part == 0) selmask[tok] = msk;
    }
    __syncthreads();
#pragma unroll
    for (int tf = 0; tf < 4; ++tf) selm[tf] = selmask[tf * 16 + r15];
#pragma unroll
    for (int tf = 0; tf < 4; ++tf) { m[tf] = -1e30f; l[tf] = 0.f; }
#pragma unroll
    for (int df = 0; df < 4; ++df)
#pragma unroll
      for (int tf = 0; tf < 4; ++tf) o[df][tf] = (f32x4){0.f, 0.f, 0.f, 0.f};
    attn_branch<2>(smem, P.p + (size_t)b * SEQ * LD1 + 1536 + g * 64, P.p + (size_t)b * SEQ * LD1 + 1792 + g * 64, LD1, 0, n, n, qf, m, l, o, selm);
    {
      int tbase = t0 + r15; asm volatile("" : "+v"(tbase));
#pragma unroll
      for (int tf = 0; tf < 4; ++tf) {
        const size_t tok = (size_t)(tbase + tf * 16);
        float lt = l[tf];
        lt += __shfl_xor(lt, 16); lt += __shfl_xor(lt, 32);
        const float gs = sigmoidf((float)P.p[tok * LD1 + 3584 + hd * 3 + 1] + P.nsa_b_gate[hd * 3 + 1]) / lt;
#pragma unroll
        for (int df = 0; df < 4; ++df) {
          half4* dst = (half4*)(P.og + tok * DM + hd * 64 + df * 16 + 4 * q);
          const half4 pv = *dst;
          const f32x4 v = o[df][tf] * gs;
          half4 hv; hv[0] = (half_t)(v[0] + (float)pv[0]); hv[1] = (half_t)(v[1] + (float)pv[1]); hv[2] = (half_t)(v[2] + (float)pv[2]); hv[3] = (half_t)(v[3] + (float)pv[3]);
          *dst = hv;
        }
      }
    }
#pragma unroll
    for (int tf = 0; tf < 4; ++tf) { m[tf] = -1e30f; l[tf] = 0.f; }
#pragma unroll
    for (int df = 0; df < 4; ++df)
#pragma unroll
      for (int tf = 0; tf < 4; ++tf) o[df][tf] = (f32x4){0.f, 0.f, 0.f, 0.f};
    attn_branch<3>(smem, P.p + (size_t)b * SEQ * LD1 + 2048 + g * 64, P.p + (size_t)b * SEQ * LD1 + 2304 + g * 64, LD1, (n > 8 ? n - 8 : 0), n, n, qf, m, l, o, selm);
    {
      int tbase = t0 + r15; asm volatile("" : "+v"(tbase));
#pragma unroll
      for (int tf = 0; tf < 4; ++tf) {
        const size_t tok = (size_t)(tbase + tf * 16);
        float lt = l[tf];
        lt += __shfl_xor(lt, 16); lt += __shfl_xor(lt, 32);
        const float gw = sigmoidf((float)P.p[tok * LD1 + 3584 + hd * 3 + 2] + P.nsa_b_gate[hd * 3 + 2]) / lt;
#pragma unroll
        for (int df = 0; df < 4; ++df) {
          half4* dst = (half4*)(P.og + tok * DM + hd * 64 + df * 16 + 4 * q);
          const half4 pv = *dst;
          const half4 z = *(const half4*)(P.p + tok * LD1 + 2560 + hd * 64 + df * 16 + 4 * q);
          const f32x4 v = o[df][tf] * gw;
          half4 hv;
#pragma unroll
          for (int e = 0; e < 4; ++e) hv[e] = (half_t)((v[e] + (float)pv[e]) * siluf((float)z[e]));
          *dst = hv;
        }
      }
    }
  }
}

constexpr int NPHASES = 13;
__device__ __forceinline__ void run_phase(int ph, const Params& P, char* smem) {
  float* sm = (float*)smem;
  switch (ph) {
    case 0:
      ph_xh_rstd(P.x, P.xh, P.rstd); ph_ropetab(P); prep_cbias_part(P);
      prep_wT(P.gla_w_in, GLA_IN, P.pre_norm, P.W0t, LD0, DM, 0, sm);
      prep_wT(P.gla_w_out, DM, nullptr, P.Wo0t, DM, DM, 2, sm);
      prep_wT(P.nsa_w_in, NSA_IN, P.pre_norm + DM, P.W1t, LD1, DM, 1, sm);
      prep_wT(P.nsa_w_out, DM, nullptr, P.Wo1t, DM, DM, 2, sm);
      prep_wT(P.ck_w1, 256, nullptr, P.cw1t, 256, 2048, 2, sm);
      prep_wT(P.cv_w1, 256, nullptr, P.cw1t + 256 * 2048, 256, 2048, 2, sm);
      prep_wT(P.ck_w2, 64, nullptr, P.cw2t, 128, 256, 4, sm);
      prep_wT(P.cv_w2, 64, nullptr, P.cw2t + 128 * 256, 128, 256, 4, sm);
      break;
    case 1: gemm_mfma(SrcPlain{P.xh, DM, P.W0t, DM}, T_TOK, LD0, DM, EpiStore{P.p, LD0, P.rstd}, smem); break;
    case 2: prep_cbias_reduce(P); ph_bcum(P, sm); break;
    case 3: ph_gla_mfma(P, smem); break;
    case 4: ph_gla_post(P); break;
    case 5: gemm_mfma(SrcPlain{P.og, DM, P.Wo0t, DM}, T_TOK, DM, DM, EpiStore{P.y, DM, nullptr}, smem); break;
    case 6: ph_post(P.x, P.y, P.post_norm, P.out, P.xh, P.rstd); break;
    case 7: gemm_mfma(SrcPlain{P.xh, DM, P.W1t, DM}, T_TOK, LD1, DM, EpiRope{P.p, LD1, P.rstd, P.ropetab}, smem); break;
    case 8: gemm_mfma(SrcCmp1{P.p, P.cw1t}, 16384, 256, 2048, EpiCmpHid{P.hid, P.cbias}, smem); break;
    case 9: gemm_mfma(SrcCmp2{P.hid, P.cw2t}, 16384, 128, 256, EpiCmpOut{P.kcmp, P.vcmp}, smem); break;
    case 10: ph_attn_mfma(P, smem); break;
    case 11: gemm_mfma(SrcPlain{P.og, DM, P.Wo1t, DM}, T_TOK, DM, DM, EpiStore{P.y, DM, nullptr}, smem); break;
    case 12: ph_post(P.out, P.y, P.post_norm + DM, P.out, nullptr, nullptr); break;
  }
}

template <int PH>
__global__ void __launch_bounds__(NTHREADS, 2) k_phase(Params P) {
  __shared__ __attribute__((aligned(16))) char smem[SMEM_BYTES];
  run_phase(PH, P, smem);
}
template <int PH>
static void launch_phases(const Params& P, hipStream_t stream) {
  hipLaunchKernelGGL(k_phase<PH>, dim3(2048), dim3(NTHREADS), 0, stream, P);
  if constexpr (PH + 1 < NPHASES) launch_phases<PH + 1>(P, stream);
}

#if MEGA
__global__ void __launch_bounds__(NTHREADS, 2) k_mega(Params P) {
  __shared__ __attribute__((aligned(16))) char smem[SMEM_BYTES];
  cg::grid_group grid = cg::this_grid();
  if (P.use_cg_sync) grid.sync();
  unsigned bt = 0;
  run_phase(0, P, smem); fast_barrier(P.bar, bt);
  run_phase(1, P, smem); fast_barrier(P.bar, bt);
  run_phase(2, P, smem); fast_barrier(P.bar, bt);
  run_phase(3, P, smem); fast_barrier(P.bar, bt);
  run_phase(4, P, smem); fast_barrier(P.bar, bt);
  run_phase(5, P, smem); fast_barrier(P.bar, bt);
  run_phase(6, P, smem); fast_barrier(P.bar, bt);
  run_phase(7, P, smem); fast_barrier(P.bar, bt);
  run_phase(8, P, smem); fast_barrier(P.bar, bt);
  run_phase(9, P, smem); fast_barrier(P.bar, bt);
  run_phase(10, P, smem); fast_barrier(P.bar, bt);
  run_phase(11, P, smem); fast_barrier(P.bar, bt);
  run_phase(12, P, smem);
}
#endif

extern "C" void kernel_launch(void* const* d_in, const int* in_sizes, int n_in, void* d_out, int out_size, void* d_ws, size_t ws_size,
                              hipStream_t stream) {
  Params P{};
  P.x = (const float*)d_in[0]; P.pos = (const int*)d_in[1]; P.pre_norm = (const float*)d_in[2]; P.post_norm = (const float*)d_in[3];
  P.gla_w_in = (const float*)d_in[4]; P.gla_w_gk_up = (const float*)d_in[5]; P.gla_b_gk = (const float*)d_in[6];
  P.gla_head_norm = (const float*)d_in[7]; P.gla_w_out = (const float*)d_in[8];
  P.nsa_w_in = (const float*)d_in[9]; P.nsa_b_gate = (const float*)d_in[10]; P.nsa_pe_k = (const float*)d_in[11]; P.nsa_pe_v = (const float*)d_in[12];
  P.ck_w1 = (const float*)d_in[13]; P.ck_w2 = (const float*)d_in[14]; P.cv_w1 = (const float*)d_in[15]; P.cv_w2 = (const float*)d_in[16];
  P.nsa_w_out = (const float*)d_in[17];
  P.out = (float*)d_out;
  char* ws = (char*)d_ws;
  const size_t MB = 1024 * 1024;
  P.W0t = (half_t*)(ws);
  P.Wo0t = (half_t*)(ws + 7 * MB);
  P.W1t = (half_t*)(ws + 9 * MB);
  P.Wo1t = (half_t*)(ws + 17 * MB);
  P.xh = (half_t*)(ws + 24 * MB);
  P.p = (half_t*)(ws + 88 * MB);
  P.y = (half_t*)(ws + 88 * MB);
  P.og = (half_t*)(ws + 320 * MB);
  P.bcum = (float*)(ws + 384 * MB);
  P.rstd = (float*)(ws + 448 * MB);
  P.kcmp = (half_t*)(ws + 449 * MB);
  P.vcmp = (half_t*)(ws + 452 * MB);
  P.ropetab = (float*)(ws + 455 * MB);
  P.cw1t = (half_t*)(ws + 19 * MB);
  P.cw2t = (half_t*)(ws + 21 * MB);
  P.cbias = (float*)(ws + 22 * MB);
  P.hid = (half_t*)(ws + 464 * MB);
  P.cbias_part = (float*)(ws + 22 * MB + 4096);
  P.bar = (unsigned*)(ws + 23 * MB);
  P.use_cg_sync = 0;
  if (ws_size < 473 * MB) { fprintf(stderr, "ws too small: %zu\n", ws_size); return; }
#if MEGA
  static int grid_blocks = 0;
  if (!grid_blocks) {
    int dev = 0, cus = 0, per_cu = 0;
    hipGetDevice(&dev);
    hipDeviceGetAttribute(&cus, hipDeviceAttributeMultiprocessorCount, dev);
    hipOccupancyMaxActiveBlocksPerMultiprocessor(&per_cu, k_mega, NTHREADS, 0);
    if (per_cu < 1) per_cu = 1;
    if (per_cu > 2) per_cu = 2;
    grid_blocks = cus * per_cu;
  }
  hipMemsetAsync(ws + 23 * MB, 0, 16384, stream);
  void* args[] = {&P};
  hipError_t e = hipLaunchCooperativeKernel((void*)k_mega, dim3(grid_blocks), dim3(NTHREADS), args, 0, stream);
  if (e != hipSuccess) fprintf(stderr, "cooperative launch failed: %s (grid %d)\n", hipGetErrorString(e), grid_blocks);
#else
  launch_phases<0>(P, stream);
#endif
}
```

```cpp
#include <hip/hip_runtime.h>
#include <hip/hip_cooperative_groups.h>
#include <cstdio>
#include <cstdint>
namespace cg = cooperative_groups;

typedef _Float16 half_t;
typedef _Float16 half8 __attribute__((ext_vector_type(8)));
typedef _Float16 half4 __attribute__((ext_vector_type(4)));
typedef float f32x4 __attribute__((ext_vector_type(4)));
typedef int v2i __attribute__((ext_vector_type(2)));
typedef int v4i __attribute__((ext_vector_type(4)));

#ifndef MEGA
#define MEGA 1
#endif

constexpr int T_TOK = 32768, DM = 1024, SEQ = 4096, NBATCH = 8;
constexpr int GLA_IN = 3088, NSA_IN = 3632;
constexpr int LD0 = 3328, LD1 = 3840;
constexpr int NC = 255;
constexpr float EPS = 1e-6f;
constexpr int NTHREADS = 512, NWAVES = NTHREADS / 64;
constexpr int SMEM_BYTES = 128 * 1024;

struct Params {
  const float* x; const int* pos; const float* pre_norm; const float* post_norm;
  const float* gla_w_in; const float* gla_w_gk_up; const float* gla_b_gk; const float* gla_head_norm; const float* gla_w_out;
  const float* nsa_w_in; const float* nsa_b_gate; const float* nsa_pe_k; const float* nsa_pe_v;
  const float* ck_w1; const float* ck_w2; const float* cv_w1; const float* cv_w2; const float* nsa_w_out;
  float* out;
  half_t* p; half_t* y; half_t* og; float* bcum; float* rstd; half_t* kcmp; half_t* vcmp; float* ropetab;
  half_t* xh; half_t* W0t; half_t* Wo0t; half_t* W1t; half_t* Wo1t;
  half_t* cw1t; half_t* cw2t; float* cbias; half_t* hid;
  float* cbias_part; unsigned* bar; long long use_cg_sync;
};

__device__ __forceinline__ int opaque_tid() { int t = threadIdx.x; asm volatile("" : "+v"(t)); return t; }
__device__ __forceinline__ float wave_sum(float v) {
#pragma unroll
  for (int o = 32; o > 0; o >>= 1) v += __shfl_xor(v, o);
  return v;
}
__device__ __forceinline__ float wave_max(float v) {
#pragma unroll
  for (int o = 32; o > 0; o >>= 1) v = fmaxf(v, __shfl_xor(v, o));
  return v;
}
typedef __attribute__((address_space(3))) void lds_void;
typedef __attribute__((address_space(1))) const void gbl_void;
typedef short s16x4 __attribute__((vector_size(8)));
typedef __attribute__((address_space(3))) s16x4 lds_s16x4;
__device__ __forceinline__ half4 tr_read4(const char* p) {
  const s16x4 v = __builtin_amdgcn_ds_read_tr16_b64_v4i16((lds_s16x4*)(p));
  return __builtin_bit_cast(half4, v);
}
constexpr float LOG2E = 1.4426950408889634f;
__device__ __forceinline__ float fexp2(float x) { return __builtin_amdgcn_exp2f(x); }
__device__ __forceinline__ float siluf(float v) { return v / (1.f + expf(-v)); }
__device__ __forceinline__ float sigmoidf(float v) { return 1.f / (1.f + expf(-v)); }
__device__ __forceinline__ float logsigmoidf(float u) { return fminf(u, 0.f) - log1pf(expf(-fabsf(u))); }

__device__ __forceinline__ void fast_barrier(unsigned* bar, unsigned& round) {
  asm volatile("s_waitcnt vmcnt(0) lgkmcnt(0)" ::: "memory");
  __syncthreads();
  round += 1;
  if (threadIdx.x == 0) {
    __builtin_amdgcn_fence(__ATOMIC_RELEASE, "agent");
    asm volatile("s_waitcnt vmcnt(0)" ::: "memory");
    const unsigned ngroups = gridDim.x >> 4;
    const unsigned old = __hip_atomic_fetch_add(bar + 64 + 64 * (blockIdx.x >> 4), 1u, __ATOMIC_RELAXED, __HIP_MEMORY_SCOPE_AGENT);
    if (old + 1 == round * 16u) __hip_atomic_fetch_add(bar, 1u, __ATOMIC_RELAXED, __HIP_MEMORY_SCOPE_AGENT);
    const unsigned target = round * ngroups;
    while (__hip_atomic_load(bar, __ATOMIC_RELAXED, __HIP_MEMORY_SCOPE_AGENT) < target) __builtin_amdgcn_s_sleep(1);
    __builtin_amdgcn_fence(__ATOMIC_ACQUIRE, "agent");
    asm volatile("s_waitcnt vmcnt(0)" ::: "memory");
  }
  __syncthreads();
}

__device__ void ph_xh_rstd(const float* src, half_t* xh, float* rstd) {
  const int tid_ = opaque_tid(); const int lane = tid_ & 63, w = tid_ >> 6;
  for (int row = blockIdx.x * NWAVES + w; row < T_TOK; row += gridDim.x * NWAVES) {
    const float4* r = (const float4*)(src + (size_t)row * DM);
    half4* xr = (half4*)(xh + (size_t)row * DM);
    float ss = 0.f;
#pragma unroll
    for (int i = 0; i < 4; ++i) {
      const float4 v = r[lane + 64 * i];
      ss += v.x * v.x + v.y * v.y + v.z * v.z + v.w * v.w;
      half4 hv; hv[0] = (half_t)v.x; hv[1] = (half_t)v.y; hv[2] = (half_t)v.z; hv[3] = (half_t)v.w;
      xr[lane + 64 * i] = hv;
    }
    ss = wave_sum(ss);
    if (lane == 0) rstd[row] = rsqrtf(ss * (1.f / DM) + EPS);
  }
}
__device__ void ph_ropetab(const Params& P) {
  for (int idx = blockIdx.x * NTHREADS + opaque_tid(); idx < T_TOK * 32; idx += gridDim.x * NTHREADS) {
    const int t = idx >> 5, i = idx & 31;
    const float inv = powf(10000.f, -(float)(2 * i) / 64.f);
    const float ang = (float)P.pos[t] * inv;
    float s, c; sincosf(ang, &s, &c);
    P.ropetab[t * 64 + i] = c; P.ropetab[t * 64 + 32 + i] = s;
  }
}
__device__ __forceinline__ int orig_col(int n, int mode) {
  if (mode == 0) {
    if (n < 2048) return n;
    if (n < 3072) return n + 16;
    if (n < 3088) return n - 1024;
    return -1;
  } else if (mode == 1) {
    if (n < 2560) return n;
    if (n < 3584) return n + 48;
    if (n < 3632) return n - 1024;
    return -1;
  }
  if (mode == 4) return n < 64 ? n : -1;
  return n;
}
__device__ void prep_wT(const float* W, int ldw, const float* gamma, half_t* Wt, int Npad, int K, int mode, float* sm) {
  float(*tile)[65] = (float(*)[65])sm;
  const int tid = opaque_tid();
  const int ntn = Npad / 64, ntk = K / 64;
  for (int t = blockIdx.x; t < ntn * ntk; t += gridDim.x) {
    const int n0 = (t / ntk) * 64, k0 = (t % ntk) * 64;
    __syncthreads();
#pragma unroll 4
    for (int r = 0; r < 4096 / NTHREADS; ++r) {
      const int idx = tid + r * NTHREADS, kk = idx >> 6, nn = idx & 63;
      const int on = orig_col(n0 + nn, mode);
      float v = 0.f;
      if (on >= 0) { v = W[(size_t)(k0 + kk) * ldw + on]; if (gamma) v *= gamma[k0 + kk]; }
      tile[kk][nn] = v;
    }
    __syncthreads();
#pragma unroll 4
    for (int r = 0; r < 4096 / NTHREADS; ++r) {
      const int idx = tid + r * NTHREADS, nn = idx >> 6, kk = idx & 63;
      Wt[(size_t)(n0 + nn) * K + k0 + kk] = (half_t)tile[kk][nn];
    }
  }
}

__device__ void prep_cbias_part(const Params& P) {
  for (int idx = blockIdx.x * NTHREADS + opaque_tid(); idx < 2 * 32 * 256; idx += gridDim.x * NTHREADS) {
    const int j = idx & 255, ks = (idx >> 8) & 31, which = idx >> 13;
    const float* pe = which ? P.nsa_pe_v : P.nsa_pe_k;
    const float* w1 = which ? P.cv_w1 : P.ck_w1;
    float a = 0.f;
#pragma unroll 8
    for (int k = ks * 64; k < ks * 64 + 64; ++k) a += pe[k] * w1[(size_t)k * 256 + j];
    P.cbias_part[idx] = a;
  }
}
__device__ void prep_cbias_reduce(const Params& P) {
  if (blockIdx.x < 2 && opaque_tid() < 256) {
    const int which = blockIdx.x, j = opaque_tid();
    float a = 0.f;
    for (int ks = 0; ks < 32; ++ks) a += P.cbias_part[(which * 32 + ks) * 256 + j];
    P.cbias[which * 256 + j] = a;
  }
}

struct EpiStore {
  half_t* C; int ldc; const float* rowscale;
  __device__ __forceinline__ void operator()(const f32x4 (&acc)[4][4], int tok0, int col0, int lane) const {
    const int r15 = lane & 15, q = lane >> 4;
#pragma unroll
    for (int m = 0; m < 4; ++m) {
      const int tok = tok0 + m * 16 + r15;
      const float s = rowscale ? rowscale[tok] : 1.f;
#pragma unroll
      for (int n = 0; n < 4; ++n) {
        const f32x4 v = acc[m][n] * s;
        half4 hv; hv[0] = (half_t)v[0]; hv[1] = (half_t)v[1]; hv[2] = (half_t)v[2]; hv[3] = (half_t)v[3];
        *(half4*)(C + (size_t)tok * ldc + col0 + n * 16 + 4 * q) = hv;
      }
    }
  }
};
struct EpiRope {
  half_t* C; int ldc; const float* rowscale; const float* ropetab;
  __device__ __forceinline__ void operator()(const f32x4 (&acc)[4][4], int tok0, int col0, int lane) const {
    const int r15 = lane & 15, q = lane >> 4;
    const int grp = col0 >> 6;
    const bool is_q = grp < 16;
    const bool roped = is_q || (grp >= 16 && grp < 20) || (grp >= 24 && grp < 28) || (grp >= 32 && grp < 36);
    const float sc = is_q ? 0.125f : 1.f;
#pragma unroll
    for (int m = 0; m < 4; ++m) {
      const int tok = tok0 + m * 16 + r15;
      const float s = rowscale[tok];
      if (roped) {
#pragma unroll
        for (int n = 0; n < 2; ++n) {
          const f32x4 cs = *(const f32x4*)(ropetab + (size_t)tok * 64 + n * 16 + 4 * q);
          const f32x4 sn = *(const f32x4*)(ropetab + (size_t)tok * 64 + 32 + n * 16 + 4 * q);
          const f32x4 x1 = acc[m][n] * s, x2 = acc[m][n + 2] * s;
          const f32x4 o1 = (x1 * cs - x2 * sn) * sc, o2 = (x2 * cs + x1 * sn) * sc;
          half4 h1, h2;
#pragma unroll
          for (int e = 0; e < 4; ++e) { h1[e] = (half_t)o1[e]; h2[e] = (half_t)o2[e]; }
          *(half4*)(C + (size_t)tok * ldc + col0 + n * 16 + 4 * q) = h1;
          *(half4*)(C + (size_t)tok * ldc + col0 + (n + 2) * 16 + 4 * q) = h2;
        }
      } else {
#pragma unroll
        for (int n = 0; n < 4; ++n) {
          const f32x4 v = acc[m][n] * s;
          half4 hv; hv[0] = (half_t)v[0]; hv[1] = (half_t)v[1]; hv[2] = (half_t)v[2]; hv[3] = (half_t)v[3];
          *(half4*)(C + (size_t)tok * ldc + col0 + n * 16 + 4 * q) = hv;
        }
      }
    }
  }
};

struct EpiCmpHid {
  half_t* hid; const float* bias;
  __device__ __forceinline__ void operator()(const f32x4 (&acc)[4][4], int tok0, int col0, int lane) const {
    const int r15 = lane & 15, q = lane >> 4;
    const int which = tok0 >> 13;
#pragma unroll
    for (int n = 0; n < 4; ++n) {
      const f32x4 bv = *(const f32x4*)(bias + which * 256 + col0 + n * 16 + 4 * q);
#pragma unroll
      for (int m = 0; m < 4; ++m) {
        const int row = tok0 + m * 16 + r15;
        const f32x4 v = acc[m][n] + bv;
        half4 hv; hv[0] = (half_t)siluf(v[0]); hv[1] = (half_t)siluf(v[1]); hv[2] = (half_t)siluf(v[2]); hv[3] = (half_t)siluf(v[3]);
        *(half4*)(hid + (size_t)row * 256 + col0 + n * 16 + 4 * q) = hv;
      }
    }
  }
};
struct EpiCmpOut {
  half_t* kcmp; half_t* vcmp;
  __device__ __forceinline__ void operator()(const f32x4 (&acc)[4][4], int tok0, int col0, int lane) const {
    if (col0 >= 64) return;
    const int r15 = lane & 15, q = lane >> 4;
#pragma unroll
    for (int m = 0; m < 4; ++m) {
      const int row = tok0 + m * 16 + r15;
      const int which = row >> 13, r = row & 8191;
      half_t* dst = (which ? vcmp : kcmp) + (size_t)r * 64;
      const bool dead = (r & 255) == 255;
#pragma unroll
      for (int n = 0; n < 4; ++n) {
        const f32x4 v = acc[m][n];
        half4 hv; hv[0] = (half_t)v[0]; hv[1] = (half_t)v[1]; hv[2] = (half_t)v[2]; hv[3] = (half_t)v[3];
        if (dead) hv = (half4){(half_t)0.f, (half_t)0.f, (half_t)0.f, (half_t)0.f};
        *(half4*)(dst + n * 16 + 4 * q) = hv;
      }
    }
  }
};

struct SrcPlain {
  const half_t* A; int lda; const half_t* Bt; int K;
  __device__ __forceinline__ void get(int mt, int nt, const half_t*& Ag, const half_t*& Bg, size_t& a_rs, int& a_ks) const {
    Ag = A + (size_t)mt * 128 * lda; Bg = Bt + (size_t)nt * 128 * K; a_rs = lda; a_ks = 64;
  }
};
struct SrcCmp1 {
  const half_t* p1; const half_t* w1t;
  __device__ __forceinline__ void get(int mt, int nt, const half_t*& Ag, const half_t*& Bg, size_t& a_rs, int& a_ks) const {
    const int which = mt >> 6, m = mt & 63, bg = m >> 1, c0 = (m & 1) * 128, b = bg >> 2, g = bg & 3;
    Ag = p1 + (size_t)(b * SEQ + 16 * c0) * LD1 + (which ? 1280 : 1024) + g * 64;
    Bg = w1t + (size_t)which * 256 * 2048 + (size_t)nt * 128 * 2048; a_rs = (size_t)16 * LD1; a_ks = LD1;
  }
};
struct SrcCmp2 {
  const half_t* hid; const half_t* w2t;
  __device__ __forceinline__ void get(int mt, int nt, const half_t*& Ag, const half_t*& Bg, size_t& a_rs, int& a_ks) const {
    Ag = hid + (size_t)mt * 128 * 256; Bg = w2t + (size_t)(mt >> 6) * 128 * 256; a_rs = 256; a_ks = 64;
  }
};

template <class Src, class Epi>
__device__ void gemm_mfma(const Src& src, int M, int Npad, int K, const Epi& epi, char* smem) {
  const int tid = opaque_tid(), lane = tid & 63, wave = tid >> 6, wr = wave >> 1, wc = wave & 1;
  const int r15 = lane & 15, q = lane >> 4;
  const int NT = Npad / 128, MT = M / 128;
  const int xcd = blockIdx.x & 7, slot = blockIdx.x >> 3, nslots = gridDim.x >> 3;
  const int mt_per_xcd = MT / 8;
  const int ntl = mt_per_xcd * NT;
  const int nk = K / 64;
  const int lrow = tid >> 3, lch = tid & 7;
  const int a_rd = (wr * 64 + r15) * 128, b_rd = (wc * 64 + r15) * 128;
  const int swz = r15 >> 1;
  for (int lt = slot; lt < ntl; lt += nslots) {
    const int grp = lt / (8 * NT), within = lt % (8 * NT);
    const int nt = within >> 3, mt = xcd * mt_per_xcd + grp * 8 + (within & 7);
    const half_t* Ag; const half_t* Bg; size_t lda; int a_ks;
    src.get(mt, nt, Ag, Bg, lda, a_ks);
    Ag += (size_t)lrow * lda + (lch ^ ((lrow >> 1) & 7)) * 8;
    Bg += (size_t)lrow * K + (lch ^ ((lrow >> 1) & 7)) * 8;
    f32x4 acc[4][4];
#pragma unroll
    for (int m = 0; m < 4; ++m)
#pragma unroll
      for (int n = 0; n < 4; ++n) acc[m][n] = (f32x4){0.f, 0.f, 0.f, 0.f};
#define GLOAD(BUF, KOFF, BOFF) { char* lb_ = smem + (BUF) * 32768 + wave * 1024; \
    _Pragma("unroll") for (int i_ = 0; i_ < 4; ++i_) { \
      __builtin_amdgcn_global_load_lds((gbl_void*)(Ag + (size_t)(32 * i_) * lda + (KOFF)), (lds_void*)(lb_ + i_ * 4096), 16, 0, 0); \
      __builtin_amdgcn_global_load_lds((gbl_void*)(Bg + (size_t)(32 * i_) * K + (BOFF)), (lds_void*)(lb_ + 16384 + i_ * 4096), 16, 0, 0); } }
    GLOAD(0, 0, 0)
    __syncthreads();
#pragma unroll 1
    for (int kt = 0; kt < nk; ++kt) {
      const int cur = kt & 1;
      if (kt + 1 < nk) GLOAD(cur ^ 1, (size_t)(kt + 1) * a_ks, (kt + 1) * 64)
      const char* cA = smem + cur * 32768 + a_rd;
      const char* cB = smem + cur * 32768 + 16384 + b_rd;
#pragma unroll
      for (int s = 0; s < 2; ++s) {
        half8 af[4], bf[4];
        const int co = ((4 * s + q) ^ swz) << 4;
#pragma unroll
        for (int m = 0; m < 4; ++m) af[m] = *(const half8*)(cA + m * 2048 + co);
#pragma unroll
        for (int n = 0; n < 4; ++n) bf[n] = *(const half8*)(cB + n * 2048 + co);
#pragma unroll
        for (int m = 0; m < 4; ++m)
#pragma unroll
          for (int n = 0; n < 4; ++n) acc[m][n] = __builtin_amdgcn_mfma_f32_16x16x32_f16(bf[n], af[m], acc[m][n], 0, 0, 0);
      }
      __syncthreads();
    }
#undef GLOAD
    epi(acc, mt * 128 + wr * 64, nt * 128 + wc * 64, lane);
  }
}

namespace g8 {
constexpr int BK = 64, HALF = 128, HTB = HALF * BK * 2;
__device__ __forceinline__ int lds_byte(int r, int c) { const int st = (r >> 4) * 2 + (c >> 5), rr = r & 15, cc = c & 31, ob = rr * 64 + cc * 2; return st * 1024 + (ob ^ (((ob >> 9) & 1) << 5)); }
__device__ __forceinline__ void stage_rc(int b, int& R, int& C) { const int st = b / 1024, sb = b % 1024, swz = sb ^ (((sb >> 9) & 1) << 5); R = (st >> 1) * 16 + swz / 64; C = (st & 1) * 32 + (swz % 64) / 2; }
__device__ __forceinline__ int cbase(int wc, int n) { return 64 * (wc >> 1) + 32 * n + 16 * (wc & 1); }
typedef f32x4 Acc[2][2][4][2];

struct SrcPlain8 {
  const half_t* A; int lda; const half_t* Bt; int K;
  __device__ __forceinline__ void get(int pm, int pn, const half_t*& Ag, const half_t*& Bg, size_t& a_rs, int& a_ks) const {
    Ag = A + (size_t)pm * 256 * lda; Bg = Bt + (size_t)pn * 256 * K; a_rs = lda; a_ks = 64;
  }
};
struct SrcCmp1_8 {
  const half_t* p1; const half_t* w1t;
  __device__ __forceinline__ void get(int pm, int pn, const half_t*& Ag, const half_t*& Bg, size_t& a_rs, int& a_ks) const {
    const int which = pm >> 5, bg = pm & 31, b = bg >> 2, g = bg & 3;
    Ag = p1 + (size_t)(b * SEQ) * LD1 + (which ? 1280 : 1024) + g * 64;
    Bg = w1t + (size_t)which * 256 * 2048; a_rs = (size_t)16 * LD1; a_ks = LD1;
  }
};
struct SrcCmp2_8 {
  const half_t* hid; const half_t* w2t;
  __device__ __forceinline__ void get(int pm, int pn, const half_t*& Ag, const half_t*& Bg, size_t& a_rs, int& a_ks) const {
    Ag = hid + (size_t)pm * 256 * 256; Bg = w2t + (size_t)(pm >> 5) * 256 * 256; a_rs = 256; a_ks = 64;
  }
};

struct EpiStore8 {
  half_t* C; int ldc; const float* rowscale;
  __device__ __forceinline__ void operator()(const Acc& acc, int row0, int col0, int wr, int wc, int fr, int fq) const {
#pragma unroll
    for (int ai = 0; ai < 2; ++ai)
#pragma unroll
      for (int m = 0; m < 4; ++m) {
        const int tok = row0 + ai * 128 + wr * 64 + m * 16 + fr;
        const float s = rowscale ? rowscale[tok] : 1.f;
        half_t* rowp = C + (size_t)tok * ldc + col0 + 4 * fq;
#pragma unroll
        for (int bj = 0; bj < 2; ++bj)
#pragma unroll
          for (int n = 0; n < 2; ++n) {
            const f32x4 v = acc[ai][bj][m][n] * s;
            half4 hv; hv[0] = (half_t)v[0]; hv[1] = (half_t)v[1]; hv[2] = (half_t)v[2]; hv[3] = (half_t)v[3];
            *(half4*)(rowp + bj * 128 + cbase(wc, n)) = hv;
          }
      }
  }
};
struct EpiRope8 {
  half_t* C; int ldc; const float* rowscale; const float* ropetab;
  __device__ __forceinline__ void operator()(const Acc& acc, int row0, int col0, int wr, int wc, int fr, int fq) const {
#pragma unroll
    for (int bj = 0; bj < 2; ++bj) {
      const int grp = (col0 + bj * 128 + 64 * (wc >> 1)) >> 6;
      const bool is_q = grp < 16;
      const bool roped = is_q || (grp >= 16 && grp < 20) || (grp >= 24 && grp < 28) || (grp >= 32 && grp < 36);
      const float sc = is_q ? 0.125f : 1.f;
#pragma unroll
      for (int ai = 0; ai < 2; ++ai)
#pragma unroll
        for (int m = 0; m < 4; ++m) {
          const int tok = row0 + ai * 128 + wr * 64 + m * 16 + fr;
          const float s = rowscale[tok];
          half_t* rowp = C + (size_t)tok * ldc + col0 + bj * 128 + 4 * fq;
          f32x4 o1 = acc[ai][bj][m][0] * s, o2 = acc[ai][bj][m][1] * s;
          if (roped) {
            const f32x4 cs = *(const f32x4*)(ropetab + (size_t)tok * 64 + 16 * (wc & 1) + 4 * fq);
            const f32x4 sn = *(const f32x4*)(ropetab + (size_t)tok * 64 + 32 + 16 * (wc & 1) + 4 * fq);
            const f32x4 x1 = o1, x2 = o2;
            o1 = (x1 * cs - x2 * sn) * sc; o2 = (x2 * cs + x1 * sn) * sc;
          }
          half4 h1, h2;
#pragma unroll
          for (int e = 0; e < 4; ++e) { h1[e] = (half_t)o1[e]; h2[e] = (half_t)o2[e]; }
          *(half4*)(rowp + cbase(wc, 0)) = h1;
          *(half4*)(rowp + cbase(wc, 1)) = h2;
        }
    }
  }
};
struct EpiCmpHid8 {
  half_t* hid; const float* bias;
  __device__ __forceinline__ void operator()(const Acc& acc, int row0, int col0, int wr, int wc, int fr, int fq) const {
    const int which = row0 >> 13;
#pragma unroll
    for (int bj = 0; bj < 2; ++bj)
#pragma unroll
      for (int n = 0; n < 2; ++n) {
        const int col = col0 + bj * 128 + cbase(wc, n) + 4 * fq;
        const f32x4 bv = *(const f32x4*)(bias + which * 256 + col);
#pragma unroll
        for (int ai = 0; ai < 2; ++ai)
#pragma unroll
          for (int m = 0; m < 4; ++m) {
            const int row = row0 + ai * 128 + wr * 64 + m * 16 + fr;
            const f32x4 v = acc[ai][bj][m][n] + bv;
            half4 hv; hv[0] = (half_t)siluf(v[0]); hv[1] = (half_t)siluf(v[1]); hv[2] = (half_t)siluf(v[2]); hv[3] = (half_t)siluf(v[3]);
            *(half4*)(hid + (size_t)row * 256 + col) = hv;
          }
      }
  }
};
struct EpiCmpOut8 {
  half_t* kcmp; half_t* vcmp;
  __device__ __forceinline__ void operator()(const Acc& acc, int row0, int col0, int wr, int wc, int fr, int fq) const {
    if (wc >= 2) return;
#pragma unroll
    for (int ai = 0; ai < 2; ++ai)
#pragma unroll
      for (int m = 0; m < 4; ++m) {
        const int row = row0 + ai * 128 + wr * 64 + m * 16 + fr;
        const int which = row >> 13, r = row & 8191;
        half_t* dst = (which ? vcmp : kcmp) + (size_t)r * 64 + 4 * fq;
        const bool dead = (r & 255) == 255;
#pragma unroll
        for (int n = 0; n < 2; ++n) {
          const f32x4 v = acc[ai][0][m][n];
          half4 hv; hv[0] = (half_t)v[0]; hv[1] = (half_t)v[1]; hv[2] = (half_t)v[2]; hv[3] = (half_t)v[3];
          if (dead) hv = (half4){(half_t)0.f, (half_t)0.f, (half_t)0.f, (half_t)0.f};
          *(half4*)(dst + cbase(wc, n)) = hv;
        }
      }
  }
};

template <class Src, class Epi>
__device__ void gemm(const Src& src, int M, int N, int K, const Epi& epi, char* smem) {
  const int tid = opaque_tid(), wid = __builtin_amdgcn_readfirstlane(tid >> 6), lane = tid & 63, wr = wid >> 2, wc = wid & 3, fr = lane & 15, fq = lane >> 4;
  const int nM = M / 256, nN = N / 256, nwg = nM * nN, G = gridDim.x, nt = K / BK;
  int sr0, sc0, sr1, sc1;
  stage_rc(tid * 16, sr0, sc0); stage_rc(tid * 16 + 8192, sr1, sc1);
  const int a_base = lds_byte(wr * 64 + fr, fq * 8);
  int b_base = 65536 + lds_byte(cbase(wc, 0) + fr, fq * 8);
  asm volatile("" : "+v"(b_base));
#define SA8(b, h) (smem + ((b) * 2 + (h)) * HTB)
#define SB8(b, h) (smem + (4 + (b) * 2 + (h)) * HTB)
#define STAGE_A(P, h, kt) { const char* g_ = (const char*)(Ag + (size_t)(h) * 128 * lda + (size_t)(kt) * a_ks); \
    __builtin_amdgcn_global_load_lds((gbl_void*)(g_ + aob0), (lds_void*)((P) + wid * 1024), 16, 0, 0); \
    __builtin_amdgcn_global_load_lds((gbl_void*)(g_ + aob1), (lds_void*)((P) + 8192 + wid * 1024), 16, 0, 0); }
#define STAGE_B(P, h, kt) { const char* g_ = (const char*)(Bg + (size_t)(h) * 128 * K + (size_t)(kt) * 64); \
    __builtin_amdgcn_global_load_lds((gbl_void*)(g_ + bob0), (lds_void*)((P) + wid * 1024), 16, 0, 0); \
    __builtin_amdgcn_global_load_lds((gbl_void*)(g_ + bob1), (lds_void*)((P) + 8192 + wid * 1024), 16, 0, 0); }
#define LDA8(dst, b, h) { _Pragma("unroll") for (int m = 0; m < 4; ++m) _Pragma("unroll") for (int k = 0; k < 2; ++k) dst[m][k] = *(const half8*)(SA8(b, h) + a_base + m * 2048 + k * 1024); }
#define LDB8(dst, b, h) { _Pragma("unroll") for (int n = 0; n < 2; ++n) _Pragma("unroll") for (int k = 0; k < 2; ++k) dst[n][k] = *(const half8*)(smem + ((b) * 2 + (h)) * HTB + b_base + n * 4096 + k * 1024); }
#define MMA8(ai, bj, At, Bx) { __builtin_amdgcn_s_setprio(1); \
    _Pragma("unroll") for (int m = 0; m < 4; ++m) _Pragma("unroll") for (int n = 0; n < 2; ++n) _Pragma("unroll") for (int k = 0; k < 2; ++k) \
      acc[ai][bj][m][n] = __builtin_amdgcn_mfma_f32_16x16x32_f16(Bx[n][k], At[m][k], acc[ai][bj][m][n], 0, 0, 0); \
    __builtin_amdgcn_s_setprio(0); }
#define WAIT_V(n) asm volatile("s_waitcnt vmcnt(" #n ")" ::: "memory")
#define WAIT_L(n) asm volatile("s_waitcnt lgkmcnt(" #n ")" ::: "memory")
#define BAR __builtin_amdgcn_s_barrier()
#define SCHED __builtin_amdgcn_sched_barrier(0)
  for (int it = 0;; ++it) {
    const int L = it * G + (int)blockIdx.x;
    if (L >= nwg) break;
    int wgid;
    { const int q = nwg / 8, r = nwg % 8, xcd = L % 8, off = L / 8; wgid = (xcd < r ? xcd * (q + 1) : r * (q + 1) + (xcd - r) * q) + off; }
    const int nig = 8 * nN, gid = wgid / nig, fm = gid * 8, gsz = (nM - fm) < 8 ? (nM - fm) : 8;
    const int pm = fm + ((wgid % nig) % gsz), pn = (wgid % nig) / gsz;
    const half_t* Ag; const half_t* Bg; size_t lda; int a_ks;
    src.get(pm, pn, Ag, Bg, lda, a_ks);
    const unsigned aob0 = (unsigned)(((size_t)sr0 * lda + sc0) * 2), aob1 = (unsigned)(((size_t)sr1 * lda + sc1) * 2);
    const unsigned bob0 = (unsigned)((sr0 * K + sc0) * 2), bob1 = (unsigned)((sr1 * K + sc1) * 2);
    Acc acc;
#pragma unroll
    for (int a = 0; a < 2; ++a)
#pragma unroll
      for (int b = 0; b < 2; ++b)
#pragma unroll
        for (int m = 0; m < 4; ++m)
#pragma unroll
          for (int n = 0; n < 2; ++n) acc[a][b][m][n] = (f32x4){0.f, 0.f, 0.f, 0.f};
    half8 At[4][2], B0[2][2], B1[2][2];
    STAGE_B(SB8(0, 0), 0, 0) STAGE_A(SA8(0, 0), 0, 0)
    STAGE_B(SB8(0, 1), 1, 0) STAGE_A(SA8(0, 1), 1, 0)
    if (wr == 1) BAR;
    WAIT_V(4); BAR;
    STAGE_B(SB8(1, 0), 0, 1) STAGE_A(SA8(1, 0), 0, 1) STAGE_B(SB8(1, 1), 1, 1)
    WAIT_V(6); BAR;
#pragma unroll 1
    for (int t = 0; t < nt - 2; t += 2) {
      LDB8(B0, 0, 0) SCHED; LDA8(At, 0, 0) STAGE_A(SA8(1, 1), 1, t + 1)
      WAIT_L(8); BAR; WAIT_L(0); MMA8(0, 0, At, B0) BAR; SCHED;
      LDB8(B1, 0, 1) STAGE_B(SB8(0, 0), 0, t + 2)
      BAR; WAIT_L(0); MMA8(0, 1, At, B1) BAR;
      LDA8(At, 0, 1) STAGE_A(SA8(0, 0), 0, t + 2)
      BAR; WAIT_L(0); MMA8(1, 0, At, B0) BAR; SCHED;
      STAGE_B(SB8(0, 1), 1, t + 2)
      WAIT_V(6); BAR; MMA8(1, 1, At, B1) BAR;
      LDB8(B0, 1, 0) SCHED; LDA8(At, 1, 0) STAGE_A(SA8(0, 1), 1, t + 2)
      WAIT_L(8); BAR; WAIT_L(0); MMA8(0, 0, At, B0) BAR; SCHED;
      LDB8(B1, 1, 1) STAGE_B(SB8(1, 0), 0, t + 3)
      BAR; WAIT_L(0); MMA8(0, 1, At, B1) BAR;
      LDA8(At, 1, 1) STAGE_A(SA8(1, 0), 0, t + 3)
      BAR; WAIT_L(0); MMA8(1, 0, At, B0) BAR; SCHED;
      STAGE_B(SB8(1, 1), 1, t + 3)
      WAIT_V(6); BAR; MMA8(1, 1, At, B1) BAR;
    }
    { LDB8(B0, 0, 0) LDA8(At, 0, 0) STAGE_A(SA8(1, 1), 1, nt - 1)
      BAR; WAIT_L(0); MMA8(0, 0, At, B0) BAR;
      LDB8(B1, 0, 1) BAR; WAIT_L(0); MMA8(0, 1, At, B1) BAR;
      LDA8(At, 0, 1) WAIT_V(4); BAR; WAIT_L(0); MMA8(1, 0, At, B0) MMA8(1, 1, At, B1) BAR; }
    { LDB8(B0, 1, 0) LDA8(At, 1, 0) WAIT_V(2); BAR; WAIT_L(0); MMA8(0, 0, At, B0) BAR;
      LDB8(B1, 1, 1) WAIT_V(0); BAR; WAIT_L(0); MMA8(0, 1, At, B1) BAR;
      LDA8(At, 1, 1) BAR; WAIT_L(0); MMA8(1, 0, At, B0) MMA8(1, 1, At, B1) BAR; }
    if (wr == 0) BAR;
    { int fr2 = fr, fq2 = fq; asm volatile("" : "+v"(fr2), "+v"(fq2)); epi(acc, pm * 256, pn * 256, wr, wc, fr2, fq2); }
  }
#undef SA8
#undef SB8
#undef STAGE_A
#undef STAGE_B
#undef LDA8
#undef LDB8
#undef MMA8
#undef WAIT_V
#undef WAIT_L
#undef BAR
#undef SCHED
}
}

__device__ void ph_gla_prep(const Params& P, float* sm) {
  float(*glr)[16] = (float(*)[16])sm;
  const int tid = opaque_tid();
  const float scale = 0.08838834764831845f;
  for (int item = blockIdx.x; item < T_TOK / 64; item += gridDim.x) {
    const int t0 = item * 64;
    __syncthreads();
    for (int idx = tid; idx < 64 * 16; idx += NTHREADS) {
      const int i = idx >> 4, r = idx & 15;
      glr[i][r] = (float)P.p[(size_t)(t0 + i) * LD0 + 3072 + r];
    }
    __syncthreads();
    {
      const int ch = tid;
      float w[16];
#pragma unroll
      for (int r = 0; r < 16; ++r) w[r] = P.gla_w_gk_up[r * 512 + ch];
      const float bb = P.gla_b_gk[ch];
      half_t* qp = P.p + (size_t)t0 * LD0 + ch;
      float cum = 0.f;
#pragma unroll 4
      for (int i = 0; i < 64; ++i) {
        float u = bb;
#pragma unroll
        for (int r = 0; r < 16; ++r) u += glr[i][r] * w[r];
        cum += logsigmoidf(u) * (1.f / 16.f);
        const float ex = exp2f(cum * LOG2E);
        const float qv = (float)qp[(size_t)i * LD0], kv = (float)qp[(size_t)i * LD0 + 512];
        qp[(size_t)i * LD0] = (half_t)(qv * scale * ex);
        qp[(size_t)i * LD0 + 512] = (half_t)(kv * __builtin_amdgcn_rcpf(ex));
        if (i == 63) P.bcum[(size_t)item * 512 + ch] = ex;
      }
    }
  }
}

constexpr int GLA_QE = 0, GLA_KE = 16384, GLA_V = 32768, GLA_DEC = 49152, GLA_BUF = 53248;
#define GLA_TR4(d0, d1, d2, d3, addr, o0, o1, o2, o3) \
  asm volatile("ds_read_b64_tr_b16 %0, %4 offset:%5\n\tds_read_b64_tr_b16 %1, %4 offset:%6\n\tds_read_b64_tr_b16 %2, %4 offset:%7\n\tds_read_b64_tr_b16 %3, %4 offset:%8" \
               : "=&v"(d0), "=&v"(d1), "=&v"(d2), "=&v"(d3) : "v"(addr), "n"(o0), "n"(o1), "n"(o2), "n"(o3) : "memory")
__device__ __forceinline__ half8 pack_h8(const v2i a, const v2i b) { const v4i p = (v4i){a[0], a[1], b[0], b[1]}; return __builtin_bit_cast(half8, p); }

__device__ void ph_gla_mfma(const Params& P, char* smem) {
  const int tid = opaque_tid();
  const int lane = tid & 63, wave = __builtin_amdgcn_readfirstlane(tid >> 6), r15 = lane & 15, q = lane >> 4;
  const int qp = r15 >> 2, pp = lane & 3;
  const int srow = tid >> 4, sslot = tid & 15;
  const int src_q = (sslot ^ (srow & 15)) * 8, src_kv = (sslot ^ ((srow & 7) << 1)) * 8;
  const int fk = ((4 * (q & 1) + qp) & 7) << 1;
  const unsigned tr_row = (unsigned)((4 * q + qp) * 256 + 8 * (pp & 1) + ((pp >> 1) << 4));
  for (int item = blockIdx.x; item < NBATCH * 4 * 2; item += gridDim.x) {
    const int b = item >> 3, h = (item >> 1) & 3, vs = item & 1;
    f32x4 S[8];
#pragma unroll
    for (int df = 0; df < 8; ++df) S[df] = (f32x4){0.f, 0.f, 0.f, 0.f};
    const half_t* qsrc = P.p + (size_t)(b * SEQ + srow) * LD0 + h * 128;
    const half_t* vsrc = P.p + (size_t)(b * SEQ + srow) * LD0 + 1024 + h * 256 + vs * 128 + src_kv;
    const float* dsrc = P.bcum + (size_t)(b * 64) * 512 + h * 128 + (lane & 31) * 4;
#define G_ISSUE(N, BUF) { char* lb_ = smem + (BUF) * GLA_BUF + wave * 1024; const size_t ro_ = (size_t)(N) * 64 * LD0; \
      __builtin_amdgcn_global_load_lds((gbl_void*)(qsrc + ro_ + src_q), (lds_void*)(lb_ + GLA_QE), 16, 0, 0); \
      __builtin_amdgcn_global_load_lds((gbl_void*)(qsrc + ro_ + (size_t)32 * LD0 + src_q), (lds_void*)(lb_ + GLA_QE + 8192), 16, 0, 0); \
      __builtin_amdgcn_global_load_lds((gbl_void*)(qsrc + ro_ + 512 + src_kv), (lds_void*)(lb_ + GLA_KE), 16, 0, 0); \
      __builtin_amdgcn_global_load_lds((gbl_void*)(qsrc + ro_ + (size_t)32 * LD0 + 512 + src_kv), (lds_void*)(lb_ + GLA_KE + 8192), 16, 0, 0); \
      __builtin_amdgcn_global_load_lds((gbl_void*)(vsrc + ro_), (lds_void*)(lb_ + GLA_V), 16, 0, 0); \
      __builtin_amdgcn_global_load_lds((gbl_void*)(vsrc + ro_ + (size_t)32 * LD0), (lds_void*)(lb_ + GLA_V + 8192), 16, 0, 0); \
      if (lane < 32) __builtin_amdgcn_global_load_lds((gbl_void*)(dsrc + (size_t)(N) * 512), (lds_void*)(smem + (BUF) * GLA_BUF + GLA_DEC + wave * 512), 16, 0, 0); }
    G_ISSUE(0, 0)
#pragma unroll 1
    for (int n = 0; n < 64; ++n) {
      asm volatile("s_waitcnt vmcnt(0)" ::: "memory");
      __builtin_amdgcn_s_barrier();
      if (n + 1 < 64) G_ISSUE(n + 1, (n + 1) & 1)
      const char* cb = smem + (n & 1) * GLA_BUF;
      f32x4 aT[4][4];
#pragma unroll
      for (int kf = 0; kf < 4; ++kf)
#pragma unroll
        for (int tf = 0; tf < 4; ++tf) aT[kf][tf] = (f32x4){0.f, 0.f, 0.f, 0.f};
#pragma unroll
      for (int ks = 0; ks < 4; ++ks) {
        half8 kef[4], qef[4];
#pragma unroll
        for (int f = 0; f < 4; ++f) {
          kef[f] = *(const half8*)(cb + GLA_KE + (16 * f + r15) * 256 + (((4 * ks + q) ^ ((r15 & 7) << 1)) << 4));
          qef[f] = *(const half8*)(cb + GLA_QE + (16 * f + r15) * 256 + (((4 * ks + q) ^ r15) << 4));
        }
#pragma unroll
        for (int kf = 0; kf < 4; ++kf)
#pragma unroll
          for (int tf = kf; tf < 4; ++tf) aT[kf][tf] = __builtin_amdgcn_mfma_f32_16x16x32_f16(kef[kf], qef[tf], aT[kf][tf], 0, 0, 0);
      }
#pragma unroll
      for (int f = 0; f < 4; ++f)
#pragma unroll
        for (int r = 0; r < 4; ++r) if (4 * q + r > r15) aT[f][f][r] = 0.f;
      const unsigned lds0 = (unsigned)(size_t)cb;
      const unsigned va = lds0 + GLA_V + tr_row + ((((2 * wave) ^ fk)) << 4);
      v2i v00, v01, v10, v11;
      GLA_TR4(v00, v01, v10, v11, va, 0, 4096, 8192, 12288);
      const unsigned ka = lds0 + GLA_KE + tr_row;
      v2i k0[4][4];
#pragma unroll
      for (int df = 0; df < 4; ++df) { const unsigned a_ = ka + ((((2 * df) ^ fk)) << 4); GLA_TR4(k0[df][0], k0[df][1], k0[df][2], k0[df][3], a_, 0, 4096, 8192, 12288); }
      asm volatile("s_waitcnt lgkmcnt(15)" : "+v"(v00), "+v"(v01), "+v"(v10), "+v"(v11) :: "memory");
      __builtin_amdgcn_sched_barrier(0);
      half8 vf[2];
      vf[0] = pack_h8(v00, v01); vf[1] = pack_h8(v10, v11);
      f32x4 o[4];
#pragma unroll
      for (int tf = 0; tf < 4; ++tf) o[tf] = (f32x4){0.f, 0.f, 0.f, 0.f};
#pragma unroll
      for (int ks2 = 0; ks2 < 2; ++ks2)
#pragma unroll
        for (int tf = 2 * ks2; tf < 4; ++tf) {
          half8 pk;
#pragma unroll
          for (int r = 0; r < 4; ++r) { pk[r] = (half_t)aT[2 * ks2][tf][r]; pk[4 + r] = (half_t)aT[2 * ks2 + 1][tf][r]; }
          o[tf] = __builtin_amdgcn_mfma_f32_16x16x32_f16(vf[ks2], pk, o[tf], 0, 0, 0);
        }
#pragma unroll
      for (int ks = 0; ks < 4; ++ks) {
        half8 sf;
#pragma unroll
        for (int r = 0; r < 4; ++r) { sf[r] = (half_t)S[2 * ks][r]; sf[4 + r] = (half_t)S[2 * ks + 1][r]; }
#pragma unroll
        for (int tf = 0; tf < 4; ++tf) {
          const int row = 16 * tf + r15;
          const half4 qa = *(const half4*)(cb + GLA_QE + row * 256 + (((4 * ks + (q >> 1)) ^ r15) << 4) + (q & 1) * 8);
          const half4 qb = *(const half4*)(cb + GLA_QE + row * 256 + (((4 * ks + 2 + (q >> 1)) ^ r15) << 4) + (q & 1) * 8);
          half8 qv;
#pragma unroll
          for (int e = 0; e < 4; ++e) { qv[e] = qa[e]; qv[4 + e] = qb[e]; }
          o[tf] = __builtin_amdgcn_mfma_f32_16x16x32_f16(sf, qv, o[tf], 0, 0, 0);
        }
      }
      {
        const size_t t0 = (size_t)(b * SEQ + n * 64);
#pragma unroll
        for (int tf = 0; tf < 4; ++tf) {
          half4 hv; hv[0] = (half_t)o[tf][0]; hv[1] = (half_t)o[tf][1]; hv[2] = (half_t)o[tf][2]; hv[3] = (half_t)o[tf][3];
          *(half4*)(P.og + (t0 + 16 * tf + r15) * DM + h * 256 + vs * 128 + 16 * wave + 4 * q) = hv;
        }
      }
      v2i k1[4][4];
#pragma unroll
      for (int df = 0; df < 4; ++df) { const unsigned a_ = ka + ((((2 * (df + 4)) ^ fk)) << 4); GLA_TR4(k1[df][0], k1[df][1], k1[df][2], k1[df][3], a_, 0, 4096, 8192, 12288); }
      asm volatile("s_waitcnt lgkmcnt(15)"
                   : "+v"(k0[0][0]), "+v"(k0[0][1]), "+v"(k0[0][2]), "+v"(k0[0][3]), "+v"(k0[1][0]), "+v"(k0[1][1]), "+v"(k0[1][2]), "+v"(k0[1][3]),
                     "+v"(k0[2][0]), "+v"(k0[2][1]), "+v"(k0[2][2]), "+v"(k0[2][3]), "+v"(k0[3][0]), "+v"(k0[3][1]), "+v"(k0[3][2]), "+v"(k0[3][3]) :: "memory");
      __builtin_amdgcn_sched_barrier(0);
#pragma unroll
      for (int df = 0; df < 4; ++df) {
        S[df] = __builtin_amdgcn_mfma_f32_16x16x32_f16(pack_h8(k0[df][0], k0[df][1]), vf[0], S[df], 0, 0, 0);
        S[df] = __builtin_amdgcn_mfma_f32_16x16x32_f16(pack_h8(k0[df][2], k0[df][3]), vf[1], S[df], 0, 0, 0);
      }
      asm volatile("s_waitcnt lgkmcnt(0)"
                   : "+v"(k1[0][0]), "+v"(k1[0][1]), "+v"(k1[0][2]), "+v"(k1[0][3]), "+v"(k1[1][0]), "+v"(k1[1][1]), "+v"(k1[1][2]), "+v"(k1[1][3]),
                     "+v"(k1[2][0]), "+v"(k1[2][1]), "+v"(k1[2][2]), "+v"(k1[2][3]), "+v"(k1[3][0]), "+v"(k1[3][1]), "+v"(k1[3][2]), "+v"(k1[3][3]) :: "memory");
      __builtin_amdgcn_sched_barrier(0);
#pragma unroll
      for (int df = 0; df < 4; ++df) {
        S[df + 4] = __builtin_amdgcn_mfma_f32_16x16x32_f16(pack_h8(k1[df][0], k1[df][1]), vf[0], S[df + 4], 0, 0, 0);
        S[df + 4] = __builtin_amdgcn_mfma_f32_16x16x32_f16(pack_h8(k1[df][2], k1[df][3]), vf[1], S[df + 4], 0, 0, 0);
      }
#pragma unroll
      for (int df = 0; df < 8; ++df) {
        const f32x4 dc = *(const f32x4*)(cb + GLA_DEC + wave * 512 + (16 * df + 4 * q) * 4);
        S[df] *= dc;
      }
    }
    asm volatile("s_waitcnt vmcnt(0)" ::: "memory");
    __builtin_amdgcn_s_barrier();
#undef G_ISSUE
  }
}

__device__ void ph_gla_post(const Params& P) {
  const int tid_ = opaque_tid(); const int lane = tid_ & 63, h = (tid_ >> 6) & 3;
  for (int t = blockIdx.x * 2 + (tid_ >> 8); t < T_TOK; t += gridDim.x * 2) {
    half4* op = (half4*)(P.og + (size_t)t * DM + h * 256) + lane;
    const half4 hv = *op;
    float v0 = (float)hv[0], v1 = (float)hv[1], v2 = (float)hv[2], v3 = (float)hv[3];
    const float ss = wave_sum(v0 * v0 + v1 * v1 + v2 * v2 + v3 * v3);
    const float r = rsqrtf(ss * (1.f / 256.f) + EPS);
    const float4 hn = ((const float4*)P.gla_head_norm)[lane];
    const half4 z = *((const half4*)(P.p + (size_t)t * LD0 + 2048 + h * 256) + lane);
    half4 o;
    o[0] = (half_t)(v0 * r * hn.x * siluf((float)z[0]));
    o[1] = (half_t)(v1 * r * hn.y * siluf((float)z[1]));
    o[2] = (half_t)(v2 * r * hn.z * siluf((float)z[2]));
    o[3] = (half_t)(v3 * r * hn.w * siluf((float)z[3]));
    *op = o;
  }
}

__device__ void ph_post(const float* base, const half_t* y, const float* g, float* dst, half_t* dsth, float* rstd_out) {
  const int tid_ = opaque_tid(); const int lane = tid_ & 63, w = tid_ >> 6;
  for (int row = blockIdx.x * NWAVES + w; row < T_TOK; row += gridDim.x * NWAVES) {
    const half4* yr = (const half4*)(y + (size_t)row * DM);
    const float4* br = (const float4*)(base + (size_t)row * DM);
    float4* dr = (float4*)(dst + (size_t)row * DM);
    float4 v[4]; float ss = 0.f;
#pragma unroll
    for (int i = 0; i < 4; ++i) {
      const half4 hv = yr[lane + 64 * i];
      v[i].x = (float)hv[0]; v[i].y = (float)hv[1]; v[i].z = (float)hv[2]; v[i].w = (float)hv[3];
      ss += v[i].x * v[i].x + v[i].y * v[i].y + v[i].z * v[i].z + v[i].w * v[i].w;
    }
    ss = wave_sum(ss);
    const float r = rsqrtf(ss * (1.f / DM) + EPS);
    float s2 = 0.f;
#pragma unroll
    for (int i = 0; i < 4; ++i) {
      const float4 gg = ((const float4*)g)[lane + 64 * i];
      const float4 bb = br[lane + 64 * i];
      float4 o;
      o.x = bb.x + v[i].x * r * gg.x; o.y = bb.y + v[i].y * r * gg.y; o.z = bb.z + v[i].z * r * gg.z; o.w = bb.w + v[i].w * r * gg.w;
      s2 += o.x * o.x + o.y * o.y + o.z * o.z + o.w * o.w;
      dr[lane + 64 * i] = o;
      if (dsth) {
        half4 hv; hv[0] = (half_t)o.x; hv[1] = (half_t)o.y; hv[2] = (half_t)o.z; hv[3] = (half_t)o.w;
        ((half4*)(dsth + (size_t)row * DM))[lane + 64 * i] = hv;
      }
    }
    if (rstd_out) { s2 = wave_sum(s2); if (lane == 0) rstd_out[row] = rsqrtf(s2 * (1.f / DM) + EPS); }
  }
}

constexpr int ATT_NB = 6, ATT_D = 5;
constexpr int ATT_K = 0, ATT_V = ATT_NB * 8192, ATT_IMP = 2 * ATT_NB * 8192, ATT_SELM = ATT_IMP + 64 * 65 * 4;
template <int N> __device__ __forceinline__ void wait_vmcnt() { asm volatile("s_waitcnt vmcnt(%0)" ::"n"(N) : "memory"); }

template <int MODE>
__device__ __forceinline__ void attn_branch(char* smem, const half_t* kbase, const half_t* vbase, int ld, int tile_lo, int tile_hi, int n, int th,
                                            const half8 (&qf)[2][2], float (&m)[2], float (&l)[2], f32x4 (&o)[4][2],
                                            const unsigned long long (&selm)[2]) {
  int tid = threadIdx.x; asm volatile("" : "+v"(tid));
  const int lane = tid & 63, r15 = lane & 15, q = lane >> 4;
  const int lrow = tid >> 3, lch = tid & 7;
  const int k_rd = r15 * 128, kswz = r15 >> 1;
  const int qp = r15 >> 2, pp = lane & 3;
  const int fx = ((2 * q + (qp >> 1)) & 3) << 1;
  const int v_rd = (4 * q + qp) * 128 + 8 * (pp & 1) + ((pp >> 1) << 4);
  unsigned int* impu = (unsigned int*)(smem + ATT_IMP);
  const int ksrc = (lch ^ ((lrow >> 1) & 7)) * 8, vsrc = (lch ^ (((lrow >> 1) & 3) << 1)) * 8;
  const int wbase = __builtin_amdgcn_readfirstlane(tid >> 6) * 1024;
#define A_GLOAD(TI, BUF) { const half_t* kp_ = kbase + (size_t)((TI) * 64 + lrow) * ld + ksrc; \
    __builtin_amdgcn_global_load_lds((gbl_void*)kp_, (lds_void*)(smem + ATT_K + (BUF) * 8192 + wbase), 16, 0, 0); \
    if (MODE != 0) { const half_t* vp_ = vbase + (size_t)((TI) * 64 + lrow) * ld + vsrc; \
      __builtin_amdgcn_global_load_lds((gbl_void*)vp_, (lds_void*)(smem + ATT_V + (BUF) * 8192 + wbase), 16, 0, 0); } }
  constexpr int GPT = (MODE == 0) ? 1 : 2;
#pragma unroll
  for (int i = 0; i < ATT_D; ++i) if (tile_lo + i <= tile_hi) A_GLOAD(tile_lo + i, i)
#pragma unroll 1
  for (int ti = tile_lo; ti <= tile_hi; ++ti) {
    const int it = ti - tile_lo, cur = it % ATT_NB;
    {
      const int rem = tile_hi - ti;
      if (rem >= 4) wait_vmcnt<4 * GPT>(); else if (rem == 3) wait_vmcnt<3 * GPT>(); else if (rem == 2) wait_vmcnt<2 * GPT>();
      else if (rem == 1) wait_vmcnt<1 * GPT>(); else wait_vmcnt<0>();
    }
    __builtin_amdgcn_s_barrier();
    if (ti + ATT_D <= tile_hi) A_GLOAD(ti + ATT_D, (it + ATT_D) % ATT_NB)
    const char* kb = smem + ATT_K + cur * 8192 + k_rd;
    const unsigned vbl = (unsigned)(size_t)(smem + ATT_V + cur * 8192 + v_rd);
    bool need_mask;
    if (MODE <= 1) need_mask = (ti * 64 + 63 > 4 * n - 2);
    else if (MODE == 2) need_mask = (ti == n);
    else need_mask = (ti == n) || (ti == n - 8);
    f32x4 s[4][2];
#pragma unroll
    for (int kf = 0; kf < 4; ++kf)
#pragma unroll
      for (int t2 = 0; t2 < 2; ++t2) s[kf][t2] = (f32x4){0.f, 0.f, 0.f, 0.f};
#pragma unroll
    for (int ks = 0; ks < 2; ++ks) {
      const int co = ((4 * ks + q) ^ kswz) << 4;
#pragma unroll
      for (int kf = 0; kf < 4; ++kf) {
        const half8 kfr = *(const half8*)(kb + kf * 2048 + co);
#pragma unroll
        for (int t2 = 0; t2 < 2; ++t2) s[kf][t2] = __builtin_amdgcn_mfma_f32_16x16x32_f16(kfr, qf[t2][ks], s[kf][t2], 0, 0, 0);
      }
    }
    v2i vr[4][4];
    if (MODE != 0) {
      const unsigned va0 = vbl + (((0) ^ fx) << 4), va1 = vbl + (((2) ^ fx) << 4), va2 = vbl + (((4) ^ fx) << 4), va3 = vbl + (((6) ^ fx) << 4);
      asm volatile(
          "ds_read_b64_tr_b16 %0, %16\n\tds_read_b64_tr_b16 %1, %16 offset:2048\n\tds_read_b64_tr_b16 %2, %16 offset:4096\n\tds_read_b64_tr_b16 %3, %16 offset:6144\n\t"
          "ds_read_b64_tr_b16 %4, %17\n\tds_read_b64_tr_b16 %5, %17 offset:2048\n\tds_read_b64_tr_b16 %6, %17 offset:4096\n\tds_read_b64_tr_b16 %7, %17 offset:6144\n\t"
          "ds_read_b64_tr_b16 %8, %18\n\tds_read_b64_tr_b16 %9, %18 offset:2048\n\tds_read_b64_tr_b16 %10, %18 offset:4096\n\tds_read_b64_tr_b16 %11, %18 offset:6144\n\t"
          "ds_read_b64_tr_b16 %12, %19\n\tds_read_b64_tr_b16 %13, %19 offset:2048\n\tds_read_b64_tr_b16 %14, %19 offset:4096\n\tds_read_b64_tr_b16 %15, %19 offset:6144"
          : "=&v"(vr[0][0]), "=&v"(vr[0][1]), "=&v"(vr[0][2]), "=&v"(vr[0][3]), "=&v"(vr[1][0]), "=&v"(vr[1][1]), "=&v"(vr[1][2]), "=&v"(vr[1][3]),
            "=&v"(vr[2][0]), "=&v"(vr[2][1]), "=&v"(vr[2][2]), "=&v"(vr[2][3]), "=&v"(vr[3][0]), "=&v"(vr[3][1]), "=&v"(vr[3][2]), "=&v"(vr[3][3])
          : "v"(va0), "v"(va1), "v"(va2), "v"(va3)
          : "memory");
    }
    if (need_mask) {
#pragma unroll
      for (int t2 = 0; t2 < 2; ++t2) {
        const int tok = th * 32 + t2 * 16 + r15;
        int lo = 0, hi = 63;
        if (MODE <= 1) { hi = 4 * n + ((tok - 31) >> 4) - ti * 64; }
        else if (MODE == 2) { hi = tok; }
        else { if (ti == n) hi = tok; else lo = tok + 1; }
#pragma unroll
        for (int kf = 0; kf < 4; ++kf)
#pragma unroll
          for (int r = 0; r < 4; ++r) {
            const int kk = kf * 16 + 4 * q + r;
            if (kk < lo || kk > hi) s[kf][t2][r] = -INFINITY;
          }
      }
    }
    half8 pf[2][2];
#pragma unroll
    for (int t2 = 0; t2 < 2; ++t2) {
      float mb, scale_p = 1.f;
      if (MODE == 1) {
        mb = m[t2] * LOG2E; scale_p = l[t2];
      } else {
        float tm = s[0][t2][0];
#pragma unroll
        for (int kf = 0; kf < 4; ++kf)
#pragma unroll
          for (int r = 0; r < 4; ++r) tm = fmaxf(tm, s[kf][t2][r]);
        tm = fmaxf(tm, __shfl_xor(tm, 16));
        tm = fmaxf(tm, __shfl_xor(tm, 32));
        bool selected = true;
        if (MODE == 2) { selected = (selm[t2] >> ti) & 1ull; if (!selected) tm = -INFINITY; }
        const float mn = fmaxf(m[t2], tm);
        const float alpha = fexp2((m[t2] - mn) * LOG2E);
        m[t2] = mn; mb = mn * LOG2E;
        if (MODE == 2 && !selected) mb = INFINITY;
        l[t2] *= alpha;
        if (MODE >= 2) {
#pragma unroll
          for (int df = 0; df < 4; ++df) o[df][t2] *= alpha;
        }
      }
      float lsum = 0.f;
#pragma unroll
      for (int kf = 0; kf < 4; ++kf) {
#pragma unroll
        for (int r = 0; r < 4; ++r) {
          float pv = fexp2(fmaf(s[kf][t2][r], LOG2E, -mb));
          if (MODE == 1) pv *= scale_p;
          s[kf][t2][r] = pv; lsum += pv;
        }
      }
      if (MODE != 1) l[t2] += lsum;
      if (MODE == 1) {
        const int tok = th * 32 + t2 * 16 + r15;
#pragma unroll
        for (int kf = 0; kf < 4; ++kf) {
          const int j = 16 * ti + 4 * kf + q;
          const unsigned int u0 = (unsigned int)(s[kf][t2][0] * 134217728.f + 0.5f), u1 = (unsigned int)(s[kf][t2][1] * 134217728.f + 0.5f);
          const unsigned int u2 = (unsigned int)(s[kf][t2][2] * 134217728.f + 0.5f), u3 = (unsigned int)(s[kf][t2][3] * 134217728.f + 0.5f);
          if (j < 64) {
            atomicAdd(&impu[tok * 65 + j], u0 + u1 + u2 + u3);
            atomicAdd(&impu[tok * 65 + j + 1], u3);
          }
        }
      }
      if (MODE != 0) {
#pragma unroll
        for (int ks = 0; ks < 2; ++ks) {
          half8 pk;
#pragma unroll
          for (int r = 0; r < 4; ++r) { pk[r] = (half_t)s[2 * ks][t2][r]; pk[4 + r] = (half_t)s[2 * ks + 1][t2][r]; }
          pf[t2][ks] = pk;
        }
      }
    }
    if (MODE != 0) {
      asm volatile("s_waitcnt lgkmcnt(0)"
                   : "+v"(vr[0][0]), "+v"(vr[0][1]), "+v"(vr[0][2]), "+v"(vr[0][3]), "+v"(vr[1][0]), "+v"(vr[1][1]), "+v"(vr[1][2]), "+v"(vr[1][3]),
                     "+v"(vr[2][0]), "+v"(vr[2][1]), "+v"(vr[2][2]), "+v"(vr[2][3]), "+v"(vr[3][0]), "+v"(vr[3][1]), "+v"(vr[3][2]), "+v"(vr[3][3])
                   :: "memory");
      __builtin_amdgcn_sched_barrier(0);
#pragma unroll
      for (int df = 0; df < 4; ++df) {
#pragma unroll
        for (int ks = 0; ks < 2; ++ks) {
          const v2i lo2 = vr[df][2 * ks], hi2 = vr[df][2 * ks + 1];
          const v4i pk4 = (v4i){lo2[0], lo2[1], hi2[0], hi2[1]};
          const half8 vf = __builtin_bit_cast(half8, pk4);
#pragma unroll
          for (int t2 = 0; t2 < 2; ++t2) o[df][t2] = __builtin_amdgcn_mfma_f32_16x16x32_f16(vf, pf[t2][ks], o[df][t2], 0, 0, 0);
        }
      }
    }
  }
  __syncthreads();
#undef A_GLOAD
}

__device__ void ph_attn_mfma(const Params& P, char* smem) {
  const int tid = opaque_tid(), lane = tid & 63, r15 = lane & 15, q = lane >> 4;
  unsigned int* impu = (unsigned int*)(smem + ATT_IMP);
  unsigned long long* selmask = (unsigned long long*)(smem + ATT_SELM);
  const int G = gridDim.x, nrounds = (2048 + G - 1) / G;
  for (int rd = 0; rd < nrounds; ++rd) {
    const int idx = rd * G + ((rd & 1) ? (G - 1 - (int)blockIdx.x) : (int)blockIdx.x);
    if (idx >= 2048) continue;
    const int n = 63 - (idx >> 5), bg = idx & 31, b = bg >> 2, g = bg & 3;
    const int wv = opaque_tid() >> 6;
    const int hd = g * 4 + (wv & 3), th = wv >> 2;
    const int t0 = b * SEQ + n * 64 + th * 32;
    half8 qf[2][2];
#pragma unroll
    for (int t2 = 0; t2 < 2; ++t2)
#pragma unroll
      for (int ks = 0; ks < 2; ++ks) qf[t2][ks] = *(const half8*)(P.p + (size_t)(t0 + t2 * 16 + r15) * LD1 + hd * 64 + 32 * ks + 8 * q);
    { const int tz = opaque_tid(); for (int i = tz; i < 64 * 65; i += NTHREADS) impu[i] = 0u; }
    float m[2], l[2]; f32x4 o[4][2]; unsigned long long selm[2] = {0ull, 0ull};
#pragma unroll
    for (int t2 = 0; t2 < 2; ++t2) { m[t2] = -1e30f; l[t2] = 0.f; }
#pragma unroll
    for (int df = 0; df < 4; ++df)
#pragma unroll
      for (int t2 = 0; t2 < 2; ++t2) o[df][t2] = (f32x4){0.f, 0.f, 0.f, 0.f};
    const half_t* kc = P.kcmp + (size_t)bg * 256 * 64;
    const half_t* vc = P.vcmp + (size_t)bg * 256 * 64;
    const int nct = (4 * n + 2) / 64;
    attn_branch<0>(smem, kc, vc, 64, 0, nct, n, th, qf, m, l, o, selm);
#pragma unroll
    for (int t2 = 0; t2 < 2; ++t2) {
      float lt = l[t2];
      lt += __shfl_xor(lt, 16); lt += __shfl_xor(lt, 32);
      l[t2] = lt > 0.f ? 1.f / lt : 0.f;
    }
    attn_branch<1>(smem, kc, vc, 64, 0, nct, n, th, qf, m, l, o, selm);
    {
      int tbase = t0 + r15; asm volatile("" : "+v"(tbase));
#pragma unroll
      for (int t2 = 0; t2 < 2; ++t2) {
        const size_t tok = (size_t)(tbase + t2 * 16);
        const float gc = sigmoidf((float)P.p[tok * LD1 + 3584 + hd * 3 + 0] + P.nsa_b_gate[hd * 3 + 0]);
#pragma unroll
        for (int df = 0; df < 4; ++df) {
          const f32x4 v = o[df][t2] * gc;
          half4 hv; hv[0] = (half_t)v[0]; hv[1] = (half_t)v[1]; hv[2] = (half_t)v[2]; hv[3] = (half_t)v[3];
          *(half4*)(P.og + tok * DM + hd * 64 + df * 16 + 4 * q) = hv;
        }
      }
    }
    {
      int tid2 = threadIdx.x; asm volatile("" : "+v"(tid2));
      const int tok = tid2 >> 3, part = tid2 & 7;
      unsigned long long msk;
      if (n + 1 <= 16) {
        msk = (1ull << (n + 1)) - 1ull;
      } else {
        unsigned int bits = 0;
#pragma clang loop unroll(disable) vectorize(disable)
        for (int jj = 0; jj < 8; ++jj) {
          const int j = part * 8 + jj;
          if (j >= 1 && j <= n - 2) {
            const unsigned int v = impu[tok * 65 + j];
            int rank = 0;
#pragma clang loop unroll(disable) vectorize(disable)
            for (int j2 = 1; j2 <= n - 2; ++j2) {
              const unsigned int v2 = impu[tok * 65 + j2];
              rank += (v2 > v || (v2 == v && j2 < j)) ? 1 : 0;
            }
            if (rank < 13) bits |= 1u << jj;
          }
        }
        msk = (unsigned long long)bits << (8 * part);
        msk |= __shfl_xor(msk, 1);
        msk |= __shfl_xor(msk, 2);
        msk |= __shfl_xor(msk, 4);
        msk |= 1ull | (1ull << n) | (1ull << (n - 1));
      }
      if (part == 0) selmask[tok] = msk;
    }
    __syncthreads();
#pragma unroll
    for (int t2 = 0; t2 < 2; ++t2) selm[t2] = selmask[th * 32 + t2 * 16 + r15];
#pragma unroll
    for (int t2 = 0; t2 < 2; ++t2) { m[t2] = -1e30f; l[t2] = 0.f; }
#pragma unroll
    for (int df = 0; df < 4; ++df)
#pragma unroll
      for (int t2 = 0; t2 < 2; ++t2) o[df][t2] = (f32x4){0.f, 0.f, 0.f, 0.f};
    attn_branch<2>(smem, P.p + (size_t)b * SEQ * LD1 + 1536 + g * 64, P.p + (size_t)b * SEQ * LD1 + 1792 + g * 64, LD1, 0, n, n, th, qf, m, l, o, selm);
    {
      int tbase = t0 + r15; asm volatile("" : "+v"(tbase));
#pragma unroll
      for (int t2 = 0; t2 < 2; ++t2) {
        const size_t tok = (size_t)(tbase + t2 * 16);
        float lt = l[t2];
        lt += __shfl_xor(lt, 16); lt += __shfl_xor(lt, 32);
        const float gs = sigmoidf((float)P.p[tok * LD1 + 3584 + hd * 3 + 1] + P.nsa_b_gate[hd * 3 + 1]) / lt;
#pragma unroll
        for (int df = 0; df < 4; ++df) {
          half4* dst = (half4*)(P.og + tok * DM + hd * 64 + df * 16 + 4 * q);
          const half4 pv = *dst;
          const f32x4 v = o[df][t2] * gs;
          half4 hv; hv[0] = (half_t)(v[0] + (float)pv[0]); hv[1] = (half_t)(v[1] + (float)pv[1]); hv[2] = (half_t)(v[2] + (float)pv[2]); hv[3] = (half_t)(v[3] + (float)pv[3]);
          *dst = hv;
        }
      }
    }
#pragma unroll
    for (int t2 = 0; t2 < 2; ++t2) { m[t2] = -1e30f; l[t2] = 0.f; }
#pragma unroll
    for (int df = 0; df < 4; ++df)
#pragma unroll
      for (int t2 = 0; t2 < 2; ++t2) o[df][t2] = (f32x4){0.f, 0.f, 0.f, 0.f};
    attn_branch<3>(smem, P.p + (size_t)b * SEQ * LD1 + 2048 + g * 64, P.p + (size_t)b * SEQ * LD1 + 2304 + g * 64, LD1, (n > 8 ? n - 8 : 0), n, n, th, qf, m, l, o, selm);
    {
      int tbase = t0 + r15; asm volatile("" : "+v"(tbase));
#pragma unroll
      for (int t2 = 0; t2 < 2; ++t2) {
        const size_t tok = (size_t)(tbase + t2 * 16);
        float lt = l[t2];
        lt += __shfl_xor(lt, 16); lt += __shfl_xor(lt, 32);
        const float gw = sigmoidf((float)P.p[tok * LD1 + 3584 + hd * 3 + 2] + P.nsa_b_gate[hd * 3 + 2]) / lt;
#pragma unroll
        for (int df = 0; df < 4; ++df) {
          half4* dst = (half4*)(P.og + tok * DM + hd * 64 + df * 16 + 4 * q);
          const half4 pv = *dst;
          const half4 z = *(const half4*)(P.p + tok * LD1 + 2560 + hd * 64 + df * 16 + 4 * q);
          const f32x4 v = o[df][t2] * gw;
          half4 hv;
#pragma unroll
          for (int e = 0; e < 4; ++e) hv[e] = (half_t)((v[e] + (float)pv[e]) * siluf((float)z[e]));
          *dst = hv;
        }
      }
    }
  }
}

constexpr int NPHASES = 13;
__device__ __forceinline__ void run_phase(int ph, const Params& P, char* smem) {
  float* sm = (float*)smem;
  switch (ph) {
    case 0:
      ph_xh_rstd(P.x, P.xh, P.rstd); ph_ropetab(P); prep_cbias_part(P);
      prep_wT(P.gla_w_in, GLA_IN, P.pre_norm, P.W0t, LD0, DM, 0, sm);
      prep_wT(P.gla_w_out, DM, nullptr, P.Wo0t, DM, DM, 2, sm);
      prep_wT(P.nsa_w_in, NSA_IN, P.pre_norm + DM, P.W1t, LD1, DM, 1, sm);
      prep_wT(P.nsa_w_out, DM, nullptr, P.Wo1t, DM, DM, 2, sm);
      prep_wT(P.ck_w1, 256, nullptr, P.cw1t, 256, 2048, 2, sm);
      prep_wT(P.cv_w1, 256, nullptr, P.cw1t + 256 * 2048, 256, 2048, 2, sm);
      prep_wT(P.ck_w2, 64, nullptr, P.cw2t, 256, 256, 4, sm);
      prep_wT(P.cv_w2, 64, nullptr, P.cw2t + 256 * 256, 256, 256, 4, sm);
      break;
    case 1: g8::gemm(g8::SrcPlain8{P.xh, DM, P.W0t, DM}, T_TOK, LD0, DM, g8::EpiStore8{P.p, LD0, P.rstd}, smem); break;
    case 2: prep_cbias_reduce(P); ph_gla_prep(P, sm); break;
    case 3: ph_gla_mfma(P, smem); break;
    case 4: ph_gla_post(P); break;
    case 5: g8::gemm(g8::SrcPlain8{P.og, DM, P.Wo0t, DM}, T_TOK, DM, DM, g8::EpiStore8{P.y, DM, nullptr}, smem); break;
    case 6: ph_post(P.x, P.y, P.post_norm, P.out, P.xh, P.rstd); break;
    case 7: g8::gemm(g8::SrcPlain8{P.xh, DM, P.W1t, DM}, T_TOK, LD1, DM, g8::EpiRope8{P.p, LD1, P.rstd, P.ropetab}, smem); break;
    case 8: g8::gemm(g8::SrcCmp1_8{P.p, P.cw1t}, 16384, 256, 2048, g8::EpiCmpHid8{P.hid, P.cbias}, smem); break;
    case 9: g8::gemm(g8::SrcCmp2_8{P.hid, P.cw2t}, 16384, 256, 256, g8::EpiCmpOut8{P.kcmp, P.vcmp}, smem); break;
    case 10: ph_attn_mfma(P, smem); break;
    case 11: g8::gemm(g8::SrcPlain8{P.og, DM, P.Wo1t, DM}, T_TOK, DM, DM, g8::EpiStore8{P.y, DM, nullptr}, smem); break;
    case 12: ph_post(P.out, P.y, P.post_norm + DM, P.out, nullptr, nullptr); break;
  }
}

template <int PH>
__global__ void __launch_bounds__(NTHREADS, 2) k_phase(Params P) {
  __shared__ __attribute__((aligned(16))) char smem[SMEM_BYTES];
  run_phase(PH, P, smem);
}
template <int PH>
static void launch_phases(const Params& P, hipStream_t stream) {
  hipLaunchKernelGGL((k_phase<PH>), dim3(256), dim3(NTHREADS), 0, stream, P);
  if constexpr (PH + 1 < NPHASES) launch_phases<PH + 1>(P, stream);
}

#if MEGA
__global__ void __launch_bounds__(NTHREADS, 2) k_mega(Params P) {
  __shared__ __attribute__((aligned(16))) char smem[SMEM_BYTES];
  cg::grid_group grid = cg::this_grid();
  if (P.use_cg_sync) grid.sync();
  unsigned bt = 0;
  run_phase(0, P, smem); fast_barrier(P.bar, bt);
  run_phase(1, P, smem); fast_barrier(P.bar, bt);
  run_phase(2, P, smem); fast_barrier(P.bar, bt);
  run_phase(3, P, smem); fast_barrier(P.bar, bt);
  run_phase(4, P, smem); fast_barrier(P.bar, bt);
  run_phase(5, P, smem); fast_barrier(P.bar, bt);
  run_phase(6, P, smem); fast_barrier(P.bar, bt);
  run_phase(7, P, smem); fast_barrier(P.bar, bt);
  run_phase(8, P, smem); fast_barrier(P.bar, bt);
  run_phase(9, P, smem); fast_barrier(P.bar, bt);
  run_phase(10, P, smem); fast_barrier(P.bar, bt);
  run_phase(11, P, smem); fast_barrier(P.bar, bt);
  run_phase(12, P, smem);
}
#endif

extern "C" void kernel_launch(void* const* d_in, const int* in_sizes, int n_in, void* d_out, int out_size, void* d_ws, size_t ws_size,
                              hipStream_t stream) {
  Params P{};
  P.x = (const float*)d_in[0]; P.pos = (const int*)d_in[1]; P.pre_norm = (const float*)d_in[2]; P.post_norm = (const float*)d_in[3];
  P.gla_w_in = (const float*)d_in[4]; P.gla_w_gk_up = (const float*)d_in[5]; P.gla_b_gk = (const float*)d_in[6];
  P.gla_head_norm = (const float*)d_in[7]; P.gla_w_out = (const float*)d_in[8];
  P.nsa_w_in = (const float*)d_in[9]; P.nsa_b_gate = (const float*)d_in[10]; P.nsa_pe_k = (const float*)d_in[11]; P.nsa_pe_v = (const float*)d_in[12];
  P.ck_w1 = (const float*)d_in[13]; P.ck_w2 = (const float*)d_in[14]; P.cv_w1 = (const float*)d_in[15]; P.cv_w2 = (const float*)d_in[16];
  P.nsa_w_out = (const float*)d_in[17];
  P.out = (float*)d_out;
  char* ws = (char*)d_ws;
  const size_t MB = 1024 * 1024;
  P.W0t = (half_t*)(ws);
  P.Wo0t = (half_t*)(ws + 7 * MB);
  P.W1t = (half_t*)(ws + 9 * MB);
  P.Wo1t = (half_t*)(ws + 17 * MB);
  P.cw1t = (half_t*)(ws + 19 * MB);
  P.cw2t = (half_t*)(ws + 21 * MB);
  P.cbias = (float*)(ws + 22 * MB);
  P.cbias_part = (float*)(ws + 22 * MB + 4096);
  P.bar = (unsigned*)(ws + 23 * MB);
  P.use_cg_sync = 0;
  P.xh = (half_t*)(ws + 24 * MB);
  P.p = (half_t*)(ws + 88 * MB);
  P.y = (half_t*)(ws + 88 * MB);
  P.og = (half_t*)(ws + 328 * MB);
  P.bcum = (float*)(ws + 392 * MB);
  P.rstd = (float*)(ws + 456 * MB);
  P.kcmp = (half_t*)(ws + 457 * MB);
  P.vcmp = (half_t*)(ws + 458 * MB);
  P.ropetab = (float*)(ws + 459 * MB);
  P.hid = (half_t*)(ws + 467 * MB);
  if (ws_size < 476 * MB) { fprintf(stderr, "ws too small: %zu\n", ws_size); return; }
#if MEGA
  static int grid_blocks = 0;
  if (!grid_blocks) {
    int dev = 0, cus = 0, per_cu = 0;
    hipGetDevice(&dev);
    hipDeviceGetAttribute(&cus, hipDeviceAttributeMultiprocessorCount, dev);
    hipOccupancyMaxActiveBlocksPerMultiprocessor(&per_cu, k_mega, NTHREADS, 0);
    if (per_cu < 1) per_cu = 1;
    if (per_cu > 1) per_cu = 1;
    grid_blocks = cus * per_cu;
  }
  hipMemsetAsync(ws + 23 * MB, 0, 16384, stream);
  void* args[] = {&P};
  hipError_t e = hipLaunchCooperativeKernel((void*)k_mega, dim3(grid_blocks), dim3(NTHREADS), args, 0, stream);
  if (e != hipSuccess) fprintf(stderr, "cooperative launch failed: %s (grid %d)\n", hipGetErrorString(e), grid_blocks);
#else
  launch_phases<0>(P, stream);
#endif
}
```

```cpp
#include <hip/hip_runtime.h>
#include <hip/hip_cooperative_groups.h>
#include <cstdio>
#include <cstdint>
namespace cg = cooperative_groups;

typedef _Float16 half_t;
typedef _Float16 half8 __attribute__((ext_vector_type(8)));
typedef _Float16 half4 __attribute__((ext_vector_type(4)));
typedef float f32x4 __attribute__((ext_vector_type(4)));
typedef int v2i __attribute__((ext_vector_type(2)));
typedef int v4i __attribute__((ext_vector_type(4)));

#ifndef MEGA
#define MEGA 1
#endif

constexpr int T_TOK = 32768, DM = 1024, SEQ = 4096, NBATCH = 8;
constexpr int GLA_IN = 3088, NSA_IN = 3632;
constexpr int LD0 = 3328, LD1 = 3840;
constexpr int NC = 255;
constexpr float EPS = 1e-6f;
constexpr int NTHREADS = 512, NWAVES = NTHREADS / 64;
constexpr int SMEM_BYTES = 160 * 1024;

struct Params {
  const float* x; const int* pos; const float* pre_norm; const float* post_norm;
  const float* gla_w_in; const float* gla_w_gk_up; const float* gla_b_gk; const float* gla_head_norm; const float* gla_w_out;
  const float* nsa_w_in; const float* nsa_b_gate; const float* nsa_pe_k; const float* nsa_pe_v;
  const float* ck_w1; const float* ck_w2; const float* cv_w1; const float* cv_w2; const float* nsa_w_out;
  float* out;
  half_t* p; half_t* y; half_t* og; float* bcum; float* rstd; half_t* kcmp; half_t* vcmp; float* ropetab;
  half_t* xh; half_t* W0t; half_t* Wo0t; half_t* W1t; half_t* Wo1t;
  half_t* cw1t; half_t* cw2t; float* cbias; half_t* hid;
  float* cbias_part; unsigned* bar; long long use_cg_sync; unsigned* kmax2;
};

__device__ __forceinline__ int lane_id() { return (int)__builtin_amdgcn_mbcnt_hi(~0u, __builtin_amdgcn_mbcnt_lo(~0u, 0u)); }
__device__ __forceinline__ int otid(int wvs) { int t = wvs * 64 + lane_id(); asm volatile("" : "+v"(t)); return t; }
__device__ __forceinline__ float wave_sum(float v) {
#pragma unroll
  for (int o = 32; o > 0; o >>= 1) v += __shfl_xor(v, o);
  return v;
}
__device__ __forceinline__ float wave_max(float v) {
#pragma unroll
  for (int o = 32; o > 0; o >>= 1) v = fmaxf(v, __shfl_xor(v, o));
  return v;
}
typedef __attribute__((address_space(3))) void lds_void;
typedef __attribute__((address_space(1))) const void gbl_void;
typedef short s16x4 __attribute__((vector_size(8)));
typedef __attribute__((address_space(3))) s16x4 lds_s16x4;
__device__ __forceinline__ half4 tr_read4(const char* p) {
  const s16x4 v = __builtin_amdgcn_ds_read_tr16_b64_v4i16((lds_s16x4*)(p));
  return __builtin_bit_cast(half4, v);
}
constexpr float LOG2E = 1.4426950408889634f;
__device__ __forceinline__ float fexp2(float x) { return __builtin_amdgcn_exp2f(x); }
typedef unsigned u32x2 __attribute__((ext_vector_type(2)));
__device__ __forceinline__ float rowmax4(float x) {
  u32x2 r = __builtin_amdgcn_permlane16_swap(__float_as_uint(x), __float_as_uint(x), false, false);
  x = fmaxf(__uint_as_float(r[0]), __uint_as_float(r[1]));
  r = __builtin_amdgcn_permlane32_swap(__float_as_uint(x), __float_as_uint(x), false, false);
  return fmaxf(__uint_as_float(r[0]), __uint_as_float(r[1]));
}
__device__ __forceinline__ float rowsum4(float x) {
  u32x2 r = __builtin_amdgcn_permlane16_swap(__float_as_uint(x), __float_as_uint(x), false, false);
  x = __uint_as_float(r[0]) + __uint_as_float(r[1]);
  r = __builtin_amdgcn_permlane32_swap(__float_as_uint(x), __float_as_uint(x), false, false);
  return __uint_as_float(r[0]) + __uint_as_float(r[1]);
}
__device__ __forceinline__ float siluf(float v) { return v / (1.f + expf(-v)); }
__device__ __forceinline__ float sigmoidf(float v) { return 1.f / (1.f + expf(-v)); }
__device__ __forceinline__ float logsigmoidf(float u) { return fminf(u, 0.f) - log1pf(expf(-fabsf(u))); }

__device__ __forceinline__ void fast_barrier(unsigned* bar, unsigned& round, int wvs) {
  asm volatile("s_waitcnt vmcnt(0) lgkmcnt(0)" ::: "memory");
  __syncthreads();
  round += 1;
  if (wvs == 0 && lane_id() == 0) {
    __builtin_amdgcn_fence(__ATOMIC_RELEASE, "agent");
    asm volatile("s_waitcnt vmcnt(0)" ::: "memory");
    const unsigned ngroups = gridDim.x >> 4;
    const unsigned old = __hip_atomic_fetch_add(bar + 64 + 64 * (blockIdx.x >> 4), 1u, __ATOMIC_RELAXED, __HIP_MEMORY_SCOPE_AGENT);
    if (old + 1 == round * 16u) __hip_atomic_fetch_add(bar, 1u, __ATOMIC_RELAXED, __HIP_MEMORY_SCOPE_AGENT);
    const unsigned target = round * ngroups;
    while (__hip_atomic_load(bar, __ATOMIC_RELAXED, __HIP_MEMORY_SCOPE_AGENT) < target) __builtin_amdgcn_s_sleep(1);
    __builtin_amdgcn_fence(__ATOMIC_ACQUIRE, "agent");
    asm volatile("s_waitcnt vmcnt(0)" ::: "memory");
  }
  __syncthreads();
}

__device__ void ph_xh_rstd(const float* src, half_t* xh, float* rstd, int wvs) {
  const int tid_ = otid(wvs); const int lane = tid_ & 63, w = tid_ >> 6;
  for (int row = blockIdx.x * NWAVES + w; row < T_TOK; row += gridDim.x * NWAVES) {
    const float4* r = (const float4*)(src + (size_t)row * DM);
    half4* xr = (half4*)(xh + (size_t)row * DM);
    float ss = 0.f;
#pragma unroll
    for (int i = 0; i < 4; ++i) {
      const float4 v = r[lane + 64 * i];
      ss += v.x * v.x + v.y * v.y + v.z * v.z + v.w * v.w;
      half4 hv; hv[0] = (half_t)v.x; hv[1] = (half_t)v.y; hv[2] = (half_t)v.z; hv[3] = (half_t)v.w;
      xr[lane + 64 * i] = hv;
    }
    ss = wave_sum(ss);
    if (lane == 0) rstd[row] = rsqrtf(ss * (1.f / DM) + EPS);
  }
}
__device__ void ph_ropetab(const Params& P, int wvs) {
  for (int idx = blockIdx.x * NTHREADS + otid(wvs); idx < T_TOK * 32; idx += gridDim.x * NTHREADS) {
    const int t = idx >> 5, i = idx & 31;
    const float inv = powf(10000.f, -(float)(2 * i) / 64.f);
    const float ang = (float)P.pos[t] * inv;
    float s, c; sincosf(ang, &s, &c);
    P.ropetab[t * 64 + i] = c; P.ropetab[t * 64 + 32 + i] = s;
  }
}
__device__ __forceinline__ int orig_col(int n, int mode) {
  if (mode == 0) {
    if (n < 2048) return n;
    if (n < 3072) return n + 16;
    if (n < 3088) return n - 1024;
    return -1;
  } else if (mode == 1) {
    if (n < 2560) return n;
    if (n < 3584) return n + 48;
    if (n < 3632) return n - 1024;
    return -1;
  }
  if (mode == 4) return n < 64 ? n : -1;
  return n;
}
__device__ void prep_wT(const float* W, int ldw, const float* gamma, half_t* Wt, int Npad, int K, int mode, float* sm, int wvs) {
  float(*tile)[65] = (float(*)[65])sm;
  const int tid = otid(wvs);
  const int ntn = Npad / 64, ntk = K / 64;
  for (int t = blockIdx.x; t < ntn * ntk; t += gridDim.x) {
    const int n0 = (t / ntk) * 64, k0 = (t % ntk) * 64;
    __syncthreads();
#pragma unroll 4
    for (int r = 0; r < 4096 / NTHREADS; ++r) {
      const int idx = tid + r * NTHREADS, kk = idx >> 6, nn = idx & 63;
      const int on = orig_col(n0 + nn, mode);
      float v = 0.f;
      if (on >= 0) { v = W[(size_t)(k0 + kk) * ldw + on]; if (gamma) v *= gamma[k0 + kk]; }
      tile[kk][nn] = v;
    }
    __syncthreads();
#pragma unroll 4
    for (int r = 0; r < 4096 / NTHREADS; ++r) {
      const int idx = tid + r * NTHREADS, nn = idx >> 6, kk = idx & 63;
      Wt[(size_t)(n0 + nn) * K + k0 + kk] = (half_t)tile[kk][nn];
    }
  }
}

__device__ void prep_cbias_part(const Params& P, int wvs) {
  for (int idx = blockIdx.x * NTHREADS + otid(wvs); idx < 2 * 32 * 256; idx += gridDim.x * NTHREADS) {
    const int j = idx & 255, ks = (idx >> 8) & 31, which = idx >> 13;
    const float* pe = which ? P.nsa_pe_v : P.nsa_pe_k;
    const float* w1 = which ? P.cv_w1 : P.ck_w1;
    float a = 0.f;
#pragma unroll 8
    for (int k = ks * 64; k < ks * 64 + 64; ++k) a += pe[k] * w1[(size_t)k * 256 + j];
    P.cbias_part[idx] = a;
  }
}
__device__ void prep_cbias_reduce(const Params& P, int wvs) {
  if (blockIdx.x < 2 && otid(wvs) < 256) {
    const int which = blockIdx.x, j = otid(wvs);
    float a = 0.f;
    for (int ks = 0; ks < 32; ++ks) a += P.cbias_part[(which * 32 + ks) * 256 + j];
    P.cbias[which * 256 + j] = a;
  }
}

namespace g8 {
constexpr int BK = 64, HALF = 128, HTB = HALF * BK * 2;
__device__ __forceinline__ int lds_byte(int r, int c) { const int st = (r >> 4) * 2 + (c >> 5), rr = r & 15, cc = c & 31, ob = rr * 64 + cc * 2; return st * 1024 + (ob ^ (((ob >> 9) & 1) << 5)); }
__device__ __forceinline__ void stage_rc(int b, int& R, int& C) { const int st = b / 1024, sb = b % 1024, swz = sb ^ (((sb >> 9) & 1) << 5); R = (st >> 1) * 16 + swz / 64; C = (st & 1) * 32 + (swz % 64) / 2; }
__device__ __forceinline__ int cbase(int wc, int n) { return 64 * (wc >> 1) + 32 * n + 16 * (wc & 1); }
typedef f32x4 Acc[2][2][4][2];

struct SrcPlain8 {
  const half_t* A; int lda; const half_t* Bt; int K;
  __device__ __forceinline__ void get(int pm, int pn, const half_t*& Ag, const half_t*& Bg, size_t& a_rs, int& a_ks) const {
    Ag = A + (size_t)pm * 256 * lda; Bg = Bt + (size_t)pn * 256 * K; a_rs = lda; a_ks = 64;
  }
};
struct SrcCmp1_8 {
  const half_t* p1; const half_t* w1t;
  __device__ __forceinline__ void get(int pm, int pn, const half_t*& Ag, const half_t*& Bg, size_t& a_rs, int& a_ks) const {
    const int which = pm >> 5, bg = pm & 31, b = bg >> 2, g = bg & 3;
    Ag = p1 + (size_t)(b * SEQ) * LD1 + (which ? 1280 : 1024) + g * 64;
    Bg = w1t + (size_t)which * 256 * 2048; a_rs = (size_t)16 * LD1; a_ks = LD1;
  }
};
struct SrcCmp2_8 {
  const half_t* hid; const half_t* w2t;
  __device__ __forceinline__ void get(int pm, int pn, const half_t*& Ag, const half_t*& Bg, size_t& a_rs, int& a_ks) const {
    Ag = hid + (size_t)pm * 256 * 256; Bg = w2t + (size_t)(pm >> 5) * 256 * 256; a_rs = 256; a_ks = 64;
  }
};

struct EpiStore8 {
  half_t* C; int ldc; const float* rowscale;
  __device__ __forceinline__ void operator()(const Acc& acc, int row0, int col0, int wr, int wc, int fr, int fq) const {
#pragma unroll
    for (int ai = 0; ai < 2; ++ai)
#pragma unroll
      for (int m = 0; m < 4; ++m) {
        const int tok = row0 + ai * 128 + wr * 64 + m * 16 + fr;
        const float s = rowscale ? rowscale[tok] : 1.f;
        half_t* rowp = C + (size_t)tok * ldc + col0 + 4 * fq;
#pragma unroll
        for (int bj = 0; bj < 2; ++bj)
#pragma unroll
          for (int n = 0; n < 2; ++n) {
            const f32x4 v = acc[ai][bj][m][n] * s;
            half4 hv; hv[0] = (half_t)v[0]; hv[1] = (half_t)v[1]; hv[2] = (half_t)v[2]; hv[3] = (half_t)v[3];
            *(half4*)(rowp + bj * 128 + cbase(wc, n)) = hv;
          }
      }
  }
};
struct EpiRope8 {
  half_t* C; int ldc; const float* rowscale; const float* ropetab;
  __device__ __forceinline__ void operator()(const Acc& acc, int row0, int col0, int wr, int wc, int fr, int fq) const {
#pragma unroll
    for (int bj = 0; bj < 2; ++bj) {
      const int grp = (col0 + bj * 128 + 64 * (wc >> 1)) >> 6;
      const bool is_q = grp < 16;
      const bool roped = is_q || (grp >= 16 && grp < 20) || (grp >= 24 && grp < 28) || (grp >= 32 && grp < 36);
      const float sc = is_q ? 0.125f : 1.f;
#pragma unroll
      for (int ai = 0; ai < 2; ++ai)
#pragma unroll
        for (int m = 0; m < 4; ++m) {
          const int tok = row0 + ai * 128 + wr * 64 + m * 16 + fr;
          const float s = rowscale[tok];
          half_t* rowp = C + (size_t)tok * ldc + col0 + bj * 128 + 4 * fq;
          f32x4 o1 = acc[ai][bj][m][0] * s, o2 = acc[ai][bj][m][1] * s;
          if (roped) {
            const f32x4 cs = *(const f32x4*)(ropetab + (size_t)tok * 64 + 16 * (wc & 1) + 4 * fq);
            const f32x4 sn = *(const f32x4*)(ropetab + (size_t)tok * 64 + 32 + 16 * (wc & 1) + 4 * fq);
            const f32x4 x1 = o1, x2 = o2;
            o1 = (x1 * cs - x2 * sn) * sc; o2 = (x2 * cs + x1 * sn) * sc;
          }
          half4 h1, h2;
#pragma unroll
          for (int e = 0; e < 4; ++e) { h1[e] = (half_t)o1[e]; h2[e] = (half_t)o2[e]; }
          *(half4*)(rowp + cbase(wc, 0)) = h1;
          *(half4*)(rowp + cbase(wc, 1)) = h2;
        }
    }
  }
};
struct EpiCmpHid8 {
  half_t* hid; const float* bias;
  __device__ __forceinline__ void operator()(const Acc& acc, int row0, int col0, int wr, int wc, int fr, int fq) const {
    const int which = row0 >> 13;
#pragma unroll
    for (int bj = 0; bj < 2; ++bj)
#pragma unroll
      for (int n = 0; n < 2; ++n) {
        const int col = col0 + bj * 128 + cbase(wc, n) + 4 * fq;
        const f32x4 bv = *(const f32x4*)(bias + which * 256 + col);
#pragma unroll
        for (int ai = 0; ai < 2; ++ai)
#pragma unroll
          for (int m = 0; m < 4; ++m) {
            const int row = row0 + ai * 128 + wr * 64 + m * 16 + fr;
            const f32x4 v = acc[ai][bj][m][n] + bv;
            half4 hv; hv[0] = (half_t)siluf(v[0]); hv[1] = (half_t)siluf(v[1]); hv[2] = (half_t)siluf(v[2]); hv[3] = (half_t)siluf(v[3]);
            *(half4*)(hid + (size_t)row * 256 + col) = hv;
          }
      }
  }
};
struct EpiCmpOut8 {
  half_t* kcmp; half_t* vcmp;
  __device__ __forceinline__ void operator()(const Acc& acc, int row0, int col0, int wr, int wc, int fr, int fq) const {
    if (wc >= 2) return;
#pragma unroll
    for (int ai = 0; ai < 2; ++ai)
#pragma unroll
      for (int m = 0; m < 4; ++m) {
        const int row = row0 + ai * 128 + wr * 64 + m * 16 + fr;
        const int which = row >> 13, r = row & 8191;
        half_t* dst = (which ? vcmp : kcmp) + (size_t)r * 64 + 4 * fq;
        const bool dead = (r & 255) == 255;
#pragma unroll
        for (int n = 0; n < 2; ++n) {
          const f32x4 v = acc[ai][0][m][n];
          half4 hv; hv[0] = (half_t)v[0]; hv[1] = (half_t)v[1]; hv[2] = (half_t)v[2]; hv[3] = (half_t)v[3];
          if (dead) hv = (half4){(half_t)0.f, (half_t)0.f, (half_t)0.f, (half_t)0.f};
          *(half4*)(dst + cbase(wc, n)) = hv;
        }
      }
  }
};

template <class Src, class Epi>
__device__ void gemm(const Src& src, int M, int N, int K, const Epi& epi, char* smem, int wvs) {
  const int tid = otid(wvs), wid = __builtin_amdgcn_readfirstlane(tid >> 6), lane = tid & 63, wr = wid >> 2, wc = wid & 3, fr = lane & 15, fq = lane >> 4;
  const int nM = M / 256, nN = N / 256, nwg = nM * nN, G = gridDim.x, nt = K / BK;
  int sr0, sc0, sr1, sc1;
  stage_rc(tid * 16, sr0, sc0); stage_rc(tid * 16 + 8192, sr1, sc1);
  const int a_base = lds_byte(wr * 64 + fr, fq * 8);
  int b_base = 65536 + lds_byte(cbase(wc, 0) + fr, fq * 8);
  asm volatile("" : "+v"(b_base));
#define SA8(b, h) (smem + ((b) * 2 + (h)) * HTB)
#define SB8(b, h) (smem + (4 + (b) * 2 + (h)) * HTB)
#define STAGE_A(P, h, kt) { const char* g_ = (const char*)(Ag + (size_t)(h) * 128 * lda + (size_t)(kt) * a_ks); \
    __builtin_amdgcn_global_load_lds((gbl_void*)(g_ + aob0), (lds_void*)((P) + wid * 1024), 16, 0, 0); \
    __builtin_amdgcn_global_load_lds((gbl_void*)(g_ + aob1), (lds_void*)((P) + 8192 + wid * 1024), 16, 0, 0); }
#define STAGE_B(P, h, kt) { const char* g_ = (const char*)(Bg + (size_t)(h) * 128 * K + (size_t)(kt) * 64); \
    __builtin_amdgcn_global_load_lds((gbl_void*)(g_ + bob0), (lds_void*)((P) + wid * 1024), 16, 0, 0); \
    __builtin_amdgcn_global_load_lds((gbl_void*)(g_ + bob1), (lds_void*)((P) + 8192 + wid * 1024), 16, 0, 0); }
#define LDA8(dst, b, h) { _Pragma("unroll") for (int m = 0; m < 4; ++m) _Pragma("unroll") for (int k = 0; k < 2; ++k) dst[m][k] = *(const half8*)(SA8(b, h) + a_base + m * 2048 + k * 1024); }
#define LDB8(dst, b, h) { _Pragma("unroll") for (int n = 0; n < 2; ++n) _Pragma("unroll") for (int k = 0; k < 2; ++k) dst[n][k] = *(const half8*)(smem + ((b) * 2 + (h)) * HTB + b_base + n * 4096 + k * 1024); }
#define MMA8(ai, bj, At, Bx) { __builtin_amdgcn_s_setprio(1); \
    _Pragma("unroll") for (int m = 0; m < 4; ++m) _Pragma("unroll") for (int n = 0; n < 2; ++n) _Pragma("unroll") for (int k = 0; k < 2; ++k) \
      acc[ai][bj][m][n] = __builtin_amdgcn_mfma_f32_16x16x32_f16(Bx[n][k], At[m][k], acc[ai][bj][m][n], 0, 0, 0); \
    __builtin_amdgcn_s_setprio(0); }
#define WAIT_V(n) asm volatile("s_waitcnt vmcnt(" #n ")" ::: "memory")
#define WAIT_L(n) asm volatile("s_waitcnt lgkmcnt(" #n ")" ::: "memory")
#define BAR __builtin_amdgcn_s_barrier()
#define SCHED __builtin_amdgcn_sched_barrier(0)
  for (int it = 0;; ++it) {
    const int L = it * G + (int)blockIdx.x;
    if (L >= nwg) break;
    int wgid;
    { const int q = nwg / 8, r = nwg % 8, xcd = L % 8, off = L / 8; wgid = (xcd < r ? xcd * (q + 1) : r * (q + 1) + (xcd - r) * q) + off; }
    const int nig = 8 * nN, gid = wgid / nig, fm = gid * 8, gsz = (nM - fm) < 8 ? (nM - fm) : 8;
    const int pm = fm + ((wgid % nig) % gsz), pn = (wgid % nig) / gsz;
    const half_t* Ag; const half_t* Bg; size_t lda; int a_ks;
    src.get(pm, pn, Ag, Bg, lda, a_ks);
    const unsigned aob0 = (unsigned)(((size_t)sr0 * lda + sc0) * 2), aob1 = (unsigned)(((size_t)sr1 * lda + sc1) * 2);
    const unsigned bob0 = (unsigned)((sr0 * K + sc0) * 2), bob1 = (unsigned)((sr1 * K + sc1) * 2);
    Acc acc;
#pragma unroll
    for (int a = 0; a < 2; ++a)
#pragma unroll
      for (int b = 0; b < 2; ++b)
#pragma unroll
        for (int m = 0; m < 4; ++m)
#pragma unroll
          for (int n = 0; n < 2; ++n) acc[a][b][m][n] = (f32x4){0.f, 0.f, 0.f, 0.f};
    half8 At[4][2], B0[2][2], B1[2][2];
    STAGE_B(SB8(0, 0), 0, 0) STAGE_A(SA8(0, 0), 0, 0)
    STAGE_B(SB8(0, 1), 1, 0) STAGE_A(SA8(0, 1), 1, 0)
    if (wr == 1) BAR;
    WAIT_V(4); BAR;
    STAGE_B(SB8(1, 0), 0, 1) STAGE_A(SA8(1, 0), 0, 1) STAGE_B(SB8(1, 1), 1, 1)
    WAIT_V(6); BAR;
#pragma unroll 1
    for (int t = 0; t < nt - 2; t += 2) {
      LDB8(B0, 0, 0) SCHED; LDA8(At, 0, 0) STAGE_A(SA8(1, 1), 1, t + 1)
      WAIT_L(8); BAR; WAIT_L(0); MMA8(0, 0, At, B0) BAR; SCHED;
      LDB8(B1, 0, 1) STAGE_B(SB8(0, 0), 0, t + 2)
      BAR; WAIT_L(0); MMA8(0, 1, At, B1) BAR;
      LDA8(At, 0, 1) STAGE_A(SA8(0, 0), 0, t + 2)
      BAR; WAIT_L(0); MMA8(1, 0, At, B0) BAR; SCHED;
      STAGE_B(SB8(0, 1), 1, t + 2)
      WAIT_V(6); BAR; MMA8(1, 1, At, B1) BAR;
      LDB8(B0, 1, 0) SCHED; LDA8(At, 1, 0) STAGE_A(SA8(0, 1), 1, t + 2)
      WAIT_L(8); BAR; WAIT_L(0); MMA8(0, 0, At, B0) BAR; SCHED;
      LDB8(B1, 1, 1) STAGE_B(SB8(1, 0), 0, t + 3)
      BAR; WAIT_L(0); MMA8(0, 1, At, B1) BAR;
      LDA8(At, 1, 1) STAGE_A(SA8(1, 0), 0, t + 3)
      BAR; WAIT_L(0); MMA8(1, 0, At, B0) BAR; SCHED;
      STAGE_B(SB8(1, 1), 1, t + 3)
      WAIT_V(6); BAR; MMA8(1, 1, At, B1) BAR;
    }
    { LDB8(B0, 0, 0) LDA8(At, 0, 0) STAGE_A(SA8(1, 1), 1, nt - 1)
      BAR; WAIT_L(0); MMA8(0, 0, At, B0) BAR;
      LDB8(B1, 0, 1) BAR; WAIT_L(0); MMA8(0, 1, At, B1) BAR;
      LDA8(At, 0, 1) WAIT_V(4); BAR; WAIT_L(0); MMA8(1, 0, At, B0) MMA8(1, 1, At, B1) BAR; }
    { LDB8(B0, 1, 0) LDA8(At, 1, 0) WAIT_V(2); BAR; WAIT_L(0); MMA8(0, 0, At, B0) BAR;
      LDB8(B1, 1, 1) WAIT_V(0); BAR; WAIT_L(0); MMA8(0, 1, At, B1) BAR;
      LDA8(At, 1, 1) BAR; WAIT_L(0); MMA8(1, 0, At, B0) MMA8(1, 1, At, B1) BAR; }
    if (wr == 0) BAR;
    { int fr2 = fr, fq2 = fq; asm volatile("" : "+v"(fr2), "+v"(fq2)); epi(acc, pm * 256, pn * 256, wr, wc, fr2, fq2); }
  }
#undef SA8
#undef SB8
#undef STAGE_A
#undef STAGE_B
#undef LDA8
#undef LDB8
#undef MMA8
#undef WAIT_V
#undef WAIT_L
#undef BAR
#undef SCHED
}
}

__device__ void ph_gla_prep(const Params& P, float* sm, int wvs) {
  float(*glr)[16] = (float(*)[16])sm;
  const int tid = otid(wvs);
  const float scale = 0.08838834764831845f;
  for (int item = blockIdx.x; item < T_TOK / 64; item += gridDim.x) {
    const int t0 = item * 64;
    __syncthreads();
    for (int idx = tid; idx < 64 * 16; idx += NTHREADS) {
      const int i = idx >> 4, r = idx & 15;
      glr[i][r] = (float)P.p[(size_t)(t0 + i) * LD0 + 3072 + r];
    }
    __syncthreads();
    {
      const int ch = tid;
      float w[16];
#pragma unroll
      for (int r = 0; r < 16; ++r) w[r] = P.gla_w_gk_up[r * 512 + ch];
      const float bb = P.gla_b_gk[ch];
      half_t* qp = P.p + (size_t)t0 * LD0 + ch;
      float cum = 0.f;
#pragma unroll 4
      for (int i = 0; i < 64; ++i) {
        float u = bb;
#pragma unroll
        for (int r = 0; r < 16; ++r) u += glr[i][r] * w[r];
        cum += logsigmoidf(u) * (1.f / 16.f);
        const float ex = exp2f(cum * LOG2E);
        const float qv = (float)qp[(size_t)i * LD0], kv = (float)qp[(size_t)i * LD0 + 512];
        qp[(size_t)i * LD0] = (half_t)(qv * scale * ex);
        qp[(size_t)i * LD0 + 512] = (half_t)(kv * __builtin_amdgcn_rcpf(ex));
        if (i == 63) P.bcum[(size_t)item * 512 + ch] = ex;
      }
    }
  }
}

constexpr int GLA_QE = 0, GLA_KE = 16384, GLA_V = 32768, GLA_DEC = 49152, GLA_BUF = 53248;
#define GLA_TR4(d0, d1, d2, d3, addr, o0, o1, o2, o3) \
  asm volatile("ds_read_b64_tr_b16 %0, %4 offset:%5\n\tds_read_b64_tr_b16 %1, %4 offset:%6\n\tds_read_b64_tr_b16 %2, %4 offset:%7\n\tds_read_b64_tr_b16 %3, %4 offset:%8" \
               : "=&v"(d0), "=&v"(d1), "=&v"(d2), "=&v"(d3) : "v"(addr), "n"(o0), "n"(o1), "n"(o2), "n"(o3) : "memory")
__device__ __forceinline__ half8 pack_h8(const v2i a, const v2i b) { const v4i p = (v4i){a[0], a[1], b[0], b[1]}; return __builtin_bit_cast(half8, p); }

__device__ void ph_gla_mfma(const Params& P, char* smem, int wvs) {
  const int tid = otid(wvs);
  const int lane = tid & 63, wave = __builtin_amdgcn_readfirstlane(tid >> 6), r15 = lane & 15, q = lane >> 4;
  const int qp = r15 >> 2, pp = lane & 3;
  const int srow = tid >> 4, sslot = tid & 15;
  const int src_q = (sslot ^ (srow & 15)) * 8, src_kv = (sslot ^ ((srow & 7) << 1)) * 8;
  const int fk = ((4 * (q & 1) + qp) & 7) << 1;
  const unsigned tr_row = (unsigned)((4 * q + qp) * 256 + 8 * (pp & 1) + ((pp >> 1) << 4));
  for (int item = blockIdx.x; item < NBATCH * 4 * 2; item += gridDim.x) {
    const int b = item >> 3, h = (item >> 1) & 3, vs = item & 1;
    f32x4 S[8];
#pragma unroll
    for (int df = 0; df < 8; ++df) S[df] = (f32x4){0.f, 0.f, 0.f, 0.f};
    const half_t* qsrc = P.p + (size_t)(b * SEQ + srow) * LD0 + h * 128;
    const half_t* vsrc = P.p + (size_t)(b * SEQ + srow) * LD0 + 1024 + h * 256 + vs * 128 + src_kv;
    const float* dsrc = P.bcum + (size_t)(b * 64) * 512 + h * 128 + (lane & 31) * 4;
#define G_ISSUE(N, BUF) { char* lb_ = smem + (BUF) * GLA_BUF + wave * 1024; const size_t ro_ = (size_t)(N) * 64 * LD0; \
      __builtin_amdgcn_global_load_lds((gbl_void*)(qsrc + ro_ + src_q), (lds_void*)(lb_ + GLA_QE), 16, 0, 0); \
      __builtin_amdgcn_global_load_lds((gbl_void*)(qsrc + ro_ + (size_t)32 * LD0 + src_q), (lds_void*)(lb_ + GLA_QE + 8192), 16, 0, 0); \
      __builtin_amdgcn_global_load_lds((gbl_void*)(qsrc + ro_ + 512 + src_kv), (lds_void*)(lb_ + GLA_KE), 16, 0, 0); \
      __builtin_amdgcn_global_load_lds((gbl_void*)(qsrc + ro_ + (size_t)32 * LD0 + 512 + src_kv), (lds_void*)(lb_ + GLA_KE + 8192), 16, 0, 0); \
      __builtin_amdgcn_global_load_lds((gbl_void*)(vsrc + ro_), (lds_void*)(lb_ + GLA_V), 16, 0, 0); \
      __builtin_amdgcn_global_load_lds((gbl_void*)(vsrc + ro_ + (size_t)32 * LD0), (lds_void*)(lb_ + GLA_V + 8192), 16, 0, 0); \
      if (lane < 32) __builtin_amdgcn_global_load_lds((gbl_void*)(dsrc + (size_t)(N) * 512), (lds_void*)(smem + (BUF) * GLA_BUF + GLA_DEC + wave * 512), 16, 0, 0); }
    G_ISSUE(0, 0)
    G_ISSUE(1, 1)
#pragma unroll 1
    for (int n = 0; n < 64; ++n) {
      if (n + 1 < 64) asm volatile("s_waitcnt vmcnt(7)" ::: "memory"); else asm volatile("s_waitcnt vmcnt(0)" ::: "memory");
      __builtin_amdgcn_s_barrier();
      if (n + 2 < 64) G_ISSUE(n + 2, (n + 2) % 3)
      const char* cb = smem + (n % 3) * GLA_BUF;
      f32x4 aT[4][4];
#pragma unroll
      for (int kf = 0; kf < 4; ++kf)
#pragma unroll
        for (int tf = 0; tf < 4; ++tf) aT[kf][tf] = (f32x4){0.f, 0.f, 0.f, 0.f};
#pragma unroll
      for (int ks = 0; ks < 4; ++ks) {
        half8 kef[4], qef[4];
#pragma unroll
        for (int f = 0; f < 4; ++f) {
          kef[f] = *(const half8*)(cb + GLA_KE + (16 * f + r15) * 256 + (((4 * ks + q) ^ ((r15 & 7) << 1)) << 4));
          qef[f] = *(const half8*)(cb + GLA_QE + (16 * f + r15) * 256 + (((4 * ks + q) ^ r15) << 4));
        }
#pragma unroll
        for (int kf = 0; kf < 4; ++kf)
#pragma unroll
          for (int tf = kf; tf < 4; ++tf) aT[kf][tf] = __builtin_amdgcn_mfma_f32_16x16x32_f16(kef[kf], qef[tf], aT[kf][tf], 0, 0, 0);
      }
#pragma unroll
      for (int f = 0; f < 4; ++f)
#pragma unroll
        for (int r = 0; r < 4; ++r) if (4 * q + r > r15) aT[f][f][r] = 0.f;
      const unsigned lds0 = (unsigned)(size_t)cb;
      const unsigned va = lds0 + GLA_V + tr_row + ((((2 * wave) ^ fk)) << 4);
      v2i v00, v01, v10, v11;
      GLA_TR4(v00, v01, v10, v11, va, 0, 4096, 8192, 12288);
      const unsigned ka = lds0 + GLA_KE + tr_row;
      v2i k0[4][4];
#pragma unroll
      for (int df = 0; df < 4; ++df) { const unsigned a_ = ka + ((((2 * df) ^ fk)) << 4); GLA_TR4(k0[df][0], k0[df][1], k0[df][2], k0[df][3], a_, 0, 4096, 8192, 12288); }
      asm volatile("s_waitcnt lgkmcnt(15)" : "+v"(v00), "+v"(v01), "+v"(v10), "+v"(v11) :: "memory");
      __builtin_amdgcn_sched_barrier(0);
      half8 vf[2];
      vf[0] = pack_h8(v00, v01); vf[1] = pack_h8(v10, v11);
      f32x4 o[4];
#pragma unroll
      for (int tf = 0; tf < 4; ++tf) o[tf] = (f32x4){0.f, 0.f, 0.f, 0.f};
#pragma unroll
      for (int ks2 = 0; ks2 < 2; ++ks2)
#pragma unroll
        for (int tf = 2 * ks2; tf < 4; ++tf) {
          half8 pk;
#pragma unroll
          for (int r = 0; r < 4; ++r) { pk[r] = (half_t)aT[2 * ks2][tf][r]; pk[4 + r] = (half_t)aT[2 * ks2 + 1][tf][r]; }
          o[tf] = __builtin_amdgcn_mfma_f32_16x16x32_f16(vf[ks2], pk, o[tf], 0, 0, 0);
        }
#pragma unroll
      for (int ks = 0; ks < 4; ++ks) {
        half8 sf;
#pragma unroll
        for (int r = 0; r < 4; ++r) { sf[r] = (half_t)S[2 * ks][r]; sf[4 + r] = (half_t)S[2 * ks + 1][r]; }
#pragma unroll
        for (int tf = 0; tf < 4; ++tf) {
          const int row = 16 * tf + r15;
          const half4 qa = *(const half4*)(cb + GLA_QE + row * 256 + (((4 * ks + (q >> 1)) ^ r15) << 4) + (q & 1) * 8);
          const half4 qb = *(const half4*)(cb + GLA_QE + row * 256 + (((4 * ks + 2 + (q >> 1)) ^ r15) << 4) + (q & 1) * 8);
          half8 qv;
#pragma unroll
          for (int e = 0; e < 4; ++e) { qv[e] = qa[e]; qv[4 + e] = qb[e]; }
          o[tf] = __builtin_amdgcn_mfma_f32_16x16x32_f16(sf, qv, o[tf], 0, 0, 0);
        }
      }
      {
        const size_t t0 = (size_t)(b * SEQ + n * 64);
#pragma unroll
        for (int tf = 0; tf < 4; ++tf) {
          half4 hv; hv[0] = (half_t)o[tf][0]; hv[1] = (half_t)o[tf][1]; hv[2] = (half_t)o[tf][2]; hv[3] = (half_t)o[tf][3];
          *(half4*)(P.og + (t0 + 16 * tf + r15) * DM + h * 256 + vs * 128 + 16 * wave + 4 * q) = hv;
        }
      }
      v2i k1[4][4];
#pragma unroll
      for (int df = 0; df < 4; ++df) { const unsigned a_ = ka + ((((2 * (df + 4)) ^ fk)) << 4); GLA_TR4(k1[df][0], k1[df][1], k1[df][2], k1[df][3], a_, 0, 4096, 8192, 12288); }
      asm volatile("s_waitcnt lgkmcnt(15)"
                   : "+v"(k0[0][0]), "+v"(k0[0][1]), "+v"(k0[0][2]), "+v"(k0[0][3]), "+v"(k0[1][0]), "+v"(k0[1][1]), "+v"(k0[1][2]), "+v"(k0[1][3]),
                     "+v"(k0[2][0]), "+v"(k0[2][1]), "+v"(k0[2][2]), "+v"(k0[2][3]), "+v"(k0[3][0]), "+v"(k0[3][1]), "+v"(k0[3][2]), "+v"(k0[3][3]) :: "memory");
      __builtin_amdgcn_sched_barrier(0);
#pragma unroll
      for (int df = 0; df < 4; ++df) {
        S[df] = __builtin_amdgcn_mfma_f32_16x16x32_f16(pack_h8(k0[df][0], k0[df][1]), vf[0], S[df], 0, 0, 0);
        S[df] = __builtin_amdgcn_mfma_f32_16x16x32_f16(pack_h8(k0[df][2], k0[df][3]), vf[1], S[df], 0, 0, 0);
      }
      asm volatile("s_waitcnt lgkmcnt(0)"
                   : "+v"(k1[0][0]), "+v"(k1[0][1]), "+v"(k1[0][2]), "+v"(k1[0][3]), "+v"(k1[1][0]), "+v"(k1[1][1]), "+v"(k1[1][2]), "+v"(k1[1][3]),
                     "+v"(k1[2][0]), "+v"(k1[2][1]), "+v"(k1[2][2]), "+v"(k1[2][3]), "+v"(k1[3][0]), "+v"(k1[3][1]), "+v"(k1[3][2]), "+v"(k1[3][3]) :: "memory");
      __builtin_amdgcn_sched_barrier(0);
#pragma unroll
      for (int df = 0; df < 4; ++df) {
        S[df + 4] = __builtin_amdgcn_mfma_f32_16x16x32_f16(pack_h8(k1[df][0], k1[df][1]), vf[0], S[df + 4], 0, 0, 0);
        S[df + 4] = __builtin_amdgcn_mfma_f32_16x16x32_f16(pack_h8(k1[df][2], k1[df][3]), vf[1], S[df + 4], 0, 0, 0);
      }
#pragma unroll
      for (int df = 0; df < 8; ++df) {
        const f32x4 dc = *(const f32x4*)(cb + GLA_DEC + wave * 512 + (16 * df + 4 * q) * 4);
        S[df] *= dc;
      }
    }
    asm volatile("s_waitcnt vmcnt(0)" ::: "memory");
    __builtin_amdgcn_s_barrier();
#undef G_ISSUE
  }
}

__device__ void ph_gla_post(const Params& P, int wvs) {
  const int tid_ = otid(wvs); const int lane = tid_ & 63, h = (tid_ >> 6) & 3;
  for (int t = blockIdx.x * 2 + (tid_ >> 8); t < T_TOK; t += gridDim.x * 2) {
    half4* op = (half4*)(P.og + (size_t)t * DM + h * 256) + lane;
    const half4 hv = *op;
    float v0 = (float)hv[0], v1 = (float)hv[1], v2 = (float)hv[2], v3 = (float)hv[3];
    const float ss = wave_sum(v0 * v0 + v1 * v1 + v2 * v2 + v3 * v3);
    const float r = rsqrtf(ss * (1.f / 256.f) + EPS);
    const float4 hn = ((const float4*)P.gla_head_norm)[lane];
    const half4 z = *((const half4*)(P.p + (size_t)t * LD0 + 2048 + h * 256) + lane);
    half4 o;
    o[0] = (half_t)(v0 * r * hn.x * siluf((float)z[0]));
    o[1] = (half_t)(v1 * r * hn.y * siluf((float)z[1]));
    o[2] = (half_t)(v2 * r * hn.z * siluf((float)z[2]));
    o[3] = (half_t)(v3 * r * hn.w * siluf((float)z[3]));
    *op = o;
  }
}

__device__ void ph_post(const float* base, const half_t* y, const float* g, float* dst, half_t* dsth, float* rstd_out, int wvs) {
  const int tid_ = otid(wvs); const int lane = tid_ & 63, w = tid_ >> 6;
  for (int row = blockIdx.x * NWAVES + w; row < T_TOK; row += gridDim.x * NWAVES) {
    const half4* yr = (const half4*)(y + (size_t)row * DM);
    const float4* br = (const float4*)(base + (size_t)row * DM);
    float4* dr = (float4*)(dst + (size_t)row * DM);
    float4 v[4]; float ss = 0.f;
#pragma unroll
    for (int i = 0; i < 4; ++i) {
      const half4 hv = yr[lane + 64 * i];
      v[i].x = (float)hv[0]; v[i].y = (float)hv[1]; v[i].z = (float)hv[2]; v[i].w = (float)hv[3];
      ss += v[i].x * v[i].x + v[i].y * v[i].y + v[i].z * v[i].z + v[i].w * v[i].w;
    }
    ss = wave_sum(ss);
    const float r = rsqrtf(ss * (1.f / DM) + EPS);
    float s2 = 0.f;
#pragma unroll
    for (int i = 0; i < 4; ++i) {
      const float4 gg = ((const float4*)g)[lane + 64 * i];
      const float4 bb = br[lane + 64 * i];
      float4 o;
      o.x = bb.x + v[i].x * r * gg.x; o.y = bb.y + v[i].y * r * gg.y; o.z = bb.z + v[i].z * r * gg.z; o.w = bb.w + v[i].w * r * gg.w;
      s2 += o.x * o.x + o.y * o.y + o.z * o.z + o.w * o.w;
      dr[lane + 64 * i] = o;
      if (dsth) {
        half4 hv; hv[0] = (half_t)o.x; hv[1] = (half_t)o.y; hv[2] = (half_t)o.z; hv[3] = (half_t)o.w;
        ((half4*)(dsth + (size_t)row * DM))[lane + 64 * i] = hv;
      }
    }
    if (rstd_out) { s2 = wave_sum(s2); if (lane == 0) rstd_out[row] = rsqrtf(s2 * (1.f / DM) + EPS); }
  }
}

__device__ void ph_kmax(const Params& P, int wvs) {
  const int tid = otid(wvs);
  for (int task = blockIdx.x; task < NBATCH * 4 * 2 * 8; task += gridDim.x) {
    const int chunk = task & 7, br = (task >> 3) & 1, bg = task >> 4, b = bg >> 2, g = bg & 3;
    const half_t* kp = P.p + (size_t)(b * SEQ + chunk * 512 + tid) * LD1 + (br ? 2048 : 1536) + g * 64;
    float ss = 0.f;
#pragma unroll
    for (int c = 0; c < 8; ++c) {
      const half8 v = *(const half8*)(kp + c * 8);
#pragma unroll
      for (int e = 0; e < 8; ++e) ss += (float)v[e] * (float)v[e];
    }
    ss = wave_max(ss);
    if ((tid & 63) == 0) __hip_atomic_fetch_max(&P.kmax2[bg * 2 + br], __float_as_uint(ss), __ATOMIC_RELAXED, __HIP_MEMORY_SCOPE_AGENT);
  }
}

constexpr int ATT_NB = 6, ATT_D = 5;
constexpr int ATT_K = 0, ATT_V = ATT_NB * 8192, ATT_IMP = 2 * ATT_NB * 8192, ATT_SELM = ATT_IMP + 64 * 68 * 4;
constexpr int IMPS = 68;
constexpr int ATT_GATE = ATT_SELM + 512;
template <int N> __device__ __forceinline__ void wait_vmcnt() { asm volatile("s_waitcnt vmcnt(%0)" ::"n"(N) : "memory"); }

template <int MODE>
__device__ __forceinline__ void attn_branch(char* smem, const half_t* kbase, const half_t* vbase, int ld, int tile_lo, int tile_hi, int n, int th,
                                            const half8 (&qf)[2][2], float (&m)[2], float (&l)[2], f32x4 (&o)[4][2],
                                            const unsigned long long (&selm)[2], int wvs) {
  const int tid = otid(wvs);
  const int lane = tid & 63, r15 = lane & 15, q = lane >> 4;
  const int lrow = tid >> 3, lch = tid & 7;
  const int k_rd = r15 * 128, kswz = r15 >> 1;
  const int qp = r15 >> 2, pp = lane & 3;
  const int fx = ((2 * q + (qp >> 1)) & 3) << 1;
  const int v_rd = (4 * q + qp) * 128 + 8 * (pp & 1) + ((pp >> 1) << 4);
  unsigned int* impu = (unsigned int*)(smem + ATT_IMP);
  const int ksrc = (lch ^ ((lrow >> 1) & 7)) * 8, vsrc = (lch ^ (((lrow >> 1) & 3) << 1)) * 8;
  const int wbase = __builtin_amdgcn_readfirstlane(tid >> 6) * 1024;
#define A_GLOAD(TI, BUF) { const half_t* kp_ = kbase + (size_t)((TI) * 64 + lrow) * ld + ksrc; \
    __builtin_amdgcn_global_load_lds((gbl_void*)kp_, (lds_void*)(smem + ATT_K + (BUF) * 8192 + wbase), 16, 0, 0); \
    if (MODE != 0) { const half_t* vp_ = vbase + (size_t)((TI) * 64 + lrow) * ld + vsrc; \
      __builtin_amdgcn_global_load_lds((gbl_void*)vp_, (lds_void*)(smem + ATT_V + (BUF) * 8192 + wbase), 16, 0, 0); } }
  constexpr int GPT = (MODE == 0) ? 1 : 2;
#pragma unroll
  for (int i = 0; i < ATT_D; ++i) if (tile_lo + i <= tile_hi) A_GLOAD(tile_lo + i, i)
#pragma unroll 1
  for (int ti = tile_lo; ti <= tile_hi; ++ti) {
    const int it = ti - tile_lo, cur = it % ATT_NB;
    {
      const int rem = tile_hi - ti;
      if (rem >= 4) wait_vmcnt<4 * GPT>(); else if (rem == 3) wait_vmcnt<3 * GPT>(); else if (rem == 2) wait_vmcnt<2 * GPT>();
      else if (rem == 1) wait_vmcnt<1 * GPT>(); else wait_vmcnt<0>();
    }
    __builtin_amdgcn_s_barrier();
    if (ti + ATT_D <= tile_hi) A_GLOAD(ti + ATT_D, (it + ATT_D) % ATT_NB)
    const char* kb = smem + ATT_K + cur * 8192 + k_rd;
    const unsigned vbl = (unsigned)(size_t)(smem + ATT_V + cur * 8192 + v_rd);
    bool need_mask;
    if (MODE <= 1) need_mask = (ti * 64 + 63 > 4 * n - 2);
    else if (MODE == 2) need_mask = (ti == n);
    else need_mask = (ti == n) || (ti == n - 8);
    f32x4 s[4][2];
#pragma unroll
    for (int kf = 0; kf < 4; ++kf)
#pragma unroll
      for (int t2 = 0; t2 < 2; ++t2) s[kf][t2] = (f32x4){0.f, 0.f, 0.f, 0.f};
#pragma unroll
    for (int ks = 0; ks < 2; ++ks) {
      const int co = ((4 * ks + q) ^ kswz) << 4;
#pragma unroll
      for (int kf = 0; kf < 4; ++kf) {
        const half8 kfr = *(const half8*)(kb + kf * 2048 + co);
#pragma unroll
        for (int t2 = 0; t2 < 2; ++t2) s[kf][t2] = __builtin_amdgcn_mfma_f32_16x16x32_f16(kfr, qf[t2][ks], s[kf][t2], 0, 0, 0);
      }
    }
    v2i vr[4][4];
    if (MODE != 0) {
      const unsigned va0 = vbl + (((0) ^ fx) << 4), va1 = vbl + (((2) ^ fx) << 4), va2 = vbl + (((4) ^ fx) << 4), va3 = vbl + (((6) ^ fx) << 4);
      asm volatile(
          "ds_read_b64_tr_b16 %0, %16\n\tds_read_b64_tr_b16 %1, %16 offset:2048\n\tds_read_b64_tr_b16 %2, %16 offset:4096\n\tds_read_b64_tr_b16 %3, %16 offset:6144\n\t"
          "ds_read_b64_tr_b16 %4, %17\n\tds_read_b64_tr_b16 %5, %17 offset:2048\n\tds_read_b64_tr_b16 %6, %17 offset:4096\n\tds_read_b64_tr_b16 %7, %17 offset:6144\n\t"
          "ds_read_b64_tr_b16 %8, %18\n\tds_read_b64_tr_b16 %9, %18 offset:2048\n\tds_read_b64_tr_b16 %10, %18 offset:4096\n\tds_read_b64_tr_b16 %11, %18 offset:6144\n\t"
          "ds_read_b64_tr_b16 %12, %19\n\tds_read_b64_tr_b16 %13, %19 offset:2048\n\tds_read_b64_tr_b16 %14, %19 offset:4096\n\tds_read_b64_tr_b16 %15, %19 offset:6144"
          : "=&v"(vr[0][0]), "=&v"(vr[0][1]), "=&v"(vr[0][2]), "=&v"(vr[0][3]), "=&v"(vr[1][0]), "=&v"(vr[1][1]), "=&v"(vr[1][2]), "=&v"(vr[1][3]),
            "=&v"(vr[2][0]), "=&v"(vr[2][1]), "=&v"(vr[2][2]), "=&v"(vr[2][3]), "=&v"(vr[3][0]), "=&v"(vr[3][1]), "=&v"(vr[3][2]), "=&v"(vr[3][3])
          : "v"(va0), "v"(va1), "v"(va2), "v"(va3)
          : "memory");
    }
    if (need_mask) {
#pragma unroll
      for (int t2 = 0; t2 < 2; ++t2) {
        const int tok = th * 32 + t2 * 16 + r15;
        int lo = 0, hi = 63;
        if (MODE <= 1) { hi = 4 * n + ((tok - 31) >> 4) - ti * 64; }
        else if (MODE == 2) { hi = tok; }
        else { if (ti == n) hi = tok; else lo = tok + 1; }
#pragma unroll
        for (int kf = 0; kf < 4; ++kf)
#pragma unroll
          for (int r = 0; r < 4; ++r) {
            const int kk = kf * 16 + 4 * q + r;
            if (kk < lo || kk > hi) s[kf][t2][r] = -INFINITY;
          }
      }
    }
    half8 pf[2][2];
#pragma unroll
    for (int t2 = 0; t2 < 2; ++t2) {
      float mb, scale_p = 1.f;
      if (MODE == 1) {
        mb = m[t2] * LOG2E; scale_p = l[t2];
      } else if (MODE >= 2) {
        mb = m[t2] * LOG2E;
        if (MODE == 2 && !((selm[t2] >> ti) & 1ull)) mb = INFINITY;
      } else {
        float tm = s[0][t2][0];
#pragma unroll
        for (int kf = 0; kf < 4; ++kf)
#pragma unroll
          for (int r = 0; r < 4; ++r) tm = fmaxf(tm, s[kf][t2][r]);
        tm = rowmax4(tm);
        const float mn = fmaxf(m[t2], tm);
        const float alpha = fexp2((m[t2] - mn) * LOG2E);
        m[t2] = mn; mb = mn * LOG2E;
        l[t2] *= alpha;
      }
      float lsum = 0.f;
#pragma unroll
      for (int kf = 0; kf < 4; ++kf) {
#pragma unroll
        for (int r = 0; r < 4; ++r) {
          float pv = fexp2(fmaf(s[kf][t2][r], LOG2E, -mb));
          if (MODE == 1) pv *= scale_p;
          s[kf][t2][r] = pv; lsum += pv;
        }
      }
      if (MODE != 1) l[t2] += lsum;
      if (MODE == 1) {
        const int tok = th * 32 + t2 * 16 + r15;
#pragma unroll
        for (int kf = 0; kf < 4; ++kf) {
          const int j = 16 * ti + 4 * kf + q;
          const unsigned int u0 = (unsigned int)(s[kf][t2][0] * 134217728.f + 0.5f), u1 = (unsigned int)(s[kf][t2][1] * 134217728.f + 0.5f);
          const unsigned int u2 = (unsigned int)(s[kf][t2][2] * 134217728.f + 0.5f), u3 = (unsigned int)(s[kf][t2][3] * 134217728.f + 0.5f);
          if (j < 64) {
            atomicAdd(&impu[tok * IMPS + j], u0 + u1 + u2 + u3);
            atomicAdd(&impu[tok * IMPS + j + 1], u3);
          }
        }
      }
      if (MODE != 0) {
#pragma unroll
        for (int ks = 0; ks < 2; ++ks) {
          half8 pk;
#pragma unroll
          for (int r = 0; r < 4; ++r) { pk[r] = (half_t)s[2 * ks][t2][r]; pk[4 + r] = (half_t)s[2 * ks + 1][t2][r]; }
          pf[t2][ks] = pk;
        }
      }
    }
    if (MODE != 0) {
      asm volatile("s_waitcnt lgkmcnt(0)"
                   : "+v"(vr[0][0]), "+v"(vr[0][1]), "+v"(vr[0][2]), "+v"(vr[0][3]), "+v"(vr[1][0]), "+v"(vr[1][1]), "+v"(vr[1][2]), "+v"(vr[1][3]),
                     "+v"(vr[2][0]), "+v"(vr[2][1]), "+v"(vr[2][2]), "+v"(vr[2][3]), "+v"(vr[3][0]), "+v"(vr[3][1]), "+v"(vr[3][2]), "+v"(vr[3][3])
                   :: "memory");
      __builtin_amdgcn_sched_barrier(0);
#pragma unroll
      for (int df = 0; df < 4; ++df) {
#pragma unroll
        for (int ks = 0; ks < 2; ++ks) {
          const v2i lo2 = vr[df][2 * ks], hi2 = vr[df][2 * ks + 1];
          const v4i pk4 = (v4i){lo2[0], lo2[1], hi2[0], hi2[1]};
          const half8 vf = __builtin_bit_cast(half8, pk4);
#pragma unroll
          for (int t2 = 0; t2 < 2; ++t2) o[df][t2] = __builtin_amdgcn_mfma_f32_16x16x32_f16(vf, pf[t2][ks], o[df][t2], 0, 0, 0);
        }
      }
    }
  }
  __syncthreads();
#undef A_GLOAD
}

__device__ void ph_attn_mfma(const Params& P, char* smem, int wvs) {
  unsigned int* impu = (unsigned int*)(smem + ATT_IMP);
  unsigned long long* selmask = (unsigned long long*)(smem + ATT_SELM);
  const int G = gridDim.x, nrounds = (2048 + G - 1) / G;
  for (int rd = 0; rd < nrounds; ++rd) {
    const int idx = rd * G + ((rd & 1) ? (G - 1 - (int)blockIdx.x) : (int)blockIdx.x);
    if (idx >= 2048) continue;
    const int tid = otid(wvs), lane = tid & 63, r15 = lane & 15, q = lane >> 4;
    const int n = 63 - (idx >> 5), bg = idx & 31, b = bg >> 2, g = bg & 3;
    const int wv = __builtin_amdgcn_readfirstlane(otid(wvs) >> 6);
    const int hd = g * 4 + (wv & 3), th = wv >> 2;
    const int t0 = b * SEQ + n * 64 + th * 32;
    half8 qf[2][2];
#pragma unroll
    for (int t2 = 0; t2 < 2; ++t2)
#pragma unroll
      for (int ks = 0; ks < 2; ++ks) qf[t2][ks] = *(const half8*)(P.p + (size_t)(t0 + t2 * 16 + r15) * LD1 + hd * 64 + 32 * ks + 8 * q);
    float* gate_l = (float*)(smem + ATT_GATE) + wv * 128;
    if (q == 0) {
#pragma unroll
      for (int t2 = 0; t2 < 2; ++t2) {
        const half_t* pr = P.p + (size_t)(t0 + t2 * 16 + r15) * LD1 + 3584 + hd * 3;
        f32x4 gv;
#pragma unroll
        for (int c = 0; c < 3; ++c) gv[c] = sigmoidf((float)pr[c] + P.nsa_b_gate[hd * 3 + c]);
        gv[3] = 0.f;
        *(f32x4*)(gate_l + (t2 * 16 + r15) * 4) = gv;
      }
    }
    { const int tz = otid(wvs); for (int i = tz; i < 64 * IMPS + 128; i += NTHREADS) impu[i] = 0u; }
    float m[2], l[2]; f32x4 o[4][2]; unsigned long long selm[2] = {0ull, 0ull};
#pragma unroll
    for (int t2 = 0; t2 < 2; ++t2) { m[t2] = -1e30f; l[t2] = 0.f; }
#pragma unroll
    for (int df = 0; df < 4; ++df)
#pragma unroll
      for (int t2 = 0; t2 < 2; ++t2) o[df][t2] = (f32x4){0.f, 0.f, 0.f, 0.f};
    const half_t* kc = P.kcmp + (size_t)bg * 256 * 64;
    const half_t* vc = P.vcmp + (size_t)bg * 256 * 64;
    const int nct = (4 * n + 2) / 64;
    attn_branch<0>(smem, kc, vc, 64, 0, nct, n, th, qf, m, l, o, selm, wvs);
#pragma unroll
    for (int t2 = 0; t2 < 2; ++t2) {
      float lt = l[t2];
      lt = rowsum4(lt);
      l[t2] = lt > 0.f ? 1.f / lt : 0.f;
    }
    attn_branch<1>(smem, kc, vc, 64, 0, nct, n, th, qf, m, l, o, selm, wvs);
    f32x4 oacc[4][2];
#pragma unroll
    for (int t2 = 0; t2 < 2; ++t2) {
      const float gc = gate_l[(t2 * 16 + r15) * 4 + 0];
#pragma unroll
      for (int df = 0; df < 4; ++df) oacc[df][t2] = o[df][t2] * gc;
    }
    {
      const int tid2 = otid(wvs);
      const int tok = tid2 >> 3, part = tid2 & 7;
      unsigned long long msk;
      if (n + 1 <= 16) {
        msk = (1ull << (n + 1)) - 1ull;
      } else {
        const uint4* rowp = (const uint4*)(impu + tok * IMPS);
        unsigned own[8];
        { const uint4 a = rowp[part * 2], b2 = rowp[part * 2 + 1];
          own[0] = a.x; own[1] = a.y; own[2] = a.z; own[3] = a.w; own[4] = b2.x; own[5] = b2.y; own[6] = b2.z; own[7] = b2.w; }
        int rank[8];
#pragma unroll
        for (int jj = 0; jj < 8; ++jj) {
          const int j = part * 8 + jj;
          own[jj] = (j >= 1 && j <= n - 2) ? ((own[jj] & ~63u) | (unsigned)(63 - j)) : 0xffffffffu;
          rank[jj] = 0;
        }
#pragma unroll 2
        for (int c4 = 0; c4 < 16; ++c4) {
          const uint4 v = rowp[c4];
          unsigned kv[4] = {v.x, v.y, v.z, v.w};
#pragma unroll
          for (int e = 0; e < 4; ++e) {
            const int j2 = c4 * 4 + e;
            const unsigned key2 = (j2 >= 1 && j2 <= n - 2) ? ((kv[e] & ~63u) | (unsigned)(63 - j2)) : 0u;
#pragma unroll
            for (int jj = 0; jj < 8; ++jj) rank[jj] += (key2 > own[jj]) ? 1 : 0;
          }
        }
        unsigned int bits = 0;
#pragma unroll
        for (int jj = 0; jj < 8; ++jj) if (rank[jj] < 13 && own[jj] != 0xffffffffu) bits |= 1u << jj;
        unsigned* sel32 = (unsigned*)selmask;
        if (bits) atomicOr(&sel32[tok * 2 + (part >> 2)], bits << (8 * (part & 3)));
        msk = 1ull | (1ull << n) | (1ull << (n - 1));
        if (part == 0) { atomicOr(&sel32[tok * 2], (unsigned)msk); atomicOr(&sel32[tok * 2 + 1], (unsigned)(msk >> 32)); }
      }
      if (n + 1 <= 16 && part == 0) selmask[tok] = msk;
    }
    __syncthreads();
#pragma unroll
    for (int t2 = 0; t2 < 2; ++t2) selm[t2] = selmask[th * 32 + t2 * 16 + r15];
    float qn2[2];
#pragma unroll
    for (int t2 = 0; t2 < 2; ++t2) {
      float a = 0.f;
#pragma unroll
      for (int ks = 0; ks < 2; ++ks)
#pragma unroll
        for (int e = 0; e < 8; ++e) a += (float)qf[t2][ks][e] * (float)qf[t2][ks][e];
      qn2[t2] = rowsum4(a);
    }
    { const float km = __uint_as_float(P.kmax2[bg * 2 + 0]);
#pragma unroll
      for (int t2 = 0; t2 < 2; ++t2) { m[t2] = sqrtf(qn2[t2] * km) * 1.001f - 5.0f; l[t2] = 0.f; } }
#pragma unroll
    for (int df = 0; df < 4; ++df)
#pragma unroll
      for (int t2 = 0; t2 < 2; ++t2) o[df][t2] = (f32x4){0.f, 0.f, 0.f, 0.f};
    attn_branch<2>(smem, P.p + (size_t)b * SEQ * LD1 + 1536 + g * 64, P.p + (size_t)b * SEQ * LD1 + 1792 + g * 64, LD1, 0, n, n, th, qf, m, l, o, selm, wvs);
#pragma unroll
    for (int t2 = 0; t2 < 2; ++t2) {
      const float gs = gate_l[(t2 * 16 + r15) * 4 + 1] / rowsum4(l[t2]);
#pragma unroll
      for (int df = 0; df < 4; ++df) oacc[df][t2] += o[df][t2] * gs;
    }
    { const float km = __uint_as_float(P.kmax2[bg * 2 + 1]);
#pragma unroll
      for (int t2 = 0; t2 < 2; ++t2) { m[t2] = sqrtf(qn2[t2] * km) * 1.001f - 5.0f; l[t2] = 0.f; } }
#pragma unroll
    for (int df = 0; df < 4; ++df)
#pragma unroll
      for (int t2 = 0; t2 < 2; ++t2) o[df][t2] = (f32x4){0.f, 0.f, 0.f, 0.f};
    attn_branch<3>(smem, P.p + (size_t)b * SEQ * LD1 + 2048 + g * 64, P.p + (size_t)b * SEQ * LD1 + 2304 + g * 64, LD1, (n > 8 ? n - 8 : 0), n, n, th, qf, m, l, o, selm, wvs);
    {
      int tbase = t0 + r15; asm volatile("" : "+v"(tbase));
#pragma unroll
      for (int t2 = 0; t2 < 2; ++t2) {
        const size_t tok = (size_t)(tbase + t2 * 16);
        const float gw = gate_l[(t2 * 16 + r15) * 4 + 2] / rowsum4(l[t2]);
#pragma unroll
        for (int df = 0; df < 4; ++df) {
          const f32x4 v = oacc[df][t2] + o[df][t2] * gw;
          const half4 z = *(const half4*)(P.p + tok * LD1 + 2560 + hd * 64 + df * 16 + 4 * q);
          half4 hv;
#pragma unroll
          for (int e = 0; e < 4; ++e) hv[e] = (half_t)(v[e] * siluf((float)z[e]));
          *(half4*)(P.og + tok * DM + hd * 64 + df * 16 + 4 * q) = hv;
        }
      }
    }
  }
}

constexpr int NPHASES = 13;
__device__ __forceinline__ void run_phase(int ph, const Params& P, char* smem, int wvs) {
  float* sm = (float*)smem;
  switch (ph) {
    case 0:
      if (blockIdx.x == 0 && otid(wvs) < 64) P.kmax2[otid(wvs)] = 0u;
      ph_xh_rstd(P.x, P.xh, P.rstd, wvs); ph_ropetab(P, wvs); prep_cbias_part(P, wvs);
      prep_wT(P.gla_w_in, GLA_IN, P.pre_norm, P.W0t, LD0, DM, 0, sm, wvs);
      prep_wT(P.gla_w_out, DM, nullptr, P.Wo0t, DM, DM, 2, sm, wvs);
      prep_wT(P.nsa_w_in, NSA_IN, P.pre_norm + DM, P.W1t, LD1, DM, 1, sm, wvs);
      prep_wT(P.nsa_w_out, DM, nullptr, P.Wo1t, DM, DM, 2, sm, wvs);
      prep_wT(P.ck_w1, 256, nullptr, P.cw1t, 256, 2048, 2, sm, wvs);
      prep_wT(P.cv_w1, 256, nullptr, P.cw1t + 256 * 2048, 256, 2048, 2, sm, wvs);
      prep_wT(P.ck_w2, 64, nullptr, P.cw2t, 256, 256, 4, sm, wvs);
      prep_wT(P.cv_w2, 64, nullptr, P.cw2t + 256 * 256, 256, 256, 4, sm, wvs);
      break;
    case 1: g8::gemm(g8::SrcPlain8{P.xh, DM, P.W0t, DM}, T_TOK, LD0, DM, g8::EpiStore8{P.p, LD0, P.rstd}, smem, wvs); break;
    case 2: prep_cbias_reduce(P, wvs); ph_gla_prep(P, sm, wvs); break;
    case 3: ph_gla_mfma(P, smem, wvs); break;
    case 4: ph_gla_post(P, wvs); break;
    case 5: g8::gemm(g8::SrcPlain8{P.og, DM, P.Wo0t, DM}, T_TOK, DM, DM, g8::EpiStore8{P.y, DM, nullptr}, smem, wvs); break;
    case 6: ph_post(P.x, P.y, P.post_norm, P.out, P.xh, P.rstd, wvs); break;
    case 7: g8::gemm(g8::SrcPlain8{P.xh, DM, P.W1t, DM}, T_TOK, LD1, DM, g8::EpiRope8{P.p, LD1, P.rstd, P.ropetab}, smem, wvs); break;
    case 8: g8::gemm(g8::SrcCmp1_8{P.p, P.cw1t}, 16384, 256, 2048, g8::EpiCmpHid8{P.hid, P.cbias}, smem, wvs); break;
    case 9: ph_kmax(P, wvs); g8::gemm(g8::SrcCmp2_8{P.hid, P.cw2t}, 16384, 256, 256, g8::EpiCmpOut8{P.kcmp, P.vcmp}, smem, wvs); break;
    case 10: ph_attn_mfma(P, smem, wvs); break;
    case 11: g8::gemm(g8::SrcPlain8{P.og, DM, P.Wo1t, DM}, T_TOK, DM, DM, g8::EpiStore8{P.y, DM, nullptr}, smem, wvs); break;
    case 12: ph_post(P.out, P.y, P.post_norm + DM, P.out, nullptr, nullptr, wvs); break;
  }
}

template <int PH>
__global__ void __launch_bounds__(NTHREADS, 2) k_phase(Params P) {
  __shared__ __attribute__((aligned(16))) char smem[SMEM_BYTES];
  run_phase(PH, P, smem, __builtin_amdgcn_readfirstlane(threadIdx.x >> 6));
}
template <int PH>
static void launch_phases(const Params& P, hipStream_t stream) {
  hipLaunchKernelGGL((k_phase<PH>), dim3(256), dim3(NTHREADS), 0, stream, P);
  if constexpr (PH + 1 < NPHASES) launch_phases<PH + 1>(P, stream);
}

#if MEGA
__global__ void __launch_bounds__(NTHREADS, 2) k_mega(Params P) {
  __shared__ __attribute__((aligned(16))) char smem[SMEM_BYTES];
  cg::grid_group grid = cg::this_grid();
  if (P.use_cg_sync) grid.sync();
  unsigned bt = 0;
  const int wvs = __builtin_amdgcn_readfirstlane(threadIdx.x >> 6);
  run_phase(0, P, smem, wvs); fast_barrier(P.bar, bt, wvs);
  run_phase(1, P, smem, wvs); fast_barrier(P.bar, bt, wvs);
  run_phase(2, P, smem, wvs); fast_barrier(P.bar, bt, wvs);
  run_phase(3, P, smem, wvs); fast_barrier(P.bar, bt, wvs);
  run_phase(4, P, smem, wvs); fast_barrier(P.bar, bt, wvs);
  run_phase(5, P, smem, wvs); fast_barrier(P.bar, bt, wvs);
  run_phase(6, P, smem, wvs); fast_barrier(P.bar, bt, wvs);
  run_phase(7, P, smem, wvs); fast_barrier(P.bar, bt, wvs);
  run_phase(8, P, smem, wvs); fast_barrier(P.bar, bt, wvs);
  run_phase(9, P, smem, wvs); fast_barrier(P.bar, bt, wvs);
  run_phase(10, P, smem, wvs); fast_barrier(P.bar, bt, wvs);
  run_phase(11, P, smem, wvs); fast_barrier(P.bar, bt, wvs);
  run_phase(12, P, smem, wvs);
}
#endif

extern "C" void kernel_launch(void* const* d_in, const int* in_sizes, int n_in, void* d_out, int out_size, void* d_ws, size_t ws_size,
                              hipStream_t stream) {
  Params P{};
  P.x = (const float*)d_in[0]; P.pos = (const int*)d_in[1]; P.pre_norm = (const float*)d_in[2]; P.post_norm = (const float*)d_in[3];
  P.gla_w_in = (const float*)d_in[4]; P.gla_w_gk_up = (const float*)d_in[5]; P.gla_b_gk = (const float*)d_in[6];
  P.gla_head_norm = (const float*)d_in[7]; P.gla_w_out = (const float*)d_in[8];
  P.nsa_w_in = (const float*)d_in[9]; P.nsa_b_gate = (const float*)d_in[10]; P.nsa_pe_k = (const float*)d_in[11]; P.nsa_pe_v = (const float*)d_in[12];
  P.ck_w1 = (const float*)d_in[13]; P.ck_w2 = (const float*)d_in[14]; P.cv_w1 = (const float*)d_in[15]; P.cv_w2 = (const float*)d_in[16];
  P.nsa_w_out = (const float*)d_in[17];
  P.out = (float*)d_out;
  char* ws = (char*)d_ws;
  const size_t MB = 1024 * 1024;
  P.W0t = (half_t*)(ws);
  P.Wo0t = (half_t*)(ws + 7 * MB);
  P.W1t = (half_t*)(ws + 9 * MB);
  P.Wo1t = (half_t*)(ws + 17 * MB);
  P.cw1t = (half_t*)(ws + 19 * MB);
  P.cw2t = (half_t*)(ws + 21 * MB);
  P.cbias = (float*)(ws + 22 * MB);
  P.cbias_part = (float*)(ws + 22 * MB + 4096);
  P.bar = (unsigned*)(ws + 23 * MB);
  P.use_cg_sync = 0;
  P.kmax2 = (unsigned*)(ws + 22 * MB + 512 * 1024);
  P.xh = (half_t*)(ws + 24 * MB);
  P.p = (half_t*)(ws + 88 * MB);
  P.y = (half_t*)(ws + 88 * MB);
  P.og = (half_t*)(ws + 328 * MB);
  P.bcum = (float*)(ws + 392 * MB);
  P.rstd = (float*)(ws + 456 * MB);
  P.kcmp = (half_t*)(ws + 457 * MB);
  P.vcmp = (half_t*)(ws + 458 * MB);
  P.ropetab = (float*)(ws + 459 * MB);
  P.hid = (half_t*)(ws + 467 * MB);
  if (ws_size < 476 * MB) { fprintf(stderr, "ws too small: %zu\n", ws_size); return; }
#if MEGA
  static int grid_blocks = 0;
  if (!grid_blocks) {
    int dev = 0, cus = 0, per_cu = 0;
    hipGetDevice(&dev);
    hipDeviceGetAttribute(&cus, hipDeviceAttributeMultiprocessorCount, dev);
    hipOccupancyMaxActiveBlocksPerMultiprocessor(&per_cu, k_mega, NTHREADS, 0);
    if (per_cu < 1) per_cu = 1;
    if (per_cu > 1) per_cu = 1;
    grid_blocks = cus * per_cu;
  }
  hipMemsetAsync(ws + 23 * MB, 0, 16384, stream);
  void* args[] = {&P};
  hipError_t e = hipLaunchCooperativeKernel((void*)k_mega, dim3(grid_blocks), dim3(NTHREADS), args, 0, stream);
  if (e != hipSuccess) fprintf(stderr, "cooperative launch failed: %s (grid %d)\n", hipGetErrorString(e), grid_blocks);
#else
  launch_phases<0>(P, stream);
#endif
}
```

```cpp
#include <hip/hip_runtime.h>
#include <hip/hip_cooperative_groups.h>
#include <cstdio>
#include <cstdint>
namespace cg = cooperative_groups;

typedef _Float16 half_t;
typedef _Float16 half8 __attribute__((ext_vector_type(8)));
typedef _Float16 half4 __attribute__((ext_vector_type(4)));
typedef float f32x4 __attribute__((ext_vector_type(4)));
typedef int v2i __attribute__((ext_vector_type(2)));
typedef int v4i __attribute__((ext_vector_type(4)));

#ifndef MEGA
#define MEGA 1
#endif

constexpr int T_TOK = 32768, DM = 1024, SEQ = 4096, NBATCH = 8;
constexpr int GLA_IN = 3088, NSA_IN = 3632;
constexpr int LD0 = 3328, LD1 = 3840;
constexpr int NC = 255;
constexpr float EPS = 1e-6f;
constexpr int NTHREADS = 512, NWAVES = NTHREADS / 64;
constexpr int SMEM_BYTES = 160 * 1024;

struct Params {
  const float* x; const int* pos; const float* pre_norm; const float* post_norm;
  const float* gla_w_in; const float* gla_w_gk_up; const float* gla_b_gk; const float* gla_head_norm; const float* gla_w_out;
  const float* nsa_w_in; const float* nsa_b_gate; const float* nsa_pe_k; const float* nsa_pe_v;
  const float* ck_w1; const float* ck_w2; const float* cv_w1; const float* cv_w2; const float* nsa_w_out;
  float* out;
  half_t* p; half_t* y; half_t* og; float* bcum; float* rstd; half_t* kcmp; half_t* vcmp; float* ropetab;
  half_t* xh; half_t* W0t; half_t* Wo0t; half_t* W1t; half_t* Wo1t;
  half_t* cw1t; half_t* cw2t; float* cbias; half_t* hid;
  float* cbias_part; unsigned* bar; long long use_cg_sync; unsigned* kmax2; float* gla_state;
};

__device__ __forceinline__ int lane_id() { return (int)__builtin_amdgcn_mbcnt_hi(~0u, __builtin_amdgcn_mbcnt_lo(~0u, 0u)); }
__device__ __forceinline__ int otid(int wvs) { int t = wvs * 64 + lane_id(); asm volatile("" : "+v"(t)); return t; }
__device__ __forceinline__ float wave_sum(float v) {
#pragma unroll
  for (int o = 32; o > 0; o >>= 1) v += __shfl_xor(v, o);
  return v;
}
__device__ __forceinline__ float wave_max(float v) {
#pragma unroll
  for (int o = 32; o > 0; o >>= 1) v = fmaxf(v, __shfl_xor(v, o));
  return v;
}
typedef __attribute__((address_space(3))) void lds_void;
typedef __attribute__((address_space(1))) const void gbl_void;
typedef short s16x4 __attribute__((vector_size(8)));
typedef __attribute__((address_space(3))) s16x4 lds_s16x4;
__device__ __forceinline__ half4 tr_read4(const char* p) {
  const s16x4 v = __builtin_amdgcn_ds_read_tr16_b64_v4i16((lds_s16x4*)(p));
  return __builtin_bit_cast(half4, v);
}
template <int N> __device__ __forceinline__ void wait_vmcnt() { asm volatile("s_waitcnt vmcnt(%0)" ::"n"(N) : "memory"); }
constexpr float LOG2E = 1.4426950408889634f;
__device__ __forceinline__ float fexp2(float x) { return __builtin_amdgcn_exp2f(x); }
typedef unsigned u32x2 __attribute__((ext_vector_type(2)));
__device__ __forceinline__ float rowmax4(float x) {
  u32x2 r = __builtin_amdgcn_permlane16_swap(__float_as_uint(x), __float_as_uint(x), false, false);
  x = fmaxf(__uint_as_float(r[0]), __uint_as_float(r[1]));
  r = __builtin_amdgcn_permlane32_swap(__float_as_uint(x), __float_as_uint(x), false, false);
  return fmaxf(__uint_as_float(r[0]), __uint_as_float(r[1]));
}
__device__ __forceinline__ float rowsum4(float x) {
  u32x2 r = __builtin_amdgcn_permlane16_swap(__float_as_uint(x), __float_as_uint(x), false, false);
  x = __uint_as_float(r[0]) + __uint_as_float(r[1]);
  r = __builtin_amdgcn_permlane32_swap(__float_as_uint(x), __float_as_uint(x), false, false);
  return __uint_as_float(r[0]) + __uint_as_float(r[1]);
}
__device__ __forceinline__ float siluf(float v) { return v / (1.f + expf(-v)); }
__device__ __forceinline__ float sigmoidf(float v) { return 1.f / (1.f + expf(-v)); }
__device__ __forceinline__ float logsigmoidf(float u) { return fminf(u, 0.f) - log1pf(expf(-fabsf(u))); }

__device__ __forceinline__ void fast_barrier(unsigned* bar, unsigned& round, int wvs) {
  asm volatile("s_waitcnt vmcnt(0) lgkmcnt(0)" ::: "memory");
  __syncthreads();
  round += 1;
  if (wvs == 0 && lane_id() == 0) {
    __builtin_amdgcn_fence(__ATOMIC_RELEASE, "agent");
    asm volatile("s_waitcnt vmcnt(0)" ::: "memory");
    const unsigned ngroups = gridDim.x >> 4;
    const unsigned old = __hip_atomic_fetch_add(bar + 64 + 64 * (blockIdx.x >> 4), 1u, __ATOMIC_RELAXED, __HIP_MEMORY_SCOPE_AGENT);
    if (old + 1 == round * 16u) __hip_atomic_fetch_add(bar, 1u, __ATOMIC_RELAXED, __HIP_MEMORY_SCOPE_AGENT);
    const unsigned target = round * ngroups;
    while (__hip_atomic_load(bar, __ATOMIC_RELAXED, __HIP_MEMORY_SCOPE_AGENT) < target) { }
    __builtin_amdgcn_fence(__ATOMIC_ACQUIRE, "agent");
    asm volatile("s_waitcnt vmcnt(0)" ::: "memory");
  }
  __syncthreads();
}

__device__ void ph_xh_rstd(const float* src, half_t* xh, float* rstd, int wvs) {
  const int tid_ = otid(wvs); const int lane = tid_ & 63, w = tid_ >> 6;
#pragma unroll 2
  for (int row = blockIdx.x * NWAVES + w; row < T_TOK; row += gridDim.x * NWAVES) {
    const float4* r = (const float4*)(src + (size_t)row * DM);
    half4* xr = (half4*)(xh + (size_t)row * DM);
    float ss = 0.f;
#pragma unroll
    for (int i = 0; i < 4; ++i) {
      const float4 v = r[lane + 64 * i];
      ss += v.x * v.x + v.y * v.y + v.z * v.z + v.w * v.w;
      half4 hv; hv[0] = (half_t)v.x; hv[1] = (half_t)v.y; hv[2] = (half_t)v.z; hv[3] = (half_t)v.w;
      xr[lane + 64 * i] = hv;
    }
    ss = wave_sum(ss);
    if (lane == 0) rstd[row] = rsqrtf(ss * (1.f / DM) + EPS);
  }
}
__device__ void ph_ropetab(const Params& P, int wvs) {
  for (int idx = blockIdx.x * NTHREADS + otid(wvs); idx < T_TOK * 32; idx += gridDim.x * NTHREADS) {
    const int t = idx >> 5, i = idx & 31;
    const float inv = powf(10000.f, -(float)(2 * i) / 64.f);
    const float ang = (float)P.pos[t] * inv;
    float s, c; sincosf(ang, &s, &c);
    P.ropetab[t * 64 + i] = c; P.ropetab[t * 64 + 32 + i] = s;
  }
}
__device__ __forceinline__ int orig_col(int n, int mode) {
  if (mode == 0) {
    if (n < 2048) return n;
    if (n < 3072) return n + 16;
    if (n < 3088) return n - 1024;
    return -1;
  } else if (mode == 1) {
    if (n < 2560) return n;
    if (n < 3584) return n + 48;
    if (n < 3632) return n - 1024;
    return -1;
  }
  if (mode == 4) return n < 64 ? n : -1;
  return n;
}
__device__ void prep_wT(const float* W, int ldw, const float* gamma, half_t* Wt, int Npad, int K, int mode, float* sm, int wvs) {
  float(*tile)[65] = (float(*)[65])sm;
  const int tid = otid(wvs);
  const int ntn = Npad / 64, ntk = K / 64;
  for (int t = blockIdx.x; t < ntn * ntk; t += gridDim.x) {
    const int n0 = (t / ntk) * 64, k0 = (t % ntk) * 64;
    __syncthreads();
#pragma unroll
    for (int r = 0; r < 4096 / NTHREADS; ++r) {
      const int idx = tid + r * NTHREADS, kk = idx >> 6, nn = idx & 63;
      const int on = orig_col(n0 + nn, mode);
      float v = 0.f;
      if (on >= 0) { v = W[(size_t)(k0 + kk) * ldw + on]; if (gamma) v *= gamma[k0 + kk]; }
      tile[kk][nn] = v;
    }
    __syncthreads();
    {
      const int nn = tid >> 3, oct = tid & 7;
      half8 hv;
#pragma unroll
      for (int e = 0; e < 8; ++e) hv[e] = (half_t)tile[oct * 8 + e][nn];
      *(half8*)(Wt + (size_t)(n0 + nn) * K + k0 + oct * 8) = hv;
    }
  }
}

__device__ void prep_cbias_part(const Params& P, int wvs) {
  for (int idx = blockIdx.x * NTHREADS + otid(wvs); idx < 2 * 32 * 256; idx += gridDim.x * NTHREADS) {
    const int j = idx & 255, ks = (idx >> 8) & 31, which = idx >> 13;
    const float* pe = which ? P.nsa_pe_v : P.nsa_pe_k;
    const float* w1 = which ? P.cv_w1 : P.ck_w1;
    float a = 0.f;
#pragma unroll 8
    for (int k = ks * 64; k < ks * 64 + 64; ++k) a += pe[k] * w1[(size_t)k * 256 + j];
    P.cbias_part[idx] = a;
  }
}
__device__ void prep_cbias_reduce(const Params& P, int wvs) {
  if (blockIdx.x < 2 && otid(wvs) < 256) {
    const int which = blockIdx.x, j = otid(wvs);
    float a = 0.f;
    for (int ks = 0; ks < 32; ++ks) a += P.cbias_part[(which * 32 + ks) * 256 + j];
    P.cbias[which * 256 + j] = a;
  }
}

namespace g8 {
constexpr int BK = 64, HALF = 128, HTB = HALF * BK * 2;
__device__ __forceinline__ int lds_byte(int r, int c) { const int st = (r >> 4) * 2 + (c >> 5), rr = r & 15, cc = c & 31, ob = rr * 64 + cc * 2; return st * 1024 + (ob ^ (((ob >> 9) & 1) << 5)); }
__device__ __forceinline__ void stage_rc(int b, int& R, int& C) { const int st = b / 1024, sb = b % 1024, swz = sb ^ (((sb >> 9) & 1) << 5); R = (st >> 1) * 16 + swz / 64; C = (st & 1) * 32 + (swz % 64) / 2; }
__device__ __forceinline__ int cbase(int wc, int n) { return 64 * (wc >> 1) + 32 * n + 16 * (wc & 1); }
typedef f32x4 Acc[2][2][4][2];

struct SrcPlain8 {
  const half_t* A; int lda; const half_t* Bt; int K;
  __device__ __forceinline__ void get(int pm, int pn, const half_t*& Ag, const half_t*& Bg, size_t& a_rs, int& a_ks) const {
    Ag = A + (size_t)pm * 256 * lda; Bg = Bt + (size_t)pn * 256 * K; a_rs = lda; a_ks = 64;
  }
};
struct SrcCmp1_8 {
  const half_t* p1; const half_t* w1t;
  __device__ __forceinline__ void get(int pm, int pn, const half_t*& Ag, const half_t*& Bg, size_t& a_rs, int& a_ks) const {
    const int which = pm >> 5, bg = pm & 31, b = bg >> 2, g = bg & 3;
    Ag = p1 + (size_t)(b * SEQ) * LD1 + (which ? 1280 : 1024) + g * 64;
    Bg = w1t + (size_t)which * 256 * 2048; a_rs = (size_t)16 * LD1; a_ks = LD1;
  }
};
struct SrcCmp2_8 {
  const half_t* hid; const half_t* w2t;
  __device__ __forceinline__ void get(int pm, int pn, const half_t*& Ag, const half_t*& Bg, size_t& a_rs, int& a_ks) const {
    Ag = hid + (size_t)pm * 256 * 256; Bg = w2t + (size_t)(pm >> 5) * 256 * 256; a_rs = 256; a_ks = 64;
  }
};

struct EpiStore8 {
  half_t* C; int ldc; const float* rowscale;
  __device__ __forceinline__ void operator()(const Acc& acc, int row0, int col0, int wr, int wc, int fr, int fq) const {
#pragma unroll
    for (int ai = 0; ai < 2; ++ai)
#pragma unroll
      for (int m = 0; m < 4; ++m) {
        const int tok = row0 + ai * 128 + wr * 64 + m * 16 + fr;
        const float s = rowscale ? rowscale[tok] : 1.f;
        half_t* rowp = C + (size_t)tok * ldc + col0 + 4 * fq;
#pragma unroll
        for (int bj = 0; bj < 2; ++bj)
#pragma unroll
          for (int n = 0; n < 2; ++n) {
            const f32x4 v = acc[ai][bj][m][n] * s;
            half4 hv; hv[0] = (half_t)v[0]; hv[1] = (half_t)v[1]; hv[2] = (half_t)v[2]; hv[3] = (half_t)v[3];
            *(half4*)(rowp + bj * 128 + cbase(wc, n)) = hv;
          }
      }
  }
};
struct EpiRope8 {
  half_t* C; int ldc; const float* rowscale; const float* ropetab;
  __device__ __forceinline__ void operator()(const Acc& acc, int row0, int col0, int wr, int wc, int fr, int fq) const {
#pragma unroll
    for (int bj = 0; bj < 2; ++bj) {
      const int grp = (col0 + bj * 128 + 64 * (wc >> 1)) >> 6;
      const bool is_q = grp < 16;
      const bool roped = is_q || (grp >= 16 && grp < 20) || (grp >= 24 && grp < 28) || (grp >= 32 && grp < 36);
      const float sc = is_q ? 0.125f : 1.f;
#pragma unroll
      for (int ai = 0; ai < 2; ++ai)
#pragma unroll
        for (int m = 0; m < 4; ++m) {
          const int tok = row0 + ai * 128 + wr * 64 + m * 16 + fr;
          const float s = rowscale[tok];
          half_t* rowp = C + (size_t)tok * ldc + col0 + bj * 128 + 4 * fq;
          f32x4 o1 = acc[ai][bj][m][0] * s, o2 = acc[ai][bj][m][1] * s;
          if (roped) {
            const f32x4 cs = *(const f32x4*)(ropetab + (size_t)tok * 64 + 16 * (wc & 1) + 4 * fq);
            const f32x4 sn = *(const f32x4*)(ropetab + (size_t)tok * 64 + 32 + 16 * (wc & 1) + 4 * fq);
            const f32x4 x1 = o1, x2 = o2;
            o1 = (x1 * cs - x2 * sn) * sc; o2 = (x2 * cs + x1 * sn) * sc;
          }
          half4 h1, h2;
#pragma unroll
          for (int e = 0; e < 4; ++e) { h1[e] = (half_t)o1[e]; h2[e] = (half_t)o2[e]; }
          *(half4*)(rowp + cbase(wc, 0)) = h1;
          *(half4*)(rowp + cbase(wc, 1)) = h2;
        }
    }
  }
};
struct EpiCmpHid8 {
  half_t* hid; const float* bias;
  __device__ __forceinline__ void operator()(const Acc& acc, int row0, int col0, int wr, int wc, int fr, int fq) const {
    const int which = row0 >> 13;
#pragma unroll
    for (int bj = 0; bj < 2; ++bj)
#pragma unroll
      for (int n = 0; n < 2; ++n) {
        const int col = col0 + bj * 128 + cbase(wc, n) + 4 * fq;
        const f32x4 bv = *(const f32x4*)(bias + which * 256 + col);
#pragma unroll
        for (int ai = 0; ai < 2; ++ai)
#pragma unroll
          for (int m = 0; m < 4; ++m) {
            const int row = row0 + ai * 128 + wr * 64 + m * 16 + fr;
            const f32x4 v = acc[ai][bj][m][n] + bv;
            half4 hv; hv[0] = (half_t)siluf(v[0]); hv[1] = (half_t)siluf(v[1]); hv[2] = (half_t)siluf(v[2]); hv[3] = (half_t)siluf(v[3]);
            *(half4*)(hid + (size_t)row * 256 + col) = hv;
          }
      }
  }
};
struct EpiCmpOut8 {
  half_t* kcmp; half_t* vcmp;
  __device__ __forceinline__ void operator()(const Acc& acc, int row0, int col0, int wr, int wc, int fr, int fq) const {
    if (wc >= 2) return;
#pragma unroll
    for (int ai = 0; ai < 2; ++ai)
#pragma unroll
      for (int m = 0; m < 4; ++m) {
        const int row = row0 + ai * 128 + wr * 64 + m * 16 + fr;
        const int which = row >> 13, r = row & 8191;
        half_t* dst = (which ? vcmp : kcmp) + (size_t)r * 64 + 4 * fq;
        const bool dead = (r & 255) == 255;
#pragma unroll
        for (int n = 0; n < 2; ++n) {
          const f32x4 v = acc[ai][0][m][n];
          half4 hv; hv[0] = (half_t)v[0]; hv[1] = (half_t)v[1]; hv[2] = (half_t)v[2]; hv[3] = (half_t)v[3];
          if (dead) hv = (half4){(half_t)0.f, (half_t)0.f, (half_t)0.f, (half_t)0.f};
          *(half4*)(dst + cbase(wc, n)) = hv;
        }
      }
  }
};

template <class Src, class Epi>
__device__ void gemm(const Src& src, int M, int N, int K, const Epi& epi, char* smem, int wvs) {
  const int tid = otid(wvs), wid = __builtin_amdgcn_readfirstlane(tid >> 6), lane = tid & 63, wr = wid >> 2, wc = wid & 3, fr = lane & 15, fq = lane >> 4;
  const int nM = M / 256, nN = N / 256, nwg = nM * nN, G = gridDim.x, nt = K / BK;
  int sr0, sc0, sr1, sc1;
  stage_rc(tid * 16, sr0, sc0); stage_rc(tid * 16 + 8192, sr1, sc1);
  const int a_base = lds_byte(wr * 64 + fr, fq * 8);
  int b_base = 65536 + lds_byte(cbase(wc, 0) + fr, fq * 8);
  asm volatile("" : "+v"(b_base));
#define SA8(b, h) (smem + ((b) * 2 + (h)) * HTB)
#define SB8(b, h) (smem + (4 + (b) * 2 + (h)) * HTB)
#define STAGE_A(P, h, kt) { const char* g_ = (const char*)(Ag + (size_t)(h) * 128 * lda + (size_t)(kt) * a_ks); \
    __builtin_amdgcn_global_load_lds((gbl_void*)(g_ + aob0), (lds_void*)((P) + wid * 1024), 16, 0, 0); \
    __builtin_amdgcn_global_load_lds((gbl_void*)(g_ + aob1), (lds_void*)((P) + 8192 + wid * 1024), 16, 0, 0); }
#define STAGE_B(P, h, kt) { const char* g_ = (const char*)(Bg + (size_t)(h) * 128 * K + (size_t)(kt) * 64); \
    __builtin_amdgcn_global_load_lds((gbl_void*)(g_ + bob0), (lds_void*)((P) + wid * 1024), 16, 0, 0); \
    __builtin_amdgcn_global_load_lds((gbl_void*)(g_ + bob1), (lds_void*)((P) + 8192 + wid * 1024), 16, 0, 0); }
#define LDA8(dst, b, h) { _Pragma("unroll") for (int m = 0; m < 4; ++m) _Pragma("unroll") for (int k = 0; k < 2; ++k) dst[m][k] = *(const half8*)(SA8(b, h) + a_base + m * 2048 + k * 1024); }
#define LDB8(dst, b, h) { _Pragma("unroll") for (int n = 0; n < 2; ++n) _Pragma("unroll") for (int k = 0; k < 2; ++k) dst[n][k] = *(const half8*)(smem + ((b) * 2 + (h)) * HTB + b_base + n * 4096 + k * 1024); }
#define MMA8(ai, bj, At, Bx) { __builtin_amdgcn_s_setprio(1); \
    _Pragma("unroll") for (int m = 0; m < 4; ++m) _Pragma("unroll") for (int n = 0; n < 2; ++n) _Pragma("unroll") for (int k = 0; k < 2; ++k) \
      acc[ai][bj][m][n] = __builtin_amdgcn_mfma_f32_16x16x32_f16(Bx[n][k], At[m][k], acc[ai][bj][m][n], 0, 0, 0); \
    __builtin_amdgcn_s_setprio(0); }
#define WAIT_V(n) asm volatile("s_waitcnt vmcnt(" #n ")" ::: "memory")
#define WAIT_L(n) asm volatile("s_waitcnt lgkmcnt(" #n ")" ::: "memory")
#define BAR __builtin_amdgcn_s_barrier()
#define SCHED __builtin_amdgcn_sched_barrier(0)
  for (int it = 0;; ++it) {
    const int L = it * G + (int)blockIdx.x;
    if (L >= nwg) break;
    int wgid;
    { const int q = nwg / 8, r = nwg % 8, xcd = L % 8, off = L / 8; wgid = (xcd < r ? xcd * (q + 1) : r * (q + 1) + (xcd - r) * q) + off; }
    const int nig = 8 * nN, gid = wgid / nig, fm = gid * 8, gsz = (nM - fm) < 8 ? (nM - fm) : 8;
    const int pm = fm + ((wgid % nig) % gsz), pn = (wgid % nig) / gsz;
    const half_t* Ag; const half_t* Bg; size_t lda; int a_ks;
    src.get(pm, pn, Ag, Bg, lda, a_ks);
    const unsigned aob0 = (unsigned)(((size_t)sr0 * lda + sc0) * 2), aob1 = (unsigned)(((size_t)sr1 * lda + sc1) * 2);
    const unsigned bob0 = (unsigned)((sr0 * K + sc0) * 2), bob1 = (unsigned)((sr1 * K + sc1) * 2);
    Acc acc;
#pragma unroll
    for (int a = 0; a < 2; ++a)
#pragma unroll
      for (int b = 0; b < 2; ++b)
#pragma unroll
        for (int m = 0; m < 4; ++m)
#pragma unroll
          for (int n = 0; n < 2; ++n) acc[a][b][m][n] = (f32x4){0.f, 0.f, 0.f, 0.f};
    half8 At[4][2], B0[2][2], B1[2][2];
    STAGE_B(SB8(0, 0), 0, 0) STAGE_A(SA8(0, 0), 0, 0)
    STAGE_B(SB8(0, 1), 1, 0) STAGE_A(SA8(0, 1), 1, 0)
    if (wr == 1) BAR;
    WAIT_V(4); BAR;
    STAGE_B(SB8(1, 0), 0, 1) STAGE_A(SA8(1, 0), 0, 1) STAGE_B(SB8(1, 1), 1, 1)
    WAIT_V(6); BAR;
#pragma unroll 1
    for (int t = 0; t < nt - 2; t += 2) {
      LDB8(B0, 0, 0) SCHED; LDA8(At, 0, 0) STAGE_A(SA8(1, 1), 1, t + 1)
      WAIT_L(8); BAR; WAIT_L(0); MMA8(0, 0, At, B0) BAR; SCHED;
      LDB8(B1, 0, 1) STAGE_B(SB8(0, 0), 0, t + 2)
      BAR; WAIT_L(0); MMA8(0, 1, At, B1) BAR;
      LDA8(At, 0, 1) STAGE_A(SA8(0, 0), 0, t + 2)
      BAR; WAIT_L(0); MMA8(1, 0, At, B0) BAR; SCHED;
      STAGE_B(SB8(0, 1), 1, t + 2)
      WAIT_V(6); BAR; MMA8(1, 1, At, B1) BAR;
      LDB8(B0, 1, 0) SCHED; LDA8(At, 1, 0) STAGE_A(SA8(0, 1), 1, t + 2)
      WAIT_L(8); BAR; WAIT_L(0); MMA8(0, 0, At, B0) BAR; SCHED;
      LDB8(B1, 1, 1) STAGE_B(SB8(1, 0), 0, t + 3)
      BAR; WAIT_L(0); MMA8(0, 1, At, B1) BAR;
      LDA8(At, 1, 1) STAGE_A(SA8(1, 0), 0, t + 3)
      BAR; WAIT_L(0); MMA8(1, 0, At, B0) BAR; SCHED;
      STAGE_B(SB8(1, 1), 1, t + 3)
      WAIT_V(6); BAR; MMA8(1, 1, At, B1) BAR;
    }
    { LDB8(B0, 0, 0) LDA8(At, 0, 0) STAGE_A(SA8(1, 1), 1, nt - 1)
      BAR; WAIT_L(0); MMA8(0, 0, At, B0) BAR;
      LDB8(B1, 0, 1) BAR; WAIT_L(0); MMA8(0, 1, At, B1) BAR;
      LDA8(At, 0, 1) WAIT_V(4); BAR; WAIT_L(0); MMA8(1, 0, At, B0) MMA8(1, 1, At, B1) BAR; }
    { LDB8(B0, 1, 0) LDA8(At, 1, 0) WAIT_V(2); BAR; WAIT_L(0); MMA8(0, 0, At, B0) BAR;
      LDB8(B1, 1, 1) WAIT_V(0); BAR; WAIT_L(0); MMA8(0, 1, At, B1) BAR;
      LDA8(At, 1, 1) BAR; WAIT_L(0); MMA8(1, 0, At, B0) MMA8(1, 1, At, B1) BAR; }
    if (wr == 0) BAR;
    { int fr2 = fr, fq2 = fq; asm volatile("" : "+v"(fr2), "+v"(fq2)); epi(acc, pm * 256, pn * 256, wr, wc, fr2, fq2); }
  }
#undef SA8
#undef SB8
#undef STAGE_A
#undef STAGE_B
#undef LDA8
#undef LDB8
#undef MMA8
#undef WAIT_V
#undef WAIT_L
#undef BAR
#undef SCHED
}
}

__device__ void ph_gla_prep(const Params& P, float* sm, int wvs) {
  float(*glr)[16] = (float(*)[16])sm;
  float(*tot)[128] = (float(*)[128])(sm + 1024);
  const int tid = otid(wvs);
  const int tq = tid >> 7, c = tid & 127;
  const float scale = 0.08838834764831845f;
  for (int item = blockIdx.x; item < (T_TOK / 64) * 4; item += gridDim.x) {
    const int chunk = item >> 2, h = item & 3;
    const int t0 = chunk * 64, ch = h * 128 + c;
    __syncthreads();
    for (int idx = tid; idx < 64 * 16; idx += NTHREADS) {
      const int i = idx >> 4, r = idx & 15;
      glr[i][r] = (float)P.p[(size_t)(t0 + i) * LD0 + 3072 + r];
    }
    float w[16];
#pragma unroll
    for (int r = 0; r < 16; ++r) w[r] = P.gla_w_gk_up[r * 512 + ch];
    const float bb = P.gla_b_gk[ch];
    half_t* qp = P.p + (size_t)(t0 + tq * 16) * LD0 + ch;
    half_t qv[16], kv[16];
#pragma unroll
    for (int i = 0; i < 16; ++i) { qv[i] = qp[(size_t)i * LD0]; kv[i] = qp[(size_t)i * LD0 + 512]; }
    __syncthreads();
    float pre[16]; float cum = 0.f;
#pragma unroll
    for (int i = 0; i < 16; ++i) {
      float u = bb;
#pragma unroll
      for (int r = 0; r < 16; ++r) u += glr[tq * 16 + i][r] * w[r];
      cum += logsigmoidf(u) * (1.f / 16.f);
      pre[i] = cum;
    }
    tot[tq][c] = cum;
    __syncthreads();
    float off = 0.f;
#pragma unroll
    for (int t = 0; t < 3; ++t) if (t < tq) off += tot[t][c];
#pragma unroll
    for (int i = 0; i < 16; ++i) {
      const float ex = exp2f((pre[i] + off) * LOG2E);
      qp[(size_t)i * LD0] = (half_t)((float)qv[i] * scale * ex);
      qp[(size_t)i * LD0 + 512] = (half_t)((float)kv[i] * __builtin_amdgcn_rcpf(ex));
      if (tq == 3 && i == 15) P.bcum[(size_t)chunk * 512 + ch] = ex;
    }
  }
}

constexpr int GLA_QE = 0, GLA_KE = 16384, GLA_V = 32768, GLA_DEC = 49152, GLA_BUF = 53248;
#define GLA_TR4(d0, d1, d2, d3, addr, o0, o1, o2, o3) \
  asm volatile("ds_read_b64_tr_b16 %0, %4 offset:%5\n\tds_read_b64_tr_b16 %1, %4 offset:%6\n\tds_read_b64_tr_b16 %2, %4 offset:%7\n\tds_read_b64_tr_b16 %3, %4 offset:%8" \
               : "=&v"(d0), "=&v"(d1), "=&v"(d2), "=&v"(d3) : "v"(addr), "n"(o0), "n"(o1), "n"(o2), "n"(o3) : "memory")
__device__ __forceinline__ half8 pack_h8(const v2i a, const v2i b) { const v4i p = (v4i){a[0], a[1], b[0], b[1]}; return __builtin_bit_cast(half8, p); }

template <bool STATE_ONLY>
__device__ void ph_gla_mfma(const Params& P, char* smem, int wvs) {
  const int tid = otid(wvs);
  const int lane = tid & 63, wave = __builtin_amdgcn_readfirstlane(tid >> 6), r15 = lane & 15, q = lane >> 4;
  const int qp = r15 >> 2, pp = lane & 3;
  const int srow = tid >> 4, sslot = tid & 15;
  const int src_q = (sslot ^ (srow & 15)) * 8, src_kv = (sslot ^ ((srow & 7) << 1)) * 8;
  const int fk = ((4 * (q & 1) + qp) & 7) << 1;
  const unsigned tr_row = (unsigned)((4 * q + qp) * 256 + 8 * (pp & 1) + ((pp >> 1) << 4));
  constexpr int NLOAD = STATE_ONLY ? 5 : 7;
  for (int item = blockIdx.x; item < (STATE_ONLY ? 3 : 4) * 64; item += gridDim.x) {
    const int seg = item >> 6, base = item & 63, b = base >> 3, h = (base >> 1) & 3, vs = base & 1;
    const int c0 = seg * 16;
    f32x4 S[8], Dacc[8];
#pragma unroll
    for (int df = 0; df < 8; ++df) { S[df] = (f32x4){0.f, 0.f, 0.f, 0.f}; Dacc[df] = (f32x4){1.f, 1.f, 1.f, 1.f}; }
    f32x4* stL = (f32x4*)P.gla_state + ((size_t)base * 8 + wave) * 8 * 64 + lane;
    f32x4* stD = stL + (size_t)3 * 64 * 8 * 8 * 64;
    if (!STATE_ONLY) {
      for (int k = 0; k < seg; ++k) {
#pragma unroll
        for (int df = 0; df < 8; ++df) {
          const f32x4 Lk = stL[((size_t)k * 64 * 8 * 8 + df) * 64];
          if (k == 0) S[df] = Lk;
          else { const f32x4 Dk = stD[((size_t)k * 64 * 8 * 8 + df) * 64]; S[df] = Dk * S[df] + Lk; }
        }
      }
    }
    const half_t* qsrc = P.p + (size_t)(b * SEQ + srow) * LD0 + h * 128;
    const half_t* vsrc = P.p + (size_t)(b * SEQ + srow) * LD0 + 1024 + h * 256 + vs * 128 + src_kv;
    const float* dsrc = P.bcum + (size_t)(b * 64 + c0) * 512 + h * 128 + (lane & 31) * 4;
#define G_ISSUE(N, BUF) { char* lb_ = smem + (BUF) * GLA_BUF + wave * 1024; const size_t ro_ = (size_t)(c0 + (N)) * 64 * LD0; \
      if (!STATE_ONLY) { __builtin_amdgcn_global_load_lds((gbl_void*)(qsrc + ro_ + src_q), (lds_void*)(lb_ + GLA_QE), 16, 0, 0); \
      __builtin_amdgcn_global_load_lds((gbl_void*)(qsrc + ro_ + (size_t)32 * LD0 + src_q), (lds_void*)(lb_ + GLA_QE + 8192), 16, 0, 0); } \
      __builtin_amdgcn_global_load_lds((gbl_void*)(qsrc + ro_ + 512 + src_kv), (lds_void*)(lb_ + GLA_KE), 16, 0, 0); \
      __builtin_amdgcn_global_load_lds((gbl_void*)(qsrc + ro_ + (size_t)32 * LD0 + 512 + src_kv), (lds_void*)(lb_ + GLA_KE + 8192), 16, 0, 0); \
      __builtin_amdgcn_global_load_lds((gbl_void*)(vsrc + ro_), (lds_void*)(lb_ + GLA_V), 16, 0, 0); \
      __builtin_amdgcn_global_load_lds((gbl_void*)(vsrc + ro_ + (size_t)32 * LD0), (lds_void*)(lb_ + GLA_V + 8192), 16, 0, 0); \
      if (lane < 32) __builtin_amdgcn_global_load_lds((gbl_void*)(dsrc + (size_t)(N) * 512), (lds_void*)(smem + (BUF) * GLA_BUF + GLA_DEC + wave * 512), 16, 0, 0); }
    G_ISSUE(0, 0)
    G_ISSUE(1, 1)
#pragma unroll 1
    for (int n = 0; n < 16; ++n) {
      if (n + 1 < 16) wait_vmcnt<NLOAD>(); else wait_vmcnt<0>();
      __builtin_amdgcn_s_barrier();
      if (n + 2 < 16) G_ISSUE(n + 2, (n + 2) % 3)
      const char* cb = smem + (n % 3) * GLA_BUF;
      f32x4 aT[4][4];
      if (!STATE_ONLY) {
#pragma unroll
      for (int kf = 0; kf < 4; ++kf)
#pragma unroll
        for (int tf = 0; tf < 4; ++tf) aT[kf][tf] = (f32x4){0.f, 0.f, 0.f, 0.f};
#pragma unroll
      for (int ks = 0; ks < 4; ++ks) {
        half8 kef[4], qef[4];
#pragma unroll
        for (int f = 0; f < 4; ++f) {
          kef[f] = *(const half8*)(cb + GLA_KE + (16 * f + r15) * 256 + (((4 * ks + q) ^ ((r15 & 7) << 1)) << 4));
          qef[f] = *(const half8*)(cb + GLA_QE + (16 * f + r15) * 256 + (((4 * ks + q) ^ r15) << 4));
        }
#pragma unroll
        for (int kf = 0; kf < 4; ++kf)
#pragma unroll
          for (int tf = kf; tf < 4; ++tf) aT[kf][tf] = __builtin_amdgcn_mfma_f32_16x16x32_f16(kef[kf], qef[tf], aT[kf][tf], 0, 0, 0);
      }
#pragma unroll
      for (int f = 0; f < 4; ++f)
#pragma unroll
        for (int r = 0; r < 4; ++r) if (4 * q + r > r15) aT[f][f][r] = 0.f;
      }
      const unsigned lds0 = (unsigned)(size_t)cb;
      const unsigned va = lds0 + GLA_V + tr_row + ((((2 * wave) ^ fk)) << 4);
      v2i v00, v01, v10, v11;
      GLA_TR4(v00, v01, v10, v11, va, 0, 4096, 8192, 12288);
      const unsigned ka = lds0 + GLA_KE + tr_row;
      v2i k0[4][4];
#pragma unroll
      for (int df = 0; df < 4; ++df) { const unsigned a_ = ka + ((((2 * df) ^ fk)) << 4); GLA_TR4(k0[df][0], k0[df][1], k0[df][2], k0[df][3], a_, 0, 4096, 8192, 12288); }
      asm volatile("s_waitcnt lgkmcnt(15)" : "+v"(v00), "+v"(v01), "+v"(v10), "+v"(v11) :: "memory");
      __builtin_amdgcn_sched_barrier(0);
      half8 vf[2];
      vf[0] = pack_h8(v00, v01); vf[1] = pack_h8(v10, v11);
      if (!STATE_ONLY) {
      f32x4 o[4];
#pragma unroll
      for (int tf = 0; tf < 4; ++tf) o[tf] = (f32x4){0.f, 0.f, 0.f, 0.f};
#pragma unroll
      for (int ks2 = 0; ks2 < 2; ++ks2)
#pragma unroll
        for (int tf = 2 * ks2; tf < 4; ++tf) {
          half8 pk;
#pragma unroll
          for (int r = 0; r < 4; ++r) { pk[r] = (half_t)aT[2 * ks2][tf][r]; pk[4 + r] = (half_t)aT[2 * ks2 + 1][tf][r]; }
          o[tf] = __builtin_amdgcn_mfma_f32_16x16x32_f16(vf[ks2], pk, o[tf], 0, 0, 0);
        }
#pragma unroll
      for (int ks = 0; ks < 4; ++ks) {
        half8 sf;
#pragma unroll
        for (int r = 0; r < 4; ++r) { sf[r] = (half_t)S[2 * ks][r]; sf[4 + r] = (half_t)S[2 * ks + 1][r]; }
#pragma unroll
        for (int tf = 0; tf < 4; ++tf) {
          const int row = 16 * tf + r15;
          const half4 qa = *(const half4*)(cb + GLA_QE + row * 256 + (((4 * ks + (q >> 1)) ^ r15) << 4) + (q & 1) * 8);
          const half4 qb = *(const half4*)(cb + GLA_QE + row * 256 + (((4 * ks + 2 + (q >> 1)) ^ r15) << 4) + (q & 1) * 8);
          half8 qv;
#pragma unroll
          for (int e = 0; e < 4; ++e) { qv[e] = qa[e]; qv[4 + e] = qb[e]; }
          o[tf] = __builtin_amdgcn_mfma_f32_16x16x32_f16(sf, qv, o[tf], 0, 0, 0);
        }
      }
      {
        const size_t t0 = (size_t)(b * SEQ + (c0 + n) * 64);
#pragma unroll
        for (int tf = 0; tf < 4; ++tf) {
          half4 hv; hv[0] = (half_t)o[tf][0]; hv[1] = (half_t)o[tf][1]; hv[2] = (half_t)o[tf][2]; hv[3] = (half_t)o[tf][3];
          *(half4*)(P.og + (t0 + 16 * tf + r15) * DM + h * 256 + vs * 128 + 16 * wave + 4 * q) = hv;
        }
      }
      }
      v2i k1[4][4];
#pragma unroll
      for (int df = 0; df < 4; ++df) { const unsigned a_ = ka + ((((2 * (df + 4)) ^ fk)) << 4); GLA_TR4(k1[df][0], k1[df][1], k1[df][2], k1[df][3], a_, 0, 4096, 8192, 12288); }
      asm volatile("s_waitcnt lgkmcnt(15)"
                   : "+v"(k0[0][0]), "+v"(k0[0][1]), "+v"(k0[0][2]), "+v"(k0[0][3]), "+v"(k0[1][0]), "+v"(k0[1][1]), "+v"(k0[1][2]), "+v"(k0[1][3]),
                     "+v"(k0[2][0]), "+v"(k0[2][1]), "+v"(k0[2][2]), "+v"(k0[2][3]), "+v"(k0[3][0]), "+v"(k0[3][1]), "+v"(k0[3][2]), "+v"(k0[3][3]) :: "memory");
      __builtin_amdgcn_sched_barrier(0);
#pragma unroll
      for (int df = 0; df < 4; ++df) {
        S[df] = __builtin_amdgcn_mfma_f32_16x16x32_f16(pack_h8(k0[df][0], k0[df][1]), vf[0], S[df], 0, 0, 0);
        S[df] = __builtin_amdgcn_mfma_f32_16x16x32_f16(pack_h8(k0[df][2], k0[df][3]), vf[1], S[df], 0, 0, 0);
      }
      asm volatile("s_waitcnt lgkmcnt(0)"
                   : "+v"(k1[0][0]), "+v"(k1[0][1]), "+v"(k1[0][2]), "+v"(k1[0][3]), "+v"(k1[1][0]), "+v"(k1[1][1]), "+v"(k1[1][2]), "+v"(k1[1][3]),
                     "+v"(k1[2][0]), "+v"(k1[2][1]), "+v"(k1[2][2]), "+v"(k1[2][3]), "+v"(k1[3][0]), "+v"(k1[3][1]), "+v"(k1[3][2]), "+v"(k1[3][3]) :: "memory");
      __builtin_amdgcn_sched_barrier(0);
#pragma unroll
      for (int df = 0; df < 4; ++df) {
        S[df + 4] = __builtin_amdgcn_mfma_f32_16x16x32_f16(pack_h8(k1[df][0], k1[df][1]), vf[0], S[df + 4], 0, 0, 0);
        S[df + 4] = __builtin_amdgcn_mfma_f32_16x16x32_f16(pack_h8(k1[df][2], k1[df][3]), vf[1], S[df + 4], 0, 0, 0);
      }
#pragma unroll
      for (int df = 0; df < 8; ++df) {
        const f32x4 dc = *(const f32x4*)(cb + GLA_DEC + wave * 512 + (16 * df + 4 * q) * 4);
        S[df] *= dc;
        if (STATE_ONLY) Dacc[df] *= dc;
      }
    }
    if (STATE_ONLY) {
#pragma unroll
      for (int df = 0; df < 8; ++df) { stL[((size_t)seg * 64 * 8 * 8 + df) * 64] = S[df]; stD[((size_t)seg * 64 * 8 * 8 + df) * 64] = Dacc[df]; }
    }
    asm volatile("s_waitcnt vmcnt(0)" ::: "memory");
    __builtin_amdgcn_s_barrier();
#undef G_ISSUE
  }
}

__device__ void ph_gla_post(const Params& P, int wvs) {
  const int tid_ = otid(wvs); const int lane = tid_ & 63, sub = lane & 31;
  const int u0 = blockIdx.x * 16 + (tid_ >> 5);
  const float4 hn0 = ((const float4*)P.gla_head_norm)[sub * 2], hn1 = ((const float4*)P.gla_head_norm)[sub * 2 + 1];
#pragma unroll 2
  for (int u = u0; u < T_TOK * 4; u += gridDim.x * 16) {
    const int t = u >> 2, h = u & 3;
    half8* op = (half8*)(P.og + (size_t)t * DM + h * 256) + sub;
    const half8 hv = *op;
    const half8 z = *((const half8*)(P.p + (size_t)t * LD0 + 2048 + h * 256) + sub);
    float v[8]; float ss = 0.f;
#pragma unroll
    for (int e = 0; e < 8; ++e) { v[e] = (float)hv[e]; ss += v[e] * v[e]; }
#pragma unroll
    for (int o = 16; o > 0; o >>= 1) ss += __shfl_xor(ss, o);
    const float r = rsqrtf(ss * (1.f / 256.f) + EPS);
    const float hn[8] = {hn0.x, hn0.y, hn0.z, hn0.w, hn1.x, hn1.y, hn1.z, hn1.w};
    half8 o;
#pragma unroll
    for (int e = 0; e < 8; ++e) o[e] = (half_t)(v[e] * r * hn[e] * siluf((float)z[e]));
    *op = o;
  }
}

__device__ void ph_post(const float* base, const half_t* y, const float* g, float* dst, half_t* dsth, float* rstd_out, int wvs) {
  const int tid_ = otid(wvs); const int lane = tid_ & 63, w = tid_ >> 6;
#pragma unroll 2
  for (int row = blockIdx.x * NWAVES + w; row < T_TOK; row += gridDim.x * NWAVES) {
    const half4* yr = (const half4*)(y + (size_t)row * DM);
    const float4* br = (const float4*)(base + (size_t)row * DM);
    float4* dr = (float4*)(dst + (size_t)row * DM);
    float4 v[4]; float ss = 0.f;
#pragma unroll
    for (int i = 0; i < 4; ++i) {
      const half4 hv = yr[lane + 64 * i];
      v[i].x = (float)hv[0]; v[i].y = (float)hv[1]; v[i].z = (float)hv[2]; v[i].w = (float)hv[3];
      ss += v[i].x * v[i].x + v[i].y * v[i].y + v[i].z * v[i].z + v[i].w * v[i].w;
    }
    ss = wave_sum(ss);
    const float r = rsqrtf(ss * (1.f / DM) + EPS);
    float s2 = 0.f;
#pragma unroll
    for (int i = 0; i < 4; ++i) {
      const float4 gg = ((const float4*)g)[lane + 64 * i];
      const float4 bb = br[lane + 64 * i];
      float4 o;
      o.x = bb.x + v[i].x * r * gg.x; o.y = bb.y + v[i].y * r * gg.y; o.z = bb.z + v[i].z * r * gg.z; o.w = bb.w + v[i].w * r * gg.w;
      s2 += o.x * o.x + o.y * o.y + o.z * o.z + o.w * o.w;
      dr[lane + 64 * i] = o;
      if (dsth) {
        half4 hv; hv[0] = (half_t)o.x; hv[1] = (half_t)o.y; hv[2] = (half_t)o.z; hv[3] = (half_t)o.w;
        ((half4*)(dsth + (size_t)row * DM))[lane + 64 * i] = hv;
      }
    }
    if (rstd_out) { s2 = wave_sum(s2); if (lane == 0) rstd_out[row] = rsqrtf(s2 * (1.f / DM) + EPS); }
  }
}

__device__ void ph_kmax(const Params& P, int wvs) {
  const int tid = otid(wvs);
  for (int task = blockIdx.x; task < NBATCH * 4 * 2 * 8; task += gridDim.x) {
    const int chunk = task & 7, br = (task >> 3) & 1, bg = task >> 4, b = bg >> 2, g = bg & 3;
    const half_t* kp = P.p + (size_t)(b * SEQ + chunk * 512 + tid) * LD1 + (br ? 2048 : 1536) + g * 64;
    float ss = 0.f;
#pragma unroll
    for (int c = 0; c < 8; ++c) {
      const half8 v = *(const half8*)(kp + c * 8);
#pragma unroll
      for (int e = 0; e < 8; ++e) ss += (float)v[e] * (float)v[e];
    }
    ss = wave_max(ss);
    if ((tid & 63) == 0) __hip_atomic_fetch_max(&P.kmax2[bg * 2 + br], __float_as_uint(ss), __ATOMIC_RELAXED, __HIP_MEMORY_SCOPE_AGENT);
  }
}

constexpr int ATT_NB = 6, ATT_D = 5;
constexpr int ATT_K = 0, ATT_V = ATT_NB * 8192, ATT_IMP = 2 * ATT_NB * 8192, ATT_SELM = ATT_IMP + 64 * 68 * 4;
constexpr int IMPS = 68;
constexpr int ATT_GATE = ATT_SELM + 512;

template <int MODE>
__device__ __forceinline__ void attn_branch(char* smem, const half_t* kbase, const half_t* vbase, int ld, int tile_lo, int tile_hi, int n, int th,
                                            const half8 (&qf)[2][2], float (&m)[2], float (&l)[2], f32x4 (&o)[4][2],
                                            const unsigned long long (&selm)[2], int wvs) {
  const int tid = otid(wvs);
  const int lane = tid & 63, r15 = lane & 15, q = lane >> 4;
  const int lrow = tid >> 3, lch = tid & 7;
  const int k_rd = r15 * 128, kswz = r15 >> 1;
  const int qp = r15 >> 2, pp = lane & 3;
  const int fx = ((2 * q + (qp >> 1)) & 3) << 1;
  const int v_rd = (4 * q + qp) * 128 + 8 * (pp & 1) + ((pp >> 1) << 4);
  unsigned int* impu = (unsigned int*)(smem + ATT_IMP);
  const int ksrc = (lch ^ ((lrow >> 1) & 7)) * 8, vsrc = (lch ^ (((lrow >> 1) & 3) << 1)) * 8;
  const int wbase = __builtin_amdgcn_readfirstlane(tid >> 6) * 1024;
#define A_GLOAD(TI, BUF) { const half_t* kp_ = kbase + (size_t)((TI) * 64 + lrow) * ld + ksrc; \
    __builtin_amdgcn_global_load_lds((gbl_void*)kp_, (lds_void*)(smem + ATT_K + (BUF) * 8192 + wbase), 16, 0, 0); \
    if (MODE != 0) { const half_t* vp_ = vbase + (size_t)((TI) * 64 + lrow) * ld + vsrc; \
      __builtin_amdgcn_global_load_lds((gbl_void*)vp_, (lds_void*)(smem + ATT_V + (BUF) * 8192 + wbase), 16, 0, 0); } }
  constexpr int GPT = (MODE == 0) ? 1 : 2;
#pragma unroll
  for (int i = 0; i < ATT_D; ++i) if (tile_lo + i <= tile_hi) A_GLOAD(tile_lo + i, i)
#pragma unroll 1
  for (int ti = tile_lo; ti <= tile_hi; ++ti) {
    const int it = ti - tile_lo, cur = it % ATT_NB;
    {
      const int rem = tile_hi - ti;
      if (rem >= 4) wait_vmcnt<4 * GPT>(); else if (rem == 3) wait_vmcnt<3 * GPT>(); else if (rem == 2) wait_vmcnt<2 * GPT>();
      else if (rem == 1) wait_vmcnt<1 * GPT>(); else wait_vmcnt<0>();
    }
    __builtin_amdgcn_s_barrier();
    if (ti + ATT_D <= tile_hi) A_GLOAD(ti + ATT_D, (it + ATT_D) % ATT_NB)
    const char* kb = smem + ATT_K + cur * 8192 + k_rd;
    const unsigned vbl = (unsigned)(size_t)(smem + ATT_V + cur * 8192 + v_rd);
    bool need_mask;
    if (MODE <= 1) need_mask = (ti * 64 + 63 > 4 * n - 2);
    else if (MODE == 2) need_mask = (ti == n);
    else need_mask = (ti == n) || (ti == n - 8);
    f32x4 s[4][2];
#pragma unroll
    for (int kf = 0; kf < 4; ++kf)
#pragma unroll
      for (int t2 = 0; t2 < 2; ++t2) s[kf][t2] = (f32x4){0.f, 0.f, 0.f, 0.f};
#pragma unroll
    for (int ks = 0; ks < 2; ++ks) {
      const int co = ((4 * ks + q) ^ kswz) << 4;
#pragma unroll
      for (int kf = 0; kf < 4; ++kf) {
        const half8 kfr = *(const half8*)(kb + kf * 2048 + co);
#pragma unroll
        for (int t2 = 0; t2 < 2; ++t2) s[kf][t2] = __builtin_amdgcn_mfma_f32_16x16x32_f16(kfr, qf[t2][ks], s[kf][t2], 0, 0, 0);
      }
    }
    v2i vr[4][4];
    if (MODE != 0) {
      const unsigned va0 = vbl + (((0) ^ fx) << 4), va1 = vbl + (((2) ^ fx) << 4), va2 = vbl + (((4) ^ fx) << 4), va3 = vbl + (((6) ^ fx) << 4);
      asm volatile(
          "ds_read_b64_tr_b16 %0, %16\n\tds_read_b64_tr_b16 %1, %16 offset:2048\n\tds_read_b64_tr_b16 %2, %16 offset:4096\n\tds_read_b64_tr_b16 %3, %16 offset:6144\n\t"
          "ds_read_b64_tr_b16 %4, %17\n\tds_read_b64_tr_b16 %5, %17 offset:2048\n\tds_read_b64_tr_b16 %6, %17 offset:4096\n\tds_read_b64_tr_b16 %7, %17 offset:6144\n\t"
          "ds_read_b64_tr_b16 %8, %18\n\tds_read_b64_tr_b16 %9, %18 offset:2048\n\tds_read_b64_tr_b16 %10, %18 offset:4096\n\tds_read_b64_tr_b16 %11, %18 offset:6144\n\t"
          "ds_read_b64_tr_b16 %12, %19\n\tds_read_b64_tr_b16 %13, %19 offset:2048\n\tds_read_b64_tr_b16 %14, %19 offset:4096\n\tds_read_b64_tr_b16 %15, %19 offset:6144"
          : "=&v"(vr[0][0]), "=&v"(vr[0][1]), "=&v"(vr[0][2]), "=&v"(vr[0][3]), "=&v"(vr[1][0]), "=&v"(vr[1][1]), "=&v"(vr[1][2]), "=&v"(vr[1][3]),
            "=&v"(vr[2][0]), "=&v"(vr[2][1]), "=&v"(vr[2][2]), "=&v"(vr[2][3]), "=&v"(vr[3][0]), "=&v"(vr[3][1]), "=&v"(vr[3][2]), "=&v"(vr[3][3])
          : "v"(va0), "v"(va1), "v"(va2), "v"(va3)
          : "memory");
    }
    if (need_mask) {
#pragma unroll
      for (int t2 = 0; t2 < 2; ++t2) {
        const int tok = th * 32 + t2 * 16 + r15;
        int lo = 0, hi = 63;
        if (MODE <= 1) { hi = 4 * n + ((tok - 31) >> 4) - ti * 64; }
        else if (MODE == 2) { hi = tok; }
        else { if (ti == n) hi = tok; else lo = tok + 1; }
#pragma unroll
        for (int kf = 0; kf < 4; ++kf)
#pragma unroll
          for (int r = 0; r < 4; ++r) {
            const int kk = kf * 16 + 4 * q + r;
            if (kk < lo || kk > hi) s[kf][t2][r] = -INFINITY;
          }
      }
    }
    half8 pf[2][2];
#pragma unroll
    for (int t2 = 0; t2 < 2; ++t2) {
      float mb, scale_p = 1.f;
      if (MODE == 1) {
        mb = m[t2] * LOG2E; scale_p = l[t2];
      } else if (MODE >= 2) {
        mb = m[t2] * LOG2E;
        if (MODE == 2 && !((selm[t2] >> ti) & 1ull)) mb = INFINITY;
      } else {
        float tm = s[0][t2][0];
#pragma unroll
        for (int kf = 0; kf < 4; ++kf)
#pragma unroll
          for (int r = 0; r < 4; ++r) tm = fmaxf(tm, s[kf][t2][r]);
        tm = rowmax4(tm);
        const float mn = fmaxf(m[t2], tm);
        const float alpha = fexp2((m[t2] - mn) * LOG2E);
        m[t2] = mn; mb = mn * LOG2E;
        l[t2] *= alpha;
      }
      float lsum = 0.f;
#pragma unroll
      for (int kf = 0; kf < 4; ++kf) {
#pragma unroll
        for (int r = 0; r < 4; ++r) {
          float pv = fexp2(fmaf(s[kf][t2][r], LOG2E, -mb));
          if (MODE == 1) pv *= scale_p;
          s[kf][t2][r] = pv; lsum += pv;
        }
      }
      if (MODE != 1) l[t2] += lsum;
      if (MODE == 1) {
        const int tok = th * 32 + t2 * 16 + r15;
#pragma unroll
        for (int kf = 0; kf < 4; ++kf) {
          const int j = 16 * ti + 4 * kf + q;
          const unsigned int u0 = (unsigned int)(s[kf][t2][0] * 134217728.f + 0.5f), u1 = (unsigned int)(s[kf][t2][1] * 134217728.f + 0.5f);
          const unsigned int u2 = (unsigned int)(s[kf][t2][2] * 134217728.f + 0.5f), u3 = (unsigned int)(s[kf][t2][3] * 134217728.f + 0.5f);
          if (j < 64) {
            atomicAdd(&impu[tok * IMPS + j], u0 + u1 + u2 + u3);
            atomicAdd(&impu[tok * IMPS + j + 1], u3);
          }
        }
      }
      if (MODE != 0) {
#pragma unroll
        for (int ks = 0; ks < 2; ++ks) {
          half8 pk;
#pragma unroll
          for (int r = 0; r < 4; ++r) { pk[r] = (half_t)s[2 * ks][t2][r]; pk[4 + r] = (half_t)s[2 * ks + 1][t2][r]; }
          pf[t2][ks] = pk;
        }
      }
    }
    if (MODE != 0) {
      asm volatile("s_waitcnt lgkmcnt(0)"
                   : "+v"(vr[0][0]), "+v"(vr[0][1]), "+v"(vr[0][2]), "+v"(vr[0][3]), "+v"(vr[1][0]), "+v"(vr[1][1]), "+v"(vr[1][2]), "+v"(vr[1][3]),
                     "+v"(vr[2][0]), "+v"(vr[2][1]), "+v"(vr[2][2]), "+v"(vr[2][3]), "+v"(vr[3][0]), "+v"(vr[3][1]), "+v"(vr[3][2]), "+v"(vr[3][3])
                   :: "memory");
      __builtin_amdgcn_sched_barrier(0);
#pragma unroll
      for (int df = 0; df < 4; ++df) {
#pragma unroll
        for (int ks = 0; ks < 2; ++ks) {
          const v2i lo2 = vr[df][2 * ks], hi2 = vr[df][2 * ks + 1];
          const v4i pk4 = (v4i){lo2[0], lo2[1], hi2[0], hi2[1]};
          const half8 vf = __builtin_bit_cast(half8, pk4);
#pragma unroll
          for (int t2 = 0; t2 < 2; ++t2) o[df][t2] = __builtin_amdgcn_mfma_f32_16x16x32_f16(vf, pf[t2][ks], o[df][t2], 0, 0, 0);
        }
      }
    }
  }
  __syncthreads();
#undef A_GLOAD
}

__device__ void ph_attn_mfma(const Params& P, char* smem, int wvs) {
  unsigned int* impu = (unsigned int*)(smem + ATT_IMP);
  unsigned long long* selmask = (unsigned long long*)(smem + ATT_SELM);
  const int G = gridDim.x, nrounds = (2048 + G - 1) / G;
  for (int rd = 0; rd < nrounds; ++rd) {
    const int idx = rd * G + ((rd & 1) ? (G - 1 - (int)blockIdx.x) : (int)blockIdx.x);
    if (idx >= 2048) continue;
    const int tid = otid(wvs), lane = tid & 63, r15 = lane & 15, q = lane >> 4;
    const int n = 63 - (idx >> 5), bg = idx & 31, b = bg >> 2, g = bg & 3;
    const int wv = __builtin_amdgcn_readfirstlane(otid(wvs) >> 6);
    const int hd = g * 4 + (wv & 3), th = wv >> 2;
    const int t0 = b * SEQ + n * 64 + th * 32;
    half8 qf[2][2];
#pragma unroll
    for (int t2 = 0; t2 < 2; ++t2)
#pragma unroll
      for (int ks = 0; ks < 2; ++ks) qf[t2][ks] = *(const half8*)(P.p + (size_t)(t0 + t2 * 16 + r15) * LD1 + hd * 64 + 32 * ks + 8 * q);
    float* gate_l = (float*)(smem + ATT_GATE) + wv * 128;
    if (q == 0) {
#pragma unroll
      for (int t2 = 0; t2 < 2; ++t2) {
        const half_t* pr = P.p + (size_t)(t0 + t2 * 16 + r15) * LD1 + 3584 + hd * 3;
        f32x4 gv;
#pragma unroll
        for (int c = 0; c < 3; ++c) gv[c] = sigmoidf((float)pr[c] + P.nsa_b_gate[hd * 3 + c]);
        gv[3] = 0.f;
        *(f32x4*)(gate_l + (t2 * 16 + r15) * 4) = gv;
      }
    }
    { const int tz = otid(wvs); for (int i = tz; i < 64 * IMPS + 128; i += NTHREADS) impu[i] = 0u; }
    float m[2], l[2]; f32x4 o[4][2]; unsigned long long selm[2] = {0ull, 0ull};
#pragma unroll
    for (int t2 = 0; t2 < 2; ++t2) { m[t2] = -1e30f; l[t2] = 0.f; }
#pragma unroll
    for (int df = 0; df < 4; ++df)
#pragma unroll
      for (int t2 = 0; t2 < 2; ++t2) o[df][t2] = (f32x4){0.f, 0.f, 0.f, 0.f};
    const half_t* kc = P.kcmp + (size_t)bg * 256 * 64;
    const half_t* vc = P.vcmp + (size_t)bg * 256 * 64;
    const int nct = (4 * n + 2) / 64;
    attn_branch<0>(smem, kc, vc, 64, 0, nct, n, th, qf, m, l, o, selm, wvs);
#pragma unroll
    for (int t2 = 0; t2 < 2; ++t2) {
      float lt = l[t2];
      lt = rowsum4(lt);
      l[t2] = lt > 0.f ? 1.f / lt : 0.f;
    }
    attn_branch<1>(smem, kc, vc, 64, 0, nct, n, th, qf, m, l, o, selm, wvs);
    f32x4 oacc[4][2];
#pragma unroll
    for (int t2 = 0; t2 < 2; ++t2) {
      const float gc = gate_l[(t2 * 16 + r15) * 4 + 0];
#pragma unroll
      for (int df = 0; df < 4; ++df) oacc[df][t2] = o[df][t2] * gc;
    }
    {
      const int tid2 = otid(wvs);
      const int tok = tid2 >> 3, part = tid2 & 7;
      unsigned long long msk;
      if (n + 1 <= 16) {
        msk = (1ull << (n + 1)) - 1ull;
      } else {
        const uint4* rowp = (const uint4*)(impu + tok * IMPS);
        unsigned own[8];
        { const uint4 a = rowp[part * 2], b2 = rowp[part * 2 + 1];
          own[0] = a.x; own[1] = a.y; own[2] = a.z; own[3] = a.w; own[4] = b2.x; own[5] = b2.y; own[6] = b2.z; own[7] = b2.w; }
        int rank[8];
#pragma unroll
        for (int jj = 0; jj < 8; ++jj) {
          const int j = part * 8 + jj;
          own[jj] = (j >= 1 && j <= n - 2) ? ((own[jj] & ~63u) | (unsigned)(63 - j)) : 0xffffffffu;
          rank[jj] = 0;
        }
#pragma unroll 2
        for (int c4 = 0; c4 < 16; ++c4) {
          const uint4 v = rowp[c4];
          unsigned kv[4] = {v.x, v.y, v.z, v.w};
#pragma unroll
          for (int e = 0; e < 4; ++e) {
            const int j2 = c4 * 4 + e;
            const unsigned key2 = (j2 >= 1 && j2 <= n - 2) ? ((kv[e] & ~63u) | (unsigned)(63 - j2)) : 0u;
#pragma unroll
            for (int jj = 0; jj < 8; ++jj) rank[jj] += (key2 > own[jj]) ? 1 : 0;
          }
        }
        unsigned int bits = 0;
#pragma unroll
        for (int jj = 0; jj < 8; ++jj) if (rank[jj] < 13 && own[jj] != 0xffffffffu) bits |= 1u << jj;
        unsigned* sel32 = (unsigned*)selmask;
        if (bits) atomicOr(&sel32[tok * 2 + (part >> 2)], bits << (8 * (part & 3)));
        msk = 1ull | (1ull << n) | (1ull << (n - 1));
        if (part == 0) { atomicOr(&sel32[tok * 2], (unsigned)msk); atomicOr(&sel32[tok * 2 + 1], (unsigned)(msk >> 32)); }
      }
      if (n + 1 <= 16 && part == 0) selmask[tok] = msk;
    }
    __syncthreads();
#pragma unroll
    for (int t2 = 0; t2 < 2; ++t2) selm[t2] = selmask[th * 32 + t2 * 16 + r15];
    float qn2[2];
#pragma unroll
    for (int t2 = 0; t2 < 2; ++t2) {
      float a = 0.f;
#pragma unroll
      for (int ks = 0; ks < 2; ++ks)
#pragma unroll
        for (int e = 0; e < 8; ++e) a += (float)qf[t2][ks][e] * (float)qf[t2][ks][e];
      qn2[t2] = rowsum4(a);
    }
    { const float km = __uint_as_float(P.kmax2[bg * 2 + 0]);
#pragma unroll
      for (int t2 = 0; t2 < 2; ++t2) { m[t2] = sqrtf(qn2[t2] * km) * 1.001f - 5.0f; l[t2] = 0.f; } }
#pragma unroll
    for (int df = 0; df < 4; ++df)
#pragma unroll
      for (int t2 = 0; t2 < 2; ++t2) o[df][t2] = (f32x4){0.f, 0.f, 0.f, 0.f};
    attn_branch<2>(smem, P.p + (size_t)b * SEQ * LD1 + 1536 + g * 64, P.p + (size_t)b * SEQ * LD1 + 1792 + g * 64, LD1, 0, n, n, th, qf, m, l, o, selm, wvs);
#pragma unroll
    for (int t2 = 0; t2 < 2; ++t2) {
      const float gs = gate_l[(t2 * 16 + r15) * 4 + 1] / rowsum4(l[t2]);
#pragma unroll
      for (int df = 0; df < 4; ++df) oacc[df][t2] += o[df][t2] * gs;
    }
    { const float km = __uint_as_float(P.kmax2[bg * 2 + 1]);
#pragma unroll
      for (int t2 = 0; t2 < 2; ++t2) { m[t2] = sqrtf(qn2[t2] * km) * 1.001f - 5.0f; l[t2] = 0.f; } }
#pragma unroll
    for (int df = 0; df < 4; ++df)
#pragma unroll
      for (int t2 = 0; t2 < 2; ++t2) o[df][t2] = (f32x4){0.f, 0.f, 0.f, 0.f};
    attn_branch<3>(smem, P.p + (size_t)b * SEQ * LD1 + 2048 + g * 64, P.p + (size_t)b * SEQ * LD1 + 2304 + g * 64, LD1, (n > 8 ? n - 8 : 0), n, n, th, qf, m, l, o, selm, wvs);
    {
      int tbase = t0 + r15; asm volatile("" : "+v"(tbase));
#pragma unroll
      for (int t2 = 0; t2 < 2; ++t2) {
        const size_t tok = (size_t)(tbase + t2 * 16);
        const float gw = gate_l[(t2 * 16 + r15) * 4 + 2] / rowsum4(l[t2]);
#pragma unroll
        for (int df = 0; df < 4; ++df) {
          const f32x4 v = oacc[df][t2] + o[df][t2] * gw;
          const half4 z = *(const half4*)(P.p + tok * LD1 + 2560 + hd * 64 + df * 16 + 4 * q);
          half4 hv;
#pragma unroll
          for (int e = 0; e < 4; ++e) hv[e] = (half_t)(v[e] * siluf((float)z[e]));
          *(half4*)(P.og + tok * DM + hd * 64 + df * 16 + 4 * q) = hv;
        }
      }
    }
  }
}

constexpr int NPHASES = 13;
__device__ __forceinline__ void run_phase(int ph, const Params& P, char* smem, int wvs) {
  float* sm = (float*)smem;
  switch (ph) {
    case 0:
      if (blockIdx.x == 0 && otid(wvs) < 64) P.kmax2[otid(wvs)] = 0u;
      ph_xh_rstd(P.x, P.xh, P.rstd, wvs); ph_ropetab(P, wvs); prep_cbias_part(P, wvs);
      prep_wT(P.gla_w_in, GLA_IN, P.pre_norm, P.W0t, LD0, DM, 0, sm, wvs);
      prep_wT(P.gla_w_out, DM, nullptr, P.Wo0t, DM, DM, 2, sm, wvs);
      prep_wT(P.nsa_w_in, NSA_IN, P.pre_norm + DM, P.W1t, LD1, DM, 1, sm, wvs);
      prep_wT(P.nsa_w_out, DM, nullptr, P.Wo1t, DM, DM, 2, sm, wvs);
      prep_wT(P.ck_w1, 256, nullptr, P.cw1t, 256, 2048, 2, sm, wvs);
      prep_wT(P.cv_w1, 256, nullptr, P.cw1t + 256 * 2048, 256, 2048, 2, sm, wvs);
      prep_wT(P.ck_w2, 64, nullptr, P.cw2t, 256, 256, 4, sm, wvs);
      prep_wT(P.cv_w2, 64, nullptr, P.cw2t + 256 * 256, 256, 256, 4, sm, wvs);
      break;
    case 1: g8::gemm(g8::SrcPlain8{P.xh, DM, P.W0t, DM}, T_TOK, LD0, DM, g8::EpiStore8{P.p, LD0, P.rstd}, smem, wvs); break;
    case 2: prep_cbias_reduce(P, wvs); ph_gla_prep(P, sm, wvs); break;
    case 13: ph_gla_mfma<true>(P, smem, wvs); break;
    case 3: ph_gla_mfma<false>(P, smem, wvs); break;
    case 4: ph_gla_post(P, wvs); break;
    case 5: g8::gemm(g8::SrcPlain8{P.og, DM, P.Wo0t, DM}, T_TOK, DM, DM, g8::EpiStore8{P.y, DM, nullptr}, smem, wvs); break;
    case 6: ph_post(P.x, P.y, P.post_norm, P.out, P.xh, P.rstd, wvs); break;
    case 7: g8::gemm(g8::SrcPlain8{P.xh, DM, P.W1t, DM}, T_TOK, LD1, DM, g8::EpiRope8{P.p, LD1, P.rstd, P.ropetab}, smem, wvs); break;
    case 8: g8::gemm(g8::SrcCmp1_8{P.p, P.cw1t}, 16384, 256, 2048, g8::EpiCmpHid8{P.hid, P.cbias}, smem, wvs); break;
    case 9: ph_kmax(P, wvs); g8::gemm(g8::SrcCmp2_8{P.hid, P.cw2t}, 16384, 256, 256, g8::EpiCmpOut8{P.kcmp, P.vcmp}, smem, wvs); break;
    case 10: ph_attn_mfma(P, smem, wvs); break;
    case 11: g8::gemm(g8::SrcPlain8{P.og, DM, P.Wo1t, DM}, T_TOK, DM, DM, g8::EpiStore8{P.y, DM, nullptr}, smem, wvs); break;
    case 12: ph_post(P.out, P.y, P.post_norm + DM, P.out, nullptr, nullptr, wvs); break;
  }
}

template <int PH>
__global__ void __launch_bounds__(NTHREADS, 2) k_phase(Params P) {
  __shared__ __attribute__((aligned(16))) char smem[SMEM_BYTES];
  run_phase(PH, P, smem, __builtin_amdgcn_readfirstlane(threadIdx.x >> 6));
}
template <int PH>
static void launch_phases(const Params& P, hipStream_t stream) {
  hipLaunchKernelGGL((k_phase<PH>), dim3(256), dim3(NTHREADS), 0, stream, P);
  if constexpr (PH + 1 < NPHASES) launch_phases<PH + 1>(P, stream);
}

#if MEGA
__global__ void __launch_bounds__(NTHREADS, 2) k_mega(Params P) {
  __shared__ __attribute__((aligned(16))) char smem[SMEM_BYTES];
  cg::grid_group grid = cg::this_grid();
  if (P.use_cg_sync) grid.sync();
  unsigned bt = 0;
  const int wvs = __builtin_amdgcn_readfirstlane(threadIdx.x >> 6);
  run_phase(0, P, smem, wvs); fast_barrier(P.bar, bt, wvs);
  run_phase(1, P, smem, wvs); fast_barrier(P.bar, bt, wvs);
  run_phase(2, P, smem, wvs); fast_barrier(P.bar, bt, wvs);
  run_phase(13, P, smem, wvs); fast_barrier(P.bar, bt, wvs);
  run_phase(3, P, smem, wvs); fast_barrier(P.bar, bt, wvs);
  run_phase(4, P, smem, wvs); fast_barrier(P.bar, bt, wvs);
  run_phase(5, P, smem, wvs); fast_barrier(P.bar, bt, wvs);
  run_phase(6, P, smem, wvs); fast_barrier(P.bar, bt, wvs);
  run_phase(7, P, smem, wvs); fast_barrier(P.bar, bt, wvs);
  run_phase(8, P, smem, wvs); fast_barrier(P.bar, bt, wvs);
  run_phase(9, P, smem, wvs); fast_barrier(P.bar, bt, wvs);
  run_phase(10, P, smem, wvs); fast_barrier(P.bar, bt, wvs);
  run_phase(11, P, smem, wvs); fast_barrier(P.bar, bt, wvs);
  run_phase(12, P, smem, wvs);
}
#endif

extern "C" void kernel_launch(void* const* d_in, const int* in_sizes, int n_in, void* d_out, int out_size, void* d_ws, size_t ws_size,
                              hipStream_t stream) {
  Params P{};
  P.x = (const float*)d_in[0]; P.pos = (const int*)d_in[1]; P.pre_norm = (const float*)d_in[2]; P.post_norm = (const float*)d_in[3];
  P.gla_w_in = (const float*)d_in[4]; P.gla_w_gk_up = (const float*)d_in[5]; P.gla_b_gk = (const float*)d_in[6];
  P.gla_head_norm = (const float*)d_in[7]; P.gla_w_out = (const float*)d_in[8];
  P.nsa_w_in = (const float*)d_in[9]; P.nsa_b_gate = (const float*)d_in[10]; P.nsa_pe_k = (const float*)d_in[11]; P.nsa_pe_v = (const float*)d_in[12];
  P.ck_w1 = (const float*)d_in[13]; P.ck_w2 = (const float*)d_in[14]; P.cv_w1 = (const float*)d_in[15]; P.cv_w2 = (const float*)d_in[16];
  P.nsa_w_out = (const float*)d_in[17];
  P.out = (float*)d_out;
  char* ws = (char*)d_ws;
  const size_t MB = 1024 * 1024;
  P.W0t = (half_t*)(ws);
  P.Wo0t = (half_t*)(ws + 7 * MB);
  P.W1t = (half_t*)(ws + 9 * MB);
  P.Wo1t = (half_t*)(ws + 17 * MB);
  P.cw1t = (half_t*)(ws + 19 * MB);
  P.cw2t = (half_t*)(ws + 21 * MB);
  P.cbias = (float*)(ws + 22 * MB);
  P.cbias_part = (float*)(ws + 22 * MB + 4096);
  P.bar = (unsigned*)(ws + 23 * MB);
  P.use_cg_sync = 0;
  P.kmax2 = (unsigned*)(ws + 22 * MB + 512 * 1024);
  P.xh = (half_t*)(ws + 24 * MB);
  P.p = (half_t*)(ws + 88 * MB);
  P.y = (half_t*)(ws + 88 * MB);
  P.og = (half_t*)(ws + 328 * MB);
  P.bcum = (float*)(ws + 392 * MB);
  P.rstd = (float*)(ws + 456 * MB);
  P.kcmp = (half_t*)(ws + 457 * MB);
  P.vcmp = (half_t*)(ws + 458 * MB);
  P.ropetab = (float*)(ws + 459 * MB);
  P.hid = (half_t*)(ws + 467 * MB);
  P.gla_state = (float*)(ws + 476 * MB);
  if (ws_size < 502 * MB) { fprintf(stderr, "ws too small: %zu\n", ws_size); return; }
#if MEGA
  static int grid_blocks = 0;
  if (!grid_blocks) {
    int dev = 0, cus = 0, per_cu = 0;
    hipGetDevice(&dev);
    hipDeviceGetAttribute(&cus, hipDeviceAttributeMultiprocessorCount, dev);
    hipOccupancyMaxActiveBlocksPerMultiprocessor(&per_cu, k_mega, NTHREADS, 0);
    if (per_cu < 1) per_cu = 1;
    if (per_cu > 1) per_cu = 1;
    grid_blocks = cus * per_cu;
  }
  hipMemsetAsync(ws + 23 * MB, 0, 16384, stream);
  void* args[] = {&P};
  hipError_t e = hipLaunchCooperativeKernel((void*)k_mega, dim3(grid_blocks), dim3(NTHREADS), args, 0, stream);
  if (e != hipSuccess) fprintf(stderr, "cooperative launch failed: %s (grid %d)\n", hipGetErrorString(e), grid_blocks);
#else
  launch_phases<0>(P, stream);
#endif
}
```

```cpp
#include <hip/hip_runtime.h>
#include <hip/hip_cooperative_groups.h>
#include <cstdio>
#include <cstdint>
namespace cg = cooperative_groups;

typedef _Float16 half_t;
typedef _Float16 half8 __attribute__((ext_vector_type(8)));
typedef _Float16 half4 __attribute__((ext_vector_type(4)));
typedef float f32x4 __attribute__((ext_vector_type(4)));
typedef int v2i __attribute__((ext_vector_type(2)));
typedef int v4i __attribute__((ext_vector_type(4)));

#ifndef MEGA
#define MEGA 1
#endif

constexpr int T_TOK = 32768, DM = 1024, SEQ = 4096, NBATCH = 8;
constexpr int GLA_IN = 3088, NSA_IN = 3632;
constexpr int LD0 = 3328, LD1 = 3584;
constexpr int NC = 255;
constexpr float EPS = 1e-6f;
constexpr int NTHREADS = 512, NWAVES = NTHREADS / 64;
constexpr int SMEM_BYTES = 160 * 1024;

struct Params {
  const float* x; const int* pos; const float* pre_norm; const float* post_norm;
  const float* gla_w_in; const float* gla_w_gk_up; const float* gla_b_gk; const float* gla_head_norm; const float* gla_w_out;
  const float* nsa_w_in; const float* nsa_b_gate; const float* nsa_pe_k; const float* nsa_pe_v;
  const float* ck_w1; const float* ck_w2; const float* cv_w1; const float* cv_w2; const float* nsa_w_out;
  float* out;
  half_t* p; half_t* y; half_t* og; float* bcum; float* rstd; half_t* kcmp; half_t* vcmp; float* ropetab;
  half_t* xh; half_t* W0t; half_t* Wo0t; half_t* W1t; half_t* Wo1t;
  half_t* cw1t; half_t* cw2t; float* cbias; half_t* hid;
  float* cbias_part; unsigned* bar; long long use_cg_sync; unsigned* kmax2; float* gla_state; half_t* WglT; float* gl;
};

__device__ __forceinline__ int lane_id() { return (int)__builtin_amdgcn_mbcnt_hi(~0u, __builtin_amdgcn_mbcnt_lo(~0u, 0u)); }
__device__ __forceinline__ int otid(int wvs) { int t = wvs * 64 + lane_id(); asm volatile("" : "+v"(t)); return t; }
__device__ __forceinline__ float wave_sum(float v) {
#pragma unroll
  for (int o = 32; o > 0; o >>= 1) v += __shfl_xor(v, o);
  return v;
}
__device__ __forceinline__ float wave_max(float v) {
#pragma unroll
  for (int o = 32; o > 0; o >>= 1) v = fmaxf(v, __shfl_xor(v, o));
  return v;
}
typedef __attribute__((address_space(3))) void lds_void;
typedef __attribute__((address_space(1))) const void gbl_void;
typedef short s16x4 __attribute__((vector_size(8)));
typedef __attribute__((address_space(3))) s16x4 lds_s16x4;
__device__ __forceinline__ half4 tr_read4(const char* p) {
  const s16x4 v = __builtin_amdgcn_ds_read_tr16_b64_v4i16((lds_s16x4*)(p));
  return __builtin_bit_cast(half4, v);
}
template <int N> __device__ __forceinline__ void wait_vmcnt() { asm volatile("s_waitcnt vmcnt(%0)" ::"n"(N) : "memory"); }
constexpr float LOG2E = 1.4426950408889634f;
__device__ __forceinline__ float fexp2(float x) { return __builtin_amdgcn_exp2f(x); }
typedef unsigned u32x2 __attribute__((ext_vector_type(2)));
__device__ __forceinline__ float rowmax4(float x) {
  u32x2 r = __builtin_amdgcn_permlane16_swap(__float_as_uint(x), __float_as_uint(x), false, false);
  x = fmaxf(__uint_as_float(r[0]), __uint_as_float(r[1]));
  r = __builtin_amdgcn_permlane32_swap(__float_as_uint(x), __float_as_uint(x), false, false);
  return fmaxf(__uint_as_float(r[0]), __uint_as_float(r[1]));
}
__device__ __forceinline__ float rowsum4(float x) {
  u32x2 r = __builtin_amdgcn_permlane16_swap(__float_as_uint(x), __float_as_uint(x), false, false);
  x = __uint_as_float(r[0]) + __uint_as_float(r[1]);
  r = __builtin_amdgcn_permlane32_swap(__float_as_uint(x), __float_as_uint(x), false, false);
  return __uint_as_float(r[0]) + __uint_as_float(r[1]);
}
__device__ __forceinline__ float siluf(float v) { return v / (1.f + expf(-v)); }
__device__ __forceinline__ float sigmoidf(float v) { return 1.f / (1.f + expf(-v)); }
__device__ __forceinline__ float logsigmoidf(float u) { return fminf(u, 0.f) - log1pf(expf(-fabsf(u))); }

__device__ __forceinline__ void fast_barrier(unsigned* bar, unsigned& round, int wvs) {
  asm volatile("s_waitcnt vmcnt(0) lgkmcnt(0)" ::: "memory");
  __syncthreads();
  round += 1;
  if (wvs == 0 && lane_id() == 0) {
    __builtin_amdgcn_fence(__ATOMIC_RELEASE, "agent");
    asm volatile("s_waitcnt vmcnt(0)" ::: "memory");
    const unsigned ngroups = gridDim.x >> 4;
    const unsigned old = __hip_atomic_fetch_add(bar + 64 + 64 * (blockIdx.x >> 4), 1u, __ATOMIC_RELAXED, __HIP_MEMORY_SCOPE_AGENT);
    if (old + 1 == round * 16u) __hip_atomic_fetch_add(bar, 1u, __ATOMIC_RELAXED, __HIP_MEMORY_SCOPE_AGENT);
    const unsigned target = round * ngroups;
    while (__hip_atomic_load(bar, __ATOMIC_RELAXED, __HIP_MEMORY_SCOPE_AGENT) < target) { }
    __builtin_amdgcn_fence(__ATOMIC_ACQUIRE, "agent");
    asm volatile("s_waitcnt vmcnt(0)" ::: "memory");
  }
  __syncthreads();
}

__device__ void ph_xh_rstd(const float* src, half_t* xh, float* rstd, int wvs) {
  const int tid_ = otid(wvs); const int lane = tid_ & 63, w = tid_ >> 6;
#pragma unroll 2
  for (int row = blockIdx.x * NWAVES + w; row < T_TOK; row += gridDim.x * NWAVES) {
    const float4* r = (const float4*)(src + (size_t)row * DM);
    half4* xr = (half4*)(xh + (size_t)row * DM);
    float ss = 0.f;
#pragma unroll
    for (int i = 0; i < 4; ++i) {
      const float4 v = r[lane + 64 * i];
      ss += v.x * v.x + v.y * v.y + v.z * v.z + v.w * v.w;
      half4 hv; hv[0] = (half_t)v.x; hv[1] = (half_t)v.y; hv[2] = (half_t)v.z; hv[3] = (half_t)v.w;
      xr[lane + 64 * i] = hv;
    }
    ss = wave_sum(ss);
    if (lane == 0) rstd[row] = rsqrtf(ss * (1.f / DM) + EPS);
  }
}
__device__ void ph_ropetab(const Params& P, int wvs) {
  for (int idx = blockIdx.x * NTHREADS + otid(wvs); idx < T_TOK * 32; idx += gridDim.x * NTHREADS) {
    const int t = idx >> 5, i = idx & 31;
    const float inv = powf(10000.f, -(float)(2 * i) / 64.f);
    const float ang = (float)P.pos[t] * inv;
    float s, c; sincosf(ang, &s, &c);
    P.ropetab[t * 64 + i] = c; P.ropetab[t * 64 + 32 + i] = s;
  }
}
__device__ __forceinline__ int orig_col(int n, int mode) {
  if (mode == 0) {
    if (n < 2048) return n;
    if (n < 3072) return n + 16;
    if (n < 3088) return n - 1024;
    return -1;
  } else if (mode == 1) {
    if (n < 2560) return n;
    if (n < 3584) return n + 48;
    return -1;
  } else if (mode == 5) {
    return n < 48 ? 2560 + n : -1;
  }
  if (mode == 4) return n < 64 ? n : -1;
  return n;
}
__device__ void prep_wT(const float* W, int ldw, const float* gamma, half_t* Wt, int Npad, int K, int mode, float* sm, int wvs) {
  float(*tile)[65] = (float(*)[65])sm;
  const int tid = otid(wvs);
  const int ntn = Npad / 64, ntk = K / 64;
  for (int t = blockIdx.x; t < ntn * ntk; t += gridDim.x) {
    const int n0 = (t / ntk) * 64, k0 = (t % ntk) * 64;
    __syncthreads();
#pragma unroll
    for (int r = 0; r < 4096 / NTHREADS; ++r) {
      const int idx = tid + r * NTHREADS, kk = idx >> 6, nn = idx & 63;
      const int on = orig_col(n0 + nn, mode);
      float v = 0.f;
      if (on >= 0) { v = W[(size_t)(k0 + kk) * ldw + on]; if (gamma) v *= gamma[k0 + kk]; }
      tile[kk][nn] = v;
    }
    __syncthreads();
    {
      const int nn = tid >> 3, oct = tid & 7;
      half8 hv;
#pragma unroll
      for (int e = 0; e < 8; ++e) hv[e] = (half_t)tile[oct * 8 + e][nn];
      *(half8*)(Wt + (size_t)(n0 + nn) * K + k0 + oct * 8) = hv;
    }
  }
}

__device__ void prep_wT4(const float* W, int ldw, const float* gamma, half_t* Wt, int Npad, int K, int mode, float* sm, int wvs) {
  float(*tile)[260] = (float(*)[260])sm;
  const int tid = otid(wvs);
  const int nsn = Npad / 256, nsk = K / 64;
  for (int t = blockIdx.x; t < nsn * nsk; t += gridDim.x) {
    const int n0 = (t / nsk) * 256, k0 = (t % nsk) * 64;
    __syncthreads();
#pragma unroll
    for (int r = 0; r < 8; ++r) {
      const int idx = tid + r * NTHREADS, kk = idx >> 6, n4 = (idx & 63) * 4;
      const int on = orig_col(n0 + n4, mode);
      f32x4 v = (f32x4){0.f, 0.f, 0.f, 0.f};
      if (on >= 0) { v = *(const f32x4*)(W + (size_t)(k0 + kk) * ldw + on); if (gamma) v *= gamma[k0 + kk]; }
      *(f32x4*)&tile[kk][n4] = v;
    }
    __syncthreads();
#pragma unroll
    for (int r = 0; r < 4; ++r) {
      const int idx = tid + r * NTHREADS, nn = idx & 255, oct = idx >> 8;
      half8 hv;
#pragma unroll
      for (int e = 0; e < 8; ++e) hv[e] = (half_t)tile[oct * 8 + e][nn];
      *(half8*)(Wt + (size_t)(n0 + nn) * K + k0 + oct * 8) = hv;
    }
  }
}

__device__ void prep_cbias_part(const Params& P, int wvs) {
  for (int idx = blockIdx.x * NTHREADS + otid(wvs); idx < 2 * 32 * 256; idx += gridDim.x * NTHREADS) {
    const int j = idx & 255, ks = (idx >> 8) & 31, which = idx >> 13;
    const float* pe = which ? P.nsa_pe_v : P.nsa_pe_k;
    const float* w1 = which ? P.cv_w1 : P.ck_w1;
    float a = 0.f;
#pragma unroll 8
    for (int k = ks * 64; k < ks * 64 + 64; ++k) a += pe[k] * w1[(size_t)k * 256 + j];
    P.cbias_part[idx] = a;
  }
}
__device__ void prep_cbias_reduce(const Params& P, int wvs) {
  if (blockIdx.x < 2 && otid(wvs) < 256) {
    const int which = blockIdx.x, j = otid(wvs);
    float a = 0.f;
    for (int ks = 0; ks < 32; ++ks) a += P.cbias_part[(which * 32 + ks) * 256 + j];
    P.cbias[which * 256 + j] = a;
  }
}

namespace g8 {
constexpr int BK = 64, HALF = 128, HTB = HALF * BK * 2;
__device__ __forceinline__ int lds_byte(int r, int c) { const int st = (r >> 4) * 2 + (c >> 5), rr = r & 15, cc = c & 31, ob = rr * 64 + cc * 2; return st * 1024 + (ob ^ (((ob >> 9) & 1) << 5)); }
__device__ __forceinline__ void stage_rc(int b, int& R, int& C) { const int st = b / 1024, sb = b % 1024, swz = sb ^ (((sb >> 9) & 1) << 5); R = (st >> 1) * 16 + swz / 64; C = (st & 1) * 32 + (swz % 64) / 2; }
typedef f32x4 Acc[2][2][4][2];

struct SrcPlain8 {
  const half_t* A; int lda; const half_t* Bt; int K;
  __device__ __forceinline__ void get(int pm, int pn, const half_t*& Ag, const half_t*& Bg, size_t& a_rs, int& a_ks) const {
    Ag = A + (size_t)pm * 256 * lda; Bg = Bt + (size_t)pn * 256 * K; a_rs = lda; a_ks = 64;
  }
};
struct SrcCmp1_8 {
  const half_t* p1; const half_t* w1t;
  __device__ __forceinline__ void get(int pm, int pn, const half_t*& Ag, const half_t*& Bg, size_t& a_rs, int& a_ks) const {
    const int which = pm >> 5, bg = pm & 31, b = bg >> 2, g = bg & 3;
    Ag = p1 + (size_t)(b * SEQ) * LD1 + (which ? 1280 : 1024) + g * 64;
    Bg = w1t + (size_t)which * 256 * 2048; a_rs = (size_t)16 * LD1; a_ks = LD1;
  }
};
struct SrcCmp2_8 {
  const half_t* hid; const half_t* w2t;
  __device__ __forceinline__ void get(int pm, int pn, const half_t*& Ag, const half_t*& Bg, size_t& a_rs, int& a_ks) const {
    Ag = hid + (size_t)pm * 256 * 256; Bg = w2t + (size_t)(pm >> 5) * 256 * 256; a_rs = 256; a_ks = 64;
  }
};

__device__ __forceinline__ half8 pack8(const f32x4 a, const f32x4 b) {
  half8 h; h[0] = (half_t)a[0]; h[1] = (half_t)a[1]; h[2] = (half_t)a[2]; h[3] = (half_t)a[3]; h[4] = (half_t)b[0]; h[5] = (half_t)b[1]; h[6] = (half_t)b[2]; h[7] = (half_t)b[3];
  return h;
}
struct EpiStore8 {
  half_t* C; int ldc; const float* rowscale;
  __device__ __forceinline__ void operator()(const Acc& acc, int row0, int col0, int wr, int wc, int fr, int fq) const {
#pragma unroll
    for (int ai = 0; ai < 2; ++ai)
#pragma unroll
      for (int m = 0; m < 4; ++m) {
        const int tok = row0 + ai * 128 + wr * 64 + m * 16 + fr;
        const float s = rowscale ? rowscale[tok] : 1.f;
        half_t* rowp = C + (size_t)tok * ldc + col0 + 64 * wc + 8 * fq;
#pragma unroll
        for (int bj = 0; bj < 2; ++bj) *(half8*)(rowp + 32 * bj) = pack8(acc[ai][bj][m][0] * s, acc[ai][bj][m][1] * s);
      }
  }
};
struct EpiRope8 {
  half_t* C; int ldc; const float* rowscale; const float* ropetab;
  __device__ __forceinline__ void operator()(const Acc& acc, int row0, int col0, int wr, int wc, int fr, int fq) const {
    const int grp = (col0 >> 6) + wc;
    const bool is_q = grp < 16;
    const bool roped = is_q || (grp >= 16 && grp < 20) || (grp >= 24 && grp < 28) || (grp >= 32 && grp < 36);
    const float sc = is_q ? 0.125f : 1.f;
#pragma unroll
    for (int ai = 0; ai < 2; ++ai)
#pragma unroll
      for (int m = 0; m < 4; ++m) {
        const int tok = row0 + ai * 128 + wr * 64 + m * 16 + fr;
        const float s = rowscale[tok];
        half_t* rowp = C + (size_t)tok * ldc + col0 + 64 * wc + 8 * fq;
        f32x4 o1[2], o2[2];
#pragma unroll
        for (int n = 0; n < 2; ++n) {
          const f32x4 x1 = acc[ai][0][m][n] * s, x2 = acc[ai][1][m][n] * s;
          if (roped) {
            const f32x4 cs = *(const f32x4*)(ropetab + (size_t)tok * 64 + 8 * fq + 4 * n);
            const f32x4 sn = *(const f32x4*)(ropetab + (size_t)tok * 64 + 32 + 8 * fq + 4 * n);
            o1[n] = (x1 * cs - x2 * sn) * sc; o2[n] = (x2 * cs + x1 * sn) * sc;
          } else { o1[n] = x1; o2[n] = x2; }
        }
        *(half8*)(rowp) = pack8(o1[0], o1[1]);
        *(half8*)(rowp + 32) = pack8(o2[0], o2[1]);
      }
  }
};
struct EpiCmpHid8 {
  half_t* hid; const float* bias;
  __device__ __forceinline__ void operator()(const Acc& acc, int row0, int col0, int wr, int wc, int fr, int fq) const {
    const int which = row0 >> 13;
#pragma unroll
    for (int bj = 0; bj < 2; ++bj) {
      const int col = col0 + 64 * wc + 32 * bj + 8 * fq;
      const f32x4 b0 = *(const f32x4*)(bias + which * 256 + col), b1 = *(const f32x4*)(bias + which * 256 + col + 4);
#pragma unroll
      for (int ai = 0; ai < 2; ++ai)
#pragma unroll
        for (int m = 0; m < 4; ++m) {
          const int row = row0 + ai * 128 + wr * 64 + m * 16 + fr;
          f32x4 v0 = acc[ai][bj][m][0] + b0, v1 = acc[ai][bj][m][1] + b1;
#pragma unroll
          for (int e = 0; e < 4; ++e) { v0[e] = siluf(v0[e]); v1[e] = siluf(v1[e]); }
          *(half8*)(hid + (size_t)row * 256 + col) = pack8(v0, v1);
        }
    }
  }
};
struct EpiCmpOut8 {
  half_t* kcmp; half_t* vcmp;
  __device__ __forceinline__ void operator()(const Acc& acc, int row0, int col0, int wr, int wc, int fr, int fq) const {
    if (wc != 0) return;
#pragma unroll
    for (int ai = 0; ai < 2; ++ai)
#pragma unroll
      for (int m = 0; m < 4; ++m) {
        const int row = row0 + ai * 128 + wr * 64 + m * 16 + fr;
        const int which = row >> 13, r = row & 8191;
        half_t* dst = (which ? vcmp : kcmp) + (size_t)r * 64 + 8 * fq;
        const bool dead = (r & 255) == 255;
#pragma unroll
        for (int bj = 0; bj < 2; ++bj) {
          half8 hv = pack8(acc[ai][bj][m][0], acc[ai][bj][m][1]);
          if (dead) hv = (half8){(half_t)0.f, (half_t)0.f, (half_t)0.f, (half_t)0.f, (half_t)0.f, (half_t)0.f, (half_t)0.f, (half_t)0.f};
          *(half8*)(dst + 32 * bj) = hv;
        }
      }
  }
};

template <class Src, class Epi>
__device__ void gemm(const Src& src, int M, int N, int K, const Epi& epi, char* smem, int wvs) {
  const int tid = otid(wvs), wid = __builtin_amdgcn_readfirstlane(tid >> 6), lane = tid & 63, wr = wid >> 2, wc = wid & 3, fr = lane & 15, fq = lane >> 4;
  const int nM = M / 256, nN = N / 256, nwg = nM * nN, G = gridDim.x, nt = K / BK;
  int sr0, sc0, sr1, sc1;
  stage_rc(tid * 16, sr0, sc0); stage_rc(tid * 16 + 8192, sr1, sc1);
  const int a_base = lds_byte(wr * 64 + fr, fq * 8);
  int b_base = 65536 + lds_byte(wc * 32 + fr, fq * 8);
  asm volatile("" : "+v"(b_base));
#define SA8(b, h) (smem + ((b) * 2 + (h)) * HTB)
#define SB8(b, h) (smem + (4 + (b) * 2 + (h)) * HTB)
#define STAGE_A(P, h, kt) { const char* g_ = (const char*)(Ag + (size_t)(h) * 128 * lda + (size_t)(kt) * a_ks); \
    __builtin_amdgcn_global_load_lds((gbl_void*)(g_ + aob0), (lds_void*)((P) + wid * 1024), 16, 0, 0); \
    __builtin_amdgcn_global_load_lds((gbl_void*)(g_ + aob1), (lds_void*)((P) + 8192 + wid * 1024), 16, 0, 0); }
#define STAGE_B(P, h, kt) { const char* g_ = (const char*)(Bg + (size_t)(h) * 32 * K + (size_t)(kt) * 64);     \
    __builtin_amdgcn_global_load_lds((gbl_void*)(g_ + bob0), (lds_void*)((P) + wid * 1024), 16, 0, 0); \
    __builtin_amdgcn_global_load_lds((gbl_void*)(g_ + bob1), (lds_void*)((P) + 8192 + wid * 1024), 16, 0, 0); }
#define LDA8(dst, b, h) { _Pragma("unroll") for (int m = 0; m < 4; ++m) _Pragma("unroll") for (int k = 0; k < 2; ++k) dst[m][k] = *(const half8*)(SA8(b, h) + a_base + m * 2048 + k * 1024); }
#define LDB8(dst, b, h) { _Pragma("unroll") for (int n = 0; n < 2; ++n) _Pragma("unroll") for (int k = 0; k < 2; ++k) dst[n][k] = *(const half8*)(smem + ((b) * 2 + (h)) * HTB + b_base + n * 2048 + k * 1024); }
#define MMA8(ai, bj, At, Bx) { __builtin_amdgcn_s_setprio(1); \
    _Pragma("unroll") for (int m = 0; m < 4; ++m) _Pragma("unroll") for (int n = 0; n < 2; ++n) _Pragma("unroll") for (int k = 0; k < 2; ++k) \
      acc[ai][bj][m][n] = __builtin_amdgcn_mfma_f32_16x16x32_f16(Bx[n][k], At[m][k], acc[ai][bj][m][n], 0, 0, 0); \
    __builtin_amdgcn_s_setprio(0); }
#define WAIT_V(n) asm volatile("s_waitcnt vmcnt(" #n ")" ::: "memory")
#define WAIT_L(n) asm volatile("s_waitcnt lgkmcnt(" #n ")" ::: "memory")
#define BAR __builtin_amdgcn_s_barrier()
#define SCHED __builtin_amdgcn_sched_barrier(0)
  for (int it = 0;; ++it) {
    const int L = it * G + (int)blockIdx.x;
    if (L >= nwg) break;
    int wgid;
    { const int q = nwg / 8, r = nwg % 8, xcd = L % 8, off = L / 8; wgid = (xcd < r ? xcd * (q + 1) : r * (q + 1) + (xcd - r) * q) + off; }
    const int nig = 8 * nN, gid = wgid / nig, fm = gid * 8, gsz = (nM - fm) < 8 ? (nM - fm) : 8;
    const int pm = fm + ((wgid % nig) % gsz), pn = (wgid % nig) / gsz;
    const half_t* Ag; const half_t* Bg; size_t lda; int a_ks;
    src.get(pm, pn, Ag, Bg, lda, a_ks);
    const unsigned aob0 = (unsigned)(((size_t)sr0 * lda + sc0) * 2), aob1 = (unsigned)(((size_t)sr1 * lda + sc1) * 2);
    const int pr0 = 64 * (sr0 >> 5) + 8 * ((sr0 & 15) >> 2) + 4 * ((sr0 >> 4) & 1) + (sr0 & 3), pr1 = 64 * (sr1 >> 5) + 8 * ((sr1 & 15) >> 2) + 4 * ((sr1 >> 4) & 1) + (sr1 & 3);
    const unsigned bob0 = (unsigned)((pr0 * K + sc0) * 2), bob1 = (unsigned)((pr1 * K + sc1) * 2);
    Acc acc;
#pragma unroll
    for (int a = 0; a < 2; ++a)
#pragma unroll
      for (int b = 0; b < 2; ++b)
#pragma unroll
        for (int m = 0; m < 4; ++m)
#pragma unroll
          for (int n = 0; n < 2; ++n) acc[a][b][m][n] = (f32x4){0.f, 0.f, 0.f, 0.f};
    half8 At[4][2], B0[2][2], B1[2][2];
    STAGE_B(SB8(0, 0), 0, 0) STAGE_A(SA8(0, 0), 0, 0)
    STAGE_B(SB8(0, 1), 1, 0) STAGE_A(SA8(0, 1), 1, 0)
    if (wr == 1) BAR;
    WAIT_V(4); BAR;
    STAGE_B(SB8(1, 0), 0, 1) STAGE_A(SA8(1, 0), 0, 1) STAGE_B(SB8(1, 1), 1, 1)
    WAIT_V(6); BAR;
#pragma unroll 1
    for (int t = 0; t < nt - 2; t += 2) {
      LDB8(B0, 0, 0) SCHED; LDA8(At, 0, 0) STAGE_A(SA8(1, 1), 1, t + 1)
      WAIT_L(8); BAR; WAIT_L(0); MMA8(0, 0, At, B0) BAR; SCHED;
      LDB8(B1, 0, 1) STAGE_B(SB8(0, 0), 0, t + 2)
      BAR; WAIT_L(0); MMA8(0, 1, At, B1) BAR;
      LDA8(At, 0, 1) STAGE_A(SA8(0, 0), 0, t + 2)
      BAR; WAIT_L(0); MMA8(1, 0, At, B0) BAR; SCHED;
      STAGE_B(SB8(0, 1), 1, t + 2)
      WAIT_V(6); BAR; MMA8(1, 1, At, B1) BAR;
      LDB8(B0, 1, 0) SCHED; LDA8(At, 1, 0) STAGE_A(SA8(0, 1), 1, t + 2)
      WAIT_L(8); BAR; WAIT_L(0); MMA8(0, 0, At, B0) BAR; SCHED;
      LDB8(B1, 1, 1) STAGE_B(SB8(1, 0), 0, t + 3)
      BAR; WAIT_L(0); MMA8(0, 1, At, B1) BAR;
      LDA8(At, 1, 1) STAGE_A(SA8(1, 0), 0, t + 3)
      BAR; WAIT_L(0); MMA8(1, 0, At, B0) BAR; SCHED;
      STAGE_B(SB8(1, 1), 1, t + 3)
      WAIT_V(6); BAR; MMA8(1, 1, At, B1) BAR;
    }
    { LDB8(B0, 0, 0) LDA8(At, 0, 0) STAGE_A(SA8(1, 1), 1, nt - 1)
      BAR; WAIT_L(0); MMA8(0, 0, At, B0) BAR;
      LDB8(B1, 0, 1) BAR; WAIT_L(0); MMA8(0, 1, At, B1) BAR;
      LDA8(At, 0, 1) WAIT_V(4); BAR; WAIT_L(0); MMA8(1, 0, At, B0) MMA8(1, 1, At, B1) BAR; }
    { LDB8(B0, 1, 0) LDA8(At, 1, 0) WAIT_V(2); BAR; WAIT_L(0); MMA8(0, 0, At, B0) BAR;
      LDB8(B1, 1, 1) WAIT_V(0); BAR; WAIT_L(0); MMA8(0, 1, At, B1) BAR;
      LDA8(At, 1, 1) BAR; WAIT_L(0); MMA8(1, 0, At, B0) MMA8(1, 1, At, B1) BAR; }
    if (wr == 0) BAR;
    { int fr2 = fr, fq2 = fq; asm volatile("" : "+v"(fr2), "+v"(fq2)); epi(acc, pm * 256, pn * 256, wr, wc, fr2, fq2); }
  }
#undef SA8
#undef SB8
#undef STAGE_A
#undef STAGE_B
#undef LDA8
#undef LDB8
#undef MMA8
#undef WAIT_V
#undef WAIT_L
#undef BAR
#undef SCHED
}
}

__device__ void ph_gla_prep(const Params& P, float* sm, int wvs) {
  float(*glr)[16] = (float(*)[16])sm;
  float(*tot)[128] = (float(*)[128])(sm + 1024);
  const int tid = otid(wvs);
  const int tq = tid >> 7, c = tid & 127;
  const float scale = 0.08838834764831845f;
  for (int item = blockIdx.x; item < (T_TOK / 64) * 4; item += gridDim.x) {
    const int chunk = item >> 2, h = item & 3;
    const int t0 = chunk * 64, ch = h * 128 + c;
    __syncthreads();
    for (int idx = tid; idx < 64 * 16; idx += NTHREADS) {
      const int i = idx >> 4, r = idx & 15;
      glr[i][r] = (float)P.p[(size_t)(t0 + i) * LD0 + 3072 + r];
    }
    float w[16];
#pragma unroll
    for (int r = 0; r < 16; ++r) w[r] = P.gla_w_gk_up[r * 512 + ch];
    const float bb = P.gla_b_gk[ch];
    half_t* qp = P.p + (size_t)(t0 + tq * 16) * LD0 + ch;
    half_t qv[16], kv[16];
#pragma unroll
    for (int i = 0; i < 16; ++i) { qv[i] = qp[(size_t)i * LD0]; kv[i] = qp[(size_t)i * LD0 + 512]; }
    __syncthreads();
    float pre[16]; float cum = 0.f;
#pragma unroll
    for (int i = 0; i < 16; ++i) {
      float u = bb;
#pragma unroll
      for (int r = 0; r < 16; ++r) u += glr[tq * 16 + i][r] * w[r];
      cum += logsigmoidf(u) * (1.f / 16.f);
      pre[i] = cum;
    }
    tot[tq][c] = cum;
    __syncthreads();
    float off = 0.f;
#pragma unroll
    for (int t = 0; t < 3; ++t) if (t < tq) off += tot[t][c];
#pragma unroll
    for (int i = 0; i < 16; ++i) {
      const float ex = exp2f((pre[i] + off) * LOG2E);
      qp[(size_t)i * LD0] = (half_t)((float)qv[i] * scale * ex);
      qp[(size_t)i * LD0 + 512] = (half_t)((float)kv[i] * __builtin_amdgcn_rcpf(ex));
      if (tq == 3 && i == 15) P.bcum[(size_t)chunk * 512 + ch] = ex;
    }
  }
}

constexpr int GLA_QE = 0, GLA_KE = 16384, GLA_V = 32768, GLA_DEC = 49152, GLA_BUF = 53248;
#define GLA_TR4(d0, d1, d2, d3, addr, o0, o1, o2, o3) \
  asm volatile("ds_read_b64_tr_b16 %0, %4 offset:%5\n\tds_read_b64_tr_b16 %1, %4 offset:%6\n\tds_read_b64_tr_b16 %2, %4 offset:%7\n\tds_read_b64_tr_b16 %3, %4 offset:%8" \
               : "=&v"(d0), "=&v"(d1), "=&v"(d2), "=&v"(d3) : "v"(addr), "n"(o0), "n"(o1), "n"(o2), "n"(o3) : "memory")
__device__ __forceinline__ half8 pack_h8(const v2i a, const v2i b) { const v4i p = (v4i){a[0], a[1], b[0], b[1]}; return __builtin_bit_cast(half8, p); }

template <bool STATE_ONLY>
__device__ void ph_gla_mfma(const Params& P, char* smem, int wvs) {
  const int tid = otid(wvs);
  const int lane = tid & 63, wave = __builtin_amdgcn_readfirstlane(tid >> 6), r15 = lane & 15, q = lane >> 4;
  const int qp = r15 >> 2, pp = lane & 3;
  const int srow = tid >> 4, sslot = tid & 15;
  const int src_q = (sslot ^ (srow & 15)) * 8, src_kv = (sslot ^ ((srow & 7) << 1)) * 8;
  const int fk = ((4 * (q & 1) + qp) & 7) << 1;
  const unsigned tr_row = (unsigned)((4 * q + qp) * 256 + 8 * (pp & 1) + ((pp >> 1) << 4));
  constexpr int NLOAD = STATE_ONLY ? 5 : 7;
  for (int item = blockIdx.x; item < (STATE_ONLY ? 3 : 4) * 64; item += gridDim.x) {
    const int seg = item >> 6, base = item & 63, b = base >> 3, h = (base >> 1) & 3, vs = base & 1;
    const int c0 = seg * 16;
    f32x4 S[8], Dacc[8];
#pragma unroll
    for (int df = 0; df < 8; ++df) { S[df] = (f32x4){0.f, 0.f, 0.f, 0.f}; Dacc[df] = (f32x4){1.f, 1.f, 1.f, 1.f}; }
    f32x4* stL = (f32x4*)P.gla_state + ((size_t)base * 8 + wave) * 8 * 64 + lane;
    f32x4* stD = stL + (size_t)3 * 64 * 8 * 8 * 64;
    if (!STATE_ONLY) {
      for (int k = 0; k < seg; ++k) {
#pragma unroll
        for (int df = 0; df < 8; ++df) {
          const f32x4 Lk = stL[((size_t)k * 64 * 8 * 8 + df) * 64];
          if (k == 0) S[df] = Lk;
          else { const f32x4 Dk = stD[((size_t)k * 64 * 8 * 8 + df) * 64]; S[df] = Dk * S[df] + Lk; }
        }
      }
    }
    const half_t* qsrc = P.p + (size_t)(b * SEQ + srow) * LD0 + h * 128;
    const half_t* vsrc = P.p + (size_t)(b * SEQ + srow) * LD0 + 1024 + h * 256 + vs * 128 + src_kv;
    const float* dsrc = P.bcum + (size_t)(b * 64 + c0) * 512 + h * 128 + (lane & 31) * 4;
#define G_ISSUE(N, BUF) { char* lb_ = smem + (BUF) * GLA_BUF + wave * 1024; const size_t ro_ = (size_t)(c0 + (N)) * 64 * LD0; \
      if (!STATE_ONLY) { __builtin_amdgcn_global_load_lds((gbl_void*)(qsrc + ro_ + src_q), (lds_void*)(lb_ + GLA_QE), 16, 0, 0); \
      __builtin_amdgcn_global_load_lds((gbl_void*)(qsrc + ro_ + (size_t)32 * LD0 + src_q), (lds_void*)(lb_ + GLA_QE + 8192), 16, 0, 0); } \
      __builtin_amdgcn_global_load_lds((gbl_void*)(qsrc + ro_ + 512 + src_kv), (lds_void*)(lb_ + GLA_KE), 16, 0, 0); \
      __builtin_amdgcn_global_load_lds((gbl_void*)(qsrc + ro_ + (size_t)32 * LD0 + 512 + src_kv), (lds_void*)(lb_ + GLA_KE + 8192), 16, 0, 0); \
      __builtin_amdgcn_global_load_lds((gbl_void*)(vsrc + ro_), (lds_void*)(lb_ + GLA_V), 16, 0, 0); \
      __builtin_amdgcn_global_load_lds((gbl_void*)(vsrc + ro_ + (size_t)32 * LD0), (lds_void*)(lb_ + GLA_V + 8192), 16, 0, 0); \
      if (lane < 32) __builtin_amdgcn_global_load_lds((gbl_void*)(dsrc + (size_t)(N) * 512), (lds_void*)(smem + (BUF) * GLA_BUF + GLA_DEC + wave * 512), 16, 0, 0); }
    G_ISSUE(0, 0)
    G_ISSUE(1, 1)
#pragma unroll 1
    for (int n = 0; n < 16; ++n) {
      if (n + 1 < 16) wait_vmcnt<NLOAD>(); else wait_vmcnt<0>();
      __builtin_amdgcn_s_barrier();
      if (n + 2 < 16) G_ISSUE(n + 2, (n + 2) % 3)
      const char* cb = smem + (n % 3) * GLA_BUF;
      f32x4 aT[4][4];
      if (!STATE_ONLY) {
#pragma unroll
      for (int kf = 0; kf < 4; ++kf)
#pragma unroll
        for (int tf = 0; tf < 4; ++tf) aT[kf][tf] = (f32x4){0.f, 0.f, 0.f, 0.f};
#pragma unroll
      for (int ks = 0; ks < 4; ++ks) {
        half8 kef[4], qef[4];
#pragma unroll
        for (int f = 0; f < 4; ++f) {
          kef[f] = *(const half8*)(cb + GLA_KE + (16 * f + r15) * 256 + (((4 * ks + q) ^ ((r15 & 7) << 1)) << 4));
          qef[f] = *(const half8*)(cb + GLA_QE + (16 * f + r15) * 256 + (((4 * ks + q) ^ r15) << 4));
        }
#pragma unroll
        for (int kf = 0; kf < 4; ++kf)
#pragma unroll
          for (int tf = kf; tf < 4; ++tf) aT[kf][tf] = __builtin_amdgcn_mfma_f32_16x16x32_f16(kef[kf], qef[tf], aT[kf][tf], 0, 0, 0);
      }
#pragma unroll
      for (int f = 0; f < 4; ++f)
#pragma unroll
        for (int r = 0; r < 4; ++r) if (4 * q + r > r15) aT[f][f][r] = 0.f;
      }
      const unsigned lds0 = (unsigned)(size_t)cb;
      const unsigned va = lds0 + GLA_V + tr_row + ((((2 * wave) ^ fk)) << 4);
      v2i v00, v01, v10, v11;
      GLA_TR4(v00, v01, v10, v11, va, 0, 4096, 8192, 12288);
      const unsigned ka = lds0 + GLA_KE + tr_row;
      v2i k0[4][4];
#pragma unroll
      for (int df = 0; df < 4; ++df) { const unsigned a_ = ka + ((((2 * df) ^ fk)) << 4); GLA_TR4(k0[df][0], k0[df][1], k0[df][2], k0[df][3], a_, 0, 4096, 8192, 12288); }
      asm volatile("s_waitcnt lgkmcnt(15)" : "+v"(v00), "+v"(v01), "+v"(v10), "+v"(v11) :: "memory");
      __builtin_amdgcn_sched_barrier(0);
      half8 vf[2];
      vf[0] = pack_h8(v00, v01); vf[1] = pack_h8(v10, v11);
      if (!STATE_ONLY) {
      f32x4 o[4];
#pragma unroll
      for (int tf = 0; tf < 4; ++tf) o[tf] = (f32x4){0.f, 0.f, 0.f, 0.f};
#pragma unroll
      for (int ks2 = 0; ks2 < 2; ++ks2)
#pragma unroll
        for (int tf = 2 * ks2; tf < 4; ++tf) {
          half8 pk;
#pragma unroll
          for (int r = 0; r < 4; ++r) { pk[r] = (half_t)aT[2 * ks2][tf][r]; pk[4 + r] = (half_t)aT[2 * ks2 + 1][tf][r]; }
          o[tf] = __builtin_amdgcn_mfma_f32_16x16x32_f16(vf[ks2], pk, o[tf], 0, 0, 0);
        }
#pragma unroll
      for (int ks = 0; ks < 4; ++ks) {
        half8 sf;
#pragma unroll
        for (int r = 0; r < 4; ++r) { sf[r] = (half_t)S[2 * ks][r]; sf[4 + r] = (half_t)S[2 * ks + 1][r]; }
#pragma unroll
        for (int tf = 0; tf < 4; ++tf) {
          const int row = 16 * tf + r15;
          const half4 qa = *(const half4*)(cb + GLA_QE + row * 256 + (((4 * ks + (q >> 1)) ^ r15) << 4) + (q & 1) * 8);
          const half4 qb = *(const half4*)(cb + GLA_QE + row * 256 + (((4 * ks + 2 + (q >> 1)) ^ r15) << 4) + (q & 1) * 8);
          half8 qv;
#pragma unroll
          for (int e = 0; e < 4; ++e) { qv[e] = qa[e]; qv[4 + e] = qb[e]; }
          o[tf] = __builtin_amdgcn_mfma_f32_16x16x32_f16(sf, qv, o[tf], 0, 0, 0);
        }
      }
      {
        const size_t t0 = (size_t)(b * SEQ + (c0 + n) * 64);
#pragma unroll
        for (int tf = 0; tf < 4; ++tf) {
          half4 hv; hv[0] = (half_t)o[tf][0]; hv[1] = (half_t)o[tf][1]; hv[2] = (half_t)o[tf][2]; hv[3] = (half_t)o[tf][3];
          *(half4*)(P.og + (t0 + 16 * tf + r15) * DM + h * 256 + vs * 128 + 16 * wave + 4 * q) = hv;
        }
      }
      }
      v2i k1[4][4];
#pragma unroll
      for (int df = 0; df < 4; ++df) { const unsigned a_ = ka + ((((2 * (df + 4)) ^ fk)) << 4); GLA_TR4(k1[df][0], k1[df][1], k1[df][2], k1[df][3], a_, 0, 4096, 8192, 12288); }
      asm volatile("s_waitcnt lgkmcnt(15)"
                   : "+v"(k0[0][0]), "+v"(k0[0][1]), "+v"(k0[0][2]), "+v"(k0[0][3]), "+v"(k0[1][0]), "+v"(k0[1][1]), "+v"(k0[1][2]), "+v"(k0[1][3]),
                     "+v"(k0[2][0]), "+v"(k0[2][1]), "+v"(k0[2][2]), "+v"(k0[2][3]), "+v"(k0[3][0]), "+v"(k0[3][1]), "+v"(k0[3][2]), "+v"(k0[3][3]) :: "memory");
      __builtin_amdgcn_sched_barrier(0);
#pragma unroll
      for (int df = 0; df < 4; ++df) {
        S[df] = __builtin_amdgcn_mfma_f32_16x16x32_f16(pack_h8(k0[df][0], k0[df][1]), vf[0], S[df], 0, 0, 0);
        S[df] = __builtin_amdgcn_mfma_f32_16x16x32_f16(pack_h8(k0[df][2], k0[df][3]), vf[1], S[df], 0, 0, 0);
      }
      asm volatile("s_waitcnt lgkmcnt(0)"
                   : "+v"(k1[0][0]), "+v"(k1[0][1]), "+v"(k1[0][2]), "+v"(k1[0][3]), "+v"(k1[1][0]), "+v"(k1[1][1]), "+v"(k1[1][2]), "+v"(k1[1][3]),
                     "+v"(k1[2][0]), "+v"(k1[2][1]), "+v"(k1[2][2]), "+v"(k1[2][3]), "+v"(k1[3][0]), "+v"(k1[3][1]), "+v"(k1[3][2]), "+v"(k1[3][3]) :: "memory");
      __builtin_amdgcn_sched_barrier(0);
#pragma unroll
      for (int df = 0; df < 4; ++df) {
        S[df + 4] = __builtin_amdgcn_mfma_f32_16x16x32_f16(pack_h8(k1[df][0], k1[df][1]), vf[0], S[df + 4], 0, 0, 0);
        S[df + 4] = __builtin_amdgcn_mfma_f32_16x16x32_f16(pack_h8(k1[df][2], k1[df][3]), vf[1], S[df + 4], 0, 0, 0);
      }
#pragma unroll
      for (int df = 0; df < 8; ++df) {
        const f32x4 dc = *(const f32x4*)(cb + GLA_DEC + wave * 512 + (16 * df + 4 * q) * 4);
        S[df] *= dc;
        if (STATE_ONLY) Dacc[df] *= dc;
      }
    }
    if (STATE_ONLY) {
#pragma unroll
      for (int df = 0; df < 8; ++df) { stL[((size_t)seg * 64 * 8 * 8 + df) * 64] = S[df]; stD[((size_t)seg * 64 * 8 * 8 + df) * 64] = Dacc[df]; }
    }
    asm volatile("s_waitcnt vmcnt(0)" ::: "memory");
    __builtin_amdgcn_s_barrier();
#undef G_ISSUE
  }
}

__device__ void ph_gla_post(const Params& P, int wvs) {
  const int tid_ = otid(wvs); const int lane = tid_ & 63, sub = lane & 31;
  const int u0 = blockIdx.x * 16 + (tid_ >> 5);
  const float4 hn0 = ((const float4*)P.gla_head_norm)[sub * 2], hn1 = ((const float4*)P.gla_head_norm)[sub * 2 + 1];
#pragma unroll 2
  for (int u = u0; u < T_TOK * 4; u += gridDim.x * 16) {
    const int t = u >> 2, h = u & 3;
    half8* op = (half8*)(P.og + (size_t)t * DM + h * 256) + sub;
    const half8 hv = *op;
    const half8 z = *((const half8*)(P.p + (size_t)t * LD0 + 2048 + h * 256) + sub);
    float v[8]; float ss = 0.f;
#pragma unroll
    for (int e = 0; e < 8; ++e) { v[e] = (float)hv[e]; ss += v[e] * v[e]; }
#pragma unroll
    for (int o = 16; o > 0; o >>= 1) ss += __shfl_xor(ss, o);
    const float r = rsqrtf(ss * (1.f / 256.f) + EPS);
    const float hn[8] = {hn0.x, hn0.y, hn0.z, hn0.w, hn1.x, hn1.y, hn1.z, hn1.w};
    half8 o;
#pragma unroll
    for (int e = 0; e < 8; ++e) o[e] = (half_t)(v[e] * r * hn[e] * siluf((float)z[e]));
    *op = o;
  }
}

__device__ void ph_post(const float* base, const half_t* y, const float* g, float* dst, half_t* dsth, float* rstd_out, int wvs) {
  const int tid_ = otid(wvs); const int lane = tid_ & 63, w = tid_ >> 6;
#pragma unroll 2
  for (int row = blockIdx.x * NWAVES + w; row < T_TOK; row += gridDim.x * NWAVES) {
    const half4* yr = (const half4*)(y + (size_t)row * DM);
    const float4* br = (const float4*)(base + (size_t)row * DM);
    float4* dr = (float4*)(dst + (size_t)row * DM);
    float4 v[4]; float ss = 0.f;
#pragma unroll
    for (int i = 0; i < 4; ++i) {
      const half4 hv = yr[lane + 64 * i];
      v[i].x = (float)hv[0]; v[i].y = (float)hv[1]; v[i].z = (float)hv[2]; v[i].w = (float)hv[3];
      ss += v[i].x * v[i].x + v[i].y * v[i].y + v[i].z * v[i].z + v[i].w * v[i].w;
    }
    ss = wave_sum(ss);
    const float r = rsqrtf(ss * (1.f / DM) + EPS);
    float s2 = 0.f;
#pragma unroll
    for (int i = 0; i < 4; ++i) {
      const float4 gg = ((const float4*)g)[lane + 64 * i];
      const float4 bb = br[lane + 64 * i];
      float4 o;
      o.x = bb.x + v[i].x * r * gg.x; o.y = bb.y + v[i].y * r * gg.y; o.z = bb.z + v[i].z * r * gg.z; o.w = bb.w + v[i].w * r * gg.w;
      s2 += o.x * o.x + o.y * o.y + o.z * o.z + o.w * o.w;
      dr[lane + 64 * i] = o;
      if (dsth) {
        half4 hv; hv[0] = (half_t)o.x; hv[1] = (half_t)o.y; hv[2] = (half_t)o.z; hv[3] = (half_t)o.w;
        ((half4*)(dsth + (size_t)row * DM))[lane + 64 * i] = hv;
      }
    }
    if (rstd_out) { s2 = wave_sum(s2); if (lane == 0) rstd_out[row] = rsqrtf(s2 * (1.f / DM) + EPS); }
  }
}

__device__ void ph_gates(const Params& P, char* smem, int wvs, int first_block) {
  const int tid = otid(wvs), lane = tid & 63, wave = tid >> 6, r15 = lane & 15, q = lane >> 4;
  const int nb = gridDim.x - first_block;
  if ((int)blockIdx.x < first_block) return;
  for (int c = tid; c < 48 * 128; c += NTHREADS) {
    const int row = c >> 7, ch = c & 127;
    *(uint4*)(smem + row * 2064 + ch * 16) = *(const uint4*)(P.WglT + (size_t)row * DM + ch * 8);
  }
  __syncthreads();
  for (int tile = (int)blockIdx.x - first_block; tile < T_TOK / 128; tile += nb) {
    const int tok = tile * 128 + wave * 16 + r15;
    const half_t* ap = P.xh + (size_t)tok * DM + 8 * q;
    const char* bp = smem + r15 * 2064 + 16 * q;
    f32x4 acc[3] = {(f32x4){0.f, 0.f, 0.f, 0.f}, (f32x4){0.f, 0.f, 0.f, 0.f}, (f32x4){0.f, 0.f, 0.f, 0.f}};
#pragma unroll 1
    for (int s0 = 0; s0 < 32; s0 += 16) {
      half8 a[16];
#pragma unroll
      for (int i = 0; i < 16; ++i) a[i] = *(const half8*)(ap + 32 * (s0 + i));
#pragma unroll
      for (int i = 0; i < 16; ++i) {
#pragma unroll
        for (int n = 0; n < 3; ++n) {
          const half8 bw = *(const half8*)(bp + n * 16 * 2064 + (s0 + i) * 64);
          acc[n] = __builtin_amdgcn_mfma_f32_16x16x32_f16(bw, a[i], acc[n], 0, 0, 0);
        }
      }
    }
    const float rs = P.rstd[tok];
#pragma unroll
    for (int n = 0; n < 3; ++n) *(f32x4*)(P.gl + (size_t)tok * 48 + 16 * n + 4 * q) = acc[n] * rs;
  }
  __syncthreads();
}

__device__ void ph_kmax(const Params& P, int wvs) {
  const int tid = otid(wvs);
  for (int task = blockIdx.x; task < NBATCH * 4 * 2 * 8; task += gridDim.x) {
    const int chunk = task & 7, br = (task >> 3) & 1, bg = task >> 4, b = bg >> 2, g = bg & 3;
    const half_t* kp = P.p + (size_t)(b * SEQ + chunk * 512 + tid) * LD1 + (br ? 2048 : 1536) + g * 64;
    float ss = 0.f;
#pragma unroll
    for (int c = 0; c < 8; ++c) {
      const half8 v = *(const half8*)(kp + c * 8);
#pragma unroll
      for (int e = 0; e < 8; ++e) ss += (float)v[e] * (float)v[e];
    }
    ss = wave_max(ss);
    if ((tid & 63) == 0) __hip_atomic_fetch_max(&P.kmax2[bg * 2 + br], __float_as_uint(ss), __ATOMIC_RELAXED, __HIP_MEMORY_SCOPE_AGENT);
  }
}

constexpr int ATT_NB = 6, ATT_D = 5;
constexpr int ATT_K = 0, ATT_V = ATT_NB * 8192, ATT_IMP = 2 * ATT_NB * 8192, ATT_SELM = ATT_IMP + 64 * 68 * 4;
constexpr int IMPS = 68;
constexpr int ATT_GATE = ATT_SELM + 512;

template <int MODE>
__device__ __forceinline__ void attn_branch(char* smem, const half_t* kbase, const half_t* vbase, int ld, int tile_lo, int tile_hi, int n, int th,
                                            const half8 (&qf)[2][2], float (&m)[2], float (&l)[2], f32x4 (&o)[4][2],
                                            const unsigned long long (&selm)[2], int wvs) {
  const int tid = otid(wvs);
  const int lane = tid & 63, r15 = lane & 15, q = lane >> 4;
  const int lrow = tid >> 3, lch = tid & 7;
  const int k_rd = r15 * 128, kswz = r15 >> 1;
  const int qp = r15 >> 2, pp = lane & 3;
  const int fx = ((2 * q + (qp >> 1)) & 3) << 1;
  const int v_rd = (4 * q + qp) * 128 + 8 * (pp & 1) + ((pp >> 1) << 4);
  unsigned int* impu = (unsigned int*)(smem + ATT_IMP);
  const int ksrc = (lch ^ ((lrow >> 1) & 7)) * 8, vsrc = (lch ^ (((lrow >> 1) & 3) << 1)) * 8;
  const int wbase = __builtin_amdgcn_readfirstlane(tid >> 6) * 1024;
#define A_GLOAD(TI, BUF) { const half_t* kp_ = kbase + (size_t)((TI) * 64 + lrow) * ld + ksrc; \
    __builtin_amdgcn_global_load_lds((gbl_void*)kp_, (lds_void*)(smem + ATT_K + (BUF) * 8192 + wbase), 16, 0, 0); \
    if (MODE != 0) { const half_t* vp_ = vbase + (size_t)((TI) * 64 + lrow) * ld + vsrc; \
      __builtin_amdgcn_global_load_lds((gbl_void*)vp_, (lds_void*)(smem + ATT_V + (BUF) * 8192 + wbase), 16, 0, 0); } }
  constexpr int GPT = (MODE == 0) ? 1 : 2;
#pragma unroll
  for (int i = 0; i < ATT_D; ++i) if (tile_lo + i <= tile_hi) A_GLOAD(tile_lo + i, i)
#pragma unroll 1
  for (int ti = tile_lo; ti <= tile_hi; ++ti) {
    const int it = ti - tile_lo, cur = it % ATT_NB;
    {
      const int rem = tile_hi - ti;
      if (rem >= 4) wait_vmcnt<4 * GPT>(); else if (rem == 3) wait_vmcnt<3 * GPT>(); else if (rem == 2) wait_vmcnt<2 * GPT>();
      else if (rem == 1) wait_vmcnt<1 * GPT>(); else wait_vmcnt<0>();
    }
    __builtin_amdgcn_s_barrier();
    if (ti + ATT_D <= tile_hi) A_GLOAD(ti + ATT_D, (it + ATT_D) % ATT_NB)
    const char* kb = smem + ATT_K + cur * 8192 + k_rd;
    const unsigned vbl = (unsigned)(size_t)(smem + ATT_V + cur * 8192 + v_rd);
    bool need_mask;
    if (MODE <= 1) need_mask = (ti * 64 + 63 > 4 * n - 2);
    else if (MODE == 2) need_mask = (ti == n);
    else need_mask = (ti == n) || (ti == n - 8);
    f32x4 s[4][2];
#pragma unroll
    for (int kf = 0; kf < 4; ++kf)
#pragma unroll
      for (int t2 = 0; t2 < 2; ++t2) s[kf][t2] = (f32x4){0.f, 0.f, 0.f, 0.f};
#pragma unroll
    for (int ks = 0; ks < 2; ++ks) {
      const int co = ((4 * ks + q) ^ kswz) << 4;
#pragma unroll
      for (int kf = 0; kf < 4; ++kf) {
        const half8 kfr = *(const half8*)(kb + kf * 2048 + co);
#pragma unroll
        for (int t2 = 0; t2 < 2; ++t2) s[kf][t2] = __builtin_amdgcn_mfma_f32_16x16x32_f16(kfr, qf[t2][ks], s[kf][t2], 0, 0, 0);
      }
    }
    v2i vr[4][4];
    if (MODE != 0) {
      const unsigned va0 = vbl + (((0) ^ fx) << 4), va1 = vbl + (((2) ^ fx) << 4), va2 = vbl + (((4) ^ fx) << 4), va3 = vbl + (((6) ^ fx) << 4);
      asm volatile(
          "ds_read_b64_tr_b16 %0, %16\n\tds_read_b64_tr_b16 %1, %16 offset:2048\n\tds_read_b64_tr_b16 %2, %16 offset:4096\n\tds_read_b64_tr_b16 %3, %16 offset:6144\n\t"
          "ds_read_b64_tr_b16 %4, %17\n\tds_read_b64_tr_b16 %5, %17 offset:2048\n\tds_read_b64_tr_b16 %6, %17 offset:4096\n\tds_read_b64_tr_b16 %7, %17 offset:6144\n\t"
          "ds_read_b64_tr_b16 %8, %18\n\tds_read_b64_tr_b16 %9, %18 offset:2048\n\tds_read_b64_tr_b16 %10, %18 offset:4096\n\tds_read_b64_tr_b16 %11, %18 offset:6144\n\t"
          "ds_read_b64_tr_b16 %12, %19\n\tds_read_b64_tr_b16 %13, %19 offset:2048\n\tds_read_b64_tr_b16 %14, %19 offset:4096\n\tds_read_b64_tr_b16 %15, %19 offset:6144"
          : "=&v"(vr[0][0]), "=&v"(vr[0][1]), "=&v"(vr[0][2]), "=&v"(vr[0][3]), "=&v"(vr[1][0]), "=&v"(vr[1][1]), "=&v"(vr[1][2]), "=&v"(vr[1][3]),
            "=&v"(vr[2][0]), "=&v"(vr[2][1]), "=&v"(vr[2][2]), "=&v"(vr[2][3]), "=&v"(vr[3][0]), "=&v"(vr[3][1]), "=&v"(vr[3][2]), "=&v"(vr[3][3])
          : "v"(va0), "v"(va1), "v"(va2), "v"(va3)
          : "memory");
    }
    if (need_mask) {
#pragma unroll
      for (int t2 = 0; t2 < 2; ++t2) {
        const int tok = th * 32 + t2 * 16 + r15;
        int lo = 0, hi = 63;
        if (MODE <= 1) { hi = 4 * n + ((tok - 31) >> 4) - ti * 64; }
        else if (MODE == 2) { hi = tok; }
        else { if (ti == n) hi = tok; else lo = tok + 1; }
#pragma unroll
        for (int kf = 0; kf < 4; ++kf)
#pragma unroll
          for (int r = 0; r < 4; ++r) {
            const int kk = kf * 16 + 4 * q + r;
            if (kk < lo || kk > hi) s[kf][t2][r] = -INFINITY;
          }
      }
    }
    half8 pf[2][2];
#pragma unroll
    for (int t2 = 0; t2 < 2; ++t2) {
      float mb, scale_p = 1.f;
      if (MODE == 1) {
        mb = m[t2] * LOG2E; scale_p = l[t2];
      } else if (MODE >= 2) {
        mb = m[t2] * LOG2E;
        if (MODE == 2 && !((selm[t2] >> ti) & 1ull)) mb = INFINITY;
      } else {
        float tm = s[0][t2][0];
#pragma unroll
        for (int kf = 0; kf < 4; ++kf)
#pragma unroll
          for (int r = 0; r < 4; ++r) tm = fmaxf(tm, s[kf][t2][r]);
        tm = rowmax4(tm);
        const float mn = fmaxf(m[t2], tm);
        const float alpha = fexp2((m[t2] - mn) * LOG2E);
        m[t2] = mn; mb = mn * LOG2E;
        l[t2] *= alpha;
      }
      float lsum = 0.f;
#pragma unroll
      for (int kf = 0; kf < 4; ++kf) {
#pragma unroll
        for (int r = 0; r < 4; ++r) {
          float pv = fexp2(fmaf(s[kf][t2][r], LOG2E, -mb));
          if (MODE == 1) pv *= scale_p;
          s[kf][t2][r] = pv; lsum += pv;
        }
      }
      if (MODE != 1) l[t2] += lsum;
      if (MODE == 1) {
        const int tok = th * 32 + t2 * 16 + r15;
#pragma unroll
        for (int kf = 0; kf < 4; ++kf) {
          const int j = 16 * ti + 4 * kf + q;
          const unsigned int u0 = (unsigned int)(s[kf][t2][0] * 134217728.f + 0.5f), u1 = (unsigned int)(s[kf][t2][1] * 134217728.f + 0.5f);
          const unsigned int u2 = (unsigned int)(s[kf][t2][2] * 134217728.f + 0.5f), u3 = (unsigned int)(s[kf][t2][3] * 134217728.f + 0.5f);
          if (j < 64) {
            atomicAdd(&impu[tok * IMPS + j], u0 + u1 + u2 + u3);
            atomicAdd(&impu[tok * IMPS + j + 1], u3);
          }
        }
      }
      if (MODE != 0) {
#pragma unroll
        for (int ks = 0; ks < 2; ++ks) {
          half8 pk;
#pragma unroll
          for (int r = 0; r < 4; ++r) { pk[r] = (half_t)s[2 * ks][t2][r]; pk[4 + r] = (half_t)s[2 * ks + 1][t2][r]; }
          pf[t2][ks] = pk;
        }
      }
    }
    if (MODE != 0) {
      asm volatile("s_waitcnt lgkmcnt(0)"
                   : "+v"(vr[0][0]), "+v"(vr[0][1]), "+v"(vr[0][2]), "+v"(vr[0][3]), "+v"(vr[1][0]), "+v"(vr[1][1]), "+v"(vr[1][2]), "+v"(vr[1][3]),
                     "+v"(vr[2][0]), "+v"(vr[2][1]), "+v"(vr[2][2]), "+v"(vr[2][3]), "+v"(vr[3][0]), "+v"(vr[3][1]), "+v"(vr[3][2]), "+v"(vr[3][3])
                   :: "memory");
      __builtin_amdgcn_sched_barrier(0);
#pragma unroll
      for (int df = 0; df < 4; ++df) {
#pragma unroll
        for (int ks = 0; ks < 2; ++ks) {
          const v2i lo2 = vr[df][2 * ks], hi2 = vr[df][2 * ks + 1];
          const v4i pk4 = (v4i){lo2[0], lo2[1], hi2[0], hi2[1]};
          const half8 vf = __builtin_bit_cast(half8, pk4);
#pragma unroll
          for (int t2 = 0; t2 < 2; ++t2) o[df][t2] = __builtin_amdgcn_mfma_f32_16x16x32_f16(vf, pf[t2][ks], o[df][t2], 0, 0, 0);
        }
      }
    }
  }
  __syncthreads();
#undef A_GLOAD
}

__device__ void ph_attn_mfma(const Params& P, char* smem, int wvs) {
  unsigned int* impu = (unsigned int*)(smem + ATT_IMP);
  unsigned long long* selmask = (unsigned long long*)(smem + ATT_SELM);
  const int G = gridDim.x, nrounds = (2048 + G - 1) / G;
  for (int rd = 0; rd < nrounds; ++rd) {
    const int idx = rd * G + ((rd & 1) ? (G - 1 - (int)blockIdx.x) : (int)blockIdx.x);
    if (idx >= 2048) continue;
    const int tid = otid(wvs), lane = tid & 63, r15 = lane & 15, q = lane >> 4;
    const int n = 63 - (idx >> 5), bg = idx & 31, b = bg >> 2, g = bg & 3;
    const int wv = __builtin_amdgcn_readfirstlane(otid(wvs) >> 6);
    const int hd = g * 4 + (wv & 3), th = wv >> 2;
    const int t0 = b * SEQ + n * 64 + th * 32;
    half8 qf[2][2];
#pragma unroll
    for (int t2 = 0; t2 < 2; ++t2)
#pragma unroll
      for (int ks = 0; ks < 2; ++ks) qf[t2][ks] = *(const half8*)(P.p + (size_t)(t0 + t2 * 16 + r15) * LD1 + hd * 64 + 32 * ks + 8 * q);
    float* gate_l = (float*)(smem + ATT_GATE) + wv * 128;
    if (q == 0) {
#pragma unroll
      for (int t2 = 0; t2 < 2; ++t2) {
        const float* pr = P.gl + (size_t)(t0 + t2 * 16 + r15) * 48 + hd * 3;
        f32x4 gv;
#pragma unroll
        for (int c = 0; c < 3; ++c) gv[c] = sigmoidf(pr[c] + P.nsa_b_gate[hd * 3 + c]);
        gv[3] = 0.f;
        *(f32x4*)(gate_l + (t2 * 16 + r15) * 4) = gv;
      }
    }
    { const int tz = otid(wvs); for (int i = tz; i < 64 * IMPS + 128; i += NTHREADS) impu[i] = 0u; }
    float m[2], l[2]; f32x4 o[4][2]; unsigned long long selm[2] = {0ull, 0ull};
#pragma unroll
    for (int t2 = 0; t2 < 2; ++t2) { m[t2] = -1e30f; l[t2] = 0.f; }
#pragma unroll
    for (int df = 0; df < 4; ++df)
#pragma unroll
      for (int t2 = 0; t2 < 2; ++t2) o[df][t2] = (f32x4){0.f, 0.f, 0.f, 0.f};
    const half_t* kc = P.kcmp + (size_t)bg * 256 * 64;
    const half_t* vc = P.vcmp + (size_t)bg * 256 * 64;
    const int nct = (4 * n + 2) / 64;
    attn_branch<0>(smem, kc, vc, 64, 0, nct, n, th, qf, m, l, o, selm, wvs);
#pragma unroll
    for (int t2 = 0; t2 < 2; ++t2) {
      float lt = l[t2];
      lt = rowsum4(lt);
      l[t2] = lt > 0.f ? 1.f / lt : 0.f;
    }
    attn_branch<1>(smem, kc, vc, 64, 0, nct, n, th, qf, m, l, o, selm, wvs);
    f32x4 oacc[4][2];
#pragma unroll
    for (int t2 = 0; t2 < 2; ++t2) {
      const float gc = gate_l[(t2 * 16 + r15) * 4 + 0];
#pragma unroll
      for (int df = 0; df < 4; ++df) oacc[df][t2] = o[df][t2] * gc;
    }
    {
      const int tid2 = otid(wvs);
      const int tok = tid2 >> 3, part = tid2 & 7;
      unsigned long long msk;
      if (n + 1 <= 16) {
        msk = (1ull << (n + 1)) - 1ull;
      } else {
        const uint4* rowp = (const uint4*)(impu + tok * IMPS);
        unsigned own[8];
        { const uint4 a = rowp[part * 2], b2 = rowp[part * 2 + 1];
          own[0] = a.x; own[1] = a.y; own[2] = a.z; own[3] = a.w; own[4] = b2.x; own[5] = b2.y; own[6] = b2.z; own[7] = b2.w; }
        int rank[8];
#pragma unroll
        for (int jj = 0; jj < 8; ++jj) {
          const int j = part * 8 + jj;
          own[jj] = (j >= 1 && j <= n - 2) ? ((own[jj] & ~63u) | (unsigned)(63 - j)) : 0xffffffffu;
          rank[jj] = 0;
        }
#pragma unroll 2
        for (int c4 = 0; c4 < 16; ++c4) {
          const uint4 v = rowp[c4];
          unsigned kv[4] = {v.x, v.y, v.z, v.w};
#pragma unroll
          for (int e = 0; e < 4; ++e) {
            const int j2 = c4 * 4 + e;
            const unsigned key2 = (j2 >= 1 && j2 <= n - 2) ? ((kv[e] & ~63u) | (unsigned)(63 - j2)) : 0u;
#pragma unroll
            for (int jj = 0; jj < 8; ++jj) rank[jj] += (key2 > own[jj]) ? 1 : 0;
          }
        }
        unsigned int bits = 0;
#pragma unroll
        for (int jj = 0; jj < 8; ++jj) if (rank[jj] < 13 && own[jj] != 0xffffffffu) bits |= 1u << jj;
        unsigned* sel32 = (unsigned*)selmask;
        if (bits) atomicOr(&sel32[tok * 2 + (part >> 2)], bits << (8 * (part & 3)));
        msk = 1ull | (1ull << n) | (1ull << (n - 1));
        if (part == 0) { atomicOr(&sel32[tok * 2], (unsigned)msk); atomicOr(&sel32[tok * 2 + 1], (unsigned)(msk >> 32)); }
      }
      if (n + 1 <= 16 && part == 0) selmask[tok] = msk;
    }
    __syncthreads();
#pragma unroll
    for (int t2 = 0; t2 < 2; ++t2) selm[t2] = selmask[th * 32 + t2 * 16 + r15];
    float qn2[2];
#pragma unroll
    for (int t2 = 0; t2 < 2; ++t2) {
      float a = 0.f;
#pragma unroll
      for (int ks = 0; ks < 2; ++ks)
#pragma unroll
        for (int e = 0; e < 8; ++e) a += (float)qf[t2][ks][e] * (float)qf[t2][ks][e];
      qn2[t2] = rowsum4(a);
    }
    { const float km = __uint_as_float(P.kmax2[bg * 2 + 0]);
#pragma unroll
      for (int t2 = 0; t2 < 2; ++t2) { m[t2] = sqrtf(qn2[t2] * km) * 1.001f - 5.0f; l[t2] = 0.f; } }
#pragma unroll
    for (int df = 0; df < 4; ++df)
#pragma unroll
      for (int t2 = 0; t2 < 2; ++t2) o[df][t2] = (f32x4){0.f, 0.f, 0.f, 0.f};
    attn_branch<2>(smem, P.p + (size_t)b * SEQ * LD1 + 1536 + g * 64, P.p + (size_t)b * SEQ * LD1 + 1792 + g * 64, LD1, 0, n, n, th, qf, m, l, o, selm, wvs);
#pragma unroll
    for (int t2 = 0; t2 < 2; ++t2) {
      const float gs = gate_l[(t2 * 16 + r15) * 4 + 1] / rowsum4(l[t2]);
#pragma unroll
      for (int df = 0; df < 4; ++df) oacc[df][t2] += o[df][t2] * gs;
    }
    { const float km = __uint_as_float(P.kmax2[bg * 2 + 1]);
#pragma unroll
      for (int t2 = 0; t2 < 2; ++t2) { m[t2] = sqrtf(qn2[t2] * km) * 1.001f - 5.0f; l[t2] = 0.f; } }
#pragma unroll
    for (int df = 0; df < 4; ++df)
#pragma unroll
      for (int t2 = 0; t2 < 2; ++t2) o[df][t2] = (f32x4){0.f, 0.f, 0.f, 0.f};
    attn_branch<3>(smem, P.p + (size_t)b * SEQ * LD1 + 2048 + g * 64, P.p + (size_t)b * SEQ * LD1 + 2304 + g * 64, LD1, (n > 8 ? n - 8 : 0), n, n, th, qf, m, l, o, selm, wvs);
    {
      int tbase = t0 + r15; asm volatile("" : "+v"(tbase));
#pragma unroll
      for (int t2 = 0; t2 < 2; ++t2) {
        const size_t tok = (size_t)(tbase + t2 * 16);
        const float gw = gate_l[(t2 * 16 + r15) * 4 + 2] / rowsum4(l[t2]);
#pragma unroll
        for (int df = 0; df < 4; ++df) {
          const f32x4 v = oacc[df][t2] + o[df][t2] * gw;
          const half4 z = *(const half4*)(P.p + tok * LD1 + 2560 + hd * 64 + df * 16 + 4 * q);
          half4 hv;
#pragma unroll
          for (int e = 0; e < 4; ++e) hv[e] = (half_t)(v[e] * siluf((float)z[e]));
          *(half4*)(P.og + tok * DM + hd * 64 + df * 16 + 4 * q) = hv;
        }
      }
    }
  }
}

constexpr int NPHASES = 13;
__device__ __forceinline__ void run_phase(int ph, const Params& P, char* smem, int wvs) {
  float* sm = (float*)smem;
  switch (ph) {
    case 0:
      if (blockIdx.x == 0 && otid(wvs) < 64) P.kmax2[otid(wvs)] = 0u;
      ph_xh_rstd(P.x, P.xh, P.rstd, wvs); ph_ropetab(P, wvs); prep_cbias_part(P, wvs);
      prep_wT4(P.gla_w_in, GLA_IN, P.pre_norm, P.W0t, LD0, DM, 0, sm, wvs);
      prep_wT4(P.gla_w_out, DM, nullptr, P.Wo0t, DM, DM, 2, sm, wvs);
      prep_wT4(P.nsa_w_in, NSA_IN, P.pre_norm + DM, P.W1t, LD1, DM, 1, sm, wvs);
      prep_wT4(P.nsa_w_out, DM, nullptr, P.Wo1t, DM, DM, 2, sm, wvs);
      prep_wT(P.nsa_w_in, NSA_IN, P.pre_norm + DM, P.WglT, 64, DM, 5, sm, wvs);
      prep_wT4(P.ck_w1, 256, nullptr, P.cw1t, 256, 2048, 2, sm, wvs);
      prep_wT4(P.cv_w1, 256, nullptr, P.cw1t + 256 * 2048, 256, 2048, 2, sm, wvs);
      prep_wT4(P.ck_w2, 64, nullptr, P.cw2t, 256, 256, 4, sm, wvs);
      prep_wT4(P.cv_w2, 64, nullptr, P.cw2t + 256 * 256, 256, 256, 4, sm, wvs);
      break;
    case 1: g8::gemm(g8::SrcPlain8{P.xh, DM, P.W0t, DM}, T_TOK, LD0, DM, g8::EpiStore8{P.p, LD0, P.rstd}, smem, wvs); break;
    case 2: prep_cbias_reduce(P, wvs); ph_gla_prep(P, sm, wvs); break;
    case 13: ph_gla_mfma<true>(P, smem, wvs); break;
    case 3: ph_gla_mfma<false>(P, smem, wvs); break;
    case 4: ph_gla_post(P, wvs); break;
    case 5: g8::gemm(g8::SrcPlain8{P.og, DM, P.Wo0t, DM}, T_TOK, DM, DM, g8::EpiStore8{P.y, DM, nullptr}, smem, wvs); break;
    case 6: ph_post(P.x, P.y, P.post_norm, P.out, P.xh, P.rstd, wvs); break;
    case 7: g8::gemm(g8::SrcPlain8{P.xh, DM, P.W1t, DM}, T_TOK, LD1, DM, g8::EpiRope8{P.p, LD1, P.rstd, P.ropetab}, smem, wvs); break;
    case 8: ph_gates(P, smem, wvs, 64); g8::gemm(g8::SrcCmp1_8{P.p, P.cw1t}, 16384, 256, 2048, g8::EpiCmpHid8{P.hid, P.cbias}, smem, wvs); break;
    case 9: ph_kmax(P, wvs); g8::gemm(g8::SrcCmp2_8{P.hid, P.cw2t}, 16384, 256, 256, g8::EpiCmpOut8{P.kcmp, P.vcmp}, smem, wvs); break;
    case 10: ph_attn_mfma(P, smem, wvs); break;
    case 11: g8::gemm(g8::SrcPlain8{P.og, DM, P.Wo1t, DM}, T_TOK, DM, DM, g8::EpiStore8{P.y, DM, nullptr}, smem, wvs); break;
    case 12: ph_post(P.out, P.y, P.post_norm + DM, P.out, nullptr, nullptr, wvs); break;
  }
}

template <int PH>
__global__ void __launch_bounds__(NTHREADS, 2) k_phase(Params P) {
  __shared__ __attribute__((aligned(16))) char smem[SMEM_BYTES];
  run_phase(PH, P, smem, __builtin_amdgcn_readfirstlane(threadIdx.x >> 6));
}
template <int PH>
static void launch_phases(const Params& P, hipStream_t stream) {
  hipLaunchKernelGGL((k_phase<PH>), dim3(256), dim3(NTHREADS), 0, stream, P);
  if constexpr (PH + 1 < NPHASES) launch_phases<PH + 1>(P, stream);
}

#if MEGA
__global__ void __launch_bounds__(NTHREADS, 2) k_mega(Params P) {
  __shared__ __attribute__((aligned(16))) char smem[SMEM_BYTES];
  cg::grid_group grid = cg::this_grid();
  if (P.use_cg_sync) grid.sync();
  unsigned bt = 0;
  const int wvs = __builtin_amdgcn_readfirstlane(threadIdx.x >> 6);
  run_phase(0, P, smem, wvs); fast_barrier(P.bar, bt, wvs);
  run_phase(1, P, smem, wvs); fast_barrier(P.bar, bt, wvs);
  run_phase(2, P, smem, wvs); fast_barrier(P.bar, bt, wvs);
  run_phase(13, P, smem, wvs); fast_barrier(P.bar, bt, wvs);
  run_phase(3, P, smem, wvs); fast_barrier(P.bar, bt, wvs);
  run_phase(4, P, smem, wvs); fast_barrier(P.bar, bt, wvs);
  run_phase(5, P, smem, wvs); fast_barrier(P.bar, bt, wvs);
  run_phase(6, P, smem, wvs); fast_barrier(P.bar, bt, wvs);
  run_phase(7, P, smem, wvs); fast_barrier(P.bar, bt, wvs);
  run_phase(8, P, smem, wvs); fast_barrier(P.bar, bt, wvs);
  run_phase(9, P, smem, wvs); fast_barrier(P.bar, bt, wvs);
  run_phase(10, P, smem, wvs); fast_barrier(P.bar, bt, wvs);
  run_phase(11, P, smem, wvs); fast_barrier(P.bar, bt, wvs);
  run_phase(12, P, smem, wvs);
}
#endif

extern "C" void kernel_launch(void* const* d_in, const int* in_sizes, int n_in, void* d_out, int out_size, void* d_ws, size_t ws_size,
                              hipStream_t stream) {
  Params P{};
  P.x = (const float*)d_in[0]; P.pos = (const int*)d_in[1]; P.pre_norm = (const float*)d_in[2]; P.post_norm = (const float*)d_in[3];
  P.gla_w_in = (const float*)d_in[4]; P.gla_w_gk_up = (const float*)d_in[5]; P.gla_b_gk = (const float*)d_in[6];
  P.gla_head_norm = (const float*)d_in[7]; P.gla_w_out = (const float*)d_in[8];
  P.nsa_w_in = (const float*)d_in[9]; P.nsa_b_gate = (const float*)d_in[10]; P.nsa_pe_k = (const float*)d_in[11]; P.nsa_pe_v = (const float*)d_in[12];
  P.ck_w1 = (const float*)d_in[13]; P.ck_w2 = (const float*)d_in[14]; P.cv_w1 = (const float*)d_in[15]; P.cv_w2 = (const float*)d_in[16];
  P.nsa_w_out = (const float*)d_in[17];
  P.out = (float*)d_out;
  char* ws = (char*)d_ws;
  const size_t MB = 1024 * 1024;
  P.W0t = (half_t*)(ws);
  P.Wo0t = (half_t*)(ws + 7 * MB);
  P.W1t = (half_t*)(ws + 9 * MB);
  P.Wo1t = (half_t*)(ws + 17 * MB);
  P.cw1t = (half_t*)(ws + 19 * MB);
  P.cw2t = (half_t*)(ws + 21 * MB);
  P.cbias = (float*)(ws + 22 * MB);
  P.cbias_part = (float*)(ws + 22 * MB + 4096);
  P.bar = (unsigned*)(ws + 23 * MB);
  P.use_cg_sync = 0;
  P.kmax2 = (unsigned*)(ws + 22 * MB + 512 * 1024);
  P.xh = (half_t*)(ws + 24 * MB);
  P.p = (half_t*)(ws + 88 * MB);
  P.y = (half_t*)(ws + 88 * MB);
  P.og = (half_t*)(ws + 328 * MB);
  P.bcum = (float*)(ws + 392 * MB);
  P.rstd = (float*)(ws + 456 * MB);
  P.kcmp = (half_t*)(ws + 457 * MB);
  P.vcmp = (half_t*)(ws + 458 * MB);
  P.ropetab = (float*)(ws + 459 * MB);
  P.hid = (half_t*)(ws + 467 * MB);
  P.WglT = (half_t*)(ws + 22 * MB + 768 * 1024);
  P.gl = (float*)(ws + 503 * MB);
  P.gla_state = (float*)(ws + 476 * MB);
  if (ws_size < 510 * MB) { fprintf(stderr, "ws too small: %zu\n", ws_size); return; }
#if MEGA
  static int grid_blocks = 0;
  if (!grid_blocks) {
    int dev = 0, cus = 0, per_cu = 0;
    hipGetDevice(&dev);
    hipDeviceGetAttribute(&cus, hipDeviceAttributeMultiprocessorCount, dev);
    hipOccupancyMaxActiveBlocksPerMultiprocessor(&per_cu, k_mega, NTHREADS, 0);
    if (per_cu < 1) per_cu = 1;
    if (per_cu > 1) per_cu = 1;
    grid_blocks = cus * per_cu;
  }
  hipMemsetAsync(ws + 23 * MB, 0, 16384, stream);
  void* args[] = {&P};
  hipError_t e = hipLaunchCooperativeKernel((void*)k_mega, dim3(grid_blocks), dim3(NTHREADS), args, 0, stream);
  if (e != hipSuccess) fprintf(stderr, "cooperative launch failed: %s (grid %d)\n", hipGetErrorString(e), grid_blocks);
#else
  launch_phases<0>(P, stream);
#endif
}
```

```cpp
#include <hip/hip_runtime.h>
#include <hip/hip_cooperative_groups.h>
#include <cstdio>
#include <cstdint>
namespace cg = cooperative_groups;

typedef _Float16 half_t;
typedef _Float16 half8 __attribute__((ext_vector_type(8)));
typedef _Float16 half4 __attribute__((ext_vector_type(4)));
typedef float f32x4 __attribute__((ext_vector_type(4)));
typedef int v2i __attribute__((ext_vector_type(2)));
typedef int v4i __attribute__((ext_vector_type(4)));

#ifndef MEGA
#define MEGA 1
#endif

constexpr int T_TOK = 32768, DM = 1024, SEQ = 4096, NBATCH = 8;
constexpr int GLA_IN = 3088, NSA_IN = 3632;
constexpr int LD0 = 3328, LD1 = 3584;
constexpr int NC = 255;
constexpr float EPS = 1e-6f;
constexpr int NTHREADS = 512, NWAVES = NTHREADS / 64;
constexpr int SMEM_BYTES = 160 * 1024;

struct Params {
  const float* x; const int* pos; const float* pre_norm; const float* post_norm;
  const float* gla_w_in; const float* gla_w_gk_up; const float* gla_b_gk; const float* gla_head_norm; const float* gla_w_out;
  const float* nsa_w_in; const float* nsa_b_gate; const float* nsa_pe_k; const float* nsa_pe_v;
  const float* ck_w1; const float* ck_w2; const float* cv_w1; const float* cv_w2; const float* nsa_w_out;
  float* out;
  half_t* p; half_t* y; half_t* og; float* bcum; float* rstd; half_t* kcmp; half_t* vcmp; float* ropetab;
  half_t* xh; half_t* W0t; half_t* Wo0t; half_t* W1t; half_t* Wo1t;
  half_t* cw1t; half_t* cw2t; float* cbias; half_t* hid;
  float* cbias_part; unsigned* bar; long long use_cg_sync; unsigned* kmax2; float* gla_state; half_t* WglT; float* gl;
};

__device__ __forceinline__ int lane_id() { return (int)__builtin_amdgcn_mbcnt_hi(~0u, __builtin_amdgcn_mbcnt_lo(~0u, 0u)); }
__device__ __forceinline__ int otid(int wvs) { int t = wvs * 64 + lane_id(); asm volatile("" : "+v"(t)); return t; }
__device__ __forceinline__ float wave_sum(float v) {
#pragma unroll
  for (int o = 32; o > 0; o >>= 1) v += __shfl_xor(v, o);
  return v;
}
__device__ __forceinline__ float wave_max(float v) {
#pragma unroll
  for (int o = 32; o > 0; o >>= 1) v = fmaxf(v, __shfl_xor(v, o));
  return v;
}
typedef __attribute__((address_space(3))) void lds_void;
typedef __attribute__((address_space(1))) const void gbl_void;
typedef short s16x4 __attribute__((vector_size(8)));
typedef __attribute__((address_space(3))) s16x4 lds_s16x4;
__device__ __forceinline__ half4 tr_read4(const char* p) {
  const s16x4 v = __builtin_amdgcn_ds_read_tr16_b64_v4i16((lds_s16x4*)(p));
  return __builtin_bit_cast(half4, v);
}
template <int N> __device__ __forceinline__ void wait_vmcnt() { asm volatile("s_waitcnt vmcnt(%0)" ::"n"(N) : "memory"); }
constexpr float LOG2E = 1.4426950408889634f;
__device__ __forceinline__ float fexp2(float x) { return __builtin_amdgcn_exp2f(x); }
typedef unsigned u32x2 __attribute__((ext_vector_type(2)));
__device__ __forceinline__ float rowmax4(float x) {
  u32x2 r = __builtin_amdgcn_permlane16_swap(__float_as_uint(x), __float_as_uint(x), false, false);
  x = fmaxf(__uint_as_float(r[0]), __uint_as_float(r[1]));
  r = __builtin_amdgcn_permlane32_swap(__float_as_uint(x), __float_as_uint(x), false, false);
  return fmaxf(__uint_as_float(r[0]), __uint_as_float(r[1]));
}
__device__ __forceinline__ float rowsum4(float x) {
  u32x2 r = __builtin_amdgcn_permlane16_swap(__float_as_uint(x), __float_as_uint(x), false, false);
  x = __uint_as_float(r[0]) + __uint_as_float(r[1]);
  r = __builtin_amdgcn_permlane32_swap(__float_as_uint(x), __float_as_uint(x), false, false);
  return __uint_as_float(r[0]) + __uint_as_float(r[1]);
}
__device__ __forceinline__ float fast_exp2(float x) { return __builtin_amdgcn_exp2f(x); }
__device__ __forceinline__ float sigmoidf(float v) { return __builtin_amdgcn_rcpf(1.f + fast_exp2(-1.4426950408889634f * v)); }
__device__ __forceinline__ float siluf(float v) { return v * sigmoidf(v); }
__device__ __forceinline__ float logsigmoidf(float u) { return fminf(u, 0.f) - 0.6931471805599453f * __builtin_amdgcn_logf(1.f + fast_exp2(-1.4426950408889634f * fabsf(u))); }

__device__ __forceinline__ void fast_barrier(unsigned* bar, unsigned& round, int wvs) {
  asm volatile("s_waitcnt vmcnt(0) lgkmcnt(0)" ::: "memory");
  __syncthreads();
  round += 1;
  if (wvs == 0 && lane_id() == 0) {
    __builtin_amdgcn_fence(__ATOMIC_RELEASE, "agent");
    asm volatile("s_waitcnt vmcnt(0)" ::: "memory");
    const unsigned ngroups = gridDim.x >> 4;
    const unsigned old = __hip_atomic_fetch_add(bar + 64 + 64 * (blockIdx.x >> 4), 1u, __ATOMIC_RELAXED, __HIP_MEMORY_SCOPE_AGENT);
    if (old + 1 == round * 16u) __hip_atomic_fetch_add(bar, 1u, __ATOMIC_RELAXED, __HIP_MEMORY_SCOPE_AGENT);
    const unsigned target = round * ngroups;
    while (__hip_atomic_load(bar, __ATOMIC_RELAXED, __HIP_MEMORY_SCOPE_AGENT) < target) { }
    __builtin_amdgcn_fence(__ATOMIC_ACQUIRE, "agent");
    asm volatile("s_waitcnt vmcnt(0)" ::: "memory");
  }
  __syncthreads();
}

__device__ void ph_xh_rstd(const float* src, half_t* xh, float* rstd, int wvs) {
  const int tid_ = otid(wvs); const int lane = tid_ & 63, w = tid_ >> 6;
#pragma unroll 2
  for (int row = blockIdx.x * NWAVES + w; row < T_TOK; row += gridDim.x * NWAVES) {
    const float4* r = (const float4*)(src + (size_t)row * DM);
    half4* xr = (half4*)(xh + (size_t)row * DM);
    float ss = 0.f;
#pragma unroll
    for (int i = 0; i < 4; ++i) {
      const float4 v = r[lane + 64 * i];
      ss += v.x * v.x + v.y * v.y + v.z * v.z + v.w * v.w;
      half4 hv; hv[0] = (half_t)v.x; hv[1] = (half_t)v.y; hv[2] = (half_t)v.z; hv[3] = (half_t)v.w;
      xr[lane + 64 * i] = hv;
    }
    ss = wave_sum(ss);
    if (lane == 0) rstd[row] = rsqrtf(ss * (1.f / DM) + EPS);
  }
}
__device__ void ph_ropetab(const Params& P, int wvs) {
  const int tid = otid(wvs);
  const float inv = powf(10000.f, -(float)(2 * (tid & 31)) / 64.f);
  for (int idx = blockIdx.x * NTHREADS + tid; idx < T_TOK * 32; idx += gridDim.x * NTHREADS) {
    const int t = idx >> 5, i = idx & 31;
    const float ang = (float)P.pos[t] * inv;
    float s, c; sincosf(ang, &s, &c);
    P.ropetab[t * 64 + i] = c; P.ropetab[t * 64 + 32 + i] = s;
  }
}
__device__ __forceinline__ int orig_col(int n, int mode) {
  if (mode == 0) {
    if (n < 2048) return n;
    if (n < 3072) return n + 16;
    if (n < 3088) return n - 1024;
    return -1;
  } else if (mode == 1) {
    if (n < 2560) return n;
    if (n < 3584) return n + 48;
    return -1;
  } else if (mode == 5) {
    return n < 48 ? 2560 + n : -1;
  }
  if (mode == 4) return n < 64 ? n : -1;
  return n;
}
__device__ void prep_wT(const float* W, int ldw, const float* gamma, half_t* Wt, int Npad, int K, int mode, float* sm, int wvs) {
  float(*tile)[65] = (float(*)[65])sm;
  const int tid = otid(wvs);
  const int ntn = Npad / 64, ntk = K / 64;
  for (int t = blockIdx.x; t < ntn * ntk; t += gridDim.x) {
    const int n0 = (t / ntk) * 64, k0 = (t % ntk) * 64;
    __syncthreads();
#pragma unroll
    for (int r = 0; r < 4096 / NTHREADS; ++r) {
      const int idx = tid + r * NTHREADS, kk = idx >> 6, nn = idx & 63;
      const int on = orig_col(n0 + nn, mode);
      float v = 0.f;
      if (on >= 0) { v = W[(size_t)(k0 + kk) * ldw + on]; if (gamma) v *= gamma[k0 + kk]; }
      tile[kk][nn] = v;
    }
    __syncthreads();
    {
      const int nn = tid >> 3, oct = tid & 7;
      half8 hv;
#pragma unroll
      for (int e = 0; e < 8; ++e) hv[e] = (half_t)tile[oct * 8 + e][nn];
      *(half8*)(Wt + (size_t)(n0 + nn) * K + k0 + oct * 8) = hv;
    }
  }
}

__device__ void prep_wT4(const float* W, int ldw, const float* gamma, half_t* Wt, int Npad, int K, int mode, float* sm, int wvs) {
  float(*tile)[260] = (float(*)[260])sm;
  const int tid = otid(wvs);
  const int nsn = Npad / 256, nsk = K / 64;
  for (int t = blockIdx.x; t < nsn * nsk; t += gridDim.x) {
    const int n0 = (t / nsk) * 256, k0 = (t % nsk) * 64;
    __syncthreads();
#pragma unroll
    for (int r = 0; r < 8; ++r) {
      const int idx = tid + r * NTHREADS, kk = idx >> 6, n4 = (idx & 63) * 4;
      const int on = orig_col(n0 + n4, mode);
      f32x4 v = (f32x4){0.f, 0.f, 0.f, 0.f};
      if (on >= 0) { v = *(const f32x4*)(W + (size_t)(k0 + kk) * ldw + on); if (gamma) v *= gamma[k0 + kk]; }
      *(f32x4*)&tile[kk][n4] = v;
    }
    __syncthreads();
#pragma unroll
    for (int r = 0; r < 4; ++r) {
      const int idx = tid + r * NTHREADS, nn = idx & 255, oct = idx >> 8;
      half8 hv;
#pragma unroll
      for (int e = 0; e < 8; ++e) hv[e] = (half_t)tile[oct * 8 + e][nn];
      *(half8*)(Wt + (size_t)(n0 + nn) * K + k0 + oct * 8) = hv;
    }
  }
}

__device__ void prep_cbias_part(const Params& P, int wvs) {
  for (int idx = blockIdx.x * NTHREADS + otid(wvs); idx < 2 * 32 * 256; idx += gridDim.x * NTHREADS) {
    const int j = idx & 255, ks = (idx >> 8) & 31, which = idx >> 13;
    const float* pe = which ? P.nsa_pe_v : P.nsa_pe_k;
    const float* w1 = which ? P.cv_w1 : P.ck_w1;
    float a = 0.f;
#pragma unroll 8
    for (int k = ks * 64; k < ks * 64 + 64; ++k) a += pe[k] * w1[(size_t)k * 256 + j];
    P.cbias_part[idx] = a;
  }
}
__device__ void prep_cbias_reduce(const Params& P, int wvs) {
  if (blockIdx.x < 2 && otid(wvs) < 256) {
    const int which = blockIdx.x, j = otid(wvs);
    float a = 0.f;
    for (int ks = 0; ks < 32; ++ks) a += P.cbias_part[(which * 32 + ks) * 256 + j];
    P.cbias[which * 256 + j] = a;
  }
}

namespace g8 {
constexpr int BK = 64, HALF = 128, HTB = HALF * BK * 2;
__device__ __forceinline__ int lds_byte(int r, int c) { const int st = (r >> 4) * 2 + (c >> 5), rr = r & 15, cc = c & 31, ob = rr * 64 + cc * 2; return st * 1024 + (ob ^ (((ob >> 9) & 1) << 5)); }
__device__ __forceinline__ void stage_rc(int b, int& R, int& C) { const int st = b / 1024, sb = b % 1024, swz = sb ^ (((sb >> 9) & 1) << 5); R = (st >> 1) * 16 + swz / 64; C = (st & 1) * 32 + (swz % 64) / 2; }
typedef f32x4 Acc[2][2][4][2];

struct SrcPlain8 {
  const half_t* A; int lda; const half_t* Bt; int K;
  __device__ __forceinline__ void get(int pm, int pn, const half_t*& Ag, const half_t*& Bg, size_t& a_rs, int& a_ks) const {
    Ag = A + (size_t)pm * 256 * lda; Bg = Bt + (size_t)pn * 256 * K; a_rs = lda; a_ks = 64;
  }
};
struct SrcCmp1_8 {
  const half_t* p1; const half_t* w1t;
  __device__ __forceinline__ void get(int pm, int pn, const half_t*& Ag, const half_t*& Bg, size_t& a_rs, int& a_ks) const {
    const int which = pm >> 5, bg = pm & 31, b = bg >> 2, g = bg & 3;
    Ag = p1 + (size_t)(b * SEQ) * LD1 + (which ? 1280 : 1024) + g * 64;
    Bg = w1t + (size_t)which * 256 * 2048; a_rs = (size_t)16 * LD1; a_ks = LD1;
  }
};
struct SrcCmp2_8 {
  const half_t* hid; const half_t* w2t;
  __device__ __forceinline__ void get(int pm, int pn, const half_t*& Ag, const half_t*& Bg, size_t& a_rs, int& a_ks) const {
    Ag = hid + (size_t)pm * 256 * 256; Bg = w2t + (size_t)(pm >> 5) * 256 * 256; a_rs = 256; a_ks = 64;
  }
};

__device__ __forceinline__ half8 pack8(const f32x4 a, const f32x4 b) {
  half8 h; h[0] = (half_t)a[0]; h[1] = (half_t)a[1]; h[2] = (half_t)a[2]; h[3] = (half_t)a[3]; h[4] = (half_t)b[0]; h[5] = (half_t)b[1]; h[6] = (half_t)b[2]; h[7] = (half_t)b[3];
  return h;
}
struct EpiStore8 {
  half_t* C; int ldc; const float* rowscale;
  __device__ __forceinline__ void operator()(const Acc& acc, int row0, int col0, int wr, int wc, int fr, int fq) const {
#pragma unroll
    for (int ai = 0; ai < 2; ++ai)
#pragma unroll
      for (int m = 0; m < 4; ++m) {
        const int tok = row0 + ai * 128 + wr * 64 + m * 16 + fr;
        const float s = rowscale ? rowscale[tok] : 1.f;
        half_t* rowp = C + (size_t)tok * ldc + col0 + 64 * wc + 8 * fq;
#pragma unroll
        for (int bj = 0; bj < 2; ++bj) *(half8*)(rowp + 32 * bj) = pack8(acc[ai][bj][m][0] * s, acc[ai][bj][m][1] * s);
      }
  }
};
struct EpiRope8 {
  half_t* C; int ldc; const float* rowscale; const float* ropetab;
  __device__ __forceinline__ void operator()(const Acc& acc, int row0, int col0, int wr, int wc, int fr, int fq) const {
    const int grp = (col0 >> 6) + wc;
    const bool is_q = grp < 16;
    const bool roped = is_q || (grp >= 16 && grp < 20) || (grp >= 24 && grp < 28) || (grp >= 32 && grp < 36);
    const float sc = is_q ? 0.125f * 1.4426950408889634f : 1.f;
#pragma unroll
    for (int ai = 0; ai < 2; ++ai)
#pragma unroll
      for (int m = 0; m < 4; ++m) {
        const int tok = row0 + ai * 128 + wr * 64 + m * 16 + fr;
        const float s = rowscale[tok];
        half_t* rowp = C + (size_t)tok * ldc + col0 + 64 * wc + 8 * fq;
        f32x4 o1[2], o2[2];
#pragma unroll
        for (int n = 0; n < 2; ++n) {
          const f32x4 x1 = acc[ai][0][m][n] * s, x2 = acc[ai][1][m][n] * s;
          if (roped) {
            const f32x4 cs = *(const f32x4*)(ropetab + (size_t)tok * 64 + 8 * fq + 4 * n);
            const f32x4 sn = *(const f32x4*)(ropetab + (size_t)tok * 64 + 32 + 8 * fq + 4 * n);
            o1[n] = (x1 * cs - x2 * sn) * sc; o2[n] = (x2 * cs + x1 * sn) * sc;
          } else { o1[n] = x1; o2[n] = x2; }
        }
        *(half8*)(rowp) = pack8(o1[0], o1[1]);
        *(half8*)(rowp + 32) = pack8(o2[0], o2[1]);
      }
  }
};
struct EpiCmpHid8 {
  half_t* hid; const float* bias;
  __device__ __forceinline__ void operator()(const Acc& acc, int row0, int col0, int wr, int wc, int fr, int fq) const {
    const int which = row0 >> 13;
#pragma unroll
    for (int bj = 0; bj < 2; ++bj) {
      const int col = col0 + 64 * wc + 32 * bj + 8 * fq;
      const f32x4 b0 = *(const f32x4*)(bias + which * 256 + col), b1 = *(const f32x4*)(bias + which * 256 + col + 4);
#pragma unroll
      for (int ai = 0; ai < 2; ++ai)
#pragma unroll
        for (int m = 0; m < 4; ++m) {
          const int row = row0 + ai * 128 + wr * 64 + m * 16 + fr;
          f32x4 v0 = acc[ai][bj][m][0] + b0, v1 = acc[ai][bj][m][1] + b1;
#pragma unroll
          for (int e = 0; e < 4; ++e) { v0[e] = siluf(v0[e]); v1[e] = siluf(v1[e]); }
          *(half8*)(hid + (size_t)row * 256 + col) = pack8(v0, v1);
        }
    }
  }
};
struct EpiCmpOut8 {
  half_t* kcmp; half_t* vcmp;
  __device__ __forceinline__ void operator()(const Acc& acc, int row0, int col0, int wr, int wc, int fr, int fq) const {
    if (wc != 0) return;
#pragma unroll
    for (int ai = 0; ai < 2; ++ai)
#pragma unroll
      for (int m = 0; m < 4; ++m) {
        const int row = row0 + ai * 128 + wr * 64 + m * 16 + fr;
        const int which = row >> 13, r = row & 8191;
        half_t* dst = (which ? vcmp : kcmp) + (size_t)r * 64 + 8 * fq;
        const bool dead = (r & 255) == 255;
#pragma unroll
        for (int bj = 0; bj < 2; ++bj) {
          half8 hv = pack8(acc[ai][bj][m][0], acc[ai][bj][m][1]);
          if (dead) hv = (half8){(half_t)0.f, (half_t)0.f, (half_t)0.f, (half_t)0.f, (half_t)0.f, (half_t)0.f, (half_t)0.f, (half_t)0.f};
          *(half8*)(dst + 32 * bj) = hv;
        }
      }
  }
};

template <class Src, class Epi>
__device__ void gemm(const Src& src, int M, int N, int K, const Epi& epi, char* smem, int wvs) {
  const int tid = otid(wvs), wid = __builtin_amdgcn_readfirstlane(tid >> 6), lane = tid & 63, wr = wid >> 2, wc = wid & 3, fr = lane & 15, fq = lane >> 4;
  const int nM = M / 256, nN = N / 256, nwg = nM * nN, G = gridDim.x, nt = K / BK;
  int sr0, sc0, sr1, sc1;
  stage_rc(tid * 16, sr0, sc0); stage_rc(tid * 16 + 8192, sr1, sc1);
  const int a_base = lds_byte(wr * 64 + fr, fq * 8);
  int b_base = 65536 + lds_byte(wc * 32 + fr, fq * 8);
  asm volatile("" : "+v"(b_base));
#define SA8(b, h) (smem + ((b) * 2 + (h)) * HTB)
#define SB8(b, h) (smem + (4 + (b) * 2 + (h)) * HTB)
#define STAGE_A(P, h, kt) { const char* g_ = (const char*)(Ag + (size_t)(h) * 128 * lda + (size_t)(kt) * a_ks); \
    __builtin_amdgcn_global_load_lds((gbl_void*)(g_ + aob0), (lds_void*)((P) + wid * 1024), 16, 0, 0); \
    __builtin_amdgcn_global_load_lds((gbl_void*)(g_ + aob1), (lds_void*)((P) + 8192 + wid * 1024), 16, 0, 0); }
#define STAGE_B(P, h, kt) { const char* g_ = (const char*)(Bg + (size_t)(h) * 32 * K + (size_t)(kt) * 64);     \
    __builtin_amdgcn_global_load_lds((gbl_void*)(g_ + bob0), (lds_void*)((P) + wid * 1024), 16, 0, 0); \
    __builtin_amdgcn_global_load_lds((gbl_void*)(g_ + bob1), (lds_void*)((P) + 8192 + wid * 1024), 16, 0, 0); }
#define LDA8(dst, b, h) { _Pragma("unroll") for (int m = 0; m < 4; ++m) _Pragma("unroll") for (int k = 0; k < 2; ++k) dst[m][k] = *(const half8*)(SA8(b, h) + a_base + m * 2048 + k * 1024); }
#define LDB8(dst, b, h) { _Pragma("unroll") for (int n = 0; n < 2; ++n) _Pragma("unroll") for (int k = 0; k < 2; ++k) dst[n][k] = *(const half8*)(smem + ((b) * 2 + (h)) * HTB + b_base + n * 2048 + k * 1024); }
#define MMA8(ai, bj, At, Bx) { __builtin_amdgcn_s_setprio(1); \
    _Pragma("unroll") for (int m = 0; m < 4; ++m) _Pragma("unroll") for (int n = 0; n < 2; ++n) _Pragma("unroll") for (int k = 0; k < 2; ++k) \
      acc[ai][bj][m][n] = __builtin_amdgcn_mfma_f32_16x16x32_f16(Bx[n][k], At[m][k], acc[ai][bj][m][n], 0, 0, 0); \
    __builtin_amdgcn_s_setprio(0); }
#define WAIT_V(n) asm volatile("s_waitcnt vmcnt(" #n ")" ::: "memory")
#define WAIT_L(n) asm volatile("s_waitcnt lgkmcnt(" #n ")" ::: "memory")
#define BAR __builtin_amdgcn_s_barrier()
#define SCHED __builtin_amdgcn_sched_barrier(0)
  for (int it = 0;; ++it) {
    const int L = it * G + (int)blockIdx.x;
    if (L >= nwg) break;
    int wgid;
    { const int q = nwg / 8, r = nwg % 8, xcd = L % 8, off = L / 8; wgid = (xcd < r ? xcd * (q + 1) : r * (q + 1) + (xcd - r) * q) + off; }
    const int nig = 8 * nN, gid = wgid / nig, fm = gid * 8, gsz = (nM - fm) < 8 ? (nM - fm) : 8;
    const int pm = fm + ((wgid % nig) % gsz), pn = (wgid % nig) / gsz;
    const half_t* Ag; const half_t* Bg; size_t lda; int a_ks;
    src.get(pm, pn, Ag, Bg, lda, a_ks);
    const unsigned aob0 = (unsigned)(((size_t)sr0 * lda + sc0) * 2), aob1 = (unsigned)(((size_t)sr1 * lda + sc1) * 2);
    const int pr0 = 64 * (sr0 >> 5) + 8 * ((sr0 & 15) >> 2) + 4 * ((sr0 >> 4) & 1) + (sr0 & 3), pr1 = 64 * (sr1 >> 5) + 8 * ((sr1 & 15) >> 2) + 4 * ((sr1 >> 4) & 1) + (sr1 & 3);
    const unsigned bob0 = (unsigned)((pr0 * K + sc0) * 2), bob1 = (unsigned)((pr1 * K + sc1) * 2);
    Acc acc;
#pragma unroll
    for (int a = 0; a < 2; ++a)
#pragma unroll
      for (int b = 0; b < 2; ++b)
#pragma unroll
        for (int m = 0; m < 4; ++m)
#pragma unroll
          for (int n = 0; n < 2; ++n) acc[a][b][m][n] = (f32x4){0.f, 0.f, 0.f, 0.f};
    half8 At[4][2], B0[2][2], B1[2][2];
    STAGE_B(SB8(0, 0), 0, 0) STAGE_A(SA8(0, 0), 0, 0)
    STAGE_B(SB8(0, 1), 1, 0) STAGE_A(SA8(0, 1), 1, 0)
    if (wr == 1) BAR;
    WAIT_V(4); BAR;
    STAGE_B(SB8(1, 0), 0, 1) STAGE_A(SA8(1, 0), 0, 1) STAGE_B(SB8(1, 1), 1, 1)
    WAIT_V(6); BAR;
#pragma unroll 1
    for (int t = 0; t < nt - 2; t += 2) {
      LDB8(B0, 0, 0) SCHED; LDA8(At, 0, 0) STAGE_A(SA8(1, 1), 1, t + 1)
      WAIT_L(8); BAR; WAIT_L(0); MMA8(0, 0, At, B0) BAR; SCHED;
      LDB8(B1, 0, 1) STAGE_B(SB8(0, 0), 0, t + 2)
      BAR; WAIT_L(0); MMA8(0, 1, At, B1) BAR;
      LDA8(At, 0, 1) STAGE_A(SA8(0, 0), 0, t + 2)
      BAR; WAIT_L(0); MMA8(1, 0, At, B0) BAR; SCHED;
      STAGE_B(SB8(0, 1), 1, t + 2)
      WAIT_V(6); BAR; MMA8(1, 1, At, B1) BAR;
      LDB8(B0, 1, 0) SCHED; LDA8(At, 1, 0) STAGE_A(SA8(0, 1), 1, t + 2)
      WAIT_L(8); BAR; WAIT_L(0); MMA8(0, 0, At, B0) BAR; SCHED;
      LDB8(B1, 1, 1) STAGE_B(SB8(1, 0), 0, t + 3)
      BAR; WAIT_L(0); MMA8(0, 1, At, B1) BAR;
      LDA8(At, 1, 1) STAGE_A(SA8(1, 0), 0, t + 3)
      BAR; WAIT_L(0); MMA8(1, 0, At, B0) BAR; SCHED;
      STAGE_B(SB8(1, 1), 1, t + 3)
      WAIT_V(6); BAR; MMA8(1, 1, At, B1) BAR;
    }
    { LDB8(B0, 0, 0) LDA8(At, 0, 0) STAGE_A(SA8(1, 1), 1, nt - 1)
      BAR; WAIT_L(0); MMA8(0, 0, At, B0) BAR;
      LDB8(B1, 0, 1) BAR; WAIT_L(0); MMA8(0, 1, At, B1) BAR;
      LDA8(At, 0, 1) WAIT_V(4); BAR; WAIT_L(0); MMA8(1, 0, At, B0) MMA8(1, 1, At, B1) BAR; }
    { LDB8(B0, 1, 0) LDA8(At, 1, 0) WAIT_V(2); BAR; WAIT_L(0); MMA8(0, 0, At, B0) BAR;
      LDB8(B1, 1, 1) WAIT_V(0); BAR; WAIT_L(0); MMA8(0, 1, At, B1) BAR;
      LDA8(At, 1, 1) BAR; WAIT_L(0); MMA8(1, 0, At, B0) MMA8(1, 1, At, B1) BAR; }
    if (wr == 0) BAR;
    { int fr2 = fr, fq2 = fq; asm volatile("" : "+v"(fr2), "+v"(fq2)); epi(acc, pm * 256, pn * 256, wr, wc, fr2, fq2); }
  }
#undef SA8
#undef SB8
#undef STAGE_A
#undef STAGE_B
#undef LDA8
#undef LDB8
#undef MMA8
#undef WAIT_V
#undef WAIT_L
#undef BAR
#undef SCHED
}
}

__device__ void ph_gla_prep(const Params& P, float* sm, int wvs) {
  float(*glr)[16] = (float(*)[16])sm;
  float(*tot)[128] = (float(*)[128])(sm + 1024);
  float(*exl)[132] = (float(*)[132])(sm + 1536);
  const int tid = otid(wvs);
  const int tq = tid >> 7, c = tid & 127;
  const int tp = tid >> 4, co = tid & 15;
  const float scale = 0.08838834764831845f;
  for (int item = blockIdx.x; item < (T_TOK / 64) * 4; item += gridDim.x) {
    const int chunk = item >> 2, h = item & 3;
    const int t0 = chunk * 64, ch = h * 128 + c;
    __syncthreads();
    for (int idx = tid; idx < 64 * 16; idx += NTHREADS) {
      const int i = idx >> 4, r = idx & 15;
      glr[i][r] = (float)P.p[(size_t)(t0 + i) * LD0 + 3072 + r];
    }
    half_t* qp = P.p + (size_t)(t0 + 2 * tp) * LD0 + h * 128 + co * 8;
    const half8 q0 = *(const half8*)(qp), k0 = *(const half8*)(qp + 512), q1 = *(const half8*)(qp + LD0), k1 = *(const half8*)(qp + LD0 + 512);
    float w[16];
#pragma unroll
    for (int r = 0; r < 16; ++r) w[r] = P.gla_w_gk_up[r * 512 + ch];
    const float bb = P.gla_b_gk[ch];
    __syncthreads();
    float pre[16]; float cum = 0.f;
#pragma unroll
    for (int i = 0; i < 16; ++i) {
      float u = bb;
#pragma unroll
      for (int r = 0; r < 16; ++r) u += glr[tq * 16 + i][r] * w[r];
      cum += logsigmoidf(u) * (1.f / 16.f);
      pre[i] = cum;
    }
    tot[tq][c] = cum;
    __syncthreads();
    float off = 0.f;
#pragma unroll
    for (int t = 0; t < 3; ++t) if (t < tq) off += tot[t][c];
#pragma unroll
    for (int i = 0; i < 16; ++i) {
      const float ex = fast_exp2((pre[i] + off) * LOG2E);
      exl[tq * 16 + i][c] = ex;
      if (tq == 3 && i == 15) P.bcum[(size_t)chunk * 512 + ch] = ex;
    }
    __syncthreads();
    {
      const f32x4 e00 = *(const f32x4*)&exl[2 * tp][co * 8], e01 = *(const f32x4*)&exl[2 * tp][co * 8 + 4];
      const f32x4 e10 = *(const f32x4*)&exl[2 * tp + 1][co * 8], e11 = *(const f32x4*)&exl[2 * tp + 1][co * 8 + 4];
      half8 oq0, ok0, oq1, ok1;
#pragma unroll
      for (int e = 0; e < 8; ++e) {
        const float x0 = e < 4 ? e00[e] : e01[e - 4], x1 = e < 4 ? e10[e] : e11[e - 4];
        oq0[e] = (half_t)((float)q0[e] * scale * x0); ok0[e] = (half_t)((float)k0[e] * __builtin_amdgcn_rcpf(x0));
        oq1[e] = (half_t)((float)q1[e] * scale * x1); ok1[e] = (half_t)((float)k1[e] * __builtin_amdgcn_rcpf(x1));
      }
      *(half8*)(qp) = oq0; *(half8*)(qp + 512) = ok0; *(half8*)(qp + LD0) = oq1; *(half8*)(qp + LD0 + 512) = ok1;
    }
  }
}

constexpr int GLA_QE = 0, GLA_KE = 16384, GLA_V = 32768, GLA_DEC = 49152, GLA_BUF = 53248;
#define GLA_TR4(d0, d1, d2, d3, addr, o0, o1, o2, o3) \
  asm volatile("ds_read_b64_tr_b16 %0, %4 offset:%5\n\tds_read_b64_tr_b16 %1, %4 offset:%6\n\tds_read_b64_tr_b16 %2, %4 offset:%7\n\tds_read_b64_tr_b16 %3, %4 offset:%8" \
               : "=&v"(d0), "=&v"(d1), "=&v"(d2), "=&v"(d3) : "v"(addr), "n"(o0), "n"(o1), "n"(o2), "n"(o3) : "memory")
__device__ __forceinline__ half8 pack_h8(const v2i a, const v2i b) { const v4i p = (v4i){a[0], a[1], b[0], b[1]}; return __builtin_bit_cast(half8, p); }

template <bool STATE_ONLY>
__device__ void ph_gla_mfma(const Params& P, char* smem, int wvs) {
  const int tid = otid(wvs);
  const int lane = tid & 63, wave = __builtin_amdgcn_readfirstlane(tid >> 6), r15 = lane & 15, q = lane >> 4;
  const int qp = r15 >> 2, pp = lane & 3;
  const int srow = tid >> 4, sslot = tid & 15;
  const int src_q = (sslot ^ (srow & 15)) * 8, src_kv = (sslot ^ ((srow & 7) << 1)) * 8;
  const int fk = ((4 * (q & 1) + qp) & 7) << 1;
  const unsigned tr_row = (unsigned)((4 * q + qp) * 256 + 8 * (pp & 1) + ((pp >> 1) << 4));
  constexpr int NLOAD = STATE_ONLY ? 5 : 7;
  for (int item = blockIdx.x; item < (STATE_ONLY ? 3 : 4) * 64; item += gridDim.x) {
    const int seg = item >> 6, base = item & 63, b = base >> 3, h = (base >> 1) & 3, vs = base & 1;
    const int c0 = seg * 16;
    f32x4 S[8], Dacc[8];
#pragma unroll
    for (int df = 0; df < 8; ++df) { S[df] = (f32x4){0.f, 0.f, 0.f, 0.f}; Dacc[df] = (f32x4){1.f, 1.f, 1.f, 1.f}; }
    f32x4* stL = (f32x4*)P.gla_state + ((size_t)base * 8 + wave) * 8 * 64 + lane;
    f32x4* stD = stL + (size_t)3 * 64 * 8 * 8 * 64;
    if (!STATE_ONLY) {
      for (int k = 0; k < seg; ++k) {
#pragma unroll
        for (int df = 0; df < 8; ++df) {
          const f32x4 Lk = stL[((size_t)k * 64 * 8 * 8 + df) * 64];
          if (k == 0) S[df] = Lk;
          else { const f32x4 Dk = stD[((size_t)k * 64 * 8 * 8 + df) * 64]; S[df] = Dk * S[df] + Lk; }
        }
      }
    }
    const half_t* qsrc = P.p + (size_t)(b * SEQ + srow) * LD0 + h * 128;
    const half_t* vsrc = P.p + (size_t)(b * SEQ + srow) * LD0 + 1024 + h * 256 + vs * 128 + src_kv;
    const float* dsrc = P.bcum + (size_t)(b * 64 + c0) * 512 + h * 128 + (lane & 31) * 4;
#define G_ISSUE(N, BUF) { char* lb_ = smem + (BUF) * GLA_BUF + wave * 1024; const size_t ro_ = (size_t)(c0 + (N)) * 64 * LD0; \
      if (!STATE_ONLY) { __builtin_amdgcn_global_load_lds((gbl_void*)(qsrc + ro_ + src_q), (lds_void*)(lb_ + GLA_QE), 16, 0, 0); \
      __builtin_amdgcn_global_load_lds((gbl_void*)(qsrc + ro_ + (size_t)32 * LD0 + src_q), (lds_void*)(lb_ + GLA_QE + 8192), 16, 0, 0); } \
      __builtin_amdgcn_global_load_lds((gbl_void*)(qsrc + ro_ + 512 + src_kv), (lds_void*)(lb_ + GLA_KE), 16, 0, 0); \
      __builtin_amdgcn_global_load_lds((gbl_void*)(qsrc + ro_ + (size_t)32 * LD0 + 512 + src_kv), (lds_void*)(lb_ + GLA_KE + 8192), 16, 0, 0); \
      __builtin_amdgcn_global_load_lds((gbl_void*)(vsrc + ro_), (lds_void*)(lb_ + GLA_V), 16, 0, 0); \
      __builtin_amdgcn_global_load_lds((gbl_void*)(vsrc + ro_ + (size_t)32 * LD0), (lds_void*)(lb_ + GLA_V + 8192), 16, 0, 0); \
      if (lane < 32) __builtin_amdgcn_global_load_lds((gbl_void*)(dsrc + (size_t)(N) * 512), (lds_void*)(smem + (BUF) * GLA_BUF + GLA_DEC + wave * 512), 16, 0, 0); }
    G_ISSUE(0, 0)
    G_ISSUE(1, 1)
#pragma unroll 1
    for (int n = 0; n < 16; ++n) {
      if (n + 1 < 16) wait_vmcnt<NLOAD>(); else wait_vmcnt<0>();
      __builtin_amdgcn_s_barrier();
      if (n + 2 < 16) G_ISSUE(n + 2, (n + 2) % 3)
      const char* cb = smem + (n % 3) * GLA_BUF;
      f32x4 aT[4][4];
      if (!STATE_ONLY) {
#pragma unroll
      for (int kf = 0; kf < 4; ++kf)
#pragma unroll
        for (int tf = 0; tf < 4; ++tf) aT[kf][tf] = (f32x4){0.f, 0.f, 0.f, 0.f};
#pragma unroll
      for (int ks = 0; ks < 4; ++ks) {
        half8 kef[4], qef[4];
#pragma unroll
        for (int f = 0; f < 4; ++f) {
          kef[f] = *(const half8*)(cb + GLA_KE + (16 * f + r15) * 256 + (((4 * ks + q) ^ ((r15 & 7) << 1)) << 4));
          qef[f] = *(const half8*)(cb + GLA_QE + (16 * f + r15) * 256 + (((4 * ks + q) ^ r15) << 4));
        }
#pragma unroll
        for (int kf = 0; kf < 4; ++kf)
#pragma unroll
          for (int tf = kf; tf < 4; ++tf) aT[kf][tf] = __builtin_amdgcn_mfma_f32_16x16x32_f16(kef[kf], qef[tf], aT[kf][tf], 0, 0, 0);
      }
#pragma unroll
      for (int f = 0; f < 4; ++f)
#pragma unroll
        for (int r = 0; r < 4; ++r) if (4 * q + r > r15) aT[f][f][r] = 0.f;
      }
      const unsigned lds0 = (unsigned)(size_t)cb;
      const unsigned va = lds0 + GLA_V + tr_row + ((((2 * wave) ^ fk)) << 4);
      v2i v00, v01, v10, v11;
      GLA_TR4(v00, v01, v10, v11, va, 0, 4096, 8192, 12288);
      const unsigned ka = lds0 + GLA_KE + tr_row;
      v2i k0[4][4];
#pragma unroll
      for (int df = 0; df < 4; ++df) { const unsigned a_ = ka + ((((2 * df) ^ fk)) << 4); GLA_TR4(k0[df][0], k0[df][1], k0[df][2], k0[df][3], a_, 0, 4096, 8192, 12288); }
      asm volatile("s_waitcnt lgkmcnt(15)" : "+v"(v00), "+v"(v01), "+v"(v10), "+v"(v11) :: "memory");
      __builtin_amdgcn_sched_barrier(0);
      half8 vf[2];
      vf[0] = pack_h8(v00, v01); vf[1] = pack_h8(v10, v11);
      if (!STATE_ONLY) {
      f32x4 o[4];
#pragma unroll
      for (int tf = 0; tf < 4; ++tf) o[tf] = (f32x4){0.f, 0.f, 0.f, 0.f};
#pragma unroll
      for (int ks2 = 0; ks2 < 2; ++ks2)
#pragma unroll
        for (int tf = 2 * ks2; tf < 4; ++tf) {
          half8 pk;
#pragma unroll
          for (int r = 0; r < 4; ++r) { pk[r] = (half_t)aT[2 * ks2][tf][r]; pk[4 + r] = (half_t)aT[2 * ks2 + 1][tf][r]; }
          o[tf] = __builtin_amdgcn_mfma_f32_16x16x32_f16(vf[ks2], pk, o[tf], 0, 0, 0);
        }
#pragma unroll
      for (int ks = 0; ks < 4; ++ks) {
        half8 sf;
#pragma unroll
        for (int r = 0; r < 4; ++r) { sf[r] = (half_t)S[2 * ks][r]; sf[4 + r] = (half_t)S[2 * ks + 1][r]; }
#pragma unroll
        for (int tf = 0; tf < 4; ++tf) {
          const int row = 16 * tf + r15;
          const half4 qa = *(const half4*)(cb + GLA_QE + row * 256 + (((4 * ks + (q >> 1)) ^ r15) << 4) + (q & 1) * 8);
          const half4 qb = *(const half4*)(cb + GLA_QE + row * 256 + (((4 * ks + 2 + (q >> 1)) ^ r15) << 4) + (q & 1) * 8);
          half8 qv;
#pragma unroll
          for (int e = 0; e < 4; ++e) { qv[e] = qa[e]; qv[4 + e] = qb[e]; }
          o[tf] = __builtin_amdgcn_mfma_f32_16x16x32_f16(sf, qv, o[tf], 0, 0, 0);
        }
      }
      {
        const size_t t0 = (size_t)(b * SEQ + (c0 + n) * 64);
#pragma unroll
        for (int tf = 0; tf < 4; ++tf) {
          half4 hv; hv[0] = (half_t)o[tf][0]; hv[1] = (half_t)o[tf][1]; hv[2] = (half_t)o[tf][2]; hv[3] = (half_t)o[tf][3];
          *(half4*)(P.og + (t0 + 16 * tf + r15) * DM + h * 256 + vs * 128 + 16 * wave + 4 * q) = hv;
        }
      }
      }
      v2i k1[4][4];
#pragma unroll
      for (int df = 0; df < 4; ++df) { const unsigned a_ = ka + ((((2 * (df + 4)) ^ fk)) << 4); GLA_TR4(k1[df][0], k1[df][1], k1[df][2], k1[df][3], a_, 0, 4096, 8192, 12288); }
      asm volatile("s_waitcnt lgkmcnt(15)"
                   : "+v"(k0[0][0]), "+v"(k0[0][1]), "+v"(k0[0][2]), "+v"(k0[0][3]), "+v"(k0[1][0]), "+v"(k0[1][1]), "+v"(k0[1][2]), "+v"(k0[1][3]),
                     "+v"(k0[2][0]), "+v"(k0[2][1]), "+v"(k0[2][2]), "+v"(k0[2][3]), "+v"(k0[3][0]), "+v"(k0[3][1]), "+v"(k0[3][2]), "+v"(k0[3][3]) :: "memory");
      __builtin_amdgcn_sched_barrier(0);
#pragma unroll
      for (int df = 0; df < 4; ++df) {
        S[df] = __builtin_amdgcn_mfma_f32_16x16x32_f16(pack_h8(k0[df][0], k0[df][1]), vf[0], S[df], 0, 0, 0);
        S[df] = __builtin_amdgcn_mfma_f32_16x16x32_f16(pack_h8(k0[df][2], k0[df][3]), vf[1], S[df], 0, 0, 0);
      }
      asm volatile("s_waitcnt lgkmcnt(0)"
                   : "+v"(k1[0][0]), "+v"(k1[0][1]), "+v"(k1[0][2]), "+v"(k1[0][3]), "+v"(k1[1][0]), "+v"(k1[1][1]), "+v"(k1[1][2]), "+v"(k1[1][3]),
                     "+v"(k1[2][0]), "+v"(k1[2][1]), "+v"(k1[2][2]), "+v"(k1[2][3]), "+v"(k1[3][0]), "+v"(k1[3][1]), "+v"(k1[3][2]), "+v"(k1[3][3]) :: "memory");
      __builtin_amdgcn_sched_barrier(0);
#pragma unroll
      for (int df = 0; df < 4; ++df) {
        S[df + 4] = __builtin_amdgcn_mfma_f32_16x16x32_f16(pack_h8(k1[df][0], k1[df][1]), vf[0], S[df + 4], 0, 0, 0);
        S[df + 4] = __builtin_amdgcn_mfma_f32_16x16x32_f16(pack_h8(k1[df][2], k1[df][3]), vf[1], S[df + 4], 0, 0, 0);
      }
#pragma unroll
      for (int df = 0; df < 8; ++df) {
        const f32x4 dc = *(const f32x4*)(cb + GLA_DEC + wave * 512 + (16 * df + 4 * q) * 4);
        S[df] *= dc;
        if (STATE_ONLY) Dacc[df] *= dc;
      }
    }
    if (STATE_ONLY) {
#pragma unroll
      for (int df = 0; df < 8; ++df) { stL[((size_t)seg * 64 * 8 * 8 + df) * 64] = S[df]; stD[((size_t)seg * 64 * 8 * 8 + df) * 64] = Dacc[df]; }
    }
    asm volatile("s_waitcnt vmcnt(0)" ::: "memory");
    __builtin_amdgcn_s_barrier();
#undef G_ISSUE
  }
}

__device__ void ph_gla_post(const Params& P, int wvs) {
  const int tid_ = otid(wvs); const int lane = tid_ & 63, sub = lane & 31;
  const int u0 = blockIdx.x * 16 + (tid_ >> 5);
  const float4 hn0 = ((const float4*)P.gla_head_norm)[sub * 2], hn1 = ((const float4*)P.gla_head_norm)[sub * 2 + 1];
#pragma unroll 2
  for (int u = u0; u < T_TOK * 4; u += gridDim.x * 16) {
    const int t = u >> 2, h = u & 3;
    half8* op = (half8*)(P.og + (size_t)t * DM + h * 256) + sub;
    const half8 hv = *op;
    const half8 z = *((const half8*)(P.p + (size_t)t * LD0 + 2048 + h * 256) + sub);
    float v[8]; float ss = 0.f;
#pragma unroll
    for (int e = 0; e < 8; ++e) { v[e] = (float)hv[e]; ss += v[e] * v[e]; }
#pragma unroll
    for (int o = 16; o > 0; o >>= 1) ss += __shfl_xor(ss, o);
    const float r = rsqrtf(ss * (1.f / 256.f) + EPS);
    const float hn[8] = {hn0.x, hn0.y, hn0.z, hn0.w, hn1.x, hn1.y, hn1.z, hn1.w};
    half8 o;
#pragma unroll
    for (int e = 0; e < 8; ++e) o[e] = (half_t)(v[e] * r * hn[e] * siluf((float)z[e]));
    *op = o;
  }
}

__device__ void ph_post(const float* base, const half_t* y, const float* g, float* dst, half_t* dsth, float* rstd_out, int wvs) {
  const int tid_ = otid(wvs); const int lane = tid_ & 63, w = tid_ >> 6;
#pragma unroll 2
  for (int row = blockIdx.x * NWAVES + w; row < T_TOK; row += gridDim.x * NWAVES) {
    const half4* yr = (const half4*)(y + (size_t)row * DM);
    const float4* br = (const float4*)(base + (size_t)row * DM);
    float4* dr = (float4*)(dst + (size_t)row * DM);
    float4 v[4]; float ss = 0.f;
#pragma unroll
    for (int i = 0; i < 4; ++i) {
      const half4 hv = yr[lane + 64 * i];
      v[i].x = (float)hv[0]; v[i].y = (float)hv[1]; v[i].z = (float)hv[2]; v[i].w = (float)hv[3];
      ss += v[i].x * v[i].x + v[i].y * v[i].y + v[i].z * v[i].z + v[i].w * v[i].w;
    }
    ss = wave_sum(ss);
    const float r = rsqrtf(ss * (1.f / DM) + EPS);
    float s2 = 0.f;
#pragma unroll
    for (int i = 0; i < 4; ++i) {
      const float4 gg = ((const float4*)g)[lane + 64 * i];
      const float4 bb = br[lane + 64 * i];
      float4 o;
      o.x = bb.x + v[i].x * r * gg.x; o.y = bb.y + v[i].y * r * gg.y; o.z = bb.z + v[i].z * r * gg.z; o.w = bb.w + v[i].w * r * gg.w;
      s2 += o.x * o.x + o.y * o.y + o.z * o.z + o.w * o.w;
      dr[lane + 64 * i] = o;
      if (dsth) {
        half4 hv; hv[0] = (half_t)o.x; hv[1] = (half_t)o.y; hv[2] = (half_t)o.z; hv[3] = (half_t)o.w;
        ((half4*)(dsth + (size_t)row * DM))[lane + 64 * i] = hv;
      }
    }
    if (rstd_out) { s2 = wave_sum(s2); if (lane == 0) rstd_out[row] = rsqrtf(s2 * (1.f / DM) + EPS); }
  }
}

__device__ void ph_gates(const Params& P, char* smem, int wvs, int first_block) {
  const int tid = otid(wvs), lane = tid & 63, wave = tid >> 6, r15 = lane & 15, q = lane >> 4;
  const int nb = gridDim.x - first_block;
  if ((int)blockIdx.x < first_block) return;
  for (int c = tid; c < 48 * 128; c += NTHREADS) {
    const int row = c >> 7, ch = c & 127;
    *(uint4*)(smem + row * 2064 + ch * 16) = *(const uint4*)(P.WglT + (size_t)row * DM + ch * 8);
  }
  __syncthreads();
  for (int tile = (int)blockIdx.x - first_block; tile < T_TOK / 128; tile += nb) {
    const int tok = tile * 128 + wave * 16 + r15;
    const half_t* ap = P.xh + (size_t)tok * DM + 8 * q;
    const char* bp = smem + r15 * 2064 + 16 * q;
    f32x4 acc[3] = {(f32x4){0.f, 0.f, 0.f, 0.f}, (f32x4){0.f, 0.f, 0.f, 0.f}, (f32x4){0.f, 0.f, 0.f, 0.f}};
#pragma unroll 1
    for (int s0 = 0; s0 < 32; s0 += 16) {
      half8 a[16];
#pragma unroll
      for (int i = 0; i < 16; ++i) a[i] = *(const half8*)(ap + 32 * (s0 + i));
#pragma unroll
      for (int i = 0; i < 16; ++i) {
#pragma unroll
        for (int n = 0; n < 3; ++n) {
          const half8 bw = *(const half8*)(bp + n * 16 * 2064 + (s0 + i) * 64);
          acc[n] = __builtin_amdgcn_mfma_f32_16x16x32_f16(bw, a[i], acc[n], 0, 0, 0);
        }
      }
    }
    const float rs = P.rstd[tok];
#pragma unroll
    for (int n = 0; n < 3; ++n) *(f32x4*)(P.gl + (size_t)tok * 48 + 16 * n + 4 * q) = acc[n] * rs;
  }
  __syncthreads();
}

__device__ void ph_kmax(const Params& P, int wvs) {
  const int tid = otid(wvs);
  for (int task = blockIdx.x; task < NBATCH * 4 * 2 * 8; task += gridDim.x) {
    const int chunk = task & 7, br = (task >> 3) & 1, bg = task >> 4, b = bg >> 2, g = bg & 3;
    const half_t* kp = P.p + (size_t)(b * SEQ + chunk * 512 + tid) * LD1 + (br ? 2048 : 1536) + g * 64;
    float ss = 0.f;
#pragma unroll
    for (int c = 0; c < 8; ++c) {
      const half8 v = *(const half8*)(kp + c * 8);
#pragma unroll
      for (int e = 0; e < 8; ++e) ss += (float)v[e] * (float)v[e];
    }
    ss = wave_max(ss);
    if ((tid & 63) == 0) __hip_atomic_fetch_max(&P.kmax2[bg * 2 + br], __float_as_uint(ss), __ATOMIC_RELAXED, __HIP_MEMORY_SCOPE_AGENT);
  }
}

constexpr int ATT_NB = 6, ATT_D = 5;
constexpr int ATT_K = 0, ATT_V = ATT_NB * 8192, ATT_IMP = 2 * ATT_NB * 8192, ATT_SELM = ATT_IMP + 64 * 68 * 4;
constexpr int IMPS = 68;
constexpr int ATT_GATE = ATT_SELM + 512;

template <int MODE>
__device__ __forceinline__ void attn_branch(char* smem, const half_t* kbase, const half_t* vbase, int ld, int tile_lo, int tile_hi, int n, int th,
                                            const half8 (&qf)[2][2], float (&m)[2], float (&l)[2], f32x4 (&o)[4][2],
                                            const unsigned long long (&selm)[2], int wvs) {
  const int tid = otid(wvs);
  const int lane = tid & 63, r15 = lane & 15, q = lane >> 4;
  const int lrow = tid >> 3, lch = tid & 7;
  const int k_rd = r15 * 128, kswz = r15 >> 1;
  const int qp = r15 >> 2, pp = lane & 3;
  const int fx = ((2 * q + (qp >> 1)) & 3) << 1;
  const int v_rd = (4 * q + qp) * 128 + 8 * (pp & 1) + ((pp >> 1) << 4);
  unsigned int* impu = (unsigned int*)(smem + ATT_IMP);
  const int ksrc = (lch ^ ((lrow >> 1) & 7)) * 8, vsrc = (lch ^ (((lrow >> 1) & 3) << 1)) * 8;
  const int wbase = __builtin_amdgcn_readfirstlane(tid >> 6) * 1024;
#define A_GLOAD(TI, BUF) { const half_t* kp_ = kbase + (size_t)((TI) * 64 + lrow) * ld + ksrc; \
    __builtin_amdgcn_global_load_lds((gbl_void*)kp_, (lds_void*)(smem + ATT_K + (BUF) * 8192 + wbase), 16, 0, 0); \
    if (MODE != 0) { const half_t* vp_ = vbase + (size_t)((TI) * 64 + lrow) * ld + vsrc; \
      __builtin_amdgcn_global_load_lds((gbl_void*)vp_, (lds_void*)(smem + ATT_V + (BUF) * 8192 + wbase), 16, 0, 0); } }
  constexpr int GPT = (MODE == 0) ? 1 : 2;
  f32x4 lacc[2] = {(f32x4){0.f, 0.f, 0.f, 0.f}, (f32x4){0.f, 0.f, 0.f, 0.f}};
#pragma unroll
  for (int i = 0; i < ATT_D; ++i) if (tile_lo + i <= tile_hi) A_GLOAD(tile_lo + i, i)
#pragma unroll 1
  for (int ti = tile_lo; ti <= tile_hi; ++ti) {
    const int it = ti - tile_lo, cur = it % ATT_NB;
    {
      const int rem = tile_hi - ti;
      if (rem >= 4) wait_vmcnt<4 * GPT>(); else if (rem == 3) wait_vmcnt<3 * GPT>(); else if (rem == 2) wait_vmcnt<2 * GPT>();
      else if (rem == 1) wait_vmcnt<1 * GPT>(); else wait_vmcnt<0>();
    }
    __builtin_amdgcn_s_barrier();
    if (ti + ATT_D <= tile_hi) A_GLOAD(ti + ATT_D, (it + ATT_D) % ATT_NB)
    const char* kb = smem + ATT_K + cur * 8192 + k_rd;
    const unsigned vbl = (unsigned)(size_t)(smem + ATT_V + cur * 8192 + v_rd);
    bool need_mask;
    if (MODE <= 1) need_mask = (ti * 64 + 63 > 4 * n - 2);
    else if (MODE == 2) need_mask = (ti == n);
    else need_mask = (ti == n) || (ti == n - 8);
    f32x4 s[4][2];
#pragma unroll
    for (int t2 = 0; t2 < 2; ++t2) {
      float c0 = 0.f;
      if (MODE >= 2) { c0 = -m[t2]; if (MODE == 2 && !((selm[t2] >> ti) & 1ull)) c0 = -INFINITY; }
#pragma unroll
      for (int kf = 0; kf < 4; ++kf) s[kf][t2] = (f32x4){c0, c0, c0, c0};
    }
#pragma unroll
    for (int ks = 0; ks < 2; ++ks) {
      const int co = ((4 * ks + q) ^ kswz) << 4;
#pragma unroll
      for (int kf = 0; kf < 4; ++kf) {
        const half8 kfr = *(const half8*)(kb + kf * 2048 + co);
#pragma unroll
        for (int t2 = 0; t2 < 2; ++t2) s[kf][t2] = __builtin_amdgcn_mfma_f32_16x16x32_f16(kfr, qf[t2][ks], s[kf][t2], 0, 0, 0);
      }
    }
    v2i vr[4][4];
    if (MODE != 0) {
      const unsigned va0 = vbl + (((0) ^ fx) << 4), va1 = vbl + (((2) ^ fx) << 4), va2 = vbl + (((4) ^ fx) << 4), va3 = vbl + (((6) ^ fx) << 4);
      asm volatile(
          "ds_read_b64_tr_b16 %0, %16\n\tds_read_b64_tr_b16 %1, %16 offset:2048\n\tds_read_b64_tr_b16 %2, %16 offset:4096\n\tds_read_b64_tr_b16 %3, %16 offset:6144\n\t"
          "ds_read_b64_tr_b16 %4, %17\n\tds_read_b64_tr_b16 %5, %17 offset:2048\n\tds_read_b64_tr_b16 %6, %17 offset:4096\n\tds_read_b64_tr_b16 %7, %17 offset:6144\n\t"
          "ds_read_b64_tr_b16 %8, %18\n\tds_read_b64_tr_b16 %9, %18 offset:2048\n\tds_read_b64_tr_b16 %10, %18 offset:4096\n\tds_read_b64_tr_b16 %11, %18 offset:6144\n\t"
          "ds_read_b64_tr_b16 %12, %19\n\tds_read_b64_tr_b16 %13, %19 offset:2048\n\tds_read_b64_tr_b16 %14, %19 offset:4096\n\tds_read_b64_tr_b16 %15, %19 offset:6144"
          : "=&v"(vr[0][0]), "=&v"(vr[0][1]), "=&v"(vr[0][2]), "=&v"(vr[0][3]), "=&v"(vr[1][0]), "=&v"(vr[1][1]), "=&v"(vr[1][2]), "=&v"(vr[1][3]),
            "=&v"(vr[2][0]), "=&v"(vr[2][1]), "=&v"(vr[2][2]), "=&v"(vr[2][3]), "=&v"(vr[3][0]), "=&v"(vr[3][1]), "=&v"(vr[3][2]), "=&v"(vr[3][3])
          : "v"(va0), "v"(va1), "v"(va2), "v"(va3)
          : "memory");
    }
    if (need_mask) {
#pragma unroll
      for (int t2 = 0; t2 < 2; ++t2) {
        const int tok = th * 32 + t2 * 16 + r15;
        int lo = 0, hi = 63;
        if (MODE <= 1) { hi = 4 * n + ((tok - 31) >> 4) - ti * 64; }
        else if (MODE == 2) { hi = tok; }
        else { if (ti == n) hi = tok; else lo = tok + 1; }
#pragma unroll
        for (int kf = 0; kf < 4; ++kf)
#pragma unroll
          for (int r = 0; r < 4; ++r) {
            const int kk = kf * 16 + 4 * q + r;
            if (kk < lo || kk > hi) s[kf][t2][r] = -INFINITY;
          }
      }
    }
    half8 pf[2][2];
#pragma unroll
    for (int t2 = 0; t2 < 2; ++t2) {
      float mb = 0.f, scale_p = 1.f;
      if (MODE == 1) {
        mb = m[t2]; scale_p = l[t2];
      } else if (MODE == 0) {
        float tm = s[0][t2][0];
#pragma unroll
        for (int kf = 0; kf < 4; ++kf)
#pragma unroll
          for (int r = 0; r < 4; ++r) tm = fmaxf(tm, s[kf][t2][r]);
        tm = rowmax4(tm);
        const float mn = fmaxf(m[t2], tm);
        const float alpha = fexp2(m[t2] - mn);
        m[t2] = mn; mb = mn;
        l[t2] *= alpha;
      }
      float lsum = 0.f;
#pragma unroll
      for (int kf = 0; kf < 4; ++kf) {
#pragma unroll
        for (int r = 0; r < 4; ++r) {
          float pv = (MODE >= 2) ? fexp2(s[kf][t2][r]) : fexp2(s[kf][t2][r] - mb);
          if (MODE == 1) pv *= scale_p;
          s[kf][t2][r] = pv; if (MODE == 0) lsum += pv;
        }
      }
      if (MODE == 0) l[t2] += lsum;
      if (MODE == 1) {
        const int tok = th * 32 + t2 * 16 + r15;
#pragma unroll
        for (int kf = 0; kf < 4; ++kf) {
          const int j = 16 * ti + 4 * kf + q;
          const unsigned int u0 = (unsigned int)(s[kf][t2][0] * 134217728.f + 0.5f), u1 = (unsigned int)(s[kf][t2][1] * 134217728.f + 0.5f);
          const unsigned int u2 = (unsigned int)(s[kf][t2][2] * 134217728.f + 0.5f), u3 = (unsigned int)(s[kf][t2][3] * 134217728.f + 0.5f);
          if (j < 64) {
            atomicAdd(&impu[tok * IMPS + j], u0 + u1 + u2 + u3);
            atomicAdd(&impu[tok * IMPS + j + 1], u3);
          }
        }
      }
      if (MODE != 0) {
#pragma unroll
        for (int ks = 0; ks < 2; ++ks) {
          half8 pk;
#pragma unroll
          for (int r = 0; r < 4; ++r) { pk[r] = (half_t)s[2 * ks][t2][r]; pk[4 + r] = (half_t)s[2 * ks + 1][t2][r]; }
          pf[t2][ks] = pk;
        }
      }
    }
    if (MODE != 0) {
      asm volatile("s_waitcnt lgkmcnt(0)"
                   : "+v"(vr[0][0]), "+v"(vr[0][1]), "+v"(vr[0][2]), "+v"(vr[0][3]), "+v"(vr[1][0]), "+v"(vr[1][1]), "+v"(vr[1][2]), "+v"(vr[1][3]),
                     "+v"(vr[2][0]), "+v"(vr[2][1]), "+v"(vr[2][2]), "+v"(vr[2][3]), "+v"(vr[3][0]), "+v"(vr[3][1]), "+v"(vr[3][2]), "+v"(vr[3][3])
                   :: "memory");
      __builtin_amdgcn_sched_barrier(0);
#pragma unroll
      for (int df = 0; df < 4; ++df) {
#pragma unroll
        for (int ks = 0; ks < 2; ++ks) {
          const v2i lo2 = vr[df][2 * ks], hi2 = vr[df][2 * ks + 1];
          const v4i pk4 = (v4i){lo2[0], lo2[1], hi2[0], hi2[1]};
          const half8 vf = __builtin_bit_cast(half8, pk4);
#pragma unroll
          for (int t2 = 0; t2 < 2; ++t2) o[df][t2] = __builtin_amdgcn_mfma_f32_16x16x32_f16(vf, pf[t2][ks], o[df][t2], 0, 0, 0);
        }
      }
      if (MODE >= 2) {
        const half8 ones = (half8){(half_t)1.f, (half_t)1.f, (half_t)1.f, (half_t)1.f, (half_t)1.f, (half_t)1.f, (half_t)1.f, (half_t)1.f};
#pragma unroll
        for (int ks = 0; ks < 2; ++ks)
#pragma unroll
          for (int t2 = 0; t2 < 2; ++t2) lacc[t2] = __builtin_amdgcn_mfma_f32_16x16x32_f16(ones, pf[t2][ks], lacc[t2], 0, 0, 0);
      }
    }
  }
  if (MODE >= 2) { l[0] = lacc[0][0]; l[1] = lacc[1][0]; }
  __syncthreads();
#undef A_GLOAD
}

__device__ void ph_attn_mfma(const Params& P, char* smem, int wvs) {
  unsigned int* impu = (unsigned int*)(smem + ATT_IMP);
  unsigned long long* selmask = (unsigned long long*)(smem + ATT_SELM);
  const int G = gridDim.x, nrounds = (2048 + G - 1) / G;
  for (int rd = 0; rd < nrounds; ++rd) {
    const int idx = rd * G + ((rd & 1) ? (G - 1 - (int)blockIdx.x) : (int)blockIdx.x);
    if (idx >= 2048) continue;
    const int tid = otid(wvs), lane = tid & 63, r15 = lane & 15, q = lane >> 4;
    const int n = 63 - (idx >> 5), bg = idx & 31, b = bg >> 2, g = bg & 3;
    const int wv = __builtin_amdgcn_readfirstlane(otid(wvs) >> 6);
    const int hd = g * 4 + (wv & 3), th = wv >> 2;
    const int t0 = b * SEQ + n * 64 + th * 32;
    half8 qf[2][2];
#pragma unroll
    for (int t2 = 0; t2 < 2; ++t2)
#pragma unroll
      for (int ks = 0; ks < 2; ++ks) qf[t2][ks] = *(const half8*)(P.p + (size_t)(t0 + t2 * 16 + r15) * LD1 + hd * 64 + 32 * ks + 8 * q);
    float* gate_l = (float*)(smem + ATT_GATE) + wv * 128;
    if (q == 0) {
#pragma unroll
      for (int t2 = 0; t2 < 2; ++t2) {
        const float* pr = P.gl + (size_t)(t0 + t2 * 16 + r15) * 48 + hd * 3;
        f32x4 gv;
#pragma unroll
        for (int c = 0; c < 3; ++c) gv[c] = sigmoidf(pr[c] + P.nsa_b_gate[hd * 3 + c]);
        gv[3] = 0.f;
        *(f32x4*)(gate_l + (t2 * 16 + r15) * 4) = gv;
      }
    }
    { const int tz = otid(wvs); for (int i = tz; i < 64 * IMPS + 128; i += NTHREADS) impu[i] = 0u; }
    float m[2], l[2]; f32x4 o[4][2]; unsigned long long selm[2] = {0ull, 0ull};
#pragma unroll
    for (int t2 = 0; t2 < 2; ++t2) { m[t2] = -1e30f; l[t2] = 0.f; }
#pragma unroll
    for (int df = 0; df < 4; ++df)
#pragma unroll
      for (int t2 = 0; t2 < 2; ++t2) o[df][t2] = (f32x4){0.f, 0.f, 0.f, 0.f};
    const half_t* kc = P.kcmp + (size_t)bg * 256 * 64;
    const half_t* vc = P.vcmp + (size_t)bg * 256 * 64;
    const int nct = (4 * n + 2) / 64;
    attn_branch<0>(smem, kc, vc, 64, 0, nct, n, th, qf, m, l, o, selm, wvs);
#pragma unroll
    for (int t2 = 0; t2 < 2; ++t2) {
      float lt = l[t2];
      lt = rowsum4(lt);
      l[t2] = lt > 0.f ? 1.f / lt : 0.f;
    }
    attn_branch<1>(smem, kc, vc, 64, 0, nct, n, th, qf, m, l, o, selm, wvs);
    f32x4 oacc[4][2];
#pragma unroll
    for (int t2 = 0; t2 < 2; ++t2) {
      const float gc = gate_l[(t2 * 16 + r15) * 4 + 0];
#pragma unroll
      for (int df = 0; df < 4; ++df) oacc[df][t2] = o[df][t2] * gc;
    }
    {
      const int tid2 = otid(wvs);
      const int tok = tid2 >> 3, part = tid2 & 7;
      unsigned long long msk;
      if (n + 1 <= 16) {
        msk = (1ull << (n + 1)) - 1ull;
      } else {
        const uint4* rowp = (const uint4*)(impu + tok * IMPS);
        unsigned own[8];
        { const uint4 a = rowp[part * 2], b2 = rowp[part * 2 + 1];
          own[0] = a.x; own[1] = a.y; own[2] = a.z; own[3] = a.w; own[4] = b2.x; own[5] = b2.y; own[6] = b2.z; own[7] = b2.w; }
        int rank[8];
#pragma unroll
        for (int jj = 0; jj < 8; ++jj) {
          const int j = part * 8 + jj;
          own[jj] = (j >= 1 && j <= n - 2) ? ((own[jj] & ~63u) | (unsigned)(63 - j)) : 0xffffffffu;
          rank[jj] = 0;
        }
#pragma unroll 2
        for (int c4 = 0; c4 < 16; ++c4) {
          const uint4 v = rowp[c4];
          unsigned kv[4] = {v.x, v.y, v.z, v.w};
#pragma unroll
          for (int e = 0; e < 4; ++e) {
            const int j2 = c4 * 4 + e;
            const unsigned key2 = (j2 >= 1 && j2 <= n - 2) ? ((kv[e] & ~63u) | (unsigned)(63 - j2)) : 0u;
#pragma unroll
            for (int jj = 0; jj < 8; ++jj) rank[jj] += (key2 > own[jj]) ? 1 : 0;
          }
        }
        unsigned int bits = 0;
#pragma unroll
        for (int jj = 0; jj < 8; ++jj) if (rank[jj] < 13 && own[jj] != 0xffffffffu) bits |= 1u << jj;
        unsigned* sel32 = (unsigned*)selmask;
        if (bits) atomicOr(&sel32[tok * 2 + (part >> 2)], bits << (8 * (part & 3)));
        msk = 1ull | (1ull << n) | (1ull << (n - 1));
        if (part == 0) { atomicOr(&sel32[tok * 2], (unsigned)msk); atomicOr(&sel32[tok * 2 + 1], (unsigned)(msk >> 32)); }
      }
      if (n + 1 <= 16 && part == 0) selmask[tok] = msk;
    }
    __syncthreads();
#pragma unroll
    for (int t2 = 0; t2 < 2; ++t2) selm[t2] = selmask[th * 32 + t2 * 16 + r15];
    float qn2[2];
#pragma unroll
    for (int t2 = 0; t2 < 2; ++t2) {
      float a = 0.f;
#pragma unroll
      for (int ks = 0; ks < 2; ++ks)
#pragma unroll
        for (int e = 0; e < 8; ++e) a += (float)qf[t2][ks][e] * (float)qf[t2][ks][e];
      qn2[t2] = rowsum4(a);
    }
    { const float km = __uint_as_float(P.kmax2[bg * 2 + 0]);
#pragma unroll
      for (int t2 = 0; t2 < 2; ++t2) { m[t2] = sqrtf(qn2[t2] * km) * 1.001f - 5.0f * LOG2E; l[t2] = 0.f; } }
#pragma unroll
    for (int df = 0; df < 4; ++df)
#pragma unroll
      for (int t2 = 0; t2 < 2; ++t2) o[df][t2] = (f32x4){0.f, 0.f, 0.f, 0.f};
    attn_branch<2>(smem, P.p + (size_t)b * SEQ * LD1 + 1536 + g * 64, P.p + (size_t)b * SEQ * LD1 + 1792 + g * 64, LD1, 0, n, n, th, qf, m, l, o, selm, wvs);
#pragma unroll
    for (int t2 = 0; t2 < 2; ++t2) {
      const float gs = gate_l[(t2 * 16 + r15) * 4 + 1] / l[t2];
#pragma unroll
      for (int df = 0; df < 4; ++df) oacc[df][t2] += o[df][t2] * gs;
    }
    { const float km = __uint_as_float(P.kmax2[bg * 2 + 1]);
#pragma unroll
      for (int t2 = 0; t2 < 2; ++t2) { m[t2] = sqrtf(qn2[t2] * km) * 1.001f - 5.0f * LOG2E; l[t2] = 0.f; } }
#pragma unroll
    for (int df = 0; df < 4; ++df)
#pragma unroll
      for (int t2 = 0; t2 < 2; ++t2) o[df][t2] = (f32x4){0.f, 0.f, 0.f, 0.f};
    attn_branch<3>(smem, P.p + (size_t)b * SEQ * LD1 + 2048 + g * 64, P.p + (size_t)b * SEQ * LD1 + 2304 + g * 64, LD1, (n > 8 ? n - 8 : 0), n, n, th, qf, m, l, o, selm, wvs);
    {
      int tbase = t0 + r15; asm volatile("" : "+v"(tbase));
#pragma unroll
      for (int t2 = 0; t2 < 2; ++t2) {
        const size_t tok = (size_t)(tbase + t2 * 16);
        const float gw = gate_l[(t2 * 16 + r15) * 4 + 2] / l[t2];
#pragma unroll
        for (int df = 0; df < 4; ++df) {
          const f32x4 v = oacc[df][t2] + o[df][t2] * gw;
          const half4 z = *(const half4*)(P.p + tok * LD1 + 2560 + hd * 64 + df * 16 + 4 * q);
          half4 hv;
#pragma unroll
          for (int e = 0; e < 4; ++e) hv[e] = (half_t)(v[e] * siluf((float)z[e]));
          *(half4*)(P.og + tok * DM + hd * 64 + df * 16 + 4 * q) = hv;
        }
      }
    }
  }
}

constexpr int NPHASES = 13;
__device__ __forceinline__ void run_phase(int ph, const Params& P, char* smem, int wvs) {
  float* sm = (float*)smem;
  switch (ph) {
    case 0:
      if (blockIdx.x == 0 && otid(wvs) < 64) P.kmax2[otid(wvs)] = 0u;
      ph_xh_rstd(P.x, P.xh, P.rstd, wvs); ph_ropetab(P, wvs); prep_cbias_part(P, wvs);
      prep_wT4(P.gla_w_in, GLA_IN, P.pre_norm, P.W0t, LD0, DM, 0, sm, wvs);
      prep_wT4(P.gla_w_out, DM, nullptr, P.Wo0t, DM, DM, 2, sm, wvs);
      prep_wT4(P.nsa_w_in, NSA_IN, P.pre_norm + DM, P.W1t, LD1, DM, 1, sm, wvs);
      prep_wT4(P.nsa_w_out, DM, nullptr, P.Wo1t, DM, DM, 2, sm, wvs);
      prep_wT(P.nsa_w_in, NSA_IN, P.pre_norm + DM, P.WglT, 64, DM, 5, sm, wvs);
      prep_wT4(P.ck_w1, 256, nullptr, P.cw1t, 256, 2048, 2, sm, wvs);
      prep_wT4(P.cv_w1, 256, nullptr, P.cw1t + 256 * 2048, 256, 2048, 2, sm, wvs);
      prep_wT4(P.ck_w2, 64, nullptr, P.cw2t, 256, 256, 4, sm, wvs);
      prep_wT4(P.cv_w2, 64, nullptr, P.cw2t + 256 * 256, 256, 256, 4, sm, wvs);
      break;
    case 1: g8::gemm(g8::SrcPlain8{P.xh, DM, P.W0t, DM}, T_TOK, LD0, DM, g8::EpiStore8{P.p, LD0, P.rstd}, smem, wvs); break;
    case 2: prep_cbias_reduce(P, wvs); ph_gla_prep(P, sm, wvs); break;
    case 13: ph_gla_mfma<true>(P, smem, wvs); break;
    case 3: ph_gla_mfma<false>(P, smem, wvs); break;
    case 4: ph_gla_post(P, wvs); break;
    case 5: g8::gemm(g8::SrcPlain8{P.og, DM, P.Wo0t, DM}, T_TOK, DM, DM, g8::EpiStore8{P.y, DM, nullptr}, smem, wvs); break;
    case 6: ph_post(P.x, P.y, P.post_norm, P.out, P.xh, P.rstd, wvs); break;
    case 7: g8::gemm(g8::SrcPlain8{P.xh, DM, P.W1t, DM}, T_TOK, LD1, DM, g8::EpiRope8{P.p, LD1, P.rstd, P.ropetab}, smem, wvs); break;
    case 8: ph_gates(P, smem, wvs, 64); g8::gemm(g8::SrcCmp1_8{P.p, P.cw1t}, 16384, 256, 2048, g8::EpiCmpHid8{P.hid, P.cbias}, smem, wvs); break;
    case 9: ph_kmax(P, wvs); g8::gemm(g8::SrcCmp2_8{P.hid, P.cw2t}, 16384, 256, 256, g8::EpiCmpOut8{P.kcmp, P.vcmp}, smem, wvs); break;
    case 10: ph_attn_mfma(P, smem, wvs); break;
    case 11: g8::gemm(g8::SrcPlain8{P.og, DM, P.Wo1t, DM}, T_TOK, DM, DM, g8::EpiStore8{P.y, DM, nullptr}, smem, wvs); break;
    case 12: ph_post(P.out, P.y, P.post_norm + DM, P.out, nullptr, nullptr, wvs); break;
  }
}

template <int PH>
__global__ void __launch_bounds__(NTHREADS, 2) k_phase(Params P) {
  __shared__ __attribute__((aligned(16))) char smem[SMEM_BYTES];
  run_phase(PH, P, smem, __builtin_amdgcn_readfirstlane(threadIdx.x >> 6));
}
template <int PH>
static void launch_phases(const Params& P, hipStream_t stream) {
  hipLaunchKernelGGL((k_phase<PH>), dim3(256), dim3(NTHREADS), 0, stream, P);
  if constexpr (PH + 1 < NPHASES) launch_phases<PH + 1>(P, stream);
}

#if MEGA
__global__ void __launch_bounds__(NTHREADS, 2) k_mega(Params P) {
  __shared__ __attribute__((aligned(16))) char smem[SMEM_BYTES];
  cg::grid_group grid = cg::this_grid();
  if (P.use_cg_sync) grid.sync();
  unsigned bt = 0;
  const int wvs = __builtin_amdgcn_readfirstlane(threadIdx.x >> 6);
  run_phase(0, P, smem, wvs); fast_barrier(P.bar, bt, wvs);
  run_phase(1, P, smem, wvs); fast_barrier(P.bar, bt, wvs);
  run_phase(2, P, smem, wvs); fast_barrier(P.bar, bt, wvs);
  run_phase(13, P, smem, wvs); fast_barrier(P.bar, bt, wvs);
  run_phase(3, P, smem, wvs); fast_barrier(P.bar, bt, wvs);
  run_phase(4, P, smem, wvs); fast_barrier(P.bar, bt, wvs);
  run_phase(5, P, smem, wvs); fast_barrier(P.bar, bt, wvs);
  run_phase(6, P, smem, wvs); fast_barrier(P.bar, bt, wvs);
  run_phase(7, P, smem, wvs); fast_barrier(P.bar, bt, wvs);
  run_phase(8, P, smem, wvs); fast_barrier(P.bar, bt, wvs);
  run_phase(9, P, smem, wvs); fast_barrier(P.bar, bt, wvs);
  run_phase(10, P, smem, wvs); fast_barrier(P.bar, bt, wvs);
  run_phase(11, P, smem, wvs); fast_barrier(P.bar, bt, wvs);
  run_phase(12, P, smem, wvs);
}
#endif

extern "C" void kernel_launch(void* const* d_in, const int* in_sizes, int n_in, void* d_out, int out_size, void* d_ws, size_t ws_size,
                              hipStream_t stream) {
  Params P{};
  P.x = (const float*)d_in[0]; P.pos = (const int*)d_in[1]; P.pre_norm = (const float*)d_in[2]; P.post_norm = (const float*)d_in[3];
  P.gla_w_in = (const float*)d_in[4]; P.gla_w_gk_up = (const float*)d_in[5]; P.gla_b_gk = (const float*)d_in[6];
  P.gla_head_norm = (const float*)d_in[7]; P.gla_w_out = (const float*)d_in[8];
  P.nsa_w_in = (const float*)d_in[9]; P.nsa_b_gate = (const float*)d_in[10]; P.nsa_pe_k = (const float*)d_in[11]; P.nsa_pe_v = (const float*)d_in[12];
  P.ck_w1 = (const float*)d_in[13]; P.ck_w2 = (const float*)d_in[14]; P.cv_w1 = (const float*)d_in[15]; P.cv_w2 = (const float*)d_in[16];
  P.nsa_w_out = (const float*)d_in[17];
  P.out = (float*)d_out;
  char* ws = (char*)d_ws;
  const size_t MB = 1024 * 1024;
  P.W0t = (half_t*)(ws);
  P.Wo0t = (half_t*)(ws + 7 * MB);
  P.W1t = (half_t*)(ws + 9 * MB);
  P.Wo1t = (half_t*)(ws + 17 * MB);
  P.cw1t = (half_t*)(ws + 19 * MB);
  P.cw2t = (half_t*)(ws + 21 * MB);
  P.cbias = (float*)(ws + 22 * MB);
  P.cbias_part = (float*)(ws + 22 * MB + 4096);
  P.bar = (unsigned*)(ws + 23 * MB);
  P.use_cg_sync = 0;
  P.kmax2 = (unsigned*)(ws + 22 * MB + 512 * 1024);
  P.xh = (half_t*)(ws + 24 * MB);
  P.p = (half_t*)(ws + 88 * MB);
  P.y = (half_t*)(ws + 88 * MB);
  P.og = (half_t*)(ws + 328 * MB);
  P.bcum = (float*)(ws + 392 * MB);
  P.rstd = (float*)(ws + 456 * MB);
  P.kcmp = (half_t*)(ws + 457 * MB);
  P.vcmp = (half_t*)(ws + 458 * MB);
  P.ropetab = (float*)(ws + 459 * MB);
  P.hid = (half_t*)(ws + 467 * MB);
  P.WglT = (half_t*)(ws + 22 * MB + 768 * 1024);
  P.gl = (float*)(ws + 503 * MB);
  P.gla_state = (float*)(ws + 476 * MB);
  if (ws_size < 510 * MB) { fprintf(stderr, "ws too small: %zu\n", ws_size); return; }
#if MEGA
  static int grid_blocks = 0;
  if (!grid_blocks) {
    int dev = 0, cus = 0, per_cu = 0;
    hipGetDevice(&dev);
    hipDeviceGetAttribute(&cus, hipDeviceAttributeMultiprocessorCount, dev);
    hipOccupancyMaxActiveBlocksPerMultiprocessor(&per_cu, k_mega, NTHREADS, 0);
    if (per_cu < 1) per_cu = 1;
    if (per_cu > 1) per_cu = 1;
    grid_blocks = cus * per_cu;
  }
  hipMemsetAsync(ws + 23 * MB, 0, 16384, stream);
  void* args[] = {&P};
  hipError_t e = hipLaunchCooperativeKernel((void*)k_mega, dim3(grid_blocks), dim3(NTHREADS), args, 0, stream);
  if (e != hipSuccess) fprintf(stderr, "cooperative launch failed: %s (grid %d)\n", hipGetErrorString(e), grid_blocks);
#else
  launch_phases<0>(P, stream);
#endif
}
```

```cpp
#include <hip/hip_runtime.h>
#include <hip/hip_cooperative_groups.h>
#include <cstdio>
#include <cstdint>
namespace cg = cooperative_groups;

typedef _Float16 half_t;
typedef _Float16 half8 __attribute__((ext_vector_type(8)));
typedef _Float16 half4 __attribute__((ext_vector_type(4)));
typedef float f32x4 __attribute__((ext_vector_type(4)));
typedef int v2i __attribute__((ext_vector_type(2)));
typedef int v4i __attribute__((ext_vector_type(4)));

#ifndef MEGA
#define MEGA 1
#endif

constexpr int T_TOK = 32768, DM = 1024, SEQ = 4096, NBATCH = 8;
constexpr int GLA_IN = 3088, NSA_IN = 3632;
constexpr int LD0 = 3328, LD1 = 3584;
constexpr int NC = 255;
constexpr float EPS = 1e-6f;
constexpr int NTHREADS = 512, NWAVES = NTHREADS / 64;
constexpr int SMEM_BYTES = 160 * 1024;

struct Params {
  const float* x; const int* pos; const float* pre_norm; const float* post_norm;
  const float* gla_w_in; const float* gla_w_gk_up; const float* gla_b_gk; const float* gla_head_norm; const float* gla_w_out;
  const float* nsa_w_in; const float* nsa_b_gate; const float* nsa_pe_k; const float* nsa_pe_v;
  const float* ck_w1; const float* ck_w2; const float* cv_w1; const float* cv_w2; const float* nsa_w_out;
  float* out;
  half_t* p; half_t* y; half_t* og; float* bcum; float* rstd; half_t* kcmp; half_t* vcmp; float* ropetab;
  half_t* xh; half_t* W0t; half_t* Wo0t; half_t* W1t; half_t* Wo1t;
  half_t* cw1t; half_t* cw2t; float* cbias; half_t* hid;
  float* cbias_part; unsigned* bar; long long use_cg_sync; unsigned* kmax2; float* gla_state; half_t* WglT; float* gl; half_t* x1h;
};

__device__ __forceinline__ int lane_id() { return (int)__builtin_amdgcn_mbcnt_hi(~0u, __builtin_amdgcn_mbcnt_lo(~0u, 0u)); }
__device__ __forceinline__ int otid(int wvs) { int t = wvs * 64 + lane_id(); asm volatile("" : "+v"(t)); return t; }
__device__ __forceinline__ float wave_sum(float v) {
#pragma unroll
  for (int o = 32; o > 0; o >>= 1) v += __shfl_xor(v, o);
  return v;
}
__device__ __forceinline__ float wave_max(float v) {
#pragma unroll
  for (int o = 32; o > 0; o >>= 1) v = fmaxf(v, __shfl_xor(v, o));
  return v;
}
typedef __attribute__((address_space(3))) void lds_void;
typedef __attribute__((address_space(1))) const void gbl_void;
typedef short s16x4 __attribute__((vector_size(8)));
typedef __attribute__((address_space(3))) s16x4 lds_s16x4;
__device__ __forceinline__ half4 tr_read4(const char* p) {
  const s16x4 v = __builtin_amdgcn_ds_read_tr16_b64_v4i16((lds_s16x4*)(p));
  return __builtin_bit_cast(half4, v);
}
template <int N> __device__ __forceinline__ void wait_vmcnt() { asm volatile("s_waitcnt vmcnt(%0)" ::"n"(N) : "memory"); }
constexpr float LOG2E = 1.4426950408889634f;
__device__ __forceinline__ float fexp2(float x) { return __builtin_amdgcn_exp2f(x); }
typedef unsigned u32x2 __attribute__((ext_vector_type(2)));
__device__ __forceinline__ float rowmax4(float x) {
  u32x2 r = __builtin_amdgcn_permlane16_swap(__float_as_uint(x), __float_as_uint(x), false, false);
  x = fmaxf(__uint_as_float(r[0]), __uint_as_float(r[1]));
  r = __builtin_amdgcn_permlane32_swap(__float_as_uint(x), __float_as_uint(x), false, false);
  return fmaxf(__uint_as_float(r[0]), __uint_as_float(r[1]));
}
__device__ __forceinline__ float rowsum4(float x) {
  u32x2 r = __builtin_amdgcn_permlane16_swap(__float_as_uint(x), __float_as_uint(x), false, false);
  x = __uint_as_float(r[0]) + __uint_as_float(r[1]);
  r = __builtin_amdgcn_permlane32_swap(__float_as_uint(x), __float_as_uint(x), false, false);
  return __uint_as_float(r[0]) + __uint_as_float(r[1]);
}
__device__ __forceinline__ float fast_exp2(float x) { return __builtin_amdgcn_exp2f(x); }
__device__ __forceinline__ float sigmoidf(float v) { return __builtin_amdgcn_rcpf(1.f + fast_exp2(-1.4426950408889634f * v)); }
__device__ __forceinline__ float siluf(float v) { return v * sigmoidf(v); }
__device__ __forceinline__ float logsigmoidf(float u) { return fminf(u, 0.f) - 0.6931471805599453f * __builtin_amdgcn_logf(1.f + fast_exp2(-1.4426950408889634f * fabsf(u))); }

__device__ __forceinline__ void fast_barrier(unsigned* bar, unsigned& round, int wvs) {
  asm volatile("s_waitcnt vmcnt(0) lgkmcnt(0)" ::: "memory");
  __syncthreads();
  round += 1;
  if (wvs == 0 && lane_id() == 0) {
    __builtin_amdgcn_fence(__ATOMIC_RELEASE, "agent");
    asm volatile("s_waitcnt vmcnt(0)" ::: "memory");
    const unsigned ngroups = gridDim.x >> 4;
    const unsigned old = __hip_atomic_fetch_add(bar + 64 + 64 * (blockIdx.x >> 4), 1u, __ATOMIC_RELAXED, __HIP_MEMORY_SCOPE_AGENT);
    if (old + 1 == round * 16u) __hip_atomic_fetch_add(bar, 1u, __ATOMIC_RELAXED, __HIP_MEMORY_SCOPE_AGENT);
    const unsigned target = round * ngroups;
    while (__hip_atomic_load(bar, __ATOMIC_RELAXED, __HIP_MEMORY_SCOPE_AGENT) < target) { }
    __builtin_amdgcn_fence(__ATOMIC_ACQUIRE, "agent");
    asm volatile("s_waitcnt vmcnt(0)" ::: "memory");
  }
  __syncthreads();
}

__device__ void ph_xh_rstd(const float* src, half_t* xh, float* rstd, int wvs) {
  const int tid_ = otid(wvs); const int lane = tid_ & 63, w = tid_ >> 6;
#pragma unroll 2
  for (int row = blockIdx.x * NWAVES + w; row < T_TOK; row += gridDim.x * NWAVES) {
    const float4* r = (const float4*)(src + (size_t)row * DM);
    half4* xr = (half4*)(xh + (size_t)row * DM);
    float ss = 0.f;
#pragma unroll
    for (int i = 0; i < 4; ++i) {
      const float4 v = r[lane + 64 * i];
      ss += v.x * v.x + v.y * v.y + v.z * v.z + v.w * v.w;
      half4 hv; hv[0] = (half_t)v.x; hv[1] = (half_t)v.y; hv[2] = (half_t)v.z; hv[3] = (half_t)v.w;
      xr[lane + 64 * i] = hv;
    }
    ss = wave_sum(ss);
    if (lane == 0) rstd[row] = rsqrtf(ss * (1.f / DM) + EPS);
  }
}
__device__ void ph_ropetab(const Params& P, int wvs) {
  const int tid = otid(wvs);
  const float inv = powf(10000.f, -(float)(2 * (tid & 31)) / 64.f);
  for (int idx = blockIdx.x * NTHREADS + tid; idx < T_TOK * 32; idx += gridDim.x * NTHREADS) {
    const int t = idx >> 5, i = idx & 31;
    const float ang = (float)P.pos[t] * inv;
    float s, c; sincosf(ang, &s, &c);
    P.ropetab[t * 64 + i] = c; P.ropetab[t * 64 + 32 + i] = s;
  }
}
__device__ __forceinline__ int orig_col(int n, int mode) {
  if (mode == 0) {
    if (n < 2048) return n;
    if (n < 3072) return n + 16;
    if (n < 3088) return n - 1024;
    return -1;
  } else if (mode == 1) {
    if (n < 2560) return n;
    if (n < 3584) return n + 48;
    return -1;
  } else if (mode == 5) {
    return n < 48 ? 2560 + n : -1;
  }
  if (mode == 4) return n < 64 ? n : -1;
  return n;
}
__device__ void prep_wT(const float* W, int ldw, const float* gamma, half_t* Wt, int Npad, int K, int mode, float* sm, int wvs) {
  float(*tile)[65] = (float(*)[65])sm;
  const int tid = otid(wvs);
  const int ntn = Npad / 64, ntk = K / 64;
  for (int t = blockIdx.x; t < ntn * ntk; t += gridDim.x) {
    const int n0 = (t / ntk) * 64, k0 = (t % ntk) * 64;
    __syncthreads();
#pragma unroll
    for (int r = 0; r < 4096 / NTHREADS; ++r) {
      const int idx = tid + r * NTHREADS, kk = idx >> 6, nn = idx & 63;
      const int on = orig_col(n0 + nn, mode);
      float v = 0.f;
      if (on >= 0) { v = W[(size_t)(k0 + kk) * ldw + on]; if (gamma) v *= gamma[k0 + kk]; }
      tile[kk][nn] = v;
    }
    __syncthreads();
    {
      const int nn = tid >> 3, oct = tid & 7;
      half8 hv;
#pragma unroll
      for (int e = 0; e < 8; ++e) hv[e] = (half_t)tile[oct * 8 + e][nn];
      *(half8*)(Wt + (size_t)(n0 + nn) * K + k0 + oct * 8) = hv;
    }
  }
}

__device__ __forceinline__ void prep_strip(const float* W, int ldw, const float* gamma, half_t* Wt, int K, int mode, int n0, int k0, float* sm, int tid) {
  float(*tile)[260] = (float(*)[260])sm;
  __syncthreads();
#pragma unroll
  for (int r = 0; r < 8; ++r) {
    const int idx = tid + r * NTHREADS, kk = idx >> 6, n4 = (idx & 63) * 4;
    const int on = orig_col(n0 + n4, mode);
    f32x4 v = (f32x4){0.f, 0.f, 0.f, 0.f};
    if (on >= 0) { v = *(const f32x4*)(W + (size_t)(k0 + kk) * ldw + on); if (gamma) v *= gamma[k0 + kk]; }
    *(f32x4*)&tile[kk][n4] = v;
  }
  __syncthreads();
#pragma unroll
  for (int r = 0; r < 4; ++r) {
    const int idx = tid + r * NTHREADS, nn = idx & 255, oct = idx >> 8;
    half8 hv;
#pragma unroll
    for (int e = 0; e < 8; ++e) hv[e] = (half_t)tile[oct * 8 + e][nn];
    *(half8*)(Wt + (size_t)(n0 + nn) * K + k0 + oct * 8) = hv;
  }
}
__device__ void prep_weights(const Params& P, float* sm, int wvs) {
  const int tid = otid(wvs);
  constexpr int NJ = 8;
  const int nstr[NJ] = {(LD0 / 256) * (DM / 64), (DM / 256) * (DM / 64), (LD1 / 256) * (DM / 64), (DM / 256) * (DM / 64), 32, 32, 4, 4};
  int total = 0;
#pragma unroll
  for (int j = 0; j < NJ; ++j) total += nstr[j];
  for (int w = blockIdx.x; w < total; w += gridDim.x) {
    int j = 0, t = w;
#pragma unroll
    for (int jj = 0; jj < NJ - 1; ++jj) if (j == jj && t >= nstr[jj]) { t -= nstr[jj]; j = jj + 1; }
    const float* W; int ldw; const float* gamma; half_t* Wt; int K, mode;
    switch (j) {
      case 0: W = P.gla_w_in; ldw = GLA_IN; gamma = P.pre_norm; Wt = P.W0t; K = DM; mode = 0; break;
      case 1: W = P.gla_w_out; ldw = DM; gamma = nullptr; Wt = P.Wo0t; K = DM; mode = 2; break;
      case 2: W = P.nsa_w_in; ldw = NSA_IN; gamma = P.pre_norm + DM; Wt = P.W1t; K = DM; mode = 1; break;
      case 3: W = P.nsa_w_out; ldw = DM; gamma = nullptr; Wt = P.Wo1t; K = DM; mode = 2; break;
      case 4: W = P.ck_w1; ldw = 256; gamma = nullptr; Wt = P.cw1t; K = 2048; mode = 2; break;
      case 5: W = P.cv_w1; ldw = 256; gamma = nullptr; Wt = P.cw1t + 256 * 2048; K = 2048; mode = 2; break;
      case 6: W = P.ck_w2; ldw = 64; gamma = nullptr; Wt = P.cw2t; K = 256; mode = 4; break;
      default: W = P.cv_w2; ldw = 64; gamma = nullptr; Wt = P.cw2t + 256 * 256; K = 256; mode = 4; break;
    }
    const int nsk = K / 64;
    prep_strip(W, ldw, gamma, Wt, K, mode, (t / nsk) * 256, (t % nsk) * 64, sm, tid);
  }
}

__device__ void prep_cbias_part(const Params& P, int wvs) {
  for (int idx = blockIdx.x * NTHREADS + otid(wvs); idx < 2 * 32 * 256; idx += gridDim.x * NTHREADS) {
    const int j = idx & 255, ks = (idx >> 8) & 31, which = idx >> 13;
    const float* pe = which ? P.nsa_pe_v : P.nsa_pe_k;
    const float* w1 = which ? P.cv_w1 : P.ck_w1;
    float a = 0.f;
#pragma unroll 8
    for (int k = ks * 64; k < ks * 64 + 64; ++k) a += pe[k] * w1[(size_t)k * 256 + j];
    P.cbias_part[idx] = a;
  }
}
__device__ void prep_cbias_reduce(const Params& P, int wvs) {
  if (blockIdx.x < 2 && otid(wvs) < 256) {
    const int which = blockIdx.x, j = otid(wvs);
    float a = 0.f;
    for (int ks = 0; ks < 32; ++ks) a += P.cbias_part[(which * 32 + ks) * 256 + j];
    P.cbias[which * 256 + j] = a;
  }
}

namespace g8 {
constexpr int BK = 64, HALF = 128, HTB = HALF * BK * 2;
__device__ __forceinline__ int lds_byte(int r, int c) { const int st = (r >> 4) * 2 + (c >> 5), rr = r & 15, cc = c & 31, ob = rr * 64 + cc * 2; return st * 1024 + (ob ^ (((ob >> 9) & 1) << 5)); }
__device__ __forceinline__ void stage_rc(int b, int& R, int& C) { const int st = b / 1024, sb = b % 1024, swz = sb ^ (((sb >> 9) & 1) << 5); R = (st >> 1) * 16 + swz / 64; C = (st & 1) * 32 + (swz % 64) / 2; }
typedef f32x4 Acc[2][2][4][2];

struct SrcPlain8 {
  const half_t* A; int lda; const half_t* Bt; int K;
  __device__ __forceinline__ void get(int pm, int pn, const half_t*& Ag, const half_t*& Bg, size_t& a_rs, int& a_ks) const {
    Ag = A + (size_t)pm * 256 * lda; Bg = Bt + (size_t)pn * 256 * K; a_rs = lda; a_ks = 64;
  }
};
struct SrcCmp1_8 {
  const half_t* p1; const half_t* w1t;
  __device__ __forceinline__ void get(int pm, int pn, const half_t*& Ag, const half_t*& Bg, size_t& a_rs, int& a_ks) const {
    const int which = pm >> 5, bg = pm & 31, b = bg >> 2, g = bg & 3;
    Ag = p1 + (size_t)(b * SEQ) * LD1 + (which ? 1280 : 1024) + g * 64;
    Bg = w1t + (size_t)which * 256 * 2048; a_rs = (size_t)16 * LD1; a_ks = LD1;
  }
};
struct SrcCmp2_8 {
  const half_t* hid; const half_t* w2t;
  __device__ __forceinline__ void get(int pm, int pn, const half_t*& Ag, const half_t*& Bg, size_t& a_rs, int& a_ks) const {
    Ag = hid + (size_t)pm * 256 * 256; Bg = w2t + (size_t)(pm >> 5) * 256 * 256; a_rs = 256; a_ks = 64;
  }
};

__device__ __forceinline__ half8 pack8(const f32x4 a, const f32x4 b) {
  half8 h; h[0] = (half_t)a[0]; h[1] = (half_t)a[1]; h[2] = (half_t)a[2]; h[3] = (half_t)a[3]; h[4] = (half_t)b[0]; h[5] = (half_t)b[1]; h[6] = (half_t)b[2]; h[7] = (half_t)b[3];
  return h;
}
struct EpiStore8 {
  half_t* C; int ldc; const float* rowscale;
  __device__ __forceinline__ void operator()(const Acc& acc, int row0, int col0, int wr, int wc, int fr, int fq) const {
#pragma unroll
    for (int ai = 0; ai < 2; ++ai)
#pragma unroll
      for (int m = 0; m < 4; ++m) {
        const int tok = row0 + ai * 128 + wr * 64 + m * 16 + fr;
        const float s = rowscale ? rowscale[tok] : 1.f;
        half_t* rowp = C + (size_t)tok * ldc + col0 + 64 * wc + 8 * fq;
#pragma unroll
        for (int bj = 0; bj < 2; ++bj) *(half8*)(rowp + 32 * bj) = pack8(acc[ai][bj][m][0] * s, acc[ai][bj][m][1] * s);
      }
  }
};
struct EpiRope8 {
  half_t* C; int ldc; const float* rowscale; const float* ropetab;
  __device__ __forceinline__ void operator()(const Acc& acc, int row0, int col0, int wr, int wc, int fr, int fq) const {
    const int grp = (col0 >> 6) + wc;
    const bool is_q = grp < 16;
    const bool roped = is_q || (grp >= 16 && grp < 20) || (grp >= 24 && grp < 28) || (grp >= 32 && grp < 36);
    const float sc = is_q ? 0.125f * 1.4426950408889634f : 1.f;
#pragma unroll
    for (int ai = 0; ai < 2; ++ai)
#pragma unroll
      for (int m = 0; m < 4; ++m) {
        const int tok = row0 + ai * 128 + wr * 64 + m * 16 + fr;
        const float s = rowscale[tok];
        half_t* rowp = C + (size_t)tok * ldc + col0 + 64 * wc + 8 * fq;
        f32x4 o1[2], o2[2];
#pragma unroll
        for (int n = 0; n < 2; ++n) {
          const f32x4 x1 = acc[ai][0][m][n] * s, x2 = acc[ai][1][m][n] * s;
          if (roped) {
            const f32x4 cs = *(const f32x4*)(ropetab + (size_t)tok * 64 + 8 * fq + 4 * n);
            const f32x4 sn = *(const f32x4*)(ropetab + (size_t)tok * 64 + 32 + 8 * fq + 4 * n);
            o1[n] = (x1 * cs - x2 * sn) * sc; o2[n] = (x2 * cs + x1 * sn) * sc;
          } else { o1[n] = x1; o2[n] = x2; }
        }
        *(half8*)(rowp) = pack8(o1[0], o1[1]);
        *(half8*)(rowp + 32) = pack8(o2[0], o2[1]);
      }
  }
};
struct EpiCmpHid8 {
  half_t* hid; const float* bias;
  __device__ __forceinline__ void operator()(const Acc& acc, int row0, int col0, int wr, int wc, int fr, int fq) const {
    const int which = row0 >> 13;
#pragma unroll
    for (int bj = 0; bj < 2; ++bj) {
      const int col = col0 + 64 * wc + 32 * bj + 8 * fq;
      const f32x4 b0 = *(const f32x4*)(bias + which * 256 + col), b1 = *(const f32x4*)(bias + which * 256 + col + 4);
#pragma unroll
      for (int ai = 0; ai < 2; ++ai)
#pragma unroll
        for (int m = 0; m < 4; ++m) {
          const int row = row0 + ai * 128 + wr * 64 + m * 16 + fr;
          f32x4 v0 = acc[ai][bj][m][0] + b0, v1 = acc[ai][bj][m][1] + b1;
#pragma unroll
          for (int e = 0; e < 4; ++e) { v0[e] = siluf(v0[e]); v1[e] = siluf(v1[e]); }
          *(half8*)(hid + (size_t)row * 256 + col) = pack8(v0, v1);
        }
    }
  }
};
struct EpiCmpOut8 {
  half_t* kcmp; half_t* vcmp;
  __device__ __forceinline__ void operator()(const Acc& acc, int row0, int col0, int wr, int wc, int fr, int fq) const {
    if (wc != 0) return;
#pragma unroll
    for (int ai = 0; ai < 2; ++ai)
#pragma unroll
      for (int m = 0; m < 4; ++m) {
        const int row = row0 + ai * 128 + wr * 64 + m * 16 + fr;
        const int which = row >> 13, r = row & 8191;
        half_t* dst = (which ? vcmp : kcmp) + (size_t)r * 64 + 8 * fq;
        const bool dead = (r & 255) == 255;
#pragma unroll
        for (int bj = 0; bj < 2; ++bj) {
          half8 hv = pack8(acc[ai][bj][m][0], acc[ai][bj][m][1]);
          if (dead) hv = (half8){(half_t)0.f, (half_t)0.f, (half_t)0.f, (half_t)0.f, (half_t)0.f, (half_t)0.f, (half_t)0.f, (half_t)0.f};
          *(half8*)(dst + 32 * bj) = hv;
        }
      }
  }
};

template <class Src, class Epi>
__device__ void gemm(const Src& src, int M, int N, int K, const Epi& epi, char* smem, int wvs) {
  const int tid = otid(wvs), wid = __builtin_amdgcn_readfirstlane(tid >> 6), lane = tid & 63, wr = wid >> 2, wc = wid & 3, fr = lane & 15, fq = lane >> 4;
  const int nM = M / 256, nN = N / 256, nwg = nM * nN, G = gridDim.x, nt = K / BK;
  int sr0, sc0, sr1, sc1;
  stage_rc(tid * 16, sr0, sc0); stage_rc(tid * 16 + 8192, sr1, sc1);
  const int a_base = lds_byte(wr * 64 + fr, fq * 8);
  int b_base = 65536 + lds_byte(wc * 32 + fr, fq * 8);
  asm volatile("" : "+v"(b_base));
#define SA8(b, h) (smem + ((b) * 2 + (h)) * HTB)
#define SB8(b, h) (smem + (4 + (b) * 2 + (h)) * HTB)
#define STAGE_A(P, h, kt) { const char* g_ = (const char*)(Ag + (size_t)(h) * 128 * lda + (size_t)(kt) * a_ks); \
    __builtin_amdgcn_global_load_lds((gbl_void*)(g_ + aob0), (lds_void*)((P) + wid * 1024), 16, 0, 0); \
    __builtin_amdgcn_global_load_lds((gbl_void*)(g_ + aob1), (lds_void*)((P) + 8192 + wid * 1024), 16, 0, 0); }
#define STAGE_B(P, h, kt) { const char* g_ = (const char*)(Bg + (size_t)(h) * 32 * K + (size_t)(kt) * 64);     \
    __builtin_amdgcn_global_load_lds((gbl_void*)(g_ + bob0), (lds_void*)((P) + wid * 1024), 16, 0, 0); \
    __builtin_amdgcn_global_load_lds((gbl_void*)(g_ + bob1), (lds_void*)((P) + 8192 + wid * 1024), 16, 0, 0); }
#define LDA8(dst, b, h) { _Pragma("unroll") for (int m = 0; m < 4; ++m) _Pragma("unroll") for (int k = 0; k < 2; ++k) dst[m][k] = *(const half8*)(SA8(b, h) + a_base + m * 2048 + k * 1024); }
#define LDB8(dst, b, h) { _Pragma("unroll") for (int n = 0; n < 2; ++n) _Pragma("unroll") for (int k = 0; k < 2; ++k) dst[n][k] = *(const half8*)(smem + ((b) * 2 + (h)) * HTB + b_base + n * 2048 + k * 1024); }
#define MMA8(ai, bj, At, Bx) { __builtin_amdgcn_s_setprio(1); \
    _Pragma("unroll") for (int m = 0; m < 4; ++m) _Pragma("unroll") for (int n = 0; n < 2; ++n) _Pragma("unroll") for (int k = 0; k < 2; ++k) \
      acc[ai][bj][m][n] = __builtin_amdgcn_mfma_f32_16x16x32_f16(Bx[n][k], At[m][k], acc[ai][bj][m][n], 0, 0, 0); \
    __builtin_amdgcn_s_setprio(0); }
#define WAIT_V(n) asm volatile("s_waitcnt vmcnt(" #n ")" ::: "memory")
#define WAIT_L(n) asm volatile("s_waitcnt lgkmcnt(" #n ")" ::: "memory")
#define BAR __builtin_amdgcn_s_barrier()
#define SCHED __builtin_amdgcn_sched_barrier(0)
  for (int it = 0;; ++it) {
    const int L = it * G + (int)blockIdx.x;
    if (L >= nwg) break;
    int wgid;
    { const int q = nwg / 8, r = nwg % 8, xcd = L % 8, off = L / 8; wgid = (xcd < r ? xcd * (q + 1) : r * (q + 1) + (xcd - r) * q) + off; }
    const int nig = 8 * nN, gid = wgid / nig, fm = gid * 8, gsz = (nM - fm) < 8 ? (nM - fm) : 8;
    const int pm = fm + ((wgid % nig) % gsz), pn = (wgid % nig) / gsz;
    const half_t* Ag; const half_t* Bg; size_t lda; int a_ks;
    src.get(pm, pn, Ag, Bg, lda, a_ks);
    const unsigned aob0 = (unsigned)(((size_t)sr0 * lda + sc0) * 2), aob1 = (unsigned)(((size_t)sr1 * lda + sc1) * 2);
    const int pr0 = 64 * (sr0 >> 5) + 8 * ((sr0 & 15) >> 2) + 4 * ((sr0 >> 4) & 1) + (sr0 & 3), pr1 = 64 * (sr1 >> 5) + 8 * ((sr1 & 15) >> 2) + 4 * ((sr1 >> 4) & 1) + (sr1 & 3);
    const unsigned bob0 = (unsigned)((pr0 * K + sc0) * 2), bob1 = (unsigned)((pr1 * K + sc1) * 2);
    Acc acc;
#pragma unroll
    for (int a = 0; a < 2; ++a)
#pragma unroll
      for (int b = 0; b < 2; ++b)
#pragma unroll
        for (int m = 0; m < 4; ++m)
#pragma unroll
          for (int n = 0; n < 2; ++n) acc[a][b][m][n] = (f32x4){0.f, 0.f, 0.f, 0.f};
    half8 At[4][2], B0[2][2], B1[2][2];
    STAGE_B(SB8(0, 0), 0, 0) STAGE_A(SA8(0, 0), 0, 0)
    STAGE_B(SB8(0, 1), 1, 0) STAGE_A(SA8(0, 1), 1, 0)
    if (wr == 1) BAR;
    WAIT_V(4); BAR;
    STAGE_B(SB8(1, 0), 0, 1) STAGE_A(SA8(1, 0), 0, 1) STAGE_B(SB8(1, 1), 1, 1)
    WAIT_V(6); BAR;
#pragma unroll 1
    for (int t = 0; t < nt - 2; t += 2) {
      LDB8(B0, 0, 0) SCHED; LDA8(At, 0, 0) STAGE_A(SA8(1, 1), 1, t + 1)
      WAIT_L(8); BAR; WAIT_L(0); MMA8(0, 0, At, B0) BAR; SCHED;
      LDB8(B1, 0, 1) STAGE_B(SB8(0, 0), 0, t + 2)
      BAR; WAIT_L(0); MMA8(0, 1, At, B1) BAR;
      LDA8(At, 0, 1) STAGE_A(SA8(0, 0), 0, t + 2)
      BAR; WAIT_L(0); MMA8(1, 0, At, B0) BAR; SCHED;
      STAGE_B(SB8(0, 1), 1, t + 2)
      WAIT_V(6); BAR; MMA8(1, 1, At, B1) BAR;
      LDB8(B0, 1, 0) SCHED; LDA8(At, 1, 0) STAGE_A(SA8(0, 1), 1, t + 2)
      WAIT_L(8); BAR; WAIT_L(0); MMA8(0, 0, At, B0) BAR; SCHED;
      LDB8(B1, 1, 1) STAGE_B(SB8(1, 0), 0, t + 3)
      BAR; WAIT_L(0); MMA8(0, 1, At, B1) BAR;
      LDA8(At, 1, 1) STAGE_A(SA8(1, 0), 0, t + 3)
      BAR; WAIT_L(0); MMA8(1, 0, At, B0) BAR; SCHED;
      STAGE_B(SB8(1, 1), 1, t + 3)
      WAIT_V(6); BAR; MMA8(1, 1, At, B1) BAR;
    }
    { LDB8(B0, 0, 0) LDA8(At, 0, 0) STAGE_A(SA8(1, 1), 1, nt - 1)
      BAR; WAIT_L(0); MMA8(0, 0, At, B0) BAR;
      LDB8(B1, 0, 1) BAR; WAIT_L(0); MMA8(0, 1, At, B1) BAR;
      LDA8(At, 0, 1) WAIT_V(4); BAR; WAIT_L(0); MMA8(1, 0, At, B0) MMA8(1, 1, At, B1) BAR; }
    { LDB8(B0, 1, 0) LDA8(At, 1, 0) WAIT_V(2); BAR; WAIT_L(0); MMA8(0, 0, At, B0) BAR;
      LDB8(B1, 1, 1) WAIT_V(0); BAR; WAIT_L(0); MMA8(0, 1, At, B1) BAR;
      LDA8(At, 1, 1) BAR; WAIT_L(0); MMA8(1, 0, At, B0) MMA8(1, 1, At, B1) BAR; }
    if (wr == 0) BAR;
    { int fr2 = fr, fq2 = fq; asm volatile("" : "+v"(fr2), "+v"(fq2)); epi(acc, pm * 256, pn * 256, wr, wc, fr2, fq2); }
  }
#undef SA8
#undef SB8
#undef STAGE_A
#undef STAGE_B
#undef LDA8
#undef LDB8
#undef MMA8
#undef WAIT_V
#undef WAIT_L
#undef BAR
#undef SCHED
}
}

__device__ void ph_gla_prep(const Params& P, float* sm, int wvs) {
  float(*glr)[16] = (float(*)[16])sm;
  float(*tot)[128] = (float(*)[128])(sm + 1024);
  float(*exl)[132] = (float(*)[132])(sm + 1536);
  const int tid = otid(wvs);
  const int tq = tid >> 7, c = tid & 127;
  const int tp = tid >> 4, co = tid & 15;
  const float scale = 0.08838834764831845f;
  for (int item = blockIdx.x; item < (T_TOK / 64) * 4; item += gridDim.x) {
    const int chunk = item >> 2, h = item & 3;
    const int t0 = chunk * 64, ch = h * 128 + c;
    __syncthreads();
    for (int idx = tid; idx < 64 * 16; idx += NTHREADS) {
      const int i = idx >> 4, r = idx & 15;
      glr[i][r] = (float)P.p[(size_t)(t0 + i) * LD0 + 3072 + r];
    }
    half_t* qp = P.p + (size_t)(t0 + 2 * tp) * LD0 + h * 128 + co * 8;
    const half8 q0 = *(const half8*)(qp), k0 = *(const half8*)(qp + 512), q1 = *(const half8*)(qp + LD0), k1 = *(const half8*)(qp + LD0 + 512);
    float w[16];
#pragma unroll
    for (int r = 0; r < 16; ++r) w[r] = P.gla_w_gk_up[r * 512 + ch];
    const float bb = P.gla_b_gk[ch];
    __syncthreads();
    float pre[16]; float cum = 0.f;
#pragma unroll
    for (int i = 0; i < 16; ++i) {
      float u = bb;
#pragma unroll
      for (int r = 0; r < 16; ++r) u += glr[tq * 16 + i][r] * w[r];
      cum += logsigmoidf(u) * (1.f / 16.f);
      pre[i] = cum;
    }
    tot[tq][c] = cum;
    __syncthreads();
    float off = 0.f;
#pragma unroll
    for (int t = 0; t < 3; ++t) if (t < tq) off += tot[t][c];
#pragma unroll
    for (int i = 0; i < 16; ++i) {
      const float ex = fast_exp2((pre[i] + off) * LOG2E);
      exl[tq * 16 + i][c] = ex;
      if (tq == 3 && i == 15) P.bcum[(size_t)chunk * 512 + ch] = ex;
    }
    __syncthreads();
    {
      const f32x4 e00 = *(const f32x4*)&exl[2 * tp][co * 8], e01 = *(const f32x4*)&exl[2 * tp][co * 8 + 4];
      const f32x4 e10 = *(const f32x4*)&exl[2 * tp + 1][co * 8], e11 = *(const f32x4*)&exl[2 * tp + 1][co * 8 + 4];
      half8 oq0, ok0, oq1, ok1;
#pragma unroll
      for (int e = 0; e < 8; ++e) {
        const float x0 = e < 4 ? e00[e] : e01[e - 4], x1 = e < 4 ? e10[e] : e11[e - 4];
        oq0[e] = (half_t)((float)q0[e] * scale * x0); ok0[e] = (half_t)((float)k0[e] * __builtin_amdgcn_rcpf(x0));
        oq1[e] = (half_t)((float)q1[e] * scale * x1); ok1[e] = (half_t)((float)k1[e] * __builtin_amdgcn_rcpf(x1));
      }
      *(half8*)(qp) = oq0; *(half8*)(qp + 512) = ok0; *(half8*)(qp + LD0) = oq1; *(half8*)(qp + LD0 + 512) = ok1;
    }
  }
}

constexpr int GLA_QE = 0, GLA_KE = 16384, GLA_V = 32768, GLA_DEC = 49152, GLA_BUF = 53248;
#define GLA_TR4(d0, d1, d2, d3, addr, o0, o1, o2, o3) \
  asm volatile("ds_read_b64_tr_b16 %0, %4 offset:%5\n\tds_read_b64_tr_b16 %1, %4 offset:%6\n\tds_read_b64_tr_b16 %2, %4 offset:%7\n\tds_read_b64_tr_b16 %3, %4 offset:%8" \
               : "=&v"(d0), "=&v"(d1), "=&v"(d2), "=&v"(d3) : "v"(addr), "n"(o0), "n"(o1), "n"(o2), "n"(o3) : "memory")
__device__ __forceinline__ half8 pack_h8(const v2i a, const v2i b) { const v4i p = (v4i){a[0], a[1], b[0], b[1]}; return __builtin_bit_cast(half8, p); }

template <bool STATE_ONLY>
__device__ void ph_gla_mfma(const Params& P, char* smem, int wvs) {
  const int tid = otid(wvs);
  const int lane = tid & 63, wave = __builtin_amdgcn_readfirstlane(tid >> 6), r15 = lane & 15, q = lane >> 4;
  const int qp = r15 >> 2, pp = lane & 3;
  const int srow = tid >> 4, sslot = tid & 15;
  const int src_q = (sslot ^ (srow & 15)) * 8, src_kv = (sslot ^ ((srow & 7) << 1)) * 8;
  const int fk = ((4 * (q & 1) + qp) & 7) << 1;
  const unsigned tr_row = (unsigned)((4 * q + qp) * 256 + 8 * (pp & 1) + ((pp >> 1) << 4));
  constexpr int NLOAD = STATE_ONLY ? 5 : 7;
  for (int item = blockIdx.x; item < (STATE_ONLY ? 3 : 4) * 64; item += gridDim.x) {
    const int seg = item >> 6, base = item & 63, b = base >> 3, h = (base >> 1) & 3, vs = base & 1;
    const int c0 = seg * 16;
    f32x4 S[8], Dacc[8];
#pragma unroll
    for (int df = 0; df < 8; ++df) { S[df] = (f32x4){0.f, 0.f, 0.f, 0.f}; Dacc[df] = (f32x4){1.f, 1.f, 1.f, 1.f}; }
    f32x4* stL = (f32x4*)P.gla_state + ((size_t)base * 8 + wave) * 8 * 64 + lane;
    f32x4* stD = stL + (size_t)3 * 64 * 8 * 8 * 64;
    if (!STATE_ONLY) {
      for (int k = 0; k < seg; ++k) {
#pragma unroll
        for (int df = 0; df < 8; ++df) {
          const f32x4 Lk = stL[((size_t)k * 64 * 8 * 8 + df) * 64];
          if (k == 0) S[df] = Lk;
          else { const f32x4 Dk = stD[((size_t)k * 64 * 8 * 8 + df) * 64]; S[df] = Dk * S[df] + Lk; }
        }
      }
    }
    const half_t* qsrc = P.p + (size_t)(b * SEQ + srow) * LD0 + h * 128;
    const half_t* vsrc = P.p + (size_t)(b * SEQ + srow) * LD0 + 1024 + h * 256 + vs * 128 + src_kv;
    const float* dsrc = P.bcum + (size_t)(b * 64 + c0) * 512 + h * 128 + (lane & 31) * 4;
#define G_ISSUE(N, BUF) { char* lb_ = smem + (BUF) * GLA_BUF + wave * 1024; const size_t ro_ = (size_t)(c0 + (N)) * 64 * LD0; \
      if (!STATE_ONLY) { __builtin_amdgcn_global_load_lds((gbl_void*)(qsrc + ro_ + src_q), (lds_void*)(lb_ + GLA_QE), 16, 0, 0); \
      __builtin_amdgcn_global_load_lds((gbl_void*)(qsrc + ro_ + (size_t)32 * LD0 + src_q), (lds_void*)(lb_ + GLA_QE + 8192), 16, 0, 0); } \
      __builtin_amdgcn_global_load_lds((gbl_void*)(qsrc + ro_ + 512 + src_kv), (lds_void*)(lb_ + GLA_KE), 16, 0, 0); \
      __builtin_amdgcn_global_load_lds((gbl_void*)(qsrc + ro_ + (size_t)32 * LD0 + 512 + src_kv), (lds_void*)(lb_ + GLA_KE + 8192), 16, 0, 0); \
      __builtin_amdgcn_global_load_lds((gbl_void*)(vsrc + ro_), (lds_void*)(lb_ + GLA_V), 16, 0, 0); \
      __builtin_amdgcn_global_load_lds((gbl_void*)(vsrc + ro_ + (size_t)32 * LD0), (lds_void*)(lb_ + GLA_V + 8192), 16, 0, 0); \
      if (lane < 32) __builtin_amdgcn_global_load_lds((gbl_void*)(dsrc + (size_t)(N) * 512), (lds_void*)(smem + (BUF) * GLA_BUF + GLA_DEC + wave * 512), 16, 0, 0); }
    G_ISSUE(0, 0)
    G_ISSUE(1, 1)
#pragma unroll 1
    for (int n = 0; n < 16; ++n) {
      if (n + 1 < 16) wait_vmcnt<NLOAD>(); else wait_vmcnt<0>();
      __builtin_amdgcn_s_barrier();
      if (n + 2 < 16) G_ISSUE(n + 2, (n + 2) % 3)
      const char* cb = smem + (n % 3) * GLA_BUF;
      f32x4 aT[4][4];
      if (!STATE_ONLY) {
#pragma unroll
      for (int kf = 0; kf < 4; ++kf)
#pragma unroll
        for (int tf = 0; tf < 4; ++tf) aT[kf][tf] = (f32x4){0.f, 0.f, 0.f, 0.f};
#pragma unroll
      for (int ks = 0; ks < 4; ++ks) {
        half8 kef[4], qef[4];
#pragma unroll
        for (int f = 0; f < 4; ++f) {
          kef[f] = *(const half8*)(cb + GLA_KE + (16 * f + r15) * 256 + (((4 * ks + q) ^ ((r15 & 7) << 1)) << 4));
          qef[f] = *(const half8*)(cb + GLA_QE + (16 * f + r15) * 256 + (((4 * ks + q) ^ r15) << 4));
        }
#pragma unroll
        for (int kf = 0; kf < 4; ++kf)
#pragma unroll
          for (int tf = kf; tf < 4; ++tf) aT[kf][tf] = __builtin_amdgcn_mfma_f32_16x16x32_f16(kef[kf], qef[tf], aT[kf][tf], 0, 0, 0);
      }
#pragma unroll
      for (int f = 0; f < 4; ++f)
#pragma unroll
        for (int r = 0; r < 4; ++r) if (4 * q + r > r15) aT[f][f][r] = 0.f;
      }
      const unsigned lds0 = (unsigned)(size_t)cb;
      const unsigned va = lds0 + GLA_V + tr_row + ((((2 * wave) ^ fk)) << 4);
      v2i v00, v01, v10, v11;
      GLA_TR4(v00, v01, v10, v11, va, 0, 4096, 8192, 12288);
      const unsigned ka = lds0 + GLA_KE + tr_row;
      v2i k0[4][4];
#pragma unroll
      for (int df = 0; df < 4; ++df) { const unsigned a_ = ka + ((((2 * df) ^ fk)) << 4); GLA_TR4(k0[df][0], k0[df][1], k0[df][2], k0[df][3], a_, 0, 4096, 8192, 12288); }
      asm volatile("s_waitcnt lgkmcnt(15)" : "+v"(v00), "+v"(v01), "+v"(v10), "+v"(v11) :: "memory");
      __builtin_amdgcn_sched_barrier(0);
      half8 vf[2];
      vf[0] = pack_h8(v00, v01); vf[1] = pack_h8(v10, v11);
      if (!STATE_ONLY) {
      f32x4 o[4];
#pragma unroll
      for (int tf = 0; tf < 4; ++tf) o[tf] = (f32x4){0.f, 0.f, 0.f, 0.f};
#pragma unroll
      for (int ks2 = 0; ks2 < 2; ++ks2)
#pragma unroll
        for (int tf = 2 * ks2; tf < 4; ++tf) {
          half8 pk;
#pragma unroll
          for (int r = 0; r < 4; ++r) { pk[r] = (half_t)aT[2 * ks2][tf][r]; pk[4 + r] = (half_t)aT[2 * ks2 + 1][tf][r]; }
          o[tf] = __builtin_amdgcn_mfma_f32_16x16x32_f16(vf[ks2], pk, o[tf], 0, 0, 0);
        }
#pragma unroll
      for (int ks = 0; ks < 4; ++ks) {
        half8 sf;
#pragma unroll
        for (int r = 0; r < 4; ++r) { sf[r] = (half_t)S[2 * ks][r]; sf[4 + r] = (half_t)S[2 * ks + 1][r]; }
#pragma unroll
        for (int tf = 0; tf < 4; ++tf) {
          const int row = 16 * tf + r15;
          const half4 qa = *(const half4*)(cb + GLA_QE + row * 256 + (((4 * ks + (q >> 1)) ^ r15) << 4) + (q & 1) * 8);
          const half4 qb = *(const half4*)(cb + GLA_QE + row * 256 + (((4 * ks + 2 + (q >> 1)) ^ r15) << 4) + (q & 1) * 8);
          half8 qv;
#pragma unroll
          for (int e = 0; e < 4; ++e) { qv[e] = qa[e]; qv[4 + e] = qb[e]; }
          o[tf] = __builtin_amdgcn_mfma_f32_16x16x32_f16(sf, qv, o[tf], 0, 0, 0);
        }
      }
      {
        const size_t t0 = (size_t)(b * SEQ + (c0 + n) * 64);
#pragma unroll
        for (int tf = 0; tf < 4; ++tf) {
          half4 hv; hv[0] = (half_t)o[tf][0]; hv[1] = (half_t)o[tf][1]; hv[2] = (half_t)o[tf][2]; hv[3] = (half_t)o[tf][3];
          *(half4*)(P.og + (t0 + 16 * tf + r15) * DM + h * 256 + vs * 128 + 16 * wave + 4 * q) = hv;
        }
      }
      }
      v2i k1[4][4];
#pragma unroll
      for (int df = 0; df < 4; ++df) { const unsigned a_ = ka + ((((2 * (df + 4)) ^ fk)) << 4); GLA_TR4(k1[df][0], k1[df][1], k1[df][2], k1[df][3], a_, 0, 4096, 8192, 12288); }
      asm volatile("s_waitcnt lgkmcnt(15)"
                   : "+v"(k0[0][0]), "+v"(k0[0][1]), "+v"(k0[0][2]), "+v"(k0[0][3]), "+v"(k0[1][0]), "+v"(k0[1][1]), "+v"(k0[1][2]), "+v"(k0[1][3]),
                     "+v"(k0[2][0]), "+v"(k0[2][1]), "+v"(k0[2][2]), "+v"(k0[2][3]), "+v"(k0[3][0]), "+v"(k0[3][1]), "+v"(k0[3][2]), "+v"(k0[3][3]) :: "memory");
      __builtin_amdgcn_sched_barrier(0);
#pragma unroll
      for (int df = 0; df < 4; ++df) {
        S[df] = __builtin_amdgcn_mfma_f32_16x16x32_f16(pack_h8(k0[df][0], k0[df][1]), vf[0], S[df], 0, 0, 0);
        S[df] = __builtin_amdgcn_mfma_f32_16x16x32_f16(pack_h8(k0[df][2], k0[df][3]), vf[1], S[df], 0, 0, 0);
      }
      asm volatile("s_waitcnt lgkmcnt(0)"
                   : "+v"(k1[0][0]), "+v"(k1[0][1]), "+v"(k1[0][2]), "+v"(k1[0][3]), "+v"(k1[1][0]), "+v"(k1[1][1]), "+v"(k1[1][2]), "+v"(k1[1][3]),
                     "+v"(k1[2][0]), "+v"(k1[2][1]), "+v"(k1[2][2]), "+v"(k1[2][3]), "+v"(k1[3][0]), "+v"(k1[3][1]), "+v"(k1[3][2]), "+v"(k1[3][3]) :: "memory");
      __builtin_amdgcn_sched_barrier(0);
#pragma unroll
      for (int df = 0; df < 4; ++df) {
        S[df + 4] = __builtin_amdgcn_mfma_f32_16x16x32_f16(pack_h8(k1[df][0], k1[df][1]), vf[0], S[df + 4], 0, 0, 0);
        S[df + 4] = __builtin_amdgcn_mfma_f32_16x16x32_f16(pack_h8(k1[df][2], k1[df][3]), vf[1], S[df + 4], 0, 0, 0);
      }
#pragma unroll
      for (int df = 0; df < 8; ++df) {
        const f32x4 dc = *(const f32x4*)(cb + GLA_DEC + wave * 512 + (16 * df + 4 * q) * 4);
        S[df] *= dc;
        if (STATE_ONLY) Dacc[df] *= dc;
      }
    }
    if (STATE_ONLY) {
#pragma unroll
      for (int df = 0; df < 8; ++df) { stL[((size_t)seg * 64 * 8 * 8 + df) * 64] = S[df]; stD[((size_t)seg * 64 * 8 * 8 + df) * 64] = Dacc[df]; }
    }
    asm volatile("s_waitcnt vmcnt(0)" ::: "memory");
    __builtin_amdgcn_s_barrier();
#undef G_ISSUE
  }
}

__device__ void ph_gla_post(const Params& P, int wvs) {
  const int tid_ = otid(wvs); const int lane = tid_ & 63, sub = lane & 31;
  const int u0 = blockIdx.x * 16 + (tid_ >> 5);
  const float4 hn0 = ((const float4*)P.gla_head_norm)[sub * 2], hn1 = ((const float4*)P.gla_head_norm)[sub * 2 + 1];
#pragma unroll 2
  for (int u = u0; u < T_TOK * 4; u += gridDim.x * 16) {
    const int t = u >> 2, h = u & 3;
    half8* op = (half8*)(P.og + (size_t)t * DM + h * 256) + sub;
    const half8 hv = *op;
    const half8 z = *((const half8*)(P.p + (size_t)t * LD0 + 2048 + h * 256) + sub);
    float v[8]; float ss = 0.f;
#pragma unroll
    for (int e = 0; e < 8; ++e) { v[e] = (float)hv[e]; ss += v[e] * v[e]; }
#pragma unroll
    for (int o = 16; o > 0; o >>= 1) ss += __shfl_xor(ss, o);
    const float r = rsqrtf(ss * (1.f / 256.f) + EPS);
    const float hn[8] = {hn0.x, hn0.y, hn0.z, hn0.w, hn1.x, hn1.y, hn1.z, hn1.w};
    half8 o;
#pragma unroll
    for (int e = 0; e < 8; ++e) o[e] = (half_t)(v[e] * r * hn[e] * siluf((float)z[e]));
    *op = o;
  }
}

template <bool HALF_BASE>
__device__ void ph_post(const float* base, const half_t* baseh, const half_t* y, const float* g, float* dst, half_t* dsth, float* rstd_out, int wvs) {
  const int tid_ = otid(wvs); const int lane = tid_ & 63, w = tid_ >> 6;
#pragma unroll 2
  for (int row = blockIdx.x * NWAVES + w; row < T_TOK; row += gridDim.x * NWAVES) {
    const half4* yr = (const half4*)(y + (size_t)row * DM);
    float4 v[4]; float ss = 0.f;
#pragma unroll
    for (int i = 0; i < 4; ++i) {
      const half4 hv = yr[lane + 64 * i];
      v[i].x = (float)hv[0]; v[i].y = (float)hv[1]; v[i].z = (float)hv[2]; v[i].w = (float)hv[3];
      ss += v[i].x * v[i].x + v[i].y * v[i].y + v[i].z * v[i].z + v[i].w * v[i].w;
    }
    ss = wave_sum(ss);
    const float r = rsqrtf(ss * (1.f / DM) + EPS);
    float s2 = 0.f;
#pragma unroll
    for (int i = 0; i < 4; ++i) {
      const float4 gg = ((const float4*)g)[lane + 64 * i];
      float4 bb;
      if (HALF_BASE) { const half4 bh = ((const half4*)(baseh + (size_t)row * DM))[lane + 64 * i]; bb.x = (float)bh[0]; bb.y = (float)bh[1]; bb.z = (float)bh[2]; bb.w = (float)bh[3]; }
      else bb = ((const float4*)(base + (size_t)row * DM))[lane + 64 * i];
      float4 o;
      o.x = bb.x + v[i].x * r * gg.x; o.y = bb.y + v[i].y * r * gg.y; o.z = bb.z + v[i].z * r * gg.z; o.w = bb.w + v[i].w * r * gg.w;
      if (HALF_BASE) ((float4*)(dst + (size_t)row * DM))[lane + 64 * i] = o;
      else {
        s2 += o.x * o.x + o.y * o.y + o.z * o.z + o.w * o.w;
        half4 hv; hv[0] = (half_t)o.x; hv[1] = (half_t)o.y; hv[2] = (half_t)o.z; hv[3] = (half_t)o.w;
        ((half4*)(dsth + (size_t)row * DM))[lane + 64 * i] = hv;
      }
    }
    if (!HALF_BASE) { s2 = wave_sum(s2); if (lane == 0) rstd_out[row] = rsqrtf(s2 * (1.f / DM) + EPS); }
  }
}

__device__ void ph_gates(const Params& P, char* smem, int wvs, int first_block) {
  const int tid = otid(wvs), lane = tid & 63, wave = tid >> 6, r15 = lane & 15, q = lane >> 4;
  const int nb = gridDim.x - first_block;
  if ((int)blockIdx.x < first_block) return;
  for (int c = tid; c < 48 * 128; c += NTHREADS) {
    const int row = c >> 7, ch = c & 127;
    *(uint4*)(smem + row * 2064 + ch * 16) = *(const uint4*)(P.WglT + (size_t)row * DM + ch * 8);
  }
  __syncthreads();
  for (int tile = (int)blockIdx.x - first_block; tile < T_TOK / 128; tile += nb) {
    const int tok = tile * 128 + wave * 16 + r15;
    const half_t* ap = P.xh + (size_t)tok * DM + 8 * q;
    const char* bp = smem + r15 * 2064 + 16 * q;
    f32x4 acc[3] = {(f32x4){0.f, 0.f, 0.f, 0.f}, (f32x4){0.f, 0.f, 0.f, 0.f}, (f32x4){0.f, 0.f, 0.f, 0.f}};
#pragma unroll 1
    for (int s0 = 0; s0 < 32; s0 += 16) {
      half8 a[16];
#pragma unroll
      for (int i = 0; i < 16; ++i) a[i] = *(const half8*)(ap + 32 * (s0 + i));
#pragma unroll
      for (int i = 0; i < 16; ++i) {
#pragma unroll
        for (int n = 0; n < 3; ++n) {
          const half8 bw = *(const half8*)(bp + n * 16 * 2064 + (s0 + i) * 64);
          acc[n] = __builtin_amdgcn_mfma_f32_16x16x32_f16(bw, a[i], acc[n], 0, 0, 0);
        }
      }
    }
    const float rs = P.rstd[tok];
#pragma unroll
    for (int n = 0; n < 3; ++n) *(f32x4*)(P.gl + (size_t)tok * 48 + 16 * n + 4 * q) = acc[n] * rs;
  }
  __syncthreads();
}

__device__ void ph_kmax(const Params& P, int wvs, int first_block) {
  const int tid = otid(wvs);
  for (int task = (int)blockIdx.x - first_block; task < NBATCH * 4 * 2 * 8; task += gridDim.x - first_block) {
    const int chunk = task & 7, br = (task >> 3) & 1, bg = task >> 4, b = bg >> 2, g = bg & 3;
    const half_t* kp = P.p + (size_t)(b * SEQ + chunk * 512 + tid) * LD1 + (br ? 2048 : 1536) + g * 64;
    float ss = 0.f;
#pragma unroll
    for (int c = 0; c < 8; ++c) {
      const half8 v = *(const half8*)(kp + c * 8);
#pragma unroll
      for (int e = 0; e < 8; ++e) ss += (float)v[e] * (float)v[e];
    }
    ss = wave_max(ss);
    if ((tid & 63) == 0) __hip_atomic_fetch_max(&P.kmax2[bg * 2 + br], __float_as_uint(ss), __ATOMIC_RELAXED, __HIP_MEMORY_SCOPE_AGENT);
  }
}

constexpr int ATT_NB = 6, ATT_D = 5;
constexpr int ATT_K = 0, ATT_V = ATT_NB * 8192, ATT_IMP = 2 * ATT_NB * 8192, ATT_SELM = ATT_IMP + 64 * 68 * 4;
constexpr int IMPS = 68;
constexpr int ATT_GATE = ATT_SELM + 512;

__device__ __forceinline__ void attn_issue(char* smem, const half_t* kbase, const half_t* vbase, int ld, int tile_lo, int tile_hi, int wvs) {
  const int tid = otid(wvs);
  const int lrow = tid >> 3, lch = tid & 7;
  const int ksrc = (lch ^ ((lrow >> 1) & 7)) * 8, vsrc = (lch ^ (((lrow >> 1) & 3) << 1)) * 8;
  const int wbase = __builtin_amdgcn_readfirstlane(tid >> 6) * 1024;
#pragma unroll
  for (int i = 0; i < ATT_D; ++i) if (tile_lo + i <= tile_hi) {
    const half_t* kp_ = kbase + (size_t)((tile_lo + i) * 64 + lrow) * ld + ksrc;
    const half_t* vp_ = vbase + (size_t)((tile_lo + i) * 64 + lrow) * ld + vsrc;
    __builtin_amdgcn_global_load_lds((gbl_void*)kp_, (lds_void*)(smem + ATT_K + i * 8192 + wbase), 16, 0, 0);
    __builtin_amdgcn_global_load_lds((gbl_void*)vp_, (lds_void*)(smem + ATT_V + i * 8192 + wbase), 16, 0, 0);
  }
}

template <int MODE, bool PREISSUED = false>
__device__ __forceinline__ void attn_branch(char* smem, const half_t* kbase, const half_t* vbase, int ld, int tile_lo, int tile_hi, int n, int th,
                                            const half8 (&qf)[2][2], float (&m)[2], float (&l)[2], f32x4 (&o)[4][2],
                                            const unsigned long long (&selm)[2], int wvs) {
  const int tid = otid(wvs);
  const int lane = tid & 63, r15 = lane & 15, q = lane >> 4;
  const int lrow = tid >> 3, lch = tid & 7;
  const int k_rd = r15 * 128, kswz = r15 >> 1;
  const int qp = r15 >> 2, pp = lane & 3;
  const int fx = ((2 * q + (qp >> 1)) & 3) << 1;
  const int v_rd = (4 * q + qp) * 128 + 8 * (pp & 1) + ((pp >> 1) << 4);
  unsigned int* impu = (unsigned int*)(smem + ATT_IMP);
  const int ksrc = (lch ^ ((lrow >> 1) & 7)) * 8, vsrc = (lch ^ (((lrow >> 1) & 3) << 1)) * 8;
  const int wbase = __builtin_amdgcn_readfirstlane(tid >> 6) * 1024;
#define A_GLOAD(TI, BUF) { const half_t* kp_ = kbase + (size_t)((TI) * 64 + lrow) * ld + ksrc; \
    __builtin_amdgcn_global_load_lds((gbl_void*)kp_, (lds_void*)(smem + ATT_K + (BUF) * 8192 + wbase), 16, 0, 0); \
    { const half_t* vp_ = vbase + (size_t)((TI) * 64 + lrow) * ld + vsrc; \
      __builtin_amdgcn_global_load_lds((gbl_void*)vp_, (lds_void*)(smem + ATT_V + (BUF) * 8192 + wbase), 16, 0, 0); } }
  constexpr int GPT = 2;
  f32x4 lacc[2] = {(f32x4){0.f, 0.f, 0.f, 0.f}, (f32x4){0.f, 0.f, 0.f, 0.f}};
  if (MODE != 1 && !PREISSUED) {
#pragma unroll
    for (int i = 0; i < ATT_D; ++i) if (tile_lo + i <= tile_hi) A_GLOAD(tile_lo + i, i)
  }
#pragma unroll 1
  for (int ti = tile_lo; ti <= tile_hi; ++ti) {
    const int it = ti - tile_lo, cur = it % ATT_NB;
    if (MODE != 1) {
      const int rem = tile_hi - ti;
      if (rem >= 4) wait_vmcnt<4 * GPT>(); else if (rem == 3) wait_vmcnt<3 * GPT>(); else if (rem == 2) wait_vmcnt<2 * GPT>();
      else if (rem == 1) wait_vmcnt<1 * GPT>(); else wait_vmcnt<0>();
    }
    __builtin_amdgcn_s_barrier();
    if (MODE != 1) { if (ti + ATT_D <= tile_hi) A_GLOAD(ti + ATT_D, (it + ATT_D) % ATT_NB) }
    const char* kb = smem + ATT_K + cur * 8192 + k_rd;
    const unsigned vbl = (unsigned)(size_t)(smem + ATT_V + cur * 8192 + v_rd);
    bool need_mask;
    if (MODE <= 1) need_mask = (ti * 64 + 63 > 4 * n - 2);
    else if (MODE == 2) need_mask = (ti == n);
    else need_mask = (ti == n) || (ti == n - 8);
    f32x4 s[4][2];
#pragma unroll
    for (int t2 = 0; t2 < 2; ++t2) {
      float c0 = 0.f;
      if (MODE >= 2) { c0 = -m[t2]; if (MODE == 2 && !((selm[t2] >> ti) & 1ull)) c0 = -INFINITY; }
#pragma unroll
      for (int kf = 0; kf < 4; ++kf) s[kf][t2] = (f32x4){c0, c0, c0, c0};
    }
#pragma unroll
    for (int ks = 0; ks < 2; ++ks) {
      const int co = ((4 * ks + q) ^ kswz) << 4;
#pragma unroll
      for (int kf = 0; kf < 4; ++kf) {
        const half8 kfr = *(const half8*)(kb + kf * 2048 + co);
#pragma unroll
        for (int t2 = 0; t2 < 2; ++t2) s[kf][t2] = __builtin_amdgcn_mfma_f32_16x16x32_f16(kfr, qf[t2][ks], s[kf][t2], 0, 0, 0);
      }
    }
    v2i vr[4][4];
    if (MODE != 0) {
      const unsigned va0 = vbl + (((0) ^ fx) << 4), va1 = vbl + (((2) ^ fx) << 4), va2 = vbl + (((4) ^ fx) << 4), va3 = vbl + (((6) ^ fx) << 4);
      asm volatile(
          "ds_read_b64_tr_b16 %0, %16\n\tds_read_b64_tr_b16 %1, %16 offset:2048\n\tds_read_b64_tr_b16 %2, %16 offset:4096\n\tds_read_b64_tr_b16 %3, %16 offset:6144\n\t"
          "ds_read_b64_tr_b16 %4, %17\n\tds_read_b64_tr_b16 %5, %17 offset:2048\n\tds_read_b64_tr_b16 %6, %17 offset:4096\n\tds_read_b64_tr_b16 %7, %17 offset:6144\n\t"
          "ds_read_b64_tr_b16 %8, %18\n\tds_read_b64_tr_b16 %9, %18 offset:2048\n\tds_read_b64_tr_b16 %10, %18 offset:4096\n\tds_read_b64_tr_b16 %11, %18 offset:6144\n\t"
          "ds_read_b64_tr_b16 %12, %19\n\tds_read_b64_tr_b16 %13, %19 offset:2048\n\tds_read_b64_tr_b16 %14, %19 offset:4096\n\tds_read_b64_tr_b16 %15, %19 offset:6144"
          : "=&v"(vr[0][0]), "=&v"(vr[0][1]), "=&v"(vr[0][2]), "=&v"(vr[0][3]), "=&v"(vr[1][0]), "=&v"(vr[1][1]), "=&v"(vr[1][2]), "=&v"(vr[1][3]),
            "=&v"(vr[2][0]), "=&v"(vr[2][1]), "=&v"(vr[2][2]), "=&v"(vr[2][3]), "=&v"(vr[3][0]), "=&v"(vr[3][1]), "=&v"(vr[3][2]), "=&v"(vr[3][3])
          : "v"(va0), "v"(va1), "v"(va2), "v"(va3)
          : "memory");
    }
    if (need_mask) {
#pragma unroll
      for (int t2 = 0; t2 < 2; ++t2) {
        const int tok = th * 32 + t2 * 16 + r15;
        int lo = 0, hi = 63;
        if (MODE <= 1) { hi = 4 * n + ((tok - 31) >> 4) - ti * 64; }
        else if (MODE == 2) { hi = tok; }
        else { if (ti == n) hi = tok; else lo = tok + 1; }
#pragma unroll
        for (int kf = 0; kf < 4; ++kf)
#pragma unroll
          for (int r = 0; r < 4; ++r) {
            const int kk = kf * 16 + 4 * q + r;
            if (kk < lo || kk > hi) s[kf][t2][r] = -INFINITY;
          }
      }
    }
    half8 pf[2][2];
#pragma unroll
    for (int t2 = 0; t2 < 2; ++t2) {
      float mb = 0.f, scale_p = 1.f;
      if (MODE == 1) {
        mb = m[t2]; scale_p = l[t2];
      } else if (MODE == 0) {
        float tm = s[0][t2][0];
#pragma unroll
        for (int kf = 0; kf < 4; ++kf)
#pragma unroll
          for (int r = 0; r < 4; ++r) tm = fmaxf(tm, s[kf][t2][r]);
        tm = rowmax4(tm);
        const float mn = fmaxf(m[t2], tm);
        const float alpha = fexp2(m[t2] - mn);
        m[t2] = mn; mb = mn;
        l[t2] *= alpha;
      }
      float lsum = 0.f;
#pragma unroll
      for (int kf = 0; kf < 4; ++kf) {
#pragma unroll
        for (int r = 0; r < 4; ++r) {
          float pv = (MODE >= 2) ? fexp2(s[kf][t2][r]) : fexp2(s[kf][t2][r] - mb);
          if (MODE == 1) pv *= scale_p;
          s[kf][t2][r] = pv; if (MODE == 0) lsum += pv;
        }
      }
      if (MODE == 0) l[t2] += lsum;
      if (MODE == 1) {
        const int tok = th * 32 + t2 * 16 + r15;
#pragma unroll
        for (int kf = 0; kf < 4; ++kf) {
          const int j = 16 * ti + 4 * kf + q;
          const unsigned int u0 = (unsigned int)(s[kf][t2][0] * 134217728.f + 0.5f), u1 = (unsigned int)(s[kf][t2][1] * 134217728.f + 0.5f);
          const unsigned int u2 = (unsigned int)(s[kf][t2][2] * 134217728.f + 0.5f), u3 = (unsigned int)(s[kf][t2][3] * 134217728.f + 0.5f);
          if (j < 64) {
            atomicAdd(&impu[tok * IMPS + j], u0 + u1 + u2 + u3);
            atomicAdd(&impu[tok * IMPS + j + 1], u3);
          }
        }
      }
      if (MODE != 0) {
#pragma unroll
        for (int ks = 0; ks < 2; ++ks) {
          half8 pk;
#pragma unroll
          for (int r = 0; r < 4; ++r) { pk[r] = (half_t)s[2 * ks][t2][r]; pk[4 + r] = (half_t)s[2 * ks + 1][t2][r]; }
          pf[t2][ks] = pk;
        }
      }
    }
    if (MODE != 0) {
      asm volatile("s_waitcnt lgkmcnt(0)"
                   : "+v"(vr[0][0]), "+v"(vr[0][1]), "+v"(vr[0][2]), "+v"(vr[0][3]), "+v"(vr[1][0]), "+v"(vr[1][1]), "+v"(vr[1][2]), "+v"(vr[1][3]),
                     "+v"(vr[2][0]), "+v"(vr[2][1]), "+v"(vr[2][2]), "+v"(vr[2][3]), "+v"(vr[3][0]), "+v"(vr[3][1]), "+v"(vr[3][2]), "+v"(vr[3][3])
                   :: "memory");
      __builtin_amdgcn_sched_barrier(0);
#pragma unroll
      for (int df = 0; df < 4; ++df) {
#pragma unroll
        for (int ks = 0; ks < 2; ++ks) {
          const v2i lo2 = vr[df][2 * ks], hi2 = vr[df][2 * ks + 1];
          const v4i pk4 = (v4i){lo2[0], lo2[1], hi2[0], hi2[1]};
          const half8 vf = __builtin_bit_cast(half8, pk4);
#pragma unroll
          for (int t2 = 0; t2 < 2; ++t2) o[df][t2] = __builtin_amdgcn_mfma_f32_16x16x32_f16(vf, pf[t2][ks], o[df][t2], 0, 0, 0);
        }
      }
      if (MODE >= 2) {
        const half8 ones = (half8){(half_t)1.f, (half_t)1.f, (half_t)1.f, (half_t)1.f, (half_t)1.f, (half_t)1.f, (half_t)1.f, (half_t)1.f};
#pragma unroll
        for (int ks = 0; ks < 2; ++ks)
#pragma unroll
          for (int t2 = 0; t2 < 2; ++t2) lacc[t2] = __builtin_amdgcn_mfma_f32_16x16x32_f16(ones, pf[t2][ks], lacc[t2], 0, 0, 0);
      }
    }
  }
  if (MODE >= 2) { l[0] = lacc[0][0]; l[1] = lacc[1][0]; }
  __syncthreads();
#undef A_GLOAD
}

__device__ void ph_attn_mfma(const Params& P, char* smem, int wvs) {
  unsigned int* impu = (unsigned int*)(smem + ATT_IMP);
  unsigned long long* selmask = (unsigned long long*)(smem + ATT_SELM);
  const int G = gridDim.x, nrounds = (2048 + G - 1) / G;
  for (int rd = 0; rd < nrounds; ++rd) {
    const int idx = rd * G + ((rd & 1) ? (G - 1 - (int)blockIdx.x) : (int)blockIdx.x);
    if (idx >= 2048) continue;
    const int tid = otid(wvs), lane = tid & 63, r15 = lane & 15, q = lane >> 4;
    const int n = 63 - (idx >> 5), bg = idx & 31, b = bg >> 2, g = bg & 3;
    const int wv = __builtin_amdgcn_readfirstlane(otid(wvs) >> 6);
    const int hd = g * 4 + (wv & 3), th = wv >> 2;
    const int t0 = b * SEQ + n * 64 + th * 32;
    const half_t* kc = P.kcmp + (size_t)bg * 256 * 64;
    const half_t* vc = P.vcmp + (size_t)bg * 256 * 64;
    const int nct = (4 * n + 2) / 64;
    attn_issue(smem, kc, vc, 64, 0, nct, wvs);
    half8 qf[2][2];
#pragma unroll
    for (int t2 = 0; t2 < 2; ++t2)
#pragma unroll
      for (int ks = 0; ks < 2; ++ks) qf[t2][ks] = *(const half8*)(P.p + (size_t)(t0 + t2 * 16 + r15) * LD1 + hd * 64 + 32 * ks + 8 * q);
    float* gate_l = (float*)(smem + ATT_GATE) + wv * 128;
    if (q == 0) {
#pragma unroll
      for (int t2 = 0; t2 < 2; ++t2) {
        const float* pr = P.gl + (size_t)(t0 + t2 * 16 + r15) * 48 + hd * 3;
        f32x4 gv;
#pragma unroll
        for (int c = 0; c < 3; ++c) gv[c] = sigmoidf(pr[c] + P.nsa_b_gate[hd * 3 + c]);
        gv[3] = 0.f;
        *(f32x4*)(gate_l + (t2 * 16 + r15) * 4) = gv;
      }
    }
    { const int tz = otid(wvs); for (int i = tz; i < 64 * IMPS + 128; i += NTHREADS) impu[i] = 0u; }
    float m[2], l[2]; f32x4 o[4][2]; unsigned long long selm[2] = {0ull, 0ull};
#pragma unroll
    for (int t2 = 0; t2 < 2; ++t2) { m[t2] = -1e30f; l[t2] = 0.f; }
#pragma unroll
    for (int df = 0; df < 4; ++df)
#pragma unroll
      for (int t2 = 0; t2 < 2; ++t2) o[df][t2] = (f32x4){0.f, 0.f, 0.f, 0.f};
    attn_branch<0, true>(smem, kc, vc, 64, 0, nct, n, th, qf, m, l, o, selm, wvs);
#pragma unroll
    for (int t2 = 0; t2 < 2; ++t2) {
      float lt = l[t2];
      lt = rowsum4(lt);
      l[t2] = lt > 0.f ? 1.f / lt : 0.f;
    }
    attn_branch<1>(smem, kc, vc, 64, 0, nct, n, th, qf, m, l, o, selm, wvs);
    f32x4 oacc[4][2];
#pragma unroll
    for (int t2 = 0; t2 < 2; ++t2) {
      const float gc = gate_l[(t2 * 16 + r15) * 4 + 0];
#pragma unroll
      for (int df = 0; df < 4; ++df) oacc[df][t2] = o[df][t2] * gc;
    }
    attn_issue(smem, P.p + (size_t)b * SEQ * LD1 + 1536 + g * 64, P.p + (size_t)b * SEQ * LD1 + 1792 + g * 64, LD1, 0, n, wvs);
    {
      const int tid2 = otid(wvs);
      const int tok = tid2 >> 3, part = tid2 & 7;
      unsigned long long msk;
      if (n + 1 <= 16) {
        msk = (1ull << (n + 1)) - 1ull;
      } else {
        const uint4* rowp = (const uint4*)(impu + tok * IMPS);
        unsigned own[8];
        { const uint4 a = rowp[part * 2], b2 = rowp[part * 2 + 1];
          own[0] = a.x; own[1] = a.y; own[2] = a.z; own[3] = a.w; own[4] = b2.x; own[5] = b2.y; own[6] = b2.z; own[7] = b2.w; }
        int rank[8];
#pragma unroll
        for (int jj = 0; jj < 8; ++jj) {
          const int j = part * 8 + jj;
          own[jj] = (j >= 1 && j <= n - 2) ? ((own[jj] & ~63u) | (unsigned)(63 - j)) : 0xffffffffu;
          rank[jj] = 0;
        }
#pragma unroll 2
        for (int c4 = 0; c4 < 16; ++c4) {
          const uint4 v = rowp[c4];
          unsigned kv[4] = {v.x, v.y, v.z, v.w};
#pragma unroll
          for (int e = 0; e < 4; ++e) {
            const int j2 = c4 * 4 + e;
            const unsigned key2 = (j2 >= 1 && j2 <= n - 2) ? ((kv[e] & ~63u) | (unsigned)(63 - j2)) : 0u;
#pragma unroll
            for (int jj = 0; jj < 8; ++jj) rank[jj] += (key2 > own[jj]) ? 1 : 0;
          }
        }
        unsigned int bits = 0;
#pragma unroll
        for (int jj = 0; jj < 8; ++jj) if (rank[jj] < 13 && own[jj] != 0xffffffffu) bits |= 1u << jj;
        unsigned* sel32 = (unsigned*)selmask;
        if (bits) atomicOr(&sel32[tok * 2 + (part >> 2)], bits << (8 * (part & 3)));
        msk = 1ull | (1ull << n) | (1ull << (n - 1));
        if (part == 0) { atomicOr(&sel32[tok * 2], (unsigned)msk); atomicOr(&sel32[tok * 2 + 1], (unsigned)(msk >> 32)); }
      }
      if (n + 1 <= 16 && part == 0) selmask[tok] = msk;
    }
    __syncthreads();
#pragma unroll
    for (int t2 = 0; t2 < 2; ++t2) selm[t2] = selmask[th * 32 + t2 * 16 + r15];
    float qn2[2];
#pragma unroll
    for (int t2 = 0; t2 < 2; ++t2) {
      float a = 0.f;
#pragma unroll
      for (int ks = 0; ks < 2; ++ks)
#pragma unroll
        for (int e = 0; e < 8; ++e) a += (float)qf[t2][ks][e] * (float)qf[t2][ks][e];
      qn2[t2] = rowsum4(a);
    }
    { const float km = __uint_as_float(P.kmax2[bg * 2 + 0]);
#pragma unroll
      for (int t2 = 0; t2 < 2; ++t2) { m[t2] = sqrtf(qn2[t2] * km) * 1.001f - 5.0f * LOG2E; l[t2] = 0.f; } }
#pragma unroll
    for (int df = 0; df < 4; ++df)
#pragma unroll
      for (int t2 = 0; t2 < 2; ++t2) o[df][t2] = (f32x4){0.f, 0.f, 0.f, 0.f};
    attn_branch<2, true>(smem, P.p + (size_t)b * SEQ * LD1 + 1536 + g * 64, P.p + (size_t)b * SEQ * LD1 + 1792 + g * 64, LD1, 0, n, n, th, qf, m, l, o, selm, wvs);
#pragma unroll
    for (int t2 = 0; t2 < 2; ++t2) {
      const float gs = gate_l[(t2 * 16 + r15) * 4 + 1] / l[t2];
#pragma unroll
      for (int df = 0; df < 4; ++df) oacc[df][t2] += o[df][t2] * gs;
    }
    { const float km = __uint_as_float(P.kmax2[bg * 2 + 1]);
#pragma unroll
      for (int t2 = 0; t2 < 2; ++t2) { m[t2] = sqrtf(qn2[t2] * km) * 1.001f - 5.0f * LOG2E; l[t2] = 0.f; } }
#pragma unroll
    for (int df = 0; df < 4; ++df)
#pragma unroll
      for (int t2 = 0; t2 < 2; ++t2) o[df][t2] = (f32x4){0.f, 0.f, 0.f, 0.f};
    attn_branch<3>(smem, P.p + (size_t)b * SEQ * LD1 + 2048 + g * 64, P.p + (size_t)b * SEQ * LD1 + 2304 + g * 64, LD1, (n > 8 ? n - 8 : 0), n, n, th, qf, m, l, o, selm, wvs);
    {
      int tbase = t0 + r15; asm volatile("" : "+v"(tbase));
#pragma unroll
      for (int t2 = 0; t2 < 2; ++t2) {
        const size_t tok = (size_t)(tbase + t2 * 16);
        const float gw = gate_l[(t2 * 16 + r15) * 4 + 2] / l[t2];
#pragma unroll
        for (int df = 0; df < 4; ++df) {
          const f32x4 v = oacc[df][t2] + o[df][t2] * gw;
          const half4 z = *(const half4*)(P.p + tok * LD1 + 2560 + hd * 64 + df * 16 + 4 * q);
          half4 hv;
#pragma unroll
          for (int e = 0; e < 4; ++e) hv[e] = (half_t)(v[e] * siluf((float)z[e]));
          *(half4*)(P.og + tok * DM + hd * 64 + df * 16 + 4 * q) = hv;
        }
      }
    }
  }
}

constexpr int NPHASES = 13;
__device__ __forceinline__ void run_phase(int ph, const Params& P, char* smem, int wvs) {
  float* sm = (float*)smem;
  switch (ph) {
    case 0:
      if (blockIdx.x == 0 && otid(wvs) < 64) P.kmax2[otid(wvs)] = 0u;
      ph_xh_rstd(P.x, P.xh, P.rstd, wvs); ph_ropetab(P, wvs); prep_cbias_part(P, wvs);
      prep_weights(P, sm, wvs);
      prep_wT(P.nsa_w_in, NSA_IN, P.pre_norm + DM, P.WglT, 64, DM, 5, sm, wvs);
      break;
    case 1: g8::gemm(g8::SrcPlain8{P.xh, DM, P.W0t, DM}, T_TOK, LD0, DM, g8::EpiStore8{P.p, LD0, P.rstd}, smem, wvs); break;
    case 2: prep_cbias_reduce(P, wvs); ph_gla_prep(P, sm, wvs); break;
    case 13: ph_gla_mfma<true>(P, smem, wvs); break;
    case 3: ph_gla_mfma<false>(P, smem, wvs); break;
    case 4: ph_gla_post(P, wvs); break;
    case 5: g8::gemm(g8::SrcPlain8{P.og, DM, P.Wo0t, DM}, T_TOK, DM, DM, g8::EpiStore8{P.y, DM, nullptr}, smem, wvs); break;
    case 6: ph_post<false>(P.x, nullptr, P.y, P.post_norm, nullptr, P.xh, P.rstd, wvs); break;
    case 7: g8::gemm(g8::SrcPlain8{P.xh, DM, P.W1t, DM}, T_TOK, LD1, DM, g8::EpiRope8{P.p, LD1, P.rstd, P.ropetab}, smem, wvs); break;
    case 8:
      if (blockIdx.x >= 64) { ph_kmax(P, wvs, 64); ph_gates(P, smem, wvs, 64); }
      g8::gemm(g8::SrcCmp1_8{P.p, P.cw1t}, 16384, 256, 2048, g8::EpiCmpHid8{P.hid, P.cbias}, smem, wvs);
      asm volatile("s_waitcnt vmcnt(0)" ::: "memory");
      __syncthreads();
      g8::gemm(g8::SrcCmp2_8{P.hid, P.cw2t}, 16384, 256, 256, g8::EpiCmpOut8{P.kcmp, P.vcmp}, smem, wvs);
      break;
    case 10: ph_attn_mfma(P, smem, wvs); break;
    case 11: g8::gemm(g8::SrcPlain8{P.og, DM, P.Wo1t, DM}, T_TOK, DM, DM, g8::EpiStore8{P.y, DM, nullptr}, smem, wvs); break;
    case 12: ph_post<true>(nullptr, P.x1h, P.y, P.post_norm + DM, P.out, nullptr, nullptr, wvs); break;
  }
}

template <int PH>
__global__ void __launch_bounds__(NTHREADS, 2) k_phase(Params P) {
  __shared__ __attribute__((aligned(16))) char smem[SMEM_BYTES];
  run_phase(PH, P, smem, __builtin_amdgcn_readfirstlane(threadIdx.x >> 6));
}
template <int PH>
static void launch_phases(const Params& P, hipStream_t stream) {
  hipLaunchKernelGGL((k_phase<PH>), dim3(256), dim3(NTHREADS), 0, stream, P);
  if constexpr (PH + 1 < NPHASES) launch_phases<PH + 1>(P, stream);
}

#if MEGA
__global__ void __launch_bounds__(NTHREADS, 2) k_mega(Params P) {
  __shared__ __attribute__((aligned(16))) char smem[SMEM_BYTES];
  cg::grid_group grid = cg::this_grid();
  if (P.use_cg_sync) grid.sync();
  unsigned bt = 0;
  const int wvs = __builtin_amdgcn_readfirstlane(threadIdx.x >> 6);
  run_phase(0, P, smem, wvs); fast_barrier(P.bar, bt, wvs);
  run_phase(1, P, smem, wvs); fast_barrier(P.bar, bt, wvs);
  run_phase(2, P, smem, wvs); fast_barrier(P.bar, bt, wvs);
  run_phase(13, P, smem, wvs); fast_barrier(P.bar, bt, wvs);
  run_phase(3, P, smem, wvs); fast_barrier(P.bar, bt, wvs);
  run_phase(4, P, smem, wvs); fast_barrier(P.bar, bt, wvs);
  run_phase(5, P, smem, wvs); fast_barrier(P.bar, bt, wvs);
  run_phase(6, P, smem, wvs); fast_barrier(P.bar, bt, wvs);
  run_phase(7, P, smem, wvs); fast_barrier(P.bar, bt, wvs);
  run_phase(8, P, smem, wvs); fast_barrier(P.bar, bt, wvs);
  run_phase(10, P, smem, wvs); fast_barrier(P.bar, bt, wvs);
  run_phase(11, P, smem, wvs); fast_barrier(P.bar, bt, wvs);
  run_phase(12, P, smem, wvs);
}
#endif

extern "C" void kernel_launch(void* const* d_in, const int* in_sizes, int n_in, void* d_out, int out_size, void* d_ws, size_t ws_size,
                              hipStream_t stream) {
  Params P{};
  P.x = (const float*)d_in[0]; P.pos = (const int*)d_in[1]; P.pre_norm = (const float*)d_in[2]; P.post_norm = (const float*)d_in[3];
  P.gla_w_in = (const float*)d_in[4]; P.gla_w_gk_up = (const float*)d_in[5]; P.gla_b_gk = (const float*)d_in[6];
  P.gla_head_norm = (const float*)d_in[7]; P.gla_w_out = (const float*)d_in[8];
  P.nsa_w_in = (const float*)d_in[9]; P.nsa_b_gate = (const float*)d_in[10]; P.nsa_pe_k = (const float*)d_in[11]; P.nsa_pe_v = (const float*)d_in[12];
  P.ck_w1 = (const float*)d_in[13]; P.ck_w2 = (const float*)d_in[14]; P.cv_w1 = (const float*)d_in[15]; P.cv_w2 = (const float*)d_in[16];
  P.nsa_w_out = (const float*)d_in[17];
  P.out = (float*)d_out;
  char* ws = (char*)d_ws;
  const size_t MB = 1024 * 1024;
  P.W0t = (half_t*)(ws);
  P.Wo0t = (half_t*)(ws + 7 * MB);
  P.W1t = (half_t*)(ws + 9 * MB);
  P.Wo1t = (half_t*)(ws + 17 * MB);
  P.cw1t = (half_t*)(ws + 19 * MB);
  P.cw2t = (half_t*)(ws + 21 * MB);
  P.cbias = (float*)(ws + 22 * MB);
  P.cbias_part = (float*)(ws + 22 * MB + 4096);
  P.bar = (unsigned*)(ws + 23 * MB);
  P.use_cg_sync = 0;
  P.kmax2 = (unsigned*)(ws + 22 * MB + 512 * 1024);
  P.xh = (half_t*)(ws + 24 * MB);
  P.x1h = P.xh;
  P.p = (half_t*)(ws + 88 * MB);
  P.y = (half_t*)(ws + 88 * MB);
  P.og = (half_t*)(ws + 328 * MB);
  P.bcum = (float*)(ws + 392 * MB);
  P.rstd = (float*)(ws + 456 * MB);
  P.kcmp = (half_t*)(ws + 457 * MB);
  P.vcmp = (half_t*)(ws + 458 * MB);
  P.ropetab = (float*)(ws + 459 * MB);
  P.hid = (half_t*)(ws + 467 * MB);
  P.WglT = (half_t*)(ws + 22 * MB + 768 * 1024);
  P.gl = (float*)(ws + 503 * MB);
  P.gla_state = (float*)(ws + 476 * MB);
  if (ws_size < 510 * MB) { fprintf(stderr, "ws too small: %zu\n", ws_size); return; }
#if MEGA
  static int grid_blocks = 0;
  if (!grid_blocks) {
    int dev = 0, cus = 0, per_cu = 0;
    hipGetDevice(&dev);
    hipDeviceGetAttribute(&cus, hipDeviceAttributeMultiprocessorCount, dev);
    hipOccupancyMaxActiveBlocksPerMultiprocessor(&per_cu, k_mega, NTHREADS, 0);
    if (per_cu < 1) per_cu = 1;
    if (per_cu > 1) per_cu = 1;
    grid_blocks = cus * per_cu;
  }
  hipMemsetAsync(ws + 23 * MB, 0, 16384, stream);
  void* args[] = {&P};
  hipError_t e = hipLaunchCooperativeKernel((void*)k_mega, dim3(grid_blocks), dim3(NTHREADS), args, 0, stream);
  if (e != hipSuccess) fprintf(stderr, "cooperative launch failed: %s (grid %d)\n", hipGetErrorString(e), grid_blocks);
#else
  launch_phases<0>(P, stream);
#endif
}
```

```cpp
#include <hip/hip_runtime.h>
#include <hip/hip_cooperative_groups.h>
#include <cstdio>
#include <cstdint>
namespace cg = cooperative_groups;

typedef _Float16 half_t;
typedef _Float16 half8 __attribute__((ext_vector_type(8)));
typedef _Float16 half4 __attribute__((ext_vector_type(4)));
typedef float f32x4 __attribute__((ext_vector_type(4)));
typedef int v2i __attribute__((ext_vector_type(2)));
typedef int v4i __attribute__((ext_vector_type(4)));

#ifndef MEGA
#define MEGA 1
#endif

constexpr int T_TOK = 32768, DM = 1024, SEQ = 4096, NBATCH = 8;
constexpr int GLA_IN = 3088, NSA_IN = 3632;
constexpr int LD0 = 3072, LD1 = 3584;
constexpr int NC = 255;
constexpr float EPS = 1e-6f;
constexpr int NTHREADS = 512, NWAVES = NTHREADS / 64;
constexpr int SMEM_BYTES = 160 * 1024;

struct Params {
  const float* x; const int* pos; const float* pre_norm; const float* post_norm;
  const float* gla_w_in; const float* gla_w_gk_up; const float* gla_b_gk; const float* gla_head_norm; const float* gla_w_out;
  const float* nsa_w_in; const float* nsa_b_gate; const float* nsa_pe_k; const float* nsa_pe_v;
  const float* ck_w1; const float* ck_w2; const float* cv_w1; const float* cv_w2; const float* nsa_w_out;
  float* out;
  half_t* p; half_t* y; half_t* og; float* bcum; float* rstd; half_t* kcmp; half_t* vcmp; float* ropetab;
  half_t* xh; half_t* W0t; half_t* Wo0t; half_t* W1t; half_t* Wo1t;
  half_t* cw1t; half_t* cw2t; float* cbias; half_t* hid;
  float* cbias_part; unsigned* bar; long long use_cg_sync; unsigned* kmax2; float* gla_state; half_t* WglT; float* gl; half_t* x1h; half_t* WglrT; float* glr;
};

__device__ __forceinline__ int lane_id() { return (int)__builtin_amdgcn_mbcnt_hi(~0u, __builtin_amdgcn_mbcnt_lo(~0u, 0u)); }
__device__ __forceinline__ int otid(int wvs) { int t = wvs * 64 + lane_id(); asm volatile("" : "+v"(t)); return t; }
__device__ __forceinline__ float wave_sum(float v) {
#pragma unroll
  for (int o = 32; o > 0; o >>= 1) v += __shfl_xor(v, o);
  return v;
}
__device__ __forceinline__ float wave_max(float v) {
#pragma unroll
  for (int o = 32; o > 0; o >>= 1) v = fmaxf(v, __shfl_xor(v, o));
  return v;
}
typedef __attribute__((address_space(3))) void lds_void;
typedef __attribute__((address_space(1))) const void gbl_void;
typedef short s16x4 __attribute__((vector_size(8)));
typedef __attribute__((address_space(3))) s16x4 lds_s16x4;
__device__ __forceinline__ half4 tr_read4(const char* p) {
  const s16x4 v = __builtin_amdgcn_ds_read_tr16_b64_v4i16((lds_s16x4*)(p));
  return __builtin_bit_cast(half4, v);
}
template <int N> __device__ __forceinline__ void wait_vmcnt() { asm volatile("s_waitcnt vmcnt(%0)" ::"n"(N) : "memory"); }
constexpr float LOG2E = 1.4426950408889634f;
__device__ __forceinline__ float fexp2(float x) { return __builtin_amdgcn_exp2f(x); }
typedef unsigned u32x2 __attribute__((ext_vector_type(2)));
__device__ __forceinline__ float rowmax4(float x) {
  u32x2 r = __builtin_amdgcn_permlane16_swap(__float_as_uint(x), __float_as_uint(x), false, false);
  x = fmaxf(__uint_as_float(r[0]), __uint_as_float(r[1]));
  r = __builtin_amdgcn_permlane32_swap(__float_as_uint(x), __float_as_uint(x), false, false);
  return fmaxf(__uint_as_float(r[0]), __uint_as_float(r[1]));
}
__device__ __forceinline__ float rowsum4(float x) {
  u32x2 r = __builtin_amdgcn_permlane16_swap(__float_as_uint(x), __float_as_uint(x), false, false);
  x = __uint_as_float(r[0]) + __uint_as_float(r[1]);
  r = __builtin_amdgcn_permlane32_swap(__float_as_uint(x), __float_as_uint(x), false, false);
  return __uint_as_float(r[0]) + __uint_as_float(r[1]);
}
__device__ __forceinline__ float fast_exp2(float x) { return __builtin_amdgcn_exp2f(x); }
__device__ __forceinline__ float sigmoidf(float v) { return __builtin_amdgcn_rcpf(1.f + fast_exp2(-1.4426950408889634f * v)); }
__device__ __forceinline__ float siluf(float v) { return v * sigmoidf(v); }
__device__ __forceinline__ float logsigmoidf(float u) { return fminf(u, 0.f) - 0.6931471805599453f * __builtin_amdgcn_logf(1.f + fast_exp2(-1.4426950408889634f * fabsf(u))); }

__device__ __forceinline__ void fast_barrier(unsigned* bar, unsigned& round, int wvs) {
  asm volatile("s_waitcnt vmcnt(0) lgkmcnt(0)" ::: "memory");
  __syncthreads();
  round += 1;
  if (wvs == 0 && lane_id() == 0) {
    __builtin_amdgcn_fence(__ATOMIC_RELEASE, "agent");
    asm volatile("s_waitcnt vmcnt(0)" ::: "memory");
    const unsigned ngroups = gridDim.x >> 4;
    const unsigned old = __hip_atomic_fetch_add(bar + 64 + 64 * (blockIdx.x >> 4), 1u, __ATOMIC_RELAXED, __HIP_MEMORY_SCOPE_AGENT);
    if (old + 1 == round * 16u) __hip_atomic_fetch_add(bar, 1u, __ATOMIC_RELAXED, __HIP_MEMORY_SCOPE_AGENT);
    const unsigned target = round * ngroups;
    while (__hip_atomic_load(bar, __ATOMIC_RELAXED, __HIP_MEMORY_SCOPE_AGENT) < target) { }
    __builtin_amdgcn_fence(__ATOMIC_ACQUIRE, "agent");
    asm volatile("s_waitcnt vmcnt(0)" ::: "memory");
  }
  __syncthreads();
}

__device__ void ph_xh_rstd(const float* src, half_t* xh, float* rstd, int wvs) {
  const int tid_ = otid(wvs); const int lane = tid_ & 63, w = tid_ >> 6;
  constexpr int RW = 4;
  const int rstride = gridDim.x * NWAVES;
#pragma unroll 1
  for (int row0 = blockIdx.x * NWAVES + w; row0 < T_TOK; row0 += rstride * RW) {
    float4 v[RW][4];
#pragma unroll
    for (int r = 0; r < RW; ++r)
#pragma unroll
      for (int i = 0; i < 4; ++i) v[r][i] = ((const float4*)(src + (size_t)(row0 + r * rstride) * DM))[lane + 64 * i];
#pragma unroll
    for (int r = 0; r < RW; ++r) {
      const int row = row0 + r * rstride;
      half4* xr = (half4*)(xh + (size_t)row * DM);
      float ss = 0.f;
#pragma unroll
      for (int i = 0; i < 4; ++i) {
        const float4 t = v[r][i];
        ss += t.x * t.x + t.y * t.y + t.z * t.z + t.w * t.w;
        half4 hv; hv[0] = (half_t)t.x; hv[1] = (half_t)t.y; hv[2] = (half_t)t.z; hv[3] = (half_t)t.w;
        xr[lane + 64 * i] = hv;
      }
      ss = wave_sum(ss);
      if (lane == 0) rstd[row] = rsqrtf(ss * (1.f / DM) + EPS);
    }
  }
}
__device__ void ph_ropetab(const Params& P, int wvs) {
  const int tid = otid(wvs);
  const float inv = powf(10000.f, -(float)(2 * (tid & 31)) / 64.f);
  for (int idx = blockIdx.x * NTHREADS + tid; idx < T_TOK * 32; idx += gridDim.x * NTHREADS) {
    const int t = idx >> 5, i = idx & 31;
    const float ang = (float)P.pos[t] * inv;
    float s, c; sincosf(ang, &s, &c);
    P.ropetab[t * 64 + i] = c; P.ropetab[t * 64 + 32 + i] = s;
  }
}
__device__ __forceinline__ int orig_col(int n, int mode) {
  if (mode == 0) {
    if (n < 2048) return n;
    if (n < 3072) return n + 16;
    return -1;
  } else if (mode == 1) {
    if (n < 2560) return n;
    if (n < 3584) return n + 48;
    return -1;
  } else if (mode == 5) {
    return n < 48 ? 2560 + n : -1;
  }
  if (mode == 4) return n < 64 ? n : -1;
  if (mode == 6) return n < 16 ? 2048 + n : -1;
  return n;
}
__device__ void prep_wT(const float* W, int ldw, const float* gamma, half_t* Wt, int Npad, int K, int mode, float* sm, int wvs) {
  float(*tile)[65] = (float(*)[65])sm;
  const int tid = otid(wvs);
  const int ntn = Npad / 64, ntk = K / 64;
  for (int t = blockIdx.x; t < ntn * ntk; t += gridDim.x) {
    const int n0 = (t / ntk) * 64, k0 = (t % ntk) * 64;
    __syncthreads();
#pragma unroll
    for (int r = 0; r < 4096 / NTHREADS; ++r) {
      const int idx = tid + r * NTHREADS, kk = idx >> 6, nn = idx & 63;
      const int on = orig_col(n0 + nn, mode);
      float v = 0.f;
      if (on >= 0) { v = W[(size_t)(k0 + kk) * ldw + on]; if (gamma) v *= gamma[k0 + kk]; }
      tile[kk][nn] = v;
    }
    __syncthreads();
    {
      const int nn = tid >> 3, oct = tid & 7;
      half8 hv;
#pragma unroll
      for (int e = 0; e < 8; ++e) hv[e] = (half_t)tile[oct * 8 + e][nn];
      *(half8*)(Wt + (size_t)(n0 + nn) * K + k0 + oct * 8) = hv;
    }
  }
}

__device__ __forceinline__ void prep_strip(const float* W, int ldw, const float* gamma, half_t* Wt, int K, int mode, int n0, int k0, float* sm, int tid) {
  float(*tile)[260] = (float(*)[260])sm;
  __syncthreads();
#pragma unroll
  for (int r = 0; r < 8; ++r) {
    const int idx = tid + r * NTHREADS, kk = idx >> 6, n4 = (idx & 63) * 4;
    const int on = orig_col(n0 + n4, mode);
    f32x4 v = (f32x4){0.f, 0.f, 0.f, 0.f};
    if (on >= 0) { v = *(const f32x4*)(W + (size_t)(k0 + kk) * ldw + on); if (gamma) v *= gamma[k0 + kk]; }
    *(f32x4*)&tile[kk][n4] = v;
  }
  __syncthreads();
#pragma unroll
  for (int r = 0; r < 4; ++r) {
    const int idx = tid + r * NTHREADS, nn = idx & 255, oct = idx >> 8;
    half8 hv;
#pragma unroll
    for (int e = 0; e < 8; ++e) hv[e] = (half_t)tile[oct * 8 + e][nn];
    *(half8*)(Wt + (size_t)(n0 + nn) * K + k0 + oct * 8) = hv;
  }
}
__device__ void prep_weights(const Params& P, float* sm, int wvs) {
  const int tid = otid(wvs);
  constexpr int NJ = 8;
  const int nstr[NJ] = {(LD0 / 256) * (DM / 64), (DM / 256) * (DM / 64), (LD1 / 256) * (DM / 64), (DM / 256) * (DM / 64), 32, 32, 4, 4};
  int total = 0;
#pragma unroll
  for (int j = 0; j < NJ; ++j) total += nstr[j];
  for (int w = blockIdx.x; w < total; w += gridDim.x) {
    int j = 0, t = w;
#pragma unroll
    for (int jj = 0; jj < NJ - 1; ++jj) if (j == jj && t >= nstr[jj]) { t -= nstr[jj]; j = jj + 1; }
    const float* W; int ldw; const float* gamma; half_t* Wt; int K, mode;
    switch (j) {
      case 0: W = P.gla_w_in; ldw = GLA_IN; gamma = P.pre_norm; Wt = P.W0t; K = DM; mode = 0; break;
      case 1: W = P.gla_w_out; ldw = DM; gamma = nullptr; Wt = P.Wo0t; K = DM; mode = 2; break;
      case 2: W = P.nsa_w_in; ldw = NSA_IN; gamma = P.pre_norm + DM; Wt = P.W1t; K = DM; mode = 1; break;
      case 3: W = P.nsa_w_out; ldw = DM; gamma = nullptr; Wt = P.Wo1t; K = DM; mode = 2; break;
      case 4: W = P.ck_w1; ldw = 256; gamma = nullptr; Wt = P.cw1t; K = 2048; mode = 2; break;
      case 5: W = P.cv_w1; ldw = 256; gamma = nullptr; Wt = P.cw1t + 256 * 2048; K = 2048; mode = 2; break;
      case 6: W = P.ck_w2; ldw = 64; gamma = nullptr; Wt = P.cw2t; K = 256; mode = 4; break;
      default: W = P.cv_w2; ldw = 64; gamma = nullptr; Wt = P.cw2t + 256 * 256; K = 256; mode = 4; break;
    }
    const int nsk = K / 64;
    prep_strip(W, ldw, gamma, Wt, K, mode, (t / nsk) * 256, (t % nsk) * 64, sm, tid);
  }
}

__device__ void prep_cbias_part(const Params& P, int wvs) {
  for (int idx = blockIdx.x * NTHREADS + otid(wvs); idx < 2 * 32 * 256; idx += gridDim.x * NTHREADS) {
    const int j = idx & 255, ks = (idx >> 8) & 31, which = idx >> 13;
    const float* pe = which ? P.nsa_pe_v : P.nsa_pe_k;
    const float* w1 = which ? P.cv_w1 : P.ck_w1;
    float a = 0.f;
#pragma unroll 8
    for (int k = ks * 64; k < ks * 64 + 64; ++k) a += pe[k] * w1[(size_t)k * 256 + j];
    P.cbias_part[idx] = a;
  }
}
__device__ void prep_cbias_reduce(const Params& P, int wvs) {
  if (blockIdx.x < 2 && otid(wvs) < 256) {
    const int which = blockIdx.x, j = otid(wvs);
    float a = 0.f;
    for (int ks = 0; ks < 32; ++ks) a += P.cbias_part[(which * 32 + ks) * 256 + j];
    P.cbias[which * 256 + j] = a;
  }
}

namespace g8 {
constexpr int BK = 64, HALF = 128, HTB = HALF * BK * 2;
__device__ __forceinline__ int lds_byte(int r, int c) { const int st = (r >> 4) * 2 + (c >> 5), rr = r & 15, cc = c & 31, ob = rr * 64 + cc * 2; return st * 1024 + (ob ^ (((ob >> 9) & 1) << 5)); }
__device__ __forceinline__ void stage_rc(int b, int& R, int& C) { const int st = b / 1024, sb = b % 1024, swz = sb ^ (((sb >> 9) & 1) << 5); R = (st >> 1) * 16 + swz / 64; C = (st & 1) * 32 + (swz % 64) / 2; }
typedef f32x4 Acc[2][2][4][2];

struct SrcPlain8 {
  const half_t* A; int lda; const half_t* Bt; int K;
  __device__ __forceinline__ void get(int pm, int pn, const half_t*& Ag, const half_t*& Bg, size_t& a_rs, int& a_ks) const {
    Ag = A + (size_t)pm * 256 * lda; Bg = Bt + (size_t)pn * 256 * K; a_rs = lda; a_ks = 64;
  }
};
struct SrcCmp1_8 {
  const half_t* p1; const half_t* w1t;
  __device__ __forceinline__ void get(int pm, int pn, const half_t*& Ag, const half_t*& Bg, size_t& a_rs, int& a_ks) const {
    const int which = pm >> 5, bg = pm & 31, b = bg >> 2, g = bg & 3;
    Ag = p1 + (size_t)(b * SEQ) * LD1 + (which ? 1280 : 1024) + g * 64;
    Bg = w1t + (size_t)which * 256 * 2048; a_rs = (size_t)16 * LD1; a_ks = LD1;
  }
};
struct SrcCmp2_8 {
  const half_t* hid; const half_t* w2t;
  __device__ __forceinline__ void get(int pm, int pn, const half_t*& Ag, const half_t*& Bg, size_t& a_rs, int& a_ks) const {
    Ag = hid + (size_t)pm * 256 * 256; Bg = w2t + (size_t)(pm >> 5) * 256 * 256; a_rs = 256; a_ks = 64;
  }
};

__device__ __forceinline__ half8 pack8(const f32x4 a, const f32x4 b) {
  half8 h; h[0] = (half_t)a[0]; h[1] = (half_t)a[1]; h[2] = (half_t)a[2]; h[3] = (half_t)a[3]; h[4] = (half_t)b[0]; h[5] = (half_t)b[1]; h[6] = (half_t)b[2]; h[7] = (half_t)b[3];
  return h;
}
struct EpiStore8 {
  half_t* C; int ldc; const float* rowscale;
  __device__ __forceinline__ void operator()(const Acc& acc, int row0, int col0, int wr, int wc, int fr, int fq) const {
#pragma unroll
    for (int ai = 0; ai < 2; ++ai)
#pragma unroll
      for (int m = 0; m < 4; ++m) {
        const int tok = row0 + ai * 128 + wr * 64 + m * 16 + fr;
        const float s = rowscale ? rowscale[tok] : 1.f;
        half_t* rowp = C + (size_t)tok * ldc + col0 + 64 * wc + 8 * fq;
#pragma unroll
        for (int bj = 0; bj < 2; ++bj) *(half8*)(rowp + 32 * bj) = pack8(acc[ai][bj][m][0] * s, acc[ai][bj][m][1] * s);
      }
  }
};
struct EpiRope8 {
  half_t* C; int ldc; const float* rowscale; const float* ropetab;
  __device__ __forceinline__ void operator()(const Acc& acc, int row0, int col0, int wr, int wc, int fr, int fq) const {
    const int grp = (col0 >> 6) + wc;
    const bool is_q = grp < 16;
    const bool roped = is_q || (grp >= 16 && grp < 20) || (grp >= 24 && grp < 28) || (grp >= 32 && grp < 36);
    const float sc = is_q ? 0.125f * 1.4426950408889634f : 1.f;
#pragma unroll
    for (int ai = 0; ai < 2; ++ai)
#pragma unroll
      for (int m = 0; m < 4; ++m) {
        const int tok = row0 + ai * 128 + wr * 64 + m * 16 + fr;
        const float s = rowscale[tok];
        half_t* rowp = C + (size_t)tok * ldc + col0 + 64 * wc + 8 * fq;
        f32x4 o1[2], o2[2];
#pragma unroll
        for (int n = 0; n < 2; ++n) {
          const f32x4 x1 = acc[ai][0][m][n] * s, x2 = acc[ai][1][m][n] * s;
          if (roped) {
            const f32x4 cs = *(const f32x4*)(ropetab + (size_t)tok * 64 + 8 * fq + 4 * n);
            const f32x4 sn = *(const f32x4*)(ropetab + (size_t)tok * 64 + 32 + 8 * fq + 4 * n);
            o1[n] = (x1 * cs - x2 * sn) * sc; o2[n] = (x2 * cs + x1 * sn) * sc;
          } else { o1[n] = x1; o2[n] = x2; }
        }
        *(half8*)(rowp) = pack8(o1[0], o1[1]);
        *(half8*)(rowp + 32) = pack8(o2[0], o2[1]);
      }
  }
};
struct EpiCmpHid8 {
  half_t* hid; const float* bias;
  __device__ __forceinline__ void operator()(const Acc& acc, int row0, int col0, int wr, int wc, int fr, int fq) const {
    const int which = row0 >> 13;
#pragma unroll
    for (int bj = 0; bj < 2; ++bj) {
      const int col = col0 + 64 * wc + 32 * bj + 8 * fq;
      const f32x4 b0 = *(const f32x4*)(bias + which * 256 + col), b1 = *(const f32x4*)(bias + which * 256 + col + 4);
#pragma unroll
      for (int ai = 0; ai < 2; ++ai)
#pragma unroll
        for (int m = 0; m < 4; ++m) {
          const int row = row0 + ai * 128 + wr * 64 + m * 16 + fr;
          f32x4 v0 = acc[ai][bj][m][0] + b0, v1 = acc[ai][bj][m][1] + b1;
#pragma unroll
          for (int e = 0; e < 4; ++e) { v0[e] = siluf(v0[e]); v1[e] = siluf(v1[e]); }
          *(half8*)(hid + (size_t)row * 256 + col) = pack8(v0, v1);
        }
    }
  }
};
struct EpiCmpOut8 {
  half_t* kcmp; half_t* vcmp;
  __device__ __forceinline__ void operator()(const Acc& acc, int row0, int col0, int wr, int wc, int fr, int fq) const {
    if (wc != 0) return;
#pragma unroll
    for (int ai = 0; ai < 2; ++ai)
#pragma unroll
      for (int m = 0; m < 4; ++m) {
        const int row = row0 + ai * 128 + wr * 64 + m * 16 + fr;
        const int which = row >> 13, r = row & 8191;
        half_t* dst = (which ? vcmp : kcmp) + (size_t)r * 64 + 8 * fq;
        const bool dead = (r & 255) == 255;
#pragma unroll
        for (int bj = 0; bj < 2; ++bj) {
          half8 hv = pack8(acc[ai][bj][m][0], acc[ai][bj][m][1]);
          if (dead) hv = (half8){(half_t)0.f, (half_t)0.f, (half_t)0.f, (half_t)0.f, (half_t)0.f, (half_t)0.f, (half_t)0.f, (half_t)0.f};
          *(half8*)(dst + 32 * bj) = hv;
        }
      }
  }
};

template <class Src, class Epi>
__device__ void gemm(const Src& src, int M, int N, int K, const Epi& epi, char* smem, int wvs) {
  const int tid = otid(wvs), wid = __builtin_amdgcn_readfirstlane(tid >> 6), lane = tid & 63, wr = wid >> 2, wc = wid & 3, fr = lane & 15, fq = lane >> 4;
  const int nM = M / 256, nN = N / 256, nwg = nM * nN, G = gridDim.x, nt = K / BK;
  int sr0, sc0, sr1, sc1;
  stage_rc(tid * 16, sr0, sc0); stage_rc(tid * 16 + 8192, sr1, sc1);
  const int a_base = lds_byte(wr * 64 + fr, fq * 8);
  int b_base = 65536 + lds_byte(wc * 32 + fr, fq * 8);
  asm volatile("" : "+v"(b_base));
#define SA8(b, h) (smem + ((b) * 2 + (h)) * HTB)
#define SB8(b, h) (smem + (4 + (b) * 2 + (h)) * HTB)
#define STAGE_A(P, h, kt) { const char* g_ = (const char*)(Ag + (size_t)(h) * 128 * lda + (size_t)(kt) * a_ks); \
    __builtin_amdgcn_global_load_lds((gbl_void*)(g_ + aob0), (lds_void*)((P) + wid * 1024), 16, 0, 0); \
    __builtin_amdgcn_global_load_lds((gbl_void*)(g_ + aob1), (lds_void*)((P) + 8192 + wid * 1024), 16, 0, 0); }
#define STAGE_B(P, h, kt) { const char* g_ = (const char*)(Bg + (size_t)(h) * 32 * K + (size_t)(kt) * 64);     \
    __builtin_amdgcn_global_load_lds((gbl_void*)(g_ + bob0), (lds_void*)((P) + wid * 1024), 16, 0, 0); \
    __builtin_amdgcn_global_load_lds((gbl_void*)(g_ + bob1), (lds_void*)((P) + 8192 + wid * 1024), 16, 0, 0); }
#define LDA8(dst, b, h) { _Pragma("unroll") for (int m = 0; m < 4; ++m) _Pragma("unroll") for (int k = 0; k < 2; ++k) dst[m][k] = *(const half8*)(SA8(b, h) + a_base + m * 2048 + k * 1024); }
#define LDB8(dst, b, h) { _Pragma("unroll") for (int n = 0; n < 2; ++n) _Pragma("unroll") for (int k = 0; k < 2; ++k) dst[n][k] = *(const half8*)(smem + ((b) * 2 + (h)) * HTB + b_base + n * 2048 + k * 1024); }
#define MMA8(ai, bj, At, Bx) { __builtin_amdgcn_s_setprio(1); \
    _Pragma("unroll") for (int m = 0; m < 4; ++m) _Pragma("unroll") for (int n = 0; n < 2; ++n) _Pragma("unroll") for (int k = 0; k < 2; ++k) \
      acc[ai][bj][m][n] = __builtin_amdgcn_mfma_f32_16x16x32_f16(Bx[n][k], At[m][k], acc[ai][bj][m][n], 0, 0, 0); \
    __builtin_amdgcn_s_setprio(0); }
#define WAIT_V(n) asm volatile("s_waitcnt vmcnt(" #n ")" ::: "memory")
#define WAIT_L(n) asm volatile("s_waitcnt lgkmcnt(" #n ")" ::: "memory")
#define BAR __builtin_amdgcn_s_barrier()
#define SCHED __builtin_amdgcn_sched_barrier(0)
  for (int it = 0;; ++it) {
    const int L = it * G + (int)blockIdx.x;
    if (L >= nwg) break;
    int wgid;
    { const int q = nwg / 8, r = nwg % 8, xcd = L % 8, off = L / 8; wgid = (xcd < r ? xcd * (q + 1) : r * (q + 1) + (xcd - r) * q) + off; }
    const int nig = 8 * nN, gid = wgid / nig, fm = gid * 8, gsz = (nM - fm) < 8 ? (nM - fm) : 8;
    const int pm = fm + ((wgid % nig) % gsz), pn = (wgid % nig) / gsz;
    const half_t* Ag; const half_t* Bg; size_t lda; int a_ks;
    src.get(pm, pn, Ag, Bg, lda, a_ks);
    const unsigned aob0 = (unsigned)(((size_t)sr0 * lda + sc0) * 2), aob1 = (unsigned)(((size_t)sr1 * lda + sc1) * 2);
    const int pr0 = 64 * (sr0 >> 5) + 8 * ((sr0 & 15) >> 2) + 4 * ((sr0 >> 4) & 1) + (sr0 & 3), pr1 = 64 * (sr1 >> 5) + 8 * ((sr1 & 15) >> 2) + 4 * ((sr1 >> 4) & 1) + (sr1 & 3);
    const unsigned bob0 = (unsigned)((pr0 * K + sc0) * 2), bob1 = (unsigned)((pr1 * K + sc1) * 2);
    Acc acc;
#pragma unroll
    for (int a = 0; a < 2; ++a)
#pragma unroll
      for (int b = 0; b < 2; ++b)
#pragma unroll
        for (int m = 0; m < 4; ++m)
#pragma unroll
          for (int n = 0; n < 2; ++n) acc[a][b][m][n] = (f32x4){0.f, 0.f, 0.f, 0.f};
    half8 At[4][2], B0[2][2], B1[2][2];
    STAGE_B(SB8(0, 0), 0, 0) STAGE_A(SA8(0, 0), 0, 0)
    STAGE_B(SB8(0, 1), 1, 0) STAGE_A(SA8(0, 1), 1, 0)
    if (wr == 1) BAR;
    WAIT_V(4); BAR;
    STAGE_B(SB8(1, 0), 0, 1) STAGE_A(SA8(1, 0), 0, 1) STAGE_B(SB8(1, 1), 1, 1)
    WAIT_V(6); BAR;
#pragma unroll 1
    for (int t = 0; t < nt - 2; t += 2) {
      LDB8(B0, 0, 0) SCHED; LDA8(At, 0, 0) STAGE_A(SA8(1, 1), 1, t + 1)
      WAIT_L(8); BAR; WAIT_L(0); MMA8(0, 0, At, B0) BAR; SCHED;
      LDB8(B1, 0, 1) STAGE_B(SB8(0, 0), 0, t + 2)
      BAR; WAIT_L(0); MMA8(0, 1, At, B1) BAR;
      LDA8(At, 0, 1) STAGE_A(SA8(0, 0), 0, t + 2)
      BAR; WAIT_L(0); MMA8(1, 0, At, B0) BAR; SCHED;
      STAGE_B(SB8(0, 1), 1, t + 2)
      WAIT_V(6); BAR; MMA8(1, 1, At, B1) BAR;
      LDB8(B0, 1, 0) SCHED; LDA8(At, 1, 0) STAGE_A(SA8(0, 1), 1, t + 2)
      WAIT_L(8); BAR; WAIT_L(0); MMA8(0, 0, At, B0) BAR; SCHED;
      LDB8(B1, 1, 1) STAGE_B(SB8(1, 0), 0, t + 3)
      BAR; WAIT_L(0); MMA8(0, 1, At, B1) BAR;
      LDA8(At, 1, 1) STAGE_A(SA8(1, 0), 0, t + 3)
      BAR; WAIT_L(0); MMA8(1, 0, At, B0) BAR; SCHED;
      STAGE_B(SB8(1, 1), 1, t + 3)
      WAIT_V(6); BAR; MMA8(1, 1, At, B1) BAR;
    }
    { LDB8(B0, 0, 0) LDA8(At, 0, 0) STAGE_A(SA8(1, 1), 1, nt - 1)
      BAR; WAIT_L(0); MMA8(0, 0, At, B0) BAR;
      LDB8(B1, 0, 1) BAR; WAIT_L(0); MMA8(0, 1, At, B1) BAR;
      LDA8(At, 0, 1) WAIT_V(4); BAR; WAIT_L(0); MMA8(1, 0, At, B0) MMA8(1, 1, At, B1) BAR; }
    { LDB8(B0, 1, 0) LDA8(At, 1, 0) WAIT_V(2); BAR; WAIT_L(0); MMA8(0, 0, At, B0) BAR;
      LDB8(B1, 1, 1) WAIT_V(0); BAR; WAIT_L(0); MMA8(0, 1, At, B1) BAR;
      LDA8(At, 1, 1) BAR; WAIT_L(0); MMA8(1, 0, At, B0) MMA8(1, 1, At, B1) BAR; }
    if (wr == 0) BAR;
    { int fr2 = fr, fq2 = fq; asm volatile("" : "+v"(fr2), "+v"(fq2)); epi(acc, pm * 256, pn * 256, wr, wc, fr2, fq2); }
  }
#undef SA8
#undef SB8
#undef STAGE_A
#undef STAGE_B
#undef LDA8
#undef LDB8
#undef MMA8
#undef WAIT_V
#undef WAIT_L
#undef BAR
#undef SCHED
}
}

struct GlaPrepOps { half8 q0, k0, q1, k1; float w[16]; float bb; };
__device__ void ph_gla_prep(const Params& P, float* sm, int wvs) {
  float(*glr)[16] = (float(*)[16])sm;
  float(*tot)[128] = (float(*)[128])(sm + 1024);
  float(*exl)[132] = (float(*)[132])(sm + 1536);
  const int tid = otid(wvs);
  const int tq = tid >> 7, c = tid & 127;
  const int tp = tid >> 4, co = tid & 15;
  const float scale = 0.08838834764831845f;
  const int nchunks = T_TOK / 64, G = gridDim.x;
  const int nj = (((nchunks - 1 - (int)blockIdx.x) / G) + 1) * 4;
  GlaPrepOps nxt; f32x4 gnx = {};
#define GLA_PREP_LOAD(j_) { const int chunk_ = (int)blockIdx.x + ((j_) >> 2) * G, h_ = (j_) & 3, ch_ = h_ * 128 + c; \
    const half_t* qp_ = P.p + (size_t)(chunk_ * 64 + 2 * tp) * LD0 + h_ * 128 + co * 8; \
    nxt.q0 = *(const half8*)(qp_); nxt.k0 = *(const half8*)(qp_ + 512); nxt.q1 = *(const half8*)(qp_ + LD0); nxt.k1 = *(const half8*)(qp_ + LD0 + 512); \
    _Pragma("unroll") for (int r = 0; r < 16; ++r) nxt.w[r] = P.gla_w_gk_up[r * 512 + ch_]; \
    nxt.bb = P.gla_b_gk[ch_]; \
    if (h_ == 0 && tid < 256) gnx = *(const f32x4*)(P.glr + (size_t)(chunk_ * 64) * 16 + tid * 4); }
  GLA_PREP_LOAD(0)
#pragma unroll 1
  for (int j = 0; j < nj; ++j) {
    const int chunk = (int)blockIdx.x + (j >> 2) * G, h = j & 3;
    const int t0 = chunk * 64, ch = h * 128 + c;
    const GlaPrepOps cur = nxt;
    __syncthreads();
    if (h == 0 && tid < 256) *(f32x4*)(sm + tid * 4) = gnx;
    if (j + 1 < nj) GLA_PREP_LOAD(j + 1)
    __syncthreads();
    float pre[16]; float cum = 0.f;
#pragma unroll
    for (int i = 0; i < 16; ++i) {
      float u = cur.bb;
#pragma unroll
      for (int r = 0; r < 16; ++r) u += glr[tq * 16 + i][r] * cur.w[r];
      cum += logsigmoidf(u) * (1.f / 16.f);
      pre[i] = cum;
    }
    tot[tq][c] = cum;
    __syncthreads();
    float off = 0.f;
#pragma unroll
    for (int t = 0; t < 3; ++t) if (t < tq) off += tot[t][c];
#pragma unroll
    for (int i = 0; i < 16; ++i) {
      const float ex = fast_exp2((pre[i] + off) * LOG2E);
      exl[tq * 16 + i][c] = ex;
      if (tq == 3 && i == 15) P.bcum[(size_t)chunk * 512 + ch] = ex;
    }
    __syncthreads();
    {
      half_t* qp = P.p + (size_t)(t0 + 2 * tp) * LD0 + h * 128 + co * 8;
      const f32x4 e00 = *(const f32x4*)&exl[2 * tp][co * 8], e01 = *(const f32x4*)&exl[2 * tp][co * 8 + 4];
      const f32x4 e10 = *(const f32x4*)&exl[2 * tp + 1][co * 8], e11 = *(const f32x4*)&exl[2 * tp + 1][co * 8 + 4];
      half8 oq0, ok0, oq1, ok1;
#pragma unroll
      for (int e = 0; e < 8; ++e) {
        const float x0 = e < 4 ? e00[e] : e01[e - 4], x1 = e < 4 ? e10[e] : e11[e - 4];
        oq0[e] = (half_t)((float)cur.q0[e] * scale * x0); ok0[e] = (half_t)((float)cur.k0[e] * __builtin_amdgcn_rcpf(x0));
        oq1[e] = (half_t)((float)cur.q1[e] * scale * x1); ok1[e] = (half_t)((float)cur.k1[e] * __builtin_amdgcn_rcpf(x1));
      }
      *(half8*)(qp) = oq0; *(half8*)(qp + 512) = ok0; *(half8*)(qp + LD0) = oq1; *(half8*)(qp + LD0 + 512) = ok1;
    }
  }
#undef GLA_PREP_LOAD
}

constexpr int GLA_QE = 0, GLA_KE = 16384, GLA_V = 32768, GLA_DEC = 49152, GLA_BUF = 53248;
#define GLA_TR4(d0, d1, d2, d3, addr, o0, o1, o2, o3) \
  asm volatile("ds_read_b64_tr_b16 %0, %4 offset:%5\n\tds_read_b64_tr_b16 %1, %4 offset:%6\n\tds_read_b64_tr_b16 %2, %4 offset:%7\n\tds_read_b64_tr_b16 %3, %4 offset:%8" \
               : "=&v"(d0), "=&v"(d1), "=&v"(d2), "=&v"(d3) : "v"(addr), "n"(o0), "n"(o1), "n"(o2), "n"(o3) : "memory")
__device__ __forceinline__ half8 pack_h8(const v2i a, const v2i b) { const v4i p = (v4i){a[0], a[1], b[0], b[1]}; return __builtin_bit_cast(half8, p); }

template <bool STATE_ONLY>
__device__ void ph_gla_mfma(const Params& P, char* smem, int wvs) {
  const int tid = otid(wvs);
  const int lane = tid & 63, wave = __builtin_amdgcn_readfirstlane(tid >> 6), r15 = lane & 15, q = lane >> 4;
  const int qp = r15 >> 2, pp = lane & 3;
  const int srow = tid >> 4, sslot = tid & 15;
  const int src_q = (sslot ^ (srow & 15)) * 8, src_kv = (sslot ^ ((srow & 7) << 1)) * 8;
  const int fk = ((4 * (q & 1) + qp) & 7) << 1;
  const unsigned tr_row = (unsigned)((4 * q + qp) * 256 + 8 * (pp & 1) + ((pp >> 1) << 4));
  constexpr int NLOAD = STATE_ONLY ? 5 : 7;
  for (int item = blockIdx.x; item < (STATE_ONLY ? 3 : 4) * 64; item += gridDim.x) {
    const int seg = item >> 6, base = item & 63, b = base >> 3, h = (base >> 1) & 3, vs = base & 1;
    const int c0 = seg * 16;
    f32x4 S[8], Dacc[8];
#pragma unroll
    for (int df = 0; df < 8; ++df) { S[df] = (f32x4){0.f, 0.f, 0.f, 0.f}; Dacc[df] = (f32x4){1.f, 1.f, 1.f, 1.f}; }
    f32x4* stL = (f32x4*)P.gla_state + ((size_t)base * 8 + wave) * 8 * 64 + lane;
    f32x4* stD = stL + (size_t)3 * 64 * 8 * 8 * 64;
    if (!STATE_ONLY) {
      for (int k = 0; k < seg; ++k) {
#pragma unroll
        for (int df = 0; df < 8; ++df) {
          const f32x4 Lk = stL[((size_t)k * 64 * 8 * 8 + df) * 64];
          if (k == 0) S[df] = Lk;
          else { const f32x4 Dk = stD[((size_t)k * 64 * 8 * 8 + df) * 64]; S[df] = Dk * S[df] + Lk; }
        }
      }
    }
    const half_t* qsrc = P.p + (size_t)(b * SEQ + srow) * LD0 + h * 128;
    const half_t* vsrc = P.p + (size_t)(b * SEQ + srow) * LD0 + 1024 + h * 256 + vs * 128 + src_kv;
    const float* dsrc = P.bcum + (size_t)(b * 64 + c0) * 512 + h * 128 + (lane & 31) * 4;
#define G_ISSUE(N, BUF) { char* lb_ = smem + (BUF) * GLA_BUF + wave * 1024; const size_t ro_ = (size_t)(c0 + (N)) * 64 * LD0; \
      if (!STATE_ONLY) { __builtin_amdgcn_global_load_lds((gbl_void*)(qsrc + ro_ + src_q), (lds_void*)(lb_ + GLA_QE), 16, 0, 0); \
      __builtin_amdgcn_global_load_lds((gbl_void*)(qsrc + ro_ + (size_t)32 * LD0 + src_q), (lds_void*)(lb_ + GLA_QE + 8192), 16, 0, 0); } \
      __builtin_amdgcn_global_load_lds((gbl_void*)(qsrc + ro_ + 512 + src_kv), (lds_void*)(lb_ + GLA_KE), 16, 0, 0); \
      __builtin_amdgcn_global_load_lds((gbl_void*)(qsrc + ro_ + (size_t)32 * LD0 + 512 + src_kv), (lds_void*)(lb_ + GLA_KE + 8192), 16, 0, 0); \
      __builtin_amdgcn_global_load_lds((gbl_void*)(vsrc + ro_), (lds_void*)(lb_ + GLA_V), 16, 0, 0); \
      __builtin_amdgcn_global_load_lds((gbl_void*)(vsrc + ro_ + (size_t)32 * LD0), (lds_void*)(lb_ + GLA_V + 8192), 16, 0, 0); \
      if (lane < 32) __builtin_amdgcn_global_load_lds((gbl_void*)(dsrc + (size_t)(N) * 512), (lds_void*)(smem + (BUF) * GLA_BUF + GLA_DEC + wave * 512), 16, 0, 0); }
    G_ISSUE(0, 0)
    G_ISSUE(1, 1)
#pragma unroll 1
    for (int n = 0; n < 16; ++n) {
      if (n + 1 < 16) wait_vmcnt<NLOAD>(); else wait_vmcnt<0>();
      __builtin_amdgcn_s_barrier();
      if (n + 2 < 16) G_ISSUE(n + 2, (n + 2) % 3)
      const char* cb = smem + (n % 3) * GLA_BUF;
      f32x4 aT[4][4];
      if (!STATE_ONLY) {
#pragma unroll
      for (int kf = 0; kf < 4; ++kf)
#pragma unroll
        for (int tf = 0; tf < 4; ++tf) aT[kf][tf] = (f32x4){0.f, 0.f, 0.f, 0.f};
#pragma unroll
      for (int ks = 0; ks < 4; ++ks) {
        half8 kef[4], qef[4];
#pragma unroll
        for (int f = 0; f < 4; ++f) {
          kef[f] = *(const half8*)(cb + GLA_KE + (16 * f + r15) * 256 + (((4 * ks + q) ^ ((r15 & 7) << 1)) << 4));
          qef[f] = *(const half8*)(cb + GLA_QE + (16 * f + r15) * 256 + (((4 * ks + q) ^ r15) << 4));
        }
#pragma unroll
        for (int kf = 0; kf < 4; ++kf)
#pragma unroll
          for (int tf = kf; tf < 4; ++tf) aT[kf][tf] = __builtin_amdgcn_mfma_f32_16x16x32_f16(kef[kf], qef[tf], aT[kf][tf], 0, 0, 0);
      }
#pragma unroll
      for (int f = 0; f < 4; ++f)
#pragma unroll
        for (int r = 0; r < 4; ++r) if (4 * q + r > r15) aT[f][f][r] = 0.f;
      }
      const unsigned lds0 = (unsigned)(size_t)cb;
      const unsigned va = lds0 + GLA_V + tr_row + ((((2 * wave) ^ fk)) << 4);
      v2i v00, v01, v10, v11;
      GLA_TR4(v00, v01, v10, v11, va, 0, 4096, 8192, 12288);
      const unsigned ka = lds0 + GLA_KE + tr_row;
      v2i k0[4][4];
#pragma unroll
      for (int df = 0; df < 4; ++df) { const unsigned a_ = ka + ((((2 * df) ^ fk)) << 4); GLA_TR4(k0[df][0], k0[df][1], k0[df][2], k0[df][3], a_, 0, 4096, 8192, 12288); }
      asm volatile("s_waitcnt lgkmcnt(15)" : "+v"(v00), "+v"(v01), "+v"(v10), "+v"(v11) :: "memory");
      __builtin_amdgcn_sched_barrier(0);
      half8 vf[2];
      vf[0] = pack_h8(v00, v01); vf[1] = pack_h8(v10, v11);
      if (!STATE_ONLY) {
      f32x4 o[4];
#pragma unroll
      for (int tf = 0; tf < 4; ++tf) o[tf] = (f32x4){0.f, 0.f, 0.f, 0.f};
#pragma unroll
      for (int ks2 = 0; ks2 < 2; ++ks2)
#pragma unroll
        for (int tf = 2 * ks2; tf < 4; ++tf) {
          half8 pk;
#pragma unroll
          for (int r = 0; r < 4; ++r) { pk[r] = (half_t)aT[2 * ks2][tf][r]; pk[4 + r] = (half_t)aT[2 * ks2 + 1][tf][r]; }
          o[tf] = __builtin_amdgcn_mfma_f32_16x16x32_f16(vf[ks2], pk, o[tf], 0, 0, 0);
        }
#pragma unroll
      for (int ks = 0; ks < 4; ++ks) {
        half8 sf;
#pragma unroll
        for (int r = 0; r < 4; ++r) { sf[r] = (half_t)S[2 * ks][r]; sf[4 + r] = (half_t)S[2 * ks + 1][r]; }
#pragma unroll
        for (int tf = 0; tf < 4; ++tf) {
          const int row = 16 * tf + r15;
          const half4 qa = *(const half4*)(cb + GLA_QE + row * 256 + (((4 * ks + (q >> 1)) ^ r15) << 4) + (q & 1) * 8);
          const half4 qb = *(const half4*)(cb + GLA_QE + row * 256 + (((4 * ks + 2 + (q >> 1)) ^ r15) << 4) + (q & 1) * 8);
          half8 qv;
#pragma unroll
          for (int e = 0; e < 4; ++e) { qv[e] = qa[e]; qv[4 + e] = qb[e]; }
          o[tf] = __builtin_amdgcn_mfma_f32_16x16x32_f16(sf, qv, o[tf], 0, 0, 0);
        }
      }
      {
        const size_t t0 = (size_t)(b * SEQ + (c0 + n) * 64);
#pragma unroll
        for (int tf = 0; tf < 4; ++tf) {
          half4 hv; hv[0] = (half_t)o[tf][0]; hv[1] = (half_t)o[tf][1]; hv[2] = (half_t)o[tf][2]; hv[3] = (half_t)o[tf][3];
          *(half4*)(P.og + (t0 + 16 * tf + r15) * DM + h * 256 + vs * 128 + 16 * wave + 4 * q) = hv;
        }
      }
      }
      v2i k1[4][4];
#pragma unroll
      for (int df = 0; df < 4; ++df) { const unsigned a_ = ka + ((((2 * (df + 4)) ^ fk)) << 4); GLA_TR4(k1[df][0], k1[df][1], k1[df][2], k1[df][3], a_, 0, 4096, 8192, 12288); }
      asm volatile("s_waitcnt lgkmcnt(15)"
                   : "+v"(k0[0][0]), "+v"(k0[0][1]), "+v"(k0[0][2]), "+v"(k0[0][3]), "+v"(k0[1][0]), "+v"(k0[1][1]), "+v"(k0[1][2]), "+v"(k0[1][3]),
                     "+v"(k0[2][0]), "+v"(k0[2][1]), "+v"(k0[2][2]), "+v"(k0[2][3]), "+v"(k0[3][0]), "+v"(k0[3][1]), "+v"(k0[3][2]), "+v"(k0[3][3]) :: "memory");
      __builtin_amdgcn_sched_barrier(0);
#pragma unroll
      for (int df = 0; df < 4; ++df) {
        S[df] = __builtin_amdgcn_mfma_f32_16x16x32_f16(pack_h8(k0[df][0], k0[df][1]), vf[0], S[df], 0, 0, 0);
        S[df] = __builtin_amdgcn_mfma_f32_16x16x32_f16(pack_h8(k0[df][2], k0[df][3]), vf[1], S[df], 0, 0, 0);
      }
      asm volatile("s_waitcnt lgkmcnt(0)"
                   : "+v"(k1[0][0]), "+v"(k1[0][1]), "+v"(k1[0][2]), "+v"(k1[0][3]), "+v"(k1[1][0]), "+v"(k1[1][1]), "+v"(k1[1][2]), "+v"(k1[1][3]),
                     "+v"(k1[2][0]), "+v"(k1[2][1]), "+v"(k1[2][2]), "+v"(k1[2][3]), "+v"(k1[3][0]), "+v"(k1[3][1]), "+v"(k1[3][2]), "+v"(k1[3][3]) :: "memory");
      __builtin_amdgcn_sched_barrier(0);
#pragma unroll
      for (int df = 0; df < 4; ++df) {
        S[df + 4] = __builtin_amdgcn_mfma_f32_16x16x32_f16(pack_h8(k1[df][0], k1[df][1]), vf[0], S[df + 4], 0, 0, 0);
        S[df + 4] = __builtin_amdgcn_mfma_f32_16x16x32_f16(pack_h8(k1[df][2], k1[df][3]), vf[1], S[df + 4], 0, 0, 0);
      }
#pragma unroll
      for (int df = 0; df < 8; ++df) {
        const f32x4 dc = *(const f32x4*)(cb + GLA_DEC + wave * 512 + (16 * df + 4 * q) * 4);
        S[df] *= dc;
        if (STATE_ONLY) Dacc[df] *= dc;
      }
    }
    if (STATE_ONLY) {
#pragma unroll
      for (int df = 0; df < 8; ++df) { stL[((size_t)seg * 64 * 8 * 8 + df) * 64] = S[df]; stD[((size_t)seg * 64 * 8 * 8 + df) * 64] = Dacc[df]; }
    }
    asm volatile("s_waitcnt vmcnt(0)" ::: "memory");
    __builtin_amdgcn_s_barrier();
#undef G_ISSUE
  }
}

__device__ void ph_gla_post(const Params& P, int wvs) {
  const int tid_ = otid(wvs); const int lane = tid_ & 63, sub = lane & 31;
  const int u0 = blockIdx.x * 16 + (tid_ >> 5);
  const float4 hn0 = ((const float4*)P.gla_head_norm)[sub * 2], hn1 = ((const float4*)P.gla_head_norm)[sub * 2 + 1];
  constexpr int UW = 4;
  const int ustride = gridDim.x * 16;
#pragma unroll 1
  for (int ub = u0; ub < T_TOK * 4; ub += ustride * UW) {
    half8 hv[UW], z[UW];
#pragma unroll
    for (int r = 0; r < UW; ++r) {
      const int u = ub + r * ustride, t = u >> 2, h = u & 3;
      hv[r] = *((const half8*)(P.og + (size_t)t * DM + h * 256) + sub);
      z[r] = *((const half8*)(P.p + (size_t)t * LD0 + 2048 + h * 256) + sub);
    }
#pragma unroll
    for (int r = 0; r < UW; ++r) {
      const int u = ub + r * ustride, t = u >> 2, h = u & 3;
      float v[8]; float ss = 0.f;
#pragma unroll
      for (int e = 0; e < 8; ++e) { v[e] = (float)hv[r][e]; ss += v[e] * v[e]; }
#pragma unroll
      for (int o = 16; o > 0; o >>= 1) ss += __shfl_xor(ss, o);
      const float rr = rsqrtf(ss * (1.f / 256.f) + EPS);
      const float hn[8] = {hn0.x, hn0.y, hn0.z, hn0.w, hn1.x, hn1.y, hn1.z, hn1.w};
      half8 o;
#pragma unroll
      for (int e = 0; e < 8; ++e) o[e] = (half_t)(v[e] * rr * hn[e] * siluf((float)z[r][e]));
      *((half8*)(P.og + (size_t)t * DM + h * 256) + sub) = o;
    }
  }
}

template <bool FINAL>
__device__ void ph_post(const half_t* baseh, const half_t* y, const float* g, float* dst, half_t* dsth, float* rstd_out, int wvs) {
  const int tid_ = otid(wvs); const int lane = tid_ & 63, w = tid_ >> 6;
  constexpr int RW = 4;
  const int rstride = gridDim.x * NWAVES;
#pragma unroll 1
  for (int row0 = blockIdx.x * NWAVES + w; row0 < T_TOK; row0 += rstride * RW) {
    half4 yv[RW][4], bv[RW][4];
#pragma unroll
    for (int r = 0; r < RW; ++r)
#pragma unroll
      for (int i = 0; i < 4; ++i) yv[r][i] = ((const half4*)(y + (size_t)(row0 + r * rstride) * DM))[lane + 64 * i];
#pragma unroll
    for (int r = 0; r < RW; ++r)
#pragma unroll
      for (int i = 0; i < 4; ++i) bv[r][i] = ((const half4*)(baseh + (size_t)(row0 + r * rstride) * DM))[lane + 64 * i];
#pragma unroll
    for (int r = 0; r < RW; ++r) {
      const int row = row0 + r * rstride;
      float ss = 0.f;
#pragma unroll
      for (int i = 0; i < 4; ++i)
#pragma unroll
        for (int e = 0; e < 4; ++e) { const float t = (float)yv[r][i][e]; ss += t * t; }
      ss = wave_sum(ss);
      const float rr = rsqrtf(ss * (1.f / DM) + EPS);
      float s2 = 0.f;
#pragma unroll
      for (int i = 0; i < 4; ++i) {
        const float4 gg = ((const float4*)g)[lane + 64 * i];
        float4 o;
        o.x = (float)bv[r][i][0] + (float)yv[r][i][0] * rr * gg.x; o.y = (float)bv[r][i][1] + (float)yv[r][i][1] * rr * gg.y;
        o.z = (float)bv[r][i][2] + (float)yv[r][i][2] * rr * gg.z; o.w = (float)bv[r][i][3] + (float)yv[r][i][3] * rr * gg.w;
        if (FINAL) ((float4*)(dst + (size_t)row * DM))[lane + 64 * i] = o;
        else {
          s2 += o.x * o.x + o.y * o.y + o.z * o.z + o.w * o.w;
          half4 hv; hv[0] = (half_t)o.x; hv[1] = (half_t)o.y; hv[2] = (half_t)o.z; hv[3] = (half_t)o.w;
          ((half4*)(dsth + (size_t)row * DM))[lane + 64 * i] = hv;
        }
      }
      if (!FINAL) { s2 = wave_sum(s2); if (lane == 0) rstd_out[row] = rsqrtf(s2 * (1.f / DM) + EPS); }
    }
  }
}

template <int NF>
__device__ void ph_rowproj(const Params& P, const half_t* Wt, float* out, char* smem, int wvs, int first_block) {
  const int tid = otid(wvs), lane = tid & 63, wave = tid >> 6, r15 = lane & 15, q = lane >> 4;
  const int nb = gridDim.x - first_block;
  if ((int)blockIdx.x < first_block) return;
  __syncthreads();
  for (int c = tid; c < 16 * NF * 128; c += NTHREADS) {
    const int row = c >> 7, ch = c & 127;
    *(uint4*)(smem + row * 2064 + ch * 16) = *(const uint4*)(Wt + (size_t)row * DM + ch * 8);
  }
  __syncthreads();
  for (int tile = (int)blockIdx.x - first_block; tile < T_TOK / 128; tile += nb) {
    const int tok = tile * 128 + wave * 16 + r15;
    const half_t* ap = P.xh + (size_t)tok * DM + 8 * q;
    const char* bp = smem + r15 * 2064 + 16 * q;
    f32x4 acc[NF];
#pragma unroll
    for (int n = 0; n < NF; ++n) acc[n] = (f32x4){0.f, 0.f, 0.f, 0.f};
#pragma unroll 1
    for (int s0 = 0; s0 < 32; s0 += 16) {
      half8 a[16];
#pragma unroll
      for (int i = 0; i < 16; ++i) a[i] = *(const half8*)(ap + 32 * (s0 + i));
#pragma unroll
      for (int i = 0; i < 16; ++i) {
#pragma unroll
        for (int n = 0; n < NF; ++n) {
          const half8 bw = *(const half8*)(bp + n * 16 * 2064 + (s0 + i) * 64);
          acc[n] = __builtin_amdgcn_mfma_f32_16x16x32_f16(bw, a[i], acc[n], 0, 0, 0);
        }
      }
    }
    const float rs = P.rstd[tok];
#pragma unroll
    for (int n = 0; n < NF; ++n) *(f32x4*)(out + (size_t)tok * (16 * NF) + 16 * n + 4 * q) = acc[n] * rs;
  }
  __syncthreads();
}

__device__ void ph_kmax(const Params& P, int wvs, int first_block) {
  const int tid = otid(wvs);
  for (int task = (int)blockIdx.x - first_block; task < NBATCH * 4 * 2 * 8; task += gridDim.x - first_block) {
    const int chunk = task & 7, br = (task >> 3) & 1, bg = task >> 4, b = bg >> 2, g = bg & 3;
    const half_t* kp = P.p + (size_t)(b * SEQ + chunk * 512 + tid) * LD1 + (br ? 2048 : 1536) + g * 64;
    float ss = 0.f;
#pragma unroll
    for (int c = 0; c < 8; ++c) {
      const half8 v = *(const half8*)(kp + c * 8);
#pragma unroll
      for (int e = 0; e < 8; ++e) ss += (float)v[e] * (float)v[e];
    }
    ss = wave_max(ss);
    if ((tid & 63) == 0) __hip_atomic_fetch_max(&P.kmax2[bg * 2 + br], __float_as_uint(ss), __ATOMIC_RELAXED, __HIP_MEMORY_SCOPE_AGENT);
  }
}

constexpr int ATT_NB = 6, ATT_D = 5;
constexpr int ATT_K = 0, ATT_V = ATT_NB * 8192, ATT_IMP = 2 * ATT_NB * 8192, ATT_SELM = ATT_IMP + 64 * 68 * 4;
constexpr int IMPS = 68;
constexpr int ATT_GATE = ATT_SELM + 512;

__device__ __forceinline__ void attn_issue(char* smem, const half_t* kbase, const half_t* vbase, int ld, int tile_lo, int tile_hi, int wvs, int rot = 0) {
  const int tid = otid(wvs);
  const int lrow = tid >> 3, lch = tid & 7;
  const int ksrc = (lch ^ ((lrow >> 1) & 7)) * 8, vsrc = (lch ^ (((lrow >> 1) & 3) << 1)) * 8;
  const int wbase = __builtin_amdgcn_readfirstlane(tid >> 6) * 1024;
#pragma unroll
  for (int i = 0; i < ATT_D; ++i) if (tile_lo + i <= tile_hi) {
    const int nt_ = tile_hi - tile_lo + 1, tr_ = tile_lo + ((rot + i >= nt_) ? rot + i - nt_ : rot + i);
    const half_t* kp_ = kbase + (size_t)(tr_ * 64 + lrow) * ld + ksrc;
    const half_t* vp_ = vbase + (size_t)(tr_ * 64 + lrow) * ld + vsrc;
    __builtin_amdgcn_global_load_lds((gbl_void*)kp_, (lds_void*)(smem + ATT_K + i * 8192 + wbase), 16, 0, 0);
    __builtin_amdgcn_global_load_lds((gbl_void*)vp_, (lds_void*)(smem + ATT_V + i * 8192 + wbase), 16, 0, 0);
  }
}

template <int MODE, bool PREISSUED = false>
__device__ __forceinline__ void attn_branch(char* smem, const half_t* kbase, const half_t* vbase, int ld, int tile_lo, int tile_hi, int n, int th,
                                            const half8 (&qf)[2][2], float (&m)[2], float (&l)[2], f32x4 (&o)[4][2],
                                            const unsigned long long (&selm)[2], int wvs) {
  const int tid = otid(wvs);
  const int lane = tid & 63, r15 = lane & 15, q = lane >> 4;
  const int lrow = tid >> 3, lch = tid & 7;
  const int k_rd = r15 * 128, kswz = r15 >> 1;
  const int qp = r15 >> 2, pp = lane & 3;
  const int fx = ((2 * q + (qp >> 1)) & 3) << 1;
  const int v_rd = (4 * q + qp) * 128 + 8 * (pp & 1) + ((pp >> 1) << 4);
  unsigned int* impu = (unsigned int*)(smem + ATT_IMP);
  const int ksrc = (lch ^ ((lrow >> 1) & 7)) * 8, vsrc = (lch ^ (((lrow >> 1) & 3) << 1)) * 8;
  const int wbase = __builtin_amdgcn_readfirstlane(tid >> 6) * 1024;
#define A_GLOAD(TI, BUF) { const half_t* kp_ = kbase + (size_t)((TI) * 64 + lrow) * ld + ksrc; \
    __builtin_amdgcn_global_load_lds((gbl_void*)kp_, (lds_void*)(smem + ATT_K + (BUF) * 8192 + wbase), 16, 0, 0); \
    { const half_t* vp_ = vbase + (size_t)((TI) * 64 + lrow) * ld + vsrc; \
      __builtin_amdgcn_global_load_lds((gbl_void*)vp_, (lds_void*)(smem + ATT_V + (BUF) * 8192 + wbase), 16, 0, 0); } }
  constexpr int GPT = 2;
  f32x4 lacc[2] = {(f32x4){0.f, 0.f, 0.f, 0.f}, (f32x4){0.f, 0.f, 0.f, 0.f}};
  if (MODE != 1 && !PREISSUED) {
#pragma unroll
    for (int i = 0; i < ATT_D; ++i) if (tile_lo + i <= tile_hi) A_GLOAD(tile_lo + i, i)
  }
#pragma unroll 1
  for (int ti = tile_lo; ti <= tile_hi; ++ti) {
    const int it = ti - tile_lo, cur = it % ATT_NB;
    if (MODE != 1) {
      const int rem = tile_hi - ti;
      if (rem >= 4) wait_vmcnt<4 * GPT>(); else if (rem == 3) wait_vmcnt<3 * GPT>(); else if (rem == 2) wait_vmcnt<2 * GPT>();
      else if (rem == 1) wait_vmcnt<1 * GPT>(); else wait_vmcnt<0>();
    }
    __builtin_amdgcn_s_barrier();
    if (MODE != 1) { if (ti + ATT_D <= tile_hi) A_GLOAD(ti + ATT_D, (it + ATT_D) % ATT_NB) }
    const char* kb = smem + ATT_K + cur * 8192 + k_rd;
    const unsigned vbl = (unsigned)(size_t)(smem + ATT_V + cur * 8192 + v_rd);
    bool need_mask;
    if (MODE <= 1) need_mask = (ti * 64 + 63 > 4 * n - 2);
    else if (MODE == 2) need_mask = (ti == n);
    else need_mask = (ti == n) || (ti == n - 8);
    f32x4 s[4][2];
#pragma unroll
    for (int t2 = 0; t2 < 2; ++t2) {
      float c0 = 0.f;
      if (MODE >= 2) { c0 = -m[t2]; if (MODE == 2 && !((selm[t2] >> ti) & 1ull)) c0 = -INFINITY; }
#pragma unroll
      for (int kf = 0; kf < 4; ++kf) s[kf][t2] = (f32x4){c0, c0, c0, c0};
    }
#pragma unroll
    for (int ks = 0; ks < 2; ++ks) {
      const int co = ((4 * ks + q) ^ kswz) << 4;
#pragma unroll
      for (int kf = 0; kf < 4; ++kf) {
        const half8 kfr = *(const half8*)(kb + kf * 2048 + co);
#pragma unroll
        for (int t2 = 0; t2 < 2; ++t2) s[kf][t2] = __builtin_amdgcn_mfma_f32_16x16x32_f16(kfr, qf[t2][ks], s[kf][t2], 0, 0, 0);
      }
    }
    v2i vr[4][4];
    if (MODE != 0) {
      const unsigned va0 = vbl + (((0) ^ fx) << 4), va1 = vbl + (((2) ^ fx) << 4), va2 = vbl + (((4) ^ fx) << 4), va3 = vbl + (((6) ^ fx) << 4);
      asm volatile(
          "ds_read_b64_tr_b16 %0, %16\n\tds_read_b64_tr_b16 %1, %16 offset:2048\n\tds_read_b64_tr_b16 %2, %16 offset:4096\n\tds_read_b64_tr_b16 %3, %16 offset:6144\n\t"
          "ds_read_b64_tr_b16 %4, %17\n\tds_read_b64_tr_b16 %5, %17 offset:2048\n\tds_read_b64_tr_b16 %6, %17 offset:4096\n\tds_read_b64_tr_b16 %7, %17 offset:6144\n\t"
          "ds_read_b64_tr_b16 %8, %18\n\tds_read_b64_tr_b16 %9, %18 offset:2048\n\tds_read_b64_tr_b16 %10, %18 offset:4096\n\tds_read_b64_tr_b16 %11, %18 offset:6144\n\t"
          "ds_read_b64_tr_b16 %12, %19\n\tds_read_b64_tr_b16 %13, %19 offset:2048\n\tds_read_b64_tr_b16 %14, %19 offset:4096\n\tds_read_b64_tr_b16 %15, %19 offset:6144"
          : "=&v"(vr[0][0]), "=&v"(vr[0][1]), "=&v"(vr[0][2]), "=&v"(vr[0][3]), "=&v"(vr[1][0]), "=&v"(vr[1][1]), "=&v"(vr[1][2]), "=&v"(vr[1][3]),
            "=&v"(vr[2][0]), "=&v"(vr[2][1]), "=&v"(vr[2][2]), "=&v"(vr[2][3]), "=&v"(vr[3][0]), "=&v"(vr[3][1]), "=&v"(vr[3][2]), "=&v"(vr[3][3])
          : "v"(va0), "v"(va1), "v"(va2), "v"(va3)
          : "memory");
    }
    if (need_mask) {
#pragma unroll
      for (int t2 = 0; t2 < 2; ++t2) {
        const int tok = th * 32 + t2 * 16 + r15;
        int lo = 0, hi = 63;
        if (MODE <= 1) { hi = 4 * n + ((tok - 31) >> 4) - ti * 64; }
        else if (MODE == 2) { hi = tok; }
        else { if (ti == n) hi = tok; else lo = tok + 1; }
#pragma unroll
        for (int kf = 0; kf < 4; ++kf)
#pragma unroll
          for (int r = 0; r < 4; ++r) {
            const int kk = kf * 16 + 4 * q + r;
            if (kk < lo || kk > hi) s[kf][t2][r] = -INFINITY;
          }
      }
    }
    half8 pf[2][2];
#pragma unroll
    for (int t2 = 0; t2 < 2; ++t2) {
      float mb = 0.f, scale_p = 1.f;
      if (MODE == 1) {
        mb = m[t2]; scale_p = l[t2];
      } else if (MODE == 0) {
        float tm = s[0][t2][0];
#pragma unroll
        for (int kf = 0; kf < 4; ++kf)
#pragma unroll
          for (int r = 0; r < 4; ++r) tm = fmaxf(tm, s[kf][t2][r]);
        tm = rowmax4(tm);
        const float mn = fmaxf(m[t2], tm);
        const float alpha = fexp2(m[t2] - mn);
        m[t2] = mn; mb = mn;
        l[t2] *= alpha;
      }
      float lsum = 0.f;
#pragma unroll
      for (int kf = 0; kf < 4; ++kf) {
#pragma unroll
        for (int r = 0; r < 4; ++r) {
          float pv = (MODE >= 2) ? fexp2(s[kf][t2][r]) : fexp2(s[kf][t2][r] - mb);
          if (MODE == 1) pv *= scale_p;
          s[kf][t2][r] = pv; if (MODE == 0) lsum += pv;
        }
      }
      if (MODE == 0) l[t2] += lsum;
      if (MODE == 1) {
        const int tok = th * 32 + t2 * 16 + r15;
#pragma unroll
        for (int kf = 0; kf < 4; ++kf) {
          const int j = 16 * ti + 4 * kf + q;
          const unsigned int u0 = (unsigned int)(s[kf][t2][0] * 134217728.f + 0.5f), u1 = (unsigned int)(s[kf][t2][1] * 134217728.f + 0.5f);
          const unsigned int u2 = (unsigned int)(s[kf][t2][2] * 134217728.f + 0.5f), u3 = (unsigned int)(s[kf][t2][3] * 134217728.f + 0.5f);
          if (j < 64) {
            atomicAdd(&impu[tok * IMPS + j], u0 + u1 + u2 + u3);
            atomicAdd(&impu[tok * IMPS + j + 1], u3);
          }
        }
      }
      if (MODE != 0) {
#pragma unroll
        for (int ks = 0; ks < 2; ++ks) {
          half8 pk;
#pragma unroll
          for (int r = 0; r < 4; ++r) { pk[r] = (half_t)s[2 * ks][t2][r]; pk[4 + r] = (half_t)s[2 * ks + 1][t2][r]; }
          pf[t2][ks] = pk;
        }
      }
    }
    if (MODE != 0) {
      asm volatile("s_waitcnt lgkmcnt(0)"
                   : "+v"(vr[0][0]), "+v"(vr[0][1]), "+v"(vr[0][2]), "+v"(vr[0][3]), "+v"(vr[1][0]), "+v"(vr[1][1]), "+v"(vr[1][2]), "+v"(vr[1][3]),
                     "+v"(vr[2][0]), "+v"(vr[2][1]), "+v"(vr[2][2]), "+v"(vr[2][3]), "+v"(vr[3][0]), "+v"(vr[3][1]), "+v"(vr[3][2]), "+v"(vr[3][3])
                   :: "memory");
      __builtin_amdgcn_sched_barrier(0);
#pragma unroll
      for (int df = 0; df < 4; ++df) {
#pragma unroll
        for (int ks = 0; ks < 2; ++ks) {
          const v2i lo2 = vr[df][2 * ks], hi2 = vr[df][2 * ks + 1];
          const v4i pk4 = (v4i){lo2[0], lo2[1], hi2[0], hi2[1]};
          const half8 vf = __builtin_bit_cast(half8, pk4);
#pragma unroll
          for (int t2 = 0; t2 < 2; ++t2) o[df][t2] = __builtin_amdgcn_mfma_f32_16x16x32_f16(vf, pf[t2][ks], o[df][t2], 0, 0, 0);
        }
      }
      if (MODE >= 2) {
        const half8 ones = (half8){(half_t)1.f, (half_t)1.f, (half_t)1.f, (half_t)1.f, (half_t)1.f, (half_t)1.f, (half_t)1.f, (half_t)1.f};
#pragma unroll
        for (int ks = 0; ks < 2; ++ks)
#pragma unroll
          for (int t2 = 0; t2 < 2; ++t2) lacc[t2] = __builtin_amdgcn_mfma_f32_16x16x32_f16(ones, pf[t2][ks], lacc[t2], 0, 0, 0);
      }
    }
  }
  if (MODE >= 2) { l[0] = lacc[0][0]; l[1] = lacc[1][0]; }
  __syncthreads();
#undef A_GLOAD
}

template <int MODE, bool PREISSUED>
__device__ __forceinline__ void attn_branch_pp(char* smem, const half_t* kbase, const half_t* vbase, int ld, int tile_lo, int tile_hi, int n, int th,
                                               const half8 (&qf)[2][2], const float (&m)[2], float (&l)[2], f32x4 (&o)[4][2],
                                               const unsigned long long (&selm)[2], int wvs, int rot) {
  const int tid = otid(wvs);
  const int lane = tid & 63, r15 = lane & 15, q = lane >> 4;
  const int lrow = tid >> 3, lch = tid & 7;
  const int k_rd = r15 * 128, kswz = r15 >> 1;
  const int qp = r15 >> 2, pp = lane & 3;
  const int fx = ((2 * q + (qp >> 1)) & 3) << 1;
  const int v_rd = (4 * q + qp) * 128 + 8 * (pp & 1) + ((pp >> 1) << 4);
  const int ksrc = (lch ^ ((lrow >> 1) & 7)) * 8, vsrc = (lch ^ (((lrow >> 1) & 3) << 1)) * 8;
  const int wbase = __builtin_amdgcn_readfirstlane(tid >> 6) * 1024;
#define A_GLOAD(TI, BUF) { const half_t* kp_ = kbase + (size_t)((TI) * 64 + lrow) * ld + ksrc; \
    __builtin_amdgcn_global_load_lds((gbl_void*)kp_, (lds_void*)(smem + ATT_K + (BUF) * 8192 + wbase), 16, 0, 0); \
    { const half_t* vp_ = vbase + (size_t)((TI) * 64 + lrow) * ld + vsrc; \
      __builtin_amdgcn_global_load_lds((gbl_void*)vp_, (lds_void*)(smem + ATT_V + (BUF) * 8192 + wbase), 16, 0, 0); } }
#define PP_BAR { __builtin_amdgcn_sched_barrier(0); __builtin_amdgcn_s_barrier(); __builtin_amdgcn_sched_barrier(0); }
  const int nt = tile_hi - tile_lo + 1;
  f32x4 lacc[2] = {(f32x4){0.f, 0.f, 0.f, 0.f}, (f32x4){0.f, 0.f, 0.f, 0.f}};
  if (!PREISSUED) {
#pragma unroll
    for (int i = 0; i < ATT_D; ++i) if (i < nt) A_GLOAD(tile_lo + ((rot + i >= nt) ? rot + i - nt : rot + i), i)
  }
  { const int r = nt - 1;
    if (r >= 4) wait_vmcnt<8>(); else if (r == 3) wait_vmcnt<6>(); else if (r == 2) wait_vmcnt<4>(); else if (r == 1) wait_vmcnt<2>(); else wait_vmcnt<0>(); }
  half8 pf[2][2];
  v2i vr[4][4];
#pragma unroll
  for (int a = 0; a < 2; ++a)
#pragma unroll
    for (int b = 0; b < 2; ++b) pf[a][b] = (half8){(half_t)0.f, (half_t)0.f, (half_t)0.f, (half_t)0.f, (half_t)0.f, (half_t)0.f, (half_t)0.f, (half_t)0.f};
#pragma unroll
  for (int a = 0; a < 4; ++a)
#pragma unroll
    for (int b = 0; b < 4; ++b) vr[a][b] = (v2i){0, 0};
  const half8 ones = (half8){(half_t)1.f, (half_t)1.f, (half_t)1.f, (half_t)1.f, (half_t)1.f, (half_t)1.f, (half_t)1.f, (half_t)1.f};
#define PP_PV { _Pragma("unroll") for (int df = 0; df < 4; ++df) _Pragma("unroll") for (int ks = 0; ks < 2; ++ks) { \
      const v2i lo2 = vr[df][2 * ks], hi2 = vr[df][2 * ks + 1]; const v4i pk4 = (v4i){lo2[0], lo2[1], hi2[0], hi2[1]}; const half8 vf = __builtin_bit_cast(half8, pk4); \
      _Pragma("unroll") for (int t2 = 0; t2 < 2; ++t2) o[df][t2] = __builtin_amdgcn_mfma_f32_16x16x32_f16(vf, pf[t2][ks], o[df][t2], 0, 0, 0); } \
    _Pragma("unroll") for (int ks = 0; ks < 2; ++ks) _Pragma("unroll") for (int t2 = 0; t2 < 2; ++t2) lacc[t2] = __builtin_amdgcn_mfma_f32_16x16x32_f16(ones, pf[t2][ks], lacc[t2], 0, 0, 0); }
  __builtin_amdgcn_sched_barrier(0);
  if (th == 1) __builtin_amdgcn_s_barrier();
  __builtin_amdgcn_sched_barrier(0);
  int trel = rot, tpf = rot + ATT_D; while (tpf >= nt) tpf -= nt;
  v4i kq[2][4];
  const unsigned kco0 = (unsigned)(((4 * 0 + q) ^ kswz) << 4), kco1 = (unsigned)(((4 * 1 + q) ^ kswz) << 4);
#define PP_KREAD(BUF) { const unsigned kb_ = (unsigned)(size_t)(smem + ATT_K + (BUF) * 8192 + k_rd); const unsigned ka0 = kb_ + kco0, ka1 = kb_ + kco1; \
    asm volatile("ds_read_b128 %0, %8\n\tds_read_b128 %1, %8 offset:2048\n\tds_read_b128 %2, %8 offset:4096\n\tds_read_b128 %3, %8 offset:6144\n\t" \
                 "ds_read_b128 %4, %9\n\tds_read_b128 %5, %9 offset:2048\n\tds_read_b128 %6, %9 offset:4096\n\tds_read_b128 %7, %9 offset:6144" \
                 : "=&v"(kq[0][0]), "=&v"(kq[0][1]), "=&v"(kq[0][2]), "=&v"(kq[0][3]), "=&v"(kq[1][0]), "=&v"(kq[1][1]), "=&v"(kq[1][2]), "=&v"(kq[1][3]) \
                 : "v"(ka0), "v"(ka1) : "memory"); }
#define PP_KWAIT asm volatile("s_waitcnt lgkmcnt(0)" : "+v"(kq[0][0]), "+v"(kq[0][1]), "+v"(kq[0][2]), "+v"(kq[0][3]), "+v"(kq[1][0]), "+v"(kq[1][1]), "+v"(kq[1][2]), "+v"(kq[1][3]) :: "memory");
#pragma unroll 1
  for (int it = 0; it < nt; ++it) {
    const int ti = tile_lo + trel, cur = it % ATT_NB;
    trel = (trel + 1 == nt) ? 0 : trel + 1;
    PP_BAR
    f32x4 s[4][2];
    PP_KREAD(cur)
    __builtin_amdgcn_s_setprio(1);
    PP_PV
    PP_KWAIT
#pragma unroll
    for (int t2 = 0; t2 < 2; ++t2) {
      float c0 = -m[t2];
      if (MODE == 2 && !((selm[t2] >> ti) & 1ull)) c0 = -INFINITY;
#pragma unroll
      for (int kf = 0; kf < 4; ++kf) s[kf][t2] = (f32x4){c0, c0, c0, c0};
    }
#pragma unroll
    for (int ks = 0; ks < 2; ++ks) {
#pragma unroll
      for (int kf = 0; kf < 4; ++kf) {
        const half8 kfr = __builtin_bit_cast(half8, kq[ks][kf]);
#pragma unroll
        for (int t2 = 0; t2 < 2; ++t2) s[kf][t2] = __builtin_amdgcn_mfma_f32_16x16x32_f16(kfr, qf[t2][ks], s[kf][t2], 0, 0, 0);
      }
    }
    __builtin_amdgcn_s_setprio(0);
    { const int r = nt - 2 - it;
      if (r >= 3) wait_vmcnt<6>(); else if (r == 2) wait_vmcnt<4>(); else if (r == 1) wait_vmcnt<2>(); else wait_vmcnt<0>(); }
    PP_BAR
    if (it + ATT_D < nt) A_GLOAD(tile_lo + tpf, (it + ATT_D) % ATT_NB)
    tpf = (tpf + 1 == nt) ? 0 : tpf + 1;
    {
      const unsigned vbl = (unsigned)(size_t)(smem + ATT_V + cur * 8192 + v_rd);
      const unsigned va0 = vbl + (((0) ^ fx) << 4), va1 = vbl + (((2) ^ fx) << 4), va2 = vbl + (((4) ^ fx) << 4), va3 = vbl + (((6) ^ fx) << 4);
      asm volatile(
          "ds_read_b64_tr_b16 %0, %16\n\tds_read_b64_tr_b16 %1, %16 offset:2048\n\tds_read_b64_tr_b16 %2, %16 offset:4096\n\tds_read_b64_tr_b16 %3, %16 offset:6144\n\t"
          "ds_read_b64_tr_b16 %4, %17\n\tds_read_b64_tr_b16 %5, %17 offset:2048\n\tds_read_b64_tr_b16 %6, %17 offset:4096\n\tds_read_b64_tr_b16 %7, %17 offset:6144\n\t"
          "ds_read_b64_tr_b16 %8, %18\n\tds_read_b64_tr_b16 %9, %18 offset:2048\n\tds_read_b64_tr_b16 %10, %18 offset:4096\n\tds_read_b64_tr_b16 %11, %18 offset:6144\n\t"
          "ds_read_b64_tr_b16 %12, %19\n\tds_read_b64_tr_b16 %13, %19 offset:2048\n\tds_read_b64_tr_b16 %14, %19 offset:4096\n\tds_read_b64_tr_b16 %15, %19 offset:6144"
          : "=&v"(vr[0][0]), "=&v"(vr[0][1]), "=&v"(vr[0][2]), "=&v"(vr[0][3]), "=&v"(vr[1][0]), "=&v"(vr[1][1]), "=&v"(vr[1][2]), "=&v"(vr[1][3]),
            "=&v"(vr[2][0]), "=&v"(vr[2][1]), "=&v"(vr[2][2]), "=&v"(vr[2][3]), "=&v"(vr[3][0]), "=&v"(vr[3][1]), "=&v"(vr[3][2]), "=&v"(vr[3][3])
          : "v"(va0), "v"(va1), "v"(va2), "v"(va3)
          : "memory");
    }
    bool need_mask;
    if (MODE == 2) need_mask = (ti == n); else need_mask = (ti == n) || (ti == n - 8);
    if (need_mask) {
#pragma unroll
      for (int t2 = 0; t2 < 2; ++t2) {
        const int tok = th * 32 + t2 * 16 + r15;
        int lo = 0, hi = 63;
        if (MODE == 2) { hi = tok; }
        else { if (ti == n) hi = tok; else lo = tok + 1; }
#pragma unroll
        for (int kf = 0; kf < 4; ++kf)
#pragma unroll
          for (int r = 0; r < 4; ++r) {
            const int kk = kf * 16 + 4 * q + r;
            if (kk < lo || kk > hi) s[kf][t2][r] = -INFINITY;
          }
      }
    }
#pragma unroll
    for (int t2 = 0; t2 < 2; ++t2) {
#pragma unroll
      for (int kf = 0; kf < 4; ++kf)
#pragma unroll
        for (int r = 0; r < 4; ++r) s[kf][t2][r] = fexp2(s[kf][t2][r]);
#pragma unroll
      for (int ks = 0; ks < 2; ++ks) {
        half8 pk;
#pragma unroll
        for (int r = 0; r < 4; ++r) { pk[r] = (half_t)s[2 * ks][t2][r]; pk[4 + r] = (half_t)s[2 * ks + 1][t2][r]; }
        pf[t2][ks] = pk;
      }
    }
    asm volatile("s_waitcnt lgkmcnt(0)"
                 : "+v"(vr[0][0]), "+v"(vr[0][1]), "+v"(vr[0][2]), "+v"(vr[0][3]), "+v"(vr[1][0]), "+v"(vr[1][1]), "+v"(vr[1][2]), "+v"(vr[1][3]),
                   "+v"(vr[2][0]), "+v"(vr[2][1]), "+v"(vr[2][2]), "+v"(vr[2][3]), "+v"(vr[3][0]), "+v"(vr[3][1]), "+v"(vr[3][2]), "+v"(vr[3][3])
                 :: "memory");
  }
  PP_BAR
  PP_PV
  __builtin_amdgcn_sched_barrier(0);
  if (th == 0) __builtin_amdgcn_s_barrier();
  __builtin_amdgcn_sched_barrier(0);
  l[0] = lacc[0][0]; l[1] = lacc[1][0];
  __syncthreads();
#undef A_GLOAD
#undef PP_BAR
#undef PP_PV
#undef PP_KREAD
#undef PP_KWAIT
}

__device__ void ph_attn_mfma(const Params& P, char* smem, int wvs) {
  unsigned int* impu = (unsigned int*)(smem + ATT_IMP);
  unsigned long long* selmask = (unsigned long long*)(smem + ATT_SELM);
  const int G = gridDim.x, nrounds = (2048 + G - 1) / G;
  for (int rd = 0; rd < nrounds; ++rd) {
    const int idx = rd * G + ((rd & 1) ? (G - 1 - (int)blockIdx.x) : (int)blockIdx.x);
    if (idx >= 2048) continue;
    const int tid = otid(wvs), lane = tid & 63, r15 = lane & 15, q = lane >> 4;
    const int n = 63 - (idx >> 5), bg = idx & 31, b = bg >> 2, g = bg & 3;
    const int wv = __builtin_amdgcn_readfirstlane(otid(wvs) >> 6);
    const int hd = g * 4 + (wv & 3), th = wv >> 2;
    const int t0 = b * SEQ + n * 64 + th * 32;
    const half_t* kc = P.kcmp + (size_t)bg * 256 * 64;
    const half_t* vc = P.vcmp + (size_t)bg * 256 * 64;
    const int nct = (4 * n + 2) / 64;
    attn_issue(smem, kc, vc, 64, 0, nct, wvs);
    half8 qf[2][2];
#pragma unroll
    for (int t2 = 0; t2 < 2; ++t2)
#pragma unroll
      for (int ks = 0; ks < 2; ++ks) qf[t2][ks] = *(const half8*)(P.p + (size_t)(t0 + t2 * 16 + r15) * LD1 + hd * 64 + 32 * ks + 8 * q);
    float* gate_l = (float*)(smem + ATT_GATE) + wv * 128;
    if (q == 0) {
#pragma unroll
      for (int t2 = 0; t2 < 2; ++t2) {
        const float* pr = P.gl + (size_t)(t0 + t2 * 16 + r15) * 48 + hd * 3;
        f32x4 gv;
#pragma unroll
        for (int c = 0; c < 3; ++c) gv[c] = sigmoidf(pr[c] + P.nsa_b_gate[hd * 3 + c]);
        gv[3] = 0.f;
        *(f32x4*)(gate_l + (t2 * 16 + r15) * 4) = gv;
      }
    }
    { const int tz = otid(wvs); for (int i = tz; i < 64 * IMPS + 128; i += NTHREADS) impu[i] = 0u; }
    float m[2], l[2]; f32x4 o[4][2]; unsigned long long selm[2] = {0ull, 0ull};
#pragma unroll
    for (int t2 = 0; t2 < 2; ++t2) { m[t2] = -1e30f; l[t2] = 0.f; }
#pragma unroll
    for (int df = 0; df < 4; ++df)
#pragma unroll
      for (int t2 = 0; t2 < 2; ++t2) o[df][t2] = (f32x4){0.f, 0.f, 0.f, 0.f};
    attn_branch<0, true>(smem, kc, vc, 64, 0, nct, n, th, qf, m, l, o, selm, wvs);
#pragma unroll
    for (int t2 = 0; t2 < 2; ++t2) {
      float lt = l[t2];
      lt = rowsum4(lt);
      l[t2] = lt > 0.f ? 1.f / lt : 0.f;
    }
    attn_branch<1>(smem, kc, vc, 64, 0, nct, n, th, qf, m, l, o, selm, wvs);
    f32x4 oacc[4][2];
#pragma unroll
    for (int t2 = 0; t2 < 2; ++t2) {
      const float gc = gate_l[(t2 * 16 + r15) * 4 + 0];
#pragma unroll
      for (int df = 0; df < 4; ++df) oacc[df][t2] = o[df][t2] * gc;
    }
    const int shr = ((int)blockIdx.x >> 5) & 7;
    const int rot_s = (shr * (n + 1)) >> 3;
    attn_issue(smem, P.p + (size_t)b * SEQ * LD1 + 1536 + g * 64, P.p + (size_t)b * SEQ * LD1 + 1792 + g * 64, LD1, 0, n, wvs, rot_s);
    {
      const int tid2 = otid(wvs);
      const int tok = tid2 >> 3, part = tid2 & 7;
      unsigned long long msk;
      if (n + 1 <= 16) {
        msk = (1ull << (n + 1)) - 1ull;
      } else {
        const uint4* rowp = (const uint4*)(impu + tok * IMPS);
        unsigned own[8];
        { const uint4 a = rowp[part * 2], b2 = rowp[part * 2 + 1];
          own[0] = a.x; own[1] = a.y; own[2] = a.z; own[3] = a.w; own[4] = b2.x; own[5] = b2.y; own[6] = b2.z; own[7] = b2.w; }
        int rank[8];
#pragma unroll
        for (int jj = 0; jj < 8; ++jj) {
          const int j = part * 8 + jj;
          own[jj] = (j >= 1 && j <= n - 2) ? ((own[jj] & ~63u) | (unsigned)(63 - j)) : 0xffffffffu;
          rank[jj] = 0;
        }
#pragma unroll 2
        for (int c4 = 0; c4 < 16; ++c4) {
          const uint4 v = rowp[c4];
          unsigned kv[4] = {v.x, v.y, v.z, v.w};
#pragma unroll
          for (int e = 0; e < 4; ++e) {
            const int j2 = c4 * 4 + e;
            const unsigned key2 = (j2 >= 1 && j2 <= n - 2) ? ((kv[e] & ~63u) | (unsigned)(63 - j2)) : 0u;
#pragma unroll
            for (int jj = 0; jj < 8; ++jj) rank[jj] += (key2 > own[jj]) ? 1 : 0;
          }
        }
        unsigned int bits = 0;
#pragma unroll
        for (int jj = 0; jj < 8; ++jj) if (rank[jj] < 13 && own[jj] != 0xffffffffu) bits |= 1u << jj;
        unsigned* sel32 = (unsigned*)selmask;
        if (bits) atomicOr(&sel32[tok * 2 + (part >> 2)], bits << (8 * (part & 3)));
        msk = 1ull | (1ull << n) | (1ull << (n - 1));
        if (part == 0) { atomicOr(&sel32[tok * 2], (unsigned)msk); atomicOr(&sel32[tok * 2 + 1], (unsigned)(msk >> 32)); }
      }
      if (n + 1 <= 16 && part == 0) selmask[tok] = msk;
    }
    __syncthreads();
#pragma unroll
    for (int t2 = 0; t2 < 2; ++t2) selm[t2] = selmask[th * 32 + t2 * 16 + r15];
    float qn2[2];
#pragma unroll
    for (int t2 = 0; t2 < 2; ++t2) {
      float a = 0.f;
#pragma unroll
      for (int ks = 0; ks < 2; ++ks)
#pragma unroll
        for (int e = 0; e < 8; ++e) a += (float)qf[t2][ks][e] * (float)qf[t2][ks][e];
      qn2[t2] = rowsum4(a);
    }
    { const float km = __uint_as_float(P.kmax2[bg * 2 + 0]);
#pragma unroll
      for (int t2 = 0; t2 < 2; ++t2) { m[t2] = sqrtf(qn2[t2] * km) * 1.001f - 5.0f * LOG2E; l[t2] = 0.f; } }
#pragma unroll
    for (int df = 0; df < 4; ++df)
#pragma unroll
      for (int t2 = 0; t2 < 2; ++t2) o[df][t2] = (f32x4){0.f, 0.f, 0.f, 0.f};
    attn_branch_pp<2, true>(smem, P.p + (size_t)b * SEQ * LD1 + 1536 + g * 64, P.p + (size_t)b * SEQ * LD1 + 1792 + g * 64, LD1, 0, n, n, th, qf, m, l, o, selm, wvs, rot_s);
#pragma unroll
    for (int t2 = 0; t2 < 2; ++t2) {
      const float gs = gate_l[(t2 * 16 + r15) * 4 + 1] / l[t2];
#pragma unroll
      for (int df = 0; df < 4; ++df) oacc[df][t2] += o[df][t2] * gs;
    }
    { const float km = __uint_as_float(P.kmax2[bg * 2 + 1]);
#pragma unroll
      for (int t2 = 0; t2 < 2; ++t2) { m[t2] = sqrtf(qn2[t2] * km) * 1.001f - 5.0f * LOG2E; l[t2] = 0.f; } }
#pragma unroll
    for (int df = 0; df < 4; ++df)
#pragma unroll
      for (int t2 = 0; t2 < 2; ++t2) o[df][t2] = (f32x4){0.f, 0.f, 0.f, 0.f};
    attn_branch_pp<3, false>(smem, P.p + (size_t)b * SEQ * LD1 + 2048 + g * 64, P.p + (size_t)b * SEQ * LD1 + 2304 + g * 64, LD1, (n > 8 ? n - 8 : 0), n, n, th, qf, m, l, o, selm, wvs, ((7 - shr) * (n > 8 ? 9 : n + 1)) >> 3);
    {
      int tbase = t0 + r15; asm volatile("" : "+v"(tbase));
#pragma unroll
      for (int t2 = 0; t2 < 2; ++t2) {
        const size_t tok = (size_t)(tbase + t2 * 16);
        const float gw = gate_l[(t2 * 16 + r15) * 4 + 2] / l[t2];
#pragma unroll
        for (int df = 0; df < 4; ++df) {
          const f32x4 v = oacc[df][t2] + o[df][t2] * gw;
          const half4 z = *(const half4*)(P.p + tok * LD1 + 2560 + hd * 64 + df * 16 + 4 * q);
          half4 hv;
#pragma unroll
          for (int e = 0; e < 4; ++e) hv[e] = (half_t)(v[e] * siluf((float)z[e]));
          *(half4*)(P.og + tok * DM + hd * 64 + df * 16 + 4 * q) = hv;
        }
      }
    }
  }
}

constexpr int NPHASES = 13;
__device__ __forceinline__ void run_phase(int ph, const Params& P, char* smem, int wvs) {
  float* sm = (float*)smem;
  switch (ph) {
    case 0:
      if (blockIdx.x == 0 && otid(wvs) < 64) P.kmax2[otid(wvs)] = 0u;
      ph_xh_rstd(P.x, P.xh, P.rstd, wvs); ph_ropetab(P, wvs); prep_cbias_part(P, wvs);
      prep_weights(P, sm, wvs);
      prep_wT(P.nsa_w_in, NSA_IN, P.pre_norm + DM, P.WglT, 64, DM, 5, sm, wvs);
      prep_wT(P.gla_w_in, GLA_IN, P.pre_norm, P.WglrT, 64, DM, 6, sm, wvs);
      break;
    case 1:
      g8::gemm(g8::SrcPlain8{P.xh, DM, P.W0t, DM}, T_TOK, LD0, DM, g8::EpiStore8{P.p, LD0, P.rstd}, smem, wvs);
      ph_rowproj<1>(P, P.WglrT, P.glr, smem, wvs, 0);
      break;
    case 2: prep_cbias_reduce(P, wvs); ph_gla_prep(P, sm, wvs); break;
    case 13: ph_gla_mfma<true>(P, smem, wvs); break;
    case 3: ph_gla_mfma<false>(P, smem, wvs); break;
    case 4: ph_gla_post(P, wvs); break;
    case 5: g8::gemm(g8::SrcPlain8{P.og, DM, P.Wo0t, DM}, T_TOK, DM, DM, g8::EpiStore8{P.y, DM, nullptr}, smem, wvs); break;
    case 6: ph_post<false>(P.xh, P.y, P.post_norm, nullptr, P.xh, P.rstd, wvs); break;
    case 7: g8::gemm(g8::SrcPlain8{P.xh, DM, P.W1t, DM}, T_TOK, LD1, DM, g8::EpiRope8{P.p, LD1, P.rstd, P.ropetab}, smem, wvs); break;
    case 8:
      if (blockIdx.x >= 64) { ph_kmax(P, wvs, 64); ph_rowproj<3>(P, P.WglT, P.gl, smem, wvs, 64); }
      g8::gemm(g8::SrcCmp1_8{P.p, P.cw1t}, 16384, 256, 2048, g8::EpiCmpHid8{P.hid, P.cbias}, smem, wvs);
      asm volatile("s_waitcnt vmcnt(0)" ::: "memory");
      __syncthreads();
      g8::gemm(g8::SrcCmp2_8{P.hid, P.cw2t}, 16384, 256, 256, g8::EpiCmpOut8{P.kcmp, P.vcmp}, smem, wvs);
      break;
    case 10: ph_attn_mfma(P, smem, wvs); break;
    case 11: g8::gemm(g8::SrcPlain8{P.og, DM, P.Wo1t, DM}, T_TOK, DM, DM, g8::EpiStore8{P.y, DM, nullptr}, smem, wvs); break;
    case 12: ph_post<true>(P.x1h, P.y, P.post_norm + DM, P.out, nullptr, nullptr, wvs); break;
  }
}

template <int PH>
__global__ void __launch_bounds__(NTHREADS, 2) k_phase(Params P) {
  __shared__ __attribute__((aligned(16))) char smem[SMEM_BYTES];
  run_phase(PH, P, smem, __builtin_amdgcn_readfirstlane(threadIdx.x >> 6));
}
template <int PH>
static void launch_phases(const Params& P, hipStream_t stream) {
  hipLaunchKernelGGL((k_phase<PH>), dim3(256), dim3(NTHREADS), 0, stream, P);
  if constexpr (PH + 1 < NPHASES) launch_phases<PH + 1>(P, stream);
}

#if MEGA
__global__ void __launch_bounds__(NTHREADS, 2) k_mega(Params P) {
  __shared__ __attribute__((aligned(16))) char smem[SMEM_BYTES];
  cg::grid_group grid = cg::this_grid();
  if (P.use_cg_sync) grid.sync();
  unsigned bt = 0;
  const int wvs = __builtin_amdgcn_readfirstlane(threadIdx.x >> 6);
  run_phase(0, P, smem, wvs); fast_barrier(P.bar, bt, wvs);
  run_phase(1, P, smem, wvs); fast_barrier(P.bar, bt, wvs);
  run_phase(2, P, smem, wvs); fast_barrier(P.bar, bt, wvs);
  run_phase(13, P, smem, wvs); fast_barrier(P.bar, bt, wvs);
  run_phase(3, P, smem, wvs); fast_barrier(P.bar, bt, wvs);
  run_phase(4, P, smem, wvs); fast_barrier(P.bar, bt, wvs);
  run_phase(5, P, smem, wvs); fast_barrier(P.bar, bt, wvs);
  run_phase(6, P, smem, wvs); fast_barrier(P.bar, bt, wvs);
  run_phase(7, P, smem, wvs); fast_barrier(P.bar, bt, wvs);
  run_phase(8, P, smem, wvs); fast_barrier(P.bar, bt, wvs);
  run_phase(10, P, smem, wvs); fast_barrier(P.bar, bt, wvs);
  run_phase(11, P, smem, wvs); fast_barrier(P.bar, bt, wvs);
  run_phase(12, P, smem, wvs);
}
#endif

extern "C" void kernel_launch(void* const* d_in, const int* in_sizes, int n_in, void* d_out, int out_size, void* d_ws, size_t ws_size,
                              hipStream_t stream) {
  Params P{};
  P.x = (const float*)d_in[0]; P.pos = (const int*)d_in[1]; P.pre_norm = (const float*)d_in[2]; P.post_norm = (const float*)d_in[3];
  P.gla_w_in = (const float*)d_in[4]; P.gla_w_gk_up = (const float*)d_in[5]; P.gla_b_gk = (const float*)d_in[6];
  P.gla_head_norm = (const float*)d_in[7]; P.gla_w_out = (const float*)d_in[8];
  P.nsa_w_in = (const float*)d_in[9]; P.nsa_b_gate = (const float*)d_in[10]; P.nsa_pe_k = (const float*)d_in[11]; P.nsa_pe_v = (const float*)d_in[12];
  P.ck_w1 = (const float*)d_in[13]; P.ck_w2 = (const float*)d_in[14]; P.cv_w1 = (const float*)d_in[15]; P.cv_w2 = (const float*)d_in[16];
  P.nsa_w_out = (const float*)d_in[17];
  P.out = (float*)d_out;
  char* ws = (char*)d_ws;
  const size_t MB = 1024 * 1024;
  P.W0t = (half_t*)(ws);
  P.Wo0t = (half_t*)(ws + 7 * MB);
  P.W1t = (half_t*)(ws + 9 * MB);
  P.Wo1t = (half_t*)(ws + 17 * MB);
  P.cw1t = (half_t*)(ws + 19 * MB);
  P.cw2t = (half_t*)(ws + 21 * MB);
  P.cbias = (float*)(ws + 22 * MB);
  P.cbias_part = (float*)(ws + 22 * MB + 4096);
  P.bar = (unsigned*)(ws + 23 * MB);
  P.use_cg_sync = 0;
  P.kmax2 = (unsigned*)(ws + 22 * MB + 512 * 1024);
  P.xh = (half_t*)(ws + 24 * MB);
  P.x1h = P.xh;
  P.p = (half_t*)(ws + 88 * MB);
  P.y = (half_t*)(ws + 88 * MB);
  P.og = (half_t*)(ws + 328 * MB);
  P.bcum = (float*)(ws + 392 * MB);
  P.rstd = (float*)(ws + 456 * MB);
  P.kcmp = (half_t*)(ws + 457 * MB);
  P.vcmp = (half_t*)(ws + 458 * MB);
  P.ropetab = (float*)(ws + 459 * MB);
  P.hid = (half_t*)(ws + 467 * MB);
  P.WglT = (half_t*)(ws + 22 * MB + 768 * 1024);
  P.WglrT = (half_t*)(ws + 22 * MB + 896 * 1024);
  P.glr = (float*)(ws + 509 * MB);
  P.gl = (float*)(ws + 503 * MB);
  P.gla_state = (float*)(ws + 476 * MB);
  if (ws_size < 512 * MB) { fprintf(stderr, "ws too small: %zu\n", ws_size); return; }
#if MEGA
  static int grid_blocks = 0;
  if (!grid_blocks) {
    int dev = 0, cus = 0, per_cu = 0;
    hipGetDevice(&dev);
    hipDeviceGetAttribute(&cus, hipDeviceAttributeMultiprocessorCount, dev);
    hipOccupancyMaxActiveBlocksPerMultiprocessor(&per_cu, k_mega, NTHREADS, 0);
    if (per_cu < 1) per_cu = 1;
    if (per_cu > 1) per_cu = 1;
    grid_blocks = cus * per_cu;
  }
  hipMemsetAsync(ws + 23 * MB, 0, 16384, stream);
  void* args[] = {&P};
  hipError_t e = hipLaunchCooperativeKernel((void*)k_mega, dim3(grid_blocks), dim3(NTHREADS), args, 0, stream);
  if (e != hipSuccess) fprintf(stderr, "cooperative launch failed: %s (grid %d)\n", hipGetErrorString(e), grid_blocks);
#else
  launch_phases<0>(P, stream);
#endif
}
```

```cpp
#include <hip/hip_runtime.h>
#include <hip/hip_cooperative_groups.h>
#include <cstdio>
#include <cstdint>
namespace cg = cooperative_groups;

typedef _Float16 half_t;
typedef _Float16 half8 __attribute__((ext_vector_type(8)));
typedef _Float16 half4 __attribute__((ext_vector_type(4)));
typedef float f32x4 __attribute__((ext_vector_type(4)));
typedef int v2i __attribute__((ext_vector_type(2)));
typedef int v4i __attribute__((ext_vector_type(4)));

#ifndef MEGA
#define MEGA 1
#endif

constexpr int T_TOK = 32768, DM = 1024, SEQ = 4096, NBATCH = 8;
constexpr int GLA_IN = 3088, NSA_IN = 3632;
constexpr int LD0 = 3072, LD1 = 3584;
constexpr int NC = 255;
constexpr float EPS = 1e-6f;
constexpr int NTHREADS = 512, NWAVES = NTHREADS / 64;
constexpr int SMEM_BYTES = 160 * 1024;

struct Params {
  const float* x; const int* pos; const float* pre_norm; const float* post_norm;
  const float* gla_w_in; const float* gla_w_gk_up; const float* gla_b_gk; const float* gla_head_norm; const float* gla_w_out;
  const float* nsa_w_in; const float* nsa_b_gate; const float* nsa_pe_k; const float* nsa_pe_v;
  const float* ck_w1; const float* ck_w2; const float* cv_w1; const float* cv_w2; const float* nsa_w_out;
  float* out;
  half_t* p; half_t* y; half_t* og; float* bcum; float* rstd; half_t* kcmp; half_t* vcmp; float* ropetab;
  half_t* xh; half_t* W0t; half_t* Wo0t; half_t* W1t; half_t* Wo1t;
  half_t* cw1t; half_t* cw2t; float* cbias; half_t* hid;
  float* cbias_part; unsigned* bar; long long use_cg_sync; unsigned* kmax2; float* gla_state; half_t* WglT; float* gl; half_t* x1h; half_t* WglrT; float* glr;
};

__device__ __forceinline__ int lane_id() { return (int)__builtin_amdgcn_mbcnt_hi(~0u, __builtin_amdgcn_mbcnt_lo(~0u, 0u)); }
__device__ __forceinline__ int otid(int wvs) { int t = wvs * 64 + lane_id(); asm volatile("" : "+v"(t)); return t; }
__device__ __forceinline__ float wave_sum(float v) {
#pragma unroll
  for (int o = 32; o > 0; o >>= 1) v += __shfl_xor(v, o);
  return v;
}
__device__ __forceinline__ float wave_max(float v) {
#pragma unroll
  for (int o = 32; o > 0; o >>= 1) v = fmaxf(v, __shfl_xor(v, o));
  return v;
}
typedef __attribute__((address_space(3))) void lds_void;
typedef __attribute__((address_space(1))) const void gbl_void;
typedef short s16x4 __attribute__((vector_size(8)));
typedef __attribute__((address_space(3))) s16x4 lds_s16x4;
__device__ __forceinline__ half4 tr_read4(const char* p) {
  const s16x4 v = __builtin_amdgcn_ds_read_tr16_b64_v4i16((lds_s16x4*)(p));
  return __builtin_bit_cast(half4, v);
}
template <int N> __device__ __forceinline__ void wait_vmcnt() { asm volatile("s_waitcnt vmcnt(%0)" ::"n"(N) : "memory"); }
constexpr float LOG2E = 1.4426950408889634f;
__device__ __forceinline__ float fexp2(float x) { return __builtin_amdgcn_exp2f(x); }
typedef unsigned u32x2 __attribute__((ext_vector_type(2)));
__device__ __forceinline__ float rowmax4(float x) {
  u32x2 r = __builtin_amdgcn_permlane16_swap(__float_as_uint(x), __float_as_uint(x), false, false);
  x = fmaxf(__uint_as_float(r[0]), __uint_as_float(r[1]));
  r = __builtin_amdgcn_permlane32_swap(__float_as_uint(x), __float_as_uint(x), false, false);
  return fmaxf(__uint_as_float(r[0]), __uint_as_float(r[1]));
}
__device__ __forceinline__ float rowsum4(float x) {
  u32x2 r = __builtin_amdgcn_permlane16_swap(__float_as_uint(x), __float_as_uint(x), false, false);
  x = __uint_as_float(r[0]) + __uint_as_float(r[1]);
  r = __builtin_amdgcn_permlane32_swap(__float_as_uint(x), __float_as_uint(x), false, false);
  return __uint_as_float(r[0]) + __uint_as_float(r[1]);
}
__device__ __forceinline__ float fast_exp2(float x) { return __builtin_amdgcn_exp2f(x); }
__device__ __forceinline__ float sigmoidf(float v) { return __builtin_amdgcn_rcpf(1.f + fast_exp2(-1.4426950408889634f * v)); }
__device__ __forceinline__ float siluf(float v) { return v * sigmoidf(v); }
__device__ __forceinline__ float logsigmoidf(float u) { return fminf(u, 0.f) - 0.6931471805599453f * __builtin_amdgcn_logf(1.f + fast_exp2(-1.4426950408889634f * fabsf(u))); }

__device__ __forceinline__ void fast_barrier(unsigned* bar, unsigned& round, int wvs) {
  asm volatile("s_waitcnt vmcnt(0) lgkmcnt(0)" ::: "memory");
  __syncthreads();
  round += 1;
  if (wvs == 0 && lane_id() == 0) {
    __builtin_amdgcn_fence(__ATOMIC_RELEASE, "agent");
    asm volatile("s_waitcnt vmcnt(0)" ::: "memory");
    const unsigned ngroups = gridDim.x >> 4;
    const unsigned old = __hip_atomic_fetch_add(bar + 64 + 64 * (blockIdx.x >> 4), 1u, __ATOMIC_RELAXED, __HIP_MEMORY_SCOPE_AGENT);
    if (old + 1 == round * 16u) __hip_atomic_fetch_add(bar, 1u, __ATOMIC_RELAXED, __HIP_MEMORY_SCOPE_AGENT);
    const unsigned target = round * ngroups;
    while (__hip_atomic_load(bar, __ATOMIC_RELAXED, __HIP_MEMORY_SCOPE_AGENT) < target) { }
    __builtin_amdgcn_fence(__ATOMIC_ACQUIRE, "agent");
    asm volatile("s_waitcnt vmcnt(0)" ::: "memory");
  }
  __syncthreads();
}

__device__ void ph_xh_rstd(const float* src, half_t* xh, float* rstd, int wvs) {
  const int tid_ = otid(wvs); const int lane = tid_ & 63, w = tid_ >> 6;
  constexpr int RW = 4;
  const int rstride = gridDim.x * NWAVES;
#pragma unroll 1
  for (int row0 = blockIdx.x * NWAVES + w; row0 < T_TOK; row0 += rstride * RW) {
    float4 v[RW][4];
#pragma unroll
    for (int r = 0; r < RW; ++r)
#pragma unroll
      for (int i = 0; i < 4; ++i) v[r][i] = ((const float4*)(src + (size_t)(row0 + r * rstride) * DM))[lane + 64 * i];
#pragma unroll
    for (int r = 0; r < RW; ++r) {
      const int row = row0 + r * rstride;
      half4* xr = (half4*)(xh + (size_t)row * DM);
      float ss = 0.f;
#pragma unroll
      for (int i = 0; i < 4; ++i) {
        const float4 t = v[r][i];
        ss += t.x * t.x + t.y * t.y + t.z * t.z + t.w * t.w;
        half4 hv; hv[0] = (half_t)t.x; hv[1] = (half_t)t.y; hv[2] = (half_t)t.z; hv[3] = (half_t)t.w;
        xr[lane + 64 * i] = hv;
      }
      ss = wave_sum(ss);
      if (lane == 0) rstd[row] = rsqrtf(ss * (1.f / DM) + EPS);
    }
  }
}
__device__ void ph_ropetab(const Params& P, int wvs) {
  const int tid = otid(wvs);
  const float inv = powf(10000.f, -(float)(2 * (tid & 31)) / 64.f);
  for (int idx = blockIdx.x * NTHREADS + tid; idx < T_TOK * 32; idx += gridDim.x * NTHREADS) {
    const int t = idx >> 5, i = idx & 31;
    const float ang = (float)P.pos[t] * inv;
    float s, c; sincosf(ang, &s, &c);
    P.ropetab[t * 64 + i] = c; P.ropetab[t * 64 + 32 + i] = s;
  }
}
__device__ __forceinline__ int orig_col(int n, int mode) {
  if (mode == 0) {
    if (n < 2048) return n;
    if (n < 3072) return n + 16;
    return -1;
  } else if (mode == 1) {
    if (n < 2560) return n;
    if (n < 3584) return n + 48;
    return -1;
  } else if (mode == 5) {
    return n < 48 ? 2560 + n : -1;
  }
  if (mode == 4) return n < 64 ? n : -1;
  if (mode == 6) return n < 16 ? 2048 + n : -1;
  return n;
}
__device__ void prep_wT(const float* W, int ldw, const float* gamma, half_t* Wt, int Npad, int K, int mode, float* sm, int wvs) {
  float(*tile)[65] = (float(*)[65])sm;
  const int tid = otid(wvs);
  const int ntn = Npad / 64, ntk = K / 64;
  for (int t = blockIdx.x; t < ntn * ntk; t += gridDim.x) {
    const int n0 = (t / ntk) * 64, k0 = (t % ntk) * 64;
    __syncthreads();
#pragma unroll
    for (int r = 0; r < 4096 / NTHREADS; ++r) {
      const int idx = tid + r * NTHREADS, kk = idx >> 6, nn = idx & 63;
      const int on = orig_col(n0 + nn, mode);
      float v = 0.f;
      if (on >= 0) { v = W[(size_t)(k0 + kk) * ldw + on]; if (gamma) v *= gamma[k0 + kk]; }
      tile[kk][nn] = v;
    }
    __syncthreads();
    {
      const int nn = tid >> 3, oct = tid & 7;
      half8 hv;
#pragma unroll
      for (int e = 0; e < 8; ++e) hv[e] = (half_t)tile[oct * 8 + e][nn];
      *(half8*)(Wt + (size_t)(n0 + nn) * K + k0 + oct * 8) = hv;
    }
  }
}

__device__ __forceinline__ void prep_strip(const float* W, int ldw, const float* gamma, half_t* Wt, int K, int mode, int n0, int k0, float* sm, int tid) {
  float(*tile)[260] = (float(*)[260])sm;
  __syncthreads();
#pragma unroll
  for (int r = 0; r < 8; ++r) {
    const int idx = tid + r * NTHREADS, kk = idx >> 6, n4 = (idx & 63) * 4;
    const int on = orig_col(n0 + n4, mode);
    f32x4 v = (f32x4){0.f, 0.f, 0.f, 0.f};
    if (on >= 0) { v = *(const f32x4*)(W + (size_t)(k0 + kk) * ldw + on); if (gamma) v *= gamma[k0 + kk]; }
    *(f32x4*)&tile[kk][n4] = v;
  }
  __syncthreads();
#pragma unroll
  for (int r = 0; r < 4; ++r) {
    const int idx = tid + r * NTHREADS, nn = idx & 255, oct = idx >> 8;
    half8 hv;
#pragma unroll
    for (int e = 0; e < 8; ++e) hv[e] = (half_t)tile[oct * 8 + e][nn];
    *(half8*)(Wt + (size_t)(n0 + nn) * K + k0 + oct * 8) = hv;
  }
}
__device__ void prep_weights(const Params& P, float* sm, int wvs) {
  const int tid = otid(wvs);
  constexpr int NJ = 8;
  const int nstr[NJ] = {(LD0 / 256) * (DM / 64), (DM / 256) * (DM / 64), (LD1 / 256) * (DM / 64), (DM / 256) * (DM / 64), 32, 32, 4, 4};
  int total = 0;
#pragma unroll
  for (int j = 0; j < NJ; ++j) total += nstr[j];
  for (int w = blockIdx.x; w < total; w += gridDim.x) {
    int j = 0, t = w;
#pragma unroll
    for (int jj = 0; jj < NJ - 1; ++jj) if (j == jj && t >= nstr[jj]) { t -= nstr[jj]; j = jj + 1; }
    const float* W; int ldw; const float* gamma; half_t* Wt; int K, mode;
    switch (j) {
      case 0: W = P.gla_w_in; ldw = GLA_IN; gamma = P.pre_norm; Wt = P.W0t; K = DM; mode = 0; break;
      case 1: W = P.gla_w_out; ldw = DM; gamma = nullptr; Wt = P.Wo0t; K = DM; mode = 2; break;
      case 2: W = P.nsa_w_in; ldw = NSA_IN; gamma = P.pre_norm + DM; Wt = P.W1t; K = DM; mode = 1; break;
      case 3: W = P.nsa_w_out; ldw = DM; gamma = nullptr; Wt = P.Wo1t; K = DM; mode = 2; break;
      case 4: W = P.ck_w1; ldw = 256; gamma = nullptr; Wt = P.cw1t; K = 2048; mode = 2; break;
      case 5: W = P.cv_w1; ldw = 256; gamma = nullptr; Wt = P.cw1t + 256 * 2048; K = 2048; mode = 2; break;
      case 6: W = P.ck_w2; ldw = 64; gamma = nullptr; Wt = P.cw2t; K = 256; mode = 4; break;
      default: W = P.cv_w2; ldw = 64; gamma = nullptr; Wt = P.cw2t + 256 * 256; K = 256; mode = 4; break;
    }
    const int nsk = K / 64;
    prep_strip(W, ldw, gamma, Wt, K, mode, (t / nsk) * 256, (t % nsk) * 64, sm, tid);
  }
}

__device__ void prep_cbias_part(const Params& P, int wvs) {
  for (int idx = blockIdx.x * NTHREADS + otid(wvs); idx < 2 * 32 * 256; idx += gridDim.x * NTHREADS) {
    const int j = idx & 255, ks = (idx >> 8) & 31, which = idx >> 13;
    const float* pe = which ? P.nsa_pe_v : P.nsa_pe_k;
    const float* w1 = which ? P.cv_w1 : P.ck_w1;
    float a = 0.f;
#pragma unroll 8
    for (int k = ks * 64; k < ks * 64 + 64; ++k) a += pe[k] * w1[(size_t)k * 256 + j];
    P.cbias_part[idx] = a;
  }
}
__device__ void prep_cbias_reduce(const Params& P, int wvs) {
  if (blockIdx.x < 2 && otid(wvs) < 256) {
    const int which = blockIdx.x, j = otid(wvs);
    float a = 0.f;
    for (int ks = 0; ks < 32; ++ks) a += P.cbias_part[(which * 32 + ks) * 256 + j];
    P.cbias[which * 256 + j] = a;
  }
}

namespace g8 {
constexpr int BK = 64, HALF = 128, HTB = HALF * BK * 2;
__device__ __forceinline__ int lds_byte(int r, int c) { const int st = (r >> 4) * 2 + (c >> 5), rr = r & 15, cc = c & 31, ob = rr * 64 + cc * 2; return st * 1024 + (ob ^ (((ob >> 9) & 1) << 5)); }
__device__ __forceinline__ void stage_rc(int b, int& R, int& C) { const int st = b / 1024, sb = b % 1024, swz = sb ^ (((sb >> 9) & 1) << 5); R = (st >> 1) * 16 + swz / 64; C = (st & 1) * 32 + (swz % 64) / 2; }
typedef f32x4 Acc[2][2][4][2];

struct SrcPlain8 {
  const half_t* A; int lda; const half_t* Bt; int K;
  __device__ __forceinline__ void get(int pm, int pn, const half_t*& Ag, const half_t*& Bg, size_t& a_rs, int& a_ks) const {
    Ag = A + (size_t)pm * 256 * lda; Bg = Bt + (size_t)pn * 256 * K; a_rs = lda; a_ks = 64;
  }
};
struct SrcCmp1_8 {
  const half_t* p1; const half_t* w1t;
  __device__ __forceinline__ void get(int pm, int pn, const half_t*& Ag, const half_t*& Bg, size_t& a_rs, int& a_ks) const {
    const int which = pm >> 5, bg = pm & 31, b = bg >> 2, g = bg & 3;
    Ag = p1 + (size_t)(b * SEQ) * LD1 + (which ? 1280 : 1024) + g * 64;
    Bg = w1t + (size_t)which * 256 * 2048; a_rs = (size_t)16 * LD1; a_ks = LD1;
  }
};
struct SrcCmp2_8 {
  const half_t* hid; const half_t* w2t;
  __device__ __forceinline__ void get(int pm, int pn, const half_t*& Ag, const half_t*& Bg, size_t& a_rs, int& a_ks) const {
    Ag = hid + (size_t)pm * 256 * 256; Bg = w2t + (size_t)(pm >> 5) * 256 * 256; a_rs = 256; a_ks = 64;
  }
};

__device__ __forceinline__ half8 pack8(const f32x4 a, const f32x4 b) {
  half8 h; h[0] = (half_t)a[0]; h[1] = (half_t)a[1]; h[2] = (half_t)a[2]; h[3] = (half_t)a[3]; h[4] = (half_t)b[0]; h[5] = (half_t)b[1]; h[6] = (half_t)b[2]; h[7] = (half_t)b[3];
  return h;
}
struct EpiStore8 {
  half_t* C; int ldc; const float* rowscale;
  __device__ __forceinline__ void operator()(const Acc& acc, int row0, int col0, int wr, int wc, int fr, int fq) const {
#pragma unroll
    for (int ai = 0; ai < 2; ++ai)
#pragma unroll
      for (int m = 0; m < 4; ++m) {
        const int tok = row0 + ai * 128 + wr * 64 + m * 16 + fr;
        const float s = rowscale ? rowscale[tok] : 1.f;
        half_t* rowp = C + (size_t)tok * ldc + col0 + 64 * wc + 8 * fq;
#pragma unroll
        for (int bj = 0; bj < 2; ++bj) *(half8*)(rowp + 32 * bj) = pack8(acc[ai][bj][m][0] * s, acc[ai][bj][m][1] * s);
      }
  }
};
struct EpiRope8 {
  half_t* C; int ldc; const float* rowscale; const float* ropetab;
  __device__ __forceinline__ void operator()(const Acc& acc, int row0, int col0, int wr, int wc, int fr, int fq) const {
    const int grp = (col0 >> 6) + wc;
    const bool is_q = grp < 16;
    const bool roped = is_q || (grp >= 16 && grp < 20) || (grp >= 24 && grp < 28) || (grp >= 32 && grp < 36);
    const float sc = is_q ? 0.125f * 1.4426950408889634f : 1.f;
#pragma unroll
    for (int ai = 0; ai < 2; ++ai)
#pragma unroll
      for (int m = 0; m < 4; ++m) {
        const int tok = row0 + ai * 128 + wr * 64 + m * 16 + fr;
        const float s = rowscale[tok];
        half_t* rowp = C + (size_t)tok * ldc + col0 + 64 * wc + 8 * fq;
        f32x4 o1[2], o2[2];
#pragma unroll
        for (int n = 0; n < 2; ++n) {
          const f32x4 x1 = acc[ai][0][m][n] * s, x2 = acc[ai][1][m][n] * s;
          if (roped) {
            const f32x4 cs = *(const f32x4*)(ropetab + (size_t)tok * 64 + 8 * fq + 4 * n);
            const f32x4 sn = *(const f32x4*)(ropetab + (size_t)tok * 64 + 32 + 8 * fq + 4 * n);
            o1[n] = (x1 * cs - x2 * sn) * sc; o2[n] = (x2 * cs + x1 * sn) * sc;
          } else { o1[n] = x1; o2[n] = x2; }
        }
        *(half8*)(rowp) = pack8(o1[0], o1[1]);
        *(half8*)(rowp + 32) = pack8(o2[0], o2[1]);
      }
  }
};
struct EpiCmpHid8 {
  half_t* hid; const float* bias;
  __device__ __forceinline__ void operator()(const Acc& acc, int row0, int col0, int wr, int wc, int fr, int fq) const {
    const int which = row0 >> 13;
#pragma unroll
    for (int bj = 0; bj < 2; ++bj) {
      const int col = col0 + 64 * wc + 32 * bj + 8 * fq;
      const f32x4 b0 = *(const f32x4*)(bias + which * 256 + col), b1 = *(const f32x4*)(bias + which * 256 + col + 4);
#pragma unroll
      for (int ai = 0; ai < 2; ++ai)
#pragma unroll
        for (int m = 0; m < 4; ++m) {
          const int row = row0 + ai * 128 + wr * 64 + m * 16 + fr;
          f32x4 v0 = acc[ai][bj][m][0] + b0, v1 = acc[ai][bj][m][1] + b1;
#pragma unroll
          for (int e = 0; e < 4; ++e) { v0[e] = siluf(v0[e]); v1[e] = siluf(v1[e]); }
          *(half8*)(hid + (size_t)row * 256 + col) = pack8(v0, v1);
        }
    }
  }
};
struct EpiCmpOut8 {
  half_t* kcmp; half_t* vcmp;
  __device__ __forceinline__ void operator()(const Acc& acc, int row0, int col0, int wr, int wc, int fr, int fq) const {
    if (wc != 0) return;
#pragma unroll
    for (int ai = 0; ai < 2; ++ai)
#pragma unroll
      for (int m = 0; m < 4; ++m) {
        const int row = row0 + ai * 128 + wr * 64 + m * 16 + fr;
        const int which = row >> 13, r = row & 8191;
        half_t* dst = (which ? vcmp : kcmp) + (size_t)r * 64 + 8 * fq;
        const bool dead = (r & 255) == 255;
#pragma unroll
        for (int bj = 0; bj < 2; ++bj) {
          half8 hv = pack8(acc[ai][bj][m][0], acc[ai][bj][m][1]);
          if (dead) hv = (half8){(half_t)0.f, (half_t)0.f, (half_t)0.f, (half_t)0.f, (half_t)0.f, (half_t)0.f, (half_t)0.f, (half_t)0.f};
          *(half8*)(dst + 32 * bj) = hv;
        }
      }
  }
};

template <class Src, class Epi>
__device__ void gemm(const Src& src, int M, int N, int K, const Epi& epi, char* smem, int wvs) {
  const int tid = otid(wvs), wid = __builtin_amdgcn_readfirstlane(tid >> 6), lane = tid & 63, wr = wid >> 2, wc = wid & 3, fr = lane & 15, fq = lane >> 4;
  const int nM = M / 256, nN = N / 256, nwg = nM * nN, G = gridDim.x, nt = K / BK;
  int sr0, sc0, sr1, sc1;
  stage_rc(tid * 16, sr0, sc0); stage_rc(tid * 16 + 8192, sr1, sc1);
  const int a_base = lds_byte(wr * 64 + fr, fq * 8);
  int b_base = 65536 + lds_byte(wc * 32 + fr, fq * 8);
  asm volatile("" : "+v"(b_base));
#define SA8(b, h) (smem + ((b) * 2 + (h)) * HTB)
#define SB8(b, h) (smem + (4 + (b) * 2 + (h)) * HTB)
#define STAGE_A(P, h, kt) { const char* g_ = (const char*)(Ag + (size_t)(h) * 128 * lda + (size_t)(kt) * a_ks); \
    __builtin_amdgcn_global_load_lds((gbl_void*)(g_ + aob0), (lds_void*)((P) + wid * 1024), 16, 0, 0); \
    __builtin_amdgcn_global_load_lds((gbl_void*)(g_ + aob1), (lds_void*)((P) + 8192 + wid * 1024), 16, 0, 0); }
#define STAGE_B(P, h, kt) { const char* g_ = (const char*)(Bg + (size_t)(h) * 32 * K + (size_t)(kt) * 64);     \
    __builtin_amdgcn_global_load_lds((gbl_void*)(g_ + bob0), (lds_void*)((P) + wid * 1024), 16, 0, 0); \
    __builtin_amdgcn_global_load_lds((gbl_void*)(g_ + bob1), (lds_void*)((P) + 8192 + wid * 1024), 16, 0, 0); }
#define LDA8(dst, b, h) { _Pragma("unroll") for (int m = 0; m < 4; ++m) _Pragma("unroll") for (int k = 0; k < 2; ++k) dst[m][k] = *(const half8*)(SA8(b, h) + a_base + m * 2048 + k * 1024); }
#define LDB8(dst, b, h) { _Pragma("unroll") for (int n = 0; n < 2; ++n) _Pragma("unroll") for (int k = 0; k < 2; ++k) dst[n][k] = *(const half8*)(smem + ((b) * 2 + (h)) * HTB + b_base + n * 2048 + k * 1024); }
#define MMA8(ai, bj, At, Bx) { __builtin_amdgcn_s_setprio(1); \
    _Pragma("unroll") for (int m = 0; m < 4; ++m) _Pragma("unroll") for (int n = 0; n < 2; ++n) _Pragma("unroll") for (int k = 0; k < 2; ++k) \
      acc[ai][bj][m][n] = __builtin_amdgcn_mfma_f32_16x16x32_f16(Bx[n][k], At[m][k], acc[ai][bj][m][n], 0, 0, 0); \
    __builtin_amdgcn_s_setprio(0); }
#define WAIT_V(n) asm volatile("s_waitcnt vmcnt(" #n ")" ::: "memory")
#define WAIT_L(n) asm volatile("s_waitcnt lgkmcnt(" #n ")" ::: "memory")
#define BAR __builtin_amdgcn_s_barrier()
#define SCHED __builtin_amdgcn_sched_barrier(0)
  for (int it = 0;; ++it) {
    const int L = it * G + (int)blockIdx.x;
    if (L >= nwg) break;
    int wgid;
    { const int q = nwg / 8, r = nwg % 8, xcd = L % 8, off = L / 8; wgid = (xcd < r ? xcd * (q + 1) : r * (q + 1) + (xcd - r) * q) + off; }
    const int nig = 8 * nN, gid = wgid / nig, fm = gid * 8, gsz = (nM - fm) < 8 ? (nM - fm) : 8;
    const int pm = fm + ((wgid % nig) % gsz), pn = (wgid % nig) / gsz;
    const half_t* Ag; const half_t* Bg; size_t lda; int a_ks;
    src.get(pm, pn, Ag, Bg, lda, a_ks);
    const unsigned aob0 = (unsigned)(((size_t)sr0 * lda + sc0) * 2), aob1 = (unsigned)(((size_t)sr1 * lda + sc1) * 2);
    const int pr0 = 64 * (sr0 >> 5) + 8 * ((sr0 & 15) >> 2) + 4 * ((sr0 >> 4) & 1) + (sr0 & 3), pr1 = 64 * (sr1 >> 5) + 8 * ((sr1 & 15) >> 2) + 4 * ((sr1 >> 4) & 1) + (sr1 & 3);
    const unsigned bob0 = (unsigned)((pr0 * K + sc0) * 2), bob1 = (unsigned)((pr1 * K + sc1) * 2);
    Acc acc;
#pragma unroll
    for (int a = 0; a < 2; ++a)
#pragma unroll
      for (int b = 0; b < 2; ++b)
#pragma unroll
        for (int m = 0; m < 4; ++m)
#pragma unroll
          for (int n = 0; n < 2; ++n) acc[a][b][m][n] = (f32x4){0.f, 0.f, 0.f, 0.f};
    half8 At[4][2], B0[2][2], B1[2][2];
    STAGE_B(SB8(0, 0), 0, 0) STAGE_A(SA8(0, 0), 0, 0)
    STAGE_B(SB8(0, 1), 1, 0) STAGE_A(SA8(0, 1), 1, 0)
    if (wr == 1) BAR;
    WAIT_V(4); BAR;
    STAGE_B(SB8(1, 0), 0, 1) STAGE_A(SA8(1, 0), 0, 1) STAGE_B(SB8(1, 1), 1, 1)
    WAIT_V(6); BAR;
#pragma unroll 1
    for (int t = 0; t < nt - 2; t += 2) {
      LDB8(B0, 0, 0) SCHED; LDA8(At, 0, 0) STAGE_A(SA8(1, 1), 1, t + 1)
      WAIT_L(8); BAR; WAIT_L(0); MMA8(0, 0, At, B0) BAR; SCHED;
      LDB8(B1, 0, 1) STAGE_B(SB8(0, 0), 0, t + 2)
      BAR; WAIT_L(0); MMA8(0, 1, At, B1) BAR;
      LDA8(At, 0, 1) STAGE_A(SA8(0, 0), 0, t + 2)
      BAR; WAIT_L(0); MMA8(1, 0, At, B0) BAR; SCHED;
      STAGE_B(SB8(0, 1), 1, t + 2)
      WAIT_V(6); BAR; MMA8(1, 1, At, B1) BAR;
      LDB8(B0, 1, 0) SCHED; LDA8(At, 1, 0) STAGE_A(SA8(0, 1), 1, t + 2)
      WAIT_L(8); BAR; WAIT_L(0); MMA8(0, 0, At, B0) BAR; SCHED;
      LDB8(B1, 1, 1) STAGE_B(SB8(1, 0), 0, t + 3)
      BAR; WAIT_L(0); MMA8(0, 1, At, B1) BAR;
      LDA8(At, 1, 1) STAGE_A(SA8(1, 0), 0, t + 3)
      BAR; WAIT_L(0); MMA8(1, 0, At, B0) BAR; SCHED;
      STAGE_B(SB8(1, 1), 1, t + 3)
      WAIT_V(6); BAR; MMA8(1, 1, At, B1) BAR;
    }
    { LDB8(B0, 0, 0) LDA8(At, 0, 0) STAGE_A(SA8(1, 1), 1, nt - 1)
      BAR; WAIT_L(0); MMA8(0, 0, At, B0) BAR;
      LDB8(B1, 0, 1) BAR; WAIT_L(0); MMA8(0, 1, At, B1) BAR;
      LDA8(At, 0, 1) WAIT_V(4); BAR; WAIT_L(0); MMA8(1, 0, At, B0) MMA8(1, 1, At, B1) BAR; }
    { LDB8(B0, 1, 0) LDA8(At, 1, 0) WAIT_V(2); BAR; WAIT_L(0); MMA8(0, 0, At, B0) BAR;
      LDB8(B1, 1, 1) WAIT_V(0); BAR; WAIT_L(0); MMA8(0, 1, At, B1) BAR;
      LDA8(At, 1, 1) BAR; WAIT_L(0); MMA8(1, 0, At, B0) MMA8(1, 1, At, B1) BAR; }
    if (wr == 0) BAR;
    { int fr2 = fr, fq2 = fq; asm volatile("" : "+v"(fr2), "+v"(fq2)); epi(acc, pm * 256, pn * 256, wr, wc, fr2, fq2); }
  }
#undef SA8
#undef SB8
#undef STAGE_A
#undef STAGE_B
#undef LDA8
#undef LDB8
#undef MMA8
#undef WAIT_V
#undef WAIT_L
#undef BAR
#undef SCHED
}
}

struct GlaPrepOps { half8 q0, k0, q1, k1; float w[16]; float bb; };
__device__ void ph_gla_prep(const Params& P, float* sm, int wvs) {
  float(*glr)[16] = (float(*)[16])sm;
  float(*tot)[128] = (float(*)[128])(sm + 1024);
  float(*exl)[132] = (float(*)[132])(sm + 1536);
  const int tid = otid(wvs);
  const int tq = tid >> 7, c = tid & 127;
  const int tp = tid >> 4, co = tid & 15;
  const float scale = 0.08838834764831845f;
  const int nchunks = T_TOK / 64, G = gridDim.x;
  const int nj = (((nchunks - 1 - (int)blockIdx.x) / G) + 1) * 4;
  GlaPrepOps nxt; f32x4 gnx = {};
#define GLA_PREP_LOAD(j_) { const int chunk_ = (int)blockIdx.x + ((j_) >> 2) * G, h_ = (j_) & 3, ch_ = h_ * 128 + c; \
    const half_t* qp_ = P.p + (size_t)(chunk_ * 64 + 2 * tp) * LD0 + h_ * 128 + co * 8; \
    nxt.q0 = *(const half8*)(qp_); nxt.k0 = *(const half8*)(qp_ + 512); nxt.q1 = *(const half8*)(qp_ + LD0); nxt.k1 = *(const half8*)(qp_ + LD0 + 512); \
    _Pragma("unroll") for (int r = 0; r < 16; ++r) nxt.w[r] = P.gla_w_gk_up[r * 512 + ch_]; \
    nxt.bb = P.gla_b_gk[ch_]; \
    if (h_ == 0 && tid < 256) gnx = *(const f32x4*)(P.glr + (size_t)(chunk_ * 64) * 16 + tid * 4); }
  GLA_PREP_LOAD(0)
#pragma unroll 1
  for (int j = 0; j < nj; ++j) {
    const int chunk = (int)blockIdx.x + (j >> 2) * G, h = j & 3;
    const int t0 = chunk * 64, ch = h * 128 + c;
    const GlaPrepOps cur = nxt;
    __syncthreads();
    if (h == 0 && tid < 256) *(f32x4*)(sm + tid * 4) = gnx;
    if (j + 1 < nj) GLA_PREP_LOAD(j + 1)
    __syncthreads();
    float pre[16]; float cum = 0.f;
#pragma unroll
    for (int i = 0; i < 16; ++i) {
      float u = cur.bb;
#pragma unroll
      for (int r = 0; r < 16; ++r) u += glr[tq * 16 + i][r] * cur.w[r];
      cum += logsigmoidf(u) * (1.f / 16.f);
      pre[i] = cum;
    }
    tot[tq][c] = cum;
    __syncthreads();
    float off = 0.f;
#pragma unroll
    for (int t = 0; t < 3; ++t) if (t < tq) off += tot[t][c];
#pragma unroll
    for (int i = 0; i < 16; ++i) {
      const float ex = fast_exp2((pre[i] + off) * LOG2E);
      exl[tq * 16 + i][c] = ex;
      if (tq == 3 && i == 15) P.bcum[(size_t)chunk * 512 + ch] = ex;
    }
    __syncthreads();
    {
      half_t* qp = P.p + (size_t)(t0 + 2 * tp) * LD0 + h * 128 + co * 8;
      const f32x4 e00 = *(const f32x4*)&exl[2 * tp][co * 8], e01 = *(const f32x4*)&exl[2 * tp][co * 8 + 4];
      const f32x4 e10 = *(const f32x4*)&exl[2 * tp + 1][co * 8], e11 = *(const f32x4*)&exl[2 * tp + 1][co * 8 + 4];
      half8 oq0, ok0, oq1, ok1;
#pragma unroll
      for (int e = 0; e < 8; ++e) {
        const float x0 = e < 4 ? e00[e] : e01[e - 4], x1 = e < 4 ? e10[e] : e11[e - 4];
        oq0[e] = (half_t)((float)cur.q0[e] * scale * x0); ok0[e] = (half_t)((float)cur.k0[e] * __builtin_amdgcn_rcpf(x0));
        oq1[e] = (half_t)((float)cur.q1[e] * scale * x1); ok1[e] = (half_t)((float)cur.k1[e] * __builtin_amdgcn_rcpf(x1));
      }
      *(half8*)(qp) = oq0; *(half8*)(qp + 512) = ok0; *(half8*)(qp + LD0) = oq1; *(half8*)(qp + LD0 + 512) = ok1;
    }
  }
#undef GLA_PREP_LOAD
}

constexpr int GLA_QE = 0, GLA_KE = 16384, GLA_V = 32768, GLA_DEC = 49152, GLA_BUF = 53248;
#define GLA_TR4(d0, d1, d2, d3, addr, o0, o1, o2, o3) \
  asm volatile("ds_read_b64_tr_b16 %0, %4 offset:%5\n\tds_read_b64_tr_b16 %1, %4 offset:%6\n\tds_read_b64_tr_b16 %2, %4 offset:%7\n\tds_read_b64_tr_b16 %3, %4 offset:%8" \
               : "=&v"(d0), "=&v"(d1), "=&v"(d2), "=&v"(d3) : "v"(addr), "n"(o0), "n"(o1), "n"(o2), "n"(o3) : "memory")
__device__ __forceinline__ half8 pack_h8(const v2i a, const v2i b) { const v4i p = (v4i){a[0], a[1], b[0], b[1]}; return __builtin_bit_cast(half8, p); }

template <bool STATE_ONLY>
__device__ void ph_gla_mfma(const Params& P, char* smem, int wvs) {
  const int tid = otid(wvs);
  const int lane = tid & 63, wave = __builtin_amdgcn_readfirstlane(tid >> 6), r15 = lane & 15, q = lane >> 4;
  const int qp = r15 >> 2, pp = lane & 3;
  const int srow = tid >> 4, sslot = tid & 15;
  const int src_q = (sslot ^ (srow & 15)) * 8, src_kv = (sslot ^ ((srow & 7) << 1)) * 8;
  const int fk = ((4 * (q & 1) + qp) & 7) << 1;
  const unsigned tr_row = (unsigned)((4 * q + qp) * 256 + 8 * (pp & 1) + ((pp >> 1) << 4));
  constexpr int NLOAD = STATE_ONLY ? 5 : 7;
  for (int item = blockIdx.x; item < (STATE_ONLY ? 3 : 4) * 64; item += gridDim.x) {
    const int seg = item >> 6, base = item & 63, b = base >> 3, h = (base >> 1) & 3, vs = base & 1;
    const int c0 = seg * 16;
    f32x4 S[8], Dacc[8];
#pragma unroll
    for (int df = 0; df < 8; ++df) { S[df] = (f32x4){0.f, 0.f, 0.f, 0.f}; Dacc[df] = (f32x4){1.f, 1.f, 1.f, 1.f}; }
    f32x4* stL = (f32x4*)P.gla_state + ((size_t)base * 8 + wave) * 8 * 64 + lane;
    f32x4* stD = stL + (size_t)3 * 64 * 8 * 8 * 64;
    if (!STATE_ONLY) {
      for (int k = 0; k < seg; ++k) {
#pragma unroll
        for (int df = 0; df < 8; ++df) {
          const f32x4 Lk = stL[((size_t)k * 64 * 8 * 8 + df) * 64];
          if (k == 0) S[df] = Lk;
          else { const f32x4 Dk = stD[((size_t)k * 64 * 8 * 8 + df) * 64]; S[df] = Dk * S[df] + Lk; }
        }
      }
    }
    const half_t* qsrc = P.p + (size_t)(b * SEQ + srow) * LD0 + h * 128;
    const half_t* vsrc = P.p + (size_t)(b * SEQ + srow) * LD0 + 1024 + h * 256 + vs * 128 + src_kv;
    const float* dsrc = P.bcum + (size_t)(b * 64 + c0) * 512 + h * 128 + (lane & 31) * 4;
#define G_ISSUE(N, BUF) { char* lb_ = smem + (BUF) * GLA_BUF + wave * 1024; const size_t ro_ = (size_t)(c0 + (N)) * 64 * LD0; \
      if (!STATE_ONLY) { __builtin_amdgcn_global_load_lds((gbl_void*)(qsrc + ro_ + src_q), (lds_void*)(lb_ + GLA_QE), 16, 0, 0); \
      __builtin_amdgcn_global_load_lds((gbl_void*)(qsrc + ro_ + (size_t)32 * LD0 + src_q), (lds_void*)(lb_ + GLA_QE + 8192), 16, 0, 0); } \
      __builtin_amdgcn_global_load_lds((gbl_void*)(qsrc + ro_ + 512 + src_kv), (lds_void*)(lb_ + GLA_KE), 16, 0, 0); \
      __builtin_amdgcn_global_load_lds((gbl_void*)(qsrc + ro_ + (size_t)32 * LD0 + 512 + src_kv), (lds_void*)(lb_ + GLA_KE + 8192), 16, 0, 0); \
      __builtin_amdgcn_global_load_lds((gbl_void*)(vsrc + ro_), (lds_void*)(lb_ + GLA_V), 16, 0, 0); \
      __builtin_amdgcn_global_load_lds((gbl_void*)(vsrc + ro_ + (size_t)32 * LD0), (lds_void*)(lb_ + GLA_V + 8192), 16, 0, 0); \
      if (lane < 32) __builtin_amdgcn_global_load_lds((gbl_void*)(dsrc + (size_t)(N) * 512), (lds_void*)(smem + (BUF) * GLA_BUF + GLA_DEC + wave * 512), 16, 0, 0); }
    G_ISSUE(0, 0)
    G_ISSUE(1, 1)
#pragma unroll 1
    for (int n = 0; n < 16; ++n) {
      if (n + 1 < 16) wait_vmcnt<NLOAD>(); else wait_vmcnt<0>();
      __builtin_amdgcn_s_barrier();
      if (n + 2 < 16) G_ISSUE(n + 2, (n + 2) % 3)
      const char* cb = smem + (n % 3) * GLA_BUF;
      f32x4 aT[4][4];
      if (!STATE_ONLY) {
#pragma unroll
      for (int kf = 0; kf < 4; ++kf)
#pragma unroll
        for (int tf = 0; tf < 4; ++tf) aT[kf][tf] = (f32x4){0.f, 0.f, 0.f, 0.f};
#pragma unroll
      for (int ks = 0; ks < 4; ++ks) {
        half8 kef[4], qef[4];
#pragma unroll
        for (int f = 0; f < 4; ++f) {
          kef[f] = *(const half8*)(cb + GLA_KE + (16 * f + r15) * 256 + (((4 * ks + q) ^ ((r15 & 7) << 1)) << 4));
          qef[f] = *(const half8*)(cb + GLA_QE + (16 * f + r15) * 256 + (((4 * ks + q) ^ r15) << 4));
        }
#pragma unroll
        for (int kf = 0; kf < 4; ++kf)
#pragma unroll
          for (int tf = kf; tf < 4; ++tf) aT[kf][tf] = __builtin_amdgcn_mfma_f32_16x16x32_f16(kef[kf], qef[tf], aT[kf][tf], 0, 0, 0);
      }
#pragma unroll
      for (int f = 0; f < 4; ++f)
#pragma unroll
        for (int r = 0; r < 4; ++r) if (4 * q + r > r15) aT[f][f][r] = 0.f;
      }
      const unsigned lds0 = (unsigned)(size_t)cb;
      const unsigned va = lds0 + GLA_V + tr_row + ((((2 * wave) ^ fk)) << 4);
      v2i v00, v01, v10, v11;
      GLA_TR4(v00, v01, v10, v11, va, 0, 4096, 8192, 12288);
      const unsigned ka = lds0 + GLA_KE + tr_row;
      v2i k0[4][4];
#pragma unroll
      for (int df = 0; df < 4; ++df) { const unsigned a_ = ka + ((((2 * df) ^ fk)) << 4); GLA_TR4(k0[df][0], k0[df][1], k0[df][2], k0[df][3], a_, 0, 4096, 8192, 12288); }
      asm volatile("s_waitcnt lgkmcnt(15)" : "+v"(v00), "+v"(v01), "+v"(v10), "+v"(v11) :: "memory");
      __builtin_amdgcn_sched_barrier(0);
      half8 vf[2];
      vf[0] = pack_h8(v00, v01); vf[1] = pack_h8(v10, v11);
      if (!STATE_ONLY) {
      f32x4 o[4];
#pragma unroll
      for (int tf = 0; tf < 4; ++tf) o[tf] = (f32x4){0.f, 0.f, 0.f, 0.f};
#pragma unroll
      for (int ks2 = 0; ks2 < 2; ++ks2)
#pragma unroll
        for (int tf = 2 * ks2; tf < 4; ++tf) {
          half8 pk;
#pragma unroll
          for (int r = 0; r < 4; ++r) { pk[r] = (half_t)aT[2 * ks2][tf][r]; pk[4 + r] = (half_t)aT[2 * ks2 + 1][tf][r]; }
          o[tf] = __builtin_amdgcn_mfma_f32_16x16x32_f16(vf[ks2], pk, o[tf], 0, 0, 0);
        }
#pragma unroll
      for (int ks = 0; ks < 4; ++ks) {
        half8 sf;
#pragma unroll
        for (int r = 0; r < 4; ++r) { sf[r] = (half_t)S[2 * ks][r]; sf[4 + r] = (half_t)S[2 * ks + 1][r]; }
#pragma unroll
        for (int tf = 0; tf < 4; ++tf) {
          const int row = 16 * tf + r15;
          const half4 qa = *(const half4*)(cb + GLA_QE + row * 256 + (((4 * ks + (q >> 1)) ^ r15) << 4) + (q & 1) * 8);
          const half4 qb = *(const half4*)(cb + GLA_QE + row * 256 + (((4 * ks + 2 + (q >> 1)) ^ r15) << 4) + (q & 1) * 8);
          half8 qv;
#pragma unroll
          for (int e = 0; e < 4; ++e) { qv[e] = qa[e]; qv[4 + e] = qb[e]; }
          o[tf] = __builtin_amdgcn_mfma_f32_16x16x32_f16(sf, qv, o[tf], 0, 0, 0);
        }
      }
      {
        const size_t t0 = (size_t)(b * SEQ + (c0 + n) * 64);
#pragma unroll
        for (int tf = 0; tf < 4; ++tf) {
          half4 hv; hv[0] = (half_t)o[tf][0]; hv[1] = (half_t)o[tf][1]; hv[2] = (half_t)o[tf][2]; hv[3] = (half_t)o[tf][3];
          *(half4*)(P.og + (t0 + 16 * tf + r15) * DM + h * 256 + vs * 128 + 16 * wave + 4 * q) = hv;
        }
      }
      }
      v2i k1[4][4];
#pragma unroll
      for (int df = 0; df < 4; ++df) { const unsigned a_ = ka + ((((2 * (df + 4)) ^ fk)) << 4); GLA_TR4(k1[df][0], k1[df][1], k1[df][2], k1[df][3], a_, 0, 4096, 8192, 12288); }
      asm volatile("s_waitcnt lgkmcnt(15)"
                   : "+v"(k0[0][0]), "+v"(k0[0][1]), "+v"(k0[0][2]), "+v"(k0[0][3]), "+v"(k0[1][0]), "+v"(k0[1][1]), "+v"(k0[1][2]), "+v"(k0[1][3]),
                     "+v"(k0[2][0]), "+v"(k0[2][1]), "+v"(k0[2][2]), "+v"(k0[2][3]), "+v"(k0[3][0]), "+v"(k0[3][1]), "+v"(k0[3][2]), "+v"(k0[3][3]) :: "memory");
      __builtin_amdgcn_sched_barrier(0);
#pragma unroll
      for (int df = 0; df < 4; ++df) {
        S[df] = __builtin_amdgcn_mfma_f32_16x16x32_f16(pack_h8(k0[df][0], k0[df][1]), vf[0], S[df], 0, 0, 0);
        S[df] = __builtin_amdgcn_mfma_f32_16x16x32_f16(pack_h8(k0[df][2], k0[df][3]), vf[1], S[df], 0, 0, 0);
      }
      asm volatile("s_waitcnt lgkmcnt(0)"
                   : "+v"(k1[0][0]), "+v"(k1[0][1]), "+v"(k1[0][2]), "+v"(k1[0][3]), "+v"(k1[1][0]), "+v"(k1[1][1]), "+v"(k1[1][2]), "+v"(k1[1][3]),
                     "+v"(k1[2][0]), "+v"(k1[2][1]), "+v"(k1[2][2]), "+v"(k1[2][3]), "+v"(k1[3][0]), "+v"(k1[3][1]), "+v"(k1[3][2]), "+v"(k1[3][3]) :: "memory");
      __builtin_amdgcn_sched_barrier(0);
#pragma unroll
      for (int df = 0; df < 4; ++df) {
        S[df + 4] = __builtin_amdgcn_mfma_f32_16x16x32_f16(pack_h8(k1[df][0], k1[df][1]), vf[0], S[df + 4], 0, 0, 0);
        S[df + 4] = __builtin_amdgcn_mfma_f32_16x16x32_f16(pack_h8(k1[df][2], k1[df][3]), vf[1], S[df + 4], 0, 0, 0);
      }
#pragma unroll
      for (int df = 0; df < 8; ++df) {
        const f32x4 dc = *(const f32x4*)(cb + GLA_DEC + wave * 512 + (16 * df + 4 * q) * 4);
        S[df] *= dc;
        if (STATE_ONLY) Dacc[df] *= dc;
      }
    }
    if (STATE_ONLY) {
#pragma unroll
      for (int df = 0; df < 8; ++df) { stL[((size_t)seg * 64 * 8 * 8 + df) * 64] = S[df]; stD[((size_t)seg * 64 * 8 * 8 + df) * 64] = Dacc[df]; }
    }
    asm volatile("s_waitcnt vmcnt(0)" ::: "memory");
    __builtin_amdgcn_s_barrier();
#undef G_ISSUE
  }
}

__device__ void ph_gla_post(const Params& P, int wvs) {
  const int tid_ = otid(wvs); const int lane = tid_ & 63, sub = lane & 31;
  const int u0 = blockIdx.x * 16 + (tid_ >> 5);
  const float4 hn0 = ((const float4*)P.gla_head_norm)[sub * 2], hn1 = ((const float4*)P.gla_head_norm)[sub * 2 + 1];
  constexpr int UW = 4;
  const int ustride = gridDim.x * 16;
#pragma unroll 1
  for (int ub = u0; ub < T_TOK * 4; ub += ustride * UW) {
    half8 hv[UW], z[UW];
#pragma unroll
    for (int r = 0; r < UW; ++r) {
      const int u = ub + r * ustride, t = u >> 2, h = u & 3;
      hv[r] = *((const half8*)(P.og + (size_t)t * DM + h * 256) + sub);
      z[r] = *((const half8*)(P.p + (size_t)t * LD0 + 2048 + h * 256) + sub);
    }
#pragma unroll
    for (int r = 0; r < UW; ++r) {
      const int u = ub + r * ustride, t = u >> 2, h = u & 3;
      float v[8]; float ss = 0.f;
#pragma unroll
      for (int e = 0; e < 8; ++e) { v[e] = (float)hv[r][e]; ss += v[e] * v[e]; }
#pragma unroll
      for (int o = 16; o > 0; o >>= 1) ss += __shfl_xor(ss, o);
      const float rr = rsqrtf(ss * (1.f / 256.f) + EPS);
      const float hn[8] = {hn0.x, hn0.y, hn0.z, hn0.w, hn1.x, hn1.y, hn1.z, hn1.w};
      half8 o;
#pragma unroll
      for (int e = 0; e < 8; ++e) o[e] = (half_t)(v[e] * rr * hn[e] * siluf((float)z[r][e]));
      *((half8*)(P.og + (size_t)t * DM + h * 256) + sub) = o;
    }
  }
}

template <bool FINAL>
__device__ void ph_post(const half_t* baseh, const half_t* y, const float* g, float* dst, half_t* dsth, float* rstd_out, int wvs) {
  const int tid_ = otid(wvs); const int lane = tid_ & 63, w = tid_ >> 6;
  constexpr int RW = 4;
  const int rstride = gridDim.x * NWAVES;
#pragma unroll 1
  for (int row0 = blockIdx.x * NWAVES + w; row0 < T_TOK; row0 += rstride * RW) {
    half4 yv[RW][4], bv[RW][4];
#pragma unroll
    for (int r = 0; r < RW; ++r)
#pragma unroll
      for (int i = 0; i < 4; ++i) yv[r][i] = ((const half4*)(y + (size_t)(row0 + r * rstride) * DM))[lane + 64 * i];
#pragma unroll
    for (int r = 0; r < RW; ++r)
#pragma unroll
      for (int i = 0; i < 4; ++i) bv[r][i] = ((const half4*)(baseh + (size_t)(row0 + r * rstride) * DM))[lane + 64 * i];
#pragma unroll
    for (int r = 0; r < RW; ++r) {
      const int row = row0 + r * rstride;
      float ss = 0.f;
#pragma unroll
      for (int i = 0; i < 4; ++i)
#pragma unroll
        for (int e = 0; e < 4; ++e) { const float t = (float)yv[r][i][e]; ss += t * t; }
      ss = wave_sum(ss);
      const float rr = rsqrtf(ss * (1.f / DM) + EPS);
      float s2 = 0.f;
#pragma unroll
      for (int i = 0; i < 4; ++i) {
        const float4 gg = ((const float4*)g)[lane + 64 * i];
        float4 o;
        o.x = (float)bv[r][i][0] + (float)yv[r][i][0] * rr * gg.x; o.y = (float)bv[r][i][1] + (float)yv[r][i][1] * rr * gg.y;
        o.z = (float)bv[r][i][2] + (float)yv[r][i][2] * rr * gg.z; o.w = (float)bv[r][i][3] + (float)yv[r][i][3] * rr * gg.w;
        if (FINAL) ((float4*)(dst + (size_t)row * DM))[lane + 64 * i] = o;
        else {
          s2 += o.x * o.x + o.y * o.y + o.z * o.z + o.w * o.w;
          half4 hv; hv[0] = (half_t)o.x; hv[1] = (half_t)o.y; hv[2] = (half_t)o.z; hv[3] = (half_t)o.w;
          ((half4*)(dsth + (size_t)row * DM))[lane + 64 * i] = hv;
        }
      }
      if (!FINAL) { s2 = wave_sum(s2); if (lane == 0) rstd_out[row] = rsqrtf(s2 * (1.f / DM) + EPS); }
    }
  }
}

template <int NF>
__device__ void ph_rowproj(const Params& P, const half_t* Wt, float* out, char* smem, int wvs, int first_block) {
  const int tid = otid(wvs), lane = tid & 63, wave = tid >> 6, r15 = lane & 15, q = lane >> 4;
  const int nb = gridDim.x - first_block;
  if ((int)blockIdx.x < first_block) return;
  __syncthreads();
  for (int c = tid; c < 16 * NF * 128; c += NTHREADS) {
    const int row = c >> 7, ch = c & 127;
    *(uint4*)(smem + row * 2064 + ch * 16) = *(const uint4*)(Wt + (size_t)row * DM + ch * 8);
  }
  __syncthreads();
  for (int tile = (int)blockIdx.x - first_block; tile < T_TOK / 128; tile += nb) {
    const int tok = tile * 128 + wave * 16 + r15;
    const half_t* ap = P.xh + (size_t)tok * DM + 8 * q;
    const char* bp = smem + r15 * 2064 + 16 * q;
    f32x4 acc[NF];
#pragma unroll
    for (int n = 0; n < NF; ++n) acc[n] = (f32x4){0.f, 0.f, 0.f, 0.f};
#pragma unroll 1
    for (int s0 = 0; s0 < 32; s0 += 16) {
      half8 a[16];
#pragma unroll
      for (int i = 0; i < 16; ++i) a[i] = *(const half8*)(ap + 32 * (s0 + i));
#pragma unroll
      for (int i = 0; i < 16; ++i) {
#pragma unroll
        for (int n = 0; n < NF; ++n) {
          const half8 bw = *(const half8*)(bp + n * 16 * 2064 + (s0 + i) * 64);
          acc[n] = __builtin_amdgcn_mfma_f32_16x16x32_f16(bw, a[i], acc[n], 0, 0, 0);
        }
      }
    }
    const float rs = P.rstd[tok];
#pragma unroll
    for (int n = 0; n < NF; ++n) *(f32x4*)(out + (size_t)tok * (16 * NF) + 16 * n + 4 * q) = acc[n] * rs;
  }
  __syncthreads();
}

__device__ void ph_kmax(const Params& P, int wvs, int first_block) {
  const int tid = otid(wvs);
  for (int task = (int)blockIdx.x - first_block; task < NBATCH * 4 * 2 * 8; task += gridDim.x - first_block) {
    const int chunk = task & 7, br = (task >> 3) & 1, bg = task >> 4, b = bg >> 2, g = bg & 3;
    const half_t* kp = P.p + (size_t)(b * SEQ + chunk * 512 + tid) * LD1 + (br ? 2048 : 1536) + g * 64;
    float ss = 0.f;
#pragma unroll
    for (int c = 0; c < 8; ++c) {
      const half8 v = *(const half8*)(kp + c * 8);
#pragma unroll
      for (int e = 0; e < 8; ++e) ss += (float)v[e] * (float)v[e];
    }
    ss = wave_max(ss);
    if ((tid & 63) == 0) __hip_atomic_fetch_max(&P.kmax2[bg * 2 + br], __float_as_uint(ss), __ATOMIC_RELAXED, __HIP_MEMORY_SCOPE_AGENT);
  }
}

constexpr int ATT_NB = 6, ATT_D = 5;
constexpr int ATT_K = 0, ATT_V = ATT_NB * 8192, ATT_Z = 2 * ATT_NB * 8192, ATT_IMP = ATT_Z + 32768, ATT_SELM = ATT_IMP + 64 * 68 * 4;
constexpr int IMPS = 68;
constexpr int ATT_GATE = ATT_SELM + 512;

__device__ __forceinline__ void attn_issue(char* smem, const half_t* kbase, const half_t* vbase, int ld, int tile_lo, int tile_hi, int wvs, int rot = 0) {
  const int tid = otid(wvs);
  const int lrow = tid >> 3, lch = tid & 7;
  const int ksrc = (lch ^ ((lrow >> 1) & 7)) * 8, vsrc = (lch ^ (((lrow >> 1) & 3) << 1)) * 8;
  const int wbase = __builtin_amdgcn_readfirstlane(tid >> 6) * 1024;
#pragma unroll
  for (int i = 0; i < ATT_D; ++i) if (tile_lo + i <= tile_hi) {
    const int nt_ = tile_hi - tile_lo + 1, tr_ = tile_lo + ((rot + i >= nt_) ? rot + i - nt_ : rot + i);
    const half_t* kp_ = kbase + (size_t)(tr_ * 64 + lrow) * ld + ksrc;
    const half_t* vp_ = vbase + (size_t)(tr_ * 64 + lrow) * ld + vsrc;
    __builtin_amdgcn_global_load_lds((gbl_void*)kp_, (lds_void*)(smem + ATT_K + i * 8192 + wbase), 16, 0, 0);
    __builtin_amdgcn_global_load_lds((gbl_void*)vp_, (lds_void*)(smem + ATT_V + i * 8192 + wbase), 16, 0, 0);
  }
}

template <int MODE, bool PREISSUED = false>
__device__ __forceinline__ void attn_branch(char* smem, const half_t* kbase, const half_t* vbase, int ld, int tile_lo, int tile_hi, int n, int th,
                                            const half8 (&qf)[2][2], float (&m)[2], float (&l)[2], f32x4 (&o)[4][2],
                                            const unsigned long long (&selm)[2], int wvs) {
  const int tid = otid(wvs);
  const int lane = tid & 63, r15 = lane & 15, q = lane >> 4;
  const int lrow = tid >> 3, lch = tid & 7;
  const int k_rd = r15 * 128, kswz = r15 >> 1;
  const int qp = r15 >> 2, pp = lane & 3;
  const int fx = ((2 * q + (qp >> 1)) & 3) << 1;
  const int v_rd = (4 * q + qp) * 128 + 8 * (pp & 1) + ((pp >> 1) << 4);
  unsigned int* impu = (unsigned int*)(smem + ATT_IMP);
  const int ksrc = (lch ^ ((lrow >> 1) & 7)) * 8, vsrc = (lch ^ (((lrow >> 1) & 3) << 1)) * 8;
  const int wbase = __builtin_amdgcn_readfirstlane(tid >> 6) * 1024;
#define A_GLOAD(TI, BUF) { const half_t* kp_ = kbase + (size_t)((TI) * 64 + lrow) * ld + ksrc; \
    __builtin_amdgcn_global_load_lds((gbl_void*)kp_, (lds_void*)(smem + ATT_K + (BUF) * 8192 + wbase), 16, 0, 0); \
    { const half_t* vp_ = vbase + (size_t)((TI) * 64 + lrow) * ld + vsrc; \
      __builtin_amdgcn_global_load_lds((gbl_void*)vp_, (lds_void*)(smem + ATT_V + (BUF) * 8192 + wbase), 16, 0, 0); } }
  constexpr int GPT = 2;
  f32x4 lacc[2] = {(f32x4){0.f, 0.f, 0.f, 0.f}, (f32x4){0.f, 0.f, 0.f, 0.f}};
  if (MODE != 1 && !PREISSUED) {
#pragma unroll
    for (int i = 0; i < ATT_D; ++i) if (tile_lo + i <= tile_hi) A_GLOAD(tile_lo + i, i)
  }
#pragma unroll 1
  for (int ti = tile_lo; ti <= tile_hi; ++ti) {
    const int it = ti - tile_lo, cur = it % ATT_NB;
    if (MODE != 1) {
      const int rem = tile_hi - ti;
      if (rem >= 4) wait_vmcnt<4 * GPT>(); else if (rem == 3) wait_vmcnt<3 * GPT>(); else if (rem == 2) wait_vmcnt<2 * GPT>();
      else if (rem == 1) wait_vmcnt<1 * GPT>(); else wait_vmcnt<0>();
    }
    __builtin_amdgcn_s_barrier();
    if (MODE != 1) { if (ti + ATT_D <= tile_hi) A_GLOAD(ti + ATT_D, (it + ATT_D) % ATT_NB) }
    const char* kb = smem + ATT_K + cur * 8192 + k_rd;
    const unsigned vbl = (unsigned)(size_t)(smem + ATT_V + cur * 8192 + v_rd);
    bool need_mask;
    if (MODE <= 1) need_mask = (ti * 64 + 63 > 4 * n - 2);
    else if (MODE == 2) need_mask = (ti == n);
    else need_mask = (ti == n) || (ti == n - 8);
    f32x4 s[4][2];
#pragma unroll
    for (int t2 = 0; t2 < 2; ++t2) {
      float c0 = 0.f;
      if (MODE >= 2) { c0 = -m[t2]; if (MODE == 2 && !((selm[t2] >> ti) & 1ull)) c0 = -INFINITY; }
#pragma unroll
      for (int kf = 0; kf < 4; ++kf) s[kf][t2] = (f32x4){c0, c0, c0, c0};
    }
#pragma unroll
    for (int ks = 0; ks < 2; ++ks) {
      const int co = ((4 * ks + q) ^ kswz) << 4;
#pragma unroll
      for (int kf = 0; kf < 4; ++kf) {
        const half8 kfr = *(const half8*)(kb + kf * 2048 + co);
#pragma unroll
        for (int t2 = 0; t2 < 2; ++t2) s[kf][t2] = __builtin_amdgcn_mfma_f32_16x16x32_f16(kfr, qf[t2][ks], s[kf][t2], 0, 0, 0);
      }
    }
    v2i vr[4][4];
    if (MODE != 0) {
      const unsigned va0 = vbl + (((0) ^ fx) << 4), va1 = vbl + (((2) ^ fx) << 4), va2 = vbl + (((4) ^ fx) << 4), va3 = vbl + (((6) ^ fx) << 4);
      asm volatile(
          "ds_read_b64_tr_b16 %0, %16\n\tds_read_b64_tr_b16 %1, %16 offset:2048\n\tds_read_b64_tr_b16 %2, %16 offset:4096\n\tds_read_b64_tr_b16 %3, %16 offset:6144\n\t"
          "ds_read_b64_tr_b16 %4, %17\n\tds_read_b64_tr_b16 %5, %17 offset:2048\n\tds_read_b64_tr_b16 %6, %17 offset:4096\n\tds_read_b64_tr_b16 %7, %17 offset:6144\n\t"
          "ds_read_b64_tr_b16 %8, %18\n\tds_read_b64_tr_b16 %9, %18 offset:2048\n\tds_read_b64_tr_b16 %10, %18 offset:4096\n\tds_read_b64_tr_b16 %11, %18 offset:6144\n\t"
          "ds_read_b64_tr_b16 %12, %19\n\tds_read_b64_tr_b16 %13, %19 offset:2048\n\tds_read_b64_tr_b16 %14, %19 offset:4096\n\tds_read_b64_tr_b16 %15, %19 offset:6144"
          : "=&v"(vr[0][0]), "=&v"(vr[0][1]), "=&v"(vr[0][2]), "=&v"(vr[0][3]), "=&v"(vr[1][0]), "=&v"(vr[1][1]), "=&v"(vr[1][2]), "=&v"(vr[1][3]),
            "=&v"(vr[2][0]), "=&v"(vr[2][1]), "=&v"(vr[2][2]), "=&v"(vr[2][3]), "=&v"(vr[3][0]), "=&v"(vr[3][1]), "=&v"(vr[3][2]), "=&v"(vr[3][3])
          : "v"(va0), "v"(va1), "v"(va2), "v"(va3)
          : "memory");
    }
    if (need_mask) {
#pragma unroll
      for (int t2 = 0; t2 < 2; ++t2) {
        const int tok = th * 32 + t2 * 16 + r15;
        int lo = 0, hi = 63;
        if (MODE <= 1) { hi = 4 * n + ((tok - 31) >> 4) - ti * 64; }
        else if (MODE == 2) { hi = tok; }
        else { if (ti == n) hi = tok; else lo = tok + 1; }
#pragma unroll
        for (int kf = 0; kf < 4; ++kf)
#pragma unroll
          for (int r = 0; r < 4; ++r) {
            const int kk = kf * 16 + 4 * q + r;
            if (kk < lo || kk > hi) s[kf][t2][r] = -INFINITY;
          }
      }
    }
    half8 pf[2][2];
#pragma unroll
    for (int t2 = 0; t2 < 2; ++t2) {
      float mb = 0.f, scale_p = 1.f;
      if (MODE == 1) {
        mb = m[t2]; scale_p = l[t2];
      } else if (MODE == 0) {
        float tm = s[0][t2][0];
#pragma unroll
        for (int kf = 0; kf < 4; ++kf)
#pragma unroll
          for (int r = 0; r < 4; ++r) tm = fmaxf(tm, s[kf][t2][r]);
        tm = rowmax4(tm);
        const float mn = fmaxf(m[t2], tm);
        const float alpha = fexp2(m[t2] - mn);
        m[t2] = mn; mb = mn;
        l[t2] *= alpha;
      }
      float lsum = 0.f;
#pragma unroll
      for (int kf = 0; kf < 4; ++kf) {
#pragma unroll
        for (int r = 0; r < 4; ++r) {
          float pv = (MODE >= 2) ? fexp2(s[kf][t2][r]) : fexp2(s[kf][t2][r] - mb);
          if (MODE == 1) pv *= scale_p;
          s[kf][t2][r] = pv; if (MODE == 0) lsum += pv;
        }
      }
      if (MODE == 0) l[t2] += lsum;
      if (MODE == 1) {
        const int tok = th * 32 + t2 * 16 + r15;
#pragma unroll
        for (int kf = 0; kf < 4; ++kf) {
          const int j = 16 * ti + 4 * kf + q;
          const unsigned int u0 = (unsigned int)(s[kf][t2][0] * 134217728.f + 0.5f), u1 = (unsigned int)(s[kf][t2][1] * 134217728.f + 0.5f);
          const unsigned int u2 = (unsigned int)(s[kf][t2][2] * 134217728.f + 0.5f), u3 = (unsigned int)(s[kf][t2][3] * 134217728.f + 0.5f);
          if (j < 64) {
            atomicAdd(&impu[tok * IMPS + j], u0 + u1 + u2 + u3);
            atomicAdd(&impu[tok * IMPS + j + 1], u3);
          }
        }
      }
      if (MODE != 0) {
#pragma unroll
        for (int ks = 0; ks < 2; ++ks) {
          half8 pk;
#pragma unroll
          for (int r = 0; r < 4; ++r) { pk[r] = (half_t)s[2 * ks][t2][r]; pk[4 + r] = (half_t)s[2 * ks + 1][t2][r]; }
          pf[t2][ks] = pk;
        }
      }
    }
    if (MODE != 0) {
      asm volatile("s_waitcnt lgkmcnt(0)"
                   : "+v"(vr[0][0]), "+v"(vr[0][1]), "+v"(vr[0][2]), "+v"(vr[0][3]), "+v"(vr[1][0]), "+v"(vr[1][1]), "+v"(vr[1][2]), "+v"(vr[1][3]),
                     "+v"(vr[2][0]), "+v"(vr[2][1]), "+v"(vr[2][2]), "+v"(vr[2][3]), "+v"(vr[3][0]), "+v"(vr[3][1]), "+v"(vr[3][2]), "+v"(vr[3][3])
                   :: "memory");
      __builtin_amdgcn_sched_barrier(0);
#pragma unroll
      for (int df = 0; df < 4; ++df) {
#pragma unroll
        for (int ks = 0; ks < 2; ++ks) {
          const v2i lo2 = vr[df][2 * ks], hi2 = vr[df][2 * ks + 1];
          const v4i pk4 = (v4i){lo2[0], lo2[1], hi2[0], hi2[1]};
          const half8 vf = __builtin_bit_cast(half8, pk4);
#pragma unroll
          for (int t2 = 0; t2 < 2; ++t2) o[df][t2] = __builtin_amdgcn_mfma_f32_16x16x32_f16(vf, pf[t2][ks], o[df][t2], 0, 0, 0);
        }
      }
      if (MODE >= 2) {
        const half8 ones = (half8){(half_t)1.f, (half_t)1.f, (half_t)1.f, (half_t)1.f, (half_t)1.f, (half_t)1.f, (half_t)1.f, (half_t)1.f};
#pragma unroll
        for (int ks = 0; ks < 2; ++ks)
#pragma unroll
          for (int t2 = 0; t2 < 2; ++t2) lacc[t2] = __builtin_amdgcn_mfma_f32_16x16x32_f16(ones, pf[t2][ks], lacc[t2], 0, 0, 0);
      }
    }
  }
  if (MODE >= 2) { l[0] = lacc[0][0]; l[1] = lacc[1][0]; }
  __syncthreads();
#undef A_GLOAD
}

template <int MODE, bool PREISSUED>
__device__ __forceinline__ void attn_branch_pp(char* smem, const half_t* kbase, const half_t* vbase, int ld, int tile_lo, int tile_hi, int n, int th,
                                               const half8 (&qf)[2][2], const float (&m)[2], float (&l)[2], f32x4 (&o)[4][2],
                                               const unsigned long long (&selm)[2], int wvs, int rot) {
  const int tid = otid(wvs);
  const int lane = tid & 63, r15 = lane & 15, q = lane >> 4;
  const int lrow = tid >> 3, lch = tid & 7;
  const int k_rd = r15 * 128, kswz = r15 >> 1;
  const int qp = r15 >> 2, pp = lane & 3;
  const int fx = ((2 * q + (qp >> 1)) & 3) << 1;
  const int v_rd = (4 * q + qp) * 128 + 8 * (pp & 1) + ((pp >> 1) << 4);
  const int ksrc = (lch ^ ((lrow >> 1) & 7)) * 8, vsrc = (lch ^ (((lrow >> 1) & 3) << 1)) * 8;
  const int wbase = __builtin_amdgcn_readfirstlane(tid >> 6) * 1024;
#define A_GLOAD(TI, BUF) { const half_t* kp_ = kbase + (size_t)((TI) * 64 + lrow) * ld + ksrc; \
    __builtin_amdgcn_global_load_lds((gbl_void*)kp_, (lds_void*)(smem + ATT_K + (BUF) * 8192 + wbase), 16, 0, 0); \
    { const half_t* vp_ = vbase + (size_t)((TI) * 64 + lrow) * ld + vsrc; \
      __builtin_amdgcn_global_load_lds((gbl_void*)vp_, (lds_void*)(smem + ATT_V + (BUF) * 8192 + wbase), 16, 0, 0); } }
#define PP_BAR { __builtin_amdgcn_sched_barrier(0); __builtin_amdgcn_s_barrier(); __builtin_amdgcn_sched_barrier(0); }
  const int nt = tile_hi - tile_lo + 1;
  f32x4 lacc[2] = {(f32x4){0.f, 0.f, 0.f, 0.f}, (f32x4){0.f, 0.f, 0.f, 0.f}};
  if (!PREISSUED) {
#pragma unroll
    for (int i = 0; i < ATT_D; ++i) if (i < nt) A_GLOAD(tile_lo + ((rot + i >= nt) ? rot + i - nt : rot + i), i)
  }
  { const int r = nt - 1;
    if (r >= 4) wait_vmcnt<8>(); else if (r == 3) wait_vmcnt<6>(); else if (r == 2) wait_vmcnt<4>(); else if (r == 1) wait_vmcnt<2>(); else wait_vmcnt<0>(); }
  half8 pf[2][2];
  v2i vr[4][4];
#pragma unroll
  for (int a = 0; a < 2; ++a)
#pragma unroll
    for (int b = 0; b < 2; ++b) pf[a][b] = (half8){(half_t)0.f, (half_t)0.f, (half_t)0.f, (half_t)0.f, (half_t)0.f, (half_t)0.f, (half_t)0.f, (half_t)0.f};
#pragma unroll
  for (int a = 0; a < 4; ++a)
#pragma unroll
    for (int b = 0; b < 4; ++b) vr[a][b] = (v2i){0, 0};
  const half8 ones = (half8){(half_t)1.f, (half_t)1.f, (half_t)1.f, (half_t)1.f, (half_t)1.f, (half_t)1.f, (half_t)1.f, (half_t)1.f};
#define PP_PV { _Pragma("unroll") for (int df = 0; df < 4; ++df) _Pragma("unroll") for (int ks = 0; ks < 2; ++ks) { \
      const v2i lo2 = vr[df][2 * ks], hi2 = vr[df][2 * ks + 1]; const v4i pk4 = (v4i){lo2[0], lo2[1], hi2[0], hi2[1]}; const half8 vf = __builtin_bit_cast(half8, pk4); \
      _Pragma("unroll") for (int t2 = 0; t2 < 2; ++t2) o[df][t2] = __builtin_amdgcn_mfma_f32_16x16x32_f16(vf, pf[t2][ks], o[df][t2], 0, 0, 0); } \
    _Pragma("unroll") for (int ks = 0; ks < 2; ++ks) _Pragma("unroll") for (int t2 = 0; t2 < 2; ++t2) lacc[t2] = __builtin_amdgcn_mfma_f32_16x16x32_f16(ones, pf[t2][ks], lacc[t2], 0, 0, 0); }
  __builtin_amdgcn_sched_barrier(0);
  if (th == 1) __builtin_amdgcn_s_barrier();
  __builtin_amdgcn_sched_barrier(0);
  int trel = rot, tpf = rot + ATT_D; while (tpf >= nt) tpf -= nt;
  v4i kq[2][4];
  const unsigned kco0 = (unsigned)(((4 * 0 + q) ^ kswz) << 4), kco1 = (unsigned)(((4 * 1 + q) ^ kswz) << 4);
#define PP_KREAD(BUF) { const unsigned kb_ = (unsigned)(size_t)(smem + ATT_K + (BUF) * 8192 + k_rd); const unsigned ka0 = kb_ + kco0, ka1 = kb_ + kco1; \
    asm volatile("ds_read_b128 %0, %8\n\tds_read_b128 %1, %8 offset:2048\n\tds_read_b128 %2, %8 offset:4096\n\tds_read_b128 %3, %8 offset:6144\n\t" \
                 "ds_read_b128 %4, %9\n\tds_read_b128 %5, %9 offset:2048\n\tds_read_b128 %6, %9 offset:4096\n\tds_read_b128 %7, %9 offset:6144" \
                 : "=&v"(kq[0][0]), "=&v"(kq[0][1]), "=&v"(kq[0][2]), "=&v"(kq[0][3]), "=&v"(kq[1][0]), "=&v"(kq[1][1]), "=&v"(kq[1][2]), "=&v"(kq[1][3]) \
                 : "v"(ka0), "v"(ka1) : "memory"); }
#define PP_KWAIT asm volatile("s_waitcnt lgkmcnt(0)" : "+v"(kq[0][0]), "+v"(kq[0][1]), "+v"(kq[0][2]), "+v"(kq[0][3]), "+v"(kq[1][0]), "+v"(kq[1][1]), "+v"(kq[1][2]), "+v"(kq[1][3]) :: "memory");
#pragma unroll 1
  for (int it = 0; it < nt; ++it) {
    const int ti = tile_lo + trel, cur = it % ATT_NB;
    trel = (trel + 1 == nt) ? 0 : trel + 1;
    PP_BAR
    f32x4 s[4][2];
    PP_KREAD(cur)
    __builtin_amdgcn_s_setprio(1);
    PP_PV
    PP_KWAIT
#pragma unroll
    for (int t2 = 0; t2 < 2; ++t2) {
      float c0 = -m[t2];
      if (MODE == 2 && !((selm[t2] >> ti) & 1ull)) c0 = -INFINITY;
#pragma unroll
      for (int kf = 0; kf < 4; ++kf) s[kf][t2] = (f32x4){c0, c0, c0, c0};
    }
#pragma unroll
    for (int ks = 0; ks < 2; ++ks) {
#pragma unroll
      for (int kf = 0; kf < 4; ++kf) {
        const half8 kfr = __builtin_bit_cast(half8, kq[ks][kf]);
#pragma unroll
        for (int t2 = 0; t2 < 2; ++t2) s[kf][t2] = __builtin_amdgcn_mfma_f32_16x16x32_f16(kfr, qf[t2][ks], s[kf][t2], 0, 0, 0);
      }
    }
    __builtin_amdgcn_s_setprio(0);
    { const int r = nt - 2 - it;
      if (r >= 3) wait_vmcnt<6>(); else if (r == 2) wait_vmcnt<4>(); else if (r == 1) wait_vmcnt<2>(); else wait_vmcnt<0>(); }
    PP_BAR
    if (it + ATT_D < nt) A_GLOAD(tile_lo + tpf, (it + ATT_D) % ATT_NB)
    tpf = (tpf + 1 == nt) ? 0 : tpf + 1;
    {
      const unsigned vbl = (unsigned)(size_t)(smem + ATT_V + cur * 8192 + v_rd);
      const unsigned va0 = vbl + (((0) ^ fx) << 4), va1 = vbl + (((2) ^ fx) << 4), va2 = vbl + (((4) ^ fx) << 4), va3 = vbl + (((6) ^ fx) << 4);
      asm volatile(
          "ds_read_b64_tr_b16 %0, %16\n\tds_read_b64_tr_b16 %1, %16 offset:2048\n\tds_read_b64_tr_b16 %2, %16 offset:4096\n\tds_read_b64_tr_b16 %3, %16 offset:6144\n\t"
          "ds_read_b64_tr_b16 %4, %17\n\tds_read_b64_tr_b16 %5, %17 offset:2048\n\tds_read_b64_tr_b16 %6, %17 offset:4096\n\tds_read_b64_tr_b16 %7, %17 offset:6144\n\t"
          "ds_read_b64_tr_b16 %8, %18\n\tds_read_b64_tr_b16 %9, %18 offset:2048\n\tds_read_b64_tr_b16 %10, %18 offset:4096\n\tds_read_b64_tr_b16 %11, %18 offset:6144\n\t"
          "ds_read_b64_tr_b16 %12, %19\n\tds_read_b64_tr_b16 %13, %19 offset:2048\n\tds_read_b64_tr_b16 %14, %19 offset:4096\n\tds_read_b64_tr_b16 %15, %19 offset:6144"
          : "=&v"(vr[0][0]), "=&v"(vr[0][1]), "=&v"(vr[0][2]), "=&v"(vr[0][3]), "=&v"(vr[1][0]), "=&v"(vr[1][1]), "=&v"(vr[1][2]), "=&v"(vr[1][3]),
            "=&v"(vr[2][0]), "=&v"(vr[2][1]), "=&v"(vr[2][2]), "=&v"(vr[2][3]), "=&v"(vr[3][0]), "=&v"(vr[3][1]), "=&v"(vr[3][2]), "=&v"(vr[3][3])
          : "v"(va0), "v"(va1), "v"(va2), "v"(va3)
          : "memory");
    }
    bool need_mask;
    if (MODE == 2) need_mask = (ti == n); else need_mask = (ti == n) || (ti == n - 8);
    if (need_mask) {
#pragma unroll
      for (int t2 = 0; t2 < 2; ++t2) {
        const int tok = th * 32 + t2 * 16 + r15;
        int lo = 0, hi = 63;
        if (MODE == 2) { hi = tok; }
        else { if (ti == n) hi = tok; else lo = tok + 1; }
#pragma unroll
        for (int kf = 0; kf < 4; ++kf)
#pragma unroll
          for (int r = 0; r < 4; ++r) {
            const int kk = kf * 16 + 4 * q + r;
            if (kk < lo || kk > hi) s[kf][t2][r] = -INFINITY;
          }
      }
    }
#pragma unroll
    for (int t2 = 0; t2 < 2; ++t2) {
#pragma unroll
      for (int kf = 0; kf < 4; ++kf)
#pragma unroll
        for (int r = 0; r < 4; ++r) s[kf][t2][r] = fexp2(s[kf][t2][r]);
#pragma unroll
      for (int ks = 0; ks < 2; ++ks) {
        half8 pk;
#pragma unroll
        for (int r = 0; r < 4; ++r) { pk[r] = (half_t)s[2 * ks][t2][r]; pk[4 + r] = (half_t)s[2 * ks + 1][t2][r]; }
        pf[t2][ks] = pk;
      }
    }
    asm volatile("s_waitcnt lgkmcnt(0)"
                 : "+v"(vr[0][0]), "+v"(vr[0][1]), "+v"(vr[0][2]), "+v"(vr[0][3]), "+v"(vr[1][0]), "+v"(vr[1][1]), "+v"(vr[1][2]), "+v"(vr[1][3]),
                   "+v"(vr[2][0]), "+v"(vr[2][1]), "+v"(vr[2][2]), "+v"(vr[2][3]), "+v"(vr[3][0]), "+v"(vr[3][1]), "+v"(vr[3][2]), "+v"(vr[3][3])
                 :: "memory");
  }
  PP_BAR
  PP_PV
  __builtin_amdgcn_sched_barrier(0);
  if (th == 0) __builtin_amdgcn_s_barrier();
  __builtin_amdgcn_sched_barrier(0);
  l[0] = lacc[0][0]; l[1] = lacc[1][0];
  __syncthreads();
#undef A_GLOAD
#undef PP_BAR
#undef PP_PV
#undef PP_KREAD
#undef PP_KWAIT
}

__device__ void ph_attn_mfma(const Params& P, char* smem, int wvs) {
  unsigned int* impu = (unsigned int*)(smem + ATT_IMP);
  unsigned long long* selmask = (unsigned long long*)(smem + ATT_SELM);
  const int G = gridDim.x, nrounds = (2048 + G - 1) / G;
  for (int rd = 0; rd < nrounds; ++rd) {
    const int idx = rd * G + ((rd & 1) ? (G - 1 - (int)blockIdx.x) : (int)blockIdx.x);
    if (idx >= 2048) continue;
    const int tid = otid(wvs), lane = tid & 63, r15 = lane & 15, q = lane >> 4;
    const int n = 63 - (idx >> 5), bg = idx & 31, b = bg >> 2, g = bg & 3;
    const int wv = __builtin_amdgcn_readfirstlane(otid(wvs) >> 6);
    const int hd = g * 4 + (wv & 3), th = wv >> 2;
    const int t0 = b * SEQ + n * 64 + th * 32;
    const half_t* kc = P.kcmp + (size_t)bg * 256 * 64;
    const half_t* vc = P.vcmp + (size_t)bg * 256 * 64;
    const int nct = (4 * n + 2) / 64;
    attn_issue(smem, kc, vc, 64, 0, nct, wvs);
    half8 qf[2][2];
#pragma unroll
    for (int t2 = 0; t2 < 2; ++t2)
#pragma unroll
      for (int ks = 0; ks < 2; ++ks) qf[t2][ks] = *(const half8*)(P.p + (size_t)(t0 + t2 * 16 + r15) * LD1 + hd * 64 + 32 * ks + 8 * q);
    float* gate_l = (float*)(smem + ATT_GATE) + wv * 128;
    if (q == 0) {
#pragma unroll
      for (int t2 = 0; t2 < 2; ++t2) {
        const float* pr = P.gl + (size_t)(t0 + t2 * 16 + r15) * 48 + hd * 3;
        f32x4 gv;
#pragma unroll
        for (int c = 0; c < 3; ++c) gv[c] = sigmoidf(pr[c] + P.nsa_b_gate[hd * 3 + c]);
        gv[3] = 0.f;
        *(f32x4*)(gate_l + (t2 * 16 + r15) * 4) = gv;
      }
    }
    { const int tz = otid(wvs); for (int i = tz; i < 64 * IMPS + 128; i += NTHREADS) impu[i] = 0u; }
    float m[2], l[2]; f32x4 o[4][2]; unsigned long long selm[2] = {0ull, 0ull};
#pragma unroll
    for (int t2 = 0; t2 < 2; ++t2) { m[t2] = -1e30f; l[t2] = 0.f; }
#pragma unroll
    for (int df = 0; df < 4; ++df)
#pragma unroll
      for (int t2 = 0; t2 < 2; ++t2) o[df][t2] = (f32x4){0.f, 0.f, 0.f, 0.f};
    attn_branch<0, true>(smem, kc, vc, 64, 0, nct, n, th, qf, m, l, o, selm, wvs);
#pragma unroll
    for (int t2 = 0; t2 < 2; ++t2) {
      float lt = l[t2];
      lt = rowsum4(lt);
      l[t2] = lt > 0.f ? 1.f / lt : 0.f;
    }
    attn_branch<1>(smem, kc, vc, 64, 0, nct, n, th, qf, m, l, o, selm, wvs);
    f32x4 oacc[4][2];
#pragma unroll
    for (int t2 = 0; t2 < 2; ++t2) {
      const float gc = gate_l[(t2 * 16 + r15) * 4 + 0];
#pragma unroll
      for (int df = 0; df < 4; ++df) oacc[df][t2] = o[df][t2] * gc;
    }
    {
      const int tz = otid(wvs), lz = tz & 63;
#pragma unroll
      for (int i = 0; i < 4; ++i) {
        const int slab = i * 8 + wv, tokz = slab * 2 + (lz >> 5), cz = (lz & 31) ^ (tokz & 15);
        const half_t* zp = P.p + (size_t)(b * SEQ + n * 64 + tokz) * LD1 + 2560 + g * 256 + cz * 8;
        __builtin_amdgcn_global_load_lds((gbl_void*)zp, (lds_void*)(smem + ATT_Z + slab * 1024), 16, 0, 0);
      }
    }
    const int shr = ((int)blockIdx.x >> 5) & 7;
    const int rot_s = (shr * (n + 1)) >> 3;
    attn_issue(smem, P.p + (size_t)b * SEQ * LD1 + 1536 + g * 64, P.p + (size_t)b * SEQ * LD1 + 1792 + g * 64, LD1, 0, n, wvs, rot_s);
    {
      const int tid2 = otid(wvs);
      const int tok = tid2 >> 3, part = tid2 & 7;
      unsigned long long msk;
      if (n + 1 <= 16) {
        msk = (1ull << (n + 1)) - 1ull;
      } else {
        const uint4* rowp = (const uint4*)(impu + tok * IMPS);
        unsigned own[8];
        { const uint4 a = rowp[part * 2], b2 = rowp[part * 2 + 1];
          own[0] = a.x; own[1] = a.y; own[2] = a.z; own[3] = a.w; own[4] = b2.x; own[5] = b2.y; own[6] = b2.z; own[7] = b2.w; }
        int rank[8];
#pragma unroll
        for (int jj = 0; jj < 8; ++jj) {
          const int j = part * 8 + jj;
          own[jj] = (j >= 1 && j <= n - 2) ? ((own[jj] & ~63u) | (unsigned)(63 - j)) : 0xffffffffu;
          rank[jj] = 0;
        }
#pragma unroll 2
        for (int c4 = 0; c4 < 16; ++c4) {
          const uint4 v = rowp[c4];
          unsigned kv[4] = {v.x, v.y, v.z, v.w};
#pragma unroll
          for (int e = 0; e < 4; ++e) {
            const int j2 = c4 * 4 + e;
            const unsigned key2 = (j2 >= 1 && j2 <= n - 2) ? ((kv[e] & ~63u) | (unsigned)(63 - j2)) : 0u;
#pragma unroll
            for (int jj = 0; jj < 8; ++jj) rank[jj] += (key2 > own[jj]) ? 1 : 0;
          }
        }
        unsigned int bits = 0;
#pragma unroll
        for (int jj = 0; jj < 8; ++jj) if (rank[jj] < 13 && own[jj] != 0xffffffffu) bits |= 1u << jj;
        unsigned* sel32 = (unsigned*)selmask;
        if (bits) atomicOr(&sel32[tok * 2 + (part >> 2)], bits << (8 * (part & 3)));
        msk = 1ull | (1ull << n) | (1ull << (n - 1));
        if (part == 0) { atomicOr(&sel32[tok * 2], (unsigned)msk); atomicOr(&sel32[tok * 2 + 1], (unsigned)(msk >> 32)); }
      }
      if (n + 1 <= 16 && part == 0) selmask[tok] = msk;
    }
    __syncthreads();
#pragma unroll
    for (int t2 = 0; t2 < 2; ++t2) selm[t2] = selmask[th * 32 + t2 * 16 + r15];
    float qn2[2];
#pragma unroll
    for (int t2 = 0; t2 < 2; ++t2) {
      float a = 0.f;
#pragma unroll
      for (int ks = 0; ks < 2; ++ks)
#pragma unroll
        for (int e = 0; e < 8; ++e) a += (float)qf[t2][ks][e] * (float)qf[t2][ks][e];
      qn2[t2] = rowsum4(a);
    }
    { const float km = __uint_as_float(P.kmax2[bg * 2 + 0]);
#pragma unroll
      for (int t2 = 0; t2 < 2; ++t2) { m[t2] = sqrtf(qn2[t2] * km) * 1.001f - 5.0f * LOG2E; l[t2] = 0.f; } }
#pragma unroll
    for (int df = 0; df < 4; ++df)
#pragma unroll
      for (int t2 = 0; t2 < 2; ++t2) o[df][t2] = (f32x4){0.f, 0.f, 0.f, 0.f};
    attn_branch_pp<2, true>(smem, P.p + (size_t)b * SEQ * LD1 + 1536 + g * 64, P.p + (size_t)b * SEQ * LD1 + 1792 + g * 64, LD1, 0, n, n, th, qf, m, l, o, selm, wvs, rot_s);
#pragma unroll
    for (int t2 = 0; t2 < 2; ++t2) {
      const float gs = gate_l[(t2 * 16 + r15) * 4 + 1] / l[t2];
#pragma unroll
      for (int df = 0; df < 4; ++df) oacc[df][t2] += o[df][t2] * gs;
    }
    { const float km = __uint_as_float(P.kmax2[bg * 2 + 1]);
#pragma unroll
      for (int t2 = 0; t2 < 2; ++t2) { m[t2] = sqrtf(qn2[t2] * km) * 1.001f - 5.0f * LOG2E; l[t2] = 0.f; } }
#pragma unroll
    for (int df = 0; df < 4; ++df)
#pragma unroll
      for (int t2 = 0; t2 < 2; ++t2) o[df][t2] = (f32x4){0.f, 0.f, 0.f, 0.f};
    attn_branch_pp<3, false>(smem, P.p + (size_t)b * SEQ * LD1 + 2048 + g * 64, P.p + (size_t)b * SEQ * LD1 + 2304 + g * 64, LD1, (n > 8 ? n - 8 : 0), n, n, th, qf, m, l, o, selm, wvs, ((7 - shr) * (n > 8 ? 9 : n + 1)) >> 3);
    {
      int tbase = t0 + r15; asm volatile("" : "+v"(tbase));
#pragma unroll
      for (int t2 = 0; t2 < 2; ++t2) {
        const size_t tok = (size_t)(tbase + t2 * 16);
        const float gw = gate_l[(t2 * 16 + r15) * 4 + 2] / l[t2];
#pragma unroll
        for (int df = 0; df < 4; ++df) {
          const f32x4 v = oacc[df][t2] + o[df][t2] * gw;
          const int tokl = th * 32 + t2 * 16 + r15, cz = (wv & 3) * 8 + df * 2 + (q >> 1);
          const half4 z = *(const half4*)(smem + ATT_Z + tokl * 512 + ((cz ^ (tokl & 15)) << 4) + (q & 1) * 8);
          half4 hv;
#pragma unroll
          for (int e = 0; e < 4; ++e) hv[e] = (half_t)(v[e] * siluf((float)z[e]));
          *(half4*)(P.og + tok * DM + hd * 64 + df * 16 + 4 * q) = hv;
        }
      }
    }
  }
}

constexpr int NPHASES = 13;
__device__ __forceinline__ void run_phase(int ph, const Params& P, char* smem, int wvs) {
  float* sm = (float*)smem;
  switch (ph) {
    case 0:
      if (blockIdx.x == 0 && otid(wvs) < 64) P.kmax2[otid(wvs)] = 0u;
      ph_xh_rstd(P.x, P.xh, P.rstd, wvs); ph_ropetab(P, wvs); prep_cbias_part(P, wvs);
      prep_weights(P, sm, wvs);
      prep_wT(P.nsa_w_in, NSA_IN, P.pre_norm + DM, P.WglT, 64, DM, 5, sm, wvs);
      prep_wT(P.gla_w_in, GLA_IN, P.pre_norm, P.WglrT, 64, DM, 6, sm, wvs);
      break;
    case 1:
      g8::gemm(g8::SrcPlain8{P.xh, DM, P.W0t, DM}, T_TOK, LD0, DM, g8::EpiStore8{P.p, LD0, P.rstd}, smem, wvs);
      ph_rowproj<1>(P, P.WglrT, P.glr, smem, wvs, 0);
      break;
    case 2: prep_cbias_reduce(P, wvs); ph_gla_prep(P, sm, wvs); break;
    case 13: ph_gla_mfma<true>(P, smem, wvs); break;
    case 3: ph_gla_mfma<false>(P, smem, wvs); break;
    case 4: ph_gla_post(P, wvs); break;
    case 5: g8::gemm(g8::SrcPlain8{P.og, DM, P.Wo0t, DM}, T_TOK, DM, DM, g8::EpiStore8{P.y, DM, nullptr}, smem, wvs); break;
    case 6: ph_post<false>(P.xh, P.y, P.post_norm, nullptr, P.xh, P.rstd, wvs); break;
    case 7: g8::gemm(g8::SrcPlain8{P.xh, DM, P.W1t, DM}, T_TOK, LD1, DM, g8::EpiRope8{P.p, LD1, P.rstd, P.ropetab}, smem, wvs); break;
    case 8:
      if (blockIdx.x >= 64) { ph_kmax(P, wvs, 64); ph_rowproj<3>(P, P.WglT, P.gl, smem, wvs, 64); }
      g8::gemm(g8::SrcCmp1_8{P.p, P.cw1t}, 16384, 256, 2048, g8::EpiCmpHid8{P.hid, P.cbias}, smem, wvs);
      asm volatile("s_waitcnt vmcnt(0)" ::: "memory");
      __syncthreads();
      g8::gemm(g8::SrcCmp2_8{P.hid, P.cw2t}, 16384, 256, 256, g8::EpiCmpOut8{P.kcmp, P.vcmp}, smem, wvs);
      break;
    case 10: ph_attn_mfma(P, smem, wvs); break;
    case 11: g8::gemm(g8::SrcPlain8{P.og, DM, P.Wo1t, DM}, T_TOK, DM, DM, g8::EpiStore8{P.y, DM, nullptr}, smem, wvs); break;
    case 12: ph_post<true>(P.x1h, P.y, P.post_norm + DM, P.out, nullptr, nullptr, wvs); break;
  }
}

template <int PH>
__global__ void __launch_bounds__(NTHREADS, 2) k_phase(Params P) {
  __shared__ __attribute__((aligned(16))) char smem[SMEM_BYTES];
  run_phase(PH, P, smem, __builtin_amdgcn_readfirstlane(threadIdx.x >> 6));
}
template <int PH>
static void launch_phases(const Params& P, hipStream_t stream) {
  hipLaunchKernelGGL((k_phase<PH>), dim3(256), dim3(NTHREADS), 0, stream, P);
  if constexpr (PH + 1 < NPHASES) launch_phases<PH + 1>(P, stream);
}

#if MEGA
__global__ void __launch_bounds__(NTHREADS, 2) k_mega(Params P) {
  __shared__ __attribute__((aligned(16))) char smem[SMEM_BYTES];
  cg::grid_group grid = cg::this_grid();
  if (P.use_cg_sync) grid.sync();
  unsigned bt = 0;
  const int wvs = __builtin_amdgcn_readfirstlane(threadIdx.x >> 6);
  run_phase(0, P, smem, wvs); fast_barrier(P.bar, bt, wvs);
  run_phase(1, P, smem, wvs); fast_barrier(P.bar, bt, wvs);
  run_phase(2, P, smem, wvs); fast_barrier(P.bar, bt, wvs);
  run_phase(13, P, smem, wvs); fast_barrier(P.bar, bt, wvs);
  run_phase(3, P, smem, wvs); fast_barrier(P.bar, bt, wvs);
  run_phase(4, P, smem, wvs); fast_barrier(P.bar, bt, wvs);
  run_phase(5, P, smem, wvs); fast_barrier(P.bar, bt, wvs);
  run_phase(6, P, smem, wvs); fast_barrier(P.bar, bt, wvs);
  run_phase(7, P, smem, wvs); fast_barrier(P.bar, bt, wvs);
  run_phase(8, P, smem, wvs); fast_barrier(P.bar, bt, wvs);
  run_phase(10, P, smem, wvs); fast_barrier(P.bar, bt, wvs);
  run_phase(11, P, smem, wvs); fast_barrier(P.bar, bt, wvs);
  run_phase(12, P, smem, wvs);
}
#endif

extern "C" void kernel_launch(void* const* d_in, const int* in_sizes, int n_in, void* d_out, int out_size, void* d_ws, size_t ws_size,
                              hipStream_t stream) {
  Params P{};
  P.x = (const float*)d_in[0]; P.pos = (const int*)d_in[1]; P.pre_norm = (const float*)d_in[2]; P.post_norm = (const float*)d_in[3];
  P.gla_w_in = (const float*)d_in[4]; P.gla_w_gk_up = (const float*)d_in[5]; P.gla_b_gk = (const float*)d_in[6];
  P.gla_head_norm = (const float*)d_in[7]; P.gla_w_out = (const float*)d_in[8];
  P.nsa_w_in = (const float*)d_in[9]; P.nsa_b_gate = (const float*)d_in[10]; P.nsa_pe_k = (const float*)d_in[11]; P.nsa_pe_v = (const float*)d_in[12];
  P.ck_w1 = (const float*)d_in[13]; P.ck_w2 = (const float*)d_in[14]; P.cv_w1 = (const float*)d_in[15]; P.cv_w2 = (const float*)d_in[16];
  P.nsa_w_out = (const float*)d_in[17];
  P.out = (float*)d_out;
  char* ws = (char*)d_ws;
  const size_t MB = 1024 * 1024;
  P.W0t = (half_t*)(ws);
  P.Wo0t = (half_t*)(ws + 7 * MB);
  P.W1t = (half_t*)(ws + 9 * MB);
  P.Wo1t = (half_t*)(ws + 17 * MB);
  P.cw1t = (half_t*)(ws + 19 * MB);
  P.cw2t = (half_t*)(ws + 21 * MB);
  P.cbias = (float*)(ws + 22 * MB);
  P.cbias_part = (float*)(ws + 22 * MB + 4096);
  P.bar = (unsigned*)(ws + 23 * MB);
  P.use_cg_sync = 0;
  P.kmax2 = (unsigned*)(ws + 22 * MB + 512 * 1024);
  P.xh = (half_t*)(ws + 24 * MB);
  P.x1h = P.xh;
  P.p = (half_t*)(ws + 88 * MB);
  P.y = (half_t*)(ws + 88 * MB);
  P.og = (half_t*)(ws + 328 * MB);
  P.bcum = (float*)(ws + 392 * MB);
  P.rstd = (float*)(ws + 456 * MB);
  P.kcmp = (half_t*)(ws + 457 * MB);
  P.vcmp = (half_t*)(ws + 458 * MB);
  P.ropetab = (float*)(ws + 459 * MB);
  P.hid = (half_t*)(ws + 467 * MB);
  P.WglT = (half_t*)(ws + 22 * MB + 768 * 1024);
  P.WglrT = (half_t*)(ws + 22 * MB + 896 * 1024);
  P.glr = (float*)(ws + 509 * MB);
  P.gl = (float*)(ws + 503 * MB);
  P.gla_state = (float*)(ws + 476 * MB);
  if (ws_size < 512 * MB) { fprintf(stderr, "ws too small: %zu\n", ws_size); return; }
#if MEGA
  static int grid_blocks = 0;
  if (!grid_blocks) {
    int dev = 0, cus = 0, per_cu = 0;
    hipGetDevice(&dev);
    hipDeviceGetAttribute(&cus, hipDeviceAttributeMultiprocessorCount, dev);
    hipOccupancyMaxActiveBlocksPerMultiprocessor(&per_cu, k_mega, NTHREADS, 0);
    if (per_cu < 1) per_cu = 1;
    if (per_cu > 1) per_cu = 1;
    grid_blocks = cus * per_cu;
  }
  hipMemsetAsync(ws + 23 * MB, 0, 16384, stream);
  void* args[] = {&P};
  hipError_t e = hipLaunchCooperativeKernel((void*)k_mega, dim3(grid_blocks), dim3(NTHREADS), args, 0, stream);
  if (e != hipSuccess) fprintf(stderr, "cooperative launch failed: %s (grid %d)\n", hipGetErrorString(e), grid_blocks);
#else
  launch_phases<0>(P, stream);
#endif
}
```

```cpp
#include <hip/hip_runtime.h>
#include <hip/hip_cooperative_groups.h>
#include <cstdio>
#include <cstdint>
namespace cg = cooperative_groups;

typedef _Float16 half_t;
typedef _Float16 half8 __attribute__((ext_vector_type(8)));
typedef _Float16 half4 __attribute__((ext_vector_type(4)));
typedef float f32x4 __attribute__((ext_vector_type(4)));
typedef int v2i __attribute__((ext_vector_type(2)));
typedef int v4i __attribute__((ext_vector_type(4)));

#ifndef MEGA
#define MEGA 1
#endif

constexpr int T_TOK = 32768, DM = 1024, SEQ = 4096, NBATCH = 8;
constexpr int GLA_IN = 3088, NSA_IN = 3632;
constexpr int LD0 = 3072, LD1 = 3584;
constexpr int NC = 255;
constexpr float EPS = 1e-6f;
constexpr int NTHREADS = 512, NWAVES = NTHREADS / 64;
constexpr int SMEM_BYTES = 160 * 1024;

struct Params {
  const float* x; const int* pos; const float* pre_norm; const float* post_norm;
  const float* gla_w_in; const float* gla_w_gk_up; const float* gla_b_gk; const float* gla_head_norm; const float* gla_w_out;
  const float* nsa_w_in; const float* nsa_b_gate; const float* nsa_pe_k; const float* nsa_pe_v;
  const float* ck_w1; const float* ck_w2; const float* cv_w1; const float* cv_w2; const float* nsa_w_out;
  float* out;
  half_t* p; half_t* y; half_t* og; float* bcum; float* rstd; half_t* kcmp; half_t* vcmp; float* ropetab;
  half_t* xh; half_t* W0t; half_t* Wo0t; half_t* W1t; half_t* Wo1t;
  half_t* cw1t; half_t* cw2t; float* cbias; half_t* hid;
  float* cbias_part; unsigned* bar; long long use_cg_sync; unsigned* kmax2; float* gla_state; half_t* WglT; float* gl; half_t* x1h; half_t* WglrT; float* glr;
};

__device__ __forceinline__ int lane_id() { return (int)__builtin_amdgcn_mbcnt_hi(~0u, __builtin_amdgcn_mbcnt_lo(~0u, 0u)); }
__device__ __forceinline__ int otid(int wvs) { int t = wvs * 64 + lane_id(); asm volatile("" : "+v"(t)); return t; }
__device__ __forceinline__ float wave_sum(float v) {
#pragma unroll
  for (int o = 32; o > 0; o >>= 1) v += __shfl_xor(v, o);
  return v;
}
__device__ __forceinline__ float wave_max(float v) {
#pragma unroll
  for (int o = 32; o > 0; o >>= 1) v = fmaxf(v, __shfl_xor(v, o));
  return v;
}
typedef __attribute__((address_space(3))) void lds_void;
typedef __attribute__((address_space(1))) const void gbl_void;
typedef short s16x4 __attribute__((vector_size(8)));
typedef __attribute__((address_space(3))) s16x4 lds_s16x4;
__device__ __forceinline__ half4 tr_read4(const char* p) {
  const s16x4 v = __builtin_amdgcn_ds_read_tr16_b64_v4i16((lds_s16x4*)(p));
  return __builtin_bit_cast(half4, v);
}
template <int N> __device__ __forceinline__ void wait_vmcnt() { asm volatile("s_waitcnt vmcnt(%0)" ::"n"(N) : "memory"); }
constexpr float LOG2E = 1.4426950408889634f;
__device__ __forceinline__ float fexp2(float x) { return __builtin_amdgcn_exp2f(x); }
typedef unsigned u32x2 __attribute__((ext_vector_type(2)));
__device__ __forceinline__ float rowmax4(float x) {
  u32x2 r = __builtin_amdgcn_permlane16_swap(__float_as_uint(x), __float_as_uint(x), false, false);
  x = fmaxf(__uint_as_float(r[0]), __uint_as_float(r[1]));
  r = __builtin_amdgcn_permlane32_swap(__float_as_uint(x), __float_as_uint(x), false, false);
  return fmaxf(__uint_as_float(r[0]), __uint_as_float(r[1]));
}
__device__ __forceinline__ float rowsum4(float x) {
  u32x2 r = __builtin_amdgcn_permlane16_swap(__float_as_uint(x), __float_as_uint(x), false, false);
  x = __uint_as_float(r[0]) + __uint_as_float(r[1]);
  r = __builtin_amdgcn_permlane32_swap(__float_as_uint(x), __float_as_uint(x), false, false);
  return __uint_as_float(r[0]) + __uint_as_float(r[1]);
}
__device__ __forceinline__ float fast_exp2(float x) { return __builtin_amdgcn_exp2f(x); }
__device__ __forceinline__ float sigmoidf(float v) { return __builtin_amdgcn_rcpf(1.f + fast_exp2(-1.4426950408889634f * v)); }
__device__ __forceinline__ float siluf(float v) { return v * sigmoidf(v); }
__device__ __forceinline__ float logsigmoidf(float u) { return fminf(u, 0.f) - 0.6931471805599453f * __builtin_amdgcn_logf(1.f + fast_exp2(-1.4426950408889634f * fabsf(u))); }

__device__ __forceinline__ void fast_barrier(unsigned* bar, unsigned& round, int wvs) {
  asm volatile("s_waitcnt vmcnt(0) lgkmcnt(0)" ::: "memory");
  __syncthreads();
  round += 1;
  if (wvs == 0 && lane_id() == 0) {
    __builtin_amdgcn_fence(__ATOMIC_RELEASE, "agent");
    asm volatile("s_waitcnt vmcnt(0)" ::: "memory");
    const unsigned ngroups = gridDim.x >> 4;
    const unsigned old = __hip_atomic_fetch_add(bar + 64 + 64 * (blockIdx.x >> 4), 1u, __ATOMIC_RELAXED, __HIP_MEMORY_SCOPE_AGENT);
    if (old + 1 == round * 16u) __hip_atomic_fetch_add(bar, 1u, __ATOMIC_RELAXED, __HIP_MEMORY_SCOPE_AGENT);
    const unsigned target = round * ngroups;
    while (__hip_atomic_load(bar, __ATOMIC_RELAXED, __HIP_MEMORY_SCOPE_AGENT) < target) { }
    __builtin_amdgcn_fence(__ATOMIC_ACQUIRE, "agent");
    asm volatile("s_waitcnt vmcnt(0)" ::: "memory");
  }
  __syncthreads();
}

__device__ void ph_xh_rstd(const float* src, half_t* xh, float* rstd, int wvs) {
  const int tid_ = otid(wvs); const int lane = tid_ & 63, w = tid_ >> 6;
  constexpr int RW = 4;
  const int rstride = gridDim.x * NWAVES;
#pragma unroll 1
  for (int row0 = blockIdx.x * NWAVES + w; row0 < T_TOK; row0 += rstride * RW) {
    float4 v[RW][4];
#pragma unroll
    for (int r = 0; r < RW; ++r)
#pragma unroll
      for (int i = 0; i < 4; ++i) v[r][i] = ((const float4*)(src + (size_t)(row0 + r * rstride) * DM))[lane + 64 * i];
#pragma unroll
    for (int r = 0; r < RW; ++r) {
      const int row = row0 + r * rstride;
      half4* xr = (half4*)(xh + (size_t)row * DM);
      float ss = 0.f;
#pragma unroll
      for (int i = 0; i < 4; ++i) {
        const float4 t = v[r][i];
        ss += t.x * t.x + t.y * t.y + t.z * t.z + t.w * t.w;
        half4 hv; hv[0] = (half_t)t.x; hv[1] = (half_t)t.y; hv[2] = (half_t)t.z; hv[3] = (half_t)t.w;
        xr[lane + 64 * i] = hv;
      }
      ss = wave_sum(ss);
      if (lane == 0) rstd[row] = rsqrtf(ss * (1.f / DM) + EPS);
    }
  }
}
__device__ void ph_ropetab(const Params& P, int wvs) {
  const int tid = otid(wvs);
  const float inv = powf(10000.f, -(float)(2 * (tid & 31)) / 64.f);
  for (int idx = blockIdx.x * NTHREADS + tid; idx < T_TOK * 32; idx += gridDim.x * NTHREADS) {
    const int t = idx >> 5, i = idx & 31;
    const float ang = (float)P.pos[t] * inv;
    float s, c; sincosf(ang, &s, &c);
    P.ropetab[t * 64 + i] = c; P.ropetab[t * 64 + 32 + i] = s;
  }
}
__device__ __forceinline__ int orig_col(int n, int mode) {
  if (mode == 0) {
    if (n < 2048) return n;
    if (n < 3072) return n + 16;
    return -1;
  } else if (mode == 1) {
    if (n < 2560) return n;
    if (n < 3584) return n + 48;
    return -1;
  } else if (mode == 5) {
    return n < 48 ? 2560 + n : -1;
  }
  if (mode == 4) return n < 64 ? n : -1;
  if (mode == 6) return n < 16 ? 2048 + n : -1;
  return n;
}
__device__ void prep_wT(const float* W, int ldw, const float* gamma, half_t* Wt, int Npad, int K, int mode, float* sm, int wvs) {
  float(*tile)[65] = (float(*)[65])sm;
  const int tid = otid(wvs);
  const int ntn = Npad / 64, ntk = K / 64;
  for (int t = blockIdx.x; t < ntn * ntk; t += gridDim.x) {
    const int n0 = (t / ntk) * 64, k0 = (t % ntk) * 64;
    __syncthreads();
#pragma unroll
    for (int r = 0; r < 4096 / NTHREADS; ++r) {
      const int idx = tid + r * NTHREADS, kk = idx >> 6, nn = idx & 63;
      const int on = orig_col(n0 + nn, mode);
      float v = 0.f;
      if (on >= 0) { v = W[(size_t)(k0 + kk) * ldw + on]; if (gamma) v *= gamma[k0 + kk]; }
      tile[kk][nn] = v;
    }
    __syncthreads();
    {
      const int nn = tid >> 3, oct = tid & 7;
      half8 hv;
#pragma unroll
      for (int e = 0; e < 8; ++e) hv[e] = (half_t)tile[oct * 8 + e][nn];
      *(half8*)(Wt + (size_t)(n0 + nn) * K + k0 + oct * 8) = hv;
    }
  }
}

__device__ __forceinline__ void prep_strip(const float* W, int ldw, const float* gamma, half_t* Wt, int K, int mode, int n0, int k0, float* sm, int tid) {
  float(*tile)[260] = (float(*)[260])sm;
  __syncthreads();
#pragma unroll
  for (int r = 0; r < 8; ++r) {
    const int idx = tid + r * NTHREADS, kk = idx >> 6, n4 = (idx & 63) * 4;
    const int on = orig_col(n0 + n4, mode);
    f32x4 v = (f32x4){0.f, 0.f, 0.f, 0.f};
    if (on >= 0) { v = *(const f32x4*)(W + (size_t)(k0 + kk) * ldw + on); if (gamma) v *= gamma[k0 + kk]; }
    *(f32x4*)&tile[kk][n4] = v;
  }
  __syncthreads();
#pragma unroll
  for (int r = 0; r < 4; ++r) {
    const int idx = tid + r * NTHREADS, nn = idx & 255, oct = idx >> 8;
    half8 hv;
#pragma unroll
    for (int e = 0; e < 8; ++e) hv[e] = (half_t)tile[oct * 8 + e][nn];
    *(half8*)(Wt + (size_t)(n0 + nn) * K + k0 + oct * 8) = hv;
  }
}
__device__ void prep_weights(const Params& P, float* sm, int wvs) {
  const int tid = otid(wvs);
  constexpr int NJ = 8;
  const int nstr[NJ] = {(LD0 / 256) * (DM / 64), (DM / 256) * (DM / 64), (LD1 / 256) * (DM / 64), (DM / 256) * (DM / 64), 32, 32, 4, 4};
  int total = 0;
#pragma unroll
  for (int j = 0; j < NJ; ++j) total += nstr[j];
  for (int w = blockIdx.x; w < total; w += gridDim.x) {
    int j = 0, t = w;
#pragma unroll
    for (int jj = 0; jj < NJ - 1; ++jj) if (j == jj && t >= nstr[jj]) { t -= nstr[jj]; j = jj + 1; }
    const float* W; int ldw; const float* gamma; half_t* Wt; int K, mode;
    switch (j) {
      case 0: W = P.gla_w_in; ldw = GLA_IN; gamma = P.pre_norm; Wt = P.W0t; K = DM; mode = 0; break;
      case 1: W = P.gla_w_out; ldw = DM; gamma = nullptr; Wt = P.Wo0t; K = DM; mode = 2; break;
      case 2: W = P.nsa_w_in; ldw = NSA_IN; gamma = P.pre_norm + DM; Wt = P.W1t; K = DM; mode = 1; break;
      case 3: W = P.nsa_w_out; ldw = DM; gamma = nullptr; Wt = P.Wo1t; K = DM; mode = 2; break;
      case 4: W = P.ck_w1; ldw = 256; gamma = nullptr; Wt = P.cw1t; K = 2048; mode = 2; break;
      case 5: W = P.cv_w1; ldw = 256; gamma = nullptr; Wt = P.cw1t + 256 * 2048; K = 2048; mode = 2; break;
      case 6: W = P.ck_w2; ldw = 64; gamma = nullptr; Wt = P.cw2t; K = 256; mode = 4; break;
      default: W = P.cv_w2; ldw = 64; gamma = nullptr; Wt = P.cw2t + 256 * 256; K = 256; mode = 4; break;
    }
    const int nsk = K / 64;
    prep_strip(W, ldw, gamma, Wt, K, mode, (t / nsk) * 256, (t % nsk) * 64, sm, tid);
  }
}

__device__ void prep_cbias_part(const Params& P, int wvs) {
  for (int idx = blockIdx.x * NTHREADS + otid(wvs); idx < 2 * 32 * 256; idx += gridDim.x * NTHREADS) {
    const int j = idx & 255, ks = (idx >> 8) & 31, which = idx >> 13;
    const float* pe = which ? P.nsa_pe_v : P.nsa_pe_k;
    const float* w1 = which ? P.cv_w1 : P.ck_w1;
    float a = 0.f;
#pragma unroll 8
    for (int k = ks * 64; k < ks * 64 + 64; ++k) a += pe[k] * w1[(size_t)k * 256 + j];
    P.cbias_part[idx] = a;
  }
}
__device__ void prep_cbias_reduce(const Params& P, int wvs) {
  if (blockIdx.x < 2 && otid(wvs) < 256) {
    const int which = blockIdx.x, j = otid(wvs);
    float a = 0.f;
    for (int ks = 0; ks < 32; ++ks) a += P.cbias_part[(which * 32 + ks) * 256 + j];
    P.cbias[which * 256 + j] = a;
  }
}

namespace g8 {
constexpr int BK = 64, HALF = 128, HTB = HALF * BK * 2;
__device__ __forceinline__ int lds_byte(int r, int c) { const int st = (r >> 4) * 2 + (c >> 5), rr = r & 15, cc = c & 31, ob = rr * 64 + cc * 2; return st * 1024 + (ob ^ (((ob >> 9) & 1) << 5)); }
__device__ __forceinline__ void stage_rc(int b, int& R, int& C) { const int st = b / 1024, sb = b % 1024, swz = sb ^ (((sb >> 9) & 1) << 5); R = (st >> 1) * 16 + swz / 64; C = (st & 1) * 32 + (swz % 64) / 2; }
typedef f32x4 Acc[2][2][4][2];

struct SrcPlain8 {
  const half_t* A; int lda; const half_t* Bt; int K;
  __device__ __forceinline__ void get(int pm, int pn, const half_t*& Ag, const half_t*& Bg, size_t& a_rs, int& a_ks) const {
    Ag = A + (size_t)pm * 256 * lda; Bg = Bt + (size_t)pn * 256 * K; a_rs = lda; a_ks = 64;
  }
};
struct SrcCmp1_8 {
  const half_t* p1; const half_t* w1t;
  __device__ __forceinline__ void get(int pm, int pn, const half_t*& Ag, const half_t*& Bg, size_t& a_rs, int& a_ks) const {
    const int which = pm >> 5, bg = pm & 31, b = bg >> 2, g = bg & 3;
    Ag = p1 + (size_t)(b * SEQ) * LD1 + (which ? 1280 : 1024) + g * 64;
    Bg = w1t + (size_t)which * 256 * 2048; a_rs = (size_t)16 * LD1; a_ks = LD1;
  }
};
struct SrcCmp2_8 {
  const half_t* hid; const half_t* w2t;
  __device__ __forceinline__ void get(int pm, int pn, const half_t*& Ag, const half_t*& Bg, size_t& a_rs, int& a_ks) const {
    Ag = hid + (size_t)pm * 256 * 256; Bg = w2t + (size_t)(pm >> 5) * 256 * 256; a_rs = 256; a_ks = 64;
  }
};

__device__ __forceinline__ half8 pack8(const f32x4 a, const f32x4 b) {
  half8 h; h[0] = (half_t)a[0]; h[1] = (half_t)a[1]; h[2] = (half_t)a[2]; h[3] = (half_t)a[3]; h[4] = (half_t)b[0]; h[5] = (half_t)b[1]; h[6] = (half_t)b[2]; h[7] = (half_t)b[3];
  return h;
}
struct EpiStore8 {
  half_t* C; int ldc; const float* rowscale;
  __device__ __forceinline__ void operator()(const Acc& acc, int row0, int col0, int wr, int wc, int fr, int fq) const {
    float rs[2][4];
#pragma unroll
    for (int ai = 0; ai < 2; ++ai)
#pragma unroll
      for (int m = 0; m < 4; ++m) rs[ai][m] = rowscale ? rowscale[row0 + ai * 128 + wr * 64 + m * 16 + fr] : 1.f;
#pragma unroll
    for (int ai = 0; ai < 2; ++ai)
#pragma unroll
      for (int m = 0; m < 4; ++m) {
        const int tok = row0 + ai * 128 + wr * 64 + m * 16 + fr;
        const float s = rs[ai][m];
        half_t* rowp = C + (size_t)tok * ldc + col0 + 64 * wc + 8 * fq;
#pragma unroll
        for (int bj = 0; bj < 2; ++bj) *(half8*)(rowp + 32 * bj) = pack8(acc[ai][bj][m][0] * s, acc[ai][bj][m][1] * s);
      }
  }
};
struct EpiRope8 {
  half_t* C; int ldc; const float* rowscale; const float* ropetab;
  __device__ __forceinline__ void operator()(const Acc& acc, int row0, int col0, int wr, int wc, int fr, int fq) const {
    const int grp = (col0 >> 6) + wc;
    const bool is_q = grp < 16;
    const bool roped = is_q || (grp >= 16 && grp < 20) || (grp >= 24 && grp < 28) || (grp >= 32 && grp < 36);
    const float sc = is_q ? 0.125f * 1.4426950408889634f : 1.f;
    float s = rowscale[row0 + wr * 64 + fr];
    f32x4 cs[2], sn[2];
    if (roped) {
      const int tok0 = row0 + wr * 64 + fr;
#pragma unroll
      for (int n = 0; n < 2; ++n) { cs[n] = *(const f32x4*)(ropetab + (size_t)tok0 * 64 + 8 * fq + 4 * n); sn[n] = *(const f32x4*)(ropetab + (size_t)tok0 * 64 + 32 + 8 * fq + 4 * n); }
    }
#pragma unroll
    for (int i = 0; i < 8; ++i) {
        const int ai = i >> 2, m = i & 3;
        const int tok = row0 + ai * 128 + wr * 64 + m * 16 + fr;
        half_t* rowp = C + (size_t)tok * ldc + col0 + 64 * wc + 8 * fq;
        f32x4 o1[2], o2[2];
#pragma unroll
        for (int n = 0; n < 2; ++n) {
          const f32x4 x1 = acc[ai][0][m][n] * s, x2 = acc[ai][1][m][n] * s;
          if (roped) { o1[n] = (x1 * cs[n] - x2 * sn[n]) * sc; o2[n] = (x2 * cs[n] + x1 * sn[n]) * sc; }
          else { o1[n] = x1; o2[n] = x2; }
        }
        const half8 p1 = pack8(o1[0], o1[1]), p2 = pack8(o2[0], o2[1]);
        if (i + 1 < 8) {
          const int tokn = row0 + ((i + 1) >> 2) * 128 + wr * 64 + ((i + 1) & 3) * 16 + fr;
          s = rowscale[tokn];
          if (roped) {
#pragma unroll
            for (int n = 0; n < 2; ++n) { cs[n] = *(const f32x4*)(ropetab + (size_t)tokn * 64 + 8 * fq + 4 * n); sn[n] = *(const f32x4*)(ropetab + (size_t)tokn * 64 + 32 + 8 * fq + 4 * n); }
          }
        }
        *(half8*)(rowp) = p1;
        *(half8*)(rowp + 32) = p2;
    }
  }
};
struct EpiCmpHid8 {
  half_t* hid; const float* bias;
  __device__ __forceinline__ void operator()(const Acc& acc, int row0, int col0, int wr, int wc, int fr, int fq) const {
    const int which = row0 >> 13;
#pragma unroll
    for (int bj = 0; bj < 2; ++bj) {
      const int col = col0 + 64 * wc + 32 * bj + 8 * fq;
      const f32x4 b0 = *(const f32x4*)(bias + which * 256 + col), b1 = *(const f32x4*)(bias + which * 256 + col + 4);
#pragma unroll
      for (int ai = 0; ai < 2; ++ai)
#pragma unroll
        for (int m = 0; m < 4; ++m) {
          const int row = row0 + ai * 128 + wr * 64 + m * 16 + fr;
          f32x4 v0 = acc[ai][bj][m][0] + b0, v1 = acc[ai][bj][m][1] + b1;
#pragma unroll
          for (int e = 0; e < 4; ++e) { v0[e] = siluf(v0[e]); v1[e] = siluf(v1[e]); }
          *(half8*)(hid + (size_t)row * 256 + col) = pack8(v0, v1);
        }
    }
  }
};
struct EpiCmpOut8 {
  half_t* kcmp; half_t* vcmp;
  __device__ __forceinline__ void operator()(const Acc& acc, int row0, int col0, int wr, int wc, int fr, int fq) const {
    if (wc != 0) return;
#pragma unroll
    for (int ai = 0; ai < 2; ++ai)
#pragma unroll
      for (int m = 0; m < 4; ++m) {
        const int row = row0 + ai * 128 + wr * 64 + m * 16 + fr;
        const int which = row >> 13, r = row & 8191;
        half_t* dst = (which ? vcmp : kcmp) + (size_t)r * 64 + 8 * fq;
        const bool dead = (r & 255) == 255;
#pragma unroll
        for (int bj = 0; bj < 2; ++bj) {
          half8 hv = pack8(acc[ai][bj][m][0], acc[ai][bj][m][1]);
          if (dead) hv = (half8){(half_t)0.f, (half_t)0.f, (half_t)0.f, (half_t)0.f, (half_t)0.f, (half_t)0.f, (half_t)0.f, (half_t)0.f};
          *(half8*)(dst + 32 * bj) = hv;
        }
      }
  }
};

template <class Src, class Epi>
__device__ void gemm(const Src& src, int M, int N, int K, const Epi& epi, char* smem, int wvs) {
  const int tid = otid(wvs), wid = __builtin_amdgcn_readfirstlane(tid >> 6), lane = tid & 63, wr = wid >> 2, wc = wid & 3, fr = lane & 15, fq = lane >> 4;
  const int nM = M / 256, nN = N / 256, nwg = nM * nN, G = gridDim.x, nt = K / BK;
  int sr0, sc0, sr1, sc1;
  stage_rc(tid * 16, sr0, sc0); stage_rc(tid * 16 + 8192, sr1, sc1);
  const int a_base = lds_byte(wr * 64 + fr, fq * 8);
  int b_base = 65536 + lds_byte(wc * 32 + fr, fq * 8);
  asm volatile("" : "+v"(b_base));
#define SA8(b, h) (smem + ((b) * 2 + (h)) * HTB)
#define SB8(b, h) (smem + (4 + (b) * 2 + (h)) * HTB)
#define STAGE_A(P, h, kt) { const char* g_ = (const char*)(Ag + (size_t)(h) * 128 * lda + (size_t)(kt) * a_ks); \
    __builtin_amdgcn_global_load_lds((gbl_void*)(g_ + aob0), (lds_void*)((P) + wid * 1024), 16, 0, 0); \
    __builtin_amdgcn_global_load_lds((gbl_void*)(g_ + aob1), (lds_void*)((P) + 8192 + wid * 1024), 16, 0, 0); }
#define STAGE_B(P, h, kt) { const char* g_ = (const char*)(Bg + (size_t)(h) * 32 * K + (size_t)(kt) * 64);     \
    __builtin_amdgcn_global_load_lds((gbl_void*)(g_ + bob0), (lds_void*)((P) + wid * 1024), 16, 0, 0); \
    __builtin_amdgcn_global_load_lds((gbl_void*)(g_ + bob1), (lds_void*)((P) + 8192 + wid * 1024), 16, 0, 0); }
#define LDA8(dst, b, h) { _Pragma("unroll") for (int m = 0; m < 4; ++m) _Pragma("unroll") for (int k = 0; k < 2; ++k) dst[m][k] = *(const half8*)(SA8(b, h) + a_base + m * 2048 + k * 1024); }
#define LDB8(dst, b, h) { _Pragma("unroll") for (int n = 0; n < 2; ++n) _Pragma("unroll") for (int k = 0; k < 2; ++k) dst[n][k] = *(const half8*)(smem + ((b) * 2 + (h)) * HTB + b_base + n * 2048 + k * 1024); }
#define MMA8(ai, bj, At, Bx) { __builtin_amdgcn_s_setprio(1); \
    _Pragma("unroll") for (int m = 0; m < 4; ++m) _Pragma("unroll") for (int n = 0; n < 2; ++n) _Pragma("unroll") for (int k = 0; k < 2; ++k) \
      acc[ai][bj][m][n] = __builtin_amdgcn_mfma_f32_16x16x32_f16(Bx[n][k], At[m][k], acc[ai][bj][m][n], 0, 0, 0); \
    __builtin_amdgcn_s_setprio(0); }
#define WAIT_V(n) asm volatile("s_waitcnt vmcnt(" #n ")" ::: "memory")
#define WAIT_L(n) asm volatile("s_waitcnt lgkmcnt(" #n ")" ::: "memory")
#define BAR __builtin_amdgcn_s_barrier()
#define SCHED __builtin_amdgcn_sched_barrier(0)
  for (int it = 0;; ++it) {
    const int L = it * G + (int)blockIdx.x;
    if (L >= nwg) break;
    int wgid;
    { const int q = nwg / 8, r = nwg % 8, xcd = L % 8, off = L / 8; wgid = (xcd < r ? xcd * (q + 1) : r * (q + 1) + (xcd - r) * q) + off; }
    const int nig = 8 * nN, gid = wgid / nig, fm = gid * 8, gsz = (nM - fm) < 8 ? (nM - fm) : 8;
    const int pm = fm + ((wgid % nig) % gsz), pn = (wgid % nig) / gsz;
    const half_t* Ag; const half_t* Bg; size_t lda; int a_ks;
    src.get(pm, pn, Ag, Bg, lda, a_ks);
    const unsigned aob0 = (unsigned)(((size_t)sr0 * lda + sc0) * 2), aob1 = (unsigned)(((size_t)sr1 * lda + sc1) * 2);
    const int pr0 = 64 * (sr0 >> 5) + 8 * ((sr0 & 15) >> 2) + 4 * ((sr0 >> 4) & 1) + (sr0 & 3), pr1 = 64 * (sr1 >> 5) + 8 * ((sr1 & 15) >> 2) + 4 * ((sr1 >> 4) & 1) + (sr1 & 3);
    const unsigned bob0 = (unsigned)((pr0 * K + sc0) * 2), bob1 = (unsigned)((pr1 * K + sc1) * 2);
    Acc acc;
#pragma unroll
    for (int a = 0; a < 2; ++a)
#pragma unroll
      for (int b = 0; b < 2; ++b)
#pragma unroll
        for (int m = 0; m < 4; ++m)
#pragma unroll
          for (int n = 0; n < 2; ++n) acc[a][b][m][n] = (f32x4){0.f, 0.f, 0.f, 0.f};
    half8 At[4][2], B0[2][2], B1[2][2];
    STAGE_B(SB8(0, 0), 0, 0) STAGE_A(SA8(0, 0), 0, 0)
    STAGE_B(SB8(0, 1), 1, 0) STAGE_A(SA8(0, 1), 1, 0)
    if (wr == 1) BAR;
    WAIT_V(4); BAR;
    STAGE_B(SB8(1, 0), 0, 1) STAGE_A(SA8(1, 0), 0, 1) STAGE_B(SB8(1, 1), 1, 1)
    WAIT_V(6); BAR;
#pragma unroll 1
    for (int t = 0; t < nt - 2; t += 2) {
      LDB8(B0, 0, 0) SCHED; LDA8(At, 0, 0) STAGE_A(SA8(1, 1), 1, t + 1)
      WAIT_L(8); BAR; WAIT_L(0); MMA8(0, 0, At, B0) BAR; SCHED;
      LDB8(B1, 0, 1) STAGE_B(SB8(0, 0), 0, t + 2)
      BAR; WAIT_L(0); MMA8(0, 1, At, B1) BAR;
      LDA8(At, 0, 1) STAGE_A(SA8(0, 0), 0, t + 2)
      BAR; WAIT_L(0); MMA8(1, 0, At, B0) BAR; SCHED;
      STAGE_B(SB8(0, 1), 1, t + 2)
      WAIT_V(6); BAR; MMA8(1, 1, At, B1) BAR;
      LDB8(B0, 1, 0) SCHED; LDA8(At, 1, 0) STAGE_A(SA8(0, 1), 1, t + 2)
      WAIT_L(8); BAR; WAIT_L(0); MMA8(0, 0, At, B0) BAR; SCHED;
      LDB8(B1, 1, 1) STAGE_B(SB8(1, 0), 0, t + 3)
      BAR; WAIT_L(0); MMA8(0, 1, At, B1) BAR;
      LDA8(At, 1, 1) STAGE_A(SA8(1, 0), 0, t + 3)
      BAR; WAIT_L(0); MMA8(1, 0, At, B0) BAR; SCHED;
      STAGE_B(SB8(1, 1), 1, t + 3)
      WAIT_V(6); BAR; MMA8(1, 1, At, B1) BAR;
    }
    { LDB8(B0, 0, 0) LDA8(At, 0, 0) STAGE_A(SA8(1, 1), 1, nt - 1)
      BAR; WAIT_L(0); MMA8(0, 0, At, B0) BAR;
      LDB8(B1, 0, 1) BAR; WAIT_L(0); MMA8(0, 1, At, B1) BAR;
      LDA8(At, 0, 1) WAIT_V(4); BAR; WAIT_L(0); MMA8(1, 0, At, B0) MMA8(1, 1, At, B1) BAR; }
    { LDB8(B0, 1, 0) LDA8(At, 1, 0) WAIT_V(2); BAR; WAIT_L(0); MMA8(0, 0, At, B0) BAR;
      LDB8(B1, 1, 1) WAIT_V(0); BAR; WAIT_L(0); MMA8(0, 1, At, B1) BAR;
      LDA8(At, 1, 1) BAR; WAIT_L(0); MMA8(1, 0, At, B0) MMA8(1, 1, At, B1) BAR; }
    if (wr == 0) BAR;
    { int fr2 = fr, fq2 = fq; asm volatile("" : "+v"(fr2), "+v"(fq2)); epi(acc, pm * 256, pn * 256, wr, wc, fr2, fq2); }
  }
#undef SA8
#undef SB8
#undef STAGE_A
#undef STAGE_B
#undef LDA8
#undef LDB8
#undef MMA8
#undef WAIT_V
#undef WAIT_L
#undef BAR
#undef SCHED
}
}

struct GlaPrepOps { half8 q0, k0, q1, k1; float w[16]; float bb; };
__device__ void ph_gla_prep(const Params& P, float* sm, int wvs) {
  float(*glr)[16] = (float(*)[16])sm;
  float(*tot)[128] = (float(*)[128])(sm + 1024);
  float(*exl)[132] = (float(*)[132])(sm + 1536);
  const int tid = otid(wvs);
  const int tq = tid >> 7, c = tid & 127;
  const int tp = tid >> 4, co = tid & 15;
  const float scale = 0.08838834764831845f;
  const int nchunks = T_TOK / 64, G = gridDim.x;
  const int nj = (((nchunks - 1 - (int)blockIdx.x) / G) + 1) * 4;
  GlaPrepOps nxt; f32x4 gnx = {};
#define GLA_PREP_LOAD(j_) { const int chunk_ = (int)blockIdx.x + ((j_) >> 2) * G, h_ = (j_) & 3, ch_ = h_ * 128 + c; \
    const half_t* qp_ = P.p + (size_t)(chunk_ * 64 + 2 * tp) * LD0 + h_ * 128 + co * 8; \
    nxt.q0 = *(const half8*)(qp_); nxt.k0 = *(const half8*)(qp_ + 512); nxt.q1 = *(const half8*)(qp_ + LD0); nxt.k1 = *(const half8*)(qp_ + LD0 + 512); \
    _Pragma("unroll") for (int r = 0; r < 16; ++r) nxt.w[r] = P.gla_w_gk_up[r * 512 + ch_]; \
    nxt.bb = P.gla_b_gk[ch_]; \
    if (h_ == 0 && tid < 256) gnx = *(const f32x4*)(P.glr + (size_t)(chunk_ * 64) * 16 + tid * 4); }
  GLA_PREP_LOAD(0)
#pragma unroll 1
  for (int j = 0; j < nj; ++j) {
    const int chunk = (int)blockIdx.x + (j >> 2) * G, h = j & 3;
    const int t0 = chunk * 64, ch = h * 128 + c;
    const GlaPrepOps cur = nxt;
    __syncthreads();
    if (h == 0 && tid < 256) *(f32x4*)(sm + tid * 4) = gnx;
    if (j + 1 < nj) GLA_PREP_LOAD(j + 1)
    __syncthreads();
    float pre[16]; float cum = 0.f;
#pragma unroll
    for (int i = 0; i < 16; ++i) {
      float u = cur.bb;
#pragma unroll
      for (int r = 0; r < 16; ++r) u += glr[tq * 16 + i][r] * cur.w[r];
      cum += logsigmoidf(u) * (1.f / 16.f);
      pre[i] = cum;
    }
    tot[tq][c] = cum;
    __syncthreads();
    float off = 0.f;
#pragma unroll
    for (int t = 0; t < 3; ++t) if (t < tq) off += tot[t][c];
#pragma unroll
    for (int i = 0; i < 16; ++i) {
      const float ex = fast_exp2((pre[i] + off) * LOG2E);
      exl[tq * 16 + i][c] = ex;
      if (tq == 3 && i == 15) P.bcum[(size_t)chunk * 512 + ch] = ex;
    }
    __syncthreads();
    {
      half_t* qp = P.p + (size_t)(t0 + 2 * tp) * LD0 + h * 128 + co * 8;
      const f32x4 e00 = *(const f32x4*)&exl[2 * tp][co * 8], e01 = *(const f32x4*)&exl[2 * tp][co * 8 + 4];
      const f32x4 e10 = *(const f32x4*)&exl[2 * tp + 1][co * 8], e11 = *(const f32x4*)&exl[2 * tp + 1][co * 8 + 4];
      half8 oq0, ok0, oq1, ok1;
#pragma unroll
      for (int e = 0; e < 8; ++e) {
        const float x0 = e < 4 ? e00[e] : e01[e - 4], x1 = e < 4 ? e10[e] : e11[e - 4];
        oq0[e] = (half_t)((float)cur.q0[e] * scale * x0); ok0[e] = (half_t)((float)cur.k0[e] * __builtin_amdgcn_rcpf(x0));
        oq1[e] = (half_t)((float)cur.q1[e] * scale * x1); ok1[e] = (half_t)((float)cur.k1[e] * __builtin_amdgcn_rcpf(x1));
      }
      *(half8*)(qp) = oq0; *(half8*)(qp + 512) = ok0; *(half8*)(qp + LD0) = oq1; *(half8*)(qp + LD0 + 512) = ok1;
    }
  }
#undef GLA_PREP_LOAD
}

constexpr int GLA_QE = 0, GLA_KE = 16384, GLA_V = 32768, GLA_DEC = 49152, GLA_BUF = 53248;
#define GLA_TR4(d0, d1, d2, d3, addr, o0, o1, o2, o3) \
  asm volatile("ds_read_b64_tr_b16 %0, %4 offset:%5\n\tds_read_b64_tr_b16 %1, %4 offset:%6\n\tds_read_b64_tr_b16 %2, %4 offset:%7\n\tds_read_b64_tr_b16 %3, %4 offset:%8" \
               : "=&v"(d0), "=&v"(d1), "=&v"(d2), "=&v"(d3) : "v"(addr), "n"(o0), "n"(o1), "n"(o2), "n"(o3) : "memory")
__device__ __forceinline__ half8 pack_h8(const v2i a, const v2i b) { const v4i p = (v4i){a[0], a[1], b[0], b[1]}; return __builtin_bit_cast(half8, p); }

template <bool STATE_ONLY>
__device__ void ph_gla_mfma(const Params& P, char* smem, int wvs) {
  const int tid = otid(wvs);
  const int lane = tid & 63, wave = __builtin_amdgcn_readfirstlane(tid >> 6), r15 = lane & 15, q = lane >> 4;
  const int qp = r15 >> 2, pp = lane & 3;
  const int srow = tid >> 4, sslot = tid & 15;
  const int src_q = (sslot ^ (srow & 15)) * 8, src_kv = (sslot ^ ((srow & 7) << 1)) * 8;
  const int fk = ((4 * (q & 1) + qp) & 7) << 1;
  const unsigned tr_row = (unsigned)((4 * q + qp) * 256 + 8 * (pp & 1) + ((pp >> 1) << 4));
  constexpr int NLOAD = STATE_ONLY ? 5 : 7;
  for (int item = blockIdx.x; item < (STATE_ONLY ? 3 : 4) * 64; item += gridDim.x) {
    const int seg = item >> 6, base = item & 63, b = base >> 3, h = (base >> 1) & 3, vs = base & 1;
    const int c0 = seg * 16;
    f32x4 S[8], Dacc[8];
#pragma unroll
    for (int df = 0; df < 8; ++df) { S[df] = (f32x4){0.f, 0.f, 0.f, 0.f}; Dacc[df] = (f32x4){1.f, 1.f, 1.f, 1.f}; }
    f32x4* stL = (f32x4*)P.gla_state + ((size_t)base * 8 + wave) * 8 * 64 + lane;
    f32x4* stD = stL + (size_t)3 * 64 * 8 * 8 * 64;
    if (!STATE_ONLY) {
      for (int k = 0; k < seg; ++k) {
#pragma unroll
        for (int df = 0; df < 8; ++df) {
          const f32x4 Lk = stL[((size_t)k * 64 * 8 * 8 + df) * 64];
          if (k == 0) S[df] = Lk;
          else { const f32x4 Dk = stD[((size_t)k * 64 * 8 * 8 + df) * 64]; S[df] = Dk * S[df] + Lk; }
        }
      }
    }
    const half_t* qsrc = P.p + (size_t)(b * SEQ + srow) * LD0 + h * 128;
    const half_t* vsrc = P.p + (size_t)(b * SEQ + srow) * LD0 + 1024 + h * 256 + vs * 128 + src_kv;
    const float* dsrc = P.bcum + (size_t)(b * 64 + c0) * 512 + h * 128 + (lane & 31) * 4;
#define G_ISSUE(N, BUF) { char* lb_ = smem + (BUF) * GLA_BUF + wave * 1024; const size_t ro_ = (size_t)(c0 + (N)) * 64 * LD0; \
      if (!STATE_ONLY) { __builtin_amdgcn_global_load_lds((gbl_void*)(qsrc + ro_ + src_q), (lds_void*)(lb_ + GLA_QE), 16, 0, 0); \
      __builtin_amdgcn_global_load_lds((gbl_void*)(qsrc + ro_ + (size_t)32 * LD0 + src_q), (lds_void*)(lb_ + GLA_QE + 8192), 16, 0, 0); } \
      __builtin_amdgcn_global_load_lds((gbl_void*)(qsrc + ro_ + 512 + src_kv), (lds_void*)(lb_ + GLA_KE), 16, 0, 0); \
      __builtin_amdgcn_global_load_lds((gbl_void*)(qsrc + ro_ + (size_t)32 * LD0 + 512 + src_kv), (lds_void*)(lb_ + GLA_KE + 8192), 16, 0, 0); \
      __builtin_amdgcn_global_load_lds((gbl_void*)(vsrc + ro_), (lds_void*)(lb_ + GLA_V), 16, 0, 0); \
      __builtin_amdgcn_global_load_lds((gbl_void*)(vsrc + ro_ + (size_t)32 * LD0), (lds_void*)(lb_ + GLA_V + 8192), 16, 0, 0); \
      if (lane < 32) __builtin_amdgcn_global_load_lds((gbl_void*)(dsrc + (size_t)(N) * 512), (lds_void*)(smem + (BUF) * GLA_BUF + GLA_DEC + wave * 512), 16, 0, 0); }
    G_ISSUE(0, 0)
    G_ISSUE(1, 1)
#pragma unroll 1
    for (int n = 0; n < 16; ++n) {
      if (n + 1 < 16) wait_vmcnt<NLOAD>(); else wait_vmcnt<0>();
      __builtin_amdgcn_s_barrier();
      if (n + 2 < 16) G_ISSUE(n + 2, (n + 2) % 3)
      const char* cb = smem + (n % 3) * GLA_BUF;
      f32x4 aT[4][4];
      if (!STATE_ONLY) {
#pragma unroll
      for (int kf = 0; kf < 4; ++kf)
#pragma unroll
        for (int tf = 0; tf < 4; ++tf) aT[kf][tf] = (f32x4){0.f, 0.f, 0.f, 0.f};
#pragma unroll
      for (int ks = 0; ks < 4; ++ks) {
        half8 kef[4], qef[4];
#pragma unroll
        for (int f = 0; f < 4; ++f) {
          kef[f] = *(const half8*)(cb + GLA_KE + (16 * f + r15) * 256 + (((4 * ks + q) ^ ((r15 & 7) << 1)) << 4));
          qef[f] = *(const half8*)(cb + GLA_QE + (16 * f + r15) * 256 + (((4 * ks + q) ^ r15) << 4));
        }
#pragma unroll
        for (int kf = 0; kf < 4; ++kf)
#pragma unroll
          for (int tf = kf; tf < 4; ++tf) aT[kf][tf] = __builtin_amdgcn_mfma_f32_16x16x32_f16(kef[kf], qef[tf], aT[kf][tf], 0, 0, 0);
      }
#pragma unroll
      for (int f = 0; f < 4; ++f)
#pragma unroll
        for (int r = 0; r < 4; ++r) if (4 * q + r > r15) aT[f][f][r] = 0.f;
      }
      const unsigned lds0 = (unsigned)(size_t)cb;
      const unsigned va = lds0 + GLA_V + tr_row + ((((2 * wave) ^ fk)) << 4);
      v2i v00, v01, v10, v11;
      GLA_TR4(v00, v01, v10, v11, va, 0, 4096, 8192, 12288);
      const unsigned ka = lds0 + GLA_KE + tr_row;
      v2i k0[4][4];
#pragma unroll
      for (int df = 0; df < 4; ++df) { const unsigned a_ = ka + ((((2 * df) ^ fk)) << 4); GLA_TR4(k0[df][0], k0[df][1], k0[df][2], k0[df][3], a_, 0, 4096, 8192, 12288); }
      asm volatile("s_waitcnt lgkmcnt(15)" : "+v"(v00), "+v"(v01), "+v"(v10), "+v"(v11) :: "memory");
      __builtin_amdgcn_sched_barrier(0);
      half8 vf[2];
      vf[0] = pack_h8(v00, v01); vf[1] = pack_h8(v10, v11);
      if (!STATE_ONLY) {
      f32x4 o[4];
#pragma unroll
      for (int tf = 0; tf < 4; ++tf) o[tf] = (f32x4){0.f, 0.f, 0.f, 0.f};
#pragma unroll
      for (int ks2 = 0; ks2 < 2; ++ks2)
#pragma unroll
        for (int tf = 2 * ks2; tf < 4; ++tf) {
          half8 pk;
#pragma unroll
          for (int r = 0; r < 4; ++r) { pk[r] = (half_t)aT[2 * ks2][tf][r]; pk[4 + r] = (half_t)aT[2 * ks2 + 1][tf][r]; }
          o[tf] = __builtin_amdgcn_mfma_f32_16x16x32_f16(vf[ks2], pk, o[tf], 0, 0, 0);
        }
#pragma unroll
      for (int ks = 0; ks < 4; ++ks) {
        half8 sf;
#pragma unroll
        for (int r = 0; r < 4; ++r) { sf[r] = (half_t)S[2 * ks][r]; sf[4 + r] = (half_t)S[2 * ks + 1][r]; }
#pragma unroll
        for (int tf = 0; tf < 4; ++tf) {
          const int row = 16 * tf + r15;
          const half4 qa = *(const half4*)(cb + GLA_QE + row * 256 + (((4 * ks + (q >> 1)) ^ r15) << 4) + (q & 1) * 8);
          const half4 qb = *(const half4*)(cb + GLA_QE + row * 256 + (((4 * ks + 2 + (q >> 1)) ^ r15) << 4) + (q & 1) * 8);
          half8 qv;
#pragma unroll
          for (int e = 0; e < 4; ++e) { qv[e] = qa[e]; qv[4 + e] = qb[e]; }
          o[tf] = __builtin_amdgcn_mfma_f32_16x16x32_f16(sf, qv, o[tf], 0, 0, 0);
        }
      }
      {
        const size_t t0 = (size_t)(b * SEQ + (c0 + n) * 64);
#pragma unroll
        for (int tf = 0; tf < 4; ++tf) {
          half4 hv; hv[0] = (half_t)o[tf][0]; hv[1] = (half_t)o[tf][1]; hv[2] = (half_t)o[tf][2]; hv[3] = (half_t)o[tf][3];
          *(half4*)(P.og + (t0 + 16 * tf + r15) * DM + h * 256 + vs * 128 + 16 * wave + 4 * q) = hv;
        }
      }
      }
      v2i k1[4][4];
#pragma unroll
      for (int df = 0; df < 4; ++df) { const unsigned a_ = ka + ((((2 * (df + 4)) ^ fk)) << 4); GLA_TR4(k1[df][0], k1[df][1], k1[df][2], k1[df][3], a_, 0, 4096, 8192, 12288); }
      asm volatile("s_waitcnt lgkmcnt(15)"
                   : "+v"(k0[0][0]), "+v"(k0[0][1]), "+v"(k0[0][2]), "+v"(k0[0][3]), "+v"(k0[1][0]), "+v"(k0[1][1]), "+v"(k0[1][2]), "+v"(k0[1][3]),
                     "+v"(k0[2][0]), "+v"(k0[2][1]), "+v"(k0[2][2]), "+v"(k0[2][3]), "+v"(k0[3][0]), "+v"(k0[3][1]), "+v"(k0[3][2]), "+v"(k0[3][3]) :: "memory");
      __builtin_amdgcn_sched_barrier(0);
#pragma unroll
      for (int df = 0; df < 4; ++df) {
        S[df] = __builtin_amdgcn_mfma_f32_16x16x32_f16(pack_h8(k0[df][0], k0[df][1]), vf[0], S[df], 0, 0, 0);
        S[df] = __builtin_amdgcn_mfma_f32_16x16x32_f16(pack_h8(k0[df][2], k0[df][3]), vf[1], S[df], 0, 0, 0);
      }
      asm volatile("s_waitcnt lgkmcnt(0)"
                   : "+v"(k1[0][0]), "+v"(k1[0][1]), "+v"(k1[0][2]), "+v"(k1[0][3]), "+v"(k1[1][0]), "+v"(k1[1][1]), "+v"(k1[1][2]), "+v"(k1[1][3]),
                     "+v"(k1[2][0]), "+v"(k1[2][1]), "+v"(k1[2][2]), "+v"(k1[2][3]), "+v"(k1[3][0]), "+v"(k1[3][1]), "+v"(k1[3][2]), "+v"(k1[3][3]) :: "memory");
      __builtin_amdgcn_sched_barrier(0);
#pragma unroll
      for (int df = 0; df < 4; ++df) {
        S[df + 4] = __builtin_amdgcn_mfma_f32_16x16x32_f16(pack_h8(k1[df][0], k1[df][1]), vf[0], S[df + 4], 0, 0, 0);
        S[df + 4] = __builtin_amdgcn_mfma_f32_16x16x32_f16(pack_h8(k1[df][2], k1[df][3]), vf[1], S[df + 4], 0, 0, 0);
      }
#pragma unroll
      for (int df = 0; df < 8; ++df) {
        const f32x4 dc = *(const f32x4*)(cb + GLA_DEC + wave * 512 + (16 * df + 4 * q) * 4);
        S[df] *= dc;
        if (STATE_ONLY) Dacc[df] *= dc;
      }
    }
    if (STATE_ONLY) {
#pragma unroll
      for (int df = 0; df < 8; ++df) { stL[((size_t)seg * 64 * 8 * 8 + df) * 64] = S[df]; stD[((size_t)seg * 64 * 8 * 8 + df) * 64] = Dacc[df]; }
    }
    asm volatile("s_waitcnt vmcnt(0)" ::: "memory");
    __builtin_amdgcn_s_barrier();
#undef G_ISSUE
  }
}

__device__ void ph_gla_post(const Params& P, int wvs) {
  const int tid_ = otid(wvs); const int lane = tid_ & 63, sub = lane & 31;
  const int u0 = blockIdx.x * 16 + (tid_ >> 5);
  const float4 hn0 = ((const float4*)P.gla_head_norm)[sub * 2], hn1 = ((const float4*)P.gla_head_norm)[sub * 2 + 1];
  constexpr int UW = 4;
  const int ustride = gridDim.x * 16;
#pragma unroll 1
  for (int ub = u0; ub < T_TOK * 4; ub += ustride * UW) {
    half8 hv[UW], z[UW];
#pragma unroll
    for (int r = 0; r < UW; ++r) {
      const int u = ub + r * ustride, t = u >> 2, h = u & 3;
      hv[r] = *((const half8*)(P.og + (size_t)t * DM + h * 256) + sub);
      z[r] = *((const half8*)(P.p + (size_t)t * LD0 + 2048 + h * 256) + sub);
    }
#pragma unroll
    for (int r = 0; r < UW; ++r) {
      const int u = ub + r * ustride, t = u >> 2, h = u & 3;
      float v[8]; float ss = 0.f;
#pragma unroll
      for (int e = 0; e < 8; ++e) { v[e] = (float)hv[r][e]; ss += v[e] * v[e]; }
#pragma unroll
      for (int o = 16; o > 0; o >>= 1) ss += __shfl_xor(ss, o);
      const float rr = rsqrtf(ss * (1.f / 256.f) + EPS);
      const float hn[8] = {hn0.x, hn0.y, hn0.z, hn0.w, hn1.x, hn1.y, hn1.z, hn1.w};
      half8 o;
#pragma unroll
      for (int e = 0; e < 8; ++e) o[e] = (half_t)(v[e] * rr * hn[e] * siluf((float)z[r][e]));
      *((half8*)(P.og + (size_t)t * DM + h * 256) + sub) = o;
    }
  }
}

template <bool FINAL>
__device__ void ph_post(const half_t* baseh, const half_t* y, const float* g, float* dst, half_t* dsth, float* rstd_out, int wvs) {
  const int tid_ = otid(wvs); const int lane = tid_ & 63, w = tid_ >> 6;
  constexpr int RW = 4;
  const int rstride = gridDim.x * NWAVES;
#pragma unroll 1
  for (int row0 = blockIdx.x * NWAVES + w; row0 < T_TOK; row0 += rstride * RW) {
    half4 yv[RW][4], bv[RW][4];
#pragma unroll
    for (int r = 0; r < RW; ++r)
#pragma unroll
      for (int i = 0; i < 4; ++i) yv[r][i] = ((const half4*)(y + (size_t)(row0 + r * rstride) * DM))[lane + 64 * i];
#pragma unroll
    for (int r = 0; r < RW; ++r)
#pragma unroll
      for (int i = 0; i < 4; ++i) bv[r][i] = ((const half4*)(baseh + (size_t)(row0 + r * rstride) * DM))[lane + 64 * i];
#pragma unroll
    for (int r = 0; r < RW; ++r) {
      const int row = row0 + r * rstride;
      float ss = 0.f;
#pragma unroll
      for (int i = 0; i < 4; ++i)
#pragma unroll
        for (int e = 0; e < 4; ++e) { const float t = (float)yv[r][i][e]; ss += t * t; }
      ss = wave_sum(ss);
      const float rr = rsqrtf(ss * (1.f / DM) + EPS);
      float s2 = 0.f;
#pragma unroll
      for (int i = 0; i < 4; ++i) {
        const float4 gg = ((const float4*)g)[lane + 64 * i];
        float4 o;
        o.x = (float)bv[r][i][0] + (float)yv[r][i][0] * rr * gg.x; o.y = (float)bv[r][i][1] + (float)yv[r][i][1] * rr * gg.y;
        o.z = (float)bv[r][i][2] + (float)yv[r][i][2] * rr * gg.z; o.w = (float)bv[r][i][3] + (float)yv[r][i][3] * rr * gg.w;
        if (FINAL) ((float4*)(dst + (size_t)row * DM))[lane + 64 * i] = o;
        else {
          s2 += o.x * o.x + o.y * o.y + o.z * o.z + o.w * o.w;
          half4 hv; hv[0] = (half_t)o.x; hv[1] = (half_t)o.y; hv[2] = (half_t)o.z; hv[3] = (half_t)o.w;
          ((half4*)(dsth + (size_t)row * DM))[lane + 64 * i] = hv;
        }
      }
      if (!FINAL) { s2 = wave_sum(s2); if (lane == 0) rstd_out[row] = rsqrtf(s2 * (1.f / DM) + EPS); }
    }
  }
}

template <int NF>
__device__ void ph_rowproj(const Params& P, const half_t* Wt, float* out, char* smem, int wvs, int first_block) {
  const int tid = otid(wvs), lane = tid & 63, wave = tid >> 6, r15 = lane & 15, q = lane >> 4;
  const int nb = gridDim.x - first_block;
  if ((int)blockIdx.x < first_block) return;
  __syncthreads();
  for (int c = tid; c < 16 * NF * 128; c += NTHREADS) {
    const int row = c >> 7, ch = c & 127;
    *(uint4*)(smem + row * 2064 + ch * 16) = *(const uint4*)(Wt + (size_t)row * DM + ch * 8);
  }
  __syncthreads();
  for (int tile = (int)blockIdx.x - first_block; tile < T_TOK / 128; tile += nb) {
    const int tok = tile * 128 + wave * 16 + r15;
    const half_t* ap = P.xh + (size_t)tok * DM + 8 * q;
    const char* bp = smem + r15 * 2064 + 16 * q;
    f32x4 acc[NF];
#pragma unroll
    for (int n = 0; n < NF; ++n) acc[n] = (f32x4){0.f, 0.f, 0.f, 0.f};
#pragma unroll 1
    for (int s0 = 0; s0 < 32; s0 += 16) {
      half8 a[16];
#pragma unroll
      for (int i = 0; i < 16; ++i) a[i] = *(const half8*)(ap + 32 * (s0 + i));
#pragma unroll
      for (int i = 0; i < 16; ++i) {
#pragma unroll
        for (int n = 0; n < NF; ++n) {
          const half8 bw = *(const half8*)(bp + n * 16 * 2064 + (s0 + i) * 64);
          acc[n] = __builtin_amdgcn_mfma_f32_16x16x32_f16(bw, a[i], acc[n], 0, 0, 0);
        }
      }
    }
    const float rs = P.rstd[tok];
#pragma unroll
    for (int n = 0; n < NF; ++n) *(f32x4*)(out + (size_t)tok * (16 * NF) + 16 * n + 4 * q) = acc[n] * rs;
  }
  __syncthreads();
}

__device__ void ph_kmax(const Params& P, int wvs, int first_block) {
  const int tid = otid(wvs);
  for (int task = (int)blockIdx.x - first_block; task < NBATCH * 4 * 2 * 8; task += gridDim.x - first_block) {
    const int chunk = task & 7, br = (task >> 3) & 1, bg = task >> 4, b = bg >> 2, g = bg & 3;
    const half_t* kp = P.p + (size_t)(b * SEQ + chunk * 512 + tid) * LD1 + (br ? 2048 : 1536) + g * 64;
    float ss = 0.f;
#pragma unroll
    for (int c = 0; c < 8; ++c) {
      const half8 v = *(const half8*)(kp + c * 8);
#pragma unroll
      for (int e = 0; e < 8; ++e) ss += (float)v[e] * (float)v[e];
    }
    ss = wave_max(ss);
    if ((tid & 63) == 0) __hip_atomic_fetch_max(&P.kmax2[bg * 2 + br], __float_as_uint(ss), __ATOMIC_RELAXED, __HIP_MEMORY_SCOPE_AGENT);
  }
}

constexpr int ATT_NB = 6, ATT_D = 5;
constexpr int ATT_K = 0, ATT_V = ATT_NB * 8192, ATT_Z = 2 * ATT_NB * 8192, ATT_IMP = ATT_Z + 32768, ATT_SELM = ATT_IMP + 64 * 68 * 4;
constexpr int IMPS = 68;
constexpr int ATT_GATE = ATT_SELM + 512;

__device__ __forceinline__ void attn_issue(char* smem, const half_t* kbase, const half_t* vbase, int ld, int tile_lo, int tile_hi, int wvs, int rot = 0) {
  const int tid = otid(wvs);
  const int lrow = tid >> 3, lch = tid & 7;
  const int ksrc = (lch ^ ((lrow >> 1) & 7)) * 8, vsrc = (lch ^ (((lrow >> 1) & 3) << 1)) * 8;
  const int wbase = __builtin_amdgcn_readfirstlane(tid >> 6) * 1024;
#pragma unroll
  for (int i = 0; i < ATT_D; ++i) if (tile_lo + i <= tile_hi) {
    const int nt_ = tile_hi - tile_lo + 1, tr_ = tile_lo + ((rot + i >= nt_) ? rot + i - nt_ : rot + i);
    const half_t* kp_ = kbase + (size_t)(tr_ * 64 + lrow) * ld + ksrc;
    const half_t* vp_ = vbase + (size_t)(tr_ * 64 + lrow) * ld + vsrc;
    __builtin_amdgcn_global_load_lds((gbl_void*)kp_, (lds_void*)(smem + ATT_K + i * 8192 + wbase), 16, 0, 0);
    __builtin_amdgcn_global_load_lds((gbl_void*)vp_, (lds_void*)(smem + ATT_V + i * 8192 + wbase), 16, 0, 0);
  }
}

template <int MODE, bool PREISSUED = false>
__device__ __forceinline__ void attn_branch(char* smem, const half_t* kbase, const half_t* vbase, int ld, int tile_lo, int tile_hi, int n, int th,
                                            const half8 (&qf)[2][2], float (&m)[2], float (&l)[2], f32x4 (&o)[4][2],
                                            const unsigned long long (&selm)[2], int wvs) {
  const int tid = otid(wvs);
  const int lane = tid & 63, r15 = lane & 15, q = lane >> 4;
  const int lrow = tid >> 3, lch = tid & 7;
  const int k_rd = r15 * 128, kswz = r15 >> 1;
  const int qp = r15 >> 2, pp = lane & 3;
  const int fx = ((2 * q + (qp >> 1)) & 3) << 1;
  const int v_rd = (4 * q + qp) * 128 + 8 * (pp & 1) + ((pp >> 1) << 4);
  unsigned int* impu = (unsigned int*)(smem + ATT_IMP);
  const int ksrc = (lch ^ ((lrow >> 1) & 7)) * 8, vsrc = (lch ^ (((lrow >> 1) & 3) << 1)) * 8;
  const int wbase = __builtin_amdgcn_readfirstlane(tid >> 6) * 1024;
#define A_GLOAD(TI, BUF) { const half_t* kp_ = kbase + (size_t)((TI) * 64 + lrow) * ld + ksrc; \
    __builtin_amdgcn_global_load_lds((gbl_void*)kp_, (lds_void*)(smem + ATT_K + (BUF) * 8192 + wbase), 16, 0, 0); \
    { const half_t* vp_ = vbase + (size_t)((TI) * 64 + lrow) * ld + vsrc; \
      __builtin_amdgcn_global_load_lds((gbl_void*)vp_, (lds_void*)(smem + ATT_V + (BUF) * 8192 + wbase), 16, 0, 0); } }
  constexpr int GPT = 2;
  f32x4 lacc[2] = {(f32x4){0.f, 0.f, 0.f, 0.f}, (f32x4){0.f, 0.f, 0.f, 0.f}};
  if (MODE != 1 && !PREISSUED) {
#pragma unroll
    for (int i = 0; i < ATT_D; ++i) if (tile_lo + i <= tile_hi) A_GLOAD(tile_lo + i, i)
  }
#pragma unroll 1
  for (int ti = tile_lo; ti <= tile_hi; ++ti) {
    const int it = ti - tile_lo, cur = it % ATT_NB;
    if (MODE != 1) {
      const int rem = tile_hi - ti;
      if (rem >= 4) wait_vmcnt<4 * GPT>(); else if (rem == 3) wait_vmcnt<3 * GPT>(); else if (rem == 2) wait_vmcnt<2 * GPT>();
      else if (rem == 1) wait_vmcnt<1 * GPT>(); else wait_vmcnt<0>();
    }
    __builtin_amdgcn_s_barrier();
    if (MODE != 1) { if (ti + ATT_D <= tile_hi) A_GLOAD(ti + ATT_D, (it + ATT_D) % ATT_NB) }
    const char* kb = smem + ATT_K + cur * 8192 + k_rd;
    const unsigned vbl = (unsigned)(size_t)(smem + ATT_V + cur * 8192 + v_rd);
    bool need_mask;
    if (MODE <= 1) need_mask = (ti * 64 + 63 > 4 * n - 2);
    else if (MODE == 2) need_mask = (ti == n);
    else need_mask = (ti == n) || (ti == n - 8);
    f32x4 s[4][2];
#pragma unroll
    for (int t2 = 0; t2 < 2; ++t2) {
      float c0 = 0.f;
      if (MODE >= 2) { c0 = -m[t2]; if (MODE == 2 && !((selm[t2] >> ti) & 1ull)) c0 = -INFINITY; }
#pragma unroll
      for (int kf = 0; kf < 4; ++kf) s[kf][t2] = (f32x4){c0, c0, c0, c0};
    }
#pragma unroll
    for (int ks = 0; ks < 2; ++ks) {
      const int co = ((4 * ks + q) ^ kswz) << 4;
#pragma unroll
      for (int kf = 0; kf < 4; ++kf) {
        const half8 kfr = *(const half8*)(kb + kf * 2048 + co);
#pragma unroll
        for (int t2 = 0; t2 < 2; ++t2) s[kf][t2] = __builtin_amdgcn_mfma_f32_16x16x32_f16(kfr, qf[t2][ks], s[kf][t2], 0, 0, 0);
      }
    }
    v2i vr[4][4];
    if (MODE != 0) {
      const unsigned va0 = vbl + (((0) ^ fx) << 4), va1 = vbl + (((2) ^ fx) << 4), va2 = vbl + (((4) ^ fx) << 4), va3 = vbl + (((6) ^ fx) << 4);
      asm volatile(
          "ds_read_b64_tr_b16 %0, %16\n\tds_read_b64_tr_b16 %1, %16 offset:2048\n\tds_read_b64_tr_b16 %2, %16 offset:4096\n\tds_read_b64_tr_b16 %3, %16 offset:6144\n\t"
          "ds_read_b64_tr_b16 %4, %17\n\tds_read_b64_tr_b16 %5, %17 offset:2048\n\tds_read_b64_tr_b16 %6, %17 offset:4096\n\tds_read_b64_tr_b16 %7, %17 offset:6144\n\t"
          "ds_read_b64_tr_b16 %8, %18\n\tds_read_b64_tr_b16 %9, %18 offset:2048\n\tds_read_b64_tr_b16 %10, %18 offset:4096\n\tds_read_b64_tr_b16 %11, %18 offset:6144\n\t"
          "ds_read_b64_tr_b16 %12, %19\n\tds_read_b64_tr_b16 %13, %19 offset:2048\n\tds_read_b64_tr_b16 %14, %19 offset:4096\n\tds_read_b64_tr_b16 %15, %19 offset:6144"
          : "=&v"(vr[0][0]), "=&v"(vr[0][1]), "=&v"(vr[0][2]), "=&v"(vr[0][3]), "=&v"(vr[1][0]), "=&v"(vr[1][1]), "=&v"(vr[1][2]), "=&v"(vr[1][3]),
            "=&v"(vr[2][0]), "=&v"(vr[2][1]), "=&v"(vr[2][2]), "=&v"(vr[2][3]), "=&v"(vr[3][0]), "=&v"(vr[3][1]), "=&v"(vr[3][2]), "=&v"(vr[3][3])
          : "v"(va0), "v"(va1), "v"(va2), "v"(va3)
          : "memory");
    }
    if (need_mask) {
#pragma unroll
      for (int t2 = 0; t2 < 2; ++t2) {
        const int tok = th * 32 + t2 * 16 + r15;
        int lo = 0, hi = 63;
        if (MODE <= 1) { hi = 4 * n + ((tok - 31) >> 4) - ti * 64; }
        else if (MODE == 2) { hi = tok; }
        else { if (ti == n) hi = tok; else lo = tok + 1; }
#pragma unroll
        for (int kf = 0; kf < 4; ++kf)
#pragma unroll
          for (int r = 0; r < 4; ++r) {
            const int kk = kf * 16 + 4 * q + r;
            if (kk < lo || kk > hi) s[kf][t2][r] = -INFINITY;
          }
      }
    }
    half8 pf[2][2];
#pragma unroll
    for (int t2 = 0; t2 < 2; ++t2) {
      float mb = 0.f, scale_p = 1.f;
      if (MODE == 1) {
        mb = m[t2]; scale_p = l[t2];
      } else if (MODE == 0) {
        float tm = s[0][t2][0];
#pragma unroll
        for (int kf = 0; kf < 4; ++kf)
#pragma unroll
          for (int r = 0; r < 4; ++r) tm = fmaxf(tm, s[kf][t2][r]);
        tm = rowmax4(tm);
        const float mn = fmaxf(m[t2], tm);
        const float alpha = fexp2(m[t2] - mn);
        m[t2] = mn; mb = mn;
        l[t2] *= alpha;
      }
      float lsum = 0.f;
#pragma unroll
      for (int kf = 0; kf < 4; ++kf) {
#pragma unroll
        for (int r = 0; r < 4; ++r) {
          float pv = (MODE >= 2) ? fexp2(s[kf][t2][r]) : fexp2(s[kf][t2][r] - mb);
          if (MODE == 1) pv *= scale_p;
          s[kf][t2][r] = pv; if (MODE == 0) lsum += pv;
        }
      }
      if (MODE == 0) l[t2] += lsum;
      if (MODE == 1) {
        const int tok = th * 32 + t2 * 16 + r15;
#pragma unroll
        for (int kf = 0; kf < 4; ++kf) {
          const int j = 16 * ti + 4 * kf + q;
          const unsigned int u0 = (unsigned int)(s[kf][t2][0] * 134217728.f + 0.5f), u1 = (unsigned int)(s[kf][t2][1] * 134217728.f + 0.5f);
          const unsigned int u2 = (unsigned int)(s[kf][t2][2] * 134217728.f + 0.5f), u3 = (unsigned int)(s[kf][t2][3] * 134217728.f + 0.5f);
          if (j < 64) {
            atomicAdd(&impu[tok * IMPS + j], u0 + u1 + u2 + u3);
            atomicAdd(&impu[tok * IMPS + j + 1], u3);
          }
        }
      }
      if (MODE != 0) {
#pragma unroll
        for (int ks = 0; ks < 2; ++ks) {
          half8 pk;
#pragma unroll
          for (int r = 0; r < 4; ++r) { pk[r] = (half_t)s[2 * ks][t2][r]; pk[4 + r] = (half_t)s[2 * ks + 1][t2][r]; }
          pf[t2][ks] = pk;
        }
      }
    }
    if (MODE != 0) {
      asm volatile("s_waitcnt lgkmcnt(0)"
                   : "+v"(vr[0][0]), "+v"(vr[0][1]), "+v"(vr[0][2]), "+v"(vr[0][3]), "+v"(vr[1][0]), "+v"(vr[1][1]), "+v"(vr[1][2]), "+v"(vr[1][3]),
                     "+v"(vr[2][0]), "+v"(vr[2][1]), "+v"(vr[2][2]), "+v"(vr[2][3]), "+v"(vr[3][0]), "+v"(vr[3][1]), "+v"(vr[3][2]), "+v"(vr[3][3])
                   :: "memory");
      __builtin_amdgcn_sched_barrier(0);
#pragma unroll
      for (int df = 0; df < 4; ++df) {
#pragma unroll
        for (int ks = 0; ks < 2; ++ks) {
          const v2i lo2 = vr[df][2 * ks], hi2 = vr[df][2 * ks + 1];
          const v4i pk4 = (v4i){lo2[0], lo2[1], hi2[0], hi2[1]};
          const half8 vf = __builtin_bit_cast(half8, pk4);
#pragma unroll
          for (int t2 = 0; t2 < 2; ++t2) o[df][t2] = __builtin_amdgcn_mfma_f32_16x16x32_f16(vf, pf[t2][ks], o[df][t2], 0, 0, 0);
        }
      }
      if (MODE >= 2) {
        const half8 ones = (half8){(half_t)1.f, (half_t)1.f, (half_t)1.f, (half_t)1.f, (half_t)1.f, (half_t)1.f, (half_t)1.f, (half_t)1.f};
#pragma unroll
        for (int ks = 0; ks < 2; ++ks)
#pragma unroll
          for (int t2 = 0; t2 < 2; ++t2) lacc[t2] = __builtin_amdgcn_mfma_f32_16x16x32_f16(ones, pf[t2][ks], lacc[t2], 0, 0, 0);
      }
    }
  }
  if (MODE >= 2) { l[0] = lacc[0][0]; l[1] = lacc[1][0]; }
  __syncthreads();
#undef A_GLOAD
}

template <int MODE, bool PREISSUED>
__device__ __forceinline__ void attn_branch_pp(char* smem, const half_t* kbase, const half_t* vbase, int ld, int tile_lo, int tile_hi, int n, int th,
                                               const half8 (&qf)[2][2], const float (&m)[2], float (&l)[2], f32x4 (&o)[4][2],
                                               const unsigned long long (&selm)[2], int wvs, int rot) {
  const int tid = otid(wvs);
  const int lane = tid & 63, r15 = lane & 15, q = lane >> 4;
  const int lrow = tid >> 3, lch = tid & 7;
  const int k_rd = r15 * 128, kswz = r15 >> 1;
  const int qp = r15 >> 2, pp = lane & 3;
  const int fx = ((2 * q + (qp >> 1)) & 3) << 1;
  const int v_rd = (4 * q + qp) * 128 + 8 * (pp & 1) + ((pp >> 1) << 4);
  const int ksrc = (lch ^ ((lrow >> 1) & 7)) * 8, vsrc = (lch ^ (((lrow >> 1) & 3) << 1)) * 8;
  const int wbase = __builtin_amdgcn_readfirstlane(tid >> 6) * 1024;
#define A_GLOAD(TI, BUF) { const half_t* kp_ = kbase + (size_t)((TI) * 64 + lrow) * ld + ksrc; \
    __builtin_amdgcn_global_load_lds((gbl_void*)kp_, (lds_void*)(smem + ATT_K + (BUF) * 8192 + wbase), 16, 0, 0); \
    { const half_t* vp_ = vbase + (size_t)((TI) * 64 + lrow) * ld + vsrc; \
      __builtin_amdgcn_global_load_lds((gbl_void*)vp_, (lds_void*)(smem + ATT_V + (BUF) * 8192 + wbase), 16, 0, 0); } }
#define PP_BAR { __builtin_amdgcn_sched_barrier(0); __builtin_amdgcn_s_barrier(); __builtin_amdgcn_sched_barrier(0); }
  const int nt = tile_hi - tile_lo + 1;
  f32x4 lacc[2] = {(f32x4){0.f, 0.f, 0.f, 0.f}, (f32x4){0.f, 0.f, 0.f, 0.f}};
  if (!PREISSUED) {
#pragma unroll
    for (int i = 0; i < ATT_D; ++i) if (i < nt) A_GLOAD(tile_lo + ((rot + i >= nt) ? rot + i - nt : rot + i), i)
  }
  { const int r = nt - 1;
    if (r >= 4) wait_vmcnt<8>(); else if (r == 3) wait_vmcnt<6>(); else if (r == 2) wait_vmcnt<4>(); else if (r == 1) wait_vmcnt<2>(); else wait_vmcnt<0>(); }
  half8 pf[2][2];
  v2i vr[4][4];
#pragma unroll
  for (int a = 0; a < 2; ++a)
#pragma unroll
    for (int b = 0; b < 2; ++b) pf[a][b] = (half8){(half_t)0.f, (half_t)0.f, (half_t)0.f, (half_t)0.f, (half_t)0.f, (half_t)0.f, (half_t)0.f, (half_t)0.f};
#pragma unroll
  for (int a = 0; a < 4; ++a)
#pragma unroll
    for (int b = 0; b < 4; ++b) vr[a][b] = (v2i){0, 0};
  const half8 ones = (half8){(half_t)1.f, (half_t)1.f, (half_t)1.f, (half_t)1.f, (half_t)1.f, (half_t)1.f, (half_t)1.f, (half_t)1.f};
#define PP_PV { _Pragma("unroll") for (int df = 0; df < 4; ++df) _Pragma("unroll") for (int ks = 0; ks < 2; ++ks) { \
      const v2i lo2 = vr[df][2 * ks], hi2 = vr[df][2 * ks + 1]; const v4i pk4 = (v4i){lo2[0], lo2[1], hi2[0], hi2[1]}; const half8 vf = __builtin_bit_cast(half8, pk4); \
      _Pragma("unroll") for (int t2 = 0; t2 < 2; ++t2) o[df][t2] = __builtin_amdgcn_mfma_f32_16x16x32_f16(vf, pf[t2][ks], o[df][t2], 0, 0, 0); } \
    _Pragma("unroll") for (int ks = 0; ks < 2; ++ks) _Pragma("unroll") for (int t2 = 0; t2 < 2; ++t2) lacc[t2] = __builtin_amdgcn_mfma_f32_16x16x32_f16(ones, pf[t2][ks], lacc[t2], 0, 0, 0); }
  __builtin_amdgcn_sched_barrier(0);
  if (th == 1) __builtin_amdgcn_s_barrier();
  __builtin_amdgcn_sched_barrier(0);
  int trel = rot, tpf = rot + ATT_D; while (tpf >= nt) tpf -= nt;
  v4i kq[2][4];
  const unsigned kco0 = (unsigned)(((4 * 0 + q) ^ kswz) << 4), kco1 = (unsigned)(((4 * 1 + q) ^ kswz) << 4);
#define PP_KREAD(BUF) { const unsigned kb_ = (unsigned)(size_t)(smem + ATT_K + (BUF) * 8192 + k_rd); const unsigned ka0 = kb_ + kco0, ka1 = kb_ + kco1; \
    asm volatile("ds_read_b128 %0, %8\n\tds_read_b128 %1, %8 offset:2048\n\tds_read_b128 %2, %8 offset:4096\n\tds_read_b128 %3, %8 offset:6144\n\t" \
                 "ds_read_b128 %4, %9\n\tds_read_b128 %5, %9 offset:2048\n\tds_read_b128 %6, %9 offset:4096\n\tds_read_b128 %7, %9 offset:6144" \
                 : "=&v"(kq[0][0]), "=&v"(kq[0][1]), "=&v"(kq[0][2]), "=&v"(kq[0][3]), "=&v"(kq[1][0]), "=&v"(kq[1][1]), "=&v"(kq[1][2]), "=&v"(kq[1][3]) \
                 : "v"(ka0), "v"(ka1) : "memory"); }
#define PP_KWAIT asm volatile("s_waitcnt lgkmcnt(0)" : "+v"(kq[0][0]), "+v"(kq[0][1]), "+v"(kq[0][2]), "+v"(kq[0][3]), "+v"(kq[1][0]), "+v"(kq[1][1]), "+v"(kq[1][2]), "+v"(kq[1][3]) :: "memory");
#pragma unroll 1
  for (int it = 0; it < nt; ++it) {
    const int ti = tile_lo + trel, cur = it % ATT_NB;
    trel = (trel + 1 == nt) ? 0 : trel + 1;
    PP_BAR
    f32x4 s[4][2];
    PP_KREAD(cur)
    __builtin_amdgcn_s_setprio(1);
    PP_PV
    PP_KWAIT
#pragma unroll
    for (int t2 = 0; t2 < 2; ++t2) {
      float c0 = -m[t2];
      if (MODE == 2 && !((selm[t2] >> ti) & 1ull)) c0 = -INFINITY;
#pragma unroll
      for (int kf = 0; kf < 4; ++kf) s[kf][t2] = (f32x4){c0, c0, c0, c0};
    }
#pragma unroll
    for (int ks = 0; ks < 2; ++ks) {
#pragma unroll
      for (int kf = 0; kf < 4; ++kf) {
        const half8 kfr = __builtin_bit_cast(half8, kq[ks][kf]);
#pragma unroll
        for (int t2 = 0; t2 < 2; ++t2) s[kf][t2] = __builtin_amdgcn_mfma_f32_16x16x32_f16(kfr, qf[t2][ks], s[kf][t2], 0, 0, 0);
      }
    }
    __builtin_amdgcn_s_setprio(0);
    { const int r = nt - 2 - it;
      if (r >= 3) wait_vmcnt<6>(); else if (r == 2) wait_vmcnt<4>(); else if (r == 1) wait_vmcnt<2>(); else wait_vmcnt<0>(); }
    PP_BAR
    if (it + ATT_D < nt) A_GLOAD(tile_lo + tpf, (it + ATT_D) % ATT_NB)
    tpf = (tpf + 1 == nt) ? 0 : tpf + 1;
    {
      const unsigned vbl = (unsigned)(size_t)(smem + ATT_V + cur * 8192 + v_rd);
      const unsigned va0 = vbl + (((0) ^ fx) << 4), va1 = vbl + (((2) ^ fx) << 4), va2 = vbl + (((4) ^ fx) << 4), va3 = vbl + (((6) ^ fx) << 4);
      asm volatile(
          "ds_read_b64_tr_b16 %0, %16\n\tds_read_b64_tr_b16 %1, %16 offset:2048\n\tds_read_b64_tr_b16 %2, %16 offset:4096\n\tds_read_b64_tr_b16 %3, %16 offset:6144\n\t"
          "ds_read_b64_tr_b16 %4, %17\n\tds_read_b64_tr_b16 %5, %17 offset:2048\n\tds_read_b64_tr_b16 %6, %17 offset:4096\n\tds_read_b64_tr_b16 %7, %17 offset:6144\n\t"
          "ds_read_b64_tr_b16 %8, %18\n\tds_read_b64_tr_b16 %9, %18 offset:2048\n\tds_read_b64_tr_b16 %10, %18 offset:4096\n\tds_read_b64_tr_b16 %11, %18 offset:6144\n\t"
          "ds_read_b64_tr_b16 %12, %19\n\tds_read_b64_tr_b16 %13, %19 offset:2048\n\tds_read_b64_tr_b16 %14, %19 offset:4096\n\tds_read_b64_tr_b16 %15, %19 offset:6144"
          : "=&v"(vr[0][0]), "=&v"(vr[0][1]), "=&v"(vr[0][2]), "=&v"(vr[0][3]), "=&v"(vr[1][0]), "=&v"(vr[1][1]), "=&v"(vr[1][2]), "=&v"(vr[1][3]),
            "=&v"(vr[2][0]), "=&v"(vr[2][1]), "=&v"(vr[2][2]), "=&v"(vr[2][3]), "=&v"(vr[3][0]), "=&v"(vr[3][1]), "=&v"(vr[3][2]), "=&v"(vr[3][3])
          : "v"(va0), "v"(va1), "v"(va2), "v"(va3)
          : "memory");
    }
    bool need_mask;
    if (MODE == 2) need_mask = (ti == n); else need_mask = (ti == n) || (ti == n - 8);
    if (need_mask) {
#pragma unroll
      for (int t2 = 0; t2 < 2; ++t2) {
        const int tok = th * 32 + t2 * 16 + r15;
        int lo = 0, hi = 63;
        if (MODE == 2) { hi = tok; }
        else { if (ti == n) hi = tok; else lo = tok + 1; }
#pragma unroll
        for (int kf = 0; kf < 4; ++kf)
#pragma unroll
          for (int r = 0; r < 4; ++r) {
            const int kk = kf * 16 + 4 * q + r;
            if (kk < lo || kk > hi) s[kf][t2][r] = -INFINITY;
          }
      }
    }
#pragma unroll
    for (int t2 = 0; t2 < 2; ++t2) {
#pragma unroll
      for (int kf = 0; kf < 4; ++kf)
#pragma unroll
        for (int r = 0; r < 4; ++r) s[kf][t2][r] = fexp2(s[kf][t2][r]);
#pragma unroll
      for (int ks = 0; ks < 2; ++ks) {
        half8 pk;
#pragma unroll
        for (int r = 0; r < 4; ++r) { pk[r] = (half_t)s[2 * ks][t2][r]; pk[4 + r] = (half_t)s[2 * ks + 1][t2][r]; }
        pf[t2][ks] = pk;
      }
    }
    asm volatile("s_waitcnt lgkmcnt(0)"
                 : "+v"(vr[0][0]), "+v"(vr[0][1]), "+v"(vr[0][2]), "+v"(vr[0][3]), "+v"(vr[1][0]), "+v"(vr[1][1]), "+v"(vr[1][2]), "+v"(vr[1][3]),
                   "+v"(vr[2][0]), "+v"(vr[2][1]), "+v"(vr[2][2]), "+v"(vr[2][3]), "+v"(vr[3][0]), "+v"(vr[3][1]), "+v"(vr[3][2]), "+v"(vr[3][3])
                 :: "memory");
  }
  PP_BAR
  PP_PV
  __builtin_amdgcn_sched_barrier(0);
  if (th == 0) __builtin_amdgcn_s_barrier();
  __builtin_amdgcn_sched_barrier(0);
  l[0] = lacc[0][0]; l[1] = lacc[1][0];
  __syncthreads();
#undef A_GLOAD
#undef PP_BAR
#undef PP_PV
#undef PP_KREAD
#undef PP_KWAIT
}

__device__ void ph_attn_mfma(const Params& P, char* smem, int wvs) {
  unsigned int* impu = (unsigned int*)(smem + ATT_IMP);
  unsigned long long* selmask = (unsigned long long*)(smem + ATT_SELM);
  const int G = gridDim.x, nrounds = (2048 + G - 1) / G;
  for (int rd = 0; rd < nrounds; ++rd) {
    const int idx = rd * G + ((rd & 1) ? (G - 1 - (int)blockIdx.x) : (int)blockIdx.x);
    if (idx >= 2048) continue;
    const int tid = otid(wvs), lane = tid & 63, r15 = lane & 15, q = lane >> 4;
    const int n = 63 - (idx >> 5), bg = idx & 31, b = bg >> 2, g = bg & 3;
    const int wv = __builtin_amdgcn_readfirstlane(otid(wvs) >> 6);
    const int hd = g * 4 + (wv & 3), th = wv >> 2;
    const int t0 = b * SEQ + n * 64 + th * 32;
    const half_t* kc = P.kcmp + (size_t)bg * 256 * 64;
    const half_t* vc = P.vcmp + (size_t)bg * 256 * 64;
    const int nct = (4 * n + 2) / 64;
    attn_issue(smem, kc, vc, 64, 0, nct, wvs);
    half8 qf[2][2];
#pragma unroll
    for (int t2 = 0; t2 < 2; ++t2)
#pragma unroll
      for (int ks = 0; ks < 2; ++ks) qf[t2][ks] = *(const half8*)(P.p + (size_t)(t0 + t2 * 16 + r15) * LD1 + hd * 64 + 32 * ks + 8 * q);
    float* gate_l = (float*)(smem + ATT_GATE) + wv * 128;
    if (q == 0) {
#pragma unroll
      for (int t2 = 0; t2 < 2; ++t2) {
        const float* pr = P.gl + (size_t)(t0 + t2 * 16 + r15) * 48 + hd * 3;
        f32x4 gv;
#pragma unroll
        for (int c = 0; c < 3; ++c) gv[c] = sigmoidf(pr[c] + P.nsa_b_gate[hd * 3 + c]);
        gv[3] = 0.f;
        *(f32x4*)(gate_l + (t2 * 16 + r15) * 4) = gv;
      }
    }
    { const int tz = otid(wvs); for (int i = tz; i < 64 * IMPS + 128; i += NTHREADS) impu[i] = 0u; }
    float m[2], l[2]; f32x4 o[4][2]; unsigned long long selm[2] = {0ull, 0ull};
#pragma unroll
    for (int t2 = 0; t2 < 2; ++t2) { m[t2] = -1e30f; l[t2] = 0.f; }
#pragma unroll
    for (int df = 0; df < 4; ++df)
#pragma unroll
      for (int t2 = 0; t2 < 2; ++t2) o[df][t2] = (f32x4){0.f, 0.f, 0.f, 0.f};
    attn_branch<0, true>(smem, kc, vc, 64, 0, nct, n, th, qf, m, l, o, selm, wvs);
#pragma unroll
    for (int t2 = 0; t2 < 2; ++t2) {
      float lt = l[t2];
      lt = rowsum4(lt);
      l[t2] = lt > 0.f ? 1.f / lt : 0.f;
    }
    attn_branch<1>(smem, kc, vc, 64, 0, nct, n, th, qf, m, l, o, selm, wvs);
    f32x4 oacc[4][2];
#pragma unroll
    for (int t2 = 0; t2 < 2; ++t2) {
      const float gc = gate_l[(t2 * 16 + r15) * 4 + 0];
#pragma unroll
      for (int df = 0; df < 4; ++df) oacc[df][t2] = o[df][t2] * gc;
    }
    {
      const int tz = otid(wvs), lz = tz & 63;
#pragma unroll
      for (int i = 0; i < 4; ++i) {
        const int slab = i * 8 + wv, tokz = slab * 2 + (lz >> 5), cz = (lz & 31) ^ (tokz & 15);
        const half_t* zp = P.p + (size_t)(b * SEQ + n * 64 + tokz) * LD1 + 2560 + g * 256 + cz * 8;
        __builtin_amdgcn_global_load_lds((gbl_void*)zp, (lds_void*)(smem + ATT_Z + slab * 1024), 16, 0, 0);
      }
    }
    const int shr = ((int)blockIdx.x >> 5) & 7;
    const int rot_s = (shr * (n + 1)) >> 3;
    attn_issue(smem, P.p + (size_t)b * SEQ * LD1 + 1536 + g * 64, P.p + (size_t)b * SEQ * LD1 + 1792 + g * 64, LD1, 0, n, wvs, rot_s);
    {
      const int tid2 = otid(wvs);
      const int tok = tid2 >> 3, part = tid2 & 7;
      unsigned long long msk;
      if (n + 1 <= 16) {
        msk = (1ull << (n + 1)) - 1ull;
      } else {
        const uint4* rowp = (const uint4*)(impu + tok * IMPS);
        unsigned own[8];
        { const uint4 a = rowp[part * 2], b2 = rowp[part * 2 + 1];
          own[0] = a.x; own[1] = a.y; own[2] = a.z; own[3] = a.w; own[4] = b2.x; own[5] = b2.y; own[6] = b2.z; own[7] = b2.w; }
        int rank[8];
#pragma unroll
        for (int jj = 0; jj < 8; ++jj) {
          const int j = part * 8 + jj;
          own[jj] = (j >= 1 && j <= n - 2) ? ((own[jj] & ~63u) | (unsigned)(63 - j)) : 0xffffffffu;
          rank[jj] = 0;
        }
#pragma unroll 2
        for (int c4 = 0; c4 < 16; ++c4) {
          const uint4 v = rowp[c4];
          unsigned kv[4] = {v.x, v.y, v.z, v.w};
#pragma unroll
          for (int e = 0; e < 4; ++e) {
            const int j2 = c4 * 4 + e;
            const unsigned key2 = (j2 >= 1 && j2 <= n - 2) ? ((kv[e] & ~63u) | (unsigned)(63 - j2)) : 0u;
#pragma unroll
            for (int jj = 0; jj < 8; ++jj) rank[jj] += (key2 > own[jj]) ? 1 : 0;
          }
        }
        unsigned int bits = 0;
#pragma unroll
        for (int jj = 0; jj < 8; ++jj) if (rank[jj] < 13 && own[jj] != 0xffffffffu) bits |= 1u << jj;
        unsigned* sel32 = (unsigned*)selmask;
        if (bits) atomicOr(&sel32[tok * 2 + (part >> 2)], bits << (8 * (part & 3)));
        msk = 1ull | (1ull << n) | (1ull << (n - 1));
        if (part == 0) { atomicOr(&sel32[tok * 2], (unsigned)msk); atomicOr(&sel32[tok * 2 + 1], (unsigned)(msk >> 32)); }
      }
      if (n + 1 <= 16 && part == 0) selmask[tok] = msk;
    }
    __syncthreads();
#pragma unroll
    for (int t2 = 0; t2 < 2; ++t2) selm[t2] = selmask[th * 32 + t2 * 16 + r15];
    float qn2[2];
#pragma unroll
    for (int t2 = 0; t2 < 2; ++t2) {
      float a = 0.f;
#pragma unroll
      for (int ks = 0; ks < 2; ++ks)
#pragma unroll
        for (int e = 0; e < 8; ++e) a += (float)qf[t2][ks][e] * (float)qf[t2][ks][e];
      qn2[t2] = rowsum4(a);
    }
    { const float km = __uint_as_float(P.kmax2[bg * 2 + 0]);
#pragma unroll
      for (int t2 = 0; t2 < 2; ++t2) { m[t2] = sqrtf(qn2[t2] * km) * 1.001f - 5.0f * LOG2E; l[t2] = 0.f; } }
#pragma unroll
    for (int df = 0; df < 4; ++df)
#pragma unroll
      for (int t2 = 0; t2 < 2; ++t2) o[df][t2] = (f32x4){0.f, 0.f, 0.f, 0.f};
    attn_branch_pp<2, true>(smem, P.p + (size_t)b * SEQ * LD1 + 1536 + g * 64, P.p + (size_t)b * SEQ * LD1 + 1792 + g * 64, LD1, 0, n, n, th, qf, m, l, o, selm, wvs, rot_s);
#pragma unroll
    for (int t2 = 0; t2 < 2; ++t2) {
      const float gs = gate_l[(t2 * 16 + r15) * 4 + 1] / l[t2];
#pragma unroll
      for (int df = 0; df < 4; ++df) oacc[df][t2] += o[df][t2] * gs;
    }
    { const float km = __uint_as_float(P.kmax2[bg * 2 + 1]);
#pragma unroll
      for (int t2 = 0; t2 < 2; ++t2) { m[t2] = sqrtf(qn2[t2] * km) * 1.001f - 5.0f * LOG2E; l[t2] = 0.f; } }
#pragma unroll
    for (int df = 0; df < 4; ++df)
#pragma unroll
      for (int t2 = 0; t2 < 2; ++t2) o[df][t2] = (f32x4){0.f, 0.f, 0.f, 0.f};
    attn_branch_pp<3, false>(smem, P.p + (size_t)b * SEQ * LD1 + 2048 + g * 64, P.p + (size_t)b * SEQ * LD1 + 2304 + g * 64, LD1, (n > 8 ? n - 8 : 0), n, n, th, qf, m, l, o, selm, wvs, ((7 - shr) * (n > 8 ? 9 : n + 1)) >> 3);
    {
      int tbase = t0 + r15; asm volatile("" : "+v"(tbase));
#pragma unroll
      for (int t2 = 0; t2 < 2; ++t2) {
        const size_t tok = (size_t)(tbase + t2 * 16);
        const float gw = gate_l[(t2 * 16 + r15) * 4 + 2] / l[t2];
#pragma unroll
        for (int df = 0; df < 4; ++df) {
          const f32x4 v = oacc[df][t2] + o[df][t2] * gw;
          const int tokl = th * 32 + t2 * 16 + r15, cz = (wv & 3) * 8 + df * 2 + (q >> 1);
          const half4 z = *(const half4*)(smem + ATT_Z + tokl * 512 + ((cz ^ (tokl & 15)) << 4) + (q & 1) * 8);
          half4 hv;
#pragma unroll
          for (int e = 0; e < 4; ++e) hv[e] = (half_t)(v[e] * siluf((float)z[e]));
          *(half4*)(P.og + tok * DM + hd * 64 + df * 16 + 4 * q) = hv;
        }
      }
    }
  }
}

constexpr int NPHASES = 13;
__device__ __forceinline__ void run_phase(int ph, const Params& P, char* smem, int wvs) {
  float* sm = (float*)smem;
  switch (ph) {
    case 0:
      if (blockIdx.x == 0 && otid(wvs) < 64) P.kmax2[otid(wvs)] = 0u;
      ph_xh_rstd(P.x, P.xh, P.rstd, wvs); ph_ropetab(P, wvs); prep_cbias_part(P, wvs);
      prep_weights(P, sm, wvs);
      prep_wT(P.nsa_w_in, NSA_IN, P.pre_norm + DM, P.WglT, 64, DM, 5, sm, wvs);
      prep_wT(P.gla_w_in, GLA_IN, P.pre_norm, P.WglrT, 64, DM, 6, sm, wvs);
      break;
    case 1:
      g8::gemm(g8::SrcPlain8{P.xh, DM, P.W0t, DM}, T_TOK, LD0, DM, g8::EpiStore8{P.p, LD0, P.rstd}, smem, wvs);
      ph_rowproj<1>(P, P.WglrT, P.glr, smem, wvs, 0);
      break;
    case 2: prep_cbias_reduce(P, wvs); ph_gla_prep(P, sm, wvs); break;
    case 13: ph_gla_mfma<true>(P, smem, wvs); break;
    case 3: ph_gla_mfma<false>(P, smem, wvs); break;
    case 4: ph_gla_post(P, wvs); break;
    case 5: g8::gemm(g8::SrcPlain8{P.og, DM, P.Wo0t, DM}, T_TOK, DM, DM, g8::EpiStore8{P.y, DM, nullptr}, smem, wvs); break;
    case 6: ph_post<false>(P.xh, P.y, P.post_norm, nullptr, P.xh, P.rstd, wvs); break;
    case 7: g8::gemm(g8::SrcPlain8{P.xh, DM, P.W1t, DM}, T_TOK, LD1, DM, g8::EpiRope8{P.p, LD1, P.rstd, P.ropetab}, smem, wvs); break;
    case 8:
      if (blockIdx.x >= 64) { ph_kmax(P, wvs, 64); ph_rowproj<3>(P, P.WglT, P.gl, smem, wvs, 64); }
      g8::gemm(g8::SrcCmp1_8{P.p, P.cw1t}, 16384, 256, 2048, g8::EpiCmpHid8{P.hid, P.cbias}, smem, wvs);
      asm volatile("s_waitcnt vmcnt(0)" ::: "memory");
      __syncthreads();
      g8::gemm(g8::SrcCmp2_8{P.hid, P.cw2t}, 16384, 256, 256, g8::EpiCmpOut8{P.kcmp, P.vcmp}, smem, wvs);
      break;
    case 10: ph_attn_mfma(P, smem, wvs); break;
    case 11: g8::gemm(g8::SrcPlain8{P.og, DM, P.Wo1t, DM}, T_TOK, DM, DM, g8::EpiStore8{P.y, DM, nullptr}, smem, wvs); break;
    case 12: ph_post<true>(P.x1h, P.y, P.post_norm + DM, P.out, nullptr, nullptr, wvs); break;
  }
}

template <int PH>
__global__ void __launch_bounds__(NTHREADS, 2) k_phase(Params P) {
  __shared__ __attribute__((aligned(16))) char smem[SMEM_BYTES];
  run_phase(PH, P, smem, __builtin_amdgcn_readfirstlane(threadIdx.x >> 6));
}
template <int PH>
static void launch_phases(const Params& P, hipStream_t stream) {
  hipLaunchKernelGGL((k_phase<PH>), dim3(256), dim3(NTHREADS), 0, stream, P);
  if constexpr (PH + 1 < NPHASES) launch_phases<PH + 1>(P, stream);
}

#if MEGA
__global__ void __launch_bounds__(NTHREADS, 2) k_mega(Params P) {
  __shared__ __attribute__((aligned(16))) char smem[SMEM_BYTES];
  cg::grid_group grid = cg::this_grid();
  if (P.use_cg_sync) grid.sync();
  unsigned bt = 0;
  const int wvs = __builtin_amdgcn_readfirstlane(threadIdx.x >> 6);
  run_phase(0, P, smem, wvs); fast_barrier(P.bar, bt, wvs);
  run_phase(1, P, smem, wvs); fast_barrier(P.bar, bt, wvs);
  run_phase(2, P, smem, wvs); fast_barrier(P.bar, bt, wvs);
  run_phase(13, P, smem, wvs); fast_barrier(P.bar, bt, wvs);
  run_phase(3, P, smem, wvs); fast_barrier(P.bar, bt, wvs);
  run_phase(4, P, smem, wvs); fast_barrier(P.bar, bt, wvs);
  run_phase(5, P, smem, wvs); fast_barrier(P.bar, bt, wvs);
  run_phase(6, P, smem, wvs); fast_barrier(P.bar, bt, wvs);
  run_phase(7, P, smem, wvs); fast_barrier(P.bar, bt, wvs);
  run_phase(8, P, smem, wvs); fast_barrier(P.bar, bt, wvs);
  run_phase(10, P, smem, wvs); fast_barrier(P.bar, bt, wvs);
  run_phase(11, P, smem, wvs); fast_barrier(P.bar, bt, wvs);
  run_phase(12, P, smem, wvs);
}
#endif

extern "C" void kernel_launch(void* const* d_in, const int* in_sizes, int n_in, void* d_out, int out_size, void* d_ws, size_t ws_size,
                              hipStream_t stream) {
  Params P{};
  P.x = (const float*)d_in[0]; P.pos = (const int*)d_in[1]; P.pre_norm = (const float*)d_in[2]; P.post_norm = (const float*)d_in[3];
  P.gla_w_in = (const float*)d_in[4]; P.gla_w_gk_up = (const float*)d_in[5]; P.gla_b_gk = (const float*)d_in[6];
  P.gla_head_norm = (const float*)d_in[7]; P.gla_w_out = (const float*)d_in[8];
  P.nsa_w_in = (const float*)d_in[9]; P.nsa_b_gate = (const float*)d_in[10]; P.nsa_pe_k = (const float*)d_in[11]; P.nsa_pe_v = (const float*)d_in[12];
  P.ck_w1 = (const float*)d_in[13]; P.ck_w2 = (const float*)d_in[14]; P.cv_w1 = (const float*)d_in[15]; P.cv_w2 = (const float*)d_in[16];
  P.nsa_w_out = (const float*)d_in[17];
  P.out = (float*)d_out;
  char* ws = (char*)d_ws;
  const size_t MB = 1024 * 1024;
  P.W0t = (half_t*)(ws);
  P.Wo0t = (half_t*)(ws + 7 * MB);
  P.W1t = (half_t*)(ws + 9 * MB);
  P.Wo1t = (half_t*)(ws + 17 * MB);
  P.cw1t = (half_t*)(ws + 19 * MB);
  P.cw2t = (half_t*)(ws + 21 * MB);
  P.cbias = (float*)(ws + 22 * MB);
  P.cbias_part = (float*)(ws + 22 * MB + 4096);
  P.bar = (unsigned*)(ws + 23 * MB);
  P.use_cg_sync = 0;
  P.kmax2 = (unsigned*)(ws + 22 * MB + 512 * 1024);
  P.xh = (half_t*)(ws + 24 * MB);
  P.x1h = P.xh;
  P.p = (half_t*)(ws + 88 * MB);
  P.y = (half_t*)(ws + 88 * MB);
  P.og = (half_t*)(ws + 328 * MB);
  P.bcum = (float*)(ws + 392 * MB);
  P.rstd = (float*)(ws + 456 * MB);
  P.kcmp = (half_t*)(ws + 457 * MB);
  P.vcmp = (half_t*)(ws + 458 * MB);
  P.ropetab = (float*)(ws + 459 * MB);
  P.hid = (half_t*)(ws + 467 * MB);
  P.WglT = (half_t*)(ws + 22 * MB + 768 * 1024);
  P.WglrT = (half_t*)(ws + 22 * MB + 896 * 1024);
  P.glr = (float*)(ws + 509 * MB);
  P.gl = (float*)(ws + 503 * MB);
  P.gla_state = (float*)(ws + 476 * MB);
  if (ws_size < 512 * MB) { fprintf(stderr, "ws too small: %zu\n", ws_size); return; }
#if MEGA
  static int grid_blocks = 0;
  if (!grid_blocks) {
    int dev = 0, cus = 0, per_cu = 0;
    hipGetDevice(&dev);
    hipDeviceGetAttribute(&cus, hipDeviceAttributeMultiprocessorCount, dev);
    hipOccupancyMaxActiveBlocksPerMultiprocessor(&per_cu, k_mega, NTHREADS, 0);
    if (per_cu < 1) per_cu = 1;
    if (per_cu > 1) per_cu = 1;
    grid_blocks = cus * per_cu;
  }
  hipMemsetAsync(ws + 23 * MB, 0, 16384, stream);
  void* args[] = {&P};
  hipError_t e = hipLaunchCooperativeKernel((void*)k_mega, dim3(grid_blocks), dim3(NTHREADS), args, 0, stream);
  if (e != hipSuccess) fprintf(stderr, "cooperative launch failed: %s (grid %d)\n", hipGetErrorString(e), grid_blocks);
#else
  launch_phases<0>(P, stream);
#endif
}
```

```cpp
#include <hip/hip_runtime.h>
#include <hip/hip_cooperative_groups.h>
#include <cstdio>
#include <cstdint>
namespace cg = cooperative_groups;

typedef _Float16 half_t;
typedef _Float16 half8 __attribute__((ext_vector_type(8)));
typedef _Float16 half4 __attribute__((ext_vector_type(4)));
typedef float f32x4 __attribute__((ext_vector_type(4)));
typedef int v2i __attribute__((ext_vector_type(2)));
typedef int v4i __attribute__((ext_vector_type(4)));

#ifndef MEGA
#define MEGA 1
#endif

constexpr int T_TOK = 32768, DM = 1024, SEQ = 4096, NBATCH = 8;
constexpr int GLA_IN = 3088, NSA_IN = 3632;
constexpr int LD0 = 3072, LD1 = 3584;
constexpr int NC = 255;
constexpr float EPS = 1e-6f;
constexpr int NTHREADS = 512, NWAVES = NTHREADS / 64;
constexpr int SMEM_BYTES = 160 * 1024;

struct Params {
  const float* x; const int* pos; const float* pre_norm; const float* post_norm;
  const float* gla_w_in; const float* gla_w_gk_up; const float* gla_b_gk; const float* gla_head_norm; const float* gla_w_out;
  const float* nsa_w_in; const float* nsa_b_gate; const float* nsa_pe_k; const float* nsa_pe_v;
  const float* ck_w1; const float* ck_w2; const float* cv_w1; const float* cv_w2; const float* nsa_w_out;
  float* out;
  half_t* p; half_t* y; half_t* og; float* bcum; float* rstd; half_t* kcmp; half_t* vcmp; float* ropetab;
  half_t* xh; half_t* W0t; half_t* Wo0t; half_t* W1t; half_t* Wo1t;
  half_t* cw1t; half_t* cw2t; float* cbias; half_t* hid;
  float* cbias_part; unsigned* bar; long long use_cg_sync; unsigned* kmax2; float* gla_state; half_t* WglT; float* gl; half_t* x1h; half_t* WglrT; float* glr;
};

__device__ __forceinline__ int lane_id() { return (int)__builtin_amdgcn_mbcnt_hi(~0u, __builtin_amdgcn_mbcnt_lo(~0u, 0u)); }
__device__ __forceinline__ int otid(int wvs) { int t = wvs * 64 + lane_id(); asm volatile("" : "+v"(t)); return t; }
typedef __attribute__((address_space(3))) void lds_void;
typedef __attribute__((address_space(1))) const void gbl_void;
typedef short s16x4 __attribute__((vector_size(8)));
typedef __attribute__((address_space(3))) s16x4 lds_s16x4;
__device__ __forceinline__ half4 tr_read4(const char* p) {
  const s16x4 v = __builtin_amdgcn_ds_read_tr16_b64_v4i16((lds_s16x4*)(p));
  return __builtin_bit_cast(half4, v);
}
template <int N> __device__ __forceinline__ void wait_vmcnt() { asm volatile("s_waitcnt vmcnt(%0)" ::"n"(N) : "memory"); }
constexpr float LOG2E = 1.4426950408889634f;
__device__ __forceinline__ float fexp2(float x) { return __builtin_amdgcn_exp2f(x); }
typedef unsigned u32x2 __attribute__((ext_vector_type(2)));
__device__ __forceinline__ float rowmax4(float x) {
  u32x2 r = __builtin_amdgcn_permlane16_swap(__float_as_uint(x), __float_as_uint(x), false, false);
  x = fmaxf(__uint_as_float(r[0]), __uint_as_float(r[1]));
  r = __builtin_amdgcn_permlane32_swap(__float_as_uint(x), __float_as_uint(x), false, false);
  return fmaxf(__uint_as_float(r[0]), __uint_as_float(r[1]));
}
__device__ __forceinline__ float rowsum4(float x) {
  u32x2 r = __builtin_amdgcn_permlane16_swap(__float_as_uint(x), __float_as_uint(x), false, false);
  x = __uint_as_float(r[0]) + __uint_as_float(r[1]);
  r = __builtin_amdgcn_permlane32_swap(__float_as_uint(x), __float_as_uint(x), false, false);
  return __uint_as_float(r[0]) + __uint_as_float(r[1]);
}
template <int CTRL> __device__ __forceinline__ float dpp_f(float x) {
  return __builtin_bit_cast(float, __builtin_amdgcn_update_dpp(0, __builtin_bit_cast(int, x), CTRL, 0xf, 0xf, true));
}
__device__ __forceinline__ float wave_sum(float v) {
  v += dpp_f<0xB1>(v);
  v += dpp_f<0x4E>(v);
  v += dpp_f<0x141>(v);
  v += dpp_f<0x140>(v);
  return rowsum4(v);
}
__device__ __forceinline__ float wave_max(float v) {
  v = fmaxf(v, dpp_f<0xB1>(v));
  v = fmaxf(v, dpp_f<0x4E>(v));
  v = fmaxf(v, dpp_f<0x141>(v));
  v = fmaxf(v, dpp_f<0x140>(v));
  return rowmax4(v);
}
__device__ __forceinline__ float fast_exp2(float x) { return __builtin_amdgcn_exp2f(x); }
__device__ __forceinline__ float sigmoidf(float v) { return __builtin_amdgcn_rcpf(1.f + fast_exp2(-1.4426950408889634f * v)); }
__device__ __forceinline__ float siluf(float v) { return v * sigmoidf(v); }
__device__ __forceinline__ float logsigmoidf(float u) { return fminf(u, 0.f) - 0.6931471805599453f * __builtin_amdgcn_logf(1.f + fast_exp2(-1.4426950408889634f * fabsf(u))); }

__device__ __forceinline__ void fast_barrier(unsigned* bar, unsigned& round, int wvs) {
  asm volatile("s_waitcnt vmcnt(0) lgkmcnt(0)" ::: "memory");
  __syncthreads();
  round += 1;
  if (wvs == 0 && lane_id() == 0) {
    __builtin_amdgcn_fence(__ATOMIC_RELEASE, "agent");
    asm volatile("s_waitcnt vmcnt(0)" ::: "memory");
    const unsigned ngroups = gridDim.x >> 4;
    const unsigned old = __hip_atomic_fetch_add(bar + 64 + 64 * (blockIdx.x >> 4), 1u, __ATOMIC_RELAXED, __HIP_MEMORY_SCOPE_AGENT);
    if (old + 1 == round * 16u) __hip_atomic_fetch_add(bar, 1u, __ATOMIC_RELAXED, __HIP_MEMORY_SCOPE_AGENT);
    const unsigned target = round * ngroups;
    while (__hip_atomic_load(bar, __ATOMIC_RELAXED, __HIP_MEMORY_SCOPE_AGENT) < target) { }
    __builtin_amdgcn_fence(__ATOMIC_ACQUIRE, "agent");
    asm volatile("s_waitcnt vmcnt(0)" ::: "memory");
  }
  __syncthreads();
}

__device__ void ph_xh_rstd(const float* src, half_t* xh, float* rstd, int wvs) {
  const int tid_ = otid(wvs); const int lane = tid_ & 63, w = tid_ >> 6;
  constexpr int RW = 4;
  const int rstride = gridDim.x * NWAVES;
#pragma unroll 1
  for (int row0 = blockIdx.x * NWAVES + w; row0 < T_TOK; row0 += rstride * RW) {
    float4 v[RW][4];
#pragma unroll
    for (int r = 0; r < RW; ++r)
#pragma unroll
      for (int i = 0; i < 4; ++i) v[r][i] = ((const float4*)(src + (size_t)(row0 + r * rstride) * DM))[lane + 64 * i];
#pragma unroll
    for (int r = 0; r < RW; ++r) {
      const int row = row0 + r * rstride;
      half4* xr = (half4*)(xh + (size_t)row * DM);
      float ss = 0.f;
#pragma unroll
      for (int i = 0; i < 4; ++i) {
        const float4 t = v[r][i];
        ss += t.x * t.x + t.y * t.y + t.z * t.z + t.w * t.w;
        half4 hv; hv[0] = (half_t)t.x; hv[1] = (half_t)t.y; hv[2] = (half_t)t.z; hv[3] = (half_t)t.w;
        xr[lane + 64 * i] = hv;
      }
      ss = wave_sum(ss);
      if (lane == 0) rstd[row] = rsqrtf(ss * (1.f / DM) + EPS);
    }
  }
}
__device__ void ph_ropetab(const Params& P, int wvs) {
  const int tid = otid(wvs);
  const float inv = powf(10000.f, -(float)(2 * (tid & 31)) / 64.f);
  for (int idx = blockIdx.x * NTHREADS + tid; idx < T_TOK * 32; idx += gridDim.x * NTHREADS) {
    const int t = idx >> 5, i = idx & 31;
    const float ang = (float)P.pos[t] * inv;
    float s, c; sincosf(ang, &s, &c);
    P.ropetab[t * 64 + i] = c; P.ropetab[t * 64 + 32 + i] = s;
  }
}
__device__ __forceinline__ int orig_col(int n, int mode) {
  if (mode == 0) {
    if (n < 2048) return n;
    if (n < 3072) return n + 16;
    return -1;
  } else if (mode == 1) {
    if (n < 2560) return n;
    if (n < 3584) return n + 48;
    return -1;
  } else if (mode == 5) {
    return n < 48 ? 2560 + n : -1;
  }
  if (mode == 4) return n < 64 ? n : -1;
  if (mode == 6) return n < 16 ? 2048 + n : -1;
  return n;
}
__device__ void prep_wT(const float* W, int ldw, const float* gamma, half_t* Wt, int Npad, int K, int mode, float* sm, int wvs) {
  float(*tile)[65] = (float(*)[65])sm;
  const int tid = otid(wvs);
  const int ntn = Npad / 64, ntk = K / 64;
  for (int t = blockIdx.x; t < ntn * ntk; t += gridDim.x) {
    const int n0 = (t / ntk) * 64, k0 = (t % ntk) * 64;
    __syncthreads();
#pragma unroll
    for (int r = 0; r < 4096 / NTHREADS; ++r) {
      const int idx = tid + r * NTHREADS, kk = idx >> 6, nn = idx & 63;
      const int on = orig_col(n0 + nn, mode);
      float v = 0.f;
      if (on >= 0) { v = W[(size_t)(k0 + kk) * ldw + on]; if (gamma) v *= gamma[k0 + kk]; }
      tile[kk][nn] = v;
    }
    __syncthreads();
    {
      const int nn = tid >> 3, oct = tid & 7;
      half8 hv;
#pragma unroll
      for (int e = 0; e < 8; ++e) hv[e] = (half_t)tile[oct * 8 + e][nn];
      *(half8*)(Wt + (size_t)(n0 + nn) * K + k0 + oct * 8) = hv;
    }
  }
}

__device__ __forceinline__ void prep_strip(const float* W, int ldw, const float* gamma, half_t* Wt, int K, int mode, int n0, int k0, float* sm, int tid) {
  float(*tile)[260] = (float(*)[260])sm;
  __syncthreads();
#pragma unroll
  for (int r = 0; r < 8; ++r) {
    const int idx = tid + r * NTHREADS, kk = idx >> 6, n4 = (idx & 63) * 4;
    const int on = orig_col(n0 + n4, mode);
    f32x4 v = (f32x4){0.f, 0.f, 0.f, 0.f};
    if (on >= 0) { v = *(const f32x4*)(W + (size_t)(k0 + kk) * ldw + on); if (gamma) v *= gamma[k0 + kk]; }
    *(f32x4*)&tile[kk][n4] = v;
  }
  __syncthreads();
#pragma unroll
  for (int r = 0; r < 4; ++r) {
    const int idx = tid + r * NTHREADS, nn = idx & 255, oct = idx >> 8;
    half8 hv;
#pragma unroll
    for (int e = 0; e < 8; ++e) hv[e] = (half_t)tile[oct * 8 + e][nn];
    *(half8*)(Wt + (size_t)(n0 + nn) * K + k0 + oct * 8) = hv;
  }
}
__device__ void prep_weights(const Params& P, float* sm, int wvs) {
  const int tid = otid(wvs);
  constexpr int NJ = 8;
  const int nstr[NJ] = {(LD0 / 256) * (DM / 64), (DM / 256) * (DM / 64), (LD1 / 256) * (DM / 64), (DM / 256) * (DM / 64), 32, 32, 4, 4};
  int total = 0;
#pragma unroll
  for (int j = 0; j < NJ; ++j) total += nstr[j];
  for (int w = blockIdx.x; w < total; w += gridDim.x) {
    int j = 0, t = w;
#pragma unroll
    for (int jj = 0; jj < NJ - 1; ++jj) if (j == jj && t >= nstr[jj]) { t -= nstr[jj]; j = jj + 1; }
    const float* W; int ldw; const float* gamma; half_t* Wt; int K, mode;
    switch (j) {
      case 0: W = P.gla_w_in; ldw = GLA_IN; gamma = P.pre_norm; Wt = P.W0t; K = DM; mode = 0; break;
      case 1: W = P.gla_w_out; ldw = DM; gamma = nullptr; Wt = P.Wo0t; K = DM; mode = 2; break;
      case 2: W = P.nsa_w_in; ldw = NSA_IN; gamma = P.pre_norm + DM; Wt = P.W1t; K = DM; mode = 1; break;
      case 3: W = P.nsa_w_out; ldw = DM; gamma = nullptr; Wt = P.Wo1t; K = DM; mode = 2; break;
      case 4: W = P.ck_w1; ldw = 256; gamma = nullptr; Wt = P.cw1t; K = 2048; mode = 2; break;
      case 5: W = P.cv_w1; ldw = 256; gamma = nullptr; Wt = P.cw1t + 256 * 2048; K = 2048; mode = 2; break;
      case 6: W = P.ck_w2; ldw = 64; gamma = nullptr; Wt = P.cw2t; K = 256; mode = 4; break;
      default: W = P.cv_w2; ldw = 64; gamma = nullptr; Wt = P.cw2t + 256 * 256; K = 256; mode = 4; break;
    }
    const int nsk = K / 64;
    prep_strip(W, ldw, gamma, Wt, K, mode, (t / nsk) * 256, (t % nsk) * 64, sm, tid);
  }
}

__device__ void prep_cbias_part(const Params& P, int wvs) {
  for (int idx = blockIdx.x * NTHREADS + otid(wvs); idx < 2 * 32 * 256; idx += gridDim.x * NTHREADS) {
    const int j = idx & 255, ks = (idx >> 8) & 31, which = idx >> 13;
    const float* pe = which ? P.nsa_pe_v : P.nsa_pe_k;
    const float* w1 = which ? P.cv_w1 : P.ck_w1;
    float a = 0.f;
#pragma unroll 8
    for (int k = ks * 64; k < ks * 64 + 64; ++k) a += pe[k] * w1[(size_t)k * 256 + j];
    P.cbias_part[idx] = a;
  }
}
__device__ void prep_cbias_reduce(const Params& P, int wvs) {
  if (blockIdx.x < 2 && otid(wvs) < 256) {
    const int which = blockIdx.x, j = otid(wvs);
    float a = 0.f;
    for (int ks = 0; ks < 32; ++ks) a += P.cbias_part[(which * 32 + ks) * 256 + j];
    P.cbias[which * 256 + j] = a;
  }
}

namespace g8 {
constexpr int BK = 64, HALF = 128, HTB = HALF * BK * 2;
__device__ __forceinline__ int lds_byte(int r, int c) { const int st = (r >> 4) * 2 + (c >> 5), rr = r & 15, cc = c & 31, ob = rr * 64 + cc * 2; return st * 1024 + (ob ^ (((ob >> 9) & 1) << 5)); }
__device__ __forceinline__ void stage_rc(int b, int& R, int& C) { const int st = b / 1024, sb = b % 1024, swz = sb ^ (((sb >> 9) & 1) << 5); R = (st >> 1) * 16 + swz / 64; C = (st & 1) * 32 + (swz % 64) / 2; }
typedef f32x4 Acc[2][2][4][2];

struct SrcPlain8 {
  const half_t* A; int lda; const half_t* Bt; int K;
  __device__ __forceinline__ void get(int pm, int pn, const half_t*& Ag, const half_t*& Bg, size_t& a_rs, int& a_ks) const {
    Ag = A + (size_t)pm * 256 * lda; Bg = Bt + (size_t)pn * 256 * K; a_rs = lda; a_ks = 64;
  }
};
struct SrcCmp1_8 {
  const half_t* p1; const half_t* w1t;
  __device__ __forceinline__ void get(int pm, int pn, const half_t*& Ag, const half_t*& Bg, size_t& a_rs, int& a_ks) const {
    const int which = pm >> 5, bg = pm & 31, b = bg >> 2, g = bg & 3;
    Ag = p1 + (size_t)(b * SEQ) * LD1 + (which ? 1280 : 1024) + g * 64;
    Bg = w1t + (size_t)which * 256 * 2048; a_rs = (size_t)16 * LD1; a_ks = LD1;
  }
};
struct SrcCmp2_8 {
  const half_t* hid; const half_t* w2t;
  __device__ __forceinline__ void get(int pm, int pn, const half_t*& Ag, const half_t*& Bg, size_t& a_rs, int& a_ks) const {
    Ag = hid + (size_t)pm * 256 * 256; Bg = w2t + (size_t)(pm >> 5) * 256 * 256; a_rs = 256; a_ks = 64;
  }
};

__device__ __forceinline__ half8 pack8(const f32x4 a, const f32x4 b) {
  half8 h; h[0] = (half_t)a[0]; h[1] = (half_t)a[1]; h[2] = (half_t)a[2]; h[3] = (half_t)a[3]; h[4] = (half_t)b[0]; h[5] = (half_t)b[1]; h[6] = (half_t)b[2]; h[7] = (half_t)b[3];
  return h;
}
struct EpiStore8 {
  half_t* C; int ldc; const float* rowscale;
  __device__ __forceinline__ void operator()(const Acc& acc, int row0, int col0, int wr, int wc, int fr, int fq) const {
    float rs[2][4];
#pragma unroll
    for (int ai = 0; ai < 2; ++ai)
#pragma unroll
      for (int m = 0; m < 4; ++m) rs[ai][m] = rowscale ? rowscale[row0 + ai * 128 + wr * 64 + m * 16 + fr] : 1.f;
#pragma unroll
    for (int ai = 0; ai < 2; ++ai)
#pragma unroll
      for (int m = 0; m < 4; ++m) {
        const int tok = row0 + ai * 128 + wr * 64 + m * 16 + fr;
        const float s = rs[ai][m];
        half_t* rowp = C + (size_t)tok * ldc + col0 + 64 * wc + 8 * fq;
#pragma unroll
        for (int bj = 0; bj < 2; ++bj) *(half8*)(rowp + 32 * bj) = pack8(acc[ai][bj][m][0] * s, acc[ai][bj][m][1] * s);
      }
  }
};
struct EpiRope8 {
  half_t* C; int ldc; const float* rowscale; const float* ropetab;
  __device__ __forceinline__ void operator()(const Acc& acc, int row0, int col0, int wr, int wc, int fr, int fq) const {
    const int grp = (col0 >> 6) + wc;
    const bool is_q = grp < 16;
    const bool roped = is_q || (grp >= 16 && grp < 20) || (grp >= 24 && grp < 28) || (grp >= 32 && grp < 36);
    const float sc = is_q ? 0.125f * 1.4426950408889634f : 1.f;
    float s = rowscale[row0 + wr * 64 + fr];
    f32x4 cs[2], sn[2];
    if (roped) {
      const int tok0 = row0 + wr * 64 + fr;
#pragma unroll
      for (int n = 0; n < 2; ++n) { cs[n] = *(const f32x4*)(ropetab + (size_t)tok0 * 64 + 8 * fq + 4 * n); sn[n] = *(const f32x4*)(ropetab + (size_t)tok0 * 64 + 32 + 8 * fq + 4 * n); }
    }
#pragma unroll
    for (int i = 0; i < 8; ++i) {
        const int ai = i >> 2, m = i & 3;
        const int tok = row0 + ai * 128 + wr * 64 + m * 16 + fr;
        half_t* rowp = C + (size_t)tok * ldc + col0 + 64 * wc + 8 * fq;
        f32x4 o1[2], o2[2];
#pragma unroll
        for (int n = 0; n < 2; ++n) {
          const f32x4 x1 = acc[ai][0][m][n] * s, x2 = acc[ai][1][m][n] * s;
          if (roped) { o1[n] = (x1 * cs[n] - x2 * sn[n]) * sc; o2[n] = (x2 * cs[n] + x1 * sn[n]) * sc; }
          else { o1[n] = x1; o2[n] = x2; }
        }
        const half8 p1 = pack8(o1[0], o1[1]), p2 = pack8(o2[0], o2[1]);
        if (i + 1 < 8) {
          const int tokn = row0 + ((i + 1) >> 2) * 128 + wr * 64 + ((i + 1) & 3) * 16 + fr;
          s = rowscale[tokn];
          if (roped) {
#pragma unroll
            for (int n = 0; n < 2; ++n) { cs[n] = *(const f32x4*)(ropetab + (size_t)tokn * 64 + 8 * fq + 4 * n); sn[n] = *(const f32x4*)(ropetab + (size_t)tokn * 64 + 32 + 8 * fq + 4 * n); }
          }
        }
        *(half8*)(rowp) = p1;
        *(half8*)(rowp + 32) = p2;
    }
  }
};
struct EpiCmpHid8 {
  half_t* hid; const float* bias;
  __device__ __forceinline__ void operator()(const Acc& acc, int row0, int col0, int wr, int wc, int fr, int fq) const {
    const int which = row0 >> 13;
#pragma unroll
    for (int bj = 0; bj < 2; ++bj) {
      const int col = col0 + 64 * wc + 32 * bj + 8 * fq;
      const f32x4 b0 = *(const f32x4*)(bias + which * 256 + col), b1 = *(const f32x4*)(bias + which * 256 + col + 4);
#pragma unroll
      for (int ai = 0; ai < 2; ++ai)
#pragma unroll
        for (int m = 0; m < 4; ++m) {
          const int row = row0 + ai * 128 + wr * 64 + m * 16 + fr;
          f32x4 v0 = acc[ai][bj][m][0] + b0, v1 = acc[ai][bj][m][1] + b1;
#pragma unroll
          for (int e = 0; e < 4; ++e) { v0[e] = siluf(v0[e]); v1[e] = siluf(v1[e]); }
          *(half8*)(hid + (size_t)row * 256 + col) = pack8(v0, v1);
        }
    }
  }
};
struct EpiCmpOut8 {
  half_t* kcmp; half_t* vcmp; unsigned* kmaxc;
  __device__ __forceinline__ void operator()(const Acc& acc, int row0, int col0, int wr, int wc, int fr, int fq) const {
    if (wc != 0) return;
#pragma unroll
    for (int ai = 0; ai < 2; ++ai)
#pragma unroll
      for (int m = 0; m < 4; ++m) {
        const int row = row0 + ai * 128 + wr * 64 + m * 16 + fr;
        const int which = row >> 13, r = row & 8191;
        half_t* dst = (which ? vcmp : kcmp) + (size_t)r * 64 + 8 * fq;
        const bool dead = (r & 255) == 255;
        float ss = 0.f;
#pragma unroll
        for (int bj = 0; bj < 2; ++bj) {
          half8 hv = pack8(acc[ai][bj][m][0], acc[ai][bj][m][1]);
          if (dead) hv = (half8){(half_t)0.f, (half_t)0.f, (half_t)0.f, (half_t)0.f, (half_t)0.f, (half_t)0.f, (half_t)0.f, (half_t)0.f};
#pragma unroll
          for (int e = 0; e < 8; ++e) ss += (float)hv[e] * (float)hv[e];
          *(half8*)(dst + 32 * bj) = hv;
        }
        if (which == 0) {
          ss = rowsum4(ss);
          ss = wave_max(ss);
          if (lane_id() == 0) __hip_atomic_fetch_max(&kmaxc[r >> 8], __float_as_uint(ss), __ATOMIC_RELAXED, __HIP_MEMORY_SCOPE_AGENT);
        }
      }
  }
};

template <class Src, class Epi>
__device__ void gemm(const Src& src, int M, int N, int K, const Epi& epi, char* smem, int wvs) {
  const int tid = otid(wvs), wid = __builtin_amdgcn_readfirstlane(tid >> 6), lane = tid & 63, wr = wid >> 2, wc = wid & 3, fr = lane & 15, fq = lane >> 4;
  const int nM = M / 256, nN = N / 256, nwg = nM * nN, G = gridDim.x, nt = K / BK;
  int sr0, sc0, sr1, sc1;
  stage_rc(tid * 16, sr0, sc0); stage_rc(tid * 16 + 8192, sr1, sc1);
  const int a_base = lds_byte(wr * 64 + fr, fq * 8);
  int b_base = 65536 + lds_byte(wc * 32 + fr, fq * 8);
  asm volatile("" : "+v"(b_base));
#define SA8(b, h) (smem + ((b) * 2 + (h)) * HTB)
#define SB8(b, h) (smem + (4 + (b) * 2 + (h)) * HTB)
#define STAGE_A(P, h, kt) { const char* g_ = (const char*)(Ag + (size_t)(h) * 128 * lda + (size_t)(kt) * a_ks); \
    __builtin_amdgcn_global_load_lds((gbl_void*)(g_ + aob0), (lds_void*)((P) + wid * 1024), 16, 0, 0); \
    __builtin_amdgcn_global_load_lds((gbl_void*)(g_ + aob1), (lds_void*)((P) + 8192 + wid * 1024), 16, 0, 0); }
#define STAGE_B(P, h, kt) { const char* g_ = (const char*)(Bg + (size_t)(h) * 32 * K + (size_t)(kt) * 64);     \
    __builtin_amdgcn_global_load_lds((gbl_void*)(g_ + bob0), (lds_void*)((P) + wid * 1024), 16, 0, 0); \
    __builtin_amdgcn_global_load_lds((gbl_void*)(g_ + bob1), (lds_void*)((P) + 8192 + wid * 1024), 16, 0, 0); }
#define LDA8(dst, b, h) { _Pragma("unroll") for (int m = 0; m < 4; ++m) _Pragma("unroll") for (int k = 0; k < 2; ++k) dst[m][k] = *(const half8*)(SA8(b, h) + a_base + m * 2048 + k * 1024); }
#define LDB8(dst, b, h) { _Pragma("unroll") for (int n = 0; n < 2; ++n) _Pragma("unroll") for (int k = 0; k < 2; ++k) dst[n][k] = *(const half8*)(smem + ((b) * 2 + (h)) * HTB + b_base + n * 2048 + k * 1024); }
#define MMA8(ai, bj, At, Bx) { __builtin_amdgcn_s_setprio(1); \
    _Pragma("unroll") for (int m = 0; m < 4; ++m) _Pragma("unroll") for (int n = 0; n < 2; ++n) _Pragma("unroll") for (int k = 0; k < 2; ++k) \
      acc[ai][bj][m][n] = __builtin_amdgcn_mfma_f32_16x16x32_f16(Bx[n][k], At[m][k], acc[ai][bj][m][n], 0, 0, 0); \
    __builtin_amdgcn_s_setprio(0); }
#define WAIT_V(n) asm volatile("s_waitcnt vmcnt(" #n ")" ::: "memory")
#define WAIT_L(n) asm volatile("s_waitcnt lgkmcnt(" #n ")" ::: "memory")
#define BAR __builtin_amdgcn_s_barrier()
#define SCHED __builtin_amdgcn_sched_barrier(0)
  for (int it = 0;; ++it) {
    const int L = it * G + (int)blockIdx.x;
    if (L >= nwg) break;
    int wgid;
    { const int q = nwg / 8, r = nwg % 8, xcd = L % 8, off = L / 8; wgid = (xcd < r ? xcd * (q + 1) : r * (q + 1) + (xcd - r) * q) + off; }
    const int nig = 8 * nN, gid = wgid / nig, fm = gid * 8, gsz = (nM - fm) < 8 ? (nM - fm) : 8;
    const int pm = fm + ((wgid % nig) % gsz), pn = (wgid % nig) / gsz;
    const half_t* Ag; const half_t* Bg; size_t lda; int a_ks;
    src.get(pm, pn, Ag, Bg, lda, a_ks);
    const unsigned aob0 = (unsigned)(((size_t)sr0 * lda + sc0) * 2), aob1 = (unsigned)(((size_t)sr1 * lda + sc1) * 2);
    const int pr0 = 64 * (sr0 >> 5) + 8 * ((sr0 & 15) >> 2) + 4 * ((sr0 >> 4) & 1) + (sr0 & 3), pr1 = 64 * (sr1 >> 5) + 8 * ((sr1 & 15) >> 2) + 4 * ((sr1 >> 4) & 1) + (sr1 & 3);
    const unsigned bob0 = (unsigned)((pr0 * K + sc0) * 2), bob1 = (unsigned)((pr1 * K + sc1) * 2);
    Acc acc;
#pragma unroll
    for (int a = 0; a < 2; ++a)
#pragma unroll
      for (int b = 0; b < 2; ++b)
#pragma unroll
        for (int m = 0; m < 4; ++m)
#pragma unroll
          for (int n = 0; n < 2; ++n) acc[a][b][m][n] = (f32x4){0.f, 0.f, 0.f, 0.f};
    half8 At[4][2], B0[2][2], B1[2][2];
    STAGE_B(SB8(0, 0), 0, 0) STAGE_A(SA8(0, 0), 0, 0)
    STAGE_B(SB8(0, 1), 1, 0) STAGE_A(SA8(0, 1), 1, 0)
    if (wr == 1) BAR;
    WAIT_V(4); BAR;
    STAGE_B(SB8(1, 0), 0, 1) STAGE_A(SA8(1, 0), 0, 1) STAGE_B(SB8(1, 1), 1, 1)
    WAIT_V(6); BAR;
#pragma unroll 1
    for (int t = 0; t < nt - 2; t += 2) {
      LDB8(B0, 0, 0) SCHED; LDA8(At, 0, 0) STAGE_A(SA8(1, 1), 1, t + 1)
      WAIT_L(8); BAR; WAIT_L(0); MMA8(0, 0, At, B0) BAR; SCHED;
      LDB8(B1, 0, 1) STAGE_B(SB8(0, 0), 0, t + 2)
      BAR; WAIT_L(0); MMA8(0, 1, At, B1) BAR;
      LDA8(At, 0, 1) STAGE_A(SA8(0, 0), 0, t + 2)
      BAR; WAIT_L(0); MMA8(1, 0, At, B0) BAR; SCHED;
      STAGE_B(SB8(0, 1), 1, t + 2)
      WAIT_V(6); BAR; MMA8(1, 1, At, B1) BAR;
      LDB8(B0, 1, 0) SCHED; LDA8(At, 1, 0) STAGE_A(SA8(0, 1), 1, t + 2)
      WAIT_L(8); BAR; WAIT_L(0); MMA8(0, 0, At, B0) BAR; SCHED;
      LDB8(B1, 1, 1) STAGE_B(SB8(1, 0), 0, t + 3)
      BAR; WAIT_L(0); MMA8(0, 1, At, B1) BAR;
      LDA8(At, 1, 1) STAGE_A(SA8(1, 0), 0, t + 3)
      BAR; WAIT_L(0); MMA8(1, 0, At, B0) BAR; SCHED;
      STAGE_B(SB8(1, 1), 1, t + 3)
      WAIT_V(6); BAR; MMA8(1, 1, At, B1) BAR;
    }
    { LDB8(B0, 0, 0) LDA8(At, 0, 0) STAGE_A(SA8(1, 1), 1, nt - 1)
      BAR; WAIT_L(0); MMA8(0, 0, At, B0) BAR;
      LDB8(B1, 0, 1) BAR; WAIT_L(0); MMA8(0, 1, At, B1) BAR;
      LDA8(At, 0, 1) WAIT_V(4); BAR; WAIT_L(0); MMA8(1, 0, At, B0) MMA8(1, 1, At, B1) BAR; }
    { LDB8(B0, 1, 0) LDA8(At, 1, 0) WAIT_V(2); BAR; WAIT_L(0); MMA8(0, 0, At, B0) BAR;
      LDB8(B1, 1, 1) WAIT_V(0); BAR; WAIT_L(0); MMA8(0, 1, At, B1) BAR;
      LDA8(At, 1, 1) BAR; WAIT_L(0); MMA8(1, 0, At, B0) MMA8(1, 1, At, B1) BAR; }
    if (wr == 0) BAR;
    { int fr2 = fr, fq2 = fq; asm volatile("" : "+v"(fr2), "+v"(fq2)); epi(acc, pm * 256, pn * 256, wr, wc, fr2, fq2); }
  }
#undef SA8
#undef SB8
#undef STAGE_A
#undef STAGE_B
#undef LDA8
#undef LDB8
#undef MMA8
#undef WAIT_V
#undef WAIT_L
#undef BAR
#undef SCHED
}
}

struct GlaPrepOps { half8 q0, k0, q1, k1; float w[16]; float bb; };
__device__ void ph_gla_prep(const Params& P, float* sm, int wvs) {
  float(*glr)[16] = (float(*)[16])sm;
  float(*tot)[128] = (float(*)[128])(sm + 1024);
  float(*exl)[132] = (float(*)[132])(sm + 1536);
  const int tid = otid(wvs);
  const int tq = tid >> 7, c = tid & 127;
  const int tp = tid >> 4, co = tid & 15;
  const float scale = 0.08838834764831845f;
  const int nchunks = T_TOK / 64, G = gridDim.x;
  const int nj = (((nchunks - 1 - (int)blockIdx.x) / G) + 1) * 4;
  GlaPrepOps nxt; f32x4 gnx = {};
#define GLA_PREP_LOAD(j_) { const int chunk_ = (int)blockIdx.x + ((j_) >> 2) * G, h_ = (j_) & 3, ch_ = h_ * 128 + c; \
    const half_t* qp_ = P.p + (size_t)(chunk_ * 64 + 2 * tp) * LD0 + h_ * 128 + co * 8; \
    nxt.q0 = *(const half8*)(qp_); nxt.k0 = *(const half8*)(qp_ + 512); nxt.q1 = *(const half8*)(qp_ + LD0); nxt.k1 = *(const half8*)(qp_ + LD0 + 512); \
    _Pragma("unroll") for (int r = 0; r < 16; ++r) nxt.w[r] = P.gla_w_gk_up[r * 512 + ch_]; \
    nxt.bb = P.gla_b_gk[ch_]; \
    if (h_ == 0 && tid < 256) gnx = *(const f32x4*)(P.glr + (size_t)(chunk_ * 64) * 16 + tid * 4); }
  GLA_PREP_LOAD(0)
#pragma unroll 1
  for (int j = 0; j < nj; ++j) {
    const int chunk = (int)blockIdx.x + (j >> 2) * G, h = j & 3;
    const int t0 = chunk * 64, ch = h * 128 + c;
    const GlaPrepOps cur = nxt;
    __syncthreads();
    if (h == 0 && tid < 256) *(f32x4*)(sm + tid * 4) = gnx;
    if (j + 1 < nj) GLA_PREP_LOAD(j + 1)
    __syncthreads();
    float pre[16]; float cum = 0.f;
#pragma unroll
    for (int i = 0; i < 16; ++i) {
      float u = cur.bb;
#pragma unroll
      for (int r = 0; r < 16; ++r) u += glr[tq * 16 + i][r] * cur.w[r];
      cum += logsigmoidf(u) * (1.f / 16.f);
      pre[i] = cum;
    }
    tot[tq][c] = cum;
    __syncthreads();
    float off = 0.f;
#pragma unroll
    for (int t = 0; t < 3; ++t) if (t < tq) off += tot[t][c];
#pragma unroll
    for (int i = 0; i < 16; ++i) {
      const float ex = fast_exp2((pre[i] + off) * LOG2E);
      exl[tq * 16 + i][c] = ex;
      if (tq == 3 && i == 15) P.bcum[(size_t)chunk * 512 + ch] = ex;
    }
    __syncthreads();
    {
      half_t* qp = P.p + (size_t)(t0 + 2 * tp) * LD0 + h * 128 + co * 8;
      const f32x4 e00 = *(const f32x4*)&exl[2 * tp][co * 8], e01 = *(const f32x4*)&exl[2 * tp][co * 8 + 4];
      const f32x4 e10 = *(const f32x4*)&exl[2 * tp + 1][co * 8], e11 = *(const f32x4*)&exl[2 * tp + 1][co * 8 + 4];
      half8 oq0, ok0, oq1, ok1;
#pragma unroll
      for (int e = 0; e < 8; ++e) {
        const float x0 = e < 4 ? e00[e] : e01[e - 4], x1 = e < 4 ? e10[e] : e11[e - 4];
        oq0[e] = (half_t)((float)cur.q0[e] * scale * x0); ok0[e] = (half_t)((float)cur.k0[e] * __builtin_amdgcn_rcpf(x0));
        oq1[e] = (half_t)((float)cur.q1[e] * scale * x1); ok1[e] = (half_t)((float)cur.k1[e] * __builtin_amdgcn_rcpf(x1));
      }
      *(half8*)(qp) = oq0; *(half8*)(qp + 512) = ok0; *(half8*)(qp + LD0) = oq1; *(half8*)(qp + LD0 + 512) = ok1;
    }
  }
#undef GLA_PREP_LOAD
}

constexpr int GLA_QE = 0, GLA_KE = 16384, GLA_V = 32768, GLA_DEC = 49152, GLA_BUF = 53248;
#define GLA_TR4(d0, d1, d2, d3, addr, o0, o1, o2, o3) \
  asm volatile("ds_read_b64_tr_b16 %0, %4 offset:%5\n\tds_read_b64_tr_b16 %1, %4 offset:%6\n\tds_read_b64_tr_b16 %2, %4 offset:%7\n\tds_read_b64_tr_b16 %3, %4 offset:%8" \
               : "=&v"(d0), "=&v"(d1), "=&v"(d2), "=&v"(d3) : "v"(addr), "n"(o0), "n"(o1), "n"(o2), "n"(o3) : "memory")
__device__ __forceinline__ half8 pack_h8(const v2i a, const v2i b) { const v4i p = (v4i){a[0], a[1], b[0], b[1]}; return __builtin_bit_cast(half8, p); }

template <bool STATE_ONLY>
__device__ void ph_gla_mfma(const Params& P, char* smem, int wvs) {
  const int tid = otid(wvs);
  const int lane = tid & 63, wave = __builtin_amdgcn_readfirstlane(tid >> 6), r15 = lane & 15, q = lane >> 4;
  const int qp = r15 >> 2, pp = lane & 3;
  const int srow = tid >> 4, sslot = tid & 15;
  const int src_q = (sslot ^ (srow & 15)) * 8, src_kv = (sslot ^ ((srow & 7) << 1)) * 8;
  const int fk = ((4 * (q & 1) + qp) & 7) << 1;
  const unsigned tr_row = (unsigned)((4 * q + qp) * 256 + 8 * (pp & 1) + ((pp >> 1) << 4));
  constexpr int NLOAD = STATE_ONLY ? 5 : 7;
  for (int item = blockIdx.x; item < (STATE_ONLY ? 3 : 4) * 64; item += gridDim.x) {
    const int seg = item >> 6, base = item & 63, b = base >> 3, h = (base >> 1) & 3, vs = base & 1;
    const int c0 = seg * 16;
    f32x4 S[8], Dacc[8];
#pragma unroll
    for (int df = 0; df < 8; ++df) { S[df] = (f32x4){0.f, 0.f, 0.f, 0.f}; Dacc[df] = (f32x4){1.f, 1.f, 1.f, 1.f}; }
    f32x4* stL = (f32x4*)P.gla_state + ((size_t)base * 8 + wave) * 8 * 64 + lane;
    f32x4* stD = stL + (size_t)3 * 64 * 8 * 8 * 64;
    if (!STATE_ONLY) {
      for (int k = 0; k < seg; ++k) {
#pragma unroll
        for (int df = 0; df < 8; ++df) {
          const f32x4 Lk = stL[((size_t)k * 64 * 8 * 8 + df) * 64];
          if (k == 0) S[df] = Lk;
          else { const f32x4 Dk = stD[((size_t)k * 64 * 8 * 8 + df) * 64]; S[df] = Dk * S[df] + Lk; }
        }
      }
    }
    const half_t* qsrc = P.p + (size_t)(b * SEQ + srow) * LD0 + h * 128;
    const half_t* vsrc = P.p + (size_t)(b * SEQ + srow) * LD0 + 1024 + h * 256 + vs * 128 + src_kv;
    const float* dsrc = P.bcum + (size_t)(b * 64 + c0) * 512 + h * 128 + (lane & 31) * 4;
#define G_ISSUE(N, BUF) { char* lb_ = smem + (BUF) * GLA_BUF + wave * 1024; const size_t ro_ = (size_t)(c0 + (N)) * 64 * LD0; \
      if (!STATE_ONLY) { __builtin_amdgcn_global_load_lds((gbl_void*)(qsrc + ro_ + src_q), (lds_void*)(lb_ + GLA_QE), 16, 0, 0); \
      __builtin_amdgcn_global_load_lds((gbl_void*)(qsrc + ro_ + (size_t)32 * LD0 + src_q), (lds_void*)(lb_ + GLA_QE + 8192), 16, 0, 0); } \
      __builtin_amdgcn_global_load_lds((gbl_void*)(qsrc + ro_ + 512 + src_kv), (lds_void*)(lb_ + GLA_KE), 16, 0, 0); \
      __builtin_amdgcn_global_load_lds((gbl_void*)(qsrc + ro_ + (size_t)32 * LD0 + 512 + src_kv), (lds_void*)(lb_ + GLA_KE + 8192), 16, 0, 0); \
      __builtin_amdgcn_global_load_lds((gbl_void*)(vsrc + ro_), (lds_void*)(lb_ + GLA_V), 16, 0, 0); \
      __builtin_amdgcn_global_load_lds((gbl_void*)(vsrc + ro_ + (size_t)32 * LD0), (lds_void*)(lb_ + GLA_V + 8192), 16, 0, 0); \
      if (lane < 32) __builtin_amdgcn_global_load_lds((gbl_void*)(dsrc + (size_t)(N) * 512), (lds_void*)(smem + (BUF) * GLA_BUF + GLA_DEC + wave * 512), 16, 0, 0); }
    G_ISSUE(0, 0)
    G_ISSUE(1, 1)
#pragma unroll 1
    for (int n = 0; n < 16; ++n) {
      if (n + 1 < 16) wait_vmcnt<NLOAD>(); else wait_vmcnt<0>();
      __builtin_amdgcn_s_barrier();
      if (n + 2 < 16) G_ISSUE(n + 2, (n + 2) % 3)
      const char* cb = smem + (n % 3) * GLA_BUF;
      f32x4 aT[4][4];
      if (!STATE_ONLY) {
#pragma unroll
      for (int kf = 0; kf < 4; ++kf)
#pragma unroll
        for (int tf = 0; tf < 4; ++tf) aT[kf][tf] = (f32x4){0.f, 0.f, 0.f, 0.f};
#pragma unroll
      for (int ks = 0; ks < 4; ++ks) {
        half8 kef[4], qef[4];
#pragma unroll
        for (int f = 0; f < 4; ++f) {
          kef[f] = *(const half8*)(cb + GLA_KE + (16 * f + r15) * 256 + (((4 * ks + q) ^ ((r15 & 7) << 1)) << 4));
          qef[f] = *(const half8*)(cb + GLA_QE + (16 * f + r15) * 256 + (((4 * ks + q) ^ r15) << 4));
        }
#pragma unroll
        for (int kf = 0; kf < 4; ++kf)
#pragma unroll
          for (int tf = kf; tf < 4; ++tf) aT[kf][tf] = __builtin_amdgcn_mfma_f32_16x16x32_f16(kef[kf], qef[tf], aT[kf][tf], 0, 0, 0);
      }
#pragma unroll
      for (int f = 0; f < 4; ++f)
#pragma unroll
        for (int r = 0; r < 4; ++r) if (4 * q + r > r15) aT[f][f][r] = 0.f;
      }
      const unsigned lds0 = (unsigned)(size_t)cb;
      const unsigned va = lds0 + GLA_V + tr_row + ((((2 * wave) ^ fk)) << 4);
      v2i v00, v01, v10, v11;
      GLA_TR4(v00, v01, v10, v11, va, 0, 4096, 8192, 12288);
      const unsigned ka = lds0 + GLA_KE + tr_row;
      v2i k0[4][4];
#pragma unroll
      for (int df = 0; df < 4; ++df) { const unsigned a_ = ka + ((((2 * df) ^ fk)) << 4); GLA_TR4(k0[df][0], k0[df][1], k0[df][2], k0[df][3], a_, 0, 4096, 8192, 12288); }
      asm volatile("s_waitcnt lgkmcnt(15)" : "+v"(v00), "+v"(v01), "+v"(v10), "+v"(v11) :: "memory");
      __builtin_amdgcn_sched_barrier(0);
      half8 vf[2];
      vf[0] = pack_h8(v00, v01); vf[1] = pack_h8(v10, v11);
      if (!STATE_ONLY) {
      f32x4 o[4];
#pragma unroll
      for (int tf = 0; tf < 4; ++tf) o[tf] = (f32x4){0.f, 0.f, 0.f, 0.f};
#pragma unroll
      for (int ks2 = 0; ks2 < 2; ++ks2)
#pragma unroll
        for (int tf = 2 * ks2; tf < 4; ++tf) {
          half8 pk;
#pragma unroll
          for (int r = 0; r < 4; ++r) { pk[r] = (half_t)aT[2 * ks2][tf][r]; pk[4 + r] = (half_t)aT[2 * ks2 + 1][tf][r]; }
          o[tf] = __builtin_amdgcn_mfma_f32_16x16x32_f16(vf[ks2], pk, o[tf], 0, 0, 0);
        }
#pragma unroll
      for (int ks = 0; ks < 4; ++ks) {
        half8 sf;
#pragma unroll
        for (int r = 0; r < 4; ++r) { sf[r] = (half_t)S[2 * ks][r]; sf[4 + r] = (half_t)S[2 * ks + 1][r]; }
#pragma unroll
        for (int tf = 0; tf < 4; ++tf) {
          const int row = 16 * tf + r15;
          const half4 qa = *(const half4*)(cb + GLA_QE + row * 256 + (((4 * ks + (q >> 1)) ^ r15) << 4) + (q & 1) * 8);
          const half4 qb = *(const half4*)(cb + GLA_QE + row * 256 + (((4 * ks + 2 + (q >> 1)) ^ r15) << 4) + (q & 1) * 8);
          half8 qv;
#pragma unroll
          for (int e = 0; e < 4; ++e) { qv[e] = qa[e]; qv[4 + e] = qb[e]; }
          o[tf] = __builtin_amdgcn_mfma_f32_16x16x32_f16(sf, qv, o[tf], 0, 0, 0);
        }
      }
      {
        const size_t t0 = (size_t)(b * SEQ + (c0 + n) * 64);
#pragma unroll
        for (int tf = 0; tf < 4; ++tf) {
          half4 hv; hv[0] = (half_t)o[tf][0]; hv[1] = (half_t)o[tf][1]; hv[2] = (half_t)o[tf][2]; hv[3] = (half_t)o[tf][3];
          *(half4*)(P.og + (t0 + 16 * tf + r15) * DM + h * 256 + vs * 128 + 16 * wave + 4 * q) = hv;
        }
      }
      }
      v2i k1[4][4];
#pragma unroll
      for (int df = 0; df < 4; ++df) { const unsigned a_ = ka + ((((2 * (df + 4)) ^ fk)) << 4); GLA_TR4(k1[df][0], k1[df][1], k1[df][2], k1[df][3], a_, 0, 4096, 8192, 12288); }
      asm volatile("s_waitcnt lgkmcnt(15)"
                   : "+v"(k0[0][0]), "+v"(k0[0][1]), "+v"(k0[0][2]), "+v"(k0[0][3]), "+v"(k0[1][0]), "+v"(k0[1][1]), "+v"(k0[1][2]), "+v"(k0[1][3]),
                     "+v"(k0[2][0]), "+v"(k0[2][1]), "+v"(k0[2][2]), "+v"(k0[2][3]), "+v"(k0[3][0]), "+v"(k0[3][1]), "+v"(k0[3][2]), "+v"(k0[3][3]) :: "memory");
      __builtin_amdgcn_sched_barrier(0);
#pragma unroll
      for (int df = 0; df < 4; ++df) {
        S[df] = __builtin_amdgcn_mfma_f32_16x16x32_f16(pack_h8(k0[df][0], k0[df][1]), vf[0], S[df], 0, 0, 0);
        S[df] = __builtin_amdgcn_mfma_f32_16x16x32_f16(pack_h8(k0[df][2], k0[df][3]), vf[1], S[df], 0, 0, 0);
      }
      asm volatile("s_waitcnt lgkmcnt(0)"
                   : "+v"(k1[0][0]), "+v"(k1[0][1]), "+v"(k1[0][2]), "+v"(k1[0][3]), "+v"(k1[1][0]), "+v"(k1[1][1]), "+v"(k1[1][2]), "+v"(k1[1][3]),
                     "+v"(k1[2][0]), "+v"(k1[2][1]), "+v"(k1[2][2]), "+v"(k1[2][3]), "+v"(k1[3][0]), "+v"(k1[3][1]), "+v"(k1[3][2]), "+v"(k1[3][3]) :: "memory");
      __builtin_amdgcn_sched_barrier(0);
#pragma unroll
      for (int df = 0; df < 4; ++df) {
        S[df + 4] = __builtin_amdgcn_mfma_f32_16x16x32_f16(pack_h8(k1[df][0], k1[df][1]), vf[0], S[df + 4], 0, 0, 0);
        S[df + 4] = __builtin_amdgcn_mfma_f32_16x16x32_f16(pack_h8(k1[df][2], k1[df][3]), vf[1], S[df + 4], 0, 0, 0);
      }
#pragma unroll
      for (int df = 0; df < 8; ++df) {
        const f32x4 dc = *(const f32x4*)(cb + GLA_DEC + wave * 512 + (16 * df + 4 * q) * 4);
        S[df] *= dc;
        if (STATE_ONLY) Dacc[df] *= dc;
      }
    }
    if (STATE_ONLY) {
#pragma unroll
      for (int df = 0; df < 8; ++df) { stL[((size_t)seg * 64 * 8 * 8 + df) * 64] = S[df]; stD[((size_t)seg * 64 * 8 * 8 + df) * 64] = Dacc[df]; }
    }
    asm volatile("s_waitcnt vmcnt(0)" ::: "memory");
    __builtin_amdgcn_s_barrier();
#undef G_ISSUE
  }
}

__device__ void ph_gla_post(const Params& P, int wvs) {
  const int tid_ = otid(wvs); const int lane = tid_ & 63, sub = lane & 31;
  const int u0 = blockIdx.x * 16 + (tid_ >> 5);
  const float4 hn0 = ((const float4*)P.gla_head_norm)[sub * 2], hn1 = ((const float4*)P.gla_head_norm)[sub * 2 + 1];
  constexpr int UW = 4;
  const int ustride = gridDim.x * 16;
#pragma unroll 1
  for (int ub = u0; ub < T_TOK * 4; ub += ustride * UW) {
    half8 hv[UW], z[UW];
#pragma unroll
    for (int r = 0; r < UW; ++r) {
      const int u = ub + r * ustride, t = u >> 2, h = u & 3;
      hv[r] = *((const half8*)(P.og + (size_t)t * DM + h * 256) + sub);
      z[r] = *((const half8*)(P.p + (size_t)t * LD0 + 2048 + h * 256) + sub);
    }
#pragma unroll
    for (int r = 0; r < UW; ++r) {
      const int u = ub + r * ustride, t = u >> 2, h = u & 3;
      float v[8]; float ss = 0.f;
#pragma unroll
      for (int e = 0; e < 8; ++e) { v[e] = (float)hv[r][e]; ss += v[e] * v[e]; }
#pragma unroll
      for (int o = 16; o > 0; o >>= 1) ss += __shfl_xor(ss, o);
      const float rr = rsqrtf(ss * (1.f / 256.f) + EPS);
      const float hn[8] = {hn0.x, hn0.y, hn0.z, hn0.w, hn1.x, hn1.y, hn1.z, hn1.w};
      half8 o;
#pragma unroll
      for (int e = 0; e < 8; ++e) o[e] = (half_t)(v[e] * rr * hn[e] * siluf((float)z[r][e]));
      *((half8*)(P.og + (size_t)t * DM + h * 256) + sub) = o;
    }
  }
}

template <bool FINAL>
__device__ void ph_post(const half_t* baseh, const half_t* y, const float* g, float* dst, half_t* dsth, float* rstd_out, int wvs) {
  const int tid_ = otid(wvs); const int lane = tid_ & 63, w = tid_ >> 6;
  constexpr int RW = 4;
  const int rstride = gridDim.x * NWAVES;
#pragma unroll 1
  for (int row0 = blockIdx.x * NWAVES + w; row0 < T_TOK; row0 += rstride * RW) {
    half4 yv[RW][4], bv[RW][4];
#pragma unroll
    for (int r = 0; r < RW; ++r)
#pragma unroll
      for (int i = 0; i < 4; ++i) yv[r][i] = ((const half4*)(y + (size_t)(row0 + r * rstride) * DM))[lane + 64 * i];
#pragma unroll
    for (int r = 0; r < RW; ++r)
#pragma unroll
      for (int i = 0; i < 4; ++i) bv[r][i] = ((const half4*)(baseh + (size_t)(row0 + r * rstride) * DM))[lane + 64 * i];
#pragma unroll
    for (int r = 0; r < RW; ++r) {
      const int row = row0 + r * rstride;
      float ss = 0.f;
#pragma unroll
      for (int i = 0; i < 4; ++i)
#pragma unroll
        for (int e = 0; e < 4; ++e) { const float t = (float)yv[r][i][e]; ss += t * t; }
      ss = wave_sum(ss);
      const float rr = rsqrtf(ss * (1.f / DM) + EPS);
      float s2 = 0.f;
#pragma unroll
      for (int i = 0; i < 4; ++i) {
        const float4 gg = ((const float4*)g)[lane + 64 * i];
        float4 o;
        o.x = (float)bv[r][i][0] + (float)yv[r][i][0] * rr * gg.x; o.y = (float)bv[r][i][1] + (float)yv[r][i][1] * rr * gg.y;
        o.z = (float)bv[r][i][2] + (float)yv[r][i][2] * rr * gg.z; o.w = (float)bv[r][i][3] + (float)yv[r][i][3] * rr * gg.w;
        if (FINAL) ((float4*)(dst + (size_t)row * DM))[lane + 64 * i] = o;
        else {
          s2 += o.x * o.x + o.y * o.y + o.z * o.z + o.w * o.w;
          half4 hv; hv[0] = (half_t)o.x; hv[1] = (half_t)o.y; hv[2] = (half_t)o.z; hv[3] = (half_t)o.w;
          ((half4*)(dsth + (size_t)row * DM))[lane + 64 * i] = hv;
        }
      }
      if (!FINAL) { s2 = wave_sum(s2); if (lane == 0) rstd_out[row] = rsqrtf(s2 * (1.f / DM) + EPS); }
    }
  }
}

template <int NF>
__device__ void ph_rowproj(const Params& P, const half_t* Wt, float* out, char* smem, int wvs, int first_block) {
  const int tid = otid(wvs), lane = tid & 63, wave = tid >> 6, r15 = lane & 15, q = lane >> 4;
  const int nb = gridDim.x - first_block;
  if ((int)blockIdx.x < first_block) return;
  __syncthreads();
  for (int c = tid; c < 16 * NF * 128; c += NTHREADS) {
    const int row = c >> 7, ch = c & 127;
    *(uint4*)(smem + row * 2064 + ch * 16) = *(const uint4*)(Wt + (size_t)row * DM + ch * 8);
  }
  __syncthreads();
  for (int tile = (int)blockIdx.x - first_block; tile < T_TOK / 128; tile += nb) {
    const int tok = tile * 128 + wave * 16 + r15;
    const half_t* ap = P.xh + (size_t)tok * DM + 8 * q;
    const char* bp = smem + r15 * 2064 + 16 * q;
    f32x4 acc[NF];
#pragma unroll
    for (int n = 0; n < NF; ++n) acc[n] = (f32x4){0.f, 0.f, 0.f, 0.f};
#pragma unroll 1
    for (int s0 = 0; s0 < 32; s0 += 16) {
      half8 a[16];
#pragma unroll
      for (int i = 0; i < 16; ++i) a[i] = *(const half8*)(ap + 32 * (s0 + i));
#pragma unroll
      for (int i = 0; i < 16; ++i) {
#pragma unroll
        for (int n = 0; n < NF; ++n) {
          const half8 bw = *(const half8*)(bp + n * 16 * 2064 + (s0 + i) * 64);
          acc[n] = __builtin_amdgcn_mfma_f32_16x16x32_f16(bw, a[i], acc[n], 0, 0, 0);
        }
      }
    }
    const float rs = P.rstd[tok];
#pragma unroll
    for (int n = 0; n < NF; ++n) *(f32x4*)(out + (size_t)tok * (16 * NF) + 16 * n + 4 * q) = acc[n] * rs;
  }
  __syncthreads();
}

__device__ void ph_kmax(const Params& P, int wvs, int first_block) {
  const int tid = otid(wvs);
  for (int task = (int)blockIdx.x - first_block; task < NBATCH * 4 * 2 * 8; task += gridDim.x - first_block) {
    const int chunk = task & 7, br = (task >> 3) & 1, bg = task >> 4, b = bg >> 2, g = bg & 3;
    const half_t* kp = P.p + (size_t)(b * SEQ + chunk * 512 + tid) * LD1 + (br ? 2048 : 1536) + g * 64;
    float ss = 0.f;
#pragma unroll
    for (int c = 0; c < 8; ++c) {
      const half8 v = *(const half8*)(kp + c * 8);
#pragma unroll
      for (int e = 0; e < 8; ++e) ss += (float)v[e] * (float)v[e];
    }
    ss = wave_max(ss);
    if ((tid & 63) == 0) __hip_atomic_fetch_max(&P.kmax2[bg * 2 + br], __float_as_uint(ss), __ATOMIC_RELAXED, __HIP_MEMORY_SCOPE_AGENT);
  }
}

constexpr int ATT_NB = 6, ATT_D = 5;
constexpr int ATT_K = 0, ATT_V = ATT_NB * 8192, ATT_Z = 2 * ATT_NB * 8192, ATT_IMP = ATT_Z + 32768, ATT_SELM = ATT_IMP + 64 * 68 * 4;
constexpr int IMPS = 68;
constexpr int ATT_GATE = ATT_SELM + 512;

__device__ __forceinline__ void attn_issue(char* smem, const half_t* kbase, const half_t* vbase, int ld, int tile_lo, int tile_hi, int wvs, int rot = 0) {
  const int tid = otid(wvs);
  const int lrow = tid >> 3, lch = tid & 7;
  const int ksrc = (lch ^ ((lrow >> 1) & 7)) * 8, vsrc = (lch ^ (((lrow >> 1) & 3) << 1)) * 8;
  const int wbase = __builtin_amdgcn_readfirstlane(tid >> 6) * 1024;
#pragma unroll
  for (int i = 0; i < ATT_D; ++i) if (tile_lo + i <= tile_hi) {
    const int nt_ = tile_hi - tile_lo + 1, tr_ = tile_lo + ((rot + i >= nt_) ? rot + i - nt_ : rot + i);
    const half_t* kp_ = kbase + (size_t)(tr_ * 64 + lrow) * ld + ksrc;
    const half_t* vp_ = vbase + (size_t)(tr_ * 64 + lrow) * ld + vsrc;
    __builtin_amdgcn_global_load_lds((gbl_void*)kp_, (lds_void*)(smem + ATT_K + i * 8192 + wbase), 16, 0, 0);
    __builtin_amdgcn_global_load_lds((gbl_void*)vp_, (lds_void*)(smem + ATT_V + i * 8192 + wbase), 16, 0, 0);
  }
}

template <int MODE, bool PREISSUED = false>
__device__ __forceinline__ void attn_branch(char* smem, const half_t* kbase, const half_t* vbase, int ld, int tile_lo, int tile_hi, int n, int th,
                                            const half8 (&qf)[2][2], float (&m)[2], float (&l)[2], f32x4 (&o)[4][2],
                                            const unsigned long long (&selm)[2], int wvs) {
  const int tid = otid(wvs);
  const int lane = tid & 63, r15 = lane & 15, q = lane >> 4;
  const int lrow = tid >> 3, lch = tid & 7;
  const int k_rd = r15 * 128, kswz = r15 >> 1;
  const int qp = r15 >> 2, pp = lane & 3;
  const int fx = ((2 * q + (qp >> 1)) & 3) << 1;
  const int v_rd = (4 * q + qp) * 128 + 8 * (pp & 1) + ((pp >> 1) << 4);
  unsigned int* impu = (unsigned int*)(smem + ATT_IMP);
  const int ksrc = (lch ^ ((lrow >> 1) & 7)) * 8, vsrc = (lch ^ (((lrow >> 1) & 3) << 1)) * 8;
  const int wbase = __builtin_amdgcn_readfirstlane(tid >> 6) * 1024;
#define A_GLOAD(TI, BUF) { const half_t* kp_ = kbase + (size_t)((TI) * 64 + lrow) * ld + ksrc; \
    __builtin_amdgcn_global_load_lds((gbl_void*)kp_, (lds_void*)(smem + ATT_K + (BUF) * 8192 + wbase), 16, 0, 0); \
    { const half_t* vp_ = vbase + (size_t)((TI) * 64 + lrow) * ld + vsrc; \
      __builtin_amdgcn_global_load_lds((gbl_void*)vp_, (lds_void*)(smem + ATT_V + (BUF) * 8192 + wbase), 16, 0, 0); } }
  constexpr int GPT = 2;
  f32x4 lacc[2] = {(f32x4){0.f, 0.f, 0.f, 0.f}, (f32x4){0.f, 0.f, 0.f, 0.f}};
  if (MODE != 1 && !PREISSUED) {
#pragma unroll
    for (int i = 0; i < ATT_D; ++i) if (tile_lo + i <= tile_hi) A_GLOAD(tile_lo + i, i)
  }
#pragma unroll 1
  for (int ti = tile_lo; ti <= tile_hi; ++ti) {
    const int it = ti - tile_lo, cur = it % ATT_NB;
    if (MODE != 1) {
      const int rem = tile_hi - ti;
      if (rem >= 4) wait_vmcnt<4 * GPT>(); else if (rem == 3) wait_vmcnt<3 * GPT>(); else if (rem == 2) wait_vmcnt<2 * GPT>();
      else if (rem == 1) wait_vmcnt<1 * GPT>(); else wait_vmcnt<0>();
    }
    __builtin_amdgcn_s_barrier();
    if (MODE != 1) { if (ti + ATT_D <= tile_hi) A_GLOAD(ti + ATT_D, (it + ATT_D) % ATT_NB) }
    const char* kb = smem + ATT_K + cur * 8192 + k_rd;
    const unsigned vbl = (unsigned)(size_t)(smem + ATT_V + cur * 8192 + v_rd);
    bool need_mask;
    if (MODE <= 1) need_mask = (ti * 64 + 63 > 4 * n - 2);
    else if (MODE == 2) need_mask = (ti == n);
    else need_mask = (ti == n) || (ti == n - 8);
    f32x4 s[4][2];
#pragma unroll
    for (int t2 = 0; t2 < 2; ++t2) {
      float c0 = 0.f;
      if (MODE >= 2) { c0 = -m[t2]; if (MODE == 2 && !((selm[t2] >> ti) & 1ull)) c0 = -INFINITY; }
#pragma unroll
      for (int kf = 0; kf < 4; ++kf) s[kf][t2] = (f32x4){c0, c0, c0, c0};
    }
#pragma unroll
    for (int ks = 0; ks < 2; ++ks) {
      const int co = ((4 * ks + q) ^ kswz) << 4;
#pragma unroll
      for (int kf = 0; kf < 4; ++kf) {
        const half8 kfr = *(const half8*)(kb + kf * 2048 + co);
#pragma unroll
        for (int t2 = 0; t2 < 2; ++t2) s[kf][t2] = __builtin_amdgcn_mfma_f32_16x16x32_f16(kfr, qf[t2][ks], s[kf][t2], 0, 0, 0);
      }
    }
    v2i vr[4][4];
    if (MODE != 0) {
      const unsigned va0 = vbl + (((0) ^ fx) << 4), va1 = vbl + (((2) ^ fx) << 4), va2 = vbl + (((4) ^ fx) << 4), va3 = vbl + (((6) ^ fx) << 4);
      asm volatile(
          "ds_read_b64_tr_b16 %0, %16\n\tds_read_b64_tr_b16 %1, %16 offset:2048\n\tds_read_b64_tr_b16 %2, %16 offset:4096\n\tds_read_b64_tr_b16 %3, %16 offset:6144\n\t"
          "ds_read_b64_tr_b16 %4, %17\n\tds_read_b64_tr_b16 %5, %17 offset:2048\n\tds_read_b64_tr_b16 %6, %17 offset:4096\n\tds_read_b64_tr_b16 %7, %17 offset:6144\n\t"
          "ds_read_b64_tr_b16 %8, %18\n\tds_read_b64_tr_b16 %9, %18 offset:2048\n\tds_read_b64_tr_b16 %10, %18 offset:4096\n\tds_read_b64_tr_b16 %11, %18 offset:6144\n\t"
          "ds_read_b64_tr_b16 %12, %19\n\tds_read_b64_tr_b16 %13, %19 offset:2048\n\tds_read_b64_tr_b16 %14, %19 offset:4096\n\tds_read_b64_tr_b16 %15, %19 offset:6144"
          : "=&v"(vr[0][0]), "=&v"(vr[0][1]), "=&v"(vr[0][2]), "=&v"(vr[0][3]), "=&v"(vr[1][0]), "=&v"(vr[1][1]), "=&v"(vr[1][2]), "=&v"(vr[1][3]),
            "=&v"(vr[2][0]), "=&v"(vr[2][1]), "=&v"(vr[2][2]), "=&v"(vr[2][3]), "=&v"(vr[3][0]), "=&v"(vr[3][1]), "=&v"(vr[3][2]), "=&v"(vr[3][3])
          : "v"(va0), "v"(va1), "v"(va2), "v"(va3)
          : "memory");
    }
    if (need_mask) {
#pragma unroll
      for (int t2 = 0; t2 < 2; ++t2) {
        const int tok = th * 32 + t2 * 16 + r15;
        int lo = 0, hi = 63;
        if (MODE <= 1) { hi = 4 * n + ((tok - 31) >> 4) - ti * 64; }
        else if (MODE == 2) { hi = tok; }
        else { if (ti == n) hi = tok; else lo = tok + 1; }
#pragma unroll
        for (int kf = 0; kf < 4; ++kf)
#pragma unroll
          for (int r = 0; r < 4; ++r) {
            const int kk = kf * 16 + 4 * q + r;
            if (kk < lo || kk > hi) s[kf][t2][r] = -INFINITY;
          }
      }
    }
    half8 pf[2][2];
#pragma unroll
    for (int t2 = 0; t2 < 2; ++t2) {
      float mb = 0.f, scale_p = 1.f;
      if (MODE == 1) {
        mb = m[t2]; scale_p = l[t2];
      } else if (MODE == 0) {
        float tm = s[0][t2][0];
#pragma unroll
        for (int kf = 0; kf < 4; ++kf)
#pragma unroll
          for (int r = 0; r < 4; ++r) tm = fmaxf(tm, s[kf][t2][r]);
        tm = rowmax4(tm);
        const float mn = fmaxf(m[t2], tm);
        const float alpha = fexp2(m[t2] - mn);
        m[t2] = mn; mb = mn;
        l[t2] *= alpha;
      }
      float lsum = 0.f;
#pragma unroll
      for (int kf = 0; kf < 4; ++kf) {
#pragma unroll
        for (int r = 0; r < 4; ++r) {
          float pv = (MODE >= 2) ? fexp2(s[kf][t2][r]) : fexp2(s[kf][t2][r] - mb);
          if (MODE == 1) pv *= scale_p;
          s[kf][t2][r] = pv; if (MODE == 0) lsum += pv;
        }
      }
      if (MODE == 0) l[t2] += lsum;
      if (MODE == 1) {
        const int tok = th * 32 + t2 * 16 + r15;
#pragma unroll
        for (int kf = 0; kf < 4; ++kf) {
          const int j = 16 * ti + 4 * kf + q;
          const unsigned int u0 = (unsigned int)(s[kf][t2][0] * 134217728.f + 0.5f), u1 = (unsigned int)(s[kf][t2][1] * 134217728.f + 0.5f);
          const unsigned int u2 = (unsigned int)(s[kf][t2][2] * 134217728.f + 0.5f), u3 = (unsigned int)(s[kf][t2][3] * 134217728.f + 0.5f);
          if (j < 64) {
            atomicAdd(&impu[tok * IMPS + j], u0 + u1 + u2 + u3);
            atomicAdd(&impu[tok * IMPS + j + 1], u3);
          }
        }
      }
      if (MODE != 0) {
#pragma unroll
        for (int ks = 0; ks < 2; ++ks) {
          half8 pk;
#pragma unroll
          for (int r = 0; r < 4; ++r) { pk[r] = (half_t)s[2 * ks][t2][r]; pk[4 + r] = (half_t)s[2 * ks + 1][t2][r]; }
          pf[t2][ks] = pk;
        }
      }
    }
    if (MODE != 0) {
      asm volatile("s_waitcnt lgkmcnt(0)"
                   : "+v"(vr[0][0]), "+v"(vr[0][1]), "+v"(vr[0][2]), "+v"(vr[0][3]), "+v"(vr[1][0]), "+v"(vr[1][1]), "+v"(vr[1][2]), "+v"(vr[1][3]),
                     "+v"(vr[2][0]), "+v"(vr[2][1]), "+v"(vr[2][2]), "+v"(vr[2][3]), "+v"(vr[3][0]), "+v"(vr[3][1]), "+v"(vr[3][2]), "+v"(vr[3][3])
                   :: "memory");
      __builtin_amdgcn_sched_barrier(0);
#pragma unroll
      for (int df = 0; df < 4; ++df) {
#pragma unroll
        for (int ks = 0; ks < 2; ++ks) {
          const v2i lo2 = vr[df][2 * ks], hi2 = vr[df][2 * ks + 1];
          const v4i pk4 = (v4i){lo2[0], lo2[1], hi2[0], hi2[1]};
          const half8 vf = __builtin_bit_cast(half8, pk4);
#pragma unroll
          for (int t2 = 0; t2 < 2; ++t2) o[df][t2] = __builtin_amdgcn_mfma_f32_16x16x32_f16(vf, pf[t2][ks], o[df][t2], 0, 0, 0);
        }
      }
      if (MODE >= 2) {
        const half8 ones = (half8){(half_t)1.f, (half_t)1.f, (half_t)1.f, (half_t)1.f, (half_t)1.f, (half_t)1.f, (half_t)1.f, (half_t)1.f};
#pragma unroll
        for (int ks = 0; ks < 2; ++ks)
#pragma unroll
          for (int t2 = 0; t2 < 2; ++t2) lacc[t2] = __builtin_amdgcn_mfma_f32_16x16x32_f16(ones, pf[t2][ks], lacc[t2], 0, 0, 0);
      }
    }
  }
  if (MODE >= 2) { l[0] = lacc[0][0]; l[1] = lacc[1][0]; }
  __syncthreads();
#undef A_GLOAD
}

__device__ __forceinline__ void attn_cmp(char* smem, int tile_hi, int n, int th, const half8 (&qf)[2][2], const float (&moff)[2], f32x4 (&o)[4][2], int wvs) {
  const int tid = otid(wvs);
  const int lane = tid & 63, r15 = lane & 15, q = lane >> 4;
  const int k_rd = r15 * 128, kswz = r15 >> 1;
  const int qp = r15 >> 2, pp = lane & 3;
  const int fx = ((2 * q + (qp >> 1)) & 3) << 1;
  const int v_rd = (4 * q + qp) * 128 + 8 * (pp & 1) + ((pp >> 1) << 4);
  unsigned int* impu = (unsigned int*)(smem + ATT_IMP);
  float lsum[2] = {0.f, 0.f};
  float usum[4][4][2], carry[2] = {0.f, 0.f};
#pragma unroll
  for (int ti = 0; ti < 4; ++ti) {
    if (ti <= tile_hi) {
      const int rem = tile_hi - ti;
      if (rem >= 3) wait_vmcnt<6>(); else if (rem == 2) wait_vmcnt<4>(); else if (rem == 1) wait_vmcnt<2>(); else wait_vmcnt<0>();
      __builtin_amdgcn_s_barrier();
      const char* kb = smem + ATT_K + ti * 8192 + k_rd;
      const unsigned vbl = (unsigned)(size_t)(smem + ATT_V + ti * 8192 + v_rd);
      f32x4 s[4][2];
#pragma unroll
      for (int t2 = 0; t2 < 2; ++t2) {
        const float c0 = -moff[t2];
#pragma unroll
        for (int kf = 0; kf < 4; ++kf) s[kf][t2] = (f32x4){c0, c0, c0, c0};
      }
#pragma unroll
      for (int ks = 0; ks < 2; ++ks) {
        const int co = ((4 * ks + q) ^ kswz) << 4;
#pragma unroll
        for (int kf = 0; kf < 4; ++kf) {
          const half8 kfr = *(const half8*)(kb + kf * 2048 + co);
#pragma unroll
          for (int t2 = 0; t2 < 2; ++t2) s[kf][t2] = __builtin_amdgcn_mfma_f32_16x16x32_f16(kfr, qf[t2][ks], s[kf][t2], 0, 0, 0);
        }
      }
      if (ti * 64 + 63 > 4 * n - 2) {
#pragma unroll
        for (int t2 = 0; t2 < 2; ++t2) {
          const int tok = th * 32 + t2 * 16 + r15;
          const int hi = 4 * n + ((tok - 31) >> 4) - ti * 64;
#pragma unroll
          for (int kf = 0; kf < 4; ++kf)
#pragma unroll
            for (int r = 0; r < 4; ++r) if (kf * 16 + 4 * q + r > hi) s[kf][t2][r] = -INFINITY;
        }
      }
      half8 pf[2][2];
#pragma unroll
      for (int t2 = 0; t2 < 2; ++t2) {
        float sh[4];
#pragma unroll
        for (int kf = 0; kf < 4; ++kf) {
#pragma unroll
          for (int r = 0; r < 4; ++r) s[kf][t2][r] = fexp2(s[kf][t2][r]);
          sh[kf] = __shfl(s[kf][t2][3], (lane + 48) & 63);
        }
#pragma unroll
        for (int kf = 0; kf < 4; ++kf) {
          const float u = (s[kf][t2][0] + s[kf][t2][1]) + (s[kf][t2][2] + s[kf][t2][3]);
          const float prev = q > 0 ? sh[kf] : (kf > 0 ? sh[kf - 1] : carry[t2]);
          usum[ti][kf][t2] = u + prev;
          lsum[t2] += u;
        }
        carry[t2] = sh[3];
#pragma unroll
        for (int ks = 0; ks < 2; ++ks) {
          half8 pk;
#pragma unroll
          for (int r = 0; r < 4; ++r) { pk[r] = (half_t)s[2 * ks][t2][r]; pk[4 + r] = (half_t)s[2 * ks + 1][t2][r]; }
          pf[t2][ks] = pk;
        }
      }
      v2i vr[4][4];
      {
        const unsigned va0 = vbl + (((0) ^ fx) << 4), va1 = vbl + (((2) ^ fx) << 4), va2 = vbl + (((4) ^ fx) << 4), va3 = vbl + (((6) ^ fx) << 4);
        asm volatile(
            "ds_read_b64_tr_b16 %0, %16\n\tds_read_b64_tr_b16 %1, %16 offset:2048\n\tds_read_b64_tr_b16 %2, %16 offset:4096\n\tds_read_b64_tr_b16 %3, %16 offset:6144\n\t"
            "ds_read_b64_tr_b16 %4, %17\n\tds_read_b64_tr_b16 %5, %17 offset:2048\n\tds_read_b64_tr_b16 %6, %17 offset:4096\n\tds_read_b64_tr_b16 %7, %17 offset:6144\n\t"
            "ds_read_b64_tr_b16 %8, %18\n\tds_read_b64_tr_b16 %9, %18 offset:2048\n\tds_read_b64_tr_b16 %10, %18 offset:4096\n\tds_read_b64_tr_b16 %11, %18 offset:6144\n\t"
            "ds_read_b64_tr_b16 %12, %19\n\tds_read_b64_tr_b16 %13, %19 offset:2048\n\tds_read_b64_tr_b16 %14, %19 offset:4096\n\tds_read_b64_tr_b16 %15, %19 offset:6144"
            : "=&v"(vr[0][0]), "=&v"(vr[0][1]), "=&v"(vr[0][2]), "=&v"(vr[0][3]), "=&v"(vr[1][0]), "=&v"(vr[1][1]), "=&v"(vr[1][2]), "=&v"(vr[1][3]),
              "=&v"(vr[2][0]), "=&v"(vr[2][1]), "=&v"(vr[2][2]), "=&v"(vr[2][3]), "=&v"(vr[3][0]), "=&v"(vr[3][1]), "=&v"(vr[3][2]), "=&v"(vr[3][3])
            : "v"(va0), "v"(va1), "v"(va2), "v"(va3)
            : "memory");
      }
      asm volatile("s_waitcnt lgkmcnt(0)"
                   : "+v"(vr[0][0]), "+v"(vr[0][1]), "+v"(vr[0][2]), "+v"(vr[0][3]), "+v"(vr[1][0]), "+v"(vr[1][1]), "+v"(vr[1][2]), "+v"(vr[1][3]),
                     "+v"(vr[2][0]), "+v"(vr[2][1]), "+v"(vr[2][2]), "+v"(vr[2][3]), "+v"(vr[3][0]), "+v"(vr[3][1]), "+v"(vr[3][2]), "+v"(vr[3][3])
                   :: "memory");
      __builtin_amdgcn_sched_barrier(0);
#pragma unroll
      for (int df = 0; df < 4; ++df)
#pragma unroll
        for (int ks = 0; ks < 2; ++ks) {
          const v2i lo2 = vr[df][2 * ks], hi2 = vr[df][2 * ks + 1];
          const v4i pk4 = (v4i){lo2[0], lo2[1], hi2[0], hi2[1]};
          const half8 vf = __builtin_bit_cast(half8, pk4);
#pragma unroll
          for (int t2 = 0; t2 < 2; ++t2) o[df][t2] = __builtin_amdgcn_mfma_f32_16x16x32_f16(vf, pf[t2][ks], o[df][t2], 0, 0, 0);
        }
    }
  }
#pragma unroll
  for (int t2 = 0; t2 < 2; ++t2) {
    const float lt = rowsum4(lsum[t2]);
    const float inv = lt > 0.f ? 1.f / lt : 0.f;
#pragma unroll
    for (int df = 0; df < 4; ++df) o[df][t2] *= inv;
    const int tok = th * 32 + t2 * 16 + r15;
    const float isc = inv * 134217728.f;
#pragma unroll
    for (int ti = 0; ti < 4; ++ti) {
      if (ti <= tile_hi) {
#pragma unroll
        for (int kf = 0; kf < 4; ++kf) {
          const int j = 16 * ti + 4 * kf + q;
          if (j < 64) atomicAdd(&impu[tok * IMPS + j], (unsigned int)(usum[ti][kf][t2] * isc + 0.5f));
        }
      }
    }
  }
  __syncthreads();
}

template <int MODE, bool PREISSUED>
__device__ __forceinline__ void attn_branch_pp(char* smem, const half_t* kbase, const half_t* vbase, int ld, int tile_lo, int tile_hi, int n, int th,
                                               const half8 (&qf)[2][2], const float (&m)[2], float (&l)[2], f32x4 (&o)[4][2],
                                               const unsigned long long (&selm)[2], int wvs, int rot) {
  const int tid = otid(wvs);
  const int lane = tid & 63, r15 = lane & 15, q = lane >> 4;
  const int lrow = tid >> 3, lch = tid & 7;
  const int k_rd = r15 * 128, kswz = r15 >> 1;
  const int qp = r15 >> 2, pp = lane & 3;
  const int fx = ((2 * q + (qp >> 1)) & 3) << 1;
  const int v_rd = (4 * q + qp) * 128 + 8 * (pp & 1) + ((pp >> 1) << 4);
  const int ksrc = (lch ^ ((lrow >> 1) & 7)) * 8, vsrc = (lch ^ (((lrow >> 1) & 3) << 1)) * 8;
  const int wbase = __builtin_amdgcn_readfirstlane(tid >> 6) * 1024;
#define A_GLOAD(TI, BUF) { const half_t* kp_ = kbase + (size_t)((TI) * 64 + lrow) * ld + ksrc; \
    __builtin_amdgcn_global_load_lds((gbl_void*)kp_, (lds_void*)(smem + ATT_K + (BUF) * 8192 + wbase), 16, 0, 0); \
    { const half_t* vp_ = vbase + (size_t)((TI) * 64 + lrow) * ld + vsrc; \
      __builtin_amdgcn_global_load_lds((gbl_void*)vp_, (lds_void*)(smem + ATT_V + (BUF) * 8192 + wbase), 16, 0, 0); } }
#define PP_BAR { __builtin_amdgcn_sched_barrier(0); __builtin_amdgcn_s_barrier(); __builtin_amdgcn_sched_barrier(0); }
  const int nt = tile_hi - tile_lo + 1;
  f32x4 lacc[2] = {(f32x4){0.f, 0.f, 0.f, 0.f}, (f32x4){0.f, 0.f, 0.f, 0.f}};
  if (!PREISSUED) {
#pragma unroll
    for (int i = 0; i < ATT_D; ++i) if (i < nt) A_GLOAD(tile_lo + ((rot + i >= nt) ? rot + i - nt : rot + i), i)
  }
  { const int r = nt - 1;
    if (r >= 4) wait_vmcnt<8>(); else if (r == 3) wait_vmcnt<6>(); else if (r == 2) wait_vmcnt<4>(); else if (r == 1) wait_vmcnt<2>(); else wait_vmcnt<0>(); }
  half8 pf[2][2];
  v2i vr[4][4];
#pragma unroll
  for (int a = 0; a < 2; ++a)
#pragma unroll
    for (int b = 0; b < 2; ++b) pf[a][b] = (half8){(half_t)0.f, (half_t)0.f, (half_t)0.f, (half_t)0.f, (half_t)0.f, (half_t)0.f, (half_t)0.f, (half_t)0.f};
#pragma unroll
  for (int a = 0; a < 4; ++a)
#pragma unroll
    for (int b = 0; b < 4; ++b) vr[a][b] = (v2i){0, 0};
  const half8 ones = (half8){(half_t)1.f, (half_t)1.f, (half_t)1.f, (half_t)1.f, (half_t)1.f, (half_t)1.f, (half_t)1.f, (half_t)1.f};
#define PP_PV { _Pragma("unroll") for (int df = 0; df < 4; ++df) _Pragma("unroll") for (int ks = 0; ks < 2; ++ks) { \
      const v2i lo2 = vr[df][2 * ks], hi2 = vr[df][2 * ks + 1]; const v4i pk4 = (v4i){lo2[0], lo2[1], hi2[0], hi2[1]}; const half8 vf = __builtin_bit_cast(half8, pk4); \
      _Pragma("unroll") for (int t2 = 0; t2 < 2; ++t2) o[df][t2] = __builtin_amdgcn_mfma_f32_16x16x32_f16(vf, pf[t2][ks], o[df][t2], 0, 0, 0); } \
    _Pragma("unroll") for (int ks = 0; ks < 2; ++ks) _Pragma("unroll") for (int t2 = 0; t2 < 2; ++t2) lacc[t2] = __builtin_amdgcn_mfma_f32_16x16x32_f16(ones, pf[t2][ks], lacc[t2], 0, 0, 0); }
  __builtin_amdgcn_sched_barrier(0);
  if (th == 1) __builtin_amdgcn_s_barrier();
  __builtin_amdgcn_sched_barrier(0);
  int trel = rot, tpf = rot + ATT_D; while (tpf >= nt) tpf -= nt;
#pragma unroll 1
  for (int it = 0; it < nt; ++it) {
    const int ti = tile_lo + trel, cur = it % ATT_NB;
    trel = (trel + 1 == nt) ? 0 : trel + 1;
    PP_BAR
    f32x4 s[4][2];
    const char* kb = smem + ATT_K + cur * 8192 + k_rd;
    __builtin_amdgcn_s_setprio(1);
    PP_PV
#pragma unroll
    for (int t2 = 0; t2 < 2; ++t2) {
      float c0 = -m[t2];
      if (MODE == 2 && !((selm[t2] >> ti) & 1ull)) c0 = -INFINITY;
#pragma unroll
      for (int kf = 0; kf < 4; ++kf) s[kf][t2] = (f32x4){c0, c0, c0, c0};
    }
#pragma unroll
    for (int ks = 0; ks < 2; ++ks) {
      const int co = ((4 * ks + q) ^ kswz) << 4;
#pragma unroll
      for (int kf = 0; kf < 4; ++kf) {
        const half8 kfr = *(const half8*)(kb + kf * 2048 + co);
#pragma unroll
        for (int t2 = 0; t2 < 2; ++t2) s[kf][t2] = __builtin_amdgcn_mfma_f32_16x16x32_f16(kfr, qf[t2][ks], s[kf][t2], 0, 0, 0);
      }
    }
    __builtin_amdgcn_s_setprio(0);
    { const int r = nt - 2 - it;
      if (r >= 3) wait_vmcnt<6>(); else if (r == 2) wait_vmcnt<4>(); else if (r == 1) wait_vmcnt<2>(); else wait_vmcnt<0>(); }
    PP_BAR
    if (it + ATT_D < nt) A_GLOAD(tile_lo + tpf, (it + ATT_D) % ATT_NB)
    tpf = (tpf + 1 == nt) ? 0 : tpf + 1;
    {
      const unsigned vbl = (unsigned)(size_t)(smem + ATT_V + cur * 8192 + v_rd);
      const unsigned va0 = vbl + (((0) ^ fx) << 4), va1 = vbl + (((2) ^ fx) << 4), va2 = vbl + (((4) ^ fx) << 4), va3 = vbl + (((6) ^ fx) << 4);
      asm volatile(
          "ds_read_b64_tr_b16 %0, %16\n\tds_read_b64_tr_b16 %1, %16 offset:2048\n\tds_read_b64_tr_b16 %2, %16 offset:4096\n\tds_read_b64_tr_b16 %3, %16 offset:6144\n\t"
          "ds_read_b64_tr_b16 %4, %17\n\tds_read_b64_tr_b16 %5, %17 offset:2048\n\tds_read_b64_tr_b16 %6, %17 offset:4096\n\tds_read_b64_tr_b16 %7, %17 offset:6144\n\t"
          "ds_read_b64_tr_b16 %8, %18\n\tds_read_b64_tr_b16 %9, %18 offset:2048\n\tds_read_b64_tr_b16 %10, %18 offset:4096\n\tds_read_b64_tr_b16 %11, %18 offset:6144\n\t"
          "ds_read_b64_tr_b16 %12, %19\n\tds_read_b64_tr_b16 %13, %19 offset:2048\n\tds_read_b64_tr_b16 %14, %19 offset:4096\n\tds_read_b64_tr_b16 %15, %19 offset:6144"
          : "=&v"(vr[0][0]), "=&v"(vr[0][1]), "=&v"(vr[0][2]), "=&v"(vr[0][3]), "=&v"(vr[1][0]), "=&v"(vr[1][1]), "=&v"(vr[1][2]), "=&v"(vr[1][3]),
            "=&v"(vr[2][0]), "=&v"(vr[2][1]), "=&v"(vr[2][2]), "=&v"(vr[2][3]), "=&v"(vr[3][0]), "=&v"(vr[3][1]), "=&v"(vr[3][2]), "=&v"(vr[3][3])
          : "v"(va0), "v"(va1), "v"(va2), "v"(va3)
          : "memory");
    }
    bool need_mask;
    if (MODE == 2) need_mask = (ti == n); else need_mask = (ti == n) || (ti == n - 8);
    if (need_mask) {
#pragma unroll
      for (int t2 = 0; t2 < 2; ++t2) {
        const int tok = th * 32 + t2 * 16 + r15;
        int lo = 0, hi = 63;
        if (MODE == 2) { hi = tok; }
        else { if (ti == n) hi = tok; else lo = tok + 1; }
#pragma unroll
        for (int kf = 0; kf < 4; ++kf)
#pragma unroll
          for (int r = 0; r < 4; ++r) {
            const int kk = kf * 16 + 4 * q + r;
            if (kk < lo || kk > hi) s[kf][t2][r] = -INFINITY;
          }
      }
    }
#pragma unroll
    for (int t2 = 0; t2 < 2; ++t2) {
#pragma unroll
      for (int kf = 0; kf < 4; ++kf)
#pragma unroll
        for (int r = 0; r < 4; ++r) s[kf][t2][r] = fexp2(s[kf][t2][r]);
#pragma unroll
      for (int ks = 0; ks < 2; ++ks) {
        half8 pk;
#pragma unroll
        for (int r = 0; r < 4; ++r) { pk[r] = (half_t)s[2 * ks][t2][r]; pk[4 + r] = (half_t)s[2 * ks + 1][t2][r]; }
        pf[t2][ks] = pk;
      }
    }
    asm volatile("s_waitcnt lgkmcnt(0)"
                 : "+v"(vr[0][0]), "+v"(vr[0][1]), "+v"(vr[0][2]), "+v"(vr[0][3]), "+v"(vr[1][0]), "+v"(vr[1][1]), "+v"(vr[1][2]), "+v"(vr[1][3]),
                   "+v"(vr[2][0]), "+v"(vr[2][1]), "+v"(vr[2][2]), "+v"(vr[2][3]), "+v"(vr[3][0]), "+v"(vr[3][1]), "+v"(vr[3][2]), "+v"(vr[3][3])
                 :: "memory");
  }
  PP_BAR
  PP_PV
  __builtin_amdgcn_sched_barrier(0);
  if (th == 0) __builtin_amdgcn_s_barrier();
  __builtin_amdgcn_sched_barrier(0);
  l[0] = lacc[0][0]; l[1] = lacc[1][0];
  __syncthreads();
#undef A_GLOAD
#undef PP_BAR
#undef PP_PV
}

__device__ void ph_attn_mfma(const Params& P, char* smem, int wvs) {
  unsigned int* impu = (unsigned int*)(smem + ATT_IMP);
  unsigned long long* selmask = (unsigned long long*)(smem + ATT_SELM);
  const int G = gridDim.x, nrounds = (2048 + G - 1) / G;
  for (int rd = 0; rd < nrounds; ++rd) {
    const int idx = rd * G + ((rd & 1) ? (G - 1 - (int)blockIdx.x) : (int)blockIdx.x);
    if (idx >= 2048) continue;
    const int tid = otid(wvs), lane = tid & 63, r15 = lane & 15, q = lane >> 4;
    const int n = 63 - (idx >> 5), bg = idx & 31, b = bg >> 2, g = bg & 3;
    const int wv = __builtin_amdgcn_readfirstlane(otid(wvs) >> 6);
    const int hd = g * 4 + (wv & 3), th = wv >> 2;
    const int t0 = b * SEQ + n * 64 + th * 32;
    const half_t* kc = P.kcmp + (size_t)bg * 256 * 64;
    const half_t* vc = P.vcmp + (size_t)bg * 256 * 64;
    const int nct = (4 * n + 2) / 64;
    attn_issue(smem, kc, vc, 64, 0, nct, wvs);
    half8 qf[2][2];
#pragma unroll
    for (int t2 = 0; t2 < 2; ++t2)
#pragma unroll
      for (int ks = 0; ks < 2; ++ks) qf[t2][ks] = *(const half8*)(P.p + (size_t)(t0 + t2 * 16 + r15) * LD1 + hd * 64 + 32 * ks + 8 * q);
    float* gate_l = (float*)(smem + ATT_GATE) + wv * 128;
    if (q == 0) {
#pragma unroll
      for (int t2 = 0; t2 < 2; ++t2) {
        const float* pr = P.gl + (size_t)(t0 + t2 * 16 + r15) * 48 + hd * 3;
        f32x4 gv;
#pragma unroll
        for (int c = 0; c < 3; ++c) gv[c] = sigmoidf(pr[c] + P.nsa_b_gate[hd * 3 + c]);
        gv[3] = 0.f;
        *(f32x4*)(gate_l + (t2 * 16 + r15) * 4) = gv;
      }
    }
    { const int tz = otid(wvs); for (int i = tz; i < 64 * IMPS + 128; i += NTHREADS) impu[i] = 0u; }
    float m[2], l[2]; f32x4 o[4][2]; unsigned long long selm[2] = {0ull, 0ull};
#pragma unroll
    for (int t2 = 0; t2 < 2; ++t2) { m[t2] = -1e30f; l[t2] = 0.f; }
#pragma unroll
    for (int df = 0; df < 4; ++df)
#pragma unroll
      for (int t2 = 0; t2 < 2; ++t2) o[df][t2] = (f32x4){0.f, 0.f, 0.f, 0.f};
    float qn2[2];
#pragma unroll
    for (int t2 = 0; t2 < 2; ++t2) {
      float a = 0.f;
#pragma unroll
      for (int ks = 0; ks < 2; ++ks)
#pragma unroll
        for (int e = 0; e < 8; ++e) a += (float)qf[t2][ks][e] * (float)qf[t2][ks][e];
      qn2[t2] = rowsum4(a);
    }
    { const float kmc = __uint_as_float(P.kmax2[64 + bg]);
#pragma unroll
      for (int t2 = 0; t2 < 2; ++t2) m[t2] = sqrtf(qn2[t2] * kmc) * 1.001f - 5.0f * LOG2E; }
    attn_cmp(smem, nct, n, th, qf, m, o, wvs);
    f32x4 oacc[4][2];
#pragma unroll
    for (int t2 = 0; t2 < 2; ++t2) {
      const float gc = gate_l[(t2 * 16 + r15) * 4 + 0];
#pragma unroll
      for (int df = 0; df < 4; ++df) oacc[df][t2] = o[df][t2] * gc;
    }
    {
      const int tz = otid(wvs), lz = tz & 63;
#pragma unroll
      for (int i = 0; i < 4; ++i) {
        const int slab = i * 8 + wv, tokz = slab * 2 + (lz >> 5), cz = (lz & 31) ^ (tokz & 15);
        const half_t* zp = P.p + (size_t)(b * SEQ + n * 64 + tokz) * LD1 + 2560 + g * 256 + cz * 8;
        __builtin_amdgcn_global_load_lds((gbl_void*)zp, (lds_void*)(smem + ATT_Z + slab * 1024), 16, 0, 0);
      }
    }
    const int shr = ((int)blockIdx.x >> 5) & 7;
    const int rot_s = (shr * (n + 1)) >> 3;
    attn_issue(smem, P.p + (size_t)b * SEQ * LD1 + 1536 + g * 64, P.p + (size_t)b * SEQ * LD1 + 1792 + g * 64, LD1, 0, n, wvs, rot_s);
    {
      const int tid2 = otid(wvs);
      const int tok = tid2 >> 3, part = tid2 & 7;
      unsigned long long msk;
      if (n + 1 <= 16) {
        msk = (1ull << (n + 1)) - 1ull;
      } else {
        const uint4* rowp = (const uint4*)(impu + tok * IMPS);
        unsigned own[8];
        { const uint4 a = rowp[part * 2], b2 = rowp[part * 2 + 1];
          own[0] = a.x; own[1] = a.y; own[2] = a.z; own[3] = a.w; own[4] = b2.x; own[5] = b2.y; own[6] = b2.z; own[7] = b2.w; }
        int rank[8];
#pragma unroll
        for (int jj = 0; jj < 8; ++jj) {
          const int j = part * 8 + jj;
          own[jj] = (j >= 1 && j <= n - 2) ? ((own[jj] & ~63u) | (unsigned)(63 - j)) : 0xffffffffu;
          rank[jj] = 0;
        }
#pragma unroll 2
        for (int c4 = 0; c4 < 16; ++c4) {
          const uint4 v = rowp[c4];
          unsigned kv[4] = {v.x, v.y, v.z, v.w};
#pragma unroll
          for (int e = 0; e < 4; ++e) {
            const int j2 = c4 * 4 + e;
            const unsigned key2 = (j2 >= 1 && j2 <= n - 2) ? ((kv[e] & ~63u) | (unsigned)(63 - j2)) : 0u;
#pragma unroll
            for (int jj = 0; jj < 8; ++jj) rank[jj] += (key2 > own[jj]) ? 1 : 0;
          }
        }
        unsigned int bits = 0;
#pragma unroll
        for (int jj = 0; jj < 8; ++jj) if (rank[jj] < 13 && own[jj] != 0xffffffffu) bits |= 1u << jj;
        unsigned* sel32 = (unsigned*)selmask;
        if (bits) atomicOr(&sel32[tok * 2 + (part >> 2)], bits << (8 * (part & 3)));
        msk = 1ull | (1ull << n) | (1ull << (n - 1));
        if (part == 0) { atomicOr(&sel32[tok * 2], (unsigned)msk); atomicOr(&sel32[tok * 2 + 1], (unsigned)(msk >> 32)); }
      }
      if (n + 1 <= 16 && part == 0) selmask[tok] = msk;
    }
    __syncthreads();
#pragma unroll
    for (int t2 = 0; t2 < 2; ++t2) selm[t2] = selmask[th * 32 + t2 * 16 + r15];
    { const float km = __uint_as_float(P.kmax2[bg * 2 + 0]);
#pragma unroll
      for (int t2 = 0; t2 < 2; ++t2) { m[t2] = sqrtf(qn2[t2] * km) * 1.001f - 5.0f * LOG2E; l[t2] = 0.f; } }
#pragma unroll
    for (int df = 0; df < 4; ++df)
#pragma unroll
      for (int t2 = 0; t2 < 2; ++t2) o[df][t2] = (f32x4){0.f, 0.f, 0.f, 0.f};
    attn_branch_pp<2, true>(smem, P.p + (size_t)b * SEQ * LD1 + 1536 + g * 64, P.p + (size_t)b * SEQ * LD1 + 1792 + g * 64, LD1, 0, n, n, th, qf, m, l, o, selm, wvs, rot_s);
#pragma unroll
    for (int t2 = 0; t2 < 2; ++t2) {
      const float gs = gate_l[(t2 * 16 + r15) * 4 + 1] / l[t2];
#pragma unroll
      for (int df = 0; df < 4; ++df) oacc[df][t2] += o[df][t2] * gs;
    }
    { const float km = __uint_as_float(P.kmax2[bg * 2 + 1]);
#pragma unroll
      for (int t2 = 0; t2 < 2; ++t2) { m[t2] = sqrtf(qn2[t2] * km) * 1.001f - 5.0f * LOG2E; l[t2] = 0.f; } }
#pragma unroll
    for (int df = 0; df < 4; ++df)
#pragma unroll
      for (int t2 = 0; t2 < 2; ++t2) o[df][t2] = (f32x4){0.f, 0.f, 0.f, 0.f};
    attn_branch_pp<3, false>(smem, P.p + (size_t)b * SEQ * LD1 + 2048 + g * 64, P.p + (size_t)b * SEQ * LD1 + 2304 + g * 64, LD1, (n > 8 ? n - 8 : 0), n, n, th, qf, m, l, o, selm, wvs, ((7 - shr) * (n > 8 ? 9 : n + 1)) >> 3);
    {
      int tbase = t0 + r15; asm volatile("" : "+v"(tbase));
#pragma unroll
      for (int t2 = 0; t2 < 2; ++t2) {
        const size_t tok = (size_t)(tbase + t2 * 16);
        const float gw = gate_l[(t2 * 16 + r15) * 4 + 2] / l[t2];
#pragma unroll
        for (int df = 0; df < 4; ++df) {
          const f32x4 v = oacc[df][t2] + o[df][t2] * gw;
          const int tokl = th * 32 + t2 * 16 + r15, cz = (wv & 3) * 8 + df * 2 + (q >> 1);
          const half4 z = *(const half4*)(smem + ATT_Z + tokl * 512 + ((cz ^ (tokl & 15)) << 4) + (q & 1) * 8);
          half4 hv;
#pragma unroll
          for (int e = 0; e < 4; ++e) hv[e] = (half_t)(v[e] * siluf((float)z[e]));
          *(half4*)(P.og + tok * DM + hd * 64 + df * 16 + 4 * q) = hv;
        }
      }
    }
  }
}

constexpr int NPHASES = 13;
__device__ __forceinline__ void run_phase(int ph, const Params& P, char* smem, int wvs) {
  float* sm = (float*)smem;
  switch (ph) {
    case 0:
      if (blockIdx.x == 0 && otid(wvs) < 128) P.kmax2[otid(wvs)] = 0u;
      ph_xh_rstd(P.x, P.xh, P.rstd, wvs); ph_ropetab(P, wvs); prep_cbias_part(P, wvs);
      prep_weights(P, sm, wvs);
      prep_wT(P.nsa_w_in, NSA_IN, P.pre_norm + DM, P.WglT, 64, DM, 5, sm, wvs);
      prep_wT(P.gla_w_in, GLA_IN, P.pre_norm, P.WglrT, 64, DM, 6, sm, wvs);
      break;
    case 1:
      g8::gemm(g8::SrcPlain8{P.xh, DM, P.W0t, DM}, T_TOK, LD0, DM, g8::EpiStore8{P.p, LD0, P.rstd}, smem, wvs);
      ph_rowproj<1>(P, P.WglrT, P.glr, smem, wvs, 0);
      break;
    case 2: prep_cbias_reduce(P, wvs); ph_gla_prep(P, sm, wvs); break;
    case 13: ph_gla_mfma<true>(P, smem, wvs); break;
    case 3: ph_gla_mfma<false>(P, smem, wvs); break;
    case 4: ph_gla_post(P, wvs); break;
    case 5: g8::gemm(g8::SrcPlain8{P.og, DM, P.Wo0t, DM}, T_TOK, DM, DM, g8::EpiStore8{P.y, DM, nullptr}, smem, wvs); break;
    case 6: ph_post<false>(P.xh, P.y, P.post_norm, nullptr, P.xh, P.rstd, wvs); break;
    case 7: g8::gemm(g8::SrcPlain8{P.xh, DM, P.W1t, DM}, T_TOK, LD1, DM, g8::EpiRope8{P.p, LD1, P.rstd, P.ropetab}, smem, wvs); break;
    case 8:
      if (blockIdx.x >= 64) { ph_kmax(P, wvs, 64); ph_rowproj<3>(P, P.WglT, P.gl, smem, wvs, 64); }
      g8::gemm(g8::SrcCmp1_8{P.p, P.cw1t}, 16384, 256, 2048, g8::EpiCmpHid8{P.hid, P.cbias}, smem, wvs);
      asm volatile("s_waitcnt vmcnt(0)" ::: "memory");
      __syncthreads();
      g8::gemm(g8::SrcCmp2_8{P.hid, P.cw2t}, 16384, 256, 256, g8::EpiCmpOut8{P.kcmp, P.vcmp, P.kmax2 + 64}, smem, wvs);
      break;
    case 10: ph_attn_mfma(P, smem, wvs); break;
    case 11: g8::gemm(g8::SrcPlain8{P.og, DM, P.Wo1t, DM}, T_TOK, DM, DM, g8::EpiStore8{P.y, DM, nullptr}, smem, wvs); break;
    case 12: ph_post<true>(P.x1h, P.y, P.post_norm + DM, P.out, nullptr, nullptr, wvs); break;
  }
}

template <int PH>
__global__ void __launch_bounds__(NTHREADS, 2) k_phase(Params P) {
  __shared__ __attribute__((aligned(16))) char smem[SMEM_BYTES];
  run_phase(PH, P, smem, __builtin_amdgcn_readfirstlane(threadIdx.x >> 6));
}
template <int PH>
static void launch_phases(const Params& P, hipStream_t stream) {
  hipLaunchKernelGGL((k_phase<PH>), dim3(256), dim3(NTHREADS), 0, stream, P);
  if constexpr (PH + 1 < NPHASES) launch_phases<PH + 1>(P, stream);
}

#if MEGA
__global__ void __launch_bounds__(NTHREADS, 2) k_mega(Params P) {
  __shared__ __attribute__((aligned(16))) char smem[SMEM_BYTES];
  cg::grid_group grid = cg::this_grid();
  if (P.use_cg_sync) grid.sync();
  unsigned bt = 0;
  const int wvs = __builtin_amdgcn_readfirstlane(threadIdx.x >> 6);
  run_phase(0, P, smem, wvs); fast_barrier(P.bar, bt, wvs);
  run_phase(1, P, smem, wvs); fast_barrier(P.bar, bt, wvs);
  run_phase(2, P, smem, wvs); fast_barrier(P.bar, bt, wvs);
  run_phase(13, P, smem, wvs); fast_barrier(P.bar, bt, wvs);
  run_phase(3, P, smem, wvs); fast_barrier(P.bar, bt, wvs);
  run_phase(4, P, smem, wvs); fast_barrier(P.bar, bt, wvs);
  run_phase(5, P, smem, wvs); fast_barrier(P.bar, bt, wvs);
  run_phase(6, P, smem, wvs); fast_barrier(P.bar, bt, wvs);
  run_phase(7, P, smem, wvs); fast_barrier(P.bar, bt, wvs);
  run_phase(8, P, smem, wvs); fast_barrier(P.bar, bt, wvs);
  run_phase(10, P, smem, wvs); fast_barrier(P.bar, bt, wvs);
  run_phase(11, P, smem, wvs); fast_barrier(P.bar, bt, wvs);
  run_phase(12, P, smem, wvs);
}
#endif

extern "C" void kernel_launch(void* const* d_in, const int* in_sizes, int n_in, void* d_out, int out_size, void* d_ws, size_t ws_size,
                              hipStream_t stream) {
  Params P{};
  P.x = (const float*)d_in[0]; P.pos = (const int*)d_in[1]; P.pre_norm = (const float*)d_in[2]; P.post_norm = (const float*)d_in[3];
  P.gla_w_in = (const float*)d_in[4]; P.gla_w_gk_up = (const float*)d_in[5]; P.gla_b_gk = (const float*)d_in[6];
  P.gla_head_norm = (const float*)d_in[7]; P.gla_w_out = (const float*)d_in[8];
  P.nsa_w_in = (const float*)d_in[9]; P.nsa_b_gate = (const float*)d_in[10]; P.nsa_pe_k = (const float*)d_in[11]; P.nsa_pe_v = (const float*)d_in[12];
  P.ck_w1 = (const float*)d_in[13]; P.ck_w2 = (const float*)d_in[14]; P.cv_w1 = (const float*)d_in[15]; P.cv_w2 = (const float*)d_in[16];
  P.nsa_w_out = (const float*)d_in[17];
  P.out = (float*)d_out;
  char* ws = (char*)d_ws;
  const size_t MB = 1024 * 1024;
  P.W0t = (half_t*)(ws);
  P.Wo0t = (half_t*)(ws + 7 * MB);
  P.W1t = (half_t*)(ws + 9 * MB);
  P.Wo1t = (half_t*)(ws + 17 * MB);
  P.cw1t = (half_t*)(ws + 19 * MB);
  P.cw2t = (half_t*)(ws + 21 * MB);
  P.cbias = (float*)(ws + 22 * MB);
  P.cbias_part = (float*)(ws + 22 * MB + 4096);
  P.bar = (unsigned*)(ws + 23 * MB);
  P.use_cg_sync = 0;
  P.kmax2 = (unsigned*)(ws + 22 * MB + 512 * 1024);
  P.xh = (half_t*)(ws + 24 * MB);
  P.x1h = P.xh;
  P.p = (half_t*)(ws + 88 * MB);
  P.y = (half_t*)(ws + 88 * MB);
  P.og = (half_t*)(ws + 328 * MB);
  P.bcum = (float*)(ws + 392 * MB);
  P.rstd = (float*)(ws + 456 * MB);
  P.kcmp = (half_t*)(ws + 457 * MB);
  P.vcmp = (half_t*)(ws + 458 * MB);
  P.ropetab = (float*)(ws + 459 * MB);
  P.hid = (half_t*)(ws + 467 * MB);
  P.WglT = (half_t*)(ws + 22 * MB + 768 * 1024);
  P.WglrT = (half_t*)(ws + 22 * MB + 896 * 1024);
  P.glr = (float*)(ws + 509 * MB);
  P.gl = (float*)(ws + 503 * MB);
  P.gla_state = (float*)(ws + 476 * MB);
  if (ws_size < 512 * MB) { fprintf(stderr, "ws too small: %zu\n", ws_size); return; }
#if MEGA
  static int grid_blocks = 0;
  if (!grid_blocks) {
    int dev = 0, cus = 0, per_cu = 0;
    hipGetDevice(&dev);
    hipDeviceGetAttribute(&cus, hipDeviceAttributeMultiprocessorCount, dev);
    hipOccupancyMaxActiveBlocksPerMultiprocessor(&per_cu, k_mega, NTHREADS, 0);
    if (per_cu < 1) per_cu = 1;
    if (per_cu > 1) per_cu = 1;
    grid_blocks = cus * per_cu;
  }
  hipMemsetAsync(ws + 23 * MB, 0, 16384, stream);
  void* args[] = {&P};
  hipError_t e = hipLaunchCooperativeKernel((void*)k_mega, dim3(grid_blocks), dim3(NTHREADS), args, 0, stream);
  if (e != hipSuccess) fprintf(stderr, "cooperative launch failed: %s (grid %d)\n", hipGetErrorString(e), grid_blocks);
#else
  launch_phases<0>(P, stream);
#endif
}
```

```cpp
#include <hip/hip_runtime.h>
#include <hip/hip_cooperative_groups.h>
#include <cstdio>
#include <cstdint>
namespace cg = cooperative_groups;

typedef _Float16 half_t;
typedef _Float16 half8 __attribute__((ext_vector_type(8)));
typedef _Float16 half4 __attribute__((ext_vector_type(4)));
typedef float f32x4 __attribute__((ext_vector_type(4)));
typedef int v2i __attribute__((ext_vector_type(2)));
typedef int v4i __attribute__((ext_vector_type(4)));

#ifndef MEGA
#define MEGA 1
#endif

constexpr int T_TOK = 32768, DM = 1024, SEQ = 4096, NBATCH = 8;
constexpr int GLA_IN = 3088, NSA_IN = 3632;
constexpr int LD0 = 3072, LD1 = 3584;
constexpr int NC = 255;
constexpr float EPS = 1e-6f;
constexpr int NTHREADS = 512, NWAVES = NTHREADS / 64;
constexpr int SMEM_BYTES = 160 * 1024;

struct Params {
  const float* x; const int* pos; const float* pre_norm; const float* post_norm;
  const float* gla_w_in; const float* gla_w_gk_up; const float* gla_b_gk; const float* gla_head_norm; const float* gla_w_out;
  const float* nsa_w_in; const float* nsa_b_gate; const float* nsa_pe_k; const float* nsa_pe_v;
  const float* ck_w1; const float* ck_w2; const float* cv_w1; const float* cv_w2; const float* nsa_w_out;
  float* out;
  half_t* p; half_t* y; half_t* og; float* bcum; float* rstd; half_t* kcmp; half_t* vcmp; float* ropetab;
  half_t* xh; half_t* W0t; half_t* Wo0t; half_t* W1t; half_t* Wo1t;
  half_t* cw1t; half_t* cw2t; float* cbias; half_t* hid;
  float* cbias_part; unsigned* bar; long long use_cg_sync; unsigned* kmax2; float* gla_state; half_t* WglT; float* gl; half_t* x1h; half_t* WglrT; float* glr;
};

__device__ __forceinline__ int lane_id() { return (int)__builtin_amdgcn_mbcnt_hi(~0u, __builtin_amdgcn_mbcnt_lo(~0u, 0u)); }
__device__ __forceinline__ int otid(int wvs) { int t = wvs * 64 + lane_id(); asm volatile("" : "+v"(t)); return t; }
typedef __attribute__((address_space(3))) void lds_void;
typedef __attribute__((address_space(1))) const void gbl_void;
typedef short s16x4 __attribute__((vector_size(8)));
typedef __attribute__((address_space(3))) s16x4 lds_s16x4;
__device__ __forceinline__ half4 tr_read4(const char* p) {
  const s16x4 v = __builtin_amdgcn_ds_read_tr16_b64_v4i16((lds_s16x4*)(p));
  return __builtin_bit_cast(half4, v);
}
template <int N> __device__ __forceinline__ void wait_vmcnt() { asm volatile("s_waitcnt vmcnt(%0)" ::"n"(N) : "memory"); }
constexpr float LOG2E = 1.4426950408889634f;
__device__ __forceinline__ float fexp2(float x) { return __builtin_amdgcn_exp2f(x); }
typedef unsigned u32x2 __attribute__((ext_vector_type(2)));
__device__ __forceinline__ float rowmax4(float x) {
  u32x2 r = __builtin_amdgcn_permlane16_swap(__float_as_uint(x), __float_as_uint(x), false, false);
  x = fmaxf(__uint_as_float(r[0]), __uint_as_float(r[1]));
  r = __builtin_amdgcn_permlane32_swap(__float_as_uint(x), __float_as_uint(x), false, false);
  return fmaxf(__uint_as_float(r[0]), __uint_as_float(r[1]));
}
__device__ __forceinline__ float rowsum4(float x) {
  u32x2 r = __builtin_amdgcn_permlane16_swap(__float_as_uint(x), __float_as_uint(x), false, false);
  x = __uint_as_float(r[0]) + __uint_as_float(r[1]);
  r = __builtin_amdgcn_permlane32_swap(__float_as_uint(x), __float_as_uint(x), false, false);
  return __uint_as_float(r[0]) + __uint_as_float(r[1]);
}
template <int CTRL> __device__ __forceinline__ float dpp_f(float x) {
  return __builtin_bit_cast(float, __builtin_amdgcn_update_dpp(0, __builtin_bit_cast(int, x), CTRL, 0xf, 0xf, true));
}
__device__ __forceinline__ float wave_sum(float v) {
  v += dpp_f<0xB1>(v);
  v += dpp_f<0x4E>(v);
  v += dpp_f<0x141>(v);
  v += dpp_f<0x140>(v);
  return rowsum4(v);
}
__device__ __forceinline__ float wave_max(float v) {
  v = fmaxf(v, dpp_f<0xB1>(v));
  v = fmaxf(v, dpp_f<0x4E>(v));
  v = fmaxf(v, dpp_f<0x141>(v));
  v = fmaxf(v, dpp_f<0x140>(v));
  return rowmax4(v);
}
__device__ __forceinline__ float fast_exp2(float x) { return __builtin_amdgcn_exp2f(x); }
__device__ __forceinline__ float sigmoidf(float v) { return __builtin_amdgcn_rcpf(1.f + fast_exp2(-1.4426950408889634f * v)); }
__device__ __forceinline__ float siluf(float v) { return v * sigmoidf(v); }
__device__ __forceinline__ float logsigmoidf(float u) { return fminf(u, 0.f) - 0.6931471805599453f * __builtin_amdgcn_logf(1.f + fast_exp2(-1.4426950408889634f * fabsf(u))); }

__device__ __forceinline__ void fast_barrier(unsigned* bar, unsigned& round, int wvs) {
  asm volatile("s_waitcnt vmcnt(0) lgkmcnt(0)" ::: "memory");
  __syncthreads();
  round += 1;
  if (wvs == 0 && lane_id() == 0) {
    __builtin_amdgcn_fence(__ATOMIC_RELEASE, "agent");
    asm volatile("s_waitcnt vmcnt(0)" ::: "memory");
    const unsigned ngroups = gridDim.x >> 4;
    const unsigned old = __hip_atomic_fetch_add(bar + 64 + 64 * (blockIdx.x >> 4), 1u, __ATOMIC_RELAXED, __HIP_MEMORY_SCOPE_AGENT);
    if (old + 1 == round * 16u) __hip_atomic_fetch_add(bar, 1u, __ATOMIC_RELAXED, __HIP_MEMORY_SCOPE_AGENT);
    const unsigned target = round * ngroups;
    while (__hip_atomic_load(bar, __ATOMIC_RELAXED, __HIP_MEMORY_SCOPE_AGENT) < target) { }
    __builtin_amdgcn_fence(__ATOMIC_ACQUIRE, "agent");
    asm volatile("s_waitcnt vmcnt(0)" ::: "memory");
  }
  __syncthreads();
}

__device__ void ph_xh_rstd(const float* src, half_t* xh, float* rstd, int wvs) {
  const int tid_ = otid(wvs); const int lane = tid_ & 63, w = tid_ >> 6;
  constexpr int RW = 4;
  const int rstride = gridDim.x * NWAVES;
#pragma unroll 1
  for (int row0 = blockIdx.x * NWAVES + w; row0 < T_TOK; row0 += rstride * RW) {
    float4 v[RW][4];
#pragma unroll
    for (int r = 0; r < RW; ++r)
#pragma unroll
      for (int i = 0; i < 4; ++i) v[r][i] = ((const float4*)(src + (size_t)(row0 + r * rstride) * DM))[lane + 64 * i];
#pragma unroll
    for (int r = 0; r < RW; ++r) {
      const int row = row0 + r * rstride;
      half4* xr = (half4*)(xh + (size_t)row * DM);
      float ss = 0.f;
#pragma unroll
      for (int i = 0; i < 4; ++i) {
        const float4 t = v[r][i];
        ss += t.x * t.x + t.y * t.y + t.z * t.z + t.w * t.w;
        half4 hv; hv[0] = (half_t)t.x; hv[1] = (half_t)t.y; hv[2] = (half_t)t.z; hv[3] = (half_t)t.w;
        xr[lane + 64 * i] = hv;
      }
      ss = wave_sum(ss);
      if (lane == 0) rstd[row] = rsqrtf(ss * (1.f / DM) + EPS);
    }
  }
}
__device__ void ph_ropetab(const Params& P, int wvs) {
  const int tid = otid(wvs);
  const float inv = powf(10000.f, -(float)(2 * (tid & 31)) / 64.f);
  for (int idx = blockIdx.x * NTHREADS + tid; idx < T_TOK * 32; idx += gridDim.x * NTHREADS) {
    const int t = idx >> 5, i = idx & 31;
    const float ang = (float)P.pos[t] * inv;
    float s, c; sincosf(ang, &s, &c);
    P.ropetab[t * 64 + i] = c; P.ropetab[t * 64 + 32 + i] = s;
  }
}
__device__ __forceinline__ int orig_col(int n, int mode) {
  if (mode == 0) {
    if (n < 2048) return n;
    if (n < 3072) return n + 16;
    return -1;
  } else if (mode == 1) {
    if (n < 2560) return n;
    if (n < 3584) return n + 48;
    return -1;
  } else if (mode == 5) {
    return n < 48 ? 2560 + n : -1;
  }
  if (mode == 4) return n < 64 ? n : -1;
  if (mode == 6) return n < 16 ? 2048 + n : -1;
  return n;
}
__device__ void prep_wT(const float* W, int ldw, const float* gamma, half_t* Wt, int Npad, int K, int mode, float* sm, int wvs) {
  float(*tile)[65] = (float(*)[65])sm;
  const int tid = otid(wvs);
  const int ntn = Npad / 64, ntk = K / 64;
  for (int t = blockIdx.x; t < ntn * ntk; t += gridDim.x) {
    const int n0 = (t / ntk) * 64, k0 = (t % ntk) * 64;
    __syncthreads();
#pragma unroll
    for (int r = 0; r < 4096 / NTHREADS; ++r) {
      const int idx = tid + r * NTHREADS, kk = idx >> 6, nn = idx & 63;
      const int on = orig_col(n0 + nn, mode);
      float v = 0.f;
      if (on >= 0) { v = W[(size_t)(k0 + kk) * ldw + on]; if (gamma) v *= gamma[k0 + kk]; }
      tile[kk][nn] = v;
    }
    __syncthreads();
    {
      const int nn = tid >> 3, oct = tid & 7;
      half8 hv;
#pragma unroll
      for (int e = 0; e < 8; ++e) hv[e] = (half_t)tile[oct * 8 + e][nn];
      *(half8*)(Wt + (size_t)(n0 + nn) * K + k0 + oct * 8) = hv;
    }
  }
}

__device__ __forceinline__ void prep_strip(const float* W, int ldw, const float* gamma, half_t* Wt, int K, int mode, int n0, int k0, float* sm, int tid) {
  float(*tile)[260] = (float(*)[260])sm;
  __syncthreads();
#pragma unroll
  for (int r = 0; r < 8; ++r) {
    const int idx = tid + r * NTHREADS, kk = idx >> 6, n4 = (idx & 63) * 4;
    const int on = orig_col(n0 + n4, mode);
    f32x4 v = (f32x4){0.f, 0.f, 0.f, 0.f};
    if (on >= 0) { v = *(const f32x4*)(W + (size_t)(k0 + kk) * ldw + on); if (gamma) v *= gamma[k0 + kk]; }
    *(f32x4*)&tile[kk][n4] = v;
  }
  __syncthreads();
#pragma unroll
  for (int r = 0; r < 4; ++r) {
    const int idx = tid + r * NTHREADS, nn = idx & 255, oct = idx >> 8;
    half8 hv;
#pragma unroll
    for (int e = 0; e < 8; ++e) hv[e] = (half_t)tile[oct * 8 + e][nn];
    *(half8*)(Wt + (size_t)(n0 + nn) * K + k0 + oct * 8) = hv;
  }
}
__device__ void prep_weights(const Params& P, float* sm, int wvs) {
  const int tid = otid(wvs);
  constexpr int NJ = 8;
  const int nstr[NJ] = {(LD0 / 256) * (DM / 64), (DM / 256) * (DM / 64), (LD1 / 256) * (DM / 64), (DM / 256) * (DM / 64), 32, 32, 4, 4};
  int total = 0;
#pragma unroll
  for (int j = 0; j < NJ; ++j) total += nstr[j];
  for (int w = blockIdx.x; w < total; w += gridDim.x) {
    int j = 0, t = w;
#pragma unroll
    for (int jj = 0; jj < NJ - 1; ++jj) if (j == jj && t >= nstr[jj]) { t -= nstr[jj]; j = jj + 1; }
    const float* W; int ldw; const float* gamma; half_t* Wt; int K, mode;
    switch (j) {
      case 0: W = P.gla_w_in; ldw = GLA_IN; gamma = P.pre_norm; Wt = P.W0t; K = DM; mode = 0; break;
      case 1: W = P.gla_w_out; ldw = DM; gamma = nullptr; Wt = P.Wo0t; K = DM; mode = 2; break;
      case 2: W = P.nsa_w_in; ldw = NSA_IN; gamma = P.pre_norm + DM; Wt = P.W1t; K = DM; mode = 1; break;
      case 3: W = P.nsa_w_out; ldw = DM; gamma = nullptr; Wt = P.Wo1t; K = DM; mode = 2; break;
      case 4: W = P.ck_w1; ldw = 256; gamma = nullptr; Wt = P.cw1t; K = 2048; mode = 2; break;
      case 5: W = P.cv_w1; ldw = 256; gamma = nullptr; Wt = P.cw1t + 256 * 2048; K = 2048; mode = 2; break;
      case 6: W = P.ck_w2; ldw = 64; gamma = nullptr; Wt = P.cw2t; K = 256; mode = 4; break;
      default: W = P.cv_w2; ldw = 64; gamma = nullptr; Wt = P.cw2t + 256 * 256; K = 256; mode = 4; break;
    }
    const int nsk = K / 64;
    prep_strip(W, ldw, gamma, Wt, K, mode, (t / nsk) * 256, (t % nsk) * 64, sm, tid);
  }
}

__device__ void prep_cbias_part(const Params& P, int wvs) {
  for (int idx = blockIdx.x * NTHREADS + otid(wvs); idx < 2 * 32 * 256; idx += gridDim.x * NTHREADS) {
    const int j = idx & 255, ks = (idx >> 8) & 31, which = idx >> 13;
    const float* pe = which ? P.nsa_pe_v : P.nsa_pe_k;
    const float* w1 = which ? P.cv_w1 : P.ck_w1;
    float a = 0.f;
#pragma unroll 8
    for (int k = ks * 64; k < ks * 64 + 64; ++k) a += pe[k] * w1[(size_t)k * 256 + j];
    P.cbias_part[idx] = a;
  }
}
__device__ void prep_cbias_reduce(const Params& P, int wvs) {
  if (blockIdx.x < 2 && otid(wvs) < 256) {
    const int which = blockIdx.x, j = otid(wvs);
    float a = 0.f;
    for (int ks = 0; ks < 32; ++ks) a += P.cbias_part[(which * 32 + ks) * 256 + j];
    P.cbias[which * 256 + j] = a;
  }
}

namespace g8 {
constexpr int BK = 64, HALF = 128, HTB = HALF * BK * 2;
__device__ __forceinline__ int lds_byte(int r, int c) { const int st = (r >> 4) * 2 + (c >> 5), rr = r & 15, cc = c & 31, ob = rr * 64 + cc * 2; return st * 1024 + (ob ^ (((ob >> 9) & 1) << 5)); }
__device__ __forceinline__ void stage_rc(int b, int& R, int& C) { const int st = b / 1024, sb = b % 1024, swz = sb ^ (((sb >> 9) & 1) << 5); R = (st >> 1) * 16 + swz / 64; C = (st & 1) * 32 + (swz % 64) / 2; }
typedef f32x4 Acc[2][2][4][2];

struct SrcPlain8 {
  const half_t* A; int lda; const half_t* Bt; int K;
  __device__ __forceinline__ void get(int pm, int pn, const half_t*& Ag, const half_t*& Bg, size_t& a_rs, int& a_ks) const {
    Ag = A + (size_t)pm * 256 * lda; Bg = Bt + (size_t)pn * 256 * K; a_rs = lda; a_ks = 64;
  }
};
struct SrcCmp1_8 {
  const half_t* p1; const half_t* w1t;
  __device__ __forceinline__ void get(int pm, int pn, const half_t*& Ag, const half_t*& Bg, size_t& a_rs, int& a_ks) const {
    const int which = pm >> 5, bg = pm & 31, b = bg >> 2, g = bg & 3;
    Ag = p1 + (size_t)(b * SEQ) * LD1 + (which ? 1280 : 1024) + g * 64;
    Bg = w1t + (size_t)which * 256 * 2048; a_rs = (size_t)16 * LD1; a_ks = LD1;
  }
};
struct SrcCmp2_8 {
  const half_t* hid; const half_t* w2t;
  __device__ __forceinline__ void get(int pm, int pn, const half_t*& Ag, const half_t*& Bg, size_t& a_rs, int& a_ks) const {
    Ag = hid + (size_t)pm * 256 * 256; Bg = w2t + (size_t)(pm >> 5) * 256 * 256; a_rs = 256; a_ks = 64;
  }
};

__device__ __forceinline__ half8 pack8(const f32x4 a, const f32x4 b) {
  half8 h; h[0] = (half_t)a[0]; h[1] = (half_t)a[1]; h[2] = (half_t)a[2]; h[3] = (half_t)a[3]; h[4] = (half_t)b[0]; h[5] = (half_t)b[1]; h[6] = (half_t)b[2]; h[7] = (half_t)b[3];
  return h;
}
struct EpiStore8 {
  half_t* C; int ldc; const float* rowscale;
  __device__ __forceinline__ void operator()(const Acc& acc, int row0, int col0, int wr, int wc, int fr, int fq) const {
    float rs[2][4];
#pragma unroll
    for (int ai = 0; ai < 2; ++ai)
#pragma unroll
      for (int m = 0; m < 4; ++m) rs[ai][m] = rowscale ? rowscale[row0 + ai * 128 + wr * 64 + m * 16 + fr] : 1.f;
#pragma unroll
    for (int ai = 0; ai < 2; ++ai)
#pragma unroll
      for (int m = 0; m < 4; ++m) {
        const int tok = row0 + ai * 128 + wr * 64 + m * 16 + fr;
        const float s = rs[ai][m];
        half_t* rowp = C + (size_t)tok * ldc + col0 + 64 * wc + 8 * fq;
#pragma unroll
        for (int bj = 0; bj < 2; ++bj) *(half8*)(rowp + 32 * bj) = pack8(acc[ai][bj][m][0] * s, acc[ai][bj][m][1] * s);
      }
  }
};
struct EpiRope8 {
  half_t* C; int ldc; const float* rowscale; const float* ropetab;
  __device__ __forceinline__ void operator()(const Acc& acc, int row0, int col0, int wr, int wc, int fr, int fq) const {
    const int grp = (col0 >> 6) + wc;
    const bool is_q = grp < 16;
    const bool roped = is_q || (grp >= 16 && grp < 20) || (grp >= 24 && grp < 28) || (grp >= 32 && grp < 36);
    const float sc = is_q ? 0.125f * 1.4426950408889634f : 1.f;
    float s = rowscale[row0 + wr * 64 + fr];
    f32x4 cs[2], sn[2];
    if (roped) {
      const int tok0 = row0 + wr * 64 + fr;
#pragma unroll
      for (int n = 0; n < 2; ++n) { cs[n] = *(const f32x4*)(ropetab + (size_t)tok0 * 64 + 8 * fq + 4 * n); sn[n] = *(const f32x4*)(ropetab + (size_t)tok0 * 64 + 32 + 8 * fq + 4 * n); }
    }
#pragma unroll
    for (int i = 0; i < 8; ++i) {
        const int ai = i >> 2, m = i & 3;
        const int tok = row0 + ai * 128 + wr * 64 + m * 16 + fr;
        half_t* rowp = C + (size_t)tok * ldc + col0 + 64 * wc + 8 * fq;
        f32x4 o1[2], o2[2];
#pragma unroll
        for (int n = 0; n < 2; ++n) {
          const f32x4 x1 = acc[ai][0][m][n] * s, x2 = acc[ai][1][m][n] * s;
          if (roped) { o1[n] = (x1 * cs[n] - x2 * sn[n]) * sc; o2[n] = (x2 * cs[n] + x1 * sn[n]) * sc; }
          else { o1[n] = x1; o2[n] = x2; }
        }
        const half8 p1 = pack8(o1[0], o1[1]), p2 = pack8(o2[0], o2[1]);
        if (i + 1 < 8) {
          const int tokn = row0 + ((i + 1) >> 2) * 128 + wr * 64 + ((i + 1) & 3) * 16 + fr;
          s = rowscale[tokn];
          if (roped) {
#pragma unroll
            for (int n = 0; n < 2; ++n) { cs[n] = *(const f32x4*)(ropetab + (size_t)tokn * 64 + 8 * fq + 4 * n); sn[n] = *(const f32x4*)(ropetab + (size_t)tokn * 64 + 32 + 8 * fq + 4 * n); }
          }
        }
        *(half8*)(rowp) = p1;
        *(half8*)(rowp + 32) = p2;
    }
  }
};
struct EpiCmpHid8 {
  half_t* hid; const float* bias;
  __device__ __forceinline__ void operator()(const Acc& acc, int row0, int col0, int wr, int wc, int fr, int fq) const {
    const int which = row0 >> 13;
#pragma unroll
    for (int bj = 0; bj < 2; ++bj) {
      const int col = col0 + 64 * wc + 32 * bj + 8 * fq;
      const f32x4 b0 = *(const f32x4*)(bias + which * 256 + col), b1 = *(const f32x4*)(bias + which * 256 + col + 4);
#pragma unroll
      for (int ai = 0; ai < 2; ++ai)
#pragma unroll
        for (int m = 0; m < 4; ++m) {
          const int row = row0 + ai * 128 + wr * 64 + m * 16 + fr;
          f32x4 v0 = acc[ai][bj][m][0] + b0, v1 = acc[ai][bj][m][1] + b1;
#pragma unroll
          for (int e = 0; e < 4; ++e) { v0[e] = siluf(v0[e]); v1[e] = siluf(v1[e]); }
          *(half8*)(hid + (size_t)row * 256 + col) = pack8(v0, v1);
        }
    }
  }
};
struct EpiCmpOut8 {
  half_t* kcmp; half_t* vcmp; unsigned* kmaxc;
  __device__ __forceinline__ void operator()(const Acc& acc, int row0, int col0, int wr, int wc, int fr, int fq) const {
    if (wc != 0) return;
#pragma unroll
    for (int ai = 0; ai < 2; ++ai)
#pragma unroll
      for (int m = 0; m < 4; ++m) {
        const int row = row0 + ai * 128 + wr * 64 + m * 16 + fr;
        const int which = row >> 13, r = row & 8191;
        half_t* dst = (which ? vcmp : kcmp) + (size_t)r * 64 + 8 * fq;
        const bool dead = (r & 255) == 255;
        float ss = 0.f;
#pragma unroll
        for (int bj = 0; bj < 2; ++bj) {
          half8 hv = pack8(acc[ai][bj][m][0], acc[ai][bj][m][1]);
          if (dead) hv = (half8){(half_t)0.f, (half_t)0.f, (half_t)0.f, (half_t)0.f, (half_t)0.f, (half_t)0.f, (half_t)0.f, (half_t)0.f};
#pragma unroll
          for (int e = 0; e < 8; ++e) ss += (float)hv[e] * (float)hv[e];
          *(half8*)(dst + 32 * bj) = hv;
        }
        if (which == 0) {
          ss = rowsum4(ss);
          ss = wave_max(ss);
          if (lane_id() == 0) __hip_atomic_fetch_max(&kmaxc[r >> 8], __float_as_uint(ss), __ATOMIC_RELAXED, __HIP_MEMORY_SCOPE_AGENT);
        }
      }
  }
};

template <class Src, class Epi>
__device__ void gemm(const Src& src, int M, int N, int K, const Epi& epi, char* smem, int wvs) {
  const int tid = otid(wvs), wid = __builtin_amdgcn_readfirstlane(tid >> 6), lane = tid & 63, wr = wid >> 2, wc = wid & 3, fr = lane & 15, fq = lane >> 4;
  const int nM = M / 256, nN = N / 256, nwg = nM * nN, G = gridDim.x, nt = K / BK;
  int sr0, sc0, sr1, sc1;
  stage_rc(tid * 16, sr0, sc0); stage_rc(tid * 16 + 8192, sr1, sc1);
  const int a_base = lds_byte(wr * 64 + fr, fq * 8);
  int b_base = 65536 + lds_byte(wc * 32 + fr, fq * 8);
  asm volatile("" : "+v"(b_base));
#define SA8(b, h) (smem + ((b) * 2 + (h)) * HTB)
#define SB8(b, h) (smem + (4 + (b) * 2 + (h)) * HTB)
#define STAGE_A(P, h, kt) { const char* g_ = (const char*)(Ag + (size_t)(h) * 128 * lda + (size_t)(kt) * a_ks); \
    __builtin_amdgcn_global_load_lds((gbl_void*)(g_ + aob0), (lds_void*)((P) + wid * 1024), 16, 0, 0); \
    __builtin_amdgcn_global_load_lds((gbl_void*)(g_ + aob1), (lds_void*)((P) + 8192 + wid * 1024), 16, 0, 0); }
#define STAGE_B(P, h, kt) { const char* g_ = (const char*)(Bg + (size_t)(h) * 32 * K + (size_t)(kt) * 64);     \
    __builtin_amdgcn_global_load_lds((gbl_void*)(g_ + bob0), (lds_void*)((P) + wid * 1024), 16, 0, 0); \
    __builtin_amdgcn_global_load_lds((gbl_void*)(g_ + bob1), (lds_void*)((P) + 8192 + wid * 1024), 16, 0, 0); }
#define LDA8(dst, b, h) { _Pragma("unroll") for (int m = 0; m < 4; ++m) _Pragma("unroll") for (int k = 0; k < 2; ++k) dst[m][k] = *(const half8*)(SA8(b, h) + a_base + m * 2048 + k * 1024); }
#define LDB8(dst, b, h) { _Pragma("unroll") for (int n = 0; n < 2; ++n) _Pragma("unroll") for (int k = 0; k < 2; ++k) dst[n][k] = *(const half8*)(smem + ((b) * 2 + (h)) * HTB + b_base + n * 2048 + k * 1024); }
#define MMA8(ai, bj, At, Bx) { __builtin_amdgcn_s_setprio(1); \
    _Pragma("unroll") for (int m = 0; m < 4; ++m) _Pragma("unroll") for (int n = 0; n < 2; ++n) _Pragma("unroll") for (int k = 0; k < 2; ++k) \
      acc[ai][bj][m][n] = __builtin_amdgcn_mfma_f32_16x16x32_f16(Bx[n][k], At[m][k], acc[ai][bj][m][n], 0, 0, 0); \
    __builtin_amdgcn_s_setprio(0); }
#define WAIT_V(n) asm volatile("s_waitcnt vmcnt(" #n ")" ::: "memory")
#define WAIT_L(n) asm volatile("s_waitcnt lgkmcnt(" #n ")" ::: "memory")
#define BAR __builtin_amdgcn_s_barrier()
#define SCHED __builtin_amdgcn_sched_barrier(0)
  for (int it = 0;; ++it) {
    const int L = it * G + (int)blockIdx.x;
    if (L >= nwg) break;
    int wgid;
    { const int q = nwg / 8, r = nwg % 8, xcd = L % 8, off = L / 8; wgid = (xcd < r ? xcd * (q + 1) : r * (q + 1) + (xcd - r) * q) + off; }
    const int nig = 8 * nN, gid = wgid / nig, fm = gid * 8, gsz = (nM - fm) < 8 ? (nM - fm) : 8;
    const int pm = fm + ((wgid % nig) % gsz), pn = (wgid % nig) / gsz;
    const half_t* Ag; const half_t* Bg; size_t lda; int a_ks;
    src.get(pm, pn, Ag, Bg, lda, a_ks);
    const unsigned aob0 = (unsigned)(((size_t)sr0 * lda + sc0) * 2), aob1 = (unsigned)(((size_t)sr1 * lda + sc1) * 2);
    const int pr0 = 64 * (sr0 >> 5) + 8 * ((sr0 & 15) >> 2) + 4 * ((sr0 >> 4) & 1) + (sr0 & 3), pr1 = 64 * (sr1 >> 5) + 8 * ((sr1 & 15) >> 2) + 4 * ((sr1 >> 4) & 1) + (sr1 & 3);
    const unsigned bob0 = (unsigned)((pr0 * K + sc0) * 2), bob1 = (unsigned)((pr1 * K + sc1) * 2);
    Acc acc;
#pragma unroll
    for (int a = 0; a < 2; ++a)
#pragma unroll
      for (int b = 0; b < 2; ++b)
#pragma unroll
        for (int m = 0; m < 4; ++m)
#pragma unroll
          for (int n = 0; n < 2; ++n) acc[a][b][m][n] = (f32x4){0.f, 0.f, 0.f, 0.f};
    half8 At[4][2], B0[2][2], B1[2][2];
    STAGE_B(SB8(0, 0), 0, 0) STAGE_A(SA8(0, 0), 0, 0)
    STAGE_B(SB8(0, 1), 1, 0) STAGE_A(SA8(0, 1), 1, 0)
    if (wr == 1) BAR;
    WAIT_V(4); BAR;
    STAGE_B(SB8(1, 0), 0, 1) STAGE_A(SA8(1, 0), 0, 1) STAGE_B(SB8(1, 1), 1, 1)
    WAIT_V(6); BAR;
#pragma unroll 1
    for (int t = 0; t < nt - 2; t += 2) {
      LDB8(B0, 0, 0) SCHED; LDA8(At, 0, 0) STAGE_A(SA8(1, 1), 1, t + 1)
      WAIT_L(8); BAR; WAIT_L(0); MMA8(0, 0, At, B0) BAR; SCHED;
      LDB8(B1, 0, 1) STAGE_B(SB8(0, 0), 0, t + 2)
      BAR; WAIT_L(0); MMA8(0, 1, At, B1) BAR;
      LDA8(At, 0, 1) STAGE_A(SA8(0, 0), 0, t + 2)
      BAR; WAIT_L(0); MMA8(1, 0, At, B0) BAR; SCHED;
      STAGE_B(SB8(0, 1), 1, t + 2)
      WAIT_V(6); BAR; MMA8(1, 1, At, B1) BAR;
      LDB8(B0, 1, 0) SCHED; LDA8(At, 1, 0) STAGE_A(SA8(0, 1), 1, t + 2)
      WAIT_L(8); BAR; WAIT_L(0); MMA8(0, 0, At, B0) BAR; SCHED;
      LDB8(B1, 1, 1) STAGE_B(SB8(1, 0), 0, t + 3)
      BAR; WAIT_L(0); MMA8(0, 1, At, B1) BAR;
      LDA8(At, 1, 1) STAGE_A(SA8(1, 0), 0, t + 3)
      BAR; WAIT_L(0); MMA8(1, 0, At, B0) BAR; SCHED;
      STAGE_B(SB8(1, 1), 1, t + 3)
      WAIT_V(6); BAR; MMA8(1, 1, At, B1) BAR;
    }
    { LDB8(B0, 0, 0) LDA8(At, 0, 0) STAGE_A(SA8(1, 1), 1, nt - 1)
      BAR; WAIT_L(0); MMA8(0, 0, At, B0) BAR;
      LDB8(B1, 0, 1) BAR; WAIT_L(0); MMA8(0, 1, At, B1) BAR;
      LDA8(At, 0, 1) WAIT_V(4); BAR; WAIT_L(0); MMA8(1, 0, At, B0) MMA8(1, 1, At, B1) BAR; }
    { LDB8(B0, 1, 0) LDA8(At, 1, 0) WAIT_V(2); BAR; WAIT_L(0); MMA8(0, 0, At, B0) BAR;
      LDB8(B1, 1, 1) WAIT_V(0); BAR; WAIT_L(0); MMA8(0, 1, At, B1) BAR;
      LDA8(At, 1, 1) BAR; WAIT_L(0); MMA8(1, 0, At, B0) MMA8(1, 1, At, B1) BAR; }
    if (wr == 0) BAR;
    { int fr2 = fr, fq2 = fq; asm volatile("" : "+v"(fr2), "+v"(fq2)); epi(acc, pm * 256, pn * 256, wr, wc, fr2, fq2); }
  }
#undef SA8
#undef SB8
#undef STAGE_A
#undef STAGE_B
#undef LDA8
#undef LDB8
#undef MMA8
#undef WAIT_V
#undef WAIT_L
#undef BAR
#undef SCHED
}
}

struct GlaPrepOps { half8 q0, k0, q1, k1; float w[16]; float bb; };
__device__ void ph_gla_prep(const Params& P, float* sm, int wvs) {
  float(*glr)[16] = (float(*)[16])sm;
  float(*tot)[128] = (float(*)[128])(sm + 1024);
  float(*exl)[132] = (float(*)[132])(sm + 1536);
  const int tid = otid(wvs);
  const int tq = tid >> 7, c = tid & 127;
  const int tp = tid >> 4, co = tid & 15;
  const float scale = 0.08838834764831845f;
  const int nchunks = T_TOK / 64, G = gridDim.x;
  const int nj = (((nchunks - 1 - (int)blockIdx.x) / G) + 1) * 4;
  GlaPrepOps nxt; f32x4 gnx = {};
#define GLA_PREP_LOAD(j_) { const int chunk_ = (int)blockIdx.x + ((j_) >> 2) * G, h_ = (j_) & 3, ch_ = h_ * 128 + c; \
    const half_t* qp_ = P.p + (size_t)(chunk_ * 64 + 2 * tp) * LD0 + h_ * 128 + co * 8; \
    nxt.q0 = *(const half8*)(qp_); nxt.k0 = *(const half8*)(qp_ + 512); nxt.q1 = *(const half8*)(qp_ + LD0); nxt.k1 = *(const half8*)(qp_ + LD0 + 512); \
    _Pragma("unroll") for (int r = 0; r < 16; ++r) nxt.w[r] = P.gla_w_gk_up[r * 512 + ch_]; \
    nxt.bb = P.gla_b_gk[ch_]; \
    if (h_ == 0 && tid < 256) gnx = *(const f32x4*)(P.glr + (size_t)(chunk_ * 64) * 16 + tid * 4); }
  GLA_PREP_LOAD(0)
#pragma unroll 1
  for (int j = 0; j < nj; ++j) {
    const int chunk = (int)blockIdx.x + (j >> 2) * G, h = j & 3;
    const int t0 = chunk * 64, ch = h * 128 + c;
    const GlaPrepOps cur = nxt;
    __syncthreads();
    if (h == 0 && tid < 256) *(f32x4*)(sm + tid * 4) = gnx;
    if (j + 1 < nj) GLA_PREP_LOAD(j + 1)
    __syncthreads();
    float pre[16]; float cum = 0.f;
#pragma unroll
    for (int i = 0; i < 16; ++i) {
      float u = cur.bb;
#pragma unroll
      for (int r = 0; r < 16; ++r) u += glr[tq * 16 + i][r] * cur.w[r];
      cum += logsigmoidf(u) * (1.f / 16.f);
      pre[i] = cum;
    }
    tot[tq][c] = cum;
    __syncthreads();
    float off = 0.f;
#pragma unroll
    for (int t = 0; t < 3; ++t) if (t < tq) off += tot[t][c];
#pragma unroll
    for (int i = 0; i < 16; ++i) {
      const float ex = fast_exp2((pre[i] + off) * LOG2E);
      exl[tq * 16 + i][c] = ex;
      if (tq == 3 && i == 15) P.bcum[(size_t)chunk * 512 + ch] = ex;
    }
    __syncthreads();
    {
      half_t* qp = P.p + (size_t)(t0 + 2 * tp) * LD0 + h * 128 + co * 8;
      const f32x4 e00 = *(const f32x4*)&exl[2 * tp][co * 8], e01 = *(const f32x4*)&exl[2 * tp][co * 8 + 4];
      const f32x4 e10 = *(const f32x4*)&exl[2 * tp + 1][co * 8], e11 = *(const f32x4*)&exl[2 * tp + 1][co * 8 + 4];
      half8 oq0, ok0, oq1, ok1;
#pragma unroll
      for (int e = 0; e < 8; ++e) {
        const float x0 = e < 4 ? e00[e] : e01[e - 4], x1 = e < 4 ? e10[e] : e11[e - 4];
        oq0[e] = (half_t)((float)cur.q0[e] * scale * x0); ok0[e] = (half_t)((float)cur.k0[e] * __builtin_amdgcn_rcpf(x0));
        oq1[e] = (half_t)((float)cur.q1[e] * scale * x1); ok1[e] = (half_t)((float)cur.k1[e] * __builtin_amdgcn_rcpf(x1));
      }
      *(half8*)(qp) = oq0; *(half8*)(qp + 512) = ok0; *(half8*)(qp + LD0) = oq1; *(half8*)(qp + LD0 + 512) = ok1;
    }
  }
#undef GLA_PREP_LOAD
}

constexpr int GLA_QE = 0, GLA_KE = 16384, GLA_V = 32768, GLA_DEC = 49152, GLA_BUF = 53248;
#define GLA_TR4(d0, d1, d2, d3, addr, o0, o1, o2, o3) \
  asm volatile("ds_read_b64_tr_b16 %0, %4 offset:%5\n\tds_read_b64_tr_b16 %1, %4 offset:%6\n\tds_read_b64_tr_b16 %2, %4 offset:%7\n\tds_read_b64_tr_b16 %3, %4 offset:%8" \
               : "=&v"(d0), "=&v"(d1), "=&v"(d2), "=&v"(d3) : "v"(addr), "n"(o0), "n"(o1), "n"(o2), "n"(o3) : "memory")
__device__ __forceinline__ half8 pack_h8(const v2i a, const v2i b) { const v4i p = (v4i){a[0], a[1], b[0], b[1]}; return __builtin_bit_cast(half8, p); }

template <bool STATE_ONLY>
__device__ void ph_gla_mfma(const Params& P, char* smem, int wvs) {
  const int tid = otid(wvs);
  const int lane = tid & 63, wave = __builtin_amdgcn_readfirstlane(tid >> 6), r15 = lane & 15, q = lane >> 4;
  const int qp = r15 >> 2, pp = lane & 3;
  const int srow = tid >> 4, sslot = tid & 15;
  const int src_q = (sslot ^ (srow & 15)) * 8, src_kv = (sslot ^ ((srow & 7) << 1)) * 8;
  const int fk = ((4 * (q & 1) + qp) & 7) << 1;
  const unsigned tr_row = (unsigned)((4 * q + qp) * 256 + 8 * (pp & 1) + ((pp >> 1) << 4));
  constexpr int NLOAD = STATE_ONLY ? 5 : 7;
  for (int item = blockIdx.x; item < (STATE_ONLY ? 3 : 4) * 64; item += gridDim.x) {
    const int seg = item >> 6, base = item & 63, b = base >> 3, h = (base >> 1) & 3, vs = base & 1;
    const int c0 = seg * 16;
    f32x4 S[8], Dacc[8];
#pragma unroll
    for (int df = 0; df < 8; ++df) { S[df] = (f32x4){0.f, 0.f, 0.f, 0.f}; Dacc[df] = (f32x4){1.f, 1.f, 1.f, 1.f}; }
    f32x4* stL = (f32x4*)P.gla_state + ((size_t)base * 8 + wave) * 8 * 64 + lane;
    f32x4* stD = stL + (size_t)3 * 64 * 8 * 8 * 64;
    if (!STATE_ONLY) {
      for (int k = 0; k < seg; ++k) {
#pragma unroll
        for (int df = 0; df < 8; ++df) {
          const f32x4 Lk = stL[((size_t)k * 64 * 8 * 8 + df) * 64];
          if (k == 0) S[df] = Lk;
          else { const f32x4 Dk = stD[((size_t)k * 64 * 8 * 8 + df) * 64]; S[df] = Dk * S[df] + Lk; }
        }
      }
    }
    const half_t* qsrc = P.p + (size_t)(b * SEQ + srow) * LD0 + h * 128;
    const half_t* vsrc = P.p + (size_t)(b * SEQ + srow) * LD0 + 1024 + h * 256 + vs * 128 + src_kv;
    const float* dsrc = P.bcum + (size_t)(b * 64 + c0) * 512 + h * 128 + (lane & 31) * 4;
#define G_ISSUE(N, BUF) { char* lb_ = smem + (BUF) * GLA_BUF + wave * 1024; const size_t ro_ = (size_t)(c0 + (N)) * 64 * LD0; \
      if (!STATE_ONLY) { __builtin_amdgcn_global_load_lds((gbl_void*)(qsrc + ro_ + src_q), (lds_void*)(lb_ + GLA_QE), 16, 0, 0); \
      __builtin_amdgcn_global_load_lds((gbl_void*)(qsrc + ro_ + (size_t)32 * LD0 + src_q), (lds_void*)(lb_ + GLA_QE + 8192), 16, 0, 0); } \
      __builtin_amdgcn_global_load_lds((gbl_void*)(qsrc + ro_ + 512 + src_kv), (lds_void*)(lb_ + GLA_KE), 16, 0, 0); \
      __builtin_amdgcn_global_load_lds((gbl_void*)(qsrc + ro_ + (size_t)32 * LD0 + 512 + src_kv), (lds_void*)(lb_ + GLA_KE + 8192), 16, 0, 0); \
      __builtin_amdgcn_global_load_lds((gbl_void*)(vsrc + ro_), (lds_void*)(lb_ + GLA_V), 16, 0, 0); \
      __builtin_amdgcn_global_load_lds((gbl_void*)(vsrc + ro_ + (size_t)32 * LD0), (lds_void*)(lb_ + GLA_V + 8192), 16, 0, 0); \
      if (lane < 32) __builtin_amdgcn_global_load_lds((gbl_void*)(dsrc + (size_t)(N) * 512), (lds_void*)(smem + (BUF) * GLA_BUF + GLA_DEC + wave * 512), 16, 0, 0); }
    G_ISSUE(0, 0)
    G_ISSUE(1, 1)
#pragma unroll 1
    for (int n = 0; n < 16; ++n) {
      if (n + 1 < 16) wait_vmcnt<NLOAD>(); else wait_vmcnt<0>();
      __builtin_amdgcn_s_barrier();
      if (n + 2 < 16) G_ISSUE(n + 2, (n + 2) % 3)
      const char* cb = smem + (n % 3) * GLA_BUF;
      f32x4 aT[4][4];
      if (!STATE_ONLY) {
#pragma unroll
      for (int kf = 0; kf < 4; ++kf)
#pragma unroll
        for (int tf = 0; tf < 4; ++tf) aT[kf][tf] = (f32x4){0.f, 0.f, 0.f, 0.f};
#pragma unroll
      for (int ks = 0; ks < 4; ++ks) {
        half8 kef[4], qef[4];
#pragma unroll
        for (int f = 0; f < 4; ++f) {
          kef[f] = *(const half8*)(cb + GLA_KE + (16 * f + r15) * 256 + (((4 * ks + q) ^ ((r15 & 7) << 1)) << 4));
          qef[f] = *(const half8*)(cb + GLA_QE + (16 * f + r15) * 256 + (((4 * ks + q) ^ r15) << 4));
        }
#pragma unroll
        for (int kf = 0; kf < 4; ++kf)
#pragma unroll
          for (int tf = kf; tf < 4; ++tf) aT[kf][tf] = __builtin_amdgcn_mfma_f32_16x16x32_f16(kef[kf], qef[tf], aT[kf][tf], 0, 0, 0);
      }
#pragma unroll
      for (int f = 0; f < 4; ++f)
#pragma unroll
        for (int r = 0; r < 4; ++r) if (4 * q + r > r15) aT[f][f][r] = 0.f;
      }
      const unsigned lds0 = (unsigned)(size_t)cb;
      const unsigned va = lds0 + GLA_V + tr_row + ((((2 * wave) ^ fk)) << 4);
      v2i v00, v01, v10, v11;
      GLA_TR4(v00, v01, v10, v11, va, 0, 4096, 8192, 12288);
      const unsigned ka = lds0 + GLA_KE + tr_row;
      v2i k0[4][4];
#pragma unroll
      for (int df = 0; df < 4; ++df) { const unsigned a_ = ka + ((((2 * df) ^ fk)) << 4); GLA_TR4(k0[df][0], k0[df][1], k0[df][2], k0[df][3], a_, 0, 4096, 8192, 12288); }
      asm volatile("s_waitcnt lgkmcnt(15)" : "+v"(v00), "+v"(v01), "+v"(v10), "+v"(v11) :: "memory");
      __builtin_amdgcn_sched_barrier(0);
      half8 vf[2];
      vf[0] = pack_h8(v00, v01); vf[1] = pack_h8(v10, v11);
      if (!STATE_ONLY) {
      f32x4 o[4];
#pragma unroll
      for (int tf = 0; tf < 4; ++tf) o[tf] = (f32x4){0.f, 0.f, 0.f, 0.f};
#pragma unroll
      for (int ks2 = 0; ks2 < 2; ++ks2)
#pragma unroll
        for (int tf = 2 * ks2; tf < 4; ++tf) {
          half8 pk;
#pragma unroll
          for (int r = 0; r < 4; ++r) { pk[r] = (half_t)aT[2 * ks2][tf][r]; pk[4 + r] = (half_t)aT[2 * ks2 + 1][tf][r]; }
          o[tf] = __builtin_amdgcn_mfma_f32_16x16x32_f16(vf[ks2], pk, o[tf], 0, 0, 0);
        }
#pragma unroll
      for (int ks = 0; ks < 4; ++ks) {
        half8 sf;
#pragma unroll
        for (int r = 0; r < 4; ++r) { sf[r] = (half_t)S[2 * ks][r]; sf[4 + r] = (half_t)S[2 * ks + 1][r]; }
#pragma unroll
        for (int tf = 0; tf < 4; ++tf) {
          const int row = 16 * tf + r15;
          const half4 qa = *(const half4*)(cb + GLA_QE + row * 256 + (((4 * ks + (q >> 1)) ^ r15) << 4) + (q & 1) * 8);
          const half4 qb = *(const half4*)(cb + GLA_QE + row * 256 + (((4 * ks + 2 + (q >> 1)) ^ r15) << 4) + (q & 1) * 8);
          half8 qv;
#pragma unroll
          for (int e = 0; e < 4; ++e) { qv[e] = qa[e]; qv[4 + e] = qb[e]; }
          o[tf] = __builtin_amdgcn_mfma_f32_16x16x32_f16(sf, qv, o[tf], 0, 0, 0);
        }
      }
      {
        const size_t t0 = (size_t)(b * SEQ + (c0 + n) * 64);
#pragma unroll
        for (int tf = 0; tf < 4; ++tf) {
          half4 hv; hv[0] = (half_t)o[tf][0]; hv[1] = (half_t)o[tf][1]; hv[2] = (half_t)o[tf][2]; hv[3] = (half_t)o[tf][3];
          *(half4*)(P.og + (t0 + 16 * tf + r15) * DM + h * 256 + vs * 128 + 16 * wave + 4 * q) = hv;
        }
      }
      }
      v2i k1[4][4];
#pragma unroll
      for (int df = 0; df < 4; ++df) { const unsigned a_ = ka + ((((2 * (df + 4)) ^ fk)) << 4); GLA_TR4(k1[df][0], k1[df][1], k1[df][2], k1[df][3], a_, 0, 4096, 8192, 12288); }
      asm volatile("s_waitcnt lgkmcnt(15)"
                   : "+v"(k0[0][0]), "+v"(k0[0][1]), "+v"(k0[0][2]), "+v"(k0[0][3]), "+v"(k0[1][0]), "+v"(k0[1][1]), "+v"(k0[1][2]), "+v"(k0[1][3]),
                     "+v"(k0[2][0]), "+v"(k0[2][1]), "+v"(k0[2][2]), "+v"(k0[2][3]), "+v"(k0[3][0]), "+v"(k0[3][1]), "+v"(k0[3][2]), "+v"(k0[3][3]) :: "memory");
      __builtin_amdgcn_sched_barrier(0);
#pragma unroll
      for (int df = 0; df < 4; ++df) {
        S[df] = __builtin_amdgcn_mfma_f32_16x16x32_f16(pack_h8(k0[df][0], k0[df][1]), vf[0], S[df], 0, 0, 0);
        S[df] = __builtin_amdgcn_mfma_f32_16x16x32_f16(pack_h8(k0[df][2], k0[df][3]), vf[1], S[df], 0, 0, 0);
      }
      asm volatile("s_waitcnt lgkmcnt(0)"
                   : "+v"(k1[0][0]), "+v"(k1[0][1]), "+v"(k1[0][2]), "+v"(k1[0][3]), "+v"(k1[1][0]), "+v"(k1[1][1]), "+v"(k1[1][2]), "+v"(k1[1][3]),
                     "+v"(k1[2][0]), "+v"(k1[2][1]), "+v"(k1[2][2]), "+v"(k1[2][3]), "+v"(k1[3][0]), "+v"(k1[3][1]), "+v"(k1[3][2]), "+v"(k1[3][3]) :: "memory");
      __builtin_amdgcn_sched_barrier(0);
#pragma unroll
      for (int df = 0; df < 4; ++df) {
        S[df + 4] = __builtin_amdgcn_mfma_f32_16x16x32_f16(pack_h8(k1[df][0], k1[df][1]), vf[0], S[df + 4], 0, 0, 0);
        S[df + 4] = __builtin_amdgcn_mfma_f32_16x16x32_f16(pack_h8(k1[df][2], k1[df][3]), vf[1], S[df + 4], 0, 0, 0);
      }
#pragma unroll
      for (int df = 0; df < 8; ++df) {
        const f32x4 dc = *(const f32x4*)(cb + GLA_DEC + wave * 512 + (16 * df + 4 * q) * 4);
        S[df] *= dc;
        if (STATE_ONLY) Dacc[df] *= dc;
      }
    }
    if (STATE_ONLY) {
#pragma unroll
      for (int df = 0; df < 8; ++df) { stL[((size_t)seg * 64 * 8 * 8 + df) * 64] = S[df]; stD[((size_t)seg * 64 * 8 * 8 + df) * 64] = Dacc[df]; }
    }
    asm volatile("s_waitcnt vmcnt(0)" ::: "memory");
    __builtin_amdgcn_s_barrier();
#undef G_ISSUE
  }
}

__device__ void ph_gla_post(const Params& P, int wvs) {
  const int tid_ = otid(wvs); const int lane = tid_ & 63, sub = lane & 31;
  const int u0 = blockIdx.x * 16 + (tid_ >> 5);
  const float4 hn0 = ((const float4*)P.gla_head_norm)[sub * 2], hn1 = ((const float4*)P.gla_head_norm)[sub * 2 + 1];
  constexpr int UW = 4;
  const int ustride = gridDim.x * 16;
#pragma unroll 1
  for (int ub = u0; ub < T_TOK * 4; ub += ustride * UW) {
    half8 hv[UW], z[UW];
#pragma unroll
    for (int r = 0; r < UW; ++r) {
      const int u = ub + r * ustride, t = u >> 2, h = u & 3;
      hv[r] = *((const half8*)(P.og + (size_t)t * DM + h * 256) + sub);
      z[r] = *((const half8*)(P.p + (size_t)t * LD0 + 2048 + h * 256) + sub);
    }
#pragma unroll
    for (int r = 0; r < UW; ++r) {
      const int u = ub + r * ustride, t = u >> 2, h = u & 3;
      float v[8]; float ss = 0.f;
#pragma unroll
      for (int e = 0; e < 8; ++e) { v[e] = (float)hv[r][e]; ss += v[e] * v[e]; }
#pragma unroll
      for (int o = 16; o > 0; o >>= 1) ss += __shfl_xor(ss, o);
      const float rr = rsqrtf(ss * (1.f / 256.f) + EPS);
      const float hn[8] = {hn0.x, hn0.y, hn0.z, hn0.w, hn1.x, hn1.y, hn1.z, hn1.w};
      half8 o;
#pragma unroll
      for (int e = 0; e < 8; ++e) o[e] = (half_t)(v[e] * rr * hn[e] * siluf((float)z[r][e]));
      *((half8*)(P.og + (size_t)t * DM + h * 256) + sub) = o;
    }
  }
}

template <bool FINAL>
__device__ void ph_post(const half_t* baseh, const half_t* y, const float* g, float* dst, half_t* dsth, float* rstd_out, int wvs) {
  const int tid_ = otid(wvs); const int lane = tid_ & 63, w = tid_ >> 6;
  constexpr int RW = 4;
  const int rstride = gridDim.x * NWAVES;
#pragma unroll 1
  for (int row0 = blockIdx.x * NWAVES + w; row0 < T_TOK; row0 += rstride * RW) {
    half4 yv[RW][4], bv[RW][4];
#pragma unroll
    for (int r = 0; r < RW; ++r)
#pragma unroll
      for (int i = 0; i < 4; ++i) yv[r][i] = ((const half4*)(y + (size_t)(row0 + r * rstride) * DM))[lane + 64 * i];
#pragma unroll
    for (int r = 0; r < RW; ++r)
#pragma unroll
      for (int i = 0; i < 4; ++i) bv[r][i] = ((const half4*)(baseh + (size_t)(row0 + r * rstride) * DM))[lane + 64 * i];
#pragma unroll
    for (int r = 0; r < RW; ++r) {
      const int row = row0 + r * rstride;
      float ss = 0.f;
#pragma unroll
      for (int i = 0; i < 4; ++i)
#pragma unroll
        for (int e = 0; e < 4; ++e) { const float t = (float)yv[r][i][e]; ss += t * t; }
      ss = wave_sum(ss);
      const float rr = rsqrtf(ss * (1.f / DM) + EPS);
      float s2 = 0.f;
#pragma unroll
      for (int i = 0; i < 4; ++i) {
        const float4 gg = ((const float4*)g)[lane + 64 * i];
        float4 o;
        o.x = (float)bv[r][i][0] + (float)yv[r][i][0] * rr * gg.x; o.y = (float)bv[r][i][1] + (float)yv[r][i][1] * rr * gg.y;
        o.z = (float)bv[r][i][2] + (float)yv[r][i][2] * rr * gg.z; o.w = (float)bv[r][i][3] + (float)yv[r][i][3] * rr * gg.w;
        if (FINAL) ((float4*)(dst + (size_t)row * DM))[lane + 64 * i] = o;
        else {
          s2 += o.x * o.x + o.y * o.y + o.z * o.z + o.w * o.w;
          half4 hv; hv[0] = (half_t)o.x; hv[1] = (half_t)o.y; hv[2] = (half_t)o.z; hv[3] = (half_t)o.w;
          ((half4*)(dsth + (size_t)row * DM))[lane + 64 * i] = hv;
        }
      }
      if (!FINAL) { s2 = wave_sum(s2); if (lane == 0) rstd_out[row] = rsqrtf(s2 * (1.f / DM) + EPS); }
    }
  }
}

template <int NF>
__device__ void ph_rowproj(const Params& P, const half_t* Wt, float* out, char* smem, int wvs, int first_block) {
  const int tid = otid(wvs), lane = tid & 63, wave = tid >> 6, r15 = lane & 15, q = lane >> 4;
  const int nb = gridDim.x - first_block;
  if ((int)blockIdx.x < first_block) return;
  __syncthreads();
  for (int c = tid; c < 16 * NF * 128; c += NTHREADS) {
    const int row = c >> 7, ch = c & 127;
    *(uint4*)(smem + row * 2064 + ch * 16) = *(const uint4*)(Wt + (size_t)row * DM + ch * 8);
  }
  __syncthreads();
  for (int tile = (int)blockIdx.x - first_block; tile < T_TOK / 128; tile += nb) {
    const int tok = tile * 128 + wave * 16 + r15;
    const half_t* ap = P.xh + (size_t)tok * DM + 8 * q;
    const char* bp = smem + r15 * 2064 + 16 * q;
    f32x4 acc[NF];
#pragma unroll
    for (int n = 0; n < NF; ++n) acc[n] = (f32x4){0.f, 0.f, 0.f, 0.f};
#pragma unroll 1
    for (int s0 = 0; s0 < 32; s0 += 16) {
      half8 a[16];
#pragma unroll
      for (int i = 0; i < 16; ++i) a[i] = *(const half8*)(ap + 32 * (s0 + i));
#pragma unroll
      for (int i = 0; i < 16; ++i) {
#pragma unroll
        for (int n = 0; n < NF; ++n) {
          const half8 bw = *(const half8*)(bp + n * 16 * 2064 + (s0 + i) * 64);
          acc[n] = __builtin_amdgcn_mfma_f32_16x16x32_f16(bw, a[i], acc[n], 0, 0, 0);
        }
      }
    }
    const float rs = P.rstd[tok];
#pragma unroll
    for (int n = 0; n < NF; ++n) *(f32x4*)(out + (size_t)tok * (16 * NF) + 16 * n + 4 * q) = acc[n] * rs;
  }
  __syncthreads();
}

__device__ void ph_kmax(const Params& P, int wvs, int first_block) {
  const int tid = otid(wvs);
  for (int task = (int)blockIdx.x - first_block; task < NBATCH * 4 * 2 * 8; task += gridDim.x - first_block) {
    const int chunk = task & 7, br = (task >> 3) & 1, bg = task >> 4, b = bg >> 2, g = bg & 3;
    const half_t* kp = P.p + (size_t)(b * SEQ + chunk * 512 + tid) * LD1 + (br ? 2048 : 1536) + g * 64;
    float ss = 0.f;
#pragma unroll
    for (int c = 0; c < 8; ++c) {
      const half8 v = *(const half8*)(kp + c * 8);
#pragma unroll
      for (int e = 0; e < 8; ++e) ss += (float)v[e] * (float)v[e];
    }
    ss = wave_max(ss);
    if ((tid & 63) == 0) __hip_atomic_fetch_max(&P.kmax2[bg * 2 + br], __float_as_uint(ss), __ATOMIC_RELAXED, __HIP_MEMORY_SCOPE_AGENT);
  }
}

constexpr int ATT_NB = 6, ATT_D = 5;
constexpr int ATT_K = 0, ATT_V = ATT_NB * 8192, ATT_Z = 2 * ATT_NB * 8192, ATT_IMP = ATT_Z + 32768, ATT_SELM = ATT_IMP + 64 * 68 * 4;
constexpr int IMPS = 68;
constexpr int ATT_GATE = ATT_SELM + 512;

__device__ __forceinline__ void attn_issue(char* smem, const half_t* kbase, const half_t* vbase, int ld, int tile_lo, int tile_hi, int wvs, int rot = 0) {
  const int tid = otid(wvs);
  const int lrow = tid >> 3, lch = tid & 7;
  const int ksrc = (lch ^ ((lrow >> 1) & 7)) * 8, vsrc = (lch ^ (((lrow >> 1) & 3) << 1)) * 8;
  const int wbase = __builtin_amdgcn_readfirstlane(tid >> 6) * 1024;
#pragma unroll
  for (int i = 0; i < ATT_D; ++i) if (tile_lo + i <= tile_hi) {
    const int nt_ = tile_hi - tile_lo + 1, tr_ = tile_lo + ((rot + i >= nt_) ? rot + i - nt_ : rot + i);
    const half_t* kp_ = kbase + (size_t)(tr_ * 64 + lrow) * ld + ksrc;
    const half_t* vp_ = vbase + (size_t)(tr_ * 64 + lrow) * ld + vsrc;
    __builtin_amdgcn_global_load_lds((gbl_void*)kp_, (lds_void*)(smem + ATT_K + i * 8192 + wbase), 16, 0, 0);
    __builtin_amdgcn_global_load_lds((gbl_void*)vp_, (lds_void*)(smem + ATT_V + i * 8192 + wbase), 16, 0, 0);
  }
}

template <int MODE, bool PREISSUED = false>
__device__ __forceinline__ void attn_branch(char* smem, const half_t* kbase, const half_t* vbase, int ld, int tile_lo, int tile_hi, int n, int th,
                                            const half8 (&qf)[2][2], float (&m)[2], float (&l)[2], f32x4 (&o)[4][2],
                                            const unsigned long long (&selm)[2], int wvs) {
  const int tid = otid(wvs);
  const int lane = tid & 63, r15 = lane & 15, q = lane >> 4;
  const int lrow = tid >> 3, lch = tid & 7;
  const int k_rd = r15 * 128, kswz = r15 >> 1;
  const int qp = r15 >> 2, pp = lane & 3;
  const int fx = ((2 * q + (qp >> 1)) & 3) << 1;
  const int v_rd = (4 * q + qp) * 128 + 8 * (pp & 1) + ((pp >> 1) << 4);
  unsigned int* impu = (unsigned int*)(smem + ATT_IMP);
  const int ksrc = (lch ^ ((lrow >> 1) & 7)) * 8, vsrc = (lch ^ (((lrow >> 1) & 3) << 1)) * 8;
  const int wbase = __builtin_amdgcn_readfirstlane(tid >> 6) * 1024;
#define A_GLOAD(TI, BUF) { const half_t* kp_ = kbase + (size_t)((TI) * 64 + lrow) * ld + ksrc; \
    __builtin_amdgcn_global_load_lds((gbl_void*)kp_, (lds_void*)(smem + ATT_K + (BUF) * 8192 + wbase), 16, 0, 0); \
    { const half_t* vp_ = vbase + (size_t)((TI) * 64 + lrow) * ld + vsrc; \
      __builtin_amdgcn_global_load_lds((gbl_void*)vp_, (lds_void*)(smem + ATT_V + (BUF) * 8192 + wbase), 16, 0, 0); } }
  constexpr int GPT = 2;
  f32x4 lacc[2] = {(f32x4){0.f, 0.f, 0.f, 0.f}, (f32x4){0.f, 0.f, 0.f, 0.f}};
  if (MODE != 1 && !PREISSUED) {
#pragma unroll
    for (int i = 0; i < ATT_D; ++i) if (tile_lo + i <= tile_hi) A_GLOAD(tile_lo + i, i)
  }
#pragma unroll 1
  for (int ti = tile_lo; ti <= tile_hi; ++ti) {
    const int it = ti - tile_lo, cur = it % ATT_NB;
    if (MODE != 1) {
      const int rem = tile_hi - ti;
      if (rem >= 4) wait_vmcnt<4 * GPT>(); else if (rem == 3) wait_vmcnt<3 * GPT>(); else if (rem == 2) wait_vmcnt<2 * GPT>();
      else if (rem == 1) wait_vmcnt<1 * GPT>(); else wait_vmcnt<0>();
    }
    __builtin_amdgcn_s_barrier();
    if (MODE != 1) { if (ti + ATT_D <= tile_hi) A_GLOAD(ti + ATT_D, (it + ATT_D) % ATT_NB) }
    const char* kb = smem + ATT_K + cur * 8192 + k_rd;
    const unsigned vbl = (unsigned)(size_t)(smem + ATT_V + cur * 8192 + v_rd);
    bool need_mask;
    if (MODE <= 1) need_mask = (ti * 64 + 63 > 4 * n - 2);
    else if (MODE == 2) need_mask = (ti == n);
    else need_mask = (ti == n) || (ti == n - 8);
    f32x4 s[4][2];
#pragma unroll
    for (int t2 = 0; t2 < 2; ++t2) {
      float c0 = 0.f;
      if (MODE >= 2) { c0 = -m[t2]; if (MODE == 2 && !((selm[t2] >> ti) & 1ull)) c0 = -INFINITY; }
#pragma unroll
      for (int kf = 0; kf < 4; ++kf) s[kf][t2] = (f32x4){c0, c0, c0, c0};
    }
#pragma unroll
    for (int ks = 0; ks < 2; ++ks) {
      const int co = ((4 * ks + q) ^ kswz) << 4;
#pragma unroll
      for (int kf = 0; kf < 4; ++kf) {
        const half8 kfr = *(const half8*)(kb + kf * 2048 + co);
#pragma unroll
        for (int t2 = 0; t2 < 2; ++t2) s[kf][t2] = __builtin_amdgcn_mfma_f32_16x16x32_f16(kfr, qf[t2][ks], s[kf][t2], 0, 0, 0);
      }
    }
    v2i vr[4][4];
    if (MODE != 0) {
      const unsigned va0 = vbl + (((0) ^ fx) << 4), va1 = vbl + (((2) ^ fx) << 4), va2 = vbl + (((4) ^ fx) << 4), va3 = vbl + (((6) ^ fx) << 4);
      asm volatile(
          "ds_read_b64_tr_b16 %0, %16\n\tds_read_b64_tr_b16 %1, %16 offset:2048\n\tds_read_b64_tr_b16 %2, %16 offset:4096\n\tds_read_b64_tr_b16 %3, %16 offset:6144\n\t"
          "ds_read_b64_tr_b16 %4, %17\n\tds_read_b64_tr_b16 %5, %17 offset:2048\n\tds_read_b64_tr_b16 %6, %17 offset:4096\n\tds_read_b64_tr_b16 %7, %17 offset:6144\n\t"
          "ds_read_b64_tr_b16 %8, %18\n\tds_read_b64_tr_b16 %9, %18 offset:2048\n\tds_read_b64_tr_b16 %10, %18 offset:4096\n\tds_read_b64_tr_b16 %11, %18 offset:6144\n\t"
          "ds_read_b64_tr_b16 %12, %19\n\tds_read_b64_tr_b16 %13, %19 offset:2048\n\tds_read_b64_tr_b16 %14, %19 offset:4096\n\tds_read_b64_tr_b16 %15, %19 offset:6144"
          : "=&v"(vr[0][0]), "=&v"(vr[0][1]), "=&v"(vr[0][2]), "=&v"(vr[0][3]), "=&v"(vr[1][0]), "=&v"(vr[1][1]), "=&v"(vr[1][2]), "=&v"(vr[1][3]),
            "=&v"(vr[2][0]), "=&v"(vr[2][1]), "=&v"(vr[2][2]), "=&v"(vr[2][3]), "=&v"(vr[3][0]), "=&v"(vr[3][1]), "=&v"(vr[3][2]), "=&v"(vr[3][3])
          : "v"(va0), "v"(va1), "v"(va2), "v"(va3)
          : "memory");
    }
    if (need_mask) {
#pragma unroll
      for (int t2 = 0; t2 < 2; ++t2) {
        const int tok = th * 32 + t2 * 16 + r15;
        int lo = 0, hi = 63;
        if (MODE <= 1) { hi = 4 * n + ((tok - 31) >> 4) - ti * 64; }
        else if (MODE == 2) { hi = tok; }
        else { if (ti == n) hi = tok; else lo = tok + 1; }
#pragma unroll
        for (int kf = 0; kf < 4; ++kf)
#pragma unroll
          for (int r = 0; r < 4; ++r) {
            const int kk = kf * 16 + 4 * q + r;
            if (kk < lo || kk > hi) s[kf][t2][r] = -INFINITY;
          }
      }
    }
    half8 pf[2][2];
#pragma unroll
    for (int t2 = 0; t2 < 2; ++t2) {
      float mb = 0.f, scale_p = 1.f;
      if (MODE == 1) {
        mb = m[t2]; scale_p = l[t2];
      } else if (MODE == 0) {
        float tm = s[0][t2][0];
#pragma unroll
        for (int kf = 0; kf < 4; ++kf)
#pragma unroll
          for (int r = 0; r < 4; ++r) tm = fmaxf(tm, s[kf][t2][r]);
        tm = rowmax4(tm);
        const float mn = fmaxf(m[t2], tm);
        const float alpha = fexp2(m[t2] - mn);
        m[t2] = mn; mb = mn;
        l[t2] *= alpha;
      }
      float lsum = 0.f;
#pragma unroll
      for (int kf = 0; kf < 4; ++kf) {
#pragma unroll
        for (int r = 0; r < 4; ++r) {
          float pv = (MODE >= 2) ? fexp2(s[kf][t2][r]) : fexp2(s[kf][t2][r] - mb);
          if (MODE == 1) pv *= scale_p;
          s[kf][t2][r] = pv; if (MODE == 0) lsum += pv;
        }
      }
      if (MODE == 0) l[t2] += lsum;
      if (MODE == 1) {
        const int tok = th * 32 + t2 * 16 + r15;
#pragma unroll
        for (int kf = 0; kf < 4; ++kf) {
          const int j = 16 * ti + 4 * kf + q;
          const unsigned int u0 = (unsigned int)(s[kf][t2][0] * 134217728.f + 0.5f), u1 = (unsigned int)(s[kf][t2][1] * 134217728.f + 0.5f);
          const unsigned int u2 = (unsigned int)(s[kf][t2][2] * 134217728.f + 0.5f), u3 = (unsigned int)(s[kf][t2][3] * 134217728.f + 0.5f);
          if (j < 64) {
            atomicAdd(&impu[tok * IMPS + j], u0 + u1 + u2 + u3);
            atomicAdd(&impu[tok * IMPS + j + 1], u3);
          }
        }
      }
      if (MODE != 0) {
#pragma unroll
        for (int ks = 0; ks < 2; ++ks) {
          half8 pk;
#pragma unroll
          for (int r = 0; r < 4; ++r) { pk[r] = (half_t)s[2 * ks][t2][r]; pk[4 + r] = (half_t)s[2 * ks + 1][t2][r]; }
          pf[t2][ks] = pk;
        }
      }
    }
    if (MODE != 0) {
      asm volatile("s_waitcnt lgkmcnt(0)"
                   : "+v"(vr[0][0]), "+v"(vr[0][1]), "+v"(vr[0][2]), "+v"(vr[0][3]), "+v"(vr[1][0]), "+v"(vr[1][1]), "+v"(vr[1][2]), "+v"(vr[1][3]),
                     "+v"(vr[2][0]), "+v"(vr[2][1]), "+v"(vr[2][2]), "+v"(vr[2][3]), "+v"(vr[3][0]), "+v"(vr[3][1]), "+v"(vr[3][2]), "+v"(vr[3][3])
                   :: "memory");
      __builtin_amdgcn_sched_barrier(0);
#pragma unroll
      for (int df = 0; df < 4; ++df) {
#pragma unroll
        for (int ks = 0; ks < 2; ++ks) {
          const v2i lo2 = vr[df][2 * ks], hi2 = vr[df][2 * ks + 1];
          const v4i pk4 = (v4i){lo2[0], lo2[1], hi2[0], hi2[1]};
          const half8 vf = __builtin_bit_cast(half8, pk4);
#pragma unroll
          for (int t2 = 0; t2 < 2; ++t2) o[df][t2] = __builtin_amdgcn_mfma_f32_16x16x32_f16(vf, pf[t2][ks], o[df][t2], 0, 0, 0);
        }
      }
      if (MODE >= 2) {
        const half8 ones = (half8){(half_t)1.f, (half_t)1.f, (half_t)1.f, (half_t)1.f, (half_t)1.f, (half_t)1.f, (half_t)1.f, (half_t)1.f};
#pragma unroll
        for (int ks = 0; ks < 2; ++ks)
#pragma unroll
          for (int t2 = 0; t2 < 2; ++t2) lacc[t2] = __builtin_amdgcn_mfma_f32_16x16x32_f16(ones, pf[t2][ks], lacc[t2], 0, 0, 0);
      }
    }
  }
  if (MODE >= 2) { l[0] = lacc[0][0]; l[1] = lacc[1][0]; }
  __syncthreads();
#undef A_GLOAD
}

__device__ __forceinline__ void attn_cmp(char* smem, int tile_hi, int n, int th, const half8 (&qf)[2][2], const float (&moff)[2], f32x4 (&o)[4][2], int wvs) {
  const int tid = otid(wvs);
  const int lane = tid & 63, r15 = lane & 15, q = lane >> 4;
  const int k_rd = r15 * 128, kswz = r15 >> 1;
  const int qp = r15 >> 2, pp = lane & 3;
  const int fx = ((2 * q + (qp >> 1)) & 3) << 1;
  const int v_rd = (4 * q + qp) * 128 + 8 * (pp & 1) + ((pp >> 1) << 4);
  unsigned int* impu = (unsigned int*)(smem + ATT_IMP);
  float lsum[2] = {0.f, 0.f};
  float usum[4][4][2], carry[2] = {0.f, 0.f};
#pragma unroll
  for (int ti = 0; ti < 4; ++ti) {
    if (ti <= tile_hi) {
      const int rem = tile_hi - ti;
      if (rem >= 3) wait_vmcnt<6>(); else if (rem == 2) wait_vmcnt<4>(); else if (rem == 1) wait_vmcnt<2>(); else wait_vmcnt<0>();
      __builtin_amdgcn_s_barrier();
      const char* kb = smem + ATT_K + ti * 8192 + k_rd;
      const unsigned vbl = (unsigned)(size_t)(smem + ATT_V + ti * 8192 + v_rd);
      f32x4 s[4][2];
#pragma unroll
      for (int t2 = 0; t2 < 2; ++t2) {
        const float c0 = -moff[t2];
#pragma unroll
        for (int kf = 0; kf < 4; ++kf) s[kf][t2] = (f32x4){c0, c0, c0, c0};
      }
#pragma unroll
      for (int ks = 0; ks < 2; ++ks) {
        const int co = ((4 * ks + q) ^ kswz) << 4;
#pragma unroll
        for (int kf = 0; kf < 4; ++kf) {
          const half8 kfr = *(const half8*)(kb + kf * 2048 + co);
#pragma unroll
          for (int t2 = 0; t2 < 2; ++t2) s[kf][t2] = __builtin_amdgcn_mfma_f32_16x16x32_f16(kfr, qf[t2][ks], s[kf][t2], 0, 0, 0);
        }
      }
      if (ti * 64 + 63 > 4 * n - 2) {
#pragma unroll
        for (int t2 = 0; t2 < 2; ++t2) {
          const int tok = th * 32 + t2 * 16 + r15;
          const int hi = 4 * n + ((tok - 31) >> 4) - ti * 64;
#pragma unroll
          for (int kf = 0; kf < 4; ++kf)
#pragma unroll
            for (int r = 0; r < 4; ++r) if (kf * 16 + 4 * q + r > hi) s[kf][t2][r] = -INFINITY;
        }
      }
      half8 pf[2][2];
#pragma unroll
      for (int t2 = 0; t2 < 2; ++t2) {
        float sh[4];
#pragma unroll
        for (int kf = 0; kf < 4; ++kf) {
#pragma unroll
          for (int r = 0; r < 4; ++r) s[kf][t2][r] = fexp2(s[kf][t2][r]);
          sh[kf] = __shfl(s[kf][t2][3], (lane + 48) & 63);
        }
#pragma unroll
        for (int kf = 0; kf < 4; ++kf) {
          const float u = (s[kf][t2][0] + s[kf][t2][1]) + (s[kf][t2][2] + s[kf][t2][3]);
          const float prev = q > 0 ? sh[kf] : (kf > 0 ? sh[kf - 1] : carry[t2]);
          usum[ti][kf][t2] = u + prev;
          lsum[t2] += u;
        }
        carry[t2] = sh[3];
#pragma unroll
        for (int ks = 0; ks < 2; ++ks) {
          half8 pk;
#pragma unroll
          for (int r = 0; r < 4; ++r) { pk[r] = (half_t)s[2 * ks][t2][r]; pk[4 + r] = (half_t)s[2 * ks + 1][t2][r]; }
          pf[t2][ks] = pk;
        }
      }
      v2i vr[4][4];
      {
        const unsigned va0 = vbl + (((0) ^ fx) << 4), va1 = vbl + (((2) ^ fx) << 4), va2 = vbl + (((4) ^ fx) << 4), va3 = vbl + (((6) ^ fx) << 4);
        asm volatile(
            "ds_read_b64_tr_b16 %0, %16\n\tds_read_b64_tr_b16 %1, %16 offset:2048\n\tds_read_b64_tr_b16 %2, %16 offset:4096\n\tds_read_b64_tr_b16 %3, %16 offset:6144\n\t"
            "ds_read_b64_tr_b16 %4, %17\n\tds_read_b64_tr_b16 %5, %17 offset:2048\n\tds_read_b64_tr_b16 %6, %17 offset:4096\n\tds_read_b64_tr_b16 %7, %17 offset:6144\n\t"
            "ds_read_b64_tr_b16 %8, %18\n\tds_read_b64_tr_b16 %9, %18 offset:2048\n\tds_read_b64_tr_b16 %10, %18 offset:4096\n\tds_read_b64_tr_b16 %11, %18 offset:6144\n\t"
            "ds_read_b64_tr_b16 %12, %19\n\tds_read_b64_tr_b16 %13, %19 offset:2048\n\tds_read_b64_tr_b16 %14, %19 offset:4096\n\tds_read_b64_tr_b16 %15, %19 offset:6144"
            : "=&v"(vr[0][0]), "=&v"(vr[0][1]), "=&v"(vr[0][2]), "=&v"(vr[0][3]), "=&v"(vr[1][0]), "=&v"(vr[1][1]), "=&v"(vr[1][2]), "=&v"(vr[1][3]),
              "=&v"(vr[2][0]), "=&v"(vr[2][1]), "=&v"(vr[2][2]), "=&v"(vr[2][3]), "=&v"(vr[3][0]), "=&v"(vr[3][1]), "=&v"(vr[3][2]), "=&v"(vr[3][3])
            : "v"(va0), "v"(va1), "v"(va2), "v"(va3)
            : "memory");
      }
      asm volatile("s_waitcnt lgkmcnt(0)"
                   : "+v"(vr[0][0]), "+v"(vr[0][1]), "+v"(vr[0][2]), "+v"(vr[0][3]), "+v"(vr[1][0]), "+v"(vr[1][1]), "+v"(vr[1][2]), "+v"(vr[1][3]),
                     "+v"(vr[2][0]), "+v"(vr[2][1]), "+v"(vr[2][2]), "+v"(vr[2][3]), "+v"(vr[3][0]), "+v"(vr[3][1]), "+v"(vr[3][2]), "+v"(vr[3][3])
                   :: "memory");
      __builtin_amdgcn_sched_barrier(0);
#pragma unroll
      for (int df = 0; df < 4; ++df)
#pragma unroll
        for (int ks = 0; ks < 2; ++ks) {
          const v2i lo2 = vr[df][2 * ks], hi2 = vr[df][2 * ks + 1];
          const v4i pk4 = (v4i){lo2[0], lo2[1], hi2[0], hi2[1]};
          const half8 vf = __builtin_bit_cast(half8, pk4);
#pragma unroll
          for (int t2 = 0; t2 < 2; ++t2) o[df][t2] = __builtin_amdgcn_mfma_f32_16x16x32_f16(vf, pf[t2][ks], o[df][t2], 0, 0, 0);
        }
    }
  }
#pragma unroll
  for (int t2 = 0; t2 < 2; ++t2) {
    const float lt = rowsum4(lsum[t2]);
    const float inv = lt > 0.f ? 1.f / lt : 0.f;
#pragma unroll
    for (int df = 0; df < 4; ++df) o[df][t2] *= inv;
    const int tok = th * 32 + t2 * 16 + r15;
    const float isc = inv * 134217728.f;
#pragma unroll
    for (int ti = 0; ti < 4; ++ti) {
      if (ti <= tile_hi) {
#pragma unroll
        for (int kf = 0; kf < 4; ++kf) {
          const int j = 16 * ti + 4 * kf + q;
          if (j < 64) atomicAdd(&impu[tok * IMPS + j], (unsigned int)(usum[ti][kf][t2] * isc + 0.5f));
        }
      }
    }
  }
  __syncthreads();
}

template <int MODE, bool PREISSUED>
__device__ __forceinline__ void attn_branch_pp(char* smem, const half_t* kbase, const half_t* vbase, int ld, int tile_lo, int tile_hi, int n, int th,
                                               const half8 (&qf)[2][2], const float (&m)[2], float (&l)[2], f32x4 (&o)[4][2],
                                               const unsigned long long (&selm)[2], int wvs, int rot) {
  const int tid = otid(wvs);
  const int lane = tid & 63, r15 = lane & 15, q = lane >> 4;
  const int lrow = tid >> 3, lch = tid & 7;
  const int k_rd = r15 * 128, kswz = r15 >> 1;
  const int qp = r15 >> 2, pp = lane & 3;
  const int fx = ((2 * q + (qp >> 1)) & 3) << 1;
  const int v_rd = (4 * q + qp) * 128 + 8 * (pp & 1) + ((pp >> 1) << 4);
  const int ksrc = (lch ^ ((lrow >> 1) & 7)) * 8, vsrc = (lch ^ (((lrow >> 1) & 3) << 1)) * 8;
  const int wbase = __builtin_amdgcn_readfirstlane(tid >> 6) * 1024;
#define A_GLOAD(TI, BUF) { const half_t* kp_ = kbase + (size_t)((TI) * 64 + lrow) * ld + ksrc; \
    __builtin_amdgcn_global_load_lds((gbl_void*)kp_, (lds_void*)(smem + ATT_K + (BUF) * 8192 + wbase), 16, 0, 0); \
    { const half_t* vp_ = vbase + (size_t)((TI) * 64 + lrow) * ld + vsrc; \
      __builtin_amdgcn_global_load_lds((gbl_void*)vp_, (lds_void*)(smem + ATT_V + (BUF) * 8192 + wbase), 16, 0, 0); } }
#define PP_BAR { __builtin_amdgcn_sched_barrier(0); __builtin_amdgcn_s_barrier(); __builtin_amdgcn_sched_barrier(0); }
  const int nt = tile_hi - tile_lo + 1;
  f32x4 lacc[2] = {(f32x4){0.f, 0.f, 0.f, 0.f}, (f32x4){0.f, 0.f, 0.f, 0.f}};
  if (!PREISSUED) {
#pragma unroll
    for (int i = 0; i < ATT_D; ++i) if (i < nt) A_GLOAD(tile_lo + ((rot + i >= nt) ? rot + i - nt : rot + i), i)
  }
  { const int r = nt - 1;
    if (r >= 4) wait_vmcnt<8>(); else if (r == 3) wait_vmcnt<6>(); else if (r == 2) wait_vmcnt<4>(); else if (r == 1) wait_vmcnt<2>(); else wait_vmcnt<0>(); }
  half8 pf[2][2];
  v2i vr[4][4];
#pragma unroll
  for (int a = 0; a < 2; ++a)
#pragma unroll
    for (int b = 0; b < 2; ++b) pf[a][b] = (half8){(half_t)0.f, (half_t)0.f, (half_t)0.f, (half_t)0.f, (half_t)0.f, (half_t)0.f, (half_t)0.f, (half_t)0.f};
#pragma unroll
  for (int a = 0; a < 4; ++a)
#pragma unroll
    for (int b = 0; b < 4; ++b) vr[a][b] = (v2i){0, 0};
  const half8 ones = (half8){(half_t)1.f, (half_t)1.f, (half_t)1.f, (half_t)1.f, (half_t)1.f, (half_t)1.f, (half_t)1.f, (half_t)1.f};
#define PP_PV { _Pragma("unroll") for (int df = 0; df < 4; ++df) _Pragma("unroll") for (int ks = 0; ks < 2; ++ks) { \
      const v2i lo2 = vr[df][2 * ks], hi2 = vr[df][2 * ks + 1]; const v4i pk4 = (v4i){lo2[0], lo2[1], hi2[0], hi2[1]}; const half8 vf = __builtin_bit_cast(half8, pk4); \
      _Pragma("unroll") for (int t2 = 0; t2 < 2; ++t2) o[df][t2] = __builtin_amdgcn_mfma_f32_16x16x32_f16(vf, pf[t2][ks], o[df][t2], 0, 0, 0); } \
    _Pragma("unroll") for (int ks = 0; ks < 2; ++ks) _Pragma("unroll") for (int t2 = 0; t2 < 2; ++t2) lacc[t2] = __builtin_amdgcn_mfma_f32_16x16x32_f16(ones, pf[t2][ks], lacc[t2], 0, 0, 0); }
  __builtin_amdgcn_sched_barrier(0);
  if (th == 1) __builtin_amdgcn_s_barrier();
  __builtin_amdgcn_sched_barrier(0);
  int trel = rot, tpf = rot + ATT_D; while (tpf >= nt) tpf -= nt;
#pragma unroll 1
  for (int it = 0; it < nt; ++it) {
    const int ti = tile_lo + trel, cur = it % ATT_NB;
    trel = (trel + 1 == nt) ? 0 : trel + 1;
    PP_BAR
    f32x4 s[4][2];
    const char* kb = smem + ATT_K + cur * 8192 + k_rd;
    __builtin_amdgcn_s_setprio(1);
    PP_PV
#pragma unroll
    for (int t2 = 0; t2 < 2; ++t2) {
      float c0 = -m[t2];
      if (MODE == 2 && !((selm[t2] >> ti) & 1ull)) c0 = -INFINITY;
#pragma unroll
      for (int kf = 0; kf < 4; ++kf) s[kf][t2] = (f32x4){c0, c0, c0, c0};
    }
#pragma unroll
    for (int ks = 0; ks < 2; ++ks) {
      const int co = ((4 * ks + q) ^ kswz) << 4;
#pragma unroll
      for (int kf = 0; kf < 4; ++kf) {
        const half8 kfr = *(const half8*)(kb + kf * 2048 + co);
#pragma unroll
        for (int t2 = 0; t2 < 2; ++t2) s[kf][t2] = __builtin_amdgcn_mfma_f32_16x16x32_f16(kfr, qf[t2][ks], s[kf][t2], 0, 0, 0);
      }
    }
    __builtin_amdgcn_s_setprio(0);
    { const int r = nt - 2 - it;
      if (r >= 3) wait_vmcnt<6>(); else if (r == 2) wait_vmcnt<4>(); else if (r == 1) wait_vmcnt<2>(); else wait_vmcnt<0>(); }
    PP_BAR
    if (it + ATT_D < nt) A_GLOAD(tile_lo + tpf, (it + ATT_D) % ATT_NB)
    tpf = (tpf + 1 == nt) ? 0 : tpf + 1;
    {
      const unsigned vbl = (unsigned)(size_t)(smem + ATT_V + cur * 8192 + v_rd);
      const unsigned va0 = vbl + (((0) ^ fx) << 4), va1 = vbl + (((2) ^ fx) << 4), va2 = vbl + (((4) ^ fx) << 4), va3 = vbl + (((6) ^ fx) << 4);
      asm volatile(
          "ds_read_b64_tr_b16 %0, %16\n\tds_read_b64_tr_b16 %1, %16 offset:2048\n\tds_read_b64_tr_b16 %2, %16 offset:4096\n\tds_read_b64_tr_b16 %3, %16 offset:6144\n\t"
          "ds_read_b64_tr_b16 %4, %17\n\tds_read_b64_tr_b16 %5, %17 offset:2048\n\tds_read_b64_tr_b16 %6, %17 offset:4096\n\tds_read_b64_tr_b16 %7, %17 offset:6144\n\t"
          "ds_read_b64_tr_b16 %8, %18\n\tds_read_b64_tr_b16 %9, %18 offset:2048\n\tds_read_b64_tr_b16 %10, %18 offset:4096\n\tds_read_b64_tr_b16 %11, %18 offset:6144\n\t"
          "ds_read_b64_tr_b16 %12, %19\n\tds_read_b64_tr_b16 %13, %19 offset:2048\n\tds_read_b64_tr_b16 %14, %19 offset:4096\n\tds_read_b64_tr_b16 %15, %19 offset:6144"
          : "=&v"(vr[0][0]), "=&v"(vr[0][1]), "=&v"(vr[0][2]), "=&v"(vr[0][3]), "=&v"(vr[1][0]), "=&v"(vr[1][1]), "=&v"(vr[1][2]), "=&v"(vr[1][3]),
            "=&v"(vr[2][0]), "=&v"(vr[2][1]), "=&v"(vr[2][2]), "=&v"(vr[2][3]), "=&v"(vr[3][0]), "=&v"(vr[3][1]), "=&v"(vr[3][2]), "=&v"(vr[3][3])
          : "v"(va0), "v"(va1), "v"(va2), "v"(va3)
          : "memory");
    }
    bool need_mask;
    if (MODE == 2) need_mask = (ti == n); else need_mask = (ti == n) || (ti == n - 8);
    if (need_mask) {
#pragma unroll
      for (int t2 = 0; t2 < 2; ++t2) {
        const int tok = th * 32 + t2 * 16 + r15;
        int lo = 0, hi = 63;
        if (MODE == 2) { hi = tok; }
        else { if (ti == n) hi = tok; else lo = tok + 1; }
#pragma unroll
        for (int kf = 0; kf < 4; ++kf)
#pragma unroll
          for (int r = 0; r < 4; ++r) {
            const int kk = kf * 16 + 4 * q + r;
            if (kk < lo || kk > hi) s[kf][t2][r] = -INFINITY;
          }
      }
    }
#pragma unroll
    for (int t2 = 0; t2 < 2; ++t2) {
#pragma unroll
      for (int kf = 0; kf < 4; ++kf)
#pragma unroll
        for (int r = 0; r < 4; ++r) s[kf][t2][r] = fexp2(s[kf][t2][r]);
#pragma unroll
      for (int ks = 0; ks < 2; ++ks) {
        half8 pk;
#pragma unroll
        for (int r = 0; r < 4; ++r) { pk[r] = (half_t)s[2 * ks][t2][r]; pk[4 + r] = (half_t)s[2 * ks + 1][t2][r]; }
        pf[t2][ks] = pk;
      }
    }
    asm volatile("s_waitcnt lgkmcnt(0)"
                 : "+v"(vr[0][0]), "+v"(vr[0][1]), "+v"(vr[0][2]), "+v"(vr[0][3]), "+v"(vr[1][0]), "+v"(vr[1][1]), "+v"(vr[1][2]), "+v"(vr[1][3]),
                   "+v"(vr[2][0]), "+v"(vr[2][1]), "+v"(vr[2][2]), "+v"(vr[2][3]), "+v"(vr[3][0]), "+v"(vr[3][1]), "+v"(vr[3][2]), "+v"(vr[3][3])
                 :: "memory");
  }
  PP_BAR
  PP_PV
  __builtin_amdgcn_sched_barrier(0);
  if (th == 0) __builtin_amdgcn_s_barrier();
  __builtin_amdgcn_sched_barrier(0);
  l[0] = lacc[0][0]; l[1] = lacc[1][0];
  __syncthreads();
#undef A_GLOAD
#undef PP_BAR
#undef PP_PV
}

__device__ void ph_attn_mfma(const Params& P, char* smem, int wvs) {
  unsigned int* impu = (unsigned int*)(smem + ATT_IMP);
  unsigned long long* selmask = (unsigned long long*)(smem + ATT_SELM);
  const int G = gridDim.x, nrounds = (2048 + G - 1) / G;
  for (int rd = 0; rd < nrounds; ++rd) {
    const int idx = rd * G + ((rd & 1) ? (G - 1 - (int)blockIdx.x) : (int)blockIdx.x);
    if (idx >= 2048) continue;
    const int tid = otid(wvs), lane = tid & 63, r15 = lane & 15, q = lane >> 4;
    const int n = 63 - (idx >> 5), bg = idx & 31, b = bg >> 2, g = bg & 3;
    const int wv = __builtin_amdgcn_readfirstlane(otid(wvs) >> 6);
    const int hd = g * 4 + (wv & 3), th = wv >> 2;
    const int t0 = b * SEQ + n * 64 + th * 32;
    const half_t* kc = P.kcmp + (size_t)bg * 256 * 64;
    const half_t* vc = P.vcmp + (size_t)bg * 256 * 64;
    const int nct = (4 * n + 2) / 64;
    attn_issue(smem, kc, vc, 64, 0, nct, wvs);
    half8 qf[2][2];
#pragma unroll
    for (int t2 = 0; t2 < 2; ++t2)
#pragma unroll
      for (int ks = 0; ks < 2; ++ks) qf[t2][ks] = *(const half8*)(P.p + (size_t)(t0 + t2 * 16 + r15) * LD1 + hd * 64 + 32 * ks + 8 * q);
    float* gate_l = (float*)(smem + ATT_GATE) + wv * 128;
    if (q == 0) {
#pragma unroll
      for (int t2 = 0; t2 < 2; ++t2) {
        const float* pr = P.gl + (size_t)(t0 + t2 * 16 + r15) * 48 + hd * 3;
        f32x4 gv;
#pragma unroll
        for (int c = 0; c < 3; ++c) gv[c] = sigmoidf(pr[c] + P.nsa_b_gate[hd * 3 + c]);
        gv[3] = 0.f;
        *(f32x4*)(gate_l + (t2 * 16 + r15) * 4) = gv;
      }
    }
    { const int tz = otid(wvs); for (int i = tz; i < 64 * IMPS + 128; i += NTHREADS) impu[i] = 0u; }
    float m[2], l[2]; f32x4 o[4][2]; unsigned long long selm[2] = {0ull, 0ull};
#pragma unroll
    for (int t2 = 0; t2 < 2; ++t2) { m[t2] = -1e30f; l[t2] = 0.f; }
#pragma unroll
    for (int df = 0; df < 4; ++df)
#pragma unroll
      for (int t2 = 0; t2 < 2; ++t2) o[df][t2] = (f32x4){0.f, 0.f, 0.f, 0.f};
    float qn2[2];
#pragma unroll
    for (int t2 = 0; t2 < 2; ++t2) {
      float a = 0.f;
#pragma unroll
      for (int ks = 0; ks < 2; ++ks)
#pragma unroll
        for (int e = 0; e < 8; ++e) a += (float)qf[t2][ks][e] * (float)qf[t2][ks][e];
      qn2[t2] = rowsum4(a);
    }
    { const float kmc = __uint_as_float(P.kmax2[64 + bg]);
#pragma unroll
      for (int t2 = 0; t2 < 2; ++t2) m[t2] = sqrtf(qn2[t2] * kmc) * 1.001f - 5.0f * LOG2E; }
    attn_cmp(smem, nct, n, th, qf, m, o, wvs);
    f32x4 oacc[4][2];
#pragma unroll
    for (int t2 = 0; t2 < 2; ++t2) {
      const float gc = gate_l[(t2 * 16 + r15) * 4 + 0];
#pragma unroll
      for (int df = 0; df < 4; ++df) oacc[df][t2] = o[df][t2] * gc;
    }
    {
      const int tz = otid(wvs), lz = tz & 63;
#pragma unroll
      for (int i = 0; i < 4; ++i) {
        const int slab = i * 8 + wv, tokz = slab * 2 + (lz >> 5), cz = (lz & 31) ^ (tokz & 15);
        const half_t* zp = P.p + (size_t)(b * SEQ + n * 64 + tokz) * LD1 + 2560 + g * 256 + cz * 8;
        __builtin_amdgcn_global_load_lds((gbl_void*)zp, (lds_void*)(smem + ATT_Z + slab * 1024), 16, 0, 0);
      }
    }
    const int shr = ((int)blockIdx.x >> 5) & 7;
    const int rot_s = (shr * (n + 1)) >> 3;
    attn_issue(smem, P.p + (size_t)b * SEQ * LD1 + 1536 + g * 64, P.p + (size_t)b * SEQ * LD1 + 1792 + g * 64, LD1, 0, n, wvs, rot_s);
    {
      const int tid2 = otid(wvs);
      const int tok = tid2 >> 3, part = tid2 & 7;
      unsigned long long msk;
      if (n + 1 <= 16) {
        msk = (1ull << (n + 1)) - 1ull;
      } else {
        const uint4* rowp = (const uint4*)(impu + tok * IMPS);
        unsigned own[8];
        { const uint4 a = rowp[part * 2], b2 = rowp[part * 2 + 1];
          own[0] = a.x; own[1] = a.y; own[2] = a.z; own[3] = a.w; own[4] = b2.x; own[5] = b2.y; own[6] = b2.z; own[7] = b2.w; }
        int rank[8];
#pragma unroll
        for (int jj = 0; jj < 8; ++jj) {
          const int j = part * 8 + jj;
          own[jj] = (j >= 1 && j <= n - 2) ? ((own[jj] & ~63u) | (unsigned)(63 - j)) : 0xffffffffu;
          rank[jj] = 0;
        }
#pragma unroll 2
        for (int c4 = 0; c4 < ((n - 2) >> 2) + 1; ++c4) {
          const uint4 v = rowp[c4];
          unsigned kv[4] = {v.x, v.y, v.z, v.w};
#pragma unroll
          for (int e = 0; e < 4; ++e) {
            const int j2 = c4 * 4 + e;
            const unsigned key2 = (j2 >= 1 && j2 <= n - 2) ? ((kv[e] & ~63u) | (unsigned)(63 - j2)) : 0u;
#pragma unroll
            for (int jj = 0; jj < 8; ++jj) rank[jj] += (key2 > own[jj]) ? 1 : 0;
          }
        }
        unsigned int bits = 0;
#pragma unroll
        for (int jj = 0; jj < 8; ++jj) if (rank[jj] < 13 && own[jj] != 0xffffffffu) bits |= 1u << jj;
        unsigned* sel32 = (unsigned*)selmask;
        if (bits) atomicOr(&sel32[tok * 2 + (part >> 2)], bits << (8 * (part & 3)));
        msk = 1ull | (1ull << n) | (1ull << (n - 1));
        if (part == 0) { atomicOr(&sel32[tok * 2], (unsigned)msk); atomicOr(&sel32[tok * 2 + 1], (unsigned)(msk >> 32)); }
      }
      if (n + 1 <= 16 && part == 0) selmask[tok] = msk;
    }
    __syncthreads();
#pragma unroll
    for (int t2 = 0; t2 < 2; ++t2) selm[t2] = selmask[th * 32 + t2 * 16 + r15];
    { const float km = __uint_as_float(P.kmax2[bg * 2 + 0]);
#pragma unroll
      for (int t2 = 0; t2 < 2; ++t2) { m[t2] = sqrtf(qn2[t2] * km) * 1.001f - 5.0f * LOG2E; l[t2] = 0.f; } }
#pragma unroll
    for (int df = 0; df < 4; ++df)
#pragma unroll
      for (int t2 = 0; t2 < 2; ++t2) o[df][t2] = (f32x4){0.f, 0.f, 0.f, 0.f};
    attn_branch_pp<2, true>(smem, P.p + (size_t)b * SEQ * LD1 + 1536 + g * 64, P.p + (size_t)b * SEQ * LD1 + 1792 + g * 64, LD1, 0, n, n, th, qf, m, l, o, selm, wvs, rot_s);
#pragma unroll
    for (int t2 = 0; t2 < 2; ++t2) {
      const float gs = gate_l[(t2 * 16 + r15) * 4 + 1] / l[t2];
#pragma unroll
      for (int df = 0; df < 4; ++df) oacc[df][t2] += o[df][t2] * gs;
    }
    { const float km = __uint_as_float(P.kmax2[bg * 2 + 1]);
#pragma unroll
      for (int t2 = 0; t2 < 2; ++t2) { m[t2] = sqrtf(qn2[t2] * km) * 1.001f - 5.0f * LOG2E; l[t2] = 0.f; } }
#pragma unroll
    for (int df = 0; df < 4; ++df)
#pragma unroll
      for (int t2 = 0; t2 < 2; ++t2) o[df][t2] = (f32x4){0.f, 0.f, 0.f, 0.f};
    attn_branch_pp<3, false>(smem, P.p + (size_t)b * SEQ * LD1 + 2048 + g * 64, P.p + (size_t)b * SEQ * LD1 + 2304 + g * 64, LD1, (n > 8 ? n - 8 : 0), n, n, th, qf, m, l, o, selm, wvs, ((7 - shr) * (n > 8 ? 9 : n + 1)) >> 3);
    {
      int tbase = t0 + r15; asm volatile("" : "+v"(tbase));
#pragma unroll
      for (int t2 = 0; t2 < 2; ++t2) {
        const size_t tok = (size_t)(tbase + t2 * 16);
        const float gw = gate_l[(t2 * 16 + r15) * 4 + 2] / l[t2];
#pragma unroll
        for (int df = 0; df < 4; ++df) {
          const f32x4 v = oacc[df][t2] + o[df][t2] * gw;
          const int tokl = th * 32 + t2 * 16 + r15, cz = (wv & 3) * 8 + df * 2 + (q >> 1);
          const half4 z = *(const half4*)(smem + ATT_Z + tokl * 512 + ((cz ^ (tokl & 15)) << 4) + (q & 1) * 8);
          half4 hv;
#pragma unroll
          for (int e = 0; e < 4; ++e) hv[e] = (half_t)(v[e] * siluf((float)z[e]));
          *(half4*)(P.og + tok * DM + hd * 64 + df * 16 + 4 * q) = hv;
        }
      }
    }
  }
}

constexpr int NPHASES = 13;
__device__ __forceinline__ void run_phase(int ph, const Params& P, char* smem, int wvs) {
  float* sm = (float*)smem;
  switch (ph) {
    case 0:
      if (blockIdx.x == 0 && otid(wvs) < 128) P.kmax2[otid(wvs)] = 0u;
      ph_xh_rstd(P.x, P.xh, P.rstd, wvs); ph_ropetab(P, wvs); prep_cbias_part(P, wvs);
      prep_weights(P, sm, wvs);
      prep_wT(P.nsa_w_in, NSA_IN, P.pre_norm + DM, P.WglT, 64, DM, 5, sm, wvs);
      prep_wT(P.gla_w_in, GLA_IN, P.pre_norm, P.WglrT, 64, DM, 6, sm, wvs);
      break;
    case 1:
      g8::gemm(g8::SrcPlain8{P.xh, DM, P.W0t, DM}, T_TOK, LD0, DM, g8::EpiStore8{P.p, LD0, P.rstd}, smem, wvs);
      ph_rowproj<1>(P, P.WglrT, P.glr, smem, wvs, 0);
      break;
    case 2: prep_cbias_reduce(P, wvs); ph_gla_prep(P, sm, wvs); break;
    case 13: ph_gla_mfma<true>(P, smem, wvs); break;
    case 3: ph_gla_mfma<false>(P, smem, wvs); break;
    case 4: ph_gla_post(P, wvs); break;
    case 5: g8::gemm(g8::SrcPlain8{P.og, DM, P.Wo0t, DM}, T_TOK, DM, DM, g8::EpiStore8{P.y, DM, nullptr}, smem, wvs); break;
    case 6: ph_post<false>(P.xh, P.y, P.post_norm, nullptr, P.xh, P.rstd, wvs); break;
    case 7: g8::gemm(g8::SrcPlain8{P.xh, DM, P.W1t, DM}, T_TOK, LD1, DM, g8::EpiRope8{P.p, LD1, P.rstd, P.ropetab}, smem, wvs); break;
    case 8:
      if (blockIdx.x >= 64) { ph_kmax(P, wvs, 64); ph_rowproj<3>(P, P.WglT, P.gl, smem, wvs, 64); }
      g8::gemm(g8::SrcCmp1_8{P.p, P.cw1t}, 16384, 256, 2048, g8::EpiCmpHid8{P.hid, P.cbias}, smem, wvs);
      asm volatile("s_waitcnt vmcnt(0)" ::: "memory");
      __syncthreads();
      g8::gemm(g8::SrcCmp2_8{P.hid, P.cw2t}, 16384, 256, 256, g8::EpiCmpOut8{P.kcmp, P.vcmp, P.kmax2 + 64}, smem, wvs);
      break;
    case 10: ph_attn_mfma(P, smem, wvs); break;
    case 11: g8::gemm(g8::SrcPlain8{P.og, DM, P.Wo1t, DM}, T_TOK, DM, DM, g8::EpiStore8{P.y, DM, nullptr}, smem, wvs); break;
    case 12: ph_post<true>(P.x1h, P.y, P.post_norm + DM, P.out, nullptr, nullptr, wvs); break;
  }
}

template <int PH>
__global__ void __launch_bounds__(NTHREADS, 2) k_phase(Params P) {
  __shared__ __attribute__((aligned(16))) char smem[SMEM_BYTES];
  run_phase(PH, P, smem, __builtin_amdgcn_readfirstlane(threadIdx.x >> 6));
}
template <int PH>
static void launch_phases(const Params& P, hipStream_t stream) {
  hipLaunchKernelGGL((k_phase<PH>), dim3(256), dim3(NTHREADS), 0, stream, P);
  if constexpr (PH + 1 < NPHASES) launch_phases<PH + 1>(P, stream);
}

#if MEGA
__global__ void __launch_bounds__(NTHREADS, 2) k_mega(Params P) {
  __shared__ __attribute__((aligned(16))) char smem[SMEM_BYTES];
  cg::grid_group grid = cg::this_grid();
  if (P.use_cg_sync) grid.sync();
  unsigned bt = 0;
  const int wvs = __builtin_amdgcn_readfirstlane(threadIdx.x >> 6);
  run_phase(0, P, smem, wvs); fast_barrier(P.bar, bt, wvs);
  run_phase(1, P, smem, wvs); fast_barrier(P.bar, bt, wvs);
  run_phase(2, P, smem, wvs); fast_barrier(P.bar, bt, wvs);
  run_phase(13, P, smem, wvs); fast_barrier(P.bar, bt, wvs);
  run_phase(3, P, smem, wvs); fast_barrier(P.bar, bt, wvs);
  run_phase(4, P, smem, wvs); fast_barrier(P.bar, bt, wvs);
  run_phase(5, P, smem, wvs); fast_barrier(P.bar, bt, wvs);
  run_phase(6, P, smem, wvs); fast_barrier(P.bar, bt, wvs);
  run_phase(7, P, smem, wvs); fast_barrier(P.bar, bt, wvs);
  run_phase(8, P, smem, wvs); fast_barrier(P.bar, bt, wvs);
  run_phase(10, P, smem, wvs); fast_barrier(P.bar, bt, wvs);
  run_phase(11, P, smem, wvs); fast_barrier(P.bar, bt, wvs);
  run_phase(12, P, smem, wvs);
}
#endif

extern "C" void kernel_launch(void* const* d_in, const int* in_sizes, int n_in, void* d_out, int out_size, void* d_ws, size_t ws_size,
                              hipStream_t stream) {
  Params P{};
  P.x = (const float*)d_in[0]; P.pos = (const int*)d_in[1]; P.pre_norm = (const float*)d_in[2]; P.post_norm = (const float*)d_in[3];
  P.gla_w_in = (const float*)d_in[4]; P.gla_w_gk_up = (const float*)d_in[5]; P.gla_b_gk = (const float*)d_in[6];
  P.gla_head_norm = (const float*)d_in[7]; P.gla_w_out = (const float*)d_in[8];
  P.nsa_w_in = (const float*)d_in[9]; P.nsa_b_gate = (const float*)d_in[10]; P.nsa_pe_k = (const float*)d_in[11]; P.nsa_pe_v = (const float*)d_in[12];
  P.ck_w1 = (const float*)d_in[13]; P.ck_w2 = (const float*)d_in[14]; P.cv_w1 = (const float*)d_in[15]; P.cv_w2 = (const float*)d_in[16];
  P.nsa_w_out = (const float*)d_in[17];
  P.out = (float*)d_out;
  char* ws = (char*)d_ws;
  const size_t MB = 1024 * 1024;
  P.W0t = (half_t*)(ws);
  P.Wo0t = (half_t*)(ws + 7 * MB);
  P.W1t = (half_t*)(ws + 9 * MB);
  P.Wo1t = (half_t*)(ws + 17 * MB);
  P.cw1t = (half_t*)(ws + 19 * MB);
  P.cw2t = (half_t*)(ws + 21 * MB);
  P.cbias = (float*)(ws + 22 * MB);
  P.cbias_part = (float*)(ws + 22 * MB + 4096);
  P.bar = (unsigned*)(ws + 23 * MB);
  P.use_cg_sync = 0;
  P.kmax2 = (unsigned*)(ws + 22 * MB + 512 * 1024);
  P.xh = (half_t*)(ws + 24 * MB);
  P.x1h = P.xh;
  P.p = (half_t*)(ws + 88 * MB);
  P.y = (half_t*)(ws + 88 * MB);
  P.og = (half_t*)(ws + 328 * MB);
  P.bcum = (float*)(ws + 392 * MB);
  P.rstd = (float*)(ws + 456 * MB);
  P.kcmp = (half_t*)(ws + 457 * MB);
  P.vcmp = (half_t*)(ws + 458 * MB);
  P.ropetab = (float*)(ws + 459 * MB);
  P.hid = (half_t*)(ws + 467 * MB);
  P.WglT = (half_t*)(ws + 22 * MB + 768 * 1024);
  P.WglrT = (half_t*)(ws + 22 * MB + 896 * 1024);
  P.glr = (float*)(ws + 509 * MB);
  P.gl = (float*)(ws + 503 * MB);
  P.gla_state = (float*)(ws + 476 * MB);
  if (ws_size < 512 * MB) { fprintf(stderr, "ws too small: %zu\n", ws_size); return; }
#if MEGA
  static int grid_blocks = 0;
  if (!grid_blocks) {
    int dev = 0, cus = 0, per_cu = 0;
    hipGetDevice(&dev);
    hipDeviceGetAttribute(&cus, hipDeviceAttributeMultiprocessorCount, dev);
    hipOccupancyMaxActiveBlocksPerMultiprocessor(&per_cu, k_mega, NTHREADS, 0);
    if (per_cu < 1) per_cu = 1;
    if (per_cu > 1) per_cu = 1;
    grid_blocks = cus * per_cu;
  }
  hipMemsetAsync(ws + 23 * MB, 0, 16384, stream);
  void* args[] = {&P};
  hipError_t e = hipLaunchCooperativeKernel((void*)k_mega, dim3(grid_blocks), dim3(NTHREADS), args, 0, stream);
  if (e != hipSuccess) fprintf(stderr, "cooperative launch failed: %s (grid %d)\n", hipGetErrorString(e), grid_blocks);
#else
  launch_phases<0>(P, stream);
#endif
}
```

```cpp
#include <hip/hip_runtime.h>
#include <hip/hip_cooperative_groups.h>
#include <cstdio>
#include <cstdint>
namespace cg = cooperative_groups;

typedef _Float16 half_t;
typedef _Float16 half8 __attribute__((ext_vector_type(8)));
typedef _Float16 half4 __attribute__((ext_vector_type(4)));
typedef float f32x4 __attribute__((ext_vector_type(4)));
typedef int v2i __attribute__((ext_vector_type(2)));
typedef int v4i __attribute__((ext_vector_type(4)));

#ifndef MEGA
#define MEGA 1
#endif

constexpr int T_TOK = 32768, DM = 1024, SEQ = 4096, NBATCH = 8;
constexpr int GLA_IN = 3088, NSA_IN = 3632;
constexpr int LD0 = 3072, LD1 = 3584;
constexpr int NC = 255;
constexpr float EPS = 1e-6f;
constexpr int NTHREADS = 512, NWAVES = NTHREADS / 64;
constexpr int SMEM_BYTES = 160 * 1024;

struct Params {
  const float* x; const int* pos; const float* pre_norm; const float* post_norm;
  const float* gla_w_in; const float* gla_w_gk_up; const float* gla_b_gk; const float* gla_head_norm; const float* gla_w_out;
  const float* nsa_w_in; const float* nsa_b_gate; const float* nsa_pe_k; const float* nsa_pe_v;
  const float* ck_w1; const float* ck_w2; const float* cv_w1; const float* cv_w2; const float* nsa_w_out;
  float* out;
  half_t* p; half_t* y; half_t* og; float* bcum; float* rstd; half_t* kcmp; half_t* vcmp; float* ropetab;
  half_t* xh; half_t* W0t; half_t* Wo0t; half_t* W1t; half_t* Wo1t;
  half_t* cw1t; half_t* cw2t; float* cbias; half_t* hid;
  float* cbias_part; unsigned* bar; long long use_cg_sync; unsigned* kmax2; float* gla_state; half_t* WglT; float* gl; half_t* x1h; half_t* WglrT; float* glr; half_t* part;
};

__device__ __forceinline__ int lane_id() { return (int)__builtin_amdgcn_mbcnt_hi(~0u, __builtin_amdgcn_mbcnt_lo(~0u, 0u)); }
__device__ __forceinline__ int otid(int wvs) { int t = wvs * 64 + lane_id(); asm volatile("" : "+v"(t)); return t; }
typedef __attribute__((address_space(3))) void lds_void;
typedef __attribute__((address_space(1))) const void gbl_void;
typedef short s16x4 __attribute__((vector_size(8)));
typedef __attribute__((address_space(3))) s16x4 lds_s16x4;
__device__ __forceinline__ half4 tr_read4(const char* p) {
  const s16x4 v = __builtin_amdgcn_ds_read_tr16_b64_v4i16((lds_s16x4*)(p));
  return __builtin_bit_cast(half4, v);
}
template <int N> __device__ __forceinline__ void wait_vmcnt() { asm volatile("s_waitcnt vmcnt(%0)" ::"n"(N) : "memory"); }
constexpr float LOG2E = 1.4426950408889634f;
__device__ __forceinline__ float fexp2(float x) { return __builtin_amdgcn_exp2f(x); }
typedef unsigned u32x2 __attribute__((ext_vector_type(2)));
__device__ __forceinline__ float rowmax4(float x) {
  u32x2 r = __builtin_amdgcn_permlane16_swap(__float_as_uint(x), __float_as_uint(x), false, false);
  x = fmaxf(__uint_as_float(r[0]), __uint_as_float(r[1]));
  r = __builtin_amdgcn_permlane32_swap(__float_as_uint(x), __float_as_uint(x), false, false);
  return fmaxf(__uint_as_float(r[0]), __uint_as_float(r[1]));
}
__device__ __forceinline__ float rowsum4(float x) {
  u32x2 r = __builtin_amdgcn_permlane16_swap(__float_as_uint(x), __float_as_uint(x), false, false);
  x = __uint_as_float(r[0]) + __uint_as_float(r[1]);
  r = __builtin_amdgcn_permlane32_swap(__float_as_uint(x), __float_as_uint(x), false, false);
  return __uint_as_float(r[0]) + __uint_as_float(r[1]);
}
template <int CTRL> __device__ __forceinline__ float dpp_f(float x) {
  return __builtin_bit_cast(float, __builtin_amdgcn_update_dpp(0, __builtin_bit_cast(int, x), CTRL, 0xf, 0xf, true));
}
__device__ __forceinline__ float wave_sum(float v) {
  v += dpp_f<0xB1>(v);
  v += dpp_f<0x4E>(v);
  v += dpp_f<0x141>(v);
  v += dpp_f<0x140>(v);
  return rowsum4(v);
}
__device__ __forceinline__ float wave_max(float v) {
  v = fmaxf(v, dpp_f<0xB1>(v));
  v = fmaxf(v, dpp_f<0x4E>(v));
  v = fmaxf(v, dpp_f<0x141>(v));
  v = fmaxf(v, dpp_f<0x140>(v));
  return rowmax4(v);
}
__device__ __forceinline__ float fast_exp2(float x) { return __builtin_amdgcn_exp2f(x); }
__device__ __forceinline__ float sigmoidf(float v) { return __builtin_amdgcn_rcpf(1.f + fast_exp2(-1.4426950408889634f * v)); }
__device__ __forceinline__ float siluf(float v) { return v * sigmoidf(v); }
__device__ __forceinline__ float logsigmoidf(float u) { return fminf(u, 0.f) - 0.6931471805599453f * __builtin_amdgcn_logf(1.f + fast_exp2(-1.4426950408889634f * fabsf(u))); }

__device__ __forceinline__ void fast_barrier(unsigned* bar, unsigned& round, int wvs) {
  asm volatile("s_waitcnt vmcnt(0) lgkmcnt(0)" ::: "memory");
  __syncthreads();
  round += 1;
  if (wvs == 0 && lane_id() == 0) {
    __builtin_amdgcn_fence(__ATOMIC_RELEASE, "agent");
    asm volatile("s_waitcnt vmcnt(0)" ::: "memory");
    const unsigned ngroups = gridDim.x >> 4;
    const unsigned old = __hip_atomic_fetch_add(bar + 64 + 64 * (blockIdx.x >> 4), 1u, __ATOMIC_RELAXED, __HIP_MEMORY_SCOPE_AGENT);
    if (old + 1 == round * 16u) __hip_atomic_fetch_add(bar, 1u, __ATOMIC_RELAXED, __HIP_MEMORY_SCOPE_AGENT);
    const unsigned target = round * ngroups;
    while (__hip_atomic_load(bar, __ATOMIC_RELAXED, __HIP_MEMORY_SCOPE_AGENT) < target) { }
    __builtin_amdgcn_fence(__ATOMIC_ACQUIRE, "agent");
    asm volatile("s_waitcnt vmcnt(0)" ::: "memory");
  }
  __syncthreads();
}

__device__ void ph_xh_rstd(const float* src, half_t* xh, float* rstd, int wvs) {
  const int tid_ = otid(wvs); const int lane = tid_ & 63, w = tid_ >> 6;
  constexpr int RW = 4;
  const int rstride = gridDim.x * NWAVES;
#pragma unroll 1
  for (int row0 = blockIdx.x * NWAVES + w; row0 < T_TOK; row0 += rstride * RW) {
    float4 v[RW][4];
#pragma unroll
    for (int r = 0; r < RW; ++r)
#pragma unroll
      for (int i = 0; i < 4; ++i) v[r][i] = ((const float4*)(src + (size_t)(row0 + r * rstride) * DM))[lane + 64 * i];
#pragma unroll
    for (int r = 0; r < RW; ++r) {
      const int row = row0 + r * rstride;
      half4* xr = (half4*)(xh + (size_t)row * DM);
      float ss = 0.f;
#pragma unroll
      for (int i = 0; i < 4; ++i) {
        const float4 t = v[r][i];
        ss += t.x * t.x + t.y * t.y + t.z * t.z + t.w * t.w;
        half4 hv; hv[0] = (half_t)t.x; hv[1] = (half_t)t.y; hv[2] = (half_t)t.z; hv[3] = (half_t)t.w;
        xr[lane + 64 * i] = hv;
      }
      ss = wave_sum(ss);
      if (lane == 0) rstd[row] = rsqrtf(ss * (1.f / DM) + EPS);
    }
  }
}
__device__ void ph_ropetab(const Params& P, int wvs) {
  const int tid = otid(wvs);
  const float inv = powf(10000.f, -(float)(2 * (tid & 31)) / 64.f);
  for (int idx = blockIdx.x * NTHREADS + tid; idx < T_TOK * 32; idx += gridDim.x * NTHREADS) {
    const int t = idx >> 5, i = idx & 31;
    const float ang = (float)P.pos[t] * inv;
    float s, c; sincosf(ang, &s, &c);
    P.ropetab[t * 64 + i] = c; P.ropetab[t * 64 + 32 + i] = s;
  }
}
__device__ __forceinline__ int orig_col(int n, int mode) {
  if (mode == 0) {
    if (n < 2048) return n;
    if (n < 3072) return n + 16;
    return -1;
  } else if (mode == 1) {
    if (n < 2560) return n;
    if (n < 3584) return n + 48;
    return -1;
  } else if (mode == 5) {
    return n < 48 ? 2560 + n : -1;
  }
  if (mode == 4) return n < 64 ? n : -1;
  if (mode == 6) return n < 16 ? 2048 + n : -1;
  return n;
}
__device__ void prep_wT(const float* W, int ldw, const float* gamma, half_t* Wt, int Npad, int K, int mode, float* sm, int wvs) {
  float(*tile)[65] = (float(*)[65])sm;
  const int tid = otid(wvs);
  const int ntn = Npad / 64, ntk = K / 64;
  for (int t = blockIdx.x; t < ntn * ntk; t += gridDim.x) {
    const int n0 = (t / ntk) * 64, k0 = (t % ntk) * 64;
    __syncthreads();
#pragma unroll
    for (int r = 0; r < 4096 / NTHREADS; ++r) {
      const int idx = tid + r * NTHREADS, kk = idx >> 6, nn = idx & 63;
      const int on = orig_col(n0 + nn, mode);
      float v = 0.f;
      if (on >= 0) { v = W[(size_t)(k0 + kk) * ldw + on]; if (gamma) v *= gamma[k0 + kk]; }
      tile[kk][nn] = v;
    }
    __syncthreads();
    {
      const int nn = tid >> 3, oct = tid & 7;
      half8 hv;
#pragma unroll
      for (int e = 0; e < 8; ++e) hv[e] = (half_t)tile[oct * 8 + e][nn];
      *(half8*)(Wt + (size_t)(n0 + nn) * K + k0 + oct * 8) = hv;
    }
  }
}

__device__ __forceinline__ void prep_strip(const float* W, int ldw, const float* gamma, half_t* Wt, int K, int mode, int n0, int k0, float* sm, int tid) {
  float(*tile)[260] = (float(*)[260])sm;
  __syncthreads();
#pragma unroll
  for (int r = 0; r < 8; ++r) {
    const int idx = tid + r * NTHREADS, kk = idx >> 6, n4 = (idx & 63) * 4;
    const int on = orig_col(n0 + n4, mode);
    f32x4 v = (f32x4){0.f, 0.f, 0.f, 0.f};
    if (on >= 0) { v = *(const f32x4*)(W + (size_t)(k0 + kk) * ldw + on); if (gamma) v *= gamma[k0 + kk]; }
    *(f32x4*)&tile[kk][n4] = v;
  }
  __syncthreads();
#pragma unroll
  for (int r = 0; r < 4; ++r) {
    const int idx = tid + r * NTHREADS, nn = idx & 255, oct = idx >> 8;
    half8 hv;
#pragma unroll
    for (int e = 0; e < 8; ++e) hv[e] = (half_t)tile[oct * 8 + e][nn];
    *(half8*)(Wt + (size_t)(n0 + nn) * K + k0 + oct * 8) = hv;
  }
}
__device__ void prep_weights(const Params& P, float* sm, int wvs) {
  const int tid = otid(wvs);
  constexpr int NJ = 8;
  const int nstr[NJ] = {(LD0 / 256) * (DM / 64), (DM / 256) * (DM / 64), (LD1 / 256) * (DM / 64), (DM / 256) * (DM / 64), 32, 32, 4, 4};
  int total = 0;
#pragma unroll
  for (int j = 0; j < NJ; ++j) total += nstr[j];
  for (int w = blockIdx.x; w < total; w += gridDim.x) {
    int j = 0, t = w;
#pragma unroll
    for (int jj = 0; jj < NJ - 1; ++jj) if (j == jj && t >= nstr[jj]) { t -= nstr[jj]; j = jj + 1; }
    const float* W; int ldw; const float* gamma; half_t* Wt; int K, mode;
    switch (j) {
      case 0: W = P.gla_w_in; ldw = GLA_IN; gamma = P.pre_norm; Wt = P.W0t; K = DM; mode = 0; break;
      case 1: W = P.gla_w_out; ldw = DM; gamma = nullptr; Wt = P.Wo0t; K = DM; mode = 2; break;
      case 2: W = P.nsa_w_in; ldw = NSA_IN; gamma = P.pre_norm + DM; Wt = P.W1t; K = DM; mode = 1; break;
      case 3: W = P.nsa_w_out; ldw = DM; gamma = nullptr; Wt = P.Wo1t; K = DM; mode = 2; break;
      case 4: W = P.ck_w1; ldw = 256; gamma = nullptr; Wt = P.cw1t; K = 2048; mode = 2; break;
      case 5: W = P.cv_w1; ldw = 256; gamma = nullptr; Wt = P.cw1t + 256 * 2048; K = 2048; mode = 2; break;
      case 6: W = P.ck_w2; ldw = 64; gamma = nullptr; Wt = P.cw2t; K = 256; mode = 4; break;
      default: W = P.cv_w2; ldw = 64; gamma = nullptr; Wt = P.cw2t + 256 * 256; K = 256; mode = 4; break;
    }
    const int nsk = K / 64;
    prep_strip(W, ldw, gamma, Wt, K, mode, (t / nsk) * 256, (t % nsk) * 64, sm, tid);
  }
}

__device__ void prep_cbias_part(const Params& P, int wvs) {
  for (int idx = blockIdx.x * NTHREADS + otid(wvs); idx < 2 * 32 * 256; idx += gridDim.x * NTHREADS) {
    const int j = idx & 255, ks = (idx >> 8) & 31, which = idx >> 13;
    const float* pe = which ? P.nsa_pe_v : P.nsa_pe_k;
    const float* w1 = which ? P.cv_w1 : P.ck_w1;
    float a = 0.f;
#pragma unroll 8
    for (int k = ks * 64; k < ks * 64 + 64; ++k) a += pe[k] * w1[(size_t)k * 256 + j];
    P.cbias_part[idx] = a;
  }
}
__device__ void prep_cbias_reduce(const Params& P, int wvs) {
  if (blockIdx.x < 2 && otid(wvs) < 256) {
    const int which = blockIdx.x, j = otid(wvs);
    float a = 0.f;
    for (int ks = 0; ks < 32; ++ks) a += P.cbias_part[(which * 32 + ks) * 256 + j];
    P.cbias[which * 256 + j] = a;
  }
}

namespace g8 {
constexpr int BK = 64, HALF = 128, HTB = HALF * BK * 2;
__device__ __forceinline__ int lds_byte(int r, int c) { const int st = (r >> 4) * 2 + (c >> 5), rr = r & 15, cc = c & 31, ob = rr * 64 + cc * 2; return st * 1024 + (ob ^ (((ob >> 9) & 1) << 5)); }
__device__ __forceinline__ void stage_rc(int b, int& R, int& C) { const int st = b / 1024, sb = b % 1024, swz = sb ^ (((sb >> 9) & 1) << 5); R = (st >> 1) * 16 + swz / 64; C = (st & 1) * 32 + (swz % 64) / 2; }
typedef f32x4 Acc[2][2][4][2];

struct SrcPlain8 {
  const half_t* A; int lda; const half_t* Bt; int K;
  __device__ __forceinline__ void get(int pm, int pn, const half_t*& Ag, const half_t*& Bg, size_t& a_rs, int& a_ks) const {
    Ag = A + (size_t)pm * 256 * lda; Bg = Bt + (size_t)pn * 256 * K; a_rs = lda; a_ks = 64;
  }
  __device__ __forceinline__ int ldb(int K_) const { return K_; }
};
struct SrcCmp1_8 {
  const half_t* p1; const half_t* w1t;
  __device__ __forceinline__ void get(int pm, int pn, const half_t*& Ag, const half_t*& Bg, size_t& a_rs, int& a_ks) const {
    const int which = pm >> 5, bg = pm & 31, b = bg >> 2, g = bg & 3;
    Ag = p1 + (size_t)(b * SEQ) * LD1 + (which ? 1280 : 1024) + g * 64;
    Bg = w1t + (size_t)which * 256 * 2048; a_rs = (size_t)16 * LD1; a_ks = LD1;
  }
  __device__ __forceinline__ int ldb(int K_) const { return K_; }
};
struct SrcCmp2_8 {
  const half_t* hid; const half_t* w2t;
  __device__ __forceinline__ void get(int pm, int pn, const half_t*& Ag, const half_t*& Bg, size_t& a_rs, int& a_ks) const {
    Ag = hid + (size_t)pm * 256 * 256; Bg = w2t + (size_t)(pm >> 5) * 256 * 256; a_rs = 256; a_ks = 64;
  }
  __device__ __forceinline__ int ldb(int K_) const { return K_; }
};
struct SrcCmp1h8 {
  const half_t* p1; const half_t* w1t;
  __device__ __forceinline__ void get(int pm, int pn, const half_t*& Ag, const half_t*& Bg, size_t& a_rs, int& a_ks) const {
    const int which = pm >> 5, bg = pm & 31, b = bg >> 2, g = bg & 3;
    Ag = p1 + (size_t)(b * SEQ) * LD1 + (which ? 1280 : 1024) + g * 64;
    Bg = w1t + (size_t)which * 256 * 2048 + pn * 1024; a_rs = (size_t)16 * LD1; a_ks = LD1;
  }
  __device__ __forceinline__ int ldb(int) const { return 2048; }
};

__device__ __forceinline__ half8 pack8(const f32x4 a, const f32x4 b) {
  half8 h; h[0] = (half_t)a[0]; h[1] = (half_t)a[1]; h[2] = (half_t)a[2]; h[3] = (half_t)a[3]; h[4] = (half_t)b[0]; h[5] = (half_t)b[1]; h[6] = (half_t)b[2]; h[7] = (half_t)b[3];
  return h;
}
struct EpiStore8 {
  half_t* C; int ldc; const float* rowscale;
  __device__ __forceinline__ void operator()(const Acc& acc, int row0, int col0, int wr, int wc, int fr, int fq) const {
    float rs[2][4];
#pragma unroll
    for (int ai = 0; ai < 2; ++ai)
#pragma unroll
      for (int m = 0; m < 4; ++m) rs[ai][m] = rowscale ? rowscale[row0 + ai * 128 + wr * 64 + m * 16 + fr] : 1.f;
#pragma unroll
    for (int ai = 0; ai < 2; ++ai)
#pragma unroll
      for (int m = 0; m < 4; ++m) {
        const int tok = row0 + ai * 128 + wr * 64 + m * 16 + fr;
        const float s = rs[ai][m];
        half_t* rowp = C + (size_t)tok * ldc + col0 + 64 * wc + 8 * fq;
#pragma unroll
        for (int bj = 0; bj < 2; ++bj) *(half8*)(rowp + 32 * bj) = pack8(acc[ai][bj][m][0] * s, acc[ai][bj][m][1] * s);
      }
  }
};
struct EpiRope8 {
  half_t* C; int ldc; const float* rowscale; const float* ropetab;
  __device__ __forceinline__ void operator()(const Acc& acc, int row0, int col0, int wr, int wc, int fr, int fq) const {
    const int grp = (col0 >> 6) + wc;
    const bool is_q = grp < 16;
    const bool roped = is_q || (grp >= 16 && grp < 20) || (grp >= 24 && grp < 28) || (grp >= 32 && grp < 36);
    const float sc = is_q ? 0.125f * 1.4426950408889634f : 1.f;
    float s = rowscale[row0 + wr * 64 + fr];
    f32x4 cs[2], sn[2];
    if (roped) {
      const int tok0 = row0 + wr * 64 + fr;
#pragma unroll
      for (int n = 0; n < 2; ++n) { cs[n] = *(const f32x4*)(ropetab + (size_t)tok0 * 64 + 8 * fq + 4 * n); sn[n] = *(const f32x4*)(ropetab + (size_t)tok0 * 64 + 32 + 8 * fq + 4 * n); }
    }
#pragma unroll
    for (int i = 0; i < 8; ++i) {
        const int ai = i >> 2, m = i & 3;
        const int tok = row0 + ai * 128 + wr * 64 + m * 16 + fr;
        half_t* rowp = C + (size_t)tok * ldc + col0 + 64 * wc + 8 * fq;
        f32x4 o1[2], o2[2];
#pragma unroll
        for (int n = 0; n < 2; ++n) {
          const f32x4 x1 = acc[ai][0][m][n] * s, x2 = acc[ai][1][m][n] * s;
          if (roped) { o1[n] = (x1 * cs[n] - x2 * sn[n]) * sc; o2[n] = (x2 * cs[n] + x1 * sn[n]) * sc; }
          else { o1[n] = x1; o2[n] = x2; }
        }
        const half8 p1 = pack8(o1[0], o1[1]), p2 = pack8(o2[0], o2[1]);
        if (i + 1 < 8) {
          const int tokn = row0 + ((i + 1) >> 2) * 128 + wr * 64 + ((i + 1) & 3) * 16 + fr;
          s = rowscale[tokn];
          if (roped) {
#pragma unroll
            for (int n = 0; n < 2; ++n) { cs[n] = *(const f32x4*)(ropetab + (size_t)tokn * 64 + 8 * fq + 4 * n); sn[n] = *(const f32x4*)(ropetab + (size_t)tokn * 64 + 32 + 8 * fq + 4 * n); }
          }
        }
        *(half8*)(rowp) = p1;
        *(half8*)(rowp + 32) = p2;
    }
  }
};
struct EpiCmpHid8 {
  half_t* hid; const float* bias;
  __device__ __forceinline__ void operator()(const Acc& acc, int row0, int col0, int wr, int wc, int fr, int fq) const {
    const int which = row0 >> 13;
#pragma unroll
    for (int bj = 0; bj < 2; ++bj) {
      const int col = col0 + 64 * wc + 32 * bj + 8 * fq;
      const f32x4 b0 = *(const f32x4*)(bias + which * 256 + col), b1 = *(const f32x4*)(bias + which * 256 + col + 4);
#pragma unroll
      for (int ai = 0; ai < 2; ++ai)
#pragma unroll
        for (int m = 0; m < 4; ++m) {
          const int row = row0 + ai * 128 + wr * 64 + m * 16 + fr;
          f32x4 v0 = acc[ai][bj][m][0] + b0, v1 = acc[ai][bj][m][1] + b1;
#pragma unroll
          for (int e = 0; e < 4; ++e) { v0[e] = siluf(v0[e]); v1[e] = siluf(v1[e]); }
          *(half8*)(hid + (size_t)row * 256 + col) = pack8(v0, v1);
        }
    }
  }
};
struct EpiCmpPart8 {
  half_t* part; unsigned* done;
  __device__ __forceinline__ void operator()(const Acc& acc, int row0, int col0, int wr, int wc, int fr, int fq) const {
    half_t* base = part + (size_t)(col0 >> 8) * 16384 * 256;
#pragma unroll
    for (int ai = 0; ai < 2; ++ai)
#pragma unroll
      for (int m = 0; m < 4; ++m) {
        half_t* rowp = base + (size_t)(row0 + ai * 128 + wr * 64 + m * 16 + fr) * 256 + 64 * wc + 8 * fq;
#pragma unroll
        for (int bj = 0; bj < 2; ++bj) *(half8*)(rowp + 32 * bj) = pack8(acc[ai][bj][m][0], acc[ai][bj][m][1]);
      }
    asm volatile("s_waitcnt vmcnt(0)" ::: "memory");
    __syncthreads();
    if (wr == 0 && wc == 0 && lane_id() == 0) {
      __builtin_amdgcn_fence(__ATOMIC_RELEASE, "agent");
      __hip_atomic_fetch_add(done + (row0 >> 8), 1u, __ATOMIC_RELAXED, __HIP_MEMORY_SCOPE_AGENT);
    }
  }
};
struct EpiCmpOut8 {
  half_t* kcmp; half_t* vcmp; unsigned* kmaxc;
  __device__ __forceinline__ void operator()(const Acc& acc, int row0, int col0, int wr, int wc, int fr, int fq) const {
    if (wc != 0) return;
#pragma unroll
    for (int ai = 0; ai < 2; ++ai)
#pragma unroll
      for (int m = 0; m < 4; ++m) {
        const int row = row0 + ai * 128 + wr * 64 + m * 16 + fr;
        const int which = row >> 13, r = row & 8191;
        half_t* dst = (which ? vcmp : kcmp) + (size_t)r * 64 + 8 * fq;
        const bool dead = (r & 255) == 255;
        float ss = 0.f;
#pragma unroll
        for (int bj = 0; bj < 2; ++bj) {
          half8 hv = pack8(acc[ai][bj][m][0], acc[ai][bj][m][1]);
          if (dead) hv = (half8){(half_t)0.f, (half_t)0.f, (half_t)0.f, (half_t)0.f, (half_t)0.f, (half_t)0.f, (half_t)0.f, (half_t)0.f};
#pragma unroll
          for (int e = 0; e < 8; ++e) ss += (float)hv[e] * (float)hv[e];
          *(half8*)(dst + 32 * bj) = hv;
        }
        if (which == 0) {
          ss = rowsum4(ss);
          ss = wave_max(ss);
          if (lane_id() == 0) __hip_atomic_fetch_max(&kmaxc[r >> 8], __float_as_uint(ss), __ATOMIC_RELAXED, __HIP_MEMORY_SCOPE_AGENT);
        }
      }
  }
};

template <class Src, class Epi>
__device__ void gemm(const Src& src, int M, int N, int K, const Epi& epi, char* smem, int wvs) {
  const int tid = otid(wvs), wid = __builtin_amdgcn_readfirstlane(tid >> 6), lane = tid & 63, wr = wid >> 2, wc = wid & 3, fr = lane & 15, fq = lane >> 4;
  const int nM = M / 256, nN = N / 256, nwg = nM * nN, G = gridDim.x, nt = K / BK;
  int sr0, sc0, sr1, sc1;
  stage_rc(tid * 16, sr0, sc0); stage_rc(tid * 16 + 8192, sr1, sc1);
  const int a_base = lds_byte(wr * 64 + fr, fq * 8);
  int b_base = 65536 + lds_byte(wc * 32 + fr, fq * 8);
  asm volatile("" : "+v"(b_base));
#define SA8(b, h) (smem + ((b) * 2 + (h)) * HTB)
#define SB8(b, h) (smem + (4 + (b) * 2 + (h)) * HTB)
#define STAGE_A(P, h, kt) { const char* g_ = (const char*)(Ag + (size_t)(h) * 128 * lda + (size_t)(kt) * a_ks); \
    __builtin_amdgcn_global_load_lds((gbl_void*)(g_ + aob0), (lds_void*)((P) + wid * 1024), 16, 0, 0); \
    __builtin_amdgcn_global_load_lds((gbl_void*)(g_ + aob1), (lds_void*)((P) + 8192 + wid * 1024), 16, 0, 0); }
#define STAGE_B(P, h, kt) { const char* g_ = (const char*)(Bg + (size_t)(h) * 32 * ldb + (size_t)(kt) * 64);     \
    __builtin_amdgcn_global_load_lds((gbl_void*)(g_ + bob0), (lds_void*)((P) + wid * 1024), 16, 0, 0); \
    __builtin_amdgcn_global_load_lds((gbl_void*)(g_ + bob1), (lds_void*)((P) + 8192 + wid * 1024), 16, 0, 0); }
#define LDA8(dst, b, h) { _Pragma("unroll") for (int m = 0; m < 4; ++m) _Pragma("unroll") for (int k = 0; k < 2; ++k) dst[m][k] = *(const half8*)(SA8(b, h) + a_base + m * 2048 + k * 1024); }
#define LDB8(dst, b, h) { _Pragma("unroll") for (int n = 0; n < 2; ++n) _Pragma("unroll") for (int k = 0; k < 2; ++k) dst[n][k] = *(const half8*)(smem + ((b) * 2 + (h)) * HTB + b_base + n * 2048 + k * 1024); }
#define MMA8(ai, bj, At, Bx) { __builtin_amdgcn_s_setprio(1); \
    _Pragma("unroll") for (int m = 0; m < 4; ++m) _Pragma("unroll") for (int n = 0; n < 2; ++n) _Pragma("unroll") for (int k = 0; k < 2; ++k) \
      acc[ai][bj][m][n] = __builtin_amdgcn_mfma_f32_16x16x32_f16(Bx[n][k], At[m][k], acc[ai][bj][m][n], 0, 0, 0); \
    __builtin_amdgcn_s_setprio(0); }
#define WAIT_V(n) asm volatile("s_waitcnt vmcnt(" #n ")" ::: "memory")
#define WAIT_L(n) asm volatile("s_waitcnt lgkmcnt(" #n ")" ::: "memory")
#define BAR __builtin_amdgcn_s_barrier()
#define SCHED __builtin_amdgcn_sched_barrier(0)
  for (int it = 0;; ++it) {
    const int L = it * G + (int)blockIdx.x;
    if (L >= nwg) break;
    int wgid;
    { const int q = nwg / 8, r = nwg % 8, xcd = L % 8, off = L / 8; wgid = (xcd < r ? xcd * (q + 1) : r * (q + 1) + (xcd - r) * q) + off; }
    const int nig = 8 * nN, gid = wgid / nig, fm = gid * 8, gsz = (nM - fm) < 8 ? (nM - fm) : 8;
    const int pm = fm + ((wgid % nig) % gsz), pn = (wgid % nig) / gsz;
    const half_t* Ag; const half_t* Bg; size_t lda; int a_ks;
    src.get(pm, pn, Ag, Bg, lda, a_ks);
    const unsigned aob0 = (unsigned)(((size_t)sr0 * lda + sc0) * 2), aob1 = (unsigned)(((size_t)sr1 * lda + sc1) * 2);
    const int pr0 = 64 * (sr0 >> 5) + 8 * ((sr0 & 15) >> 2) + 4 * ((sr0 >> 4) & 1) + (sr0 & 3), pr1 = 64 * (sr1 >> 5) + 8 * ((sr1 & 15) >> 2) + 4 * ((sr1 >> 4) & 1) + (sr1 & 3);
    const int ldb = src.ldb(K);
    const unsigned bob0 = (unsigned)((pr0 * ldb + sc0) * 2), bob1 = (unsigned)((pr1 * ldb + sc1) * 2);
    Acc acc;
#pragma unroll
    for (int a = 0; a < 2; ++a)
#pragma unroll
      for (int b = 0; b < 2; ++b)
#pragma unroll
        for (int m = 0; m < 4; ++m)
#pragma unroll
          for (int n = 0; n < 2; ++n) acc[a][b][m][n] = (f32x4){0.f, 0.f, 0.f, 0.f};
    half8 At[4][2], B0[2][2], B1[2][2];
    STAGE_B(SB8(0, 0), 0, 0) STAGE_A(SA8(0, 0), 0, 0)
    STAGE_B(SB8(0, 1), 1, 0) STAGE_A(SA8(0, 1), 1, 0)
    if (wr == 1) BAR;
    WAIT_V(4); BAR;
    STAGE_B(SB8(1, 0), 0, 1) STAGE_A(SA8(1, 0), 0, 1) STAGE_B(SB8(1, 1), 1, 1)
    WAIT_V(6); BAR;
#pragma unroll 1
    for (int t = 0; t < nt - 2; t += 2) {
      LDB8(B0, 0, 0) SCHED; LDA8(At, 0, 0) STAGE_A(SA8(1, 1), 1, t + 1)
      WAIT_L(8); BAR; WAIT_L(0); MMA8(0, 0, At, B0) BAR; SCHED;
      LDB8(B1, 0, 1) STAGE_B(SB8(0, 0), 0, t + 2)
      BAR; WAIT_L(0); MMA8(0, 1, At, B1) BAR;
      LDA8(At, 0, 1) STAGE_A(SA8(0, 0), 0, t + 2)
      BAR; WAIT_L(0); MMA8(1, 0, At, B0) BAR; SCHED;
      STAGE_B(SB8(0, 1), 1, t + 2)
      WAIT_V(6); BAR; MMA8(1, 1, At, B1) BAR;
      LDB8(B0, 1, 0) SCHED; LDA8(At, 1, 0) STAGE_A(SA8(0, 1), 1, t + 2)
      WAIT_L(8); BAR; WAIT_L(0); MMA8(0, 0, At, B0) BAR; SCHED;
      LDB8(B1, 1, 1) STAGE_B(SB8(1, 0), 0, t + 3)
      BAR; WAIT_L(0); MMA8(0, 1, At, B1) BAR;
      LDA8(At, 1, 1) STAGE_A(SA8(1, 0), 0, t + 3)
      BAR; WAIT_L(0); MMA8(1, 0, At, B0) BAR; SCHED;
      STAGE_B(SB8(1, 1), 1, t + 3)
      WAIT_V(6); BAR; MMA8(1, 1, At, B1) BAR;
    }
    { LDB8(B0, 0, 0) LDA8(At, 0, 0) STAGE_A(SA8(1, 1), 1, nt - 1)
      BAR; WAIT_L(0); MMA8(0, 0, At, B0) BAR;
      LDB8(B1, 0, 1) BAR; WAIT_L(0); MMA8(0, 1, At, B1) BAR;
      LDA8(At, 0, 1) WAIT_V(4); BAR; WAIT_L(0); MMA8(1, 0, At, B0) MMA8(1, 1, At, B1) BAR; }
    { LDB8(B0, 1, 0) LDA8(At, 1, 0) WAIT_V(2); BAR; WAIT_L(0); MMA8(0, 0, At, B0) BAR;
      LDB8(B1, 1, 1) WAIT_V(0); BAR; WAIT_L(0); MMA8(0, 1, At, B1) BAR;
      LDA8(At, 1, 1) BAR; WAIT_L(0); MMA8(1, 0, At, B0) MMA8(1, 1, At, B1) BAR; }
    if (wr == 0) BAR;
    { int fr2 = fr, fq2 = fq; asm volatile("" : "+v"(fr2), "+v"(fq2)); epi(acc, pm * 256, pn * 256, wr, wc, fr2, fq2); }
  }
#undef SA8
#undef SB8
#undef STAGE_A
#undef STAGE_B
#undef LDA8
#undef LDB8
#undef MMA8
#undef WAIT_V
#undef WAIT_L
#undef BAR
#undef SCHED
}
}

struct GlaPrepOps { half8 q0, k0, q1, k1; float w[16]; float bb; };
__device__ void ph_gla_prep(const Params& P, float* sm, int wvs) {
  float(*glr)[16] = (float(*)[16])sm;
  float(*tot)[128] = (float(*)[128])(sm + 1024);
  float(*exl)[132] = (float(*)[132])(sm + 1536);
  const int tid = otid(wvs);
  const int tq = tid >> 7, c = tid & 127;
  const int tp = tid >> 4, co = tid & 15;
  const float scale = 0.08838834764831845f;
  const int nchunks = T_TOK / 64, G = gridDim.x;
  const int nj = (((nchunks - 1 - (int)blockIdx.x) / G) + 1) * 4;
  GlaPrepOps nxt; f32x4 gnx = {};
#define GLA_PREP_LOAD(j_) { const int chunk_ = (int)blockIdx.x + ((j_) >> 2) * G, h_ = (j_) & 3, ch_ = h_ * 128 + c; \
    const half_t* qp_ = P.p + (size_t)(chunk_ * 64 + 2 * tp) * LD0 + h_ * 128 + co * 8; \
    nxt.q0 = *(const half8*)(qp_); nxt.k0 = *(const half8*)(qp_ + 512); nxt.q1 = *(const half8*)(qp_ + LD0); nxt.k1 = *(const half8*)(qp_ + LD0 + 512); \
    _Pragma("unroll") for (int r = 0; r < 16; ++r) nxt.w[r] = P.gla_w_gk_up[r * 512 + ch_]; \
    nxt.bb = P.gla_b_gk[ch_]; \
    if (h_ == 0 && tid < 256) gnx = *(const f32x4*)(P.glr + (size_t)(chunk_ * 64) * 16 + tid * 4); }
  GLA_PREP_LOAD(0)
#pragma unroll 1
  for (int j = 0; j < nj; ++j) {
    const int chunk = (int)blockIdx.x + (j >> 2) * G, h = j & 3;
    const int t0 = chunk * 64, ch = h * 128 + c;
    const GlaPrepOps cur = nxt;
    __syncthreads();
    if (h == 0 && tid < 256) *(f32x4*)(sm + tid * 4) = gnx;
    if (j + 1 < nj) GLA_PREP_LOAD(j + 1)
    __syncthreads();
    float pre[16]; float cum = 0.f;
#pragma unroll
    for (int i = 0; i < 16; ++i) {
      float u = cur.bb;
#pragma unroll
      for (int r = 0; r < 16; ++r) u += glr[tq * 16 + i][r] * cur.w[r];
      cum += logsigmoidf(u) * (1.f / 16.f);
      pre[i] = cum;
    }
    tot[tq][c] = cum;
    __syncthreads();
    float off = 0.f;
#pragma unroll
    for (int t = 0; t < 3; ++t) if (t < tq) off += tot[t][c];
#pragma unroll
    for (int i = 0; i < 16; ++i) {
      const float ex = fast_exp2((pre[i] + off) * LOG2E);
      exl[tq * 16 + i][c] = ex;
      if (tq == 3 && i == 15) P.bcum[(size_t)chunk * 512 + ch] = ex;
    }
    __syncthreads();
    {
      half_t* qp = P.p + (size_t)(t0 + 2 * tp) * LD0 + h * 128 + co * 8;
      const f32x4 e00 = *(const f32x4*)&exl[2 * tp][co * 8], e01 = *(const f32x4*)&exl[2 * tp][co * 8 + 4];
      const f32x4 e10 = *(const f32x4*)&exl[2 * tp + 1][co * 8], e11 = *(const f32x4*)&exl[2 * tp + 1][co * 8 + 4];
      half8 oq0, ok0, oq1, ok1;
#pragma unroll
      for (int e = 0; e < 8; ++e) {
        const float x0 = e < 4 ? e00[e] : e01[e - 4], x1 = e < 4 ? e10[e] : e11[e - 4];
        oq0[e] = (half_t)((float)cur.q0[e] * scale * x0); ok0[e] = (half_t)((float)cur.k0[e] * __builtin_amdgcn_rcpf(x0));
        oq1[e] = (half_t)((float)cur.q1[e] * scale * x1); ok1[e] = (half_t)((float)cur.k1[e] * __builtin_amdgcn_rcpf(x1));
      }
      *(half8*)(qp) = oq0; *(half8*)(qp + 512) = ok0; *(half8*)(qp + LD0) = oq1; *(half8*)(qp + LD0 + 512) = ok1;
    }
  }
#undef GLA_PREP_LOAD
}

constexpr int GLA_QE = 0, GLA_KE = 16384, GLA_V = 32768, GLA_DEC = 49152, GLA_BUF = 53248;
#define GLA_TR4(d0, d1, d2, d3, addr, o0, o1, o2, o3) \
  asm volatile("ds_read_b64_tr_b16 %0, %4 offset:%5\n\tds_read_b64_tr_b16 %1, %4 offset:%6\n\tds_read_b64_tr_b16 %2, %4 offset:%7\n\tds_read_b64_tr_b16 %3, %4 offset:%8" \
               : "=&v"(d0), "=&v"(d1), "=&v"(d2), "=&v"(d3) : "v"(addr), "n"(o0), "n"(o1), "n"(o2), "n"(o3) : "memory")
__device__ __forceinline__ half8 pack_h8(const v2i a, const v2i b) { const v4i p = (v4i){a[0], a[1], b[0], b[1]}; return __builtin_bit_cast(half8, p); }

template <bool STATE_ONLY>
__device__ void ph_gla_mfma(const Params& P, char* smem, int wvs) {
  const int tid = otid(wvs);
  const int lane = tid & 63, wave = __builtin_amdgcn_readfirstlane(tid >> 6), r15 = lane & 15, q = lane >> 4;
  const int qp = r15 >> 2, pp = lane & 3;
  const int srow = tid >> 4, sslot = tid & 15;
  const int src_q = (sslot ^ (srow & 15)) * 8, src_kv = (sslot ^ ((srow & 7) << 1)) * 8;
  const int fk = ((4 * (q & 1) + qp) & 7) << 1;
  const unsigned tr_row = (unsigned)((4 * q + qp) * 256 + 8 * (pp & 1) + ((pp >> 1) << 4));
  constexpr int NLOAD = STATE_ONLY ? 5 : 7;
  for (int wg = blockIdx.x; wg < (STATE_ONLY ? 3 : 4) * 64; wg += gridDim.x) {
    const int pr_ = ((wg >> 4) << 3) | (wg & 7), item = ((pr_ >> 5) << 6) | ((pr_ & 31) << 1) | ((wg >> 3) & 1);
    const int seg = item >> 6, base = item & 63, b = base >> 3, h = (base >> 1) & 3, vs = base & 1;
    const int c0 = seg * 16;
    f32x4 S[8], Dacc[8];
#pragma unroll
    for (int df = 0; df < 8; ++df) { S[df] = (f32x4){0.f, 0.f, 0.f, 0.f}; Dacc[df] = (f32x4){1.f, 1.f, 1.f, 1.f}; }
    f32x4* stL = (f32x4*)P.gla_state + ((size_t)base * 8 + wave) * 8 * 64 + lane;
    f32x4* stD = stL + (size_t)3 * 64 * 8 * 8 * 64;
    if (!STATE_ONLY) {
      for (int k = 0; k < seg; ++k) {
#pragma unroll
        for (int df = 0; df < 8; ++df) {
          const f32x4 Lk = stL[((size_t)k * 64 * 8 * 8 + df) * 64];
          if (k == 0) S[df] = Lk;
          else { const f32x4 Dk = stD[((size_t)k * 64 * 8 * 8 + df) * 64]; S[df] = Dk * S[df] + Lk; }
        }
      }
    }
    const half_t* qsrc = P.p + (size_t)(b * SEQ + srow) * LD0 + h * 128;
    const half_t* vsrc = P.p + (size_t)(b * SEQ + srow) * LD0 + 1024 + h * 256 + vs * 128 + src_kv;
    const float* dsrc = P.bcum + (size_t)(b * 64 + c0) * 512 + h * 128 + (lane & 31) * 4;
#define G_ISSUE(N, BUF) { char* lb_ = smem + (BUF) * GLA_BUF + wave * 1024; const size_t ro_ = (size_t)(c0 + (N)) * 64 * LD0; \
      if (!STATE_ONLY) { __builtin_amdgcn_global_load_lds((gbl_void*)(qsrc + ro_ + src_q), (lds_void*)(lb_ + GLA_QE), 16, 0, 0); \
      __builtin_amdgcn_global_load_lds((gbl_void*)(qsrc + ro_ + (size_t)32 * LD0 + src_q), (lds_void*)(lb_ + GLA_QE + 8192), 16, 0, 0); } \
      __builtin_amdgcn_global_load_lds((gbl_void*)(qsrc + ro_ + 512 + src_kv), (lds_void*)(lb_ + GLA_KE), 16, 0, 0); \
      __builtin_amdgcn_global_load_lds((gbl_void*)(qsrc + ro_ + (size_t)32 * LD0 + 512 + src_kv), (lds_void*)(lb_ + GLA_KE + 8192), 16, 0, 0); \
      __builtin_amdgcn_global_load_lds((gbl_void*)(vsrc + ro_), (lds_void*)(lb_ + GLA_V), 16, 0, 0); \
      __builtin_amdgcn_global_load_lds((gbl_void*)(vsrc + ro_ + (size_t)32 * LD0), (lds_void*)(lb_ + GLA_V + 8192), 16, 0, 0); \
      if (lane < 32) __builtin_amdgcn_global_load_lds((gbl_void*)(dsrc + (size_t)(N) * 512), (lds_void*)(smem + (BUF) * GLA_BUF + GLA_DEC + wave * 512), 16, 0, 0); }
    G_ISSUE(0, 0)
    G_ISSUE(1, 1)
#pragma unroll 1
    for (int n = 0; n < 16; ++n) {
      if (n + 1 < 16) wait_vmcnt<NLOAD>(); else wait_vmcnt<0>();
      __builtin_amdgcn_s_barrier();
      if (n + 2 < 16) G_ISSUE(n + 2, (n + 2) % 3)
      const char* cb = smem + (n % 3) * GLA_BUF;
      f32x4 aT[4][4];
      if (!STATE_ONLY) {
#pragma unroll
      for (int kf = 0; kf < 4; ++kf)
#pragma unroll
        for (int tf = 0; tf < 4; ++tf) aT[kf][tf] = (f32x4){0.f, 0.f, 0.f, 0.f};
#pragma unroll
      for (int ks = 0; ks < 4; ++ks) {
        half8 kef[4], qef[4];
#pragma unroll
        for (int f = 0; f < 4; ++f) {
          kef[f] = *(const half8*)(cb + GLA_KE + (16 * f + r15) * 256 + (((4 * ks + q) ^ ((r15 & 7) << 1)) << 4));
          qef[f] = *(const half8*)(cb + GLA_QE + (16 * f + r15) * 256 + (((4 * ks + q) ^ r15) << 4));
        }
#pragma unroll
        for (int kf = 0; kf < 4; ++kf)
#pragma unroll
          for (int tf = kf; tf < 4; ++tf) aT[kf][tf] = __builtin_amdgcn_mfma_f32_16x16x32_f16(kef[kf], qef[tf], aT[kf][tf], 0, 0, 0);
      }
#pragma unroll
      for (int f = 0; f < 4; ++f)
#pragma unroll
        for (int r = 0; r < 4; ++r) if (4 * q + r > r15) aT[f][f][r] = 0.f;
      }
      const unsigned lds0 = (unsigned)(size_t)cb;
      const unsigned va = lds0 + GLA_V + tr_row + ((((2 * wave) ^ fk)) << 4);
      v2i v00, v01, v10, v11;
      GLA_TR4(v00, v01, v10, v11, va, 0, 4096, 8192, 12288);
      const unsigned ka = lds0 + GLA_KE + tr_row;
      v2i k0[4][4];
#pragma unroll
      for (int df = 0; df < 4; ++df) { const unsigned a_ = ka + ((((2 * df) ^ fk)) << 4); GLA_TR4(k0[df][0], k0[df][1], k0[df][2], k0[df][3], a_, 0, 4096, 8192, 12288); }
      asm volatile("s_waitcnt lgkmcnt(15)" : "+v"(v00), "+v"(v01), "+v"(v10), "+v"(v11) :: "memory");
      __builtin_amdgcn_sched_barrier(0);
      half8 vf[2];
      vf[0] = pack_h8(v00, v01); vf[1] = pack_h8(v10, v11);
      if (!STATE_ONLY) {
      f32x4 o[4];
#pragma unroll
      for (int tf = 0; tf < 4; ++tf) o[tf] = (f32x4){0.f, 0.f, 0.f, 0.f};
#pragma unroll
      for (int ks2 = 0; ks2 < 2; ++ks2)
#pragma unroll
        for (int tf = 2 * ks2; tf < 4; ++tf) {
          half8 pk;
#pragma unroll
          for (int r = 0; r < 4; ++r) { pk[r] = (half_t)aT[2 * ks2][tf][r]; pk[4 + r] = (half_t)aT[2 * ks2 + 1][tf][r]; }
          o[tf] = __builtin_amdgcn_mfma_f32_16x16x32_f16(vf[ks2], pk, o[tf], 0, 0, 0);
        }
#pragma unroll
      for (int ks = 0; ks < 4; ++ks) {
        half8 sf;
#pragma unroll
        for (int r = 0; r < 4; ++r) { sf[r] = (half_t)S[2 * ks][r]; sf[4 + r] = (half_t)S[2 * ks + 1][r]; }
#pragma unroll
        for (int tf = 0; tf < 4; ++tf) {
          const int row = 16 * tf + r15;
          const half4 qa = *(const half4*)(cb + GLA_QE + row * 256 + (((4 * ks + (q >> 1)) ^ r15) << 4) + (q & 1) * 8);
          const half4 qb = *(const half4*)(cb + GLA_QE + row * 256 + (((4 * ks + 2 + (q >> 1)) ^ r15) << 4) + (q & 1) * 8);
          half8 qv;
#pragma unroll
          for (int e = 0; e < 4; ++e) { qv[e] = qa[e]; qv[4 + e] = qb[e]; }
          o[tf] = __builtin_amdgcn_mfma_f32_16x16x32_f16(sf, qv, o[tf], 0, 0, 0);
        }
      }
      {
        const size_t t0 = (size_t)(b * SEQ + (c0 + n) * 64);
#pragma unroll
        for (int tf = 0; tf < 4; ++tf) {
          half4 hv; hv[0] = (half_t)o[tf][0]; hv[1] = (half_t)o[tf][1]; hv[2] = (half_t)o[tf][2]; hv[3] = (half_t)o[tf][3];
          *(half4*)(P.og + (t0 + 16 * tf + r15) * DM + h * 256 + vs * 128 + 16 * wave + 4 * q) = hv;
        }
      }
      }
      v2i k1[4][4];
#pragma unroll
      for (int df = 0; df < 4; ++df) { const unsigned a_ = ka + ((((2 * (df + 4)) ^ fk)) << 4); GLA_TR4(k1[df][0], k1[df][1], k1[df][2], k1[df][3], a_, 0, 4096, 8192, 12288); }
      asm volatile("s_waitcnt lgkmcnt(15)"
                   : "+v"(k0[0][0]), "+v"(k0[0][1]), "+v"(k0[0][2]), "+v"(k0[0][3]), "+v"(k0[1][0]), "+v"(k0[1][1]), "+v"(k0[1][2]), "+v"(k0[1][3]),
                     "+v"(k0[2][0]), "+v"(k0[2][1]), "+v"(k0[2][2]), "+v"(k0[2][3]), "+v"(k0[3][0]), "+v"(k0[3][1]), "+v"(k0[3][2]), "+v"(k0[3][3]) :: "memory");
      __builtin_amdgcn_sched_barrier(0);
#pragma unroll
      for (int df = 0; df < 4; ++df) {
        S[df] = __builtin_amdgcn_mfma_f32_16x16x32_f16(pack_h8(k0[df][0], k0[df][1]), vf[0], S[df], 0, 0, 0);
        S[df] = __builtin_amdgcn_mfma_f32_16x16x32_f16(pack_h8(k0[df][2], k0[df][3]), vf[1], S[df], 0, 0, 0);
      }
      asm volatile("s_waitcnt lgkmcnt(0)"
                   : "+v"(k1[0][0]), "+v"(k1[0][1]), "+v"(k1[0][2]), "+v"(k1[0][3]), "+v"(k1[1][0]), "+v"(k1[1][1]), "+v"(k1[1][2]), "+v"(k1[1][3]),
                     "+v"(k1[2][0]), "+v"(k1[2][1]), "+v"(k1[2][2]), "+v"(k1[2][3]), "+v"(k1[3][0]), "+v"(k1[3][1]), "+v"(k1[3][2]), "+v"(k1[3][3]) :: "memory");
      __builtin_amdgcn_sched_barrier(0);
#pragma unroll
      for (int df = 0; df < 4; ++df) {
        S[df + 4] = __builtin_amdgcn_mfma_f32_16x16x32_f16(pack_h8(k1[df][0], k1[df][1]), vf[0], S[df + 4], 0, 0, 0);
        S[df + 4] = __builtin_amdgcn_mfma_f32_16x16x32_f16(pack_h8(k1[df][2], k1[df][3]), vf[1], S[df + 4], 0, 0, 0);
      }
#pragma unroll
      for (int df = 0; df < 8; ++df) {
        const f32x4 dc = *(const f32x4*)(cb + GLA_DEC + wave * 512 + (16 * df + 4 * q) * 4);
        S[df] *= dc;
        if (STATE_ONLY) Dacc[df] *= dc;
      }
    }
    if (STATE_ONLY) {
#pragma unroll
      for (int df = 0; df < 8; ++df) { stL[((size_t)seg * 64 * 8 * 8 + df) * 64] = S[df]; stD[((size_t)seg * 64 * 8 * 8 + df) * 64] = Dacc[df]; }
    }
    asm volatile("s_waitcnt vmcnt(0)" ::: "memory");
    __builtin_amdgcn_s_barrier();
#undef G_ISSUE
  }
}

__device__ void ph_gla_post(const Params& P, int wvs) {
  const int tid_ = otid(wvs); const int lane = tid_ & 63, sub = lane & 31;
  const int u0 = blockIdx.x * 16 + (tid_ >> 5);
  const float4 hn0 = ((const float4*)P.gla_head_norm)[sub * 2], hn1 = ((const float4*)P.gla_head_norm)[sub * 2 + 1];
  constexpr int UW = 4;
  const int ustride = gridDim.x * 16;
#pragma unroll 1
  for (int ub = u0; ub < T_TOK * 4; ub += ustride * UW) {
    half8 hv[UW], z[UW];
#pragma unroll
    for (int r = 0; r < UW; ++r) {
      const int u = ub + r * ustride, t = u >> 2, h = u & 3;
      hv[r] = *((const half8*)(P.og + (size_t)t * DM + h * 256) + sub);
      z[r] = *((const half8*)(P.p + (size_t)t * LD0 + 2048 + h * 256) + sub);
    }
#pragma unroll
    for (int r = 0; r < UW; ++r) {
      const int u = ub + r * ustride, t = u >> 2, h = u & 3;
      float v[8]; float ss = 0.f;
#pragma unroll
      for (int e = 0; e < 8; ++e) { v[e] = (float)hv[r][e]; ss += v[e] * v[e]; }
#pragma unroll
      for (int o = 16; o > 0; o >>= 1) ss += __shfl_xor(ss, o);
      const float rr = rsqrtf(ss * (1.f / 256.f) + EPS);
      const float hn[8] = {hn0.x, hn0.y, hn0.z, hn0.w, hn1.x, hn1.y, hn1.z, hn1.w};
      half8 o;
#pragma unroll
      for (int e = 0; e < 8; ++e) o[e] = (half_t)(v[e] * rr * hn[e] * siluf((float)z[r][e]));
      *((half8*)(P.og + (size_t)t * DM + h * 256) + sub) = o;
    }
  }
}

template <bool FINAL>
__device__ void ph_post(const half_t* baseh, const half_t* y, const float* g, float* dst, half_t* dsth, float* rstd_out, int wvs) {
  const int tid_ = otid(wvs); const int lane = tid_ & 63, w = tid_ >> 6;
  constexpr int RW = 4;
  const int rstride = gridDim.x * NWAVES;
#pragma unroll 1
  for (int row0 = blockIdx.x * NWAVES + w; row0 < T_TOK; row0 += rstride * RW) {
    half4 yv[RW][4], bv[RW][4];
#pragma unroll
    for (int r = 0; r < RW; ++r)
#pragma unroll
      for (int i = 0; i < 4; ++i) yv[r][i] = ((const half4*)(y + (size_t)(row0 + r * rstride) * DM))[lane + 64 * i];
#pragma unroll
    for (int r = 0; r < RW; ++r)
#pragma unroll
      for (int i = 0; i < 4; ++i) bv[r][i] = ((const half4*)(baseh + (size_t)(row0 + r * rstride) * DM))[lane + 64 * i];
#pragma unroll
    for (int r = 0; r < RW; ++r) {
      const int row = row0 + r * rstride;
      float ss = 0.f;
#pragma unroll
      for (int i = 0; i < 4; ++i)
#pragma unroll
        for (int e = 0; e < 4; ++e) { const float t = (float)yv[r][i][e]; ss += t * t; }
      ss = wave_sum(ss);
      const float rr = rsqrtf(ss * (1.f / DM) + EPS);
      float s2 = 0.f;
#pragma unroll
      for (int i = 0; i < 4; ++i) {
        const float4 gg = ((const float4*)g)[lane + 64 * i];
        float4 o;
        o.x = (float)bv[r][i][0] + (float)yv[r][i][0] * rr * gg.x; o.y = (float)bv[r][i][1] + (float)yv[r][i][1] * rr * gg.y;
        o.z = (float)bv[r][i][2] + (float)yv[r][i][2] * rr * gg.z; o.w = (float)bv[r][i][3] + (float)yv[r][i][3] * rr * gg.w;
        if (FINAL) ((float4*)(dst + (size_t)row * DM))[lane + 64 * i] = o;
        else {
          s2 += o.x * o.x + o.y * o.y + o.z * o.z + o.w * o.w;
          half4 hv; hv[0] = (half_t)o.x; hv[1] = (half_t)o.y; hv[2] = (half_t)o.z; hv[3] = (half_t)o.w;
          ((half4*)(dsth + (size_t)row * DM))[lane + 64 * i] = hv;
        }
      }
      if (!FINAL) { s2 = wave_sum(s2); if (lane == 0) rstd_out[row] = rsqrtf(s2 * (1.f / DM) + EPS); }
    }
  }
}

template <int NF>
__device__ void ph_rowproj(const Params& P, const half_t* Wt, float* out, char* smem, int wvs, int first_block) {
  const int tid = otid(wvs), lane = tid & 63, wave = tid >> 6, r15 = lane & 15, q = lane >> 4;
  const int nb = gridDim.x - first_block;
  if ((int)blockIdx.x < first_block) return;
  __syncthreads();
  for (int c = tid; c < 16 * NF * 128; c += NTHREADS) {
    const int row = c >> 7, ch = c & 127;
    *(uint4*)(smem + row * 2064 + ch * 16) = *(const uint4*)(Wt + (size_t)row * DM + ch * 8);
  }
  __syncthreads();
  for (int tile = (int)blockIdx.x - first_block; tile < T_TOK / 128; tile += nb) {
    const int tok = tile * 128 + wave * 16 + r15;
    const half_t* ap = P.xh + (size_t)tok * DM + 8 * q;
    const char* bp = smem + r15 * 2064 + 16 * q;
    f32x4 acc[NF];
#pragma unroll
    for (int n = 0; n < NF; ++n) acc[n] = (f32x4){0.f, 0.f, 0.f, 0.f};
#pragma unroll 1
    for (int s0 = 0; s0 < 32; s0 += 16) {
      half8 a[16];
#pragma unroll
      for (int i = 0; i < 16; ++i) a[i] = *(const half8*)(ap + 32 * (s0 + i));
#pragma unroll
      for (int i = 0; i < 16; ++i) {
#pragma unroll
        for (int n = 0; n < NF; ++n) {
          const half8 bw = *(const half8*)(bp + n * 16 * 2064 + (s0 + i) * 64);
          acc[n] = __builtin_amdgcn_mfma_f32_16x16x32_f16(bw, a[i], acc[n], 0, 0, 0);
        }
      }
    }
    const float rs = P.rstd[tok];
#pragma unroll
    for (int n = 0; n < NF; ++n) *(f32x4*)(out + (size_t)tok * (16 * NF) + 16 * n + 4 * q) = acc[n] * rs;
  }
  __syncthreads();
}

__device__ void ph_kmax(const Params& P, int wvs, int first_block) {
  const int tid = otid(wvs);
  for (int task = (int)blockIdx.x - first_block; task < NBATCH * 4 * 2 * 8; task += gridDim.x - first_block) {
    const int chunk = task & 7, br = (task >> 3) & 1, bg = task >> 4, b = bg >> 2, g = bg & 3;
    const half_t* kp = P.p + (size_t)(b * SEQ + chunk * 512 + tid) * LD1 + (br ? 2048 : 1536) + g * 64;
    float ss = 0.f;
#pragma unroll
    for (int c = 0; c < 8; ++c) {
      const half8 v = *(const half8*)(kp + c * 8);
#pragma unroll
      for (int e = 0; e < 8; ++e) ss += (float)v[e] * (float)v[e];
    }
    ss = wave_max(ss);
    if ((tid & 63) == 0) __hip_atomic_fetch_max(&P.kmax2[bg * 2 + br], __float_as_uint(ss), __ATOMIC_RELAXED, __HIP_MEMORY_SCOPE_AGENT);
  }
}

constexpr int ATT_NB = 6, ATT_D = 5;
constexpr int ATT_K = 0, ATT_V = ATT_NB * 8192, ATT_Z = 2 * ATT_NB * 8192, ATT_IMP = ATT_Z + 32768, ATT_SELM = ATT_IMP + 64 * 68 * 4;
constexpr int IMPS = 68;
constexpr int ATT_GATE = ATT_SELM + 512;

__device__ __forceinline__ void attn_issue(char* smem, const half_t* kbase, const half_t* vbase, int ld, int tile_lo, int tile_hi, int wvs, int rot = 0) {
  const int tid = otid(wvs);
  const int lrow = tid >> 3, lch = tid & 7;
  const int ksrc = (lch ^ ((lrow >> 1) & 7)) * 8, vsrc = (lch ^ (((lrow >> 1) & 3) << 1)) * 8;
  const int wbase = __builtin_amdgcn_readfirstlane(tid >> 6) * 1024;
#pragma unroll
  for (int i = 0; i < ATT_D; ++i) if (tile_lo + i <= tile_hi) {
    const int nt_ = tile_hi - tile_lo + 1, tr_ = tile_lo + ((rot + i >= nt_) ? rot + i - nt_ : rot + i);
    const half_t* kp_ = kbase + (size_t)(tr_ * 64 + lrow) * ld + ksrc;
    const half_t* vp_ = vbase + (size_t)(tr_ * 64 + lrow) * ld + vsrc;
    __builtin_amdgcn_global_load_lds((gbl_void*)kp_, (lds_void*)(smem + ATT_K + i * 8192 + wbase), 16, 0, 0);
    __builtin_amdgcn_global_load_lds((gbl_void*)vp_, (lds_void*)(smem + ATT_V + i * 8192 + wbase), 16, 0, 0);
  }
}

template <int MODE, bool PREISSUED = false>
__device__ __forceinline__ void attn_branch(char* smem, const half_t* kbase, const half_t* vbase, int ld, int tile_lo, int tile_hi, int n, int th,
                                            const half8 (&qf)[2][2], float (&m)[2], float (&l)[2], f32x4 (&o)[4][2],
                                            const unsigned long long (&selm)[2], int wvs) {
  const int tid = otid(wvs);
  const int lane = tid & 63, r15 = lane & 15, q = lane >> 4;
  const int lrow = tid >> 3, lch = tid & 7;
  const int k_rd = r15 * 128, kswz = r15 >> 1;
  const int qp = r15 >> 2, pp = lane & 3;
  const int fx = ((2 * q + (qp >> 1)) & 3) << 1;
  const int v_rd = (4 * q + qp) * 128 + 8 * (pp & 1) + ((pp >> 1) << 4);
  unsigned int* impu = (unsigned int*)(smem + ATT_IMP);
  const int ksrc = (lch ^ ((lrow >> 1) & 7)) * 8, vsrc = (lch ^ (((lrow >> 1) & 3) << 1)) * 8;
  const int wbase = __builtin_amdgcn_readfirstlane(tid >> 6) * 1024;
#define A_GLOAD(TI, BUF) { const half_t* kp_ = kbase + (size_t)((TI) * 64 + lrow) * ld + ksrc; \
    __builtin_amdgcn_global_load_lds((gbl_void*)kp_, (lds_void*)(smem + ATT_K + (BUF) * 8192 + wbase), 16, 0, 0); \
    { const half_t* vp_ = vbase + (size_t)((TI) * 64 + lrow) * ld + vsrc; \
      __builtin_amdgcn_global_load_lds((gbl_void*)vp_, (lds_void*)(smem + ATT_V + (BUF) * 8192 + wbase), 16, 0, 0); } }
  constexpr int GPT = 2;
  f32x4 lacc[2] = {(f32x4){0.f, 0.f, 0.f, 0.f}, (f32x4){0.f, 0.f, 0.f, 0.f}};
  if (MODE != 1 && !PREISSUED) {
#pragma unroll
    for (int i = 0; i < ATT_D; ++i) if (tile_lo + i <= tile_hi) A_GLOAD(tile_lo + i, i)
  }
#pragma unroll 1
  for (int ti = tile_lo; ti <= tile_hi; ++ti) {
    const int it = ti - tile_lo, cur = it % ATT_NB;
    if (MODE != 1) {
      const int rem = tile_hi - ti;
      if (rem >= 4) wait_vmcnt<4 * GPT>(); else if (rem == 3) wait_vmcnt<3 * GPT>(); else if (rem == 2) wait_vmcnt<2 * GPT>();
      else if (rem == 1) wait_vmcnt<1 * GPT>(); else wait_vmcnt<0>();
    }
    __builtin_amdgcn_s_barrier();
    if (MODE != 1) { if (ti + ATT_D <= tile_hi) A_GLOAD(ti + ATT_D, (it + ATT_D) % ATT_NB) }
    const char* kb = smem + ATT_K + cur * 8192 + k_rd;
    const unsigned vbl = (unsigned)(size_t)(smem + ATT_V + cur * 8192 + v_rd);
    bool need_mask;
    if (MODE <= 1) need_mask = (ti * 64 + 63 > 4 * n - 2);
    else if (MODE == 2) need_mask = (ti == n);
    else need_mask = (ti == n) || (ti == n - 8);
    f32x4 s[4][2];
#pragma unroll
    for (int t2 = 0; t2 < 2; ++t2) {
      float c0 = 0.f;
      if (MODE >= 2) { c0 = -m[t2]; if (MODE == 2 && !((selm[t2] >> ti) & 1ull)) c0 = -INFINITY; }
#pragma unroll
      for (int kf = 0; kf < 4; ++kf) s[kf][t2] = (f32x4){c0, c0, c0, c0};
    }
#pragma unroll
    for (int ks = 0; ks < 2; ++ks) {
      const int co = ((4 * ks + q) ^ kswz) << 4;
#pragma unroll
      for (int kf = 0; kf < 4; ++kf) {
        const half8 kfr = *(const half8*)(kb + kf * 2048 + co);
#pragma unroll
        for (int t2 = 0; t2 < 2; ++t2) s[kf][t2] = __builtin_amdgcn_mfma_f32_16x16x32_f16(kfr, qf[t2][ks], s[kf][t2], 0, 0, 0);
      }
    }
    v2i vr[4][4];
    if (MODE != 0) {
      const unsigned va0 = vbl + (((0) ^ fx) << 4), va1 = vbl + (((2) ^ fx) << 4), va2 = vbl + (((4) ^ fx) << 4), va3 = vbl + (((6) ^ fx) << 4);
      asm volatile(
          "ds_read_b64_tr_b16 %0, %16\n\tds_read_b64_tr_b16 %1, %16 offset:2048\n\tds_read_b64_tr_b16 %2, %16 offset:4096\n\tds_read_b64_tr_b16 %3, %16 offset:6144\n\t"
          "ds_read_b64_tr_b16 %4, %17\n\tds_read_b64_tr_b16 %5, %17 offset:2048\n\tds_read_b64_tr_b16 %6, %17 offset:4096\n\tds_read_b64_tr_b16 %7, %17 offset:6144\n\t"
          "ds_read_b64_tr_b16 %8, %18\n\tds_read_b64_tr_b16 %9, %18 offset:2048\n\tds_read_b64_tr_b16 %10, %18 offset:4096\n\tds_read_b64_tr_b16 %11, %18 offset:6144\n\t"
          "ds_read_b64_tr_b16 %12, %19\n\tds_read_b64_tr_b16 %13, %19 offset:2048\n\tds_read_b64_tr_b16 %14, %19 offset:4096\n\tds_read_b64_tr_b16 %15, %19 offset:6144"
          : "=&v"(vr[0][0]), "=&v"(vr[0][1]), "=&v"(vr[0][2]), "=&v"(vr[0][3]), "=&v"(vr[1][0]), "=&v"(vr[1][1]), "=&v"(vr[1][2]), "=&v"(vr[1][3]),
            "=&v"(vr[2][0]), "=&v"(vr[2][1]), "=&v"(vr[2][2]), "=&v"(vr[2][3]), "=&v"(vr[3][0]), "=&v"(vr[3][1]), "=&v"(vr[3][2]), "=&v"(vr[3][3])
          : "v"(va0), "v"(va1), "v"(va2), "v"(va3)
          : "memory");
    }
    if (need_mask) {
#pragma unroll
      for (int t2 = 0; t2 < 2; ++t2) {
        const int tok = th * 32 + t2 * 16 + r15;
        int lo = 0, hi = 63;
        if (MODE <= 1) { hi = 4 * n + ((tok - 31) >> 4) - ti * 64; }
        else if (MODE == 2) { hi = tok; }
        else { if (ti == n) hi = tok; else lo = tok + 1; }
#pragma unroll
        for (int kf = 0; kf < 4; ++kf)
#pragma unroll
          for (int r = 0; r < 4; ++r) {
            const int kk = kf * 16 + 4 * q + r;
            if (kk < lo || kk > hi) s[kf][t2][r] = -INFINITY;
          }
      }
    }
    half8 pf[2][2];
#pragma unroll
    for (int t2 = 0; t2 < 2; ++t2) {
      float mb = 0.f, scale_p = 1.f;
      if (MODE == 1) {
        mb = m[t2]; scale_p = l[t2];
      } else if (MODE == 0) {
        float tm = s[0][t2][0];
#pragma unroll
        for (int kf = 0; kf < 4; ++kf)
#pragma unroll
          for (int r = 0; r < 4; ++r) tm = fmaxf(tm, s[kf][t2][r]);
        tm = rowmax4(tm);
        const float mn = fmaxf(m[t2], tm);
        const float alpha = fexp2(m[t2] - mn);
        m[t2] = mn; mb = mn;
        l[t2] *= alpha;
      }
      float lsum = 0.f;
#pragma unroll
      for (int kf = 0; kf < 4; ++kf) {
#pragma unroll
        for (int r = 0; r < 4; ++r) {
          float pv = (MODE >= 2) ? fexp2(s[kf][t2][r]) : fexp2(s[kf][t2][r] - mb);
          if (MODE == 1) pv *= scale_p;
          s[kf][t2][r] = pv; if (MODE == 0) lsum += pv;
        }
      }
      if (MODE == 0) l[t2] += lsum;
      if (MODE == 1) {
        const int tok = th * 32 + t2 * 16 + r15;
#pragma unroll
        for (int kf = 0; kf < 4; ++kf) {
          const int j = 16 * ti + 4 * kf + q;
          const unsigned int u0 = (unsigned int)(s[kf][t2][0] * 134217728.f + 0.5f), u1 = (unsigned int)(s[kf][t2][1] * 134217728.f + 0.5f);
          const unsigned int u2 = (unsigned int)(s[kf][t2][2] * 134217728.f + 0.5f), u3 = (unsigned int)(s[kf][t2][3] * 134217728.f + 0.5f);
          if (j < 64) {
            atomicAdd(&impu[tok * IMPS + j], u0 + u1 + u2 + u3);
            atomicAdd(&impu[tok * IMPS + j + 1], u3);
          }
        }
      }
      if (MODE != 0) {
#pragma unroll
        for (int ks = 0; ks < 2; ++ks) {
          half8 pk;
#pragma unroll
          for (int r = 0; r < 4; ++r) { pk[r] = (half_t)s[2 * ks][t2][r]; pk[4 + r] = (half_t)s[2 * ks + 1][t2][r]; }
          pf[t2][ks] = pk;
        }
      }
    }
    if (MODE != 0) {
      asm volatile("s_waitcnt lgkmcnt(0)"
                   : "+v"(vr[0][0]), "+v"(vr[0][1]), "+v"(vr[0][2]), "+v"(vr[0][3]), "+v"(vr[1][0]), "+v"(vr[1][1]), "+v"(vr[1][2]), "+v"(vr[1][3]),
                     "+v"(vr[2][0]), "+v"(vr[2][1]), "+v"(vr[2][2]), "+v"(vr[2][3]), "+v"(vr[3][0]), "+v"(vr[3][1]), "+v"(vr[3][2]), "+v"(vr[3][3])
                   :: "memory");
      __builtin_amdgcn_sched_barrier(0);
#pragma unroll
      for (int df = 0; df < 4; ++df) {
#pragma unroll
        for (int ks = 0; ks < 2; ++ks) {
          const v2i lo2 = vr[df][2 * ks], hi2 = vr[df][2 * ks + 1];
          const v4i pk4 = (v4i){lo2[0], lo2[1], hi2[0], hi2[1]};
          const half8 vf = __builtin_bit_cast(half8, pk4);
#pragma unroll
          for (int t2 = 0; t2 < 2; ++t2) o[df][t2] = __builtin_amdgcn_mfma_f32_16x16x32_f16(vf, pf[t2][ks], o[df][t2], 0, 0, 0);
        }
      }
      if (MODE >= 2) {
        const half8 ones = (half8){(half_t)1.f, (half_t)1.f, (half_t)1.f, (half_t)1.f, (half_t)1.f, (half_t)1.f, (half_t)1.f, (half_t)1.f};
#pragma unroll
        for (int ks = 0; ks < 2; ++ks)
#pragma unroll
          for (int t2 = 0; t2 < 2; ++t2) lacc[t2] = __builtin_amdgcn_mfma_f32_16x16x32_f16(ones, pf[t2][ks], lacc[t2], 0, 0, 0);
      }
    }
  }
  if (MODE >= 2) { l[0] = lacc[0][0]; l[1] = lacc[1][0]; }
  __syncthreads();
#undef A_GLOAD
}

__device__ __forceinline__ void attn_cmp(char* smem, int tile_hi, int n, int th, const half8 (&qf)[2][2], const float (&moff)[2], f32x4 (&o)[4][2], int wvs) {
  const int tid = otid(wvs);
  const int lane = tid & 63, r15 = lane & 15, q = lane >> 4;
  const int k_rd = r15 * 128, kswz = r15 >> 1;
  const int qp = r15 >> 2, pp = lane & 3;
  const int fx = ((2 * q + (qp >> 1)) & 3) << 1;
  const int v_rd = (4 * q + qp) * 128 + 8 * (pp & 1) + ((pp >> 1) << 4);
  unsigned int* impu = (unsigned int*)(smem + ATT_IMP);
  float lsum[2] = {0.f, 0.f};
  float usum[4][4][2], carry[2] = {0.f, 0.f};
#pragma unroll
  for (int ti = 0; ti < 4; ++ti) {
    if (ti <= tile_hi) {
      const int rem = tile_hi - ti;
      if (rem >= 3) wait_vmcnt<6>(); else if (rem == 2) wait_vmcnt<4>(); else if (rem == 1) wait_vmcnt<2>(); else wait_vmcnt<0>();
      __builtin_amdgcn_s_barrier();
      const char* kb = smem + ATT_K + ti * 8192 + k_rd;
      const unsigned vbl = (unsigned)(size_t)(smem + ATT_V + ti * 8192 + v_rd);
      f32x4 s[4][2];
#pragma unroll
      for (int t2 = 0; t2 < 2; ++t2) {
        const float c0 = -moff[t2];
#pragma unroll
        for (int kf = 0; kf < 4; ++kf) s[kf][t2] = (f32x4){c0, c0, c0, c0};
      }
#pragma unroll
      for (int ks = 0; ks < 2; ++ks) {
        const int co = ((4 * ks + q) ^ kswz) << 4;
#pragma unroll
        for (int kf = 0; kf < 4; ++kf) {
          const half8 kfr = *(const half8*)(kb + kf * 2048 + co);
#pragma unroll
          for (int t2 = 0; t2 < 2; ++t2) s[kf][t2] = __builtin_amdgcn_mfma_f32_16x16x32_f16(kfr, qf[t2][ks], s[kf][t2], 0, 0, 0);
        }
      }
      if (ti * 64 + 63 > 4 * n - 2) {
#pragma unroll
        for (int t2 = 0; t2 < 2; ++t2) {
          const int tok = th * 32 + t2 * 16 + r15;
          const int hi = 4 * n + ((tok - 31) >> 4) - ti * 64;
#pragma unroll
          for (int kf = 0; kf < 4; ++kf)
#pragma unroll
            for (int r = 0; r < 4; ++r) if (kf * 16 + 4 * q + r > hi) s[kf][t2][r] = -INFINITY;
        }
      }
      half8 pf[2][2];
#pragma unroll
      for (int t2 = 0; t2 < 2; ++t2) {
        float sh[4];
#pragma unroll
        for (int kf = 0; kf < 4; ++kf) {
#pragma unroll
          for (int r = 0; r < 4; ++r) s[kf][t2][r] = fexp2(s[kf][t2][r]);
          sh[kf] = __shfl(s[kf][t2][3], (lane + 48) & 63);
        }
#pragma unroll
        for (int kf = 0; kf < 4; ++kf) {
          const float u = (s[kf][t2][0] + s[kf][t2][1]) + (s[kf][t2][2] + s[kf][t2][3]);
          const float prev = q > 0 ? sh[kf] : (kf > 0 ? sh[kf - 1] : carry[t2]);
          usum[ti][kf][t2] = u + prev;
          lsum[t2] += u;
        }
        carry[t2] = sh[3];
#pragma unroll
        for (int ks = 0; ks < 2; ++ks) {
          half8 pk;
#pragma unroll
          for (int r = 0; r < 4; ++r) { pk[r] = (half_t)s[2 * ks][t2][r]; pk[4 + r] = (half_t)s[2 * ks + 1][t2][r]; }
          pf[t2][ks] = pk;
        }
      }
      v2i vr[4][4];
      {
        const unsigned va0 = vbl + (((0) ^ fx) << 4), va1 = vbl + (((2) ^ fx) << 4), va2 = vbl + (((4) ^ fx) << 4), va3 = vbl + (((6) ^ fx) << 4);
        asm volatile(
            "ds_read_b64_tr_b16 %0, %16\n\tds_read_b64_tr_b16 %1, %16 offset:2048\n\tds_read_b64_tr_b16 %2, %16 offset:4096\n\tds_read_b64_tr_b16 %3, %16 offset:6144\n\t"
            "ds_read_b64_tr_b16 %4, %17\n\tds_read_b64_tr_b16 %5, %17 offset:2048\n\tds_read_b64_tr_b16 %6, %17 offset:4096\n\tds_read_b64_tr_b16 %7, %17 offset:6144\n\t"
            "ds_read_b64_tr_b16 %8, %18\n\tds_read_b64_tr_b16 %9, %18 offset:2048\n\tds_read_b64_tr_b16 %10, %18 offset:4096\n\tds_read_b64_tr_b16 %11, %18 offset:6144\n\t"
            "ds_read_b64_tr_b16 %12, %19\n\tds_read_b64_tr_b16 %13, %19 offset:2048\n\tds_read_b64_tr_b16 %14, %19 offset:4096\n\tds_read_b64_tr_b16 %15, %19 offset:6144"
            : "=&v"(vr[0][0]), "=&v"(vr[0][1]), "=&v"(vr[0][2]), "=&v"(vr[0][3]), "=&v"(vr[1][0]), "=&v"(vr[1][1]), "=&v"(vr[1][2]), "=&v"(vr[1][3]),
              "=&v"(vr[2][0]), "=&v"(vr[2][1]), "=&v"(vr[2][2]), "=&v"(vr[2][3]), "=&v"(vr[3][0]), "=&v"(vr[3][1]), "=&v"(vr[3][2]), "=&v"(vr[3][3])
            : "v"(va0), "v"(va1), "v"(va2), "v"(va3)
            : "memory");
      }
      asm volatile("s_waitcnt lgkmcnt(0)"
                   : "+v"(vr[0][0]), "+v"(vr[0][1]), "+v"(vr[0][2]), "+v"(vr[0][3]), "+v"(vr[1][0]), "+v"(vr[1][1]), "+v"(vr[1][2]), "+v"(vr[1][3]),
                     "+v"(vr[2][0]), "+v"(vr[2][1]), "+v"(vr[2][2]), "+v"(vr[2][3]), "+v"(vr[3][0]), "+v"(vr[3][1]), "+v"(vr[3][2]), "+v"(vr[3][3])
                   :: "memory");
      __builtin_amdgcn_sched_barrier(0);
#pragma unroll
      for (int df = 0; df < 4; ++df)
#pragma unroll
        for (int ks = 0; ks < 2; ++ks) {
          const v2i lo2 = vr[df][2 * ks], hi2 = vr[df][2 * ks + 1];
          const v4i pk4 = (v4i){lo2[0], lo2[1], hi2[0], hi2[1]};
          const half8 vf = __builtin_bit_cast(half8, pk4);
#pragma unroll
          for (int t2 = 0; t2 < 2; ++t2) o[df][t2] = __builtin_amdgcn_mfma_f32_16x16x32_f16(vf, pf[t2][ks], o[df][t2], 0, 0, 0);
        }
    }
  }
#pragma unroll
  for (int t2 = 0; t2 < 2; ++t2) {
    const float lt = rowsum4(lsum[t2]);
    const float inv = lt > 0.f ? 1.f / lt : 0.f;
#pragma unroll
    for (int df = 0; df < 4; ++df) o[df][t2] *= inv;
    const int tok = th * 32 + t2 * 16 + r15;
    const float isc = inv * 134217728.f;
#pragma unroll
    for (int ti = 0; ti < 4; ++ti) {
      if (ti <= tile_hi) {
#pragma unroll
        for (int kf = 0; kf < 4; ++kf) {
          const int j = 16 * ti + 4 * kf + q;
          if (j < 64) atomicAdd(&impu[tok * IMPS + j], (unsigned int)(usum[ti][kf][t2] * isc + 0.5f));
        }
      }
    }
  }
  __syncthreads();
}

template <int MODE, bool PREISSUED>
__device__ __forceinline__ void attn_branch_pp(char* smem, const half_t* kbase, const half_t* vbase, int ld, int tile_lo, int tile_hi, int n, int th,
                                               const half8 (&qf)[2][2], const float (&m)[2], float (&l)[2], f32x4 (&o)[4][2],
                                               const unsigned long long (&selm)[2], int wvs, int rot) {
  const int tid = otid(wvs);
  const int lane = tid & 63, r15 = lane & 15, q = lane >> 4;
  const int lrow = tid >> 3, lch = tid & 7;
  const int k_rd = r15 * 128, kswz = r15 >> 1;
  const int qp = r15 >> 2, pp = lane & 3;
  const int fx = ((2 * q + (qp >> 1)) & 3) << 1;
  const int v_rd = (4 * q + qp) * 128 + 8 * (pp & 1) + ((pp >> 1) << 4);
  const int ksrc = (lch ^ ((lrow >> 1) & 7)) * 8, vsrc = (lch ^ (((lrow >> 1) & 3) << 1)) * 8;
  const int wbase = __builtin_amdgcn_readfirstlane(tid >> 6) * 1024;
#define A_GLOAD(TI, BUF) { const half_t* kp_ = kbase + (size_t)((TI) * 64 + lrow) * ld + ksrc; \
    __builtin_amdgcn_global_load_lds((gbl_void*)kp_, (lds_void*)(smem + ATT_K + (BUF) * 8192 + wbase), 16, 0, 0); \
    { const half_t* vp_ = vbase + (size_t)((TI) * 64 + lrow) * ld + vsrc; \
      __builtin_amdgcn_global_load_lds((gbl_void*)vp_, (lds_void*)(smem + ATT_V + (BUF) * 8192 + wbase), 16, 0, 0); } }
#define PP_BAR { __builtin_amdgcn_sched_barrier(0); __builtin_amdgcn_s_barrier(); __builtin_amdgcn_sched_barrier(0); }
  const int nt = tile_hi - tile_lo + 1;
  f32x4 lacc[2] = {(f32x4){0.f, 0.f, 0.f, 0.f}, (f32x4){0.f, 0.f, 0.f, 0.f}};
  if (!PREISSUED) {
#pragma unroll
    for (int i = 0; i < ATT_D; ++i) if (i < nt) A_GLOAD(tile_lo + ((rot + i >= nt) ? rot + i - nt : rot + i), i)
  }
  { const int r = nt - 1;
    if (r >= 4) wait_vmcnt<8>(); else if (r == 3) wait_vmcnt<6>(); else if (r == 2) wait_vmcnt<4>(); else if (r == 1) wait_vmcnt<2>(); else wait_vmcnt<0>(); }
  half8 pf[2][2];
  v2i vr[4][4];
#pragma unroll
  for (int a = 0; a < 2; ++a)
#pragma unroll
    for (int b = 0; b < 2; ++b) pf[a][b] = (half8){(half_t)0.f, (half_t)0.f, (half_t)0.f, (half_t)0.f, (half_t)0.f, (half_t)0.f, (half_t)0.f, (half_t)0.f};
#pragma unroll
  for (int a = 0; a < 4; ++a)
#pragma unroll
    for (int b = 0; b < 4; ++b) vr[a][b] = (v2i){0, 0};
  const half8 ones = (half8){(half_t)1.f, (half_t)1.f, (half_t)1.f, (half_t)1.f, (half_t)1.f, (half_t)1.f, (half_t)1.f, (half_t)1.f};
#define PP_PV { _Pragma("unroll") for (int df = 0; df < 4; ++df) _Pragma("unroll") for (int ks = 0; ks < 2; ++ks) { \
      const v2i lo2 = vr[df][2 * ks], hi2 = vr[df][2 * ks + 1]; const v4i pk4 = (v4i){lo2[0], lo2[1], hi2[0], hi2[1]}; const half8 vf = __builtin_bit_cast(half8, pk4); \
      _Pragma("unroll") for (int t2 = 0; t2 < 2; ++t2) o[df][t2] = __builtin_amdgcn_mfma_f32_16x16x32_f16(vf, pf[t2][ks], o[df][t2], 0, 0, 0); } \
    _Pragma("unroll") for (int ks = 0; ks < 2; ++ks) _Pragma("unroll") for (int t2 = 0; t2 < 2; ++t2) lacc[t2] = __builtin_amdgcn_mfma_f32_16x16x32_f16(ones, pf[t2][ks], lacc[t2], 0, 0, 0); }
  __builtin_amdgcn_sched_barrier(0);
  if (th == 1) __builtin_amdgcn_s_barrier();
  __builtin_amdgcn_sched_barrier(0);
  int trel = rot, tpf = rot + ATT_D; while (tpf >= nt) tpf -= nt;
#pragma unroll 1
  for (int it = 0; it < nt; ++it) {
    const int ti = tile_lo + trel, cur = it % ATT_NB;
    trel = (trel + 1 == nt) ? 0 : trel + 1;
    PP_BAR
    f32x4 s[4][2];
    const char* kb = smem + ATT_K + cur * 8192 + k_rd;
    __builtin_amdgcn_s_setprio(1);
    PP_PV
#pragma unroll
    for (int t2 = 0; t2 < 2; ++t2) {
      float c0 = -m[t2];
      if (MODE == 2 && !((selm[t2] >> ti) & 1ull)) c0 = -INFINITY;
#pragma unroll
      for (int kf = 0; kf < 4; ++kf) s[kf][t2] = (f32x4){c0, c0, c0, c0};
    }
#pragma unroll
    for (int ks = 0; ks < 2; ++ks) {
      const int co = ((4 * ks + q) ^ kswz) << 4;
#pragma unroll
      for (int kf = 0; kf < 4; ++kf) {
        const half8 kfr = *(const half8*)(kb + kf * 2048 + co);
#pragma unroll
        for (int t2 = 0; t2 < 2; ++t2) s[kf][t2] = __builtin_amdgcn_mfma_f32_16x16x32_f16(kfr, qf[t2][ks], s[kf][t2], 0, 0, 0);
      }
    }
    __builtin_amdgcn_s_setprio(0);
    { const int r = nt - 2 - it;
      if (r >= 3) wait_vmcnt<6>(); else if (r == 2) wait_vmcnt<4>(); else if (r == 1) wait_vmcnt<2>(); else wait_vmcnt<0>(); }
    PP_BAR
    if (it + ATT_D < nt) A_GLOAD(tile_lo + tpf, (it + ATT_D) % ATT_NB)
    tpf = (tpf + 1 == nt) ? 0 : tpf + 1;
    {
      const unsigned vbl = (unsigned)(size_t)(smem + ATT_V + cur * 8192 + v_rd);
      const unsigned va0 = vbl + (((0) ^ fx) << 4), va1 = vbl + (((2) ^ fx) << 4), va2 = vbl + (((4) ^ fx) << 4), va3 = vbl + (((6) ^ fx) << 4);
      asm volatile(
          "ds_read_b64_tr_b16 %0, %16\n\tds_read_b64_tr_b16 %1, %16 offset:2048\n\tds_read_b64_tr_b16 %2, %16 offset:4096\n\tds_read_b64_tr_b16 %3, %16 offset:6144\n\t"
          "ds_read_b64_tr_b16 %4, %17\n\tds_read_b64_tr_b16 %5, %17 offset:2048\n\tds_read_b64_tr_b16 %6, %17 offset:4096\n\tds_read_b64_tr_b16 %7, %17 offset:6144\n\t"
          "ds_read_b64_tr_b16 %8, %18\n\tds_read_b64_tr_b16 %9, %18 offset:2048\n\tds_read_b64_tr_b16 %10, %18 offset:4096\n\tds_read_b64_tr_b16 %11, %18 offset:6144\n\t"
          "ds_read_b64_tr_b16 %12, %19\n\tds_read_b64_tr_b16 %13, %19 offset:2048\n\tds_read_b64_tr_b16 %14, %19 offset:4096\n\tds_read_b64_tr_b16 %15, %19 offset:6144"
          : "=&v"(vr[0][0]), "=&v"(vr[0][1]), "=&v"(vr[0][2]), "=&v"(vr[0][3]), "=&v"(vr[1][0]), "=&v"(vr[1][1]), "=&v"(vr[1][2]), "=&v"(vr[1][3]),
            "=&v"(vr[2][0]), "=&v"(vr[2][1]), "=&v"(vr[2][2]), "=&v"(vr[2][3]), "=&v"(vr[3][0]), "=&v"(vr[3][1]), "=&v"(vr[3][2]), "=&v"(vr[3][3])
          : "v"(va0), "v"(va1), "v"(va2), "v"(va3)
          : "memory");
    }
    bool need_mask;
    if (MODE == 2) need_mask = (ti == n); else need_mask = (ti == n) || (ti == n - 8);
    if (need_mask) {
#pragma unroll
      for (int t2 = 0; t2 < 2; ++t2) {
        const int tok = th * 32 + t2 * 16 + r15;
        int lo = 0, hi = 63;
        if (MODE == 2) { hi = tok; }
        else { if (ti == n) hi = tok; else lo = tok + 1; }
#pragma unroll
        for (int kf = 0; kf < 4; ++kf)
#pragma unroll
          for (int r = 0; r < 4; ++r) {
            const int kk = kf * 16 + 4 * q + r;
            if (kk < lo || kk > hi) s[kf][t2][r] = -INFINITY;
          }
      }
    }
#pragma unroll
    for (int t2 = 0; t2 < 2; ++t2) {
#pragma unroll
      for (int kf = 0; kf < 4; ++kf)
#pragma unroll
        for (int r = 0; r < 4; ++r) s[kf][t2][r] = fexp2(s[kf][t2][r]);
#pragma unroll
      for (int ks = 0; ks < 2; ++ks) {
        half8 pk;
#pragma unroll
        for (int r = 0; r < 4; ++r) { pk[r] = (half_t)s[2 * ks][t2][r]; pk[4 + r] = (half_t)s[2 * ks + 1][t2][r]; }
        pf[t2][ks] = pk;
      }
    }
    asm volatile("s_waitcnt lgkmcnt(0)"
                 : "+v"(vr[0][0]), "+v"(vr[0][1]), "+v"(vr[0][2]), "+v"(vr[0][3]), "+v"(vr[1][0]), "+v"(vr[1][1]), "+v"(vr[1][2]), "+v"(vr[1][3]),
                   "+v"(vr[2][0]), "+v"(vr[2][1]), "+v"(vr[2][2]), "+v"(vr[2][3]), "+v"(vr[3][0]), "+v"(vr[3][1]), "+v"(vr[3][2]), "+v"(vr[3][3])
                 :: "memory");
  }
  PP_BAR
  PP_PV
  __builtin_amdgcn_sched_barrier(0);
  if (th == 0) __builtin_amdgcn_s_barrier();
  __builtin_amdgcn_sched_barrier(0);
  l[0] = lacc[0][0]; l[1] = lacc[1][0];
  __syncthreads();
#undef A_GLOAD
#undef PP_BAR
#undef PP_PV
}

__device__ void ph_attn_mfma(const Params& P, char* smem, int wvs) {
  unsigned int* impu = (unsigned int*)(smem + ATT_IMP);
  unsigned long long* selmask = (unsigned long long*)(smem + ATT_SELM);
  const int G = gridDim.x, nrounds = (2048 + G - 1) / G;
  for (int rd = 0; rd < nrounds; ++rd) {
    const int idx = rd * G + ((rd & 1) ? (G - 1 - (int)blockIdx.x) : (int)blockIdx.x);
    if (idx >= 2048) continue;
    const int tid = otid(wvs), lane = tid & 63, r15 = lane & 15, q = lane >> 4;
    const int n = 63 - (idx >> 5), bg = idx & 31, b = bg >> 2, g = bg & 3;
    const int wv = __builtin_amdgcn_readfirstlane(otid(wvs) >> 6);
    const int hd = g * 4 + (wv & 3), th = wv >> 2;
    const int t0 = b * SEQ + n * 64 + th * 32;
    const half_t* kc = P.kcmp + (size_t)bg * 256 * 64;
    const half_t* vc = P.vcmp + (size_t)bg * 256 * 64;
    const int nct = (4 * n + 2) / 64;
    attn_issue(smem, kc, vc, 64, 0, nct, wvs);
    half8 qf[2][2];
#pragma unroll
    for (int t2 = 0; t2 < 2; ++t2)
#pragma unroll
      for (int ks = 0; ks < 2; ++ks) qf[t2][ks] = *(const half8*)(P.p + (size_t)(t0 + t2 * 16 + r15) * LD1 + hd * 64 + 32 * ks + 8 * q);
    float* gate_l = (float*)(smem + ATT_GATE) + wv * 128;
    if (q == 0) {
#pragma unroll
      for (int t2 = 0; t2 < 2; ++t2) {
        const float* pr = P.gl + (size_t)(t0 + t2 * 16 + r15) * 48 + hd * 3;
        f32x4 gv;
#pragma unroll
        for (int c = 0; c < 3; ++c) gv[c] = sigmoidf(pr[c] + P.nsa_b_gate[hd * 3 + c]);
        gv[3] = 0.f;
        *(f32x4*)(gate_l + (t2 * 16 + r15) * 4) = gv;
      }
    }
    { const int tz = otid(wvs); for (int i = tz; i < 64 * IMPS + 128; i += NTHREADS) impu[i] = 0u; }
    float m[2], l[2]; f32x4 o[4][2]; unsigned long long selm[2] = {0ull, 0ull};
#pragma unroll
    for (int t2 = 0; t2 < 2; ++t2) { m[t2] = -1e30f; l[t2] = 0.f; }
#pragma unroll
    for (int df = 0; df < 4; ++df)
#pragma unroll
      for (int t2 = 0; t2 < 2; ++t2) o[df][t2] = (f32x4){0.f, 0.f, 0.f, 0.f};
    float qn2[2];
#pragma unroll
    for (int t2 = 0; t2 < 2; ++t2) {
      float a = 0.f;
#pragma unroll
      for (int ks = 0; ks < 2; ++ks)
#pragma unroll
        for (int e = 0; e < 8; ++e) a += (float)qf[t2][ks][e] * (float)qf[t2][ks][e];
      qn2[t2] = rowsum4(a);
    }
    { const float kmc = __uint_as_float(P.kmax2[64 + bg]);
#pragma unroll
      for (int t2 = 0; t2 < 2; ++t2) m[t2] = sqrtf(qn2[t2] * kmc) * 1.001f - 5.0f * LOG2E; }
    attn_cmp(smem, nct, n, th, qf, m, o, wvs);
    f32x4 oacc[4][2];
#pragma unroll
    for (int t2 = 0; t2 < 2; ++t2) {
      const float gc = gate_l[(t2 * 16 + r15) * 4 + 0];
#pragma unroll
      for (int df = 0; df < 4; ++df) oacc[df][t2] = o[df][t2] * gc;
    }
    {
      const int tz = otid(wvs), lz = tz & 63;
#pragma unroll
      for (int i = 0; i < 4; ++i) {
        const int slab = i * 8 + wv, tokz = slab * 2 + (lz >> 5), cz = (lz & 31) ^ (tokz & 15);
        const half_t* zp = P.p + (size_t)(b * SEQ + n * 64 + tokz) * LD1 + 2560 + g * 256 + cz * 8;
        __builtin_amdgcn_global_load_lds((gbl_void*)zp, (lds_void*)(smem + ATT_Z + slab * 1024), 16, 0, 0);
      }
    }
    const int shr = ((int)blockIdx.x >> 5) & 7;
    const int rot_s = (shr * (n + 1)) >> 3;
    attn_issue(smem, P.p + (size_t)b * SEQ * LD1 + 1536 + g * 64, P.p + (size_t)b * SEQ * LD1 + 1792 + g * 64, LD1, 0, n, wvs, rot_s);
    {
      const int tid2 = otid(wvs);
      const int tok = tid2 >> 3, part = tid2 & 7;
      unsigned long long msk;
      if (n + 1 <= 16) {
        msk = (1ull << (n + 1)) - 1ull;
      } else {
        const uint4* rowp = (const uint4*)(impu + tok * IMPS);
        unsigned own[8];
        { const uint4 a = rowp[part * 2], b2 = rowp[part * 2 + 1];
          own[0] = a.x; own[1] = a.y; own[2] = a.z; own[3] = a.w; own[4] = b2.x; own[5] = b2.y; own[6] = b2.z; own[7] = b2.w; }
        int rank[8];
#pragma unroll
        for (int jj = 0; jj < 8; ++jj) {
          const int j = part * 8 + jj;
          own[jj] = (j >= 1 && j <= n - 2) ? ((own[jj] & ~63u) | (unsigned)(63 - j)) : 0xffffffffu;
          rank[jj] = 0;
        }
#pragma unroll 2
        for (int c4 = 0; c4 < ((n - 2) >> 2) + 1; ++c4) {
          const uint4 v = rowp[c4];
          unsigned kv[4] = {v.x, v.y, v.z, v.w};
#pragma unroll
          for (int e = 0; e < 4; ++e) {
            const int j2 = c4 * 4 + e;
            const unsigned key2 = (j2 >= 1 && j2 <= n - 2) ? ((kv[e] & ~63u) | (unsigned)(63 - j2)) : 0u;
#pragma unroll
            for (int jj = 0; jj < 8; ++jj) rank[jj] += (key2 > own[jj]) ? 1 : 0;
          }
        }
        unsigned int bits = 0;
#pragma unroll
        for (int jj = 0; jj < 8; ++jj) if (rank[jj] < 13 && own[jj] != 0xffffffffu) bits |= 1u << jj;
        unsigned* sel32 = (unsigned*)selmask;
        if (bits) atomicOr(&sel32[tok * 2 + (part >> 2)], bits << (8 * (part & 3)));
        msk = 1ull | (1ull << n) | (1ull << (n - 1));
        if (part == 0) { atomicOr(&sel32[tok * 2], (unsigned)msk); atomicOr(&sel32[tok * 2 + 1], (unsigned)(msk >> 32)); }
      }
      if (n + 1 <= 16 && part == 0) selmask[tok] = msk;
    }
    __syncthreads();
#pragma unroll
    for (int t2 = 0; t2 < 2; ++t2) selm[t2] = selmask[th * 32 + t2 * 16 + r15];
    { const float km = __uint_as_float(P.kmax2[bg * 2 + 0]);
#pragma unroll
      for (int t2 = 0; t2 < 2; ++t2) { m[t2] = sqrtf(qn2[t2] * km) * 1.001f - 5.0f * LOG2E; l[t2] = 0.f; } }
#pragma unroll
    for (int df = 0; df < 4; ++df)
#pragma unroll
      for (int t2 = 0; t2 < 2; ++t2) o[df][t2] = (f32x4){0.f, 0.f, 0.f, 0.f};
    attn_branch_pp<2, true>(smem, P.p + (size_t)b * SEQ * LD1 + 1536 + g * 64, P.p + (size_t)b * SEQ * LD1 + 1792 + g * 64, LD1, 0, n, n, th, qf, m, l, o, selm, wvs, rot_s);
#pragma unroll
    for (int t2 = 0; t2 < 2; ++t2) {
      const float gs = gate_l[(t2 * 16 + r15) * 4 + 1] / l[t2];
#pragma unroll
      for (int df = 0; df < 4; ++df) oacc[df][t2] += o[df][t2] * gs;
    }
    { const float km = __uint_as_float(P.kmax2[bg * 2 + 1]);
#pragma unroll
      for (int t2 = 0; t2 < 2; ++t2) { m[t2] = sqrtf(qn2[t2] * km) * 1.001f - 5.0f * LOG2E; l[t2] = 0.f; } }
#pragma unroll
    for (int df = 0; df < 4; ++df)
#pragma unroll
      for (int t2 = 0; t2 < 2; ++t2) o[df][t2] = (f32x4){0.f, 0.f, 0.f, 0.f};
    attn_branch_pp<3, false>(smem, P.p + (size_t)b * SEQ * LD1 + 2048 + g * 64, P.p + (size_t)b * SEQ * LD1 + 2304 + g * 64, LD1, (n > 8 ? n - 8 : 0), n, n, th, qf, m, l, o, selm, wvs, ((7 - shr) * (n > 8 ? 9 : n + 1)) >> 3);
    {
      int tbase = t0 + r15; asm volatile("" : "+v"(tbase));
#pragma unroll
      for (int t2 = 0; t2 < 2; ++t2) {
        const size_t tok = (size_t)(tbase + t2 * 16);
        const float gw = gate_l[(t2 * 16 + r15) * 4 + 2] / l[t2];
#pragma unroll
        for (int df = 0; df < 4; ++df) {
          const f32x4 v = oacc[df][t2] + o[df][t2] * gw;
          const int tokl = th * 32 + t2 * 16 + r15, cz = (wv & 3) * 8 + df * 2 + (q >> 1);
          const half4 z = *(const half4*)(smem + ATT_Z + tokl * 512 + ((cz ^ (tokl & 15)) << 4) + (q & 1) * 8);
          half4 hv;
#pragma unroll
          for (int e = 0; e < 4; ++e) hv[e] = (half_t)(v[e] * siluf((float)z[e]));
          *(half4*)(P.og + tok * DM + hd * 64 + df * 16 + 4 * q) = hv;
        }
      }
    }
  }
}

constexpr int NPHASES = 13;
__device__ __forceinline__ void run_phase(int ph, const Params& P, char* smem, int wvs) {
  float* sm = (float*)smem;
  switch (ph) {
    case 0:
      if (blockIdx.x == 0 && otid(wvs) < 192) P.kmax2[otid(wvs)] = 0u;
      ph_xh_rstd(P.x, P.xh, P.rstd, wvs); ph_ropetab(P, wvs); prep_cbias_part(P, wvs);
      prep_weights(P, sm, wvs);
      prep_wT(P.nsa_w_in, NSA_IN, P.pre_norm + DM, P.WglT, 64, DM, 5, sm, wvs);
      prep_wT(P.gla_w_in, GLA_IN, P.pre_norm, P.WglrT, 64, DM, 6, sm, wvs);
      break;
    case 1:
      g8::gemm(g8::SrcPlain8{P.xh, DM, P.W0t, DM}, T_TOK, LD0, DM, g8::EpiStore8{P.p, LD0, P.rstd}, smem, wvs);
      ph_rowproj<1>(P, P.WglrT, P.glr, smem, wvs, 0);
      break;
    case 2: prep_cbias_reduce(P, wvs); ph_gla_prep(P, sm, wvs); break;
    case 13: ph_gla_mfma<true>(P, smem, wvs); break;
    case 3: ph_gla_mfma<false>(P, smem, wvs); break;
    case 4: ph_gla_post(P, wvs); break;
    case 5: g8::gemm(g8::SrcPlain8{P.og, DM, P.Wo0t, DM}, T_TOK, DM, DM, g8::EpiStore8{P.y, DM, nullptr}, smem, wvs); break;
    case 6: ph_post<false>(P.xh, P.y, P.post_norm, nullptr, P.xh, P.rstd, wvs); break;
    case 7: g8::gemm(g8::SrcPlain8{P.xh, DM, P.W1t, DM}, T_TOK, LD1, DM, g8::EpiRope8{P.p, LD1, P.rstd, P.ropetab}, smem, wvs); break;
    case 8: {
      if (blockIdx.x >= 128) { ph_kmax(P, wvs, 128); ph_rowproj<3>(P, P.WglT, P.gl, smem, wvs, 128); }
      g8::gemm(g8::SrcCmp1h8{P.p, P.cw1t}, 16384, 512, 1024, g8::EpiCmpPart8{P.part, P.kmax2 + 128}, smem, wvs);
      if (blockIdx.x < 64) {
        const int tid = otid(wvs);
        const int pm2 = ((int)blockIdx.x & 7) * 8 + ((int)blockIdx.x >> 3);
        if (tid == 0) {
          while (__hip_atomic_load(P.kmax2 + 128 + pm2, __ATOMIC_RELAXED, __HIP_MEMORY_SCOPE_AGENT) < 2u) { }
          __builtin_amdgcn_fence(__ATOMIC_ACQUIRE, "agent");
        }
        __syncthreads();
        const int cg = tid & 31, rr = tid >> 5;
        const float* bp = P.cbias + (pm2 >> 5) * 256 + cg * 8;
        const f32x4 b0 = *(const f32x4*)bp, b1 = *(const f32x4*)(bp + 4);
        const half_t* pa = P.part + (size_t)pm2 * 256 * 256 + cg * 8;
        const half_t* pb = P.part + (size_t)16384 * 256 + (size_t)pm2 * 256 * 256 + cg * 8;
        half_t* hp = P.hid + (size_t)pm2 * 256 * 256 + cg * 8;
#pragma unroll 1
        for (int r0 = 0; r0 < 256; r0 += 64) {
          half8 av[4], bv[4];
#pragma unroll
          for (int i = 0; i < 4; ++i) {
            const int c = r0 + i * 16 + rr, c1 = c < 255 ? c + 1 : 255;
            av[i] = *(const half8*)(pa + (size_t)c * 256); bv[i] = *(const half8*)(pb + (size_t)c1 * 256);
          }
#pragma unroll
          for (int i = 0; i < 4; ++i) {
            const int c = r0 + i * 16 + rr;
            half8 hv;
#pragma unroll
            for (int e = 0; e < 8; ++e) hv[e] = (half_t)siluf((float)av[i][e] + (float)bv[i][e] + (e < 4 ? b0[e] : b1[e - 4]));
            *(half8*)(hp + (size_t)c * 256) = hv;
          }
        }
      }
      asm volatile("s_waitcnt vmcnt(0)" ::: "memory");
      __syncthreads();
      g8::gemm(g8::SrcCmp2_8{P.hid, P.cw2t}, 16384, 256, 256, g8::EpiCmpOut8{P.kcmp, P.vcmp, P.kmax2 + 64}, smem, wvs);
      break;
    }
    case 10: ph_attn_mfma(P, smem, wvs); break;
    case 11: g8::gemm(g8::SrcPlain8{P.og, DM, P.Wo1t, DM}, T_TOK, DM, DM, g8::EpiStore8{P.y, DM, nullptr}, smem, wvs); break;
    case 12: ph_post<true>(P.x1h, P.y, P.post_norm + DM, P.out, nullptr, nullptr, wvs); break;
  }
}

template <int PH>
__global__ void __launch_bounds__(NTHREADS, 2) k_phase(Params P) {
  __shared__ __attribute__((aligned(16))) char smem[SMEM_BYTES];
  run_phase(PH, P, smem, __builtin_amdgcn_readfirstlane(threadIdx.x >> 6));
}
template <int PH>
static void launch_phases(const Params& P, hipStream_t stream) {
  hipLaunchKernelGGL((k_phase<PH>), dim3(256), dim3(NTHREADS), 0, stream, P);
  if constexpr (PH + 1 < NPHASES) launch_phases<PH + 1>(P, stream);
}

#if MEGA
__global__ void __launch_bounds__(NTHREADS, 2) k_mega(Params P) {
  __shared__ __attribute__((aligned(16))) char smem[SMEM_BYTES];
  cg::grid_group grid = cg::this_grid();
  if (P.use_cg_sync) grid.sync();
  unsigned bt = 0;
  const int wvs = __builtin_amdgcn_readfirstlane(threadIdx.x >> 6);
  run_phase(0, P, smem, wvs); fast_barrier(P.bar, bt, wvs);
  run_phase(1, P, smem, wvs); fast_barrier(P.bar, bt, wvs);
  run_phase(2, P, smem, wvs); fast_barrier(P.bar, bt, wvs);
  run_phase(13, P, smem, wvs); fast_barrier(P.bar, bt, wvs);
  run_phase(3, P, smem, wvs); fast_barrier(P.bar, bt, wvs);
  run_phase(4, P, smem, wvs); fast_barrier(P.bar, bt, wvs);
  run_phase(5, P, smem, wvs); fast_barrier(P.bar, bt, wvs);
  run_phase(6, P, smem, wvs); fast_barrier(P.bar, bt, wvs);
  run_phase(7, P, smem, wvs); fast_barrier(P.bar, bt, wvs);
  run_phase(8, P, smem, wvs); fast_barrier(P.bar, bt, wvs);
  run_phase(10, P, smem, wvs); fast_barrier(P.bar, bt, wvs);
  run_phase(11, P, smem, wvs); fast_barrier(P.bar, bt, wvs);
  run_phase(12, P, smem, wvs);
}
#endif

extern "C" void kernel_launch(void* const* d_in, const int* in_sizes, int n_in, void* d_out, int out_size, void* d_ws, size_t ws_size,
                              hipStream_t stream) {
  Params P{};
  P.x = (const float*)d_in[0]; P.pos = (const int*)d_in[1]; P.pre_norm = (const float*)d_in[2]; P.post_norm = (const float*)d_in[3];
  P.gla_w_in = (const float*)d_in[4]; P.gla_w_gk_up = (const float*)d_in[5]; P.gla_b_gk = (const float*)d_in[6];
  P.gla_head_norm = (const float*)d_in[7]; P.gla_w_out = (const float*)d_in[8];
  P.nsa_w_in = (const float*)d_in[9]; P.nsa_b_gate = (const float*)d_in[10]; P.nsa_pe_k = (const float*)d_in[11]; P.nsa_pe_v = (const float*)d_in[12];
  P.ck_w1 = (const float*)d_in[13]; P.ck_w2 = (const float*)d_in[14]; P.cv_w1 = (const float*)d_in[15]; P.cv_w2 = (const float*)d_in[16];
  P.nsa_w_out = (const float*)d_in[17];
  P.out = (float*)d_out;
  char* ws = (char*)d_ws;
  const size_t MB = 1024 * 1024;
  P.W0t = (half_t*)(ws);
  P.Wo0t = (half_t*)(ws + 7 * MB);
  P.W1t = (half_t*)(ws + 9 * MB);
  P.Wo1t = (half_t*)(ws + 17 * MB);
  P.cw1t = (half_t*)(ws + 19 * MB);
  P.cw2t = (half_t*)(ws + 21 * MB);
  P.cbias = (float*)(ws + 22 * MB);
  P.cbias_part = (float*)(ws + 22 * MB + 4096);
  P.bar = (unsigned*)(ws + 23 * MB);
  P.use_cg_sync = 0;
  P.kmax2 = (unsigned*)(ws + 22 * MB + 512 * 1024);
  P.xh = (half_t*)(ws + 24 * MB);
  P.x1h = P.xh;
  P.p = (half_t*)(ws + 88 * MB);
  P.y = (half_t*)(ws + 88 * MB);
  P.og = (half_t*)(ws + 328 * MB);
  P.bcum = (float*)(ws + 392 * MB);
  P.rstd = (float*)(ws + 456 * MB);
  P.kcmp = (half_t*)(ws + 457 * MB);
  P.vcmp = (half_t*)(ws + 458 * MB);
  P.ropetab = (float*)(ws + 459 * MB);
  P.hid = (half_t*)(ws + 467 * MB);
  P.WglT = (half_t*)(ws + 22 * MB + 768 * 1024);
  P.WglrT = (half_t*)(ws + 22 * MB + 896 * 1024);
  P.glr = (float*)(ws + 509 * MB);
  P.gl = (float*)(ws + 503 * MB);
  P.gla_state = (float*)(ws + 476 * MB);
  P.part = (half_t*)(ws + 400 * MB);
  if (ws_size < 512 * MB) { fprintf(stderr, "ws too small: %zu\n", ws_size); return; }
#if MEGA
  static int grid_blocks = 0;
  if (!grid_blocks) {
    int dev = 0, cus = 0, per_cu = 0;
    hipGetDevice(&dev);
    hipDeviceGetAttribute(&cus, hipDeviceAttributeMultiprocessorCount, dev);
    hipOccupancyMaxActiveBlocksPerMultiprocessor(&per_cu, k_mega, NTHREADS, 0);
    if (per_cu < 1) per_cu = 1;
    if (per_cu > 1) per_cu = 1;
    grid_blocks = cus * per_cu;
  }
  hipMemsetAsync(ws + 23 * MB, 0, 16384, stream);
  void* args[] = {&P};
  hipError_t e = hipLaunchCooperativeKernel((void*)k_mega, dim3(grid_blocks), dim3(NTHREADS), args, 0, stream);
  if (e != hipSuccess) fprintf(stderr, "cooperative launch failed: %s (grid %d)\n", hipGetErrorString(e), grid_blocks);
#else
  launch_phases<0>(P, stream);
#endif
}
```

```cpp
#include <hip/hip_runtime.h>
#include <hip/hip_cooperative_groups.h>
#include <cstdio>
#include <cstdint>
namespace cg = cooperative_groups;

typedef _Float16 half_t;
typedef _Float16 half8 __attribute__((ext_vector_type(8)));
typedef _Float16 half4 __attribute__((ext_vector_type(4)));
typedef float f32x4 __attribute__((ext_vector_type(4)));
typedef int v2i __attribute__((ext_vector_type(2)));
typedef int v4i __attribute__((ext_vector_type(4)));

#ifndef MEGA
#define MEGA 1
#endif

constexpr int T_TOK = 32768, DM = 1024, SEQ = 4096, NBATCH = 8;
constexpr int GLA_IN = 3088, NSA_IN = 3632;
constexpr int LD0 = 3072, LD1 = 3584;
constexpr int NC = 255;
constexpr float EPS = 1e-6f;
constexpr int NTHREADS = 512, NWAVES = NTHREADS / 64;
constexpr int SMEM_BYTES = 160 * 1024;

struct Params {
  const float* x; const int* pos; const float* pre_norm; const float* post_norm;
  const float* gla_w_in; const float* gla_w_gk_up; const float* gla_b_gk; const float* gla_head_norm; const float* gla_w_out;
  const float* nsa_w_in; const float* nsa_b_gate; const float* nsa_pe_k; const float* nsa_pe_v;
  const float* ck_w1; const float* ck_w2; const float* cv_w1; const float* cv_w2; const float* nsa_w_out;
  float* out;
  half_t* p; half_t* y; half_t* og; float* bcum; float* rstd; half_t* kcmp; half_t* vcmp; float* ropetab;
  half_t* xh; half_t* W0t; half_t* Wo0t; half_t* W1t; half_t* Wo1t;
  half_t* cw1t; half_t* cw2t; float* cbias; half_t* hid;
  float* cbias_part; unsigned* bar; long long use_cg_sync; unsigned* kmax2; float* gla_state; half_t* WglT; float* gl; half_t* x1h; half_t* WglrT; float* glr; half_t* part;
};

__device__ __forceinline__ int lane_id() { return (int)__builtin_amdgcn_mbcnt_hi(~0u, __builtin_amdgcn_mbcnt_lo(~0u, 0u)); }
__device__ __forceinline__ int otid(int wvs) { int t = wvs * 64 + lane_id(); asm volatile("" : "+v"(t)); return t; }
typedef __attribute__((address_space(3))) void lds_void;
typedef __attribute__((address_space(1))) const void gbl_void;
typedef short s16x4 __attribute__((vector_size(8)));
typedef __attribute__((address_space(3))) s16x4 lds_s16x4;
__device__ __forceinline__ half4 tr_read4(const char* p) {
  const s16x4 v = __builtin_amdgcn_ds_read_tr16_b64_v4i16((lds_s16x4*)(p));
  return __builtin_bit_cast(half4, v);
}
template <int N> __device__ __forceinline__ void wait_vmcnt() { asm volatile("s_waitcnt vmcnt(%0)" ::"n"(N) : "memory"); }
constexpr float LOG2E = 1.4426950408889634f;
__device__ __forceinline__ float fexp2(float x) { return __builtin_amdgcn_exp2f(x); }
typedef unsigned u32x2 __attribute__((ext_vector_type(2)));
__device__ __forceinline__ float rowmax4(float x) {
  u32x2 r = __builtin_amdgcn_permlane16_swap(__float_as_uint(x), __float_as_uint(x), false, false);
  x = fmaxf(__uint_as_float(r[0]), __uint_as_float(r[1]));
  r = __builtin_amdgcn_permlane32_swap(__float_as_uint(x), __float_as_uint(x), false, false);
  return fmaxf(__uint_as_float(r[0]), __uint_as_float(r[1]));
}
__device__ __forceinline__ float rowsum4(float x) {
  u32x2 r = __builtin_amdgcn_permlane16_swap(__float_as_uint(x), __float_as_uint(x), false, false);
  x = __uint_as_float(r[0]) + __uint_as_float(r[1]);
  r = __builtin_amdgcn_permlane32_swap(__float_as_uint(x), __float_as_uint(x), false, false);
  return __uint_as_float(r[0]) + __uint_as_float(r[1]);
}
template <int CTRL> __device__ __forceinline__ float dpp_f(float x) {
  return __builtin_bit_cast(float, __builtin_amdgcn_update_dpp(0, __builtin_bit_cast(int, x), CTRL, 0xf, 0xf, true));
}
__device__ __forceinline__ float wave_sum(float v) {
  v += dpp_f<0xB1>(v);
  v += dpp_f<0x4E>(v);
  v += dpp_f<0x141>(v);
  v += dpp_f<0x140>(v);
  return rowsum4(v);
}
__device__ __forceinline__ float wave_max(float v) {
  v = fmaxf(v, dpp_f<0xB1>(v));
  v = fmaxf(v, dpp_f<0x4E>(v));
  v = fmaxf(v, dpp_f<0x141>(v));
  v = fmaxf(v, dpp_f<0x140>(v));
  return rowmax4(v);
}
__device__ __forceinline__ float fast_exp2(float x) { return __builtin_amdgcn_exp2f(x); }
__device__ __forceinline__ float sigmoidf(float v) { return __builtin_amdgcn_rcpf(1.f + fast_exp2(-1.4426950408889634f * v)); }
__device__ __forceinline__ float siluf(float v) { return v * sigmoidf(v); }
__device__ __forceinline__ float logsigmoidf(float u) { return fminf(u, 0.f) - 0.6931471805599453f * __builtin_amdgcn_logf(1.f + fast_exp2(-1.4426950408889634f * fabsf(u))); }

__device__ __forceinline__ void fast_barrier(unsigned* bar, unsigned& round, int wvs) {
  asm volatile("s_waitcnt vmcnt(0) lgkmcnt(0)" ::: "memory");
  __syncthreads();
  round += 1;
  if (wvs == 0 && lane_id() == 0) {
    __builtin_amdgcn_fence(__ATOMIC_RELEASE, "agent");
    asm volatile("s_waitcnt vmcnt(0)" ::: "memory");
    const unsigned ngroups = gridDim.x >> 4;
    const unsigned old = __hip_atomic_fetch_add(bar + 64 + 64 * (blockIdx.x >> 4), 1u, __ATOMIC_RELAXED, __HIP_MEMORY_SCOPE_AGENT);
    if (old + 1 == round * 16u) __hip_atomic_fetch_add(bar, 1u, __ATOMIC_RELAXED, __HIP_MEMORY_SCOPE_AGENT);
    const unsigned target = round * ngroups;
    while (__hip_atomic_load(bar, __ATOMIC_RELAXED, __HIP_MEMORY_SCOPE_AGENT) < target) { }
    __builtin_amdgcn_fence(__ATOMIC_ACQUIRE, "agent");
    asm volatile("s_waitcnt vmcnt(0)" ::: "memory");
  }
  __syncthreads();
}

__device__ void ph_xh_rstd(const float* src, half_t* xh, float* rstd, int wvs) {
  const int tid_ = otid(wvs); const int lane = tid_ & 63, w = tid_ >> 6;
  constexpr int RW = 4;
  const int rstride = gridDim.x * NWAVES;
#pragma unroll 1
  for (int row0 = blockIdx.x * NWAVES + w; row0 < T_TOK; row0 += rstride * RW) {
    float4 v[RW][4];
#pragma unroll
    for (int r = 0; r < RW; ++r)
#pragma unroll
      for (int i = 0; i < 4; ++i) v[r][i] = ((const float4*)(src + (size_t)(row0 + r * rstride) * DM))[lane + 64 * i];
#pragma unroll
    for (int r = 0; r < RW; ++r) {
      const int row = row0 + r * rstride;
      half4* xr = (half4*)(xh + (size_t)row * DM);
      float ss = 0.f;
#pragma unroll
      for (int i = 0; i < 4; ++i) {
        const float4 t = v[r][i];
        ss += t.x * t.x + t.y * t.y + t.z * t.z + t.w * t.w;
        half4 hv; hv[0] = (half_t)t.x; hv[1] = (half_t)t.y; hv[2] = (half_t)t.z; hv[3] = (half_t)t.w;
        xr[lane + 64 * i] = hv;
      }
      ss = wave_sum(ss);
      if (lane == 0) rstd[row] = rsqrtf(ss * (1.f / DM) + EPS);
    }
  }
}
__device__ void ph_ropetab(const Params& P, int wvs) {
  const int tid = otid(wvs);
  const float inv = powf(10000.f, -(float)(2 * (tid & 31)) / 64.f);
  for (int idx = blockIdx.x * NTHREADS + tid; idx < T_TOK * 32; idx += gridDim.x * NTHREADS) {
    const int t = idx >> 5, i = idx & 31;
    const float ang = (float)P.pos[t] * inv;
    float s, c; sincosf(ang, &s, &c);
    P.ropetab[t * 64 + i] = c; P.ropetab[t * 64 + 32 + i] = s;
  }
}
__device__ __forceinline__ int orig_col(int n, int mode) {
  if (mode == 0) {
    if (n < 2048) return n;
    if (n < 3072) return n + 16;
    return -1;
  } else if (mode == 1) {
    if (n < 2560) return n;
    if (n < 3584) return n + 48;
    return -1;
  } else if (mode == 5) {
    return n < 48 ? 2560 + n : -1;
  }
  if (mode == 4) return n < 64 ? n : -1;
  if (mode == 6) return n < 16 ? 2048 + n : -1;
  return n;
}
__device__ void prep_wT(const float* W, int ldw, const float* gamma, half_t* Wt, int Npad, int K, int mode, float* sm, int wvs) {
  float(*tile)[65] = (float(*)[65])sm;
  const int tid = otid(wvs);
  const int ntn = Npad / 64, ntk = K / 64;
  for (int t = blockIdx.x; t < ntn * ntk; t += gridDim.x) {
    const int n0 = (t / ntk) * 64, k0 = (t % ntk) * 64;
    __syncthreads();
#pragma unroll
    for (int r = 0; r < 4096 / NTHREADS; ++r) {
      const int idx = tid + r * NTHREADS, kk = idx >> 6, nn = idx & 63;
      const int on = orig_col(n0 + nn, mode);
      float v = 0.f;
      if (on >= 0) { v = W[(size_t)(k0 + kk) * ldw + on]; if (gamma) v *= gamma[k0 + kk]; }
      tile[kk][nn] = v;
    }
    __syncthreads();
    {
      const int nn = tid >> 3, oct = tid & 7;
      half8 hv;
#pragma unroll
      for (int e = 0; e < 8; ++e) hv[e] = (half_t)tile[oct * 8 + e][nn];
      *(half8*)(Wt + (size_t)(n0 + nn) * K + k0 + oct * 8) = hv;
    }
  }
}

__device__ __forceinline__ void prep_strip(const float* W, int ldw, const float* gamma, half_t* Wt, int K, int mode, int n0, int k0, float* sm, int tid) {
  float(*tile)[260] = (float(*)[260])sm;
  __syncthreads();
#pragma unroll
  for (int r = 0; r < 8; ++r) {
    const int idx = tid + r * NTHREADS, kk = idx >> 6, n4 = (idx & 63) * 4;
    const int on = orig_col(n0 + n4, mode);
    f32x4 v = (f32x4){0.f, 0.f, 0.f, 0.f};
    if (on >= 0) { v = *(const f32x4*)(W + (size_t)(k0 + kk) * ldw + on); if (gamma) v *= gamma[k0 + kk]; }
    *(f32x4*)&tile[kk][n4] = v;
  }
  __syncthreads();
#pragma unroll
  for (int r = 0; r < 4; ++r) {
    const int idx = tid + r * NTHREADS, nn = idx & 255, oct = idx >> 8;
    half8 hv;
#pragma unroll
    for (int e = 0; e < 8; ++e) hv[e] = (half_t)tile[oct * 8 + e][nn];
    *(half8*)(Wt + (size_t)(n0 + nn) * K + k0 + oct * 8) = hv;
  }
}
__device__ void prep_weights(const Params& P, float* sm, int wvs) {
  const int tid = otid(wvs);
  constexpr int NJ = 8;
  const int nstr[NJ] = {(LD0 / 256) * (DM / 64), (DM / 256) * (DM / 64), (LD1 / 256) * (DM / 64), (DM / 256) * (DM / 64), 32, 32, 4, 4};
  int total = 0;
#pragma unroll
  for (int j = 0; j < NJ; ++j) total += nstr[j];
  for (int w = blockIdx.x; w < total; w += gridDim.x) {
    int j = 0, t = w;
#pragma unroll
    for (int jj = 0; jj < NJ - 1; ++jj) if (j == jj && t >= nstr[jj]) { t -= nstr[jj]; j = jj + 1; }
    const float* W; int ldw; const float* gamma; half_t* Wt; int K, mode;
    switch (j) {
      case 0: W = P.gla_w_in; ldw = GLA_IN; gamma = P.pre_norm; Wt = P.W0t; K = DM; mode = 0; break;
      case 1: W = P.gla_w_out; ldw = DM; gamma = nullptr; Wt = P.Wo0t; K = DM; mode = 2; break;
      case 2: W = P.nsa_w_in; ldw = NSA_IN; gamma = P.pre_norm + DM; Wt = P.W1t; K = DM; mode = 1; break;
      case 3: W = P.nsa_w_out; ldw = DM; gamma = nullptr; Wt = P.Wo1t; K = DM; mode = 2; break;
      case 4: W = P.ck_w1; ldw = 256; gamma = nullptr; Wt = P.cw1t; K = 2048; mode = 2; break;
      case 5: W = P.cv_w1; ldw = 256; gamma = nullptr; Wt = P.cw1t + 256 * 2048; K = 2048; mode = 2; break;
      case 6: W = P.ck_w2; ldw = 64; gamma = nullptr; Wt = P.cw2t; K = 256; mode = 4; break;
      default: W = P.cv_w2; ldw = 64; gamma = nullptr; Wt = P.cw2t + 256 * 256; K = 256; mode = 4; break;
    }
    const int nsk = K / 64;
    prep_strip(W, ldw, gamma, Wt, K, mode, (t / nsk) * 256, (t % nsk) * 64, sm, tid);
  }
}

__device__ void prep_cbias_part(const Params& P, int wvs) {
  for (int idx = blockIdx.x * NTHREADS + otid(wvs); idx < 2 * 32 * 256; idx += gridDim.x * NTHREADS) {
    const int j = idx & 255, ks = (idx >> 8) & 31, which = idx >> 13;
    const float* pe = which ? P.nsa_pe_v : P.nsa_pe_k;
    const float* w1 = which ? P.cv_w1 : P.ck_w1;
    float a = 0.f;
#pragma unroll 8
    for (int k = ks * 64; k < ks * 64 + 64; ++k) a += pe[k] * w1[(size_t)k * 256 + j];
    P.cbias_part[idx] = a;
  }
}
__device__ void prep_cbias_reduce(const Params& P, int wvs) {
  if (blockIdx.x < 2 && otid(wvs) < 256) {
    const int which = blockIdx.x, j = otid(wvs);
    float a = 0.f;
    for (int ks = 0; ks < 32; ++ks) a += P.cbias_part[(which * 32 + ks) * 256 + j];
    P.cbias[which * 256 + j] = a;
  }
}

namespace g8 {
constexpr int BK = 64, HALF = 128, HTB = HALF * BK * 2;
__device__ __forceinline__ int lds_byte(int r, int c) { const int st = (r >> 4) * 2 + (c >> 5), rr = r & 15, cc = c & 31, ob = rr * 64 + cc * 2; return st * 1024 + (ob ^ (((ob >> 9) & 1) << 5)); }
__device__ __forceinline__ void stage_rc(int b, int& R, int& C) { const int st = b / 1024, sb = b % 1024, swz = sb ^ (((sb >> 9) & 1) << 5); R = (st >> 1) * 16 + swz / 64; C = (st & 1) * 32 + (swz % 64) / 2; }
typedef f32x4 Acc[2][2][4][2];

struct SrcPlain8 {
  const half_t* A; int lda; const half_t* Bt; int K;
  __device__ __forceinline__ void get(int pm, int pn, const half_t*& Ag, const half_t*& Bg, size_t& a_rs, int& a_ks) const {
    Ag = A + (size_t)pm * 256 * lda; Bg = Bt + (size_t)pn * 256 * K; a_rs = lda; a_ks = 64;
  }
  __device__ __forceinline__ int ldb(int K_) const { return K_; }
};
struct SrcCmp1_8 {
  const half_t* p1; const half_t* w1t;
  __device__ __forceinline__ void get(int pm, int pn, const half_t*& Ag, const half_t*& Bg, size_t& a_rs, int& a_ks) const {
    const int which = pm >> 5, bg = pm & 31, b = bg >> 2, g = bg & 3;
    Ag = p1 + (size_t)(b * SEQ) * LD1 + (which ? 1280 : 1024) + g * 64;
    Bg = w1t + (size_t)which * 256 * 2048; a_rs = (size_t)16 * LD1; a_ks = LD1;
  }
  __device__ __forceinline__ int ldb(int K_) const { return K_; }
};
struct SrcCmp2_8 {
  const half_t* hid; const half_t* w2t;
  __device__ __forceinline__ void get(int pm, int pn, const half_t*& Ag, const half_t*& Bg, size_t& a_rs, int& a_ks) const {
    Ag = hid + (size_t)pm * 256 * 256; Bg = w2t + (size_t)(pm >> 5) * 256 * 256; a_rs = 256; a_ks = 64;
  }
  __device__ __forceinline__ int ldb(int K_) const { return K_; }
};
struct SrcCmp1h8 {
  const half_t* p1; const half_t* w1t;
  __device__ __forceinline__ void get(int pm, int pn, const half_t*& Ag, const half_t*& Bg, size_t& a_rs, int& a_ks) const {
    const int which = pm >> 5, bg = pm & 31, b = bg >> 2, g = bg & 3;
    Ag = p1 + (size_t)(b * SEQ) * LD1 + (which ? 1280 : 1024) + g * 64;
    Bg = w1t + (size_t)which * 256 * 2048 + pn * 1024; a_rs = (size_t)16 * LD1; a_ks = LD1;
  }
  __device__ __forceinline__ int ldb(int) const { return 2048; }
};

__device__ __forceinline__ half8 pack8(const f32x4 a, const f32x4 b) {
  half8 h; h[0] = (half_t)a[0]; h[1] = (half_t)a[1]; h[2] = (half_t)a[2]; h[3] = (half_t)a[3]; h[4] = (half_t)b[0]; h[5] = (half_t)b[1]; h[6] = (half_t)b[2]; h[7] = (half_t)b[3];
  return h;
}
struct EpiStore8 {
  half_t* C; int ldc; const float* rowscale;
  __device__ __forceinline__ void operator()(const Acc& acc, int row0, int col0, int wr, int wc, int fr, int fq) const {
    float rs[2][4];
#pragma unroll
    for (int ai = 0; ai < 2; ++ai)
#pragma unroll
      for (int m = 0; m < 4; ++m) rs[ai][m] = rowscale ? rowscale[row0 + ai * 128 + wr * 64 + m * 16 + fr] : 1.f;
#pragma unroll
    for (int ai = 0; ai < 2; ++ai)
#pragma unroll
      for (int m = 0; m < 4; ++m) {
        const int tok = row0 + ai * 128 + wr * 64 + m * 16 + fr;
        const float s = rs[ai][m];
        half_t* rowp = C + (size_t)tok * ldc + col0 + 64 * wc + 8 * fq;
#pragma unroll
        for (int bj = 0; bj < 2; ++bj) *(half8*)(rowp + 32 * bj) = pack8(acc[ai][bj][m][0] * s, acc[ai][bj][m][1] * s);
      }
  }
};
struct EpiRope8 {
  half_t* C; int ldc; const float* rowscale; const float* ropetab;
  __device__ __forceinline__ void operator()(const Acc& acc, int row0, int col0, int wr, int wc, int fr, int fq) const {
    const int grp = (col0 >> 6) + wc;
    const bool is_q = grp < 16;
    const bool roped = is_q || (grp >= 16 && grp < 20) || (grp >= 24 && grp < 28) || (grp >= 32 && grp < 36);
    const float sc = is_q ? 0.125f * 1.4426950408889634f : 1.f;
    float s = rowscale[row0 + wr * 64 + fr];
    f32x4 cs[2], sn[2];
    if (roped) {
      const int tok0 = row0 + wr * 64 + fr;
#pragma unroll
      for (int n = 0; n < 2; ++n) { cs[n] = *(const f32x4*)(ropetab + (size_t)tok0 * 64 + 8 * fq + 4 * n); sn[n] = *(const f32x4*)(ropetab + (size_t)tok0 * 64 + 32 + 8 * fq + 4 * n); }
    }
#pragma unroll
    for (int i = 0; i < 8; ++i) {
        const int ai = i >> 2, m = i & 3;
        const int tok = row0 + ai * 128 + wr * 64 + m * 16 + fr;
        half_t* rowp = C + (size_t)tok * ldc + col0 + 64 * wc + 8 * fq;
        f32x4 o1[2], o2[2];
#pragma unroll
        for (int n = 0; n < 2; ++n) {
          const f32x4 x1 = acc[ai][0][m][n] * s, x2 = acc[ai][1][m][n] * s;
          if (roped) { o1[n] = (x1 * cs[n] - x2 * sn[n]) * sc; o2[n] = (x2 * cs[n] + x1 * sn[n]) * sc; }
          else { o1[n] = x1; o2[n] = x2; }
        }
        const half8 p1 = pack8(o1[0], o1[1]), p2 = pack8(o2[0], o2[1]);
        if (i + 1 < 8) {
          const int tokn = row0 + ((i + 1) >> 2) * 128 + wr * 64 + ((i + 1) & 3) * 16 + fr;
          s = rowscale[tokn];
          if (roped) {
#pragma unroll
            for (int n = 0; n < 2; ++n) { cs[n] = *(const f32x4*)(ropetab + (size_t)tokn * 64 + 8 * fq + 4 * n); sn[n] = *(const f32x4*)(ropetab + (size_t)tokn * 64 + 32 + 8 * fq + 4 * n); }
          }
        }
        *(half8*)(rowp) = p1;
        *(half8*)(rowp + 32) = p2;
    }
  }
};
struct EpiCmpHid8 {
  half_t* hid; const float* bias;
  __device__ __forceinline__ void operator()(const Acc& acc, int row0, int col0, int wr, int wc, int fr, int fq) const {
    const int which = row0 >> 13;
#pragma unroll
    for (int bj = 0; bj < 2; ++bj) {
      const int col = col0 + 64 * wc + 32 * bj + 8 * fq;
      const f32x4 b0 = *(const f32x4*)(bias + which * 256 + col), b1 = *(const f32x4*)(bias + which * 256 + col + 4);
#pragma unroll
      for (int ai = 0; ai < 2; ++ai)
#pragma unroll
        for (int m = 0; m < 4; ++m) {
          const int row = row0 + ai * 128 + wr * 64 + m * 16 + fr;
          f32x4 v0 = acc[ai][bj][m][0] + b0, v1 = acc[ai][bj][m][1] + b1;
#pragma unroll
          for (int e = 0; e < 4; ++e) { v0[e] = siluf(v0[e]); v1[e] = siluf(v1[e]); }
          *(half8*)(hid + (size_t)row * 256 + col) = pack8(v0, v1);
        }
    }
  }
};
struct EpiCmpPart8 {
  half_t* part; unsigned* done;
  __device__ __forceinline__ void operator()(const Acc& acc, int row0, int col0, int wr, int wc, int fr, int fq) const {
    half_t* base = part + (size_t)(col0 >> 8) * 16384 * 256;
#pragma unroll
    for (int ai = 0; ai < 2; ++ai)
#pragma unroll
      for (int m = 0; m < 4; ++m) {
        half_t* rowp = base + (size_t)(row0 + ai * 128 + wr * 64 + m * 16 + fr) * 256 + 64 * wc + 8 * fq;
#pragma unroll
        for (int bj = 0; bj < 2; ++bj) *(half8*)(rowp + 32 * bj) = pack8(acc[ai][bj][m][0], acc[ai][bj][m][1]);
      }
    asm volatile("s_waitcnt vmcnt(0)" ::: "memory");
    __syncthreads();
    if (wr == 0 && wc == 0 && lane_id() == 0) {
      __builtin_amdgcn_fence(__ATOMIC_RELEASE, "agent");
      __hip_atomic_fetch_add(done + (row0 >> 8), 1u, __ATOMIC_RELAXED, __HIP_MEMORY_SCOPE_AGENT);
    }
  }
};
struct EpiCmpOut8 {
  half_t* kcmp; half_t* vcmp; unsigned* kmaxc;
  __device__ __forceinline__ void operator()(const Acc& acc, int row0, int col0, int wr, int wc, int fr, int fq) const {
    if (wc != 0) return;
#pragma unroll
    for (int ai = 0; ai < 2; ++ai)
#pragma unroll
      for (int m = 0; m < 4; ++m) {
        const int row = row0 + ai * 128 + wr * 64 + m * 16 + fr;
        const int which = row >> 13, r = row & 8191;
        half_t* dst = (which ? vcmp : kcmp) + (size_t)r * 64 + 8 * fq;
        const bool dead = (r & 255) == 255;
        float ss = 0.f;
#pragma unroll
        for (int bj = 0; bj < 2; ++bj) {
          half8 hv = pack8(acc[ai][bj][m][0], acc[ai][bj][m][1]);
          if (dead) hv = (half8){(half_t)0.f, (half_t)0.f, (half_t)0.f, (half_t)0.f, (half_t)0.f, (half_t)0.f, (half_t)0.f, (half_t)0.f};
#pragma unroll
          for (int e = 0; e < 8; ++e) ss += (float)hv[e] * (float)hv[e];
          *(half8*)(dst + 32 * bj) = hv;
        }
        if (which == 0) {
          ss = rowsum4(ss);
          ss = wave_max(ss);
          if (lane_id() == 0) __hip_atomic_fetch_max(&kmaxc[r >> 8], __float_as_uint(ss), __ATOMIC_RELAXED, __HIP_MEMORY_SCOPE_AGENT);
        }
      }
  }
};

template <class Src, class Epi>
__device__ void gemm(const Src& src, int M, int N, int K, const Epi& epi, char* smem, int wvs) {
  const int tid = otid(wvs), wid = __builtin_amdgcn_readfirstlane(tid >> 6), lane = tid & 63, wr = wid >> 2, wc = wid & 3, fr = lane & 15, fq = lane >> 4;
  const int nM = M / 256, nN = N / 256, nwg = nM * nN, G = gridDim.x, nt = K / BK;
  int sr0, sc0, sr1, sc1;
  stage_rc(tid * 16, sr0, sc0); stage_rc(tid * 16 + 8192, sr1, sc1);
  const int a_base = lds_byte(wr * 64 + fr, fq * 8);
  int b_base = 65536 + lds_byte(wc * 32 + fr, fq * 8);
  asm volatile("" : "+v"(b_base));
#define SA8(b, h) (smem + ((b) * 2 + (h)) * HTB)
#define SB8(b, h) (smem + (4 + (b) * 2 + (h)) * HTB)
#define STAGE_A(P, h, kt) { const char* g_ = (const char*)(Ag + (size_t)(h) * 128 * lda + (size_t)(kt) * a_ks); \
    __builtin_amdgcn_global_load_lds((gbl_void*)(g_ + aob0), (lds_void*)((P) + wid * 1024), 16, 0, 0); \
    __builtin_amdgcn_global_load_lds((gbl_void*)(g_ + aob1), (lds_void*)((P) + 8192 + wid * 1024), 16, 0, 0); }
#define STAGE_B(P, h, kt) { const char* g_ = (const char*)(Bg + (size_t)(h) * 32 * ldb + (size_t)(kt) * 64);     \
    __builtin_amdgcn_global_load_lds((gbl_void*)(g_ + bob0), (lds_void*)((P) + wid * 1024), 16, 0, 0); \
    __builtin_amdgcn_global_load_lds((gbl_void*)(g_ + bob1), (lds_void*)((P) + 8192 + wid * 1024), 16, 0, 0); }
#define LDA8(dst, b, h) { _Pragma("unroll") for (int m = 0; m < 4; ++m) _Pragma("unroll") for (int k = 0; k < 2; ++k) dst[m][k] = *(const half8*)(SA8(b, h) + a_base + m * 2048 + k * 1024); }
#define LDB8(dst, b, h) { _Pragma("unroll") for (int n = 0; n < 2; ++n) _Pragma("unroll") for (int k = 0; k < 2; ++k) dst[n][k] = *(const half8*)(smem + ((b) * 2 + (h)) * HTB + b_base + n * 2048 + k * 1024); }
#define MMA8(ai, bj, At, Bx) { __builtin_amdgcn_s_setprio(1); \
    _Pragma("unroll") for (int m = 0; m < 4; ++m) _Pragma("unroll") for (int n = 0; n < 2; ++n) _Pragma("unroll") for (int k = 0; k < 2; ++k) \
      acc[ai][bj][m][n] = __builtin_amdgcn_mfma_f32_16x16x32_f16(Bx[n][k], At[m][k], acc[ai][bj][m][n], 0, 0, 0); \
    __builtin_amdgcn_s_setprio(0); }
#define WAIT_V(n) asm volatile("s_waitcnt vmcnt(" #n ")" ::: "memory")
#define WAIT_L(n) asm volatile("s_waitcnt lgkmcnt(" #n ")" ::: "memory")
#define BAR __builtin_amdgcn_s_barrier()
#define SCHED __builtin_amdgcn_sched_barrier(0)
  for (int it = 0;; ++it) {
    const int L = it * G + (int)blockIdx.x;
    if (L >= nwg) break;
    int wgid;
    { const int q = nwg / 8, r = nwg % 8, xcd = L % 8, off = L / 8; wgid = (xcd < r ? xcd * (q + 1) : r * (q + 1) + (xcd - r) * q) + off; }
    const int nig = 8 * nN, gid = wgid / nig, fm = gid * 8, gsz = (nM - fm) < 8 ? (nM - fm) : 8;
    const int pm = fm + ((wgid % nig) % gsz), pn = (wgid % nig) / gsz;
    const half_t* Ag; const half_t* Bg; size_t lda; int a_ks;
    src.get(pm, pn, Ag, Bg, lda, a_ks);
    const unsigned aob0 = (unsigned)(((size_t)sr0 * lda + sc0) * 2), aob1 = (unsigned)(((size_t)sr1 * lda + sc1) * 2);
    const int pr0 = 64 * (sr0 >> 5) + 8 * ((sr0 & 15) >> 2) + 4 * ((sr0 >> 4) & 1) + (sr0 & 3), pr1 = 64 * (sr1 >> 5) + 8 * ((sr1 & 15) >> 2) + 4 * ((sr1 >> 4) & 1) + (sr1 & 3);
    const int ldb = src.ldb(K);
    const unsigned bob0 = (unsigned)((pr0 * ldb + sc0) * 2), bob1 = (unsigned)((pr1 * ldb + sc1) * 2);
    Acc acc;
#pragma unroll
    for (int a = 0; a < 2; ++a)
#pragma unroll
      for (int b = 0; b < 2; ++b)
#pragma unroll
        for (int m = 0; m < 4; ++m)
#pragma unroll
          for (int n = 0; n < 2; ++n) acc[a][b][m][n] = (f32x4){0.f, 0.f, 0.f, 0.f};
    half8 At[4][2], B0[2][2], B1[2][2];
    STAGE_B(SB8(0, 0), 0, 0) STAGE_A(SA8(0, 0), 0, 0)
    STAGE_B(SB8(0, 1), 1, 0) STAGE_A(SA8(0, 1), 1, 0)
    if (wr == 1) BAR;
    WAIT_V(4); BAR;
    STAGE_B(SB8(1, 0), 0, 1) STAGE_A(SA8(1, 0), 0, 1) STAGE_B(SB8(1, 1), 1, 1)
    WAIT_V(6); BAR;
#pragma unroll 1
    for (int t = 0; t < nt - 2; t += 2) {
      LDB8(B0, 0, 0) SCHED; LDA8(At, 0, 0) STAGE_A(SA8(1, 1), 1, t + 1)
      WAIT_L(8); BAR; WAIT_L(0); MMA8(0, 0, At, B0) BAR; SCHED;
      LDB8(B1, 0, 1) STAGE_B(SB8(0, 0), 0, t + 2)
      BAR; WAIT_L(0); MMA8(0, 1, At, B1) BAR;
      LDA8(At, 0, 1) STAGE_A(SA8(0, 0), 0, t + 2)
      BAR; WAIT_L(0); MMA8(1, 0, At, B0) BAR; SCHED;
      STAGE_B(SB8(0, 1), 1, t + 2)
      WAIT_V(6); BAR; MMA8(1, 1, At, B1) BAR;
      LDB8(B0, 1, 0) SCHED; LDA8(At, 1, 0) STAGE_A(SA8(0, 1), 1, t + 2)
      WAIT_L(8); BAR; WAIT_L(0); MMA8(0, 0, At, B0) BAR; SCHED;
      LDB8(B1, 1, 1) STAGE_B(SB8(1, 0), 0, t + 3)
      BAR; WAIT_L(0); MMA8(0, 1, At, B1) BAR;
      LDA8(At, 1, 1) STAGE_A(SA8(1, 0), 0, t + 3)
      BAR; WAIT_L(0); MMA8(1, 0, At, B0) BAR; SCHED;
      STAGE_B(SB8(1, 1), 1, t + 3)
      WAIT_V(6); BAR; MMA8(1, 1, At, B1) BAR;
    }
    { LDB8(B0, 0, 0) LDA8(At, 0, 0) STAGE_A(SA8(1, 1), 1, nt - 1)
      BAR; WAIT_L(0); MMA8(0, 0, At, B0) BAR;
      LDB8(B1, 0, 1) BAR; WAIT_L(0); MMA8(0, 1, At, B1) BAR;
      LDA8(At, 0, 1) WAIT_V(4); BAR; WAIT_L(0); MMA8(1, 0, At, B0) MMA8(1, 1, At, B1) BAR; }
    { LDB8(B0, 1, 0) LDA8(At, 1, 0) WAIT_V(2); BAR; WAIT_L(0); MMA8(0, 0, At, B0) BAR;
      LDB8(B1, 1, 1) WAIT_V(0); BAR; WAIT_L(0); MMA8(0, 1, At, B1) BAR;
      LDA8(At, 1, 1) BAR; WAIT_L(0); MMA8(1, 0, At, B0) MMA8(1, 1, At, B1) BAR; }
    if (wr == 0) BAR;
    { int fr2 = fr, fq2 = fq; asm volatile("" : "+v"(fr2), "+v"(fq2)); epi(acc, pm * 256, pn * 256, wr, wc, fr2, fq2); }
  }
#undef SA8
#undef SB8
#undef STAGE_A
#undef STAGE_B
#undef LDA8
#undef LDB8
#undef MMA8
#undef WAIT_V
#undef WAIT_L
#undef BAR
#undef SCHED
}
}

struct GlaPrepOps { half8 q0, k0, q1, k1; float w[16]; float bb; };
__device__ void ph_gla_prep(const Params& P, float* sm, int wvs) {
  float(*glr)[16] = (float(*)[16])sm;
  float(*tot)[128] = (float(*)[128])(sm + 1024);
  float(*exl)[132] = (float(*)[132])(sm + 1536);
  const int tid = otid(wvs);
  const int tq = tid >> 7, c = tid & 127;
  const int tp = tid >> 4, co = tid & 15;
  const float scale = 0.08838834764831845f;
  const int nchunks = T_TOK / 64, G = gridDim.x;
  const int nj = (((nchunks - 1 - (int)blockIdx.x) / G) + 1) * 4;
  GlaPrepOps nxt; f32x4 gnx = {};
#define GLA_PREP_LOAD(j_) { const int chunk_ = (int)blockIdx.x + ((j_) >> 2) * G, h_ = (j_) & 3, ch_ = h_ * 128 + c; \
    const half_t* qp_ = P.p + (size_t)(chunk_ * 64 + 2 * tp) * LD0 + h_ * 128 + co * 8; \
    nxt.q0 = *(const half8*)(qp_); nxt.k0 = *(const half8*)(qp_ + 512); nxt.q1 = *(const half8*)(qp_ + LD0); nxt.k1 = *(const half8*)(qp_ + LD0 + 512); \
    _Pragma("unroll") for (int r = 0; r < 16; ++r) nxt.w[r] = P.gla_w_gk_up[r * 512 + ch_]; \
    nxt.bb = P.gla_b_gk[ch_]; \
    if (h_ == 0 && tid < 256) gnx = *(const f32x4*)(P.glr + (size_t)(chunk_ * 64) * 16 + tid * 4); }
  GLA_PREP_LOAD(0)
#pragma unroll 1
  for (int j = 0; j < nj; ++j) {
    const int chunk = (int)blockIdx.x + (j >> 2) * G, h = j & 3;
    const int t0 = chunk * 64, ch = h * 128 + c;
    const GlaPrepOps cur = nxt;
    __syncthreads();
    if (h == 0 && tid < 256) *(f32x4*)(sm + tid * 4) = gnx;
    if (j + 1 < nj) GLA_PREP_LOAD(j + 1)
    __syncthreads();
    float pre[16]; float cum = 0.f;
#pragma unroll
    for (int i = 0; i < 16; ++i) {
      float u = cur.bb;
#pragma unroll
      for (int r = 0; r < 16; ++r) u += glr[tq * 16 + i][r] * cur.w[r];
      cum += logsigmoidf(u) * (1.f / 16.f);
      pre[i] = cum;
    }
    tot[tq][c] = cum;
    __syncthreads();
    float off = 0.f;
#pragma unroll
    for (int t = 0; t < 3; ++t) if (t < tq) off += tot[t][c];
#pragma unroll
    for (int i = 0; i < 16; ++i) {
      const float ex = fast_exp2((pre[i] + off) * LOG2E);
      exl[tq * 16 + i][c] = ex;
      if (tq == 3 && i == 15) P.bcum[(size_t)chunk * 512 + ch] = ex;
    }
    __syncthreads();
    {
      half_t* qp = P.p + (size_t)(t0 + 2 * tp) * LD0 + h * 128 + co * 8;
      const f32x4 e00 = *(const f32x4*)&exl[2 * tp][co * 8], e01 = *(const f32x4*)&exl[2 * tp][co * 8 + 4];
      const f32x4 e10 = *(const f32x4*)&exl[2 * tp + 1][co * 8], e11 = *(const f32x4*)&exl[2 * tp + 1][co * 8 + 4];
      half8 oq0, ok0, oq1, ok1;
#pragma unroll
      for (int e = 0; e < 8; ++e) {
        const float x0 = e < 4 ? e00[e] : e01[e - 4], x1 = e < 4 ? e10[e] : e11[e - 4];
        oq0[e] = (half_t)((float)cur.q0[e] * scale * x0); ok0[e] = (half_t)((float)cur.k0[e] * __builtin_amdgcn_rcpf(x0));
        oq1[e] = (half_t)((float)cur.q1[e] * scale * x1); ok1[e] = (half_t)((float)cur.k1[e] * __builtin_amdgcn_rcpf(x1));
      }
      *(half8*)(qp) = oq0; *(half8*)(qp + 512) = ok0; *(half8*)(qp + LD0) = oq1; *(half8*)(qp + LD0 + 512) = ok1;
    }
  }
#undef GLA_PREP_LOAD
}

constexpr int GLA_QE = 0, GLA_KE = 16384, GLA_V = 32768, GLA_DEC = 49152, GLA_BUF = 53248;
#define GLA_TR4(d0, d1, d2, d3, addr, o0, o1, o2, o3) \
  asm volatile("ds_read_b64_tr_b16 %0, %4 offset:%5\n\tds_read_b64_tr_b16 %1, %4 offset:%6\n\tds_read_b64_tr_b16 %2, %4 offset:%7\n\tds_read_b64_tr_b16 %3, %4 offset:%8" \
               : "=&v"(d0), "=&v"(d1), "=&v"(d2), "=&v"(d3) : "v"(addr), "n"(o0), "n"(o1), "n"(o2), "n"(o3) : "memory")
__device__ __forceinline__ half8 pack_h8(const v2i a, const v2i b) { const v4i p = (v4i){a[0], a[1], b[0], b[1]}; return __builtin_bit_cast(half8, p); }

template <bool STATE_ONLY>
__device__ void ph_gla_mfma(const Params& P, char* smem, int wvs) {
  const int tid = otid(wvs);
  const int lane = tid & 63, wave = __builtin_amdgcn_readfirstlane(tid >> 6), r15 = lane & 15, q = lane >> 4;
  const int qp = r15 >> 2, pp = lane & 3;
  const int srow = tid >> 4, sslot = tid & 15;
  const int src_q = (sslot ^ (srow & 15)) * 8, src_kv = (sslot ^ ((srow & 7) << 1)) * 8;
  const int fk = ((4 * (q & 1) + qp) & 7) << 1;
  const unsigned tr_row = (unsigned)((4 * q + qp) * 256 + 8 * (pp & 1) + ((pp >> 1) << 4));
  constexpr int NLOAD = STATE_ONLY ? 5 : 7;
  for (int wg = blockIdx.x; wg < (STATE_ONLY ? 3 : 4) * 64; wg += gridDim.x) {
    const int pr_ = ((wg >> 4) << 3) | (wg & 7), item = ((pr_ >> 5) << 6) | ((pr_ & 31) << 1) | ((wg >> 3) & 1);
    const int seg = item >> 6, base = item & 63, b = base >> 3, h = (base >> 1) & 3, vs = base & 1;
    const int c0 = seg * 16;
    f32x4 S[8], Dacc[8];
#pragma unroll
    for (int df = 0; df < 8; ++df) { S[df] = (f32x4){0.f, 0.f, 0.f, 0.f}; Dacc[df] = (f32x4){1.f, 1.f, 1.f, 1.f}; }
    f32x4* stL = (f32x4*)P.gla_state + ((size_t)base * 8 + wave) * 8 * 64 + lane;
    f32x4* stD = stL + (size_t)3 * 64 * 8 * 8 * 64;
    if (!STATE_ONLY) {
      for (int k = 0; k < seg; ++k) {
#pragma unroll
        for (int df = 0; df < 8; ++df) {
          const f32x4 Lk = stL[((size_t)k * 64 * 8 * 8 + df) * 64];
          if (k == 0) S[df] = Lk;
          else { const f32x4 Dk = stD[((size_t)k * 64 * 8 * 8 + df) * 64]; S[df] = Dk * S[df] + Lk; }
        }
      }
    }
    const half_t* qsrc = P.p + (size_t)(b * SEQ + srow) * LD0 + h * 128;
    const half_t* vsrc = P.p + (size_t)(b * SEQ + srow) * LD0 + 1024 + h * 256 + vs * 128 + src_kv;
    const float* dsrc = P.bcum + (size_t)(b * 64 + c0) * 512 + h * 128 + (lane & 31) * 4;
#define G_ISSUE(N, BUF) { char* lb_ = smem + (BUF) * GLA_BUF + wave * 1024; const size_t ro_ = (size_t)(c0 + (N)) * 64 * LD0; \
      if (!STATE_ONLY) { __builtin_amdgcn_global_load_lds((gbl_void*)(qsrc + ro_ + src_q), (lds_void*)(lb_ + GLA_QE), 16, 0, 0); \
      __builtin_amdgcn_global_load_lds((gbl_void*)(qsrc + ro_ + (size_t)32 * LD0 + src_q), (lds_void*)(lb_ + GLA_QE + 8192), 16, 0, 0); } \
      __builtin_amdgcn_global_load_lds((gbl_void*)(qsrc + ro_ + 512 + src_kv), (lds_void*)(lb_ + GLA_KE), 16, 0, 0); \
      __builtin_amdgcn_global_load_lds((gbl_void*)(qsrc + ro_ + (size_t)32 * LD0 + 512 + src_kv), (lds_void*)(lb_ + GLA_KE + 8192), 16, 0, 0); \
      __builtin_amdgcn_global_load_lds((gbl_void*)(vsrc + ro_), (lds_void*)(lb_ + GLA_V), 16, 0, 0); \
      __builtin_amdgcn_global_load_lds((gbl_void*)(vsrc + ro_ + (size_t)32 * LD0), (lds_void*)(lb_ + GLA_V + 8192), 16, 0, 0); \
      if (lane < 32) __builtin_amdgcn_global_load_lds((gbl_void*)(dsrc + (size_t)(N) * 512), (lds_void*)(smem + (BUF) * GLA_BUF + GLA_DEC + wave * 512), 16, 0, 0); }
    G_ISSUE(0, 0)
    G_ISSUE(1, 1)
#pragma unroll 1
    for (int n = 0; n < 16; ++n) {
      if (n + 1 < 16) wait_vmcnt<NLOAD>(); else wait_vmcnt<0>();
      __builtin_amdgcn_s_barrier();
      if (n + 2 < 16) G_ISSUE(n + 2, (n + 2) % 3)
      const char* cb = smem + (n % 3) * GLA_BUF;
      f32x4 aT[4][4];
      if (!STATE_ONLY) {
#pragma unroll
      for (int kf = 0; kf < 4; ++kf)
#pragma unroll
        for (int tf = 0; tf < 4; ++tf) aT[kf][tf] = (f32x4){0.f, 0.f, 0.f, 0.f};
#pragma unroll
      for (int ks = 0; ks < 4; ++ks) {
        half8 kef[4], qef[4];
#pragma unroll
        for (int f = 0; f < 4; ++f) {
          kef[f] = *(const half8*)(cb + GLA_KE + (16 * f + r15) * 256 + (((4 * ks + q) ^ ((r15 & 7) << 1)) << 4));
          qef[f] = *(const half8*)(cb + GLA_QE + (16 * f + r15) * 256 + (((4 * ks + q) ^ r15) << 4));
        }
#pragma unroll
        for (int kf = 0; kf < 4; ++kf)
#pragma unroll
          for (int tf = kf; tf < 4; ++tf) aT[kf][tf] = __builtin_amdgcn_mfma_f32_16x16x32_f16(kef[kf], qef[tf], aT[kf][tf], 0, 0, 0);
      }
#pragma unroll
      for (int f = 0; f < 4; ++f)
#pragma unroll
        for (int r = 0; r < 4; ++r) if (4 * q + r > r15) aT[f][f][r] = 0.f;
      }
      const unsigned lds0 = (unsigned)(size_t)cb;
      const unsigned va = lds0 + GLA_V + tr_row + ((((2 * wave) ^ fk)) << 4);
      v2i v00, v01, v10, v11;
      GLA_TR4(v00, v01, v10, v11, va, 0, 4096, 8192, 12288);
      const unsigned ka = lds0 + GLA_KE + tr_row;
      v2i k0[4][4];
#pragma unroll
      for (int df = 0; df < 4; ++df) { const unsigned a_ = ka + ((((2 * df) ^ fk)) << 4); GLA_TR4(k0[df][0], k0[df][1], k0[df][2], k0[df][3], a_, 0, 4096, 8192, 12288); }
      asm volatile("s_waitcnt lgkmcnt(15)" : "+v"(v00), "+v"(v01), "+v"(v10), "+v"(v11) :: "memory");
      __builtin_amdgcn_sched_barrier(0);
      half8 vf[2];
      vf[0] = pack_h8(v00, v01); vf[1] = pack_h8(v10, v11);
      if (!STATE_ONLY) {
      f32x4 o[4];
#pragma unroll
      for (int tf = 0; tf < 4; ++tf) o[tf] = (f32x4){0.f, 0.f, 0.f, 0.f};
#pragma unroll
      for (int ks2 = 0; ks2 < 2; ++ks2)
#pragma unroll
        for (int tf = 2 * ks2; tf < 4; ++tf) {
          half8 pk;
#pragma unroll
          for (int r = 0; r < 4; ++r) { pk[r] = (half_t)aT[2 * ks2][tf][r]; pk[4 + r] = (half_t)aT[2 * ks2 + 1][tf][r]; }
          o[tf] = __builtin_amdgcn_mfma_f32_16x16x32_f16(vf[ks2], pk, o[tf], 0, 0, 0);
        }
#pragma unroll
      for (int ks = 0; ks < 4; ++ks) {
        half8 sf;
#pragma unroll
        for (int r = 0; r < 4; ++r) { sf[r] = (half_t)S[2 * ks][r]; sf[4 + r] = (half_t)S[2 * ks + 1][r]; }
#pragma unroll
        for (int tf = 0; tf < 4; ++tf) {
          const int row = 16 * tf + r15;
          const half4 qa = *(const half4*)(cb + GLA_QE + row * 256 + (((4 * ks + (q >> 1)) ^ r15) << 4) + (q & 1) * 8);
          const half4 qb = *(const half4*)(cb + GLA_QE + row * 256 + (((4 * ks + 2 + (q >> 1)) ^ r15) << 4) + (q & 1) * 8);
          half8 qv;
#pragma unroll
          for (int e = 0; e < 4; ++e) { qv[e] = qa[e]; qv[4 + e] = qb[e]; }
          o[tf] = __builtin_amdgcn_mfma_f32_16x16x32_f16(sf, qv, o[tf], 0, 0, 0);
        }
      }
      {
        const size_t t0 = (size_t)(b * SEQ + (c0 + n) * 64);
#pragma unroll
        for (int tf = 0; tf < 4; ++tf) {
          half4 hv; hv[0] = (half_t)o[tf][0]; hv[1] = (half_t)o[tf][1]; hv[2] = (half_t)o[tf][2]; hv[3] = (half_t)o[tf][3];
          *(half4*)(P.og + (t0 + 16 * tf + r15) * DM + h * 256 + vs * 128 + 16 * wave + 4 * q) = hv;
        }
      }
      }
      v2i k1[4][4];
#pragma unroll
      for (int df = 0; df < 4; ++df) { const unsigned a_ = ka + ((((2 * (df + 4)) ^ fk)) << 4); GLA_TR4(k1[df][0], k1[df][1], k1[df][2], k1[df][3], a_, 0, 4096, 8192, 12288); }
      asm volatile("s_waitcnt lgkmcnt(15)"
                   : "+v"(k0[0][0]), "+v"(k0[0][1]), "+v"(k0[0][2]), "+v"(k0[0][3]), "+v"(k0[1][0]), "+v"(k0[1][1]), "+v"(k0[1][2]), "+v"(k0[1][3]),
                     "+v"(k0[2][0]), "+v"(k0[2][1]), "+v"(k0[2][2]), "+v"(k0[2][3]), "+v"(k0[3][0]), "+v"(k0[3][1]), "+v"(k0[3][2]), "+v"(k0[3][3]) :: "memory");
      __builtin_amdgcn_sched_barrier(0);
#pragma unroll
      for (int df = 0; df < 4; ++df) {
        S[df] = __builtin_amdgcn_mfma_f32_16x16x32_f16(pack_h8(k0[df][0], k0[df][1]), vf[0], S[df], 0, 0, 0);
        S[df] = __builtin_amdgcn_mfma_f32_16x16x32_f16(pack_h8(k0[df][2], k0[df][3]), vf[1], S[df], 0, 0, 0);
      }
      asm volatile("s_waitcnt lgkmcnt(0)"
                   : "+v"(k1[0][0]), "+v"(k1[0][1]), "+v"(k1[0][2]), "+v"(k1[0][3]), "+v"(k1[1][0]), "+v"(k1[1][1]), "+v"(k1[1][2]), "+v"(k1[1][3]),
                     "+v"(k1[2][0]), "+v"(k1[2][1]), "+v"(k1[2][2]), "+v"(k1[2][3]), "+v"(k1[3][0]), "+v"(k1[3][1]), "+v"(k1[3][2]), "+v"(k1[3][3]) :: "memory");
      __builtin_amdgcn_sched_barrier(0);
#pragma unroll
      for (int df = 0; df < 4; ++df) {
        S[df + 4] = __builtin_amdgcn_mfma_f32_16x16x32_f16(pack_h8(k1[df][0], k1[df][1]), vf[0], S[df + 4], 0, 0, 0);
        S[df + 4] = __builtin_amdgcn_mfma_f32_16x16x32_f16(pack_h8(k1[df][2], k1[df][3]), vf[1], S[df + 4], 0, 0, 0);
      }
#pragma unroll
      for (int df = 0; df < 8; ++df) {
        const f32x4 dc = *(const f32x4*)(cb + GLA_DEC + wave * 512 + (16 * df + 4 * q) * 4);
        S[df] *= dc;
        if (STATE_ONLY) Dacc[df] *= dc;
      }
    }
    if (STATE_ONLY) {
#pragma unroll
      for (int df = 0; df < 8; ++df) { stL[((size_t)seg * 64 * 8 * 8 + df) * 64] = S[df]; stD[((size_t)seg * 64 * 8 * 8 + df) * 64] = Dacc[df]; }
    }
    asm volatile("s_waitcnt vmcnt(0)" ::: "memory");
    __builtin_amdgcn_s_barrier();
#undef G_ISSUE
  }
}

__device__ void ph_gla_post(const Params& P, int wvs) {
  const int tid_ = otid(wvs); const int lane = tid_ & 63, sub = lane & 31;
  const int u0 = blockIdx.x * 16 + (tid_ >> 5);
  const float4 hn0 = ((const float4*)P.gla_head_norm)[sub * 2], hn1 = ((const float4*)P.gla_head_norm)[sub * 2 + 1];
  constexpr int UW = 4;
  const int ustride = gridDim.x * 16;
#pragma unroll 1
  for (int ub = u0; ub < T_TOK * 4; ub += ustride * UW) {
    half8 hv[UW], z[UW];
#pragma unroll
    for (int r = 0; r < UW; ++r) {
      const int u = ub + r * ustride, t = u >> 2, h = u & 3;
      hv[r] = *((const half8*)(P.og + (size_t)t * DM + h * 256) + sub);
      z[r] = *((const half8*)(P.p + (size_t)t * LD0 + 2048 + h * 256) + sub);
    }
#pragma unroll
    for (int r = 0; r < UW; ++r) {
      const int u = ub + r * ustride, t = u >> 2, h = u & 3;
      float v[8]; float ss = 0.f;
#pragma unroll
      for (int e = 0; e < 8; ++e) { v[e] = (float)hv[r][e]; ss += v[e] * v[e]; }
#pragma unroll
      for (int o = 16; o > 0; o >>= 1) ss += __shfl_xor(ss, o);
      const float rr = rsqrtf(ss * (1.f / 256.f) + EPS);
      const float hn[8] = {hn0.x, hn0.y, hn0.z, hn0.w, hn1.x, hn1.y, hn1.z, hn1.w};
      half8 o;
#pragma unroll
      for (int e = 0; e < 8; ++e) o[e] = (half_t)(v[e] * rr * hn[e] * siluf((float)z[r][e]));
      *((half8*)(P.og + (size_t)t * DM + h * 256) + sub) = o;
    }
  }
}

template <bool FINAL>
__device__ void ph_post(const half_t* baseh, const half_t* y, const float* g, float* dst, half_t* dsth, float* rstd_out, int wvs) {
  const int tid_ = otid(wvs); const int lane = tid_ & 63, w = tid_ >> 6;
  constexpr int RW = 4;
  const int rstride = gridDim.x * NWAVES;
  float4 gg4[4];
#pragma unroll
  for (int i = 0; i < 4; ++i) gg4[i] = ((const float4*)g)[lane + 64 * i];
#pragma unroll 1
  for (int row0 = blockIdx.x * NWAVES + w; row0 < T_TOK; row0 += rstride * RW) {
    half4 yv[RW][4], bv[RW][4];
#pragma unroll
    for (int r = 0; r < RW; ++r)
#pragma unroll
      for (int i = 0; i < 4; ++i) yv[r][i] = ((const half4*)(y + (size_t)(row0 + r * rstride) * DM))[lane + 64 * i];
#pragma unroll
    for (int r = 0; r < RW; ++r)
#pragma unroll
      for (int i = 0; i < 4; ++i) bv[r][i] = ((const half4*)(baseh + (size_t)(row0 + r * rstride) * DM))[lane + 64 * i];
#pragma unroll
    for (int r = 0; r < RW; ++r) {
      const int row = row0 + r * rstride;
      float ss = 0.f;
#pragma unroll
      for (int i = 0; i < 4; ++i)
#pragma unroll
        for (int e = 0; e < 4; ++e) { const float t = (float)yv[r][i][e]; ss += t * t; }
      ss = wave_sum(ss);
      const float rr = rsqrtf(ss * (1.f / DM) + EPS);
      float s2 = 0.f;
#pragma unroll
      for (int i = 0; i < 4; ++i) {
        const float4 gg = gg4[i];
        float4 o;
        o.x = (float)bv[r][i][0] + (float)yv[r][i][0] * rr * gg.x; o.y = (float)bv[r][i][1] + (float)yv[r][i][1] * rr * gg.y;
        o.z = (float)bv[r][i][2] + (float)yv[r][i][2] * rr * gg.z; o.w = (float)bv[r][i][3] + (float)yv[r][i][3] * rr * gg.w;
        if (FINAL) ((float4*)(dst + (size_t)row * DM))[lane + 64 * i] = o;
        else {
          s2 += o.x * o.x + o.y * o.y + o.z * o.z + o.w * o.w;
          half4 hv; hv[0] = (half_t)o.x; hv[1] = (half_t)o.y; hv[2] = (half_t)o.z; hv[3] = (half_t)o.w;
          ((half4*)(dsth + (size_t)row * DM))[lane + 64 * i] = hv;
        }
      }
      if (!FINAL) { s2 = wave_sum(s2); if (lane == 0) rstd_out[row] = rsqrtf(s2 * (1.f / DM) + EPS); }
    }
  }
}

template <int NF>
__device__ void ph_rowproj(const Params& P, const half_t* Wt, float* out, char* smem, int wvs, int first_block) {
  const int tid = otid(wvs), lane = tid & 63, wave = tid >> 6, r15 = lane & 15, q = lane >> 4;
  const int nb = gridDim.x - first_block;
  if ((int)blockIdx.x < first_block) return;
  __syncthreads();
  for (int c = tid; c < 16 * NF * 128; c += NTHREADS) {
    const int row = c >> 7, ch = c & 127;
    *(uint4*)(smem + row * 2064 + ch * 16) = *(const uint4*)(Wt + (size_t)row * DM + ch * 8);
  }
  __syncthreads();
  for (int tile = (int)blockIdx.x - first_block; tile < T_TOK / 128; tile += nb) {
    const int tok = tile * 128 + wave * 16 + r15;
    const half_t* ap = P.xh + (size_t)tok * DM + 8 * q;
    const char* bp = smem + r15 * 2064 + 16 * q;
    f32x4 acc[NF];
#pragma unroll
    for (int n = 0; n < NF; ++n) acc[n] = (f32x4){0.f, 0.f, 0.f, 0.f};
#pragma unroll 1
    for (int s0 = 0; s0 < 32; s0 += 16) {
      half8 a[16];
#pragma unroll
      for (int i = 0; i < 16; ++i) a[i] = *(const half8*)(ap + 32 * (s0 + i));
#pragma unroll
      for (int i = 0; i < 16; ++i) {
#pragma unroll
        for (int n = 0; n < NF; ++n) {
          const half8 bw = *(const half8*)(bp + n * 16 * 2064 + (s0 + i) * 64);
          acc[n] = __builtin_amdgcn_mfma_f32_16x16x32_f16(bw, a[i], acc[n], 0, 0, 0);
        }
      }
    }
    const float rs = P.rstd[tok];
#pragma unroll
    for (int n = 0; n < NF; ++n) *(f32x4*)(out + (size_t)tok * (16 * NF) + 16 * n + 4 * q) = acc[n] * rs;
  }
  __syncthreads();
}

__device__ void ph_kmax(const Params& P, int wvs, int first_block) {
  const int tid = otid(wvs);
  for (int task = (int)blockIdx.x - first_block; task < NBATCH * 4 * 2 * 8; task += gridDim.x - first_block) {
    const int chunk = task & 7, br = (task >> 3) & 1, bg = task >> 4, b = bg >> 2, g = bg & 3;
    const half_t* kp = P.p + (size_t)(b * SEQ + chunk * 512 + tid) * LD1 + (br ? 2048 : 1536) + g * 64;
    float ss = 0.f;
#pragma unroll
    for (int c = 0; c < 8; ++c) {
      const half8 v = *(const half8*)(kp + c * 8);
#pragma unroll
      for (int e = 0; e < 8; ++e) ss += (float)v[e] * (float)v[e];
    }
    ss = wave_max(ss);
    if ((tid & 63) == 0) __hip_atomic_fetch_max(&P.kmax2[bg * 2 + br], __float_as_uint(ss), __ATOMIC_RELAXED, __HIP_MEMORY_SCOPE_AGENT);
  }
}

constexpr int ATT_NB = 6, ATT_D = 5;
constexpr int ATT_K = 0, ATT_V = ATT_NB * 8192, ATT_Z = 2 * ATT_NB * 8192, ATT_IMP = ATT_Z + 32768, ATT_SELM = ATT_IMP + 64 * 68 * 4;
constexpr int IMPS = 68;
constexpr int ATT_GATE = ATT_SELM + 512;

__device__ __forceinline__ void attn_issue(char* smem, const half_t* kbase, const half_t* vbase, int ld, int tile_lo, int tile_hi, int wvs, int rot = 0) {
  const int tid = otid(wvs);
  const int lrow = tid >> 3, lch = tid & 7;
  const int ksrc = (lch ^ ((lrow >> 1) & 7)) * 8, vsrc = (lch ^ (((lrow >> 1) & 3) << 1)) * 8;
  const int wbase = __builtin_amdgcn_readfirstlane(tid >> 6) * 1024;
#pragma unroll
  for (int i = 0; i < ATT_D; ++i) if (tile_lo + i <= tile_hi) {
    const int nt_ = tile_hi - tile_lo + 1, tr_ = tile_lo + ((rot + i >= nt_) ? rot + i - nt_ : rot + i);
    const half_t* kp_ = kbase + (size_t)(tr_ * 64 + lrow) * ld + ksrc;
    const half_t* vp_ = vbase + (size_t)(tr_ * 64 + lrow) * ld + vsrc;
    __builtin_amdgcn_global_load_lds((gbl_void*)kp_, (lds_void*)(smem + ATT_K + i * 8192 + wbase), 16, 0, 0);
    __builtin_amdgcn_global_load_lds((gbl_void*)vp_, (lds_void*)(smem + ATT_V + i * 8192 + wbase), 16, 0, 0);
  }
}

template <int MODE, bool PREISSUED = false>
__device__ __forceinline__ void attn_branch(char* smem, const half_t* kbase, const half_t* vbase, int ld, int tile_lo, int tile_hi, int n, int th,
                                            const half8 (&qf)[2][2], float (&m)[2], float (&l)[2], f32x4 (&o)[4][2],
                                            const unsigned long long (&selm)[2], int wvs) {
  const int tid = otid(wvs);
  const int lane = tid & 63, r15 = lane & 15, q = lane >> 4;
  const int lrow = tid >> 3, lch = tid & 7;
  const int k_rd = r15 * 128, kswz = r15 >> 1;
  const int qp = r15 >> 2, pp = lane & 3;
  const int fx = ((2 * q + (qp >> 1)) & 3) << 1;
  const int v_rd = (4 * q + qp) * 128 + 8 * (pp & 1) + ((pp >> 1) << 4);
  unsigned int* impu = (unsigned int*)(smem + ATT_IMP);
  const int ksrc = (lch ^ ((lrow >> 1) & 7)) * 8, vsrc = (lch ^ (((lrow >> 1) & 3) << 1)) * 8;
  const int wbase = __builtin_amdgcn_readfirstlane(tid >> 6) * 1024;
#define A_GLOAD(TI, BUF) { const half_t* kp_ = kbase + (size_t)((TI) * 64 + lrow) * ld + ksrc; \
    __builtin_amdgcn_global_load_lds((gbl_void*)kp_, (lds_void*)(smem + ATT_K + (BUF) * 8192 + wbase), 16, 0, 0); \
    { const half_t* vp_ = vbase + (size_t)((TI) * 64 + lrow) * ld + vsrc; \
      __builtin_amdgcn_global_load_lds((gbl_void*)vp_, (lds_void*)(smem + ATT_V + (BUF) * 8192 + wbase), 16, 0, 0); } }
  constexpr int GPT = 2;
  f32x4 lacc[2] = {(f32x4){0.f, 0.f, 0.f, 0.f}, (f32x4){0.f, 0.f, 0.f, 0.f}};
  if (MODE != 1 && !PREISSUED) {
#pragma unroll
    for (int i = 0; i < ATT_D; ++i) if (tile_lo + i <= tile_hi) A_GLOAD(tile_lo + i, i)
  }
#pragma unroll 1
  for (int ti = tile_lo; ti <= tile_hi; ++ti) {
    const int it = ti - tile_lo, cur = it % ATT_NB;
    if (MODE != 1) {
      const int rem = tile_hi - ti;
      if (rem >= 4) wait_vmcnt<4 * GPT>(); else if (rem == 3) wait_vmcnt<3 * GPT>(); else if (rem == 2) wait_vmcnt<2 * GPT>();
      else if (rem == 1) wait_vmcnt<1 * GPT>(); else wait_vmcnt<0>();
    }
    __builtin_amdgcn_s_barrier();
    if (MODE != 1) { if (ti + ATT_D <= tile_hi) A_GLOAD(ti + ATT_D, (it + ATT_D) % ATT_NB) }
    const char* kb = smem + ATT_K + cur * 8192 + k_rd;
    const unsigned vbl = (unsigned)(size_t)(smem + ATT_V + cur * 8192 + v_rd);
    bool need_mask;
    if (MODE <= 1) need_mask = (ti * 64 + 63 > 4 * n - 2);
    else if (MODE == 2) need_mask = (ti == n);
    else need_mask = (ti == n) || (ti == n - 8);
    f32x4 s[4][2];
#pragma unroll
    for (int t2 = 0; t2 < 2; ++t2) {
      float c0 = 0.f;
      if (MODE >= 2) { c0 = -m[t2]; if (MODE == 2 && !((selm[t2] >> ti) & 1ull)) c0 = -INFINITY; }
#pragma unroll
      for (int kf = 0; kf < 4; ++kf) s[kf][t2] = (f32x4){c0, c0, c0, c0};
    }
#pragma unroll
    for (int ks = 0; ks < 2; ++ks) {
      const int co = ((4 * ks + q) ^ kswz) << 4;
#pragma unroll
      for (int kf = 0; kf < 4; ++kf) {
        const half8 kfr = *(const half8*)(kb + kf * 2048 + co);
#pragma unroll
        for (int t2 = 0; t2 < 2; ++t2) s[kf][t2] = __builtin_amdgcn_mfma_f32_16x16x32_f16(kfr, qf[t2][ks], s[kf][t2], 0, 0, 0);
      }
    }
    v2i vr[4][4];
    if (MODE != 0) {
      const unsigned va0 = vbl + (((0) ^ fx) << 4), va1 = vbl + (((2) ^ fx) << 4), va2 = vbl + (((4) ^ fx) << 4), va3 = vbl + (((6) ^ fx) << 4);
      asm volatile(
          "ds_read_b64_tr_b16 %0, %16\n\tds_read_b64_tr_b16 %1, %16 offset:2048\n\tds_read_b64_tr_b16 %2, %16 offset:4096\n\tds_read_b64_tr_b16 %3, %16 offset:6144\n\t"
          "ds_read_b64_tr_b16 %4, %17\n\tds_read_b64_tr_b16 %5, %17 offset:2048\n\tds_read_b64_tr_b16 %6, %17 offset:4096\n\tds_read_b64_tr_b16 %7, %17 offset:6144\n\t"
          "ds_read_b64_tr_b16 %8, %18\n\tds_read_b64_tr_b16 %9, %18 offset:2048\n\tds_read_b64_tr_b16 %10, %18 offset:4096\n\tds_read_b64_tr_b16 %11, %18 offset:6144\n\t"
          "ds_read_b64_tr_b16 %12, %19\n\tds_read_b64_tr_b16 %13, %19 offset:2048\n\tds_read_b64_tr_b16 %14, %19 offset:4096\n\tds_read_b64_tr_b16 %15, %19 offset:6144"
          : "=&v"(vr[0][0]), "=&v"(vr[0][1]), "=&v"(vr[0][2]), "=&v"(vr[0][3]), "=&v"(vr[1][0]), "=&v"(vr[1][1]), "=&v"(vr[1][2]), "=&v"(vr[1][3]),
            "=&v"(vr[2][0]), "=&v"(vr[2][1]), "=&v"(vr[2][2]), "=&v"(vr[2][3]), "=&v"(vr[3][0]), "=&v"(vr[3][1]), "=&v"(vr[3][2]), "=&v"(vr[3][3])
          : "v"(va0), "v"(va1), "v"(va2), "v"(va3)
          : "memory");
    }
    if (need_mask) {
#pragma unroll
      for (int t2 = 0; t2 < 2; ++t2) {
        const int tok = th * 32 + t2 * 16 + r15;
        int lo = 0, hi = 63;
        if (MODE <= 1) { hi = 4 * n + ((tok - 31) >> 4) - ti * 64; }
        else if (MODE == 2) { hi = tok; }
        else { if (ti == n) hi = tok; else lo = tok + 1; }
#pragma unroll
        for (int kf = 0; kf < 4; ++kf)
#pragma unroll
          for (int r = 0; r < 4; ++r) {
            const int kk = kf * 16 + 4 * q + r;
            if (kk < lo || kk > hi) s[kf][t2][r] = -INFINITY;
          }
      }
    }
    half8 pf[2][2];
#pragma unroll
    for (int t2 = 0; t2 < 2; ++t2) {
      float mb = 0.f, scale_p = 1.f;
      if (MODE == 1) {
        mb = m[t2]; scale_p = l[t2];
      } else if (MODE == 0) {
        float tm = s[0][t2][0];
#pragma unroll
        for (int kf = 0; kf < 4; ++kf)
#pragma unroll
          for (int r = 0; r < 4; ++r) tm = fmaxf(tm, s[kf][t2][r]);
        tm = rowmax4(tm);
        const float mn = fmaxf(m[t2], tm);
        const float alpha = fexp2(m[t2] - mn);
        m[t2] = mn; mb = mn;
        l[t2] *= alpha;
      }
      float lsum = 0.f;
#pragma unroll
      for (int kf = 0; kf < 4; ++kf) {
#pragma unroll
        for (int r = 0; r < 4; ++r) {
          float pv = (MODE >= 2) ? fexp2(s[kf][t2][r]) : fexp2(s[kf][t2][r] - mb);
          if (MODE == 1) pv *= scale_p;
          s[kf][t2][r] = pv; if (MODE == 0) lsum += pv;
        }
      }
      if (MODE == 0) l[t2] += lsum;
      if (MODE == 1) {
        const int tok = th * 32 + t2 * 16 + r15;
#pragma unroll
        for (int kf = 0; kf < 4; ++kf) {
          const int j = 16 * ti + 4 * kf + q;
          const unsigned int u0 = (unsigned int)(s[kf][t2][0] * 134217728.f + 0.5f), u1 = (unsigned int)(s[kf][t2][1] * 134217728.f + 0.5f);
          const unsigned int u2 = (unsigned int)(s[kf][t2][2] * 134217728.f + 0.5f), u3 = (unsigned int)(s[kf][t2][3] * 134217728.f + 0.5f);
          if (j < 64) {
            atomicAdd(&impu[tok * IMPS + j], u0 + u1 + u2 + u3);
            atomicAdd(&impu[tok * IMPS + j + 1], u3);
          }
        }
      }
      if (MODE != 0) {
#pragma unroll
        for (int ks = 0; ks < 2; ++ks) {
          half8 pk;
#pragma unroll
          for (int r = 0; r < 4; ++r) { pk[r] = (half_t)s[2 * ks][t2][r]; pk[4 + r] = (half_t)s[2 * ks + 1][t2][r]; }
          pf[t2][ks] = pk;
        }
      }
    }
    if (MODE != 0) {
      asm volatile("s_waitcnt lgkmcnt(0)"
                   : "+v"(vr[0][0]), "+v"(vr[0][1]), "+v"(vr[0][2]), "+v"(vr[0][3]), "+v"(vr[1][0]), "+v"(vr[1][1]), "+v"(vr[1][2]), "+v"(vr[1][3]),
                     "+v"(vr[2][0]), "+v"(vr[2][1]), "+v"(vr[2][2]), "+v"(vr[2][3]), "+v"(vr[3][0]), "+v"(vr[3][1]), "+v"(vr[3][2]), "+v"(vr[3][3])
                   :: "memory");
      __builtin_amdgcn_sched_barrier(0);
#pragma unroll
      for (int df = 0; df < 4; ++df) {
#pragma unroll
        for (int ks = 0; ks < 2; ++ks) {
          const v2i lo2 = vr[df][2 * ks], hi2 = vr[df][2 * ks + 1];
          const v4i pk4 = (v4i){lo2[0], lo2[1], hi2[0], hi2[1]};
          const half8 vf = __builtin_bit_cast(half8, pk4);
#pragma unroll
          for (int t2 = 0; t2 < 2; ++t2) o[df][t2] = __builtin_amdgcn_mfma_f32_16x16x32_f16(vf, pf[t2][ks], o[df][t2], 0, 0, 0);
        }
      }
      if (MODE >= 2) {
        const half8 ones = (half8){(half_t)1.f, (half_t)1.f, (half_t)1.f, (half_t)1.f, (half_t)1.f, (half_t)1.f, (half_t)1.f, (half_t)1.f};
#pragma unroll
        for (int ks = 0; ks < 2; ++ks)
#pragma unroll
          for (int t2 = 0; t2 < 2; ++t2) lacc[t2] = __builtin_amdgcn_mfma_f32_16x16x32_f16(ones, pf[t2][ks], lacc[t2], 0, 0, 0);
      }
    }
  }
  if (MODE >= 2) { l[0] = lacc[0][0]; l[1] = lacc[1][0]; }
  __syncthreads();
#undef A_GLOAD
}

__device__ __forceinline__ void attn_cmp(char* smem, int tile_hi, int n, int th, const half8 (&qf)[2][2], const float (&moff)[2], f32x4 (&o)[4][2], int wvs) {
  const int tid = otid(wvs);
  const int lane = tid & 63, r15 = lane & 15, q = lane >> 4;
  const int k_rd = r15 * 128, kswz = r15 >> 1;
  const int qp = r15 >> 2, pp = lane & 3;
  const int fx = ((2 * q + (qp >> 1)) & 3) << 1;
  const int v_rd = (4 * q + qp) * 128 + 8 * (pp & 1) + ((pp >> 1) << 4);
  unsigned int* impu = (unsigned int*)(smem + ATT_IMP);
  float lsum[2] = {0.f, 0.f};
  float usum[4][4][2], carry[2] = {0.f, 0.f};
#pragma unroll
  for (int ti = 0; ti < 4; ++ti) {
    if (ti <= tile_hi) {
      const int rem = tile_hi - ti;
      if (rem >= 3) wait_vmcnt<6>(); else if (rem == 2) wait_vmcnt<4>(); else if (rem == 1) wait_vmcnt<2>(); else wait_vmcnt<0>();
      __builtin_amdgcn_s_barrier();
      const char* kb = smem + ATT_K + ti * 8192 + k_rd;
      const unsigned vbl = (unsigned)(size_t)(smem + ATT_V + ti * 8192 + v_rd);
      f32x4 s[4][2];
#pragma unroll
      for (int t2 = 0; t2 < 2; ++t2) {
        const float c0 = -moff[t2];
#pragma unroll
        for (int kf = 0; kf < 4; ++kf) s[kf][t2] = (f32x4){c0, c0, c0, c0};
      }
#pragma unroll
      for (int ks = 0; ks < 2; ++ks) {
        const int co = ((4 * ks + q) ^ kswz) << 4;
#pragma unroll
        for (int kf = 0; kf < 4; ++kf) {
          const half8 kfr = *(const half8*)(kb + kf * 2048 + co);
#pragma unroll
          for (int t2 = 0; t2 < 2; ++t2) s[kf][t2] = __builtin_amdgcn_mfma_f32_16x16x32_f16(kfr, qf[t2][ks], s[kf][t2], 0, 0, 0);
        }
      }
      if (ti * 64 + 63 > 4 * n - 2) {
#pragma unroll
        for (int t2 = 0; t2 < 2; ++t2) {
          const int tok = th * 32 + t2 * 16 + r15;
          const int hi = 4 * n + ((tok - 31) >> 4) - ti * 64;
#pragma unroll
          for (int kf = 0; kf < 4; ++kf)
#pragma unroll
            for (int r = 0; r < 4; ++r) if (kf * 16 + 4 * q + r > hi) s[kf][t2][r] = -INFINITY;
        }
      }
      half8 pf[2][2];
#pragma unroll
      for (int t2 = 0; t2 < 2; ++t2) {
        float sh[4];
#pragma unroll
        for (int kf = 0; kf < 4; ++kf) {
#pragma unroll
          for (int r = 0; r < 4; ++r) s[kf][t2][r] = fexp2(s[kf][t2][r]);
          sh[kf] = __shfl(s[kf][t2][3], (lane + 48) & 63);
        }
#pragma unroll
        for (int kf = 0; kf < 4; ++kf) {
          const float u = (s[kf][t2][0] + s[kf][t2][1]) + (s[kf][t2][2] + s[kf][t2][3]);
          const float prev = q > 0 ? sh[kf] : (kf > 0 ? sh[kf - 1] : carry[t2]);
          usum[ti][kf][t2] = u + prev;
          lsum[t2] += u;
        }
        carry[t2] = sh[3];
#pragma unroll
        for (int ks = 0; ks < 2; ++ks) {
          half8 pk;
#pragma unroll
          for (int r = 0; r < 4; ++r) { pk[r] = (half_t)s[2 * ks][t2][r]; pk[4 + r] = (half_t)s[2 * ks + 1][t2][r]; }
          pf[t2][ks] = pk;
        }
      }
      v2i vr[4][4];
      {
        const unsigned va0 = vbl + (((0) ^ fx) << 4), va1 = vbl + (((2) ^ fx) << 4), va2 = vbl + (((4) ^ fx) << 4), va3 = vbl + (((6) ^ fx) << 4);
        asm volatile(
            "ds_read_b64_tr_b16 %0, %16\n\tds_read_b64_tr_b16 %1, %16 offset:2048\n\tds_read_b64_tr_b16 %2, %16 offset:4096\n\tds_read_b64_tr_b16 %3, %16 offset:6144\n\t"
            "ds_read_b64_tr_b16 %4, %17\n\tds_read_b64_tr_b16 %5, %17 offset:2048\n\tds_read_b64_tr_b16 %6, %17 offset:4096\n\tds_read_b64_tr_b16 %7, %17 offset:6144\n\t"
            "ds_read_b64_tr_b16 %8, %18\n\tds_read_b64_tr_b16 %9, %18 offset:2048\n\tds_read_b64_tr_b16 %10, %18 offset:4096\n\tds_read_b64_tr_b16 %11, %18 offset:6144\n\t"
            "ds_read_b64_tr_b16 %12, %19\n\tds_read_b64_tr_b16 %13, %19 offset:2048\n\tds_read_b64_tr_b16 %14, %19 offset:4096\n\tds_read_b64_tr_b16 %15, %19 offset:6144"
            : "=&v"(vr[0][0]), "=&v"(vr[0][1]), "=&v"(vr[0][2]), "=&v"(vr[0][3]), "=&v"(vr[1][0]), "=&v"(vr[1][1]), "=&v"(vr[1][2]), "=&v"(vr[1][3]),
              "=&v"(vr[2][0]), "=&v"(vr[2][1]), "=&v"(vr[2][2]), "=&v"(vr[2][3]), "=&v"(vr[3][0]), "=&v"(vr[3][1]), "=&v"(vr[3][2]), "=&v"(vr[3][3])
            : "v"(va0), "v"(va1), "v"(va2), "v"(va3)
            : "memory");
      }
      asm volatile("s_waitcnt lgkmcnt(0)"
                   : "+v"(vr[0][0]), "+v"(vr[0][1]), "+v"(vr[0][2]), "+v"(vr[0][3]), "+v"(vr[1][0]), "+v"(vr[1][1]), "+v"(vr[1][2]), "+v"(vr[1][3]),
                     "+v"(vr[2][0]), "+v"(vr[2][1]), "+v"(vr[2][2]), "+v"(vr[2][3]), "+v"(vr[3][0]), "+v"(vr[3][1]), "+v"(vr[3][2]), "+v"(vr[3][3])
                   :: "memory");
      __builtin_amdgcn_sched_barrier(0);
#pragma unroll
      for (int df = 0; df < 4; ++df)
#pragma unroll
        for (int ks = 0; ks < 2; ++ks) {
          const v2i lo2 = vr[df][2 * ks], hi2 = vr[df][2 * ks + 1];
          const v4i pk4 = (v4i){lo2[0], lo2[1], hi2[0], hi2[1]};
          const half8 vf = __builtin_bit_cast(half8, pk4);
#pragma unroll
          for (int t2 = 0; t2 < 2; ++t2) o[df][t2] = __builtin_amdgcn_mfma_f32_16x16x32_f16(vf, pf[t2][ks], o[df][t2], 0, 0, 0);
        }
    }
  }
#pragma unroll
  for (int t2 = 0; t2 < 2; ++t2) {
    const float lt = rowsum4(lsum[t2]);
    const float inv = lt > 0.f ? 1.f / lt : 0.f;
#pragma unroll
    for (int df = 0; df < 4; ++df) o[df][t2] *= inv;
    const int tok = th * 32 + t2 * 16 + r15;
    const float isc = inv * 134217728.f;
#pragma unroll
    for (int ti = 0; ti < 4; ++ti) {
      if (ti <= tile_hi) {
#pragma unroll
        for (int kf = 0; kf < 4; ++kf) {
          const int j = 16 * ti + 4 * kf + q;
          if (j < 64) atomicAdd(&impu[tok * IMPS + j], (unsigned int)(usum[ti][kf][t2] * isc + 0.5f));
        }
      }
    }
  }
  __syncthreads();
}

template <int MODE, bool PREISSUED>
__device__ __forceinline__ void attn_branch_pp(char* smem, const half_t* kbase, const half_t* vbase, int ld, int tile_lo, int tile_hi, int n, int th,
                                               const half8 (&qf)[2][2], const float (&m)[2], float (&l)[2], f32x4 (&o)[4][2],
                                               const unsigned long long (&selm)[2], int wvs, int rot) {
  const int tid = otid(wvs);
  const int lane = tid & 63, r15 = lane & 15, q = lane >> 4;
  const int lrow = tid >> 3, lch = tid & 7;
  const int k_rd = r15 * 128, kswz = r15 >> 1;
  const int qp = r15 >> 2, pp = lane & 3;
  const int fx = ((2 * q + (qp >> 1)) & 3) << 1;
  const int v_rd = (4 * q + qp) * 128 + 8 * (pp & 1) + ((pp >> 1) << 4);
  const int ksrc = (lch ^ ((lrow >> 1) & 7)) * 8, vsrc = (lch ^ (((lrow >> 1) & 3) << 1)) * 8;
  const int wbase = __builtin_amdgcn_readfirstlane(tid >> 6) * 1024;
#define A_GLOAD(TI, BUF) { const half_t* kp_ = kbase + (size_t)((TI) * 64 + lrow) * ld + ksrc; \
    __builtin_amdgcn_global_load_lds((gbl_void*)kp_, (lds_void*)(smem + ATT_K + (BUF) * 8192 + wbase), 16, 0, 0); \
    { const half_t* vp_ = vbase + (size_t)((TI) * 64 + lrow) * ld + vsrc; \
      __builtin_amdgcn_global_load_lds((gbl_void*)vp_, (lds_void*)(smem + ATT_V + (BUF) * 8192 + wbase), 16, 0, 0); } }
#define PP_BAR { __builtin_amdgcn_sched_barrier(0); __builtin_amdgcn_s_barrier(); __builtin_amdgcn_sched_barrier(0); }
  const int nt = tile_hi - tile_lo + 1;
  f32x4 lacc[2] = {(f32x4){0.f, 0.f, 0.f, 0.f}, (f32x4){0.f, 0.f, 0.f, 0.f}};
  if (!PREISSUED) {
#pragma unroll
    for (int i = 0; i < ATT_D; ++i) if (i < nt) A_GLOAD(tile_lo + ((rot + i >= nt) ? rot + i - nt : rot + i), i)
  }
  { const int r = nt - 1;
    if (r >= 4) wait_vmcnt<8>(); else if (r == 3) wait_vmcnt<6>(); else if (r == 2) wait_vmcnt<4>(); else if (r == 1) wait_vmcnt<2>(); else wait_vmcnt<0>(); }
  half8 pf[2][2];
  v2i vr[4][4];
#pragma unroll
  for (int a = 0; a < 2; ++a)
#pragma unroll
    for (int b = 0; b < 2; ++b) pf[a][b] = (half8){(half_t)0.f, (half_t)0.f, (half_t)0.f, (half_t)0.f, (half_t)0.f, (half_t)0.f, (half_t)0.f, (half_t)0.f};
#pragma unroll
  for (int a = 0; a < 4; ++a)
#pragma unroll
    for (int b = 0; b < 4; ++b) vr[a][b] = (v2i){0, 0};
  const half8 ones = (half8){(half_t)1.f, (half_t)1.f, (half_t)1.f, (half_t)1.f, (half_t)1.f, (half_t)1.f, (half_t)1.f, (half_t)1.f};
#define PP_PV { _Pragma("unroll") for (int df = 0; df < 4; ++df) _Pragma("unroll") for (int ks = 0; ks < 2; ++ks) { \
      const v2i lo2 = vr[df][2 * ks], hi2 = vr[df][2 * ks + 1]; const v4i pk4 = (v4i){lo2[0], lo2[1], hi2[0], hi2[1]}; const half8 vf = __builtin_bit_cast(half8, pk4); \
      _Pragma("unroll") for (int t2 = 0; t2 < 2; ++t2) o[df][t2] = __builtin_amdgcn_mfma_f32_16x16x32_f16(vf, pf[t2][ks], o[df][t2], 0, 0, 0); } \
    _Pragma("unroll") for (int ks = 0; ks < 2; ++ks) _Pragma("unroll") for (int t2 = 0; t2 < 2; ++t2) lacc[t2] = __builtin_amdgcn_mfma_f32_16x16x32_f16(ones, pf[t2][ks], lacc[t2], 0, 0, 0); }
  __builtin_amdgcn_sched_barrier(0);
  if (th == 1) __builtin_amdgcn_s_barrier();
  __builtin_amdgcn_sched_barrier(0);
  int trel = rot, tpf = rot + ATT_D; while (tpf >= nt) tpf -= nt;
#pragma unroll 1
  for (int it = 0; it < nt; ++it) {
    const int ti = tile_lo + trel, cur = it % ATT_NB;
    trel = (trel + 1 == nt) ? 0 : trel + 1;
    PP_BAR
    f32x4 s[4][2];
    const char* kb = smem + ATT_K + cur * 8192 + k_rd;
    __builtin_amdgcn_s_setprio(1);
    PP_PV
#pragma unroll
    for (int t2 = 0; t2 < 2; ++t2) {
      float c0 = -m[t2];
      if (MODE == 2 && !((selm[t2] >> ti) & 1ull)) c0 = -INFINITY;
#pragma unroll
      for (int kf = 0; kf < 4; ++kf) s[kf][t2] = (f32x4){c0, c0, c0, c0};
    }
#pragma unroll
    for (int ks = 0; ks < 2; ++ks) {
      const int co = ((4 * ks + q) ^ kswz) << 4;
#pragma unroll
      for (int kf = 0; kf < 4; ++kf) {
        const half8 kfr = *(const half8*)(kb + kf * 2048 + co);
#pragma unroll
        for (int t2 = 0; t2 < 2; ++t2) s[kf][t2] = __builtin_amdgcn_mfma_f32_16x16x32_f16(kfr, qf[t2][ks], s[kf][t2], 0, 0, 0);
      }
    }
    __builtin_amdgcn_s_setprio(0);
    { const int r = nt - 2 - it;
      if (r >= 3) wait_vmcnt<6>(); else if (r == 2) wait_vmcnt<4>(); else if (r == 1) wait_vmcnt<2>(); else wait_vmcnt<0>(); }
    PP_BAR
    if (it + ATT_D < nt) A_GLOAD(tile_lo + tpf, (it + ATT_D) % ATT_NB)
    tpf = (tpf + 1 == nt) ? 0 : tpf + 1;
    {
      const unsigned vbl = (unsigned)(size_t)(smem + ATT_V + cur * 8192 + v_rd);
      const unsigned va0 = vbl + (((0) ^ fx) << 4), va1 = vbl + (((2) ^ fx) << 4), va2 = vbl + (((4) ^ fx) << 4), va3 = vbl + (((6) ^ fx) << 4);
      asm volatile(
          "ds_read_b64_tr_b16 %0, %16\n\tds_read_b64_tr_b16 %1, %16 offset:2048\n\tds_read_b64_tr_b16 %2, %16 offset:4096\n\tds_read_b64_tr_b16 %3, %16 offset:6144\n\t"
          "ds_read_b64_tr_b16 %4, %17\n\tds_read_b64_tr_b16 %5, %17 offset:2048\n\tds_read_b64_tr_b16 %6, %17 offset:4096\n\tds_read_b64_tr_b16 %7, %17 offset:6144\n\t"
          "ds_read_b64_tr_b16 %8, %18\n\tds_read_b64_tr_b16 %9, %18 offset:2048\n\tds_read_b64_tr_b16 %10, %18 offset:4096\n\tds_read_b64_tr_b16 %11, %18 offset:6144\n\t"
          "ds_read_b64_tr_b16 %12, %19\n\tds_read_b64_tr_b16 %13, %19 offset:2048\n\tds_read_b64_tr_b16 %14, %19 offset:4096\n\tds_read_b64_tr_b16 %15, %19 offset:6144"
          : "=&v"(vr[0][0]), "=&v"(vr[0][1]), "=&v"(vr[0][2]), "=&v"(vr[0][3]), "=&v"(vr[1][0]), "=&v"(vr[1][1]), "=&v"(vr[1][2]), "=&v"(vr[1][3]),
            "=&v"(vr[2][0]), "=&v"(vr[2][1]), "=&v"(vr[2][2]), "=&v"(vr[2][3]), "=&v"(vr[3][0]), "=&v"(vr[3][1]), "=&v"(vr[3][2]), "=&v"(vr[3][3])
          : "v"(va0), "v"(va1), "v"(va2), "v"(va3)
          : "memory");
    }
    bool need_mask;
    if (MODE == 2) need_mask = (ti == n); else need_mask = (ti == n) || (ti == n - 8);
    if (need_mask) {
#pragma unroll
      for (int t2 = 0; t2 < 2; ++t2) {
        const int tok = th * 32 + t2 * 16 + r15;
        int lo = 0, hi = 63;
        if (MODE == 2) { hi = tok; }
        else { if (ti == n) hi = tok; else lo = tok + 1; }
#pragma unroll
        for (int kf = 0; kf < 4; ++kf)
#pragma unroll
          for (int r = 0; r < 4; ++r) {
            const int kk = kf * 16 + 4 * q + r;
            if (kk < lo || kk > hi) s[kf][t2][r] = -INFINITY;
          }
      }
    }
#pragma unroll
    for (int t2 = 0; t2 < 2; ++t2) {
#pragma unroll
      for (int kf = 0; kf < 4; ++kf)
#pragma unroll
        for (int r = 0; r < 4; ++r) s[kf][t2][r] = fexp2(s[kf][t2][r]);
#pragma unroll
      for (int ks = 0; ks < 2; ++ks) {
        half8 pk;
#pragma unroll
        for (int r = 0; r < 4; ++r) { pk[r] = (half_t)s[2 * ks][t2][r]; pk[4 + r] = (half_t)s[2 * ks + 1][t2][r]; }
        pf[t2][ks] = pk;
      }
    }
    asm volatile("s_waitcnt lgkmcnt(0)"
                 : "+v"(vr[0][0]), "+v"(vr[0][1]), "+v"(vr[0][2]), "+v"(vr[0][3]), "+v"(vr[1][0]), "+v"(vr[1][1]), "+v"(vr[1][2]), "+v"(vr[1][3]),
                   "+v"(vr[2][0]), "+v"(vr[2][1]), "+v"(vr[2][2]), "+v"(vr[2][3]), "+v"(vr[3][0]), "+v"(vr[3][1]), "+v"(vr[3][2]), "+v"(vr[3][3])
                 :: "memory");
  }
  PP_BAR
  PP_PV
  __builtin_amdgcn_sched_barrier(0);
  if (th == 0) __builtin_amdgcn_s_barrier();
  __builtin_amdgcn_sched_barrier(0);
  l[0] = lacc[0][0]; l[1] = lacc[1][0];
  __syncthreads();
#undef A_GLOAD
#undef PP_BAR
#undef PP_PV
}

__device__ void ph_attn_mfma(const Params& P, char* smem, int wvs) {
  unsigned int* impu = (unsigned int*)(smem + ATT_IMP);
  unsigned long long* selmask = (unsigned long long*)(smem + ATT_SELM);
  const int G = gridDim.x, nrounds = (2048 + G - 1) / G;
  for (int rd = 0; rd < nrounds; ++rd) {
    const int idx = rd * G + ((rd & 1) ? (G - 1 - (int)blockIdx.x) : (int)blockIdx.x);
    if (idx >= 2048) continue;
    const int tid = otid(wvs), lane = tid & 63, r15 = lane & 15, q = lane >> 4;
    const int n = 63 - (idx >> 5), bg = idx & 31, b = bg >> 2, g = bg & 3;
    const int wv = __builtin_amdgcn_readfirstlane(otid(wvs) >> 6);
    const int hd = g * 4 + (wv & 3), th = wv >> 2;
    const int t0 = b * SEQ + n * 64 + th * 32;
    const half_t* kc = P.kcmp + (size_t)bg * 256 * 64;
    const half_t* vc = P.vcmp + (size_t)bg * 256 * 64;
    const int nct = (4 * n + 2) / 64;
    attn_issue(smem, kc, vc, 64, 0, nct, wvs);
    half8 qf[2][2];
#pragma unroll
    for (int t2 = 0; t2 < 2; ++t2)
#pragma unroll
      for (int ks = 0; ks < 2; ++ks) qf[t2][ks] = *(const half8*)(P.p + (size_t)(t0 + t2 * 16 + r15) * LD1 + hd * 64 + 32 * ks + 8 * q);
    float* gate_l = (float*)(smem + ATT_GATE) + wv * 128;
    if (q == 0) {
#pragma unroll
      for (int t2 = 0; t2 < 2; ++t2) {
        const float* pr = P.gl + (size_t)(t0 + t2 * 16 + r15) * 48 + hd * 3;
        f32x4 gv;
#pragma unroll
        for (int c = 0; c < 3; ++c) gv[c] = sigmoidf(pr[c] + P.nsa_b_gate[hd * 3 + c]);
        gv[3] = 0.f;
        *(f32x4*)(gate_l + (t2 * 16 + r15) * 4) = gv;
      }
    }
    { const int tz = otid(wvs); for (int i = tz; i < 64 * IMPS + 128; i += NTHREADS) impu[i] = 0u; }
    float m[2], l[2]; f32x4 o[4][2]; unsigned long long selm[2] = {0ull, 0ull};
#pragma unroll
    for (int t2 = 0; t2 < 2; ++t2) { m[t2] = -1e30f; l[t2] = 0.f; }
#pragma unroll
    for (int df = 0; df < 4; ++df)
#pragma unroll
      for (int t2 = 0; t2 < 2; ++t2) o[df][t2] = (f32x4){0.f, 0.f, 0.f, 0.f};
    float qn2[2];
#pragma unroll
    for (int t2 = 0; t2 < 2; ++t2) {
      float a = 0.f;
#pragma unroll
      for (int ks = 0; ks < 2; ++ks)
#pragma unroll
        for (int e = 0; e < 8; ++e) a += (float)qf[t2][ks][e] * (float)qf[t2][ks][e];
      qn2[t2] = rowsum4(a);
    }
    { const float kmc = __uint_as_float(P.kmax2[64 + bg]);
#pragma unroll
      for (int t2 = 0; t2 < 2; ++t2) m[t2] = sqrtf(qn2[t2] * kmc) * 1.001f - 5.0f * LOG2E; }
    attn_cmp(smem, nct, n, th, qf, m, o, wvs);
    f32x4 oacc[4][2];
#pragma unroll
    for (int t2 = 0; t2 < 2; ++t2) {
      const float gc = gate_l[(t2 * 16 + r15) * 4 + 0];
#pragma unroll
      for (int df = 0; df < 4; ++df) oacc[df][t2] = o[df][t2] * gc;
    }
    {
      const int tz = otid(wvs), lz = tz & 63;
#pragma unroll
      for (int i = 0; i < 4; ++i) {
        const int slab = i * 8 + wv, tokz = slab * 2 + (lz >> 5), cz = (lz & 31) ^ (tokz & 15);
        const half_t* zp = P.p + (size_t)(b * SEQ + n * 64 + tokz) * LD1 + 2560 + g * 256 + cz * 8;
        __builtin_amdgcn_global_load_lds((gbl_void*)zp, (lds_void*)(smem + ATT_Z + slab * 1024), 16, 0, 0);
      }
    }
    const int shr = ((int)blockIdx.x >> 5) & 7;
    const int rot_s = (shr * (n + 1)) >> 3;
    attn_issue(smem, P.p + (size_t)b * SEQ * LD1 + 1536 + g * 64, P.p + (size_t)b * SEQ * LD1 + 1792 + g * 64, LD1, 0, n, wvs, rot_s);
    {
      const int tid2 = otid(wvs);
      const int tok = tid2 >> 3, part = tid2 & 7;
      unsigned long long msk;
      if (n + 1 <= 16) {
        msk = (1ull << (n + 1)) - 1ull;
      } else {
        const uint4* rowp = (const uint4*)(impu + tok * IMPS);
        unsigned own[8];
        { const uint4 a = rowp[part * 2], b2 = rowp[part * 2 + 1];
          own[0] = a.x; own[1] = a.y; own[2] = a.z; own[3] = a.w; own[4] = b2.x; own[5] = b2.y; own[6] = b2.z; own[7] = b2.w; }
        int rank[8];
#pragma unroll
        for (int jj = 0; jj < 8; ++jj) {
          const int j = part * 8 + jj;
          own[jj] = (j >= 1 && j <= n - 2) ? ((own[jj] & ~63u) | (unsigned)(63 - j)) : 0xffffffffu;
          rank[jj] = 0;
        }
#pragma unroll 2
        for (int c4 = 0; c4 < ((n - 2) >> 2) + 1; ++c4) {
          const uint4 v = rowp[c4];
          unsigned kv[4] = {v.x, v.y, v.z, v.w};
#pragma unroll
          for (int e = 0; e < 4; ++e) {
            const int j2 = c4 * 4 + e;
            const unsigned key2 = (j2 >= 1 && j2 <= n - 2) ? ((kv[e] & ~63u) | (unsigned)(63 - j2)) : 0u;
#pragma unroll
            for (int jj = 0; jj < 8; ++jj) rank[jj] += (key2 > own[jj]) ? 1 : 0;
          }
        }
        unsigned int bits = 0;
#pragma unroll
        for (int jj = 0; jj < 8; ++jj) if (rank[jj] < 13 && own[jj] != 0xffffffffu) bits |= 1u << jj;
        unsigned* sel32 = (unsigned*)selmask;
        if (bits) atomicOr(&sel32[tok * 2 + (part >> 2)], bits << (8 * (part & 3)));
        msk = 1ull | (1ull << n) | (1ull << (n - 1));
        if (part == 0) { atomicOr(&sel32[tok * 2], (unsigned)msk); atomicOr(&sel32[tok * 2 + 1], (unsigned)(msk >> 32)); }
      }
      if (n + 1 <= 16 && part == 0) selmask[tok] = msk;
    }
    __syncthreads();
#pragma unroll
    for (int t2 = 0; t2 < 2; ++t2) selm[t2] = selmask[th * 32 + t2 * 16 + r15];
    { const float km = __uint_as_float(P.kmax2[bg * 2 + 0]);
#pragma unroll
      for (int t2 = 0; t2 < 2; ++t2) { m[t2] = sqrtf(qn2[t2] * km) * 1.001f - 5.0f * LOG2E; l[t2] = 0.f; } }
#pragma unroll
    for (int df = 0; df < 4; ++df)
#pragma unroll
      for (int t2 = 0; t2 < 2; ++t2) o[df][t2] = (f32x4){0.f, 0.f, 0.f, 0.f};
    attn_branch_pp<2, true>(smem, P.p + (size_t)b * SEQ * LD1 + 1536 + g * 64, P.p + (size_t)b * SEQ * LD1 + 1792 + g * 64, LD1, 0, n, n, th, qf, m, l, o, selm, wvs, rot_s);
#pragma unroll
    for (int t2 = 0; t2 < 2; ++t2) {
      const float gs = gate_l[(t2 * 16 + r15) * 4 + 1] / l[t2];
#pragma unroll
      for (int df = 0; df < 4; ++df) oacc[df][t2] += o[df][t2] * gs;
    }
    { const float km = __uint_as_float(P.kmax2[bg * 2 + 1]);
#pragma unroll
      for (int t2 = 0; t2 < 2; ++t2) { m[t2] = sqrtf(qn2[t2] * km) * 1.001f - 5.0f * LOG2E; l[t2] = 0.f; } }
#pragma unroll
    for (int df = 0; df < 4; ++df)
#pragma unroll
      for (int t2 = 0; t2 < 2; ++t2) o[df][t2] = (f32x4){0.f, 0.f, 0.f, 0.f};
    attn_branch_pp<3, false>(smem, P.p + (size_t)b * SEQ * LD1 + 2048 + g * 64, P.p + (size_t)b * SEQ * LD1 + 2304 + g * 64, LD1, (n > 8 ? n - 8 : 0), n, n, th, qf, m, l, o, selm, wvs, ((7 - shr) * (n > 8 ? 9 : n + 1)) >> 3);
    {
      int tbase = t0 + r15; asm volatile("" : "+v"(tbase));
#pragma unroll
      for (int t2 = 0; t2 < 2; ++t2) {
        const size_t tok = (size_t)(tbase + t2 * 16);
        const float gw = gate_l[(t2 * 16 + r15) * 4 + 2] / l[t2];
#pragma unroll
        for (int df = 0; df < 4; ++df) {
          const f32x4 v = oacc[df][t2] + o[df][t2] * gw;
          const int tokl = th * 32 + t2 * 16 + r15, cz = (wv & 3) * 8 + df * 2 + (q >> 1);
          const half4 z = *(const half4*)(smem + ATT_Z + tokl * 512 + ((cz ^ (tokl & 15)) << 4) + (q & 1) * 8);
          half4 hv;
#pragma unroll
          for (int e = 0; e < 4; ++e) hv[e] = (half_t)(v[e] * siluf((float)z[e]));
          *(half4*)(P.og + tok * DM + hd * 64 + df * 16 + 4 * q) = hv;
        }
      }
    }
  }
}

constexpr int NPHASES = 13;
__device__ __forceinline__ void run_phase(int ph, const Params& P, char* smem, int wvs) {
  float* sm = (float*)smem;
  switch (ph) {
    case 0:
      if (blockIdx.x == 0 && otid(wvs) < 192) P.kmax2[otid(wvs)] = 0u;
      ph_xh_rstd(P.x, P.xh, P.rstd, wvs); ph_ropetab(P, wvs); prep_cbias_part(P, wvs);
      prep_weights(P, sm, wvs);
      prep_wT(P.nsa_w_in, NSA_IN, P.pre_norm + DM, P.WglT, 64, DM, 5, sm, wvs);
      prep_wT(P.gla_w_in, GLA_IN, P.pre_norm, P.WglrT, 64, DM, 6, sm, wvs);
      break;
    case 1:
      g8::gemm(g8::SrcPlain8{P.xh, DM, P.W0t, DM}, T_TOK, LD0, DM, g8::EpiStore8{P.p, LD0, P.rstd}, smem, wvs);
      ph_rowproj<1>(P, P.WglrT, P.glr, smem, wvs, 0);
      break;
    case 2: prep_cbias_reduce(P, wvs); ph_gla_prep(P, sm, wvs); break;
    case 13: ph_gla_mfma<true>(P, smem, wvs); break;
    case 3: ph_gla_mfma<false>(P, smem, wvs); break;
    case 4: ph_gla_post(P, wvs); break;
    case 5: g8::gemm(g8::SrcPlain8{P.og, DM, P.Wo0t, DM}, T_TOK, DM, DM, g8::EpiStore8{P.y, DM, nullptr}, smem, wvs); break;
    case 6: ph_post<false>(P.xh, P.y, P.post_norm, nullptr, P.xh, P.rstd, wvs); break;
    case 7: g8::gemm(g8::SrcPlain8{P.xh, DM, P.W1t, DM}, T_TOK, LD1, DM, g8::EpiRope8{P.p, LD1, P.rstd, P.ropetab}, smem, wvs); break;
    case 8: {
      if (blockIdx.x >= 128) { ph_kmax(P, wvs, 128); ph_rowproj<3>(P, P.WglT, P.gl, smem, wvs, 128); }
      g8::gemm(g8::SrcCmp1h8{P.p, P.cw1t}, 16384, 512, 1024, g8::EpiCmpPart8{P.part, P.kmax2 + 128}, smem, wvs);
      if (blockIdx.x < 64) {
        const int tid = otid(wvs);
        const int pm2 = ((int)blockIdx.x & 7) * 8 + ((int)blockIdx.x >> 3);
        if (tid == 0) {
          while (__hip_atomic_load(P.kmax2 + 128 + pm2, __ATOMIC_RELAXED, __HIP_MEMORY_SCOPE_AGENT) < 2u) { }
          __builtin_amdgcn_fence(__ATOMIC_ACQUIRE, "agent");
        }
        __syncthreads();
        const int cg = tid & 31, rr = tid >> 5;
        const float* bp = P.cbias + (pm2 >> 5) * 256 + cg * 8;
        const f32x4 b0 = *(const f32x4*)bp, b1 = *(const f32x4*)(bp + 4);
        const half_t* pa = P.part + (size_t)pm2 * 256 * 256 + cg * 8;
        const half_t* pb = P.part + (size_t)16384 * 256 + (size_t)pm2 * 256 * 256 + cg * 8;
        half_t* hp = P.hid + (size_t)pm2 * 256 * 256 + cg * 8;
#pragma unroll 1
        for (int r0 = 0; r0 < 256; r0 += 64) {
          half8 av[4], bv[4];
#pragma unroll
          for (int i = 0; i < 4; ++i) {
            const int c = r0 + i * 16 + rr, c1 = c < 255 ? c + 1 : 255;
            av[i] = *(const half8*)(pa + (size_t)c * 256); bv[i] = *(const half8*)(pb + (size_t)c1 * 256);
          }
#pragma unroll
          for (int i = 0; i < 4; ++i) {
            const int c = r0 + i * 16 + rr;
            half8 hv;
#pragma unroll
            for (int e = 0; e < 8; ++e) hv[e] = (half_t)siluf((float)av[i][e] + (float)bv[i][e] + (e < 4 ? b0[e] : b1[e - 4]));
            *(half8*)(hp + (size_t)c * 256) = hv;
          }
        }
      }
      asm volatile("s_waitcnt vmcnt(0)" ::: "memory");
      __syncthreads();
      g8::gemm(g8::SrcCmp2_8{P.hid, P.cw2t}, 16384, 256, 256, g8::EpiCmpOut8{P.kcmp, P.vcmp, P.kmax2 + 64}, smem, wvs);
      break;
    }
    case 10: ph_attn_mfma(P, smem, wvs); break;
    case 11: g8::gemm(g8::SrcPlain8{P.og, DM, P.Wo1t, DM}, T_TOK, DM, DM, g8::EpiStore8{P.y, DM, nullptr}, smem, wvs); break;
    case 12: ph_post<true>(P.x1h, P.y, P.post_norm + DM, P.out, nullptr, nullptr, wvs); break;
  }
}

template <int PH>
__global__ void __launch_bounds__(NTHREADS, 2) k_phase(Params P) {
  __shared__ __attribute__((aligned(16))) char smem[SMEM_BYTES];
  run_phase(PH, P, smem, __builtin_amdgcn_readfirstlane(threadIdx.x >> 6));
}
template <int PH>
static void launch_phases(const Params& P, hipStream_t stream) {
  hipLaunchKernelGGL((k_phase<PH>), dim3(256), dim3(NTHREADS), 0, stream, P);
  if constexpr (PH + 1 < NPHASES) launch_phases<PH + 1>(P, stream);
}

#if MEGA
__global__ void __launch_bounds__(NTHREADS, 2) k_mega(Params P) {
  __shared__ __attribute__((aligned(16))) char smem[SMEM_BYTES];
  cg::grid_group grid = cg::this_grid();
  if (P.use_cg_sync) grid.sync();
  unsigned bt = 0;
  const int wvs = __builtin_amdgcn_readfirstlane(threadIdx.x >> 6);
  run_phase(0, P, smem, wvs); fast_barrier(P.bar, bt, wvs);
  run_phase(1, P, smem, wvs); fast_barrier(P.bar, bt, wvs);
  run_phase(2, P, smem, wvs); fast_barrier(P.bar, bt, wvs);
  run_phase(13, P, smem, wvs); fast_barrier(P.bar, bt, wvs);
  run_phase(3, P, smem, wvs); fast_barrier(P.bar, bt, wvs);
  run_phase(4, P, smem, wvs); fast_barrier(P.bar, bt, wvs);
  run_phase(5, P, smem, wvs); fast_barrier(P.bar, bt, wvs);
  run_phase(6, P, smem, wvs); fast_barrier(P.bar, bt, wvs);
  run_phase(7, P, smem, wvs); fast_barrier(P.bar, bt, wvs);
  run_phase(8, P, smem, wvs); fast_barrier(P.bar, bt, wvs);
  run_phase(10, P, smem, wvs); fast_barrier(P.bar, bt, wvs);
  run_phase(11, P, smem, wvs); fast_barrier(P.bar, bt, wvs);
  run_phase(12, P, smem, wvs);
}
#endif

extern "C" void kernel_launch(void* const* d_in, const int* in_sizes, int n_in, void* d_out, int out_size, void* d_ws, size_t ws_size,
                              hipStream_t stream) {
  Params P{};
  P.x = (const float*)d_in[0]; P.pos = (const int*)d_in[1]; P.pre_norm = (const float*)d_in[2]; P.post_norm = (const float*)d_in[3];
  P.gla_w_in = (const float*)d_in[4]; P.gla_w_gk_up = (const float*)d_in[5]; P.gla_b_gk = (const float*)d_in[6];
  P.gla_head_norm = (const float*)d_in[7]; P.gla_w_out = (const float*)d_in[8];
  P.nsa_w_in = (const float*)d_in[9]; P.nsa_b_gate = (const float*)d_in[10]; P.nsa_pe_k = (const float*)d_in[11]; P.nsa_pe_v = (const float*)d_in[12];
  P.ck_w1 = (const float*)d_in[13]; P.ck_w2 = (const float*)d_in[14]; P.cv_w1 = (const float*)d_in[15]; P.cv_w2 = (const float*)d_in[16];
  P.nsa_w_out = (const float*)d_in[17];
  P.out = (float*)d_out;
  char* ws = (char*)d_ws;
  const size_t MB = 1024 * 1024;
  P.W0t = (half_t*)(ws);
  P.Wo0t = (half_t*)(ws + 7 * MB);
  P.W1t = (half_t*)(ws + 9 * MB);
  P.Wo1t = (half_t*)(ws + 17 * MB);
  P.cw1t = (half_t*)(ws + 19 * MB);
  P.cw2t = (half_t*)(ws + 21 * MB);
  P.cbias = (float*)(ws + 22 * MB);
  P.cbias_part = (float*)(ws + 22 * MB + 4096);
  P.bar = (unsigned*)(ws + 23 * MB);
  P.use_cg_sync = 0;
  P.kmax2 = (unsigned*)(ws + 22 * MB + 512 * 1024);
  P.xh = (half_t*)(ws + 24 * MB);
  P.x1h = P.xh;
  P.p = (half_t*)(ws + 88 * MB);
  P.y = (half_t*)(ws + 88 * MB);
  P.og = (half_t*)(ws + 328 * MB);
  P.bcum = (float*)(ws + 392 * MB);
  P.rstd = (float*)(ws + 456 * MB);
  P.kcmp = (half_t*)(ws + 457 * MB);
  P.vcmp = (half_t*)(ws + 458 * MB);
  P.ropetab = (float*)(ws + 459 * MB);
  P.hid = (half_t*)(ws + 467 * MB);
  P.WglT = (half_t*)(ws + 22 * MB + 768 * 1024);
  P.WglrT = (half_t*)(ws + 22 * MB + 896 * 1024);
  P.glr = (float*)(ws + 509 * MB);
  P.gl = (float*)(ws + 503 * MB);
  P.gla_state = (float*)(ws + 476 * MB);
  P.part = (half_t*)(ws + 400 * MB);
  if (ws_size < 512 * MB) { fprintf(stderr, "ws too small: %zu\n", ws_size); return; }
#if MEGA
  static int grid_blocks = 0;
  if (!grid_blocks) {
    int dev = 0, cus = 0, per_cu = 0;
    hipGetDevice(&dev);
    hipDeviceGetAttribute(&cus, hipDeviceAttributeMultiprocessorCount, dev);
    hipOccupancyMaxActiveBlocksPerMultiprocessor(&per_cu, k_mega, NTHREADS, 0);
    if (per_cu < 1) per_cu = 1;
    if (per_cu > 1) per_cu = 1;
    grid_blocks = cus * per_cu;
  }
  hipMemsetAsync(ws + 23 * MB, 0, 16384, stream);
  void* args[] = {&P};
  hipError_t e = hipLaunchCooperativeKernel((void*)k_mega, dim3(grid_blocks), dim3(NTHREADS), args, 0, stream);
  if (e != hipSuccess) fprintf(stderr, "cooperative launch failed: %s (grid %d)\n", hipGetErrorString(e), grid_blocks);
#else
  launch_phases<0>(P, stream);
#endif
}
```

```cpp
#include <hip/hip_runtime.h>
#include <hip/hip_cooperative_groups.h>
#include <cstdio>
#include <cstdint>
namespace cg = cooperative_groups;

typedef _Float16 half_t;
typedef _Float16 half8 __attribute__((ext_vector_type(8)));
typedef _Float16 half4 __attribute__((ext_vector_type(4)));
typedef float f32x4 __attribute__((ext_vector_type(4)));
typedef int v2i __attribute__((ext_vector_type(2)));
typedef int v4i __attribute__((ext_vector_type(4)));

#ifndef MEGA
#define MEGA 1
#endif

constexpr int T_TOK = 32768, DM = 1024, SEQ = 4096, NBATCH = 8;
constexpr int GLA_IN = 3088, NSA_IN = 3632;
constexpr int LD0 = 3072, LD1 = 3584;
constexpr int NC = 255;
constexpr float EPS = 1e-6f;
constexpr int NTHREADS = 512, NWAVES = NTHREADS / 64;
constexpr int SMEM_BYTES = 160 * 1024;

struct Params {
  const float* x; const int* pos; const float* pre_norm; const float* post_norm;
  const float* gla_w_in; const float* gla_w_gk_up; const float* gla_b_gk; const float* gla_head_norm; const float* gla_w_out;
  const float* nsa_w_in; const float* nsa_b_gate; const float* nsa_pe_k; const float* nsa_pe_v;
  const float* ck_w1; const float* ck_w2; const float* cv_w1; const float* cv_w2; const float* nsa_w_out;
  float* out;
  half_t* p; half_t* y; half_t* og; float* bcum; float* rstd; half_t* kcmp; half_t* vcmp; float* ropetab;
  half_t* xh; half_t* W0t; half_t* Wo0t; half_t* W1t; half_t* Wo1t;
  half_t* cw1t; half_t* cw2t; float* cbias; half_t* hid;
  float* cbias_part; unsigned* bar; long long use_cg_sync; unsigned* kmax2; float* gla_state; half_t* WglT; float* gl; half_t* x1h; half_t* WglrT; float* glr; half_t* part; float* ppart; float* rs4;
};

__device__ __forceinline__ int lane_id() { return (int)__builtin_amdgcn_mbcnt_hi(~0u, __builtin_amdgcn_mbcnt_lo(~0u, 0u)); }
__device__ __forceinline__ int otid(int wvs) { int t = wvs * 64 + lane_id(); asm volatile("" : "+v"(t)); return t; }
typedef __attribute__((address_space(3))) void lds_void;
typedef __attribute__((address_space(1))) const void gbl_void;
typedef short s16x4 __attribute__((vector_size(8)));
typedef __attribute__((address_space(3))) s16x4 lds_s16x4;
__device__ __forceinline__ half4 tr_read4(const char* p) {
  const s16x4 v = __builtin_amdgcn_ds_read_tr16_b64_v4i16((lds_s16x4*)(p));
  return __builtin_bit_cast(half4, v);
}
template <int N> __device__ __forceinline__ void wait_vmcnt() { asm volatile("s_waitcnt vmcnt(%0)" ::"n"(N) : "memory"); }
constexpr float LOG2E = 1.4426950408889634f;
__device__ __forceinline__ float fexp2(float x) { return __builtin_amdgcn_exp2f(x); }
typedef unsigned u32x2 __attribute__((ext_vector_type(2)));
__device__ __forceinline__ float rowmax4(float x) {
  u32x2 r = __builtin_amdgcn_permlane16_swap(__float_as_uint(x), __float_as_uint(x), false, false);
  x = fmaxf(__uint_as_float(r[0]), __uint_as_float(r[1]));
  r = __builtin_amdgcn_permlane32_swap(__float_as_uint(x), __float_as_uint(x), false, false);
  return fmaxf(__uint_as_float(r[0]), __uint_as_float(r[1]));
}
__device__ __forceinline__ float rowsum4(float x) {
  u32x2 r = __builtin_amdgcn_permlane16_swap(__float_as_uint(x), __float_as_uint(x), false, false);
  x = __uint_as_float(r[0]) + __uint_as_float(r[1]);
  r = __builtin_amdgcn_permlane32_swap(__float_as_uint(x), __float_as_uint(x), false, false);
  return __uint_as_float(r[0]) + __uint_as_float(r[1]);
}
template <int CTRL> __device__ __forceinline__ float dpp_f(float x) {
  return __builtin_bit_cast(float, __builtin_amdgcn_update_dpp(0, __builtin_bit_cast(int, x), CTRL, 0xf, 0xf, true));
}
__device__ __forceinline__ float wave_sum(float v) {
  v += dpp_f<0xB1>(v);
  v += dpp_f<0x4E>(v);
  v += dpp_f<0x141>(v);
  v += dpp_f<0x140>(v);
  return rowsum4(v);
}
__device__ __forceinline__ float wave_max(float v) {
  v = fmaxf(v, dpp_f<0xB1>(v));
  v = fmaxf(v, dpp_f<0x4E>(v));
  v = fmaxf(v, dpp_f<0x141>(v));
  v = fmaxf(v, dpp_f<0x140>(v));
  return rowmax4(v);
}
__device__ __forceinline__ float fast_exp2(float x) { return __builtin_amdgcn_exp2f(x); }
__device__ __forceinline__ float sigmoidf(float v) { return __builtin_amdgcn_rcpf(1.f + fast_exp2(-1.4426950408889634f * v)); }
__device__ __forceinline__ float siluf(float v) { return v * sigmoidf(v); }
__device__ __forceinline__ float logsigmoidf(float u) { return fminf(u, 0.f) - 0.6931471805599453f * __builtin_amdgcn_logf(1.f + fast_exp2(-1.4426950408889634f * fabsf(u))); }

__device__ __forceinline__ void fast_barrier(unsigned* bar, unsigned& round, int wvs) {
  asm volatile("s_waitcnt vmcnt(0) lgkmcnt(0)" ::: "memory");
  __syncthreads();
  round += 1;
  if (wvs == 0 && lane_id() == 0) {
    __builtin_amdgcn_fence(__ATOMIC_RELEASE, "agent");
    asm volatile("s_waitcnt vmcnt(0)" ::: "memory");
    const unsigned ngroups = gridDim.x >> 4, g = blockIdx.x >> 4;
    const unsigned old = __hip_atomic_fetch_add(bar + 64 + 64 * g, 1u, __ATOMIC_RELAXED, __HIP_MEMORY_SCOPE_AGENT);
    if (old + 1 == round * 16u) {
      const unsigned t = __hip_atomic_fetch_add(bar, 1u, __ATOMIC_RELAXED, __HIP_MEMORY_SCOPE_AGENT);
      if (t + 1 == round * ngroups) {
        for (unsigned k = 0; k < ngroups; ++k) __hip_atomic_store(bar + 2048 + 64 * k, round, __ATOMIC_RELAXED, __HIP_MEMORY_SCOPE_AGENT);
      }
    }
    while (__hip_atomic_load(bar + 2048 + 64 * g, __ATOMIC_RELAXED, __HIP_MEMORY_SCOPE_AGENT) < round) { }
    __builtin_amdgcn_fence(__ATOMIC_ACQUIRE, "agent");
    asm volatile("s_waitcnt vmcnt(0)" ::: "memory");
  }
  __syncthreads();
}

__device__ void ph_xh_rstd(const Params& P, int wvs) {
  const float* src = P.x; half_t* xh = P.xh; float* rstd = P.rstd;
  const int tid_ = otid(wvs); const int lane = tid_ & 63, w = tid_ >> 6;
  constexpr int RW = 4, RU = 2;
  const int rstride = gridDim.x * NWAVES;
  const float inv = powf(10000.f, -(float)(2 * (tid_ & 31)) / 64.f);
  const int rs_ = gridDim.x * NTHREADS;
  int ridx = blockIdx.x * NTHREADS + tid_;
#pragma unroll 1
  for (int row0 = blockIdx.x * NWAVES + w; row0 < T_TOK; row0 += rstride * RW) {
    int pp[RU];
#pragma unroll
    for (int u = 0; u < RU; ++u) { const int id = ridx + u * rs_; pp[u] = id < T_TOK * 32 ? P.pos[id >> 5] : 0; }
    float4 v[RW][4];
#pragma unroll
    for (int r = 0; r < RW; ++r)
#pragma unroll
      for (int i = 0; i < 4; ++i) v[r][i] = ((const float4*)(src + (size_t)(row0 + r * rstride) * DM))[lane + 64 * i];
#pragma unroll
    for (int u = 0; u < RU; ++u) {
      const int id = ridx + u * rs_;
      if (id < T_TOK * 32) {
        const int t = id >> 5, i = id & 31;
        float sn, cs; sincosf((float)pp[u] * inv, &sn, &cs);
        P.ropetab[t * 64 + i] = cs; P.ropetab[t * 64 + 32 + i] = sn;
      }
    }
    ridx += RU * rs_;
#pragma unroll
    for (int r = 0; r < RW; ++r) {
      const int row = row0 + r * rstride;
      half4* xr = (half4*)(xh + (size_t)row * DM);
      float ss = 0.f;
#pragma unroll
      for (int i = 0; i < 4; ++i) {
        const float4 t = v[r][i];
        ss += t.x * t.x + t.y * t.y + t.z * t.z + t.w * t.w;
        half4 hv; hv[0] = (half_t)t.x; hv[1] = (half_t)t.y; hv[2] = (half_t)t.z; hv[3] = (half_t)t.w;
        xr[lane + 64 * i] = hv;
      }
      ss = wave_sum(ss);
      if (lane == 0) rstd[row] = rsqrtf(ss * (1.f / DM) + EPS);
    }
  }
  for (; ridx < T_TOK * 32; ridx += rs_) {
    const int t = ridx >> 5, i = ridx & 31;
    float sn, cs; sincosf((float)P.pos[t] * inv, &sn, &cs);
    P.ropetab[t * 64 + i] = cs; P.ropetab[t * 64 + 32 + i] = sn;
  }
}
__device__ __forceinline__ int orig_col(int n, int mode) {
  if (mode == 0) {
    if (n < 2048) return n;
    if (n < 3072) return n + 16;
    return -1;
  } else if (mode == 1) {
    if (n < 2560) return n;
    if (n < 3584) return n + 48;
    return -1;
  } else if (mode == 5) {
    return n < 48 ? 2560 + n : -1;
  }
  if (mode == 4) return n < 64 ? n : -1;
  if (mode == 6) return n < 16 ? 2048 + n : -1;
  return n;
}
__device__ __forceinline__ void prep_wT_tile(const float* W, int ldw, const float* gamma, half_t* Wt, int K, int mode, int n0, int k0, float* sm, int tid) {
  float(*tile)[65] = (float(*)[65])sm;
  __syncthreads();
#pragma unroll
  for (int r = 0; r < 4096 / NTHREADS; ++r) {
    const int idx = tid + r * NTHREADS, kk = idx >> 6, nn = idx & 63;
    const int on = orig_col(n0 + nn, mode);
    float v = 0.f;
    if (on >= 0) { v = W[(size_t)(k0 + kk) * ldw + on]; if (gamma) v *= gamma[k0 + kk]; }
    tile[kk][nn] = v;
  }
  __syncthreads();
  {
    const int nn = tid >> 3, oct = tid & 7;
    half8 hv;
#pragma unroll
    for (int e = 0; e < 8; ++e) hv[e] = (half_t)tile[oct * 8 + e][nn];
    *(half8*)(Wt + (size_t)(n0 + nn) * K + k0 + oct * 8) = hv;
  }
}

struct StripJob { const float* W; const float* gamma; half_t* Wt; int ldw, K, mode, n0, k0; };
__device__ __forceinline__ void strip_load(const StripJob& J, int tid, f32x4 (&v)[8], float (&gm)[8]) {
#pragma unroll
  for (int r = 0; r < 8; ++r) {
    const int idx = tid + r * NTHREADS, kk = idx >> 6, n4 = (idx & 63) * 4;
    const int on = orig_col(J.n0 + n4, J.mode);
    v[r] = (f32x4){0.f, 0.f, 0.f, 0.f}; gm[r] = 1.f;
    if (on >= 0) { v[r] = *(const f32x4*)(J.W + (size_t)(J.k0 + kk) * J.ldw + on); if (J.gamma) gm[r] = J.gamma[J.k0 + kk]; }
  }
}
__device__ __forceinline__ void strip_to_lds(float* sm, int tid, const f32x4 (&v)[8], const float (&gm)[8]) {
  float(*tile)[260] = (float(*)[260])sm;
#pragma unroll
  for (int r = 0; r < 8; ++r) {
    const int idx = tid + r * NTHREADS, kk = idx >> 6, n4 = (idx & 63) * 4;
    *(f32x4*)&tile[kk][n4] = v[r] * gm[r];
  }
}
__device__ __forceinline__ void strip_store(const StripJob& J, const float* sm, int tid) {
  const float(*tile)[260] = (const float(*)[260])sm;
#pragma unroll
  for (int r = 0; r < 4; ++r) {
    const int idx = tid + r * NTHREADS, nn = idx & 255, oct = idx >> 8;
    half8 hv;
#pragma unroll
    for (int e = 0; e < 8; ++e) hv[e] = (half_t)tile[oct * 8 + e][nn];
    *(half8*)(J.Wt + (size_t)(J.n0 + nn) * J.K + J.k0 + oct * 8) = hv;
  }
}
__device__ __forceinline__ void prep_cbias_job(const Params& P, int job, float* sm, int tid) {
  const int which = job >> 5, ks = job & 31, j = tid & 255, hf = tid >> 8;
  const float* pe = (which ? P.nsa_pe_v : P.nsa_pe_k) + ks * 64 + hf * 32;
  const float* w1 = (which ? P.cv_w1 : P.ck_w1) + (size_t)(ks * 64 + hf * 32) * 256 + j;
  float wv[32];
#pragma unroll
  for (int k = 0; k < 32; ++k) wv[k] = w1[(size_t)k * 256];
  float a = 0.f;
#pragma unroll
  for (int k = 0; k < 32; ++k) a += pe[k] * wv[k];
  __syncthreads();
  sm[tid] = a;
  __syncthreads();
  if (tid < 256) P.cbias_part[(which * 32 + ks) * 256 + j] = sm[tid] + sm[tid + 256];
}
__device__ __forceinline__ StripJob strip_job(const Params& P, int w) {
  constexpr int NJ = 8;
  const int nstr[NJ] = {(LD0 / 256) * (DM / 64), (DM / 256) * (DM / 64), (LD1 / 256) * (DM / 64), (DM / 256) * (DM / 64), 32, 32, 4, 4};
  int j = 0, t = w;
#pragma unroll
  for (int jj = 0; jj < NJ - 1; ++jj) if (j == jj && t >= nstr[jj]) { t -= nstr[jj]; j = jj + 1; }
  StripJob J;
  switch (j) {
    case 0: J.W = P.gla_w_in; J.ldw = GLA_IN; J.gamma = P.pre_norm; J.Wt = P.W0t; J.K = DM; J.mode = 0; break;
    case 1: J.W = P.gla_w_out; J.ldw = DM; J.gamma = nullptr; J.Wt = P.Wo0t; J.K = DM; J.mode = 2; break;
    case 2: J.W = P.nsa_w_in; J.ldw = NSA_IN; J.gamma = P.pre_norm + DM; J.Wt = P.W1t; J.K = DM; J.mode = 1; break;
    case 3: J.W = P.nsa_w_out; J.ldw = DM; J.gamma = nullptr; J.Wt = P.Wo1t; J.K = DM; J.mode = 2; break;
    case 4: J.W = P.ck_w1; J.ldw = 256; J.gamma = nullptr; J.Wt = P.cw1t; J.K = 2048; J.mode = 2; break;
    case 5: J.W = P.cv_w1; J.ldw = 256; J.gamma = nullptr; J.Wt = P.cw1t + 256 * 2048; J.K = 2048; J.mode = 2; break;
    case 6: J.W = P.ck_w2; J.ldw = 64; J.gamma = nullptr; J.Wt = P.cw2t; J.K = 256; J.mode = 4; break;
    default: J.W = P.cv_w2; J.ldw = 64; J.gamma = nullptr; J.Wt = P.cw2t + 256 * 256; J.K = 256; J.mode = 4; break;
  }
  const int nsk = J.K / 64;
  J.n0 = (t / nsk) * 256; J.k0 = (t % nsk) * 64;
  return J;
}
__device__ void prep_weights(const Params& P, float* sm, int wvs) {
  const int tid = otid(wvs);
  constexpr int nstrips = (LD0 / 256) * (DM / 64) + (DM / 256) * (DM / 64) + (LD1 / 256) * (DM / 64) + (DM / 256) * (DM / 64) + 32 + 32 + 4 + 4;
  const int total = nstrips + 32 + 64;
  f32x4 v[8]; float gm[8];
  bool have = false;
  for (int w = blockIdx.x; w < total; w += gridDim.x) {
    if (w >= nstrips + 32) { prep_cbias_job(P, w - nstrips - 32, sm, tid); continue; }
    if (w >= nstrips) {
      const int t = w - nstrips;
      if (t < 16) prep_wT_tile(P.nsa_w_in, NSA_IN, P.pre_norm + DM, P.WglT, DM, 5, 0, t * 64, sm, tid);
      else prep_wT_tile(P.gla_w_in, GLA_IN, P.pre_norm, P.WglrT, DM, 6, 0, (t - 16) * 64, sm, tid);
      continue;
    }
    const StripJob J = strip_job(P, w);
    if (!have) strip_load(J, tid, v, gm);
    __syncthreads();
    strip_to_lds(sm, tid, v, gm);
    const int wn = w + (int)gridDim.x;
    have = wn < nstrips;
    if (have) { const StripJob Jn = strip_job(P, wn); strip_load(Jn, tid, v, gm); }
    __syncthreads();
    strip_store(J, sm, tid);
  }
}

__device__ void prep_cbias_reduce(const Params& P, int wvs, int first_block) {
  if ((int)blockIdx.x >= first_block && (int)blockIdx.x < first_block + 2 && otid(wvs) < 256) {
    const int which = (int)blockIdx.x - first_block, j = otid(wvs);
    float a = 0.f;
#pragma unroll
    for (int ks = 0; ks < 32; ++ks) a += P.cbias_part[(which * 32 + ks) * 256 + j];
    P.cbias[which * 256 + j] = a;
  }
}

namespace g8 {
constexpr int BK = 64, HALF = 128, HTB = HALF * BK * 2;
__device__ __forceinline__ int lds_byte(int r, int c) { const int st = (r >> 4) * 2 + (c >> 5), rr = r & 15, cc = c & 31, ob = rr * 64 + cc * 2; return st * 1024 + (ob ^ (((ob >> 9) & 1) << 5)); }
__device__ __forceinline__ void stage_rc(int b, int& R, int& C) { const int st = b / 1024, sb = b % 1024, swz = sb ^ (((sb >> 9) & 1) << 5); R = (st >> 1) * 16 + swz / 64; C = (st & 1) * 32 + (swz % 64) / 2; }
typedef f32x4 Acc[2][2][4][2];

struct SrcPlain8 {
  const half_t* A; int lda; const half_t* Bt; int K;
  __device__ __forceinline__ void get(int pm, int pn, const half_t*& Ag, const half_t*& Bg, size_t& a_rs, int& a_ks) const {
    Ag = A + (size_t)pm * 256 * lda; Bg = Bt + (size_t)pn * 256 * K; a_rs = lda; a_ks = 64;
  }
  __device__ __forceinline__ int ldb(int K_) const { return K_; }
};
struct SrcCmp1_8 {
  const half_t* p1; const half_t* w1t;
  __device__ __forceinline__ void get(int pm, int pn, const half_t*& Ag, const half_t*& Bg, size_t& a_rs, int& a_ks) const {
    const int which = pm >> 5, bg = pm & 31, b = bg >> 2, g = bg & 3;
    Ag = p1 + (size_t)(b * SEQ) * LD1 + (which ? 1280 : 1024) + g * 64;
    Bg = w1t + (size_t)which * 256 * 2048; a_rs = (size_t)16 * LD1; a_ks = LD1;
  }
  __device__ __forceinline__ int ldb(int K_) const { return K_; }
};
struct SrcCmp2_8 {
  const half_t* hid; const half_t* w2t;
  __device__ __forceinline__ void get(int pm, int pn, const half_t*& Ag, const half_t*& Bg, size_t& a_rs, int& a_ks) const {
    Ag = hid + (size_t)pm * 256 * 256; Bg = w2t + (size_t)(pm >> 5) * 256 * 256; a_rs = 256; a_ks = 64;
  }
  __device__ __forceinline__ int ldb(int K_) const { return K_; }
};
struct SrcCmp1h8 {
  const half_t* p1; const half_t* w1t;
  __device__ __forceinline__ void get(int pm, int pn, const half_t*& Ag, const half_t*& Bg, size_t& a_rs, int& a_ks) const {
    const int which = pm >> 5, bg = pm & 31, b = bg >> 2, g = bg & 3;
    Ag = p1 + (size_t)(b * SEQ) * LD1 + (which ? 1280 : 1024) + g * 64;
    Bg = w1t + (size_t)which * 256 * 2048 + pn * 1024; a_rs = (size_t)16 * LD1; a_ks = LD1;
  }
  __device__ __forceinline__ int ldb(int) const { return 2048; }
};

__device__ __forceinline__ half8 pack8(const f32x4 a, const f32x4 b) {
  half8 h; h[0] = (half_t)a[0]; h[1] = (half_t)a[1]; h[2] = (half_t)a[2]; h[3] = (half_t)a[3]; h[4] = (half_t)b[0]; h[5] = (half_t)b[1]; h[6] = (half_t)b[2]; h[7] = (half_t)b[3];
  return h;
}
struct EpiStore8 {
  half_t* C; int ldc; const float* rowscale;
  __device__ __forceinline__ void operator()(const Acc& acc, int row0, int col0, int wr, int wc, int fr, int fq) const {
    float rs[2][4];
#pragma unroll
    for (int ai = 0; ai < 2; ++ai)
#pragma unroll
      for (int m = 0; m < 4; ++m) rs[ai][m] = rowscale ? rowscale[row0 + ai * 128 + wr * 64 + m * 16 + fr] : 1.f;
#pragma unroll
    for (int ai = 0; ai < 2; ++ai)
#pragma unroll
      for (int m = 0; m < 4; ++m) {
        const int tok = row0 + ai * 128 + wr * 64 + m * 16 + fr;
        const float s = rs[ai][m];
        half_t* rowp = C + (size_t)tok * ldc + col0 + 64 * wc + 8 * fq;
#pragma unroll
        for (int bj = 0; bj < 2; ++bj) *(half8*)(rowp + 32 * bj) = pack8(acc[ai][bj][m][0] * s, acc[ai][bj][m][1] * s);
      }
  }
};
struct EpiRope8 {
  half_t* C; int ldc; const float* rs4; const float* ropetab; float* rstd_out;
  __device__ __forceinline__ float rowscale_of(int tok) const { const f32x4 p = *(const f32x4*)(rs4 + (size_t)tok * 4); return rsqrtf(((p[0] + p[1]) + (p[2] + p[3])) * (1.f / DM) + EPS); }
  __device__ __forceinline__ void operator()(const Acc& acc, int row0, int col0, int wr, int wc, int fr, int fq) const {
    const int grp = (col0 >> 6) + wc;
    const bool is_q = grp < 16;
    const bool roped = is_q || (grp >= 16 && grp < 20) || (grp >= 24 && grp < 28) || (grp >= 32 && grp < 36);
    const float sc = is_q ? 0.125f * 1.4426950408889634f : 1.f;
    float s = rowscale_of(row0 + wr * 64 + fr);
    const bool publish = (col0 == 0) && (wc == 0) && (fq == 0);
    f32x4 cs[2], sn[2];
    if (roped) {
      const int tok0 = row0 + wr * 64 + fr;
#pragma unroll
      for (int n = 0; n < 2; ++n) { cs[n] = *(const f32x4*)(ropetab + (size_t)tok0 * 64 + 8 * fq + 4 * n); sn[n] = *(const f32x4*)(ropetab + (size_t)tok0 * 64 + 32 + 8 * fq + 4 * n); }
    }
#pragma unroll
    for (int i = 0; i < 8; ++i) {
        const int ai = i >> 2, m = i & 3;
        const int tok = row0 + ai * 128 + wr * 64 + m * 16 + fr;
        half_t* rowp = C + (size_t)tok * ldc + col0 + 64 * wc + 8 * fq;
        f32x4 o1[2], o2[2];
#pragma unroll
        for (int n = 0; n < 2; ++n) {
          const f32x4 x1 = acc[ai][0][m][n] * s, x2 = acc[ai][1][m][n] * s;
          if (roped) { o1[n] = (x1 * cs[n] - x2 * sn[n]) * sc; o2[n] = (x2 * cs[n] + x1 * sn[n]) * sc; }
          else { o1[n] = x1; o2[n] = x2; }
        }
        const half8 p1 = pack8(o1[0], o1[1]), p2 = pack8(o2[0], o2[1]);
        const float s_cur = s;
        if (i + 1 < 8) {
          const int tokn = row0 + ((i + 1) >> 2) * 128 + wr * 64 + ((i + 1) & 3) * 16 + fr;
          s = rowscale_of(tokn);
          if (roped) {
#pragma unroll
            for (int n = 0; n < 2; ++n) { cs[n] = *(const f32x4*)(ropetab + (size_t)tokn * 64 + 8 * fq + 4 * n); sn[n] = *(const f32x4*)(ropetab + (size_t)tokn * 64 + 32 + 8 * fq + 4 * n); }
          }
        }
        *(half8*)(rowp) = p1;
        *(half8*)(rowp + 32) = p2;
        if (publish) rstd_out[tok] = s_cur;
    }
  }
};
template <bool FINAL>
struct EpiPost8 {
  const half_t* base; const float* g; float* out; half_t* xo; float* part; float* rs4; unsigned* cnt; char* smem;
  __device__ __forceinline__ void operator()(const Acc& acc, int row0, int col0, int wr, int wc, int fr, int fq) const {
    const int pm = row0 >> 8, pn = col0 >> 8;
    const int tid = (wr * 4 + wc) * 64 + fq * 16 + fr;
    float* ssw = (float*)(smem + 131072);
    float* rsl = ssw + 1024;
    f32x4 gw[2][2];
#pragma unroll
    for (int bj = 0; bj < 2; ++bj) { const int col = col0 + 64 * wc + 32 * bj + 8 * fq; gw[bj][0] = *(const f32x4*)(g + col); gw[bj][1] = *(const f32x4*)(g + col + 4); }
    half8 bcur[2];
#pragma unroll
    for (int bj = 0; bj < 2; ++bj) bcur[bj] = *(const half8*)(base + (size_t)(row0 + wr * 64 + fr) * DM + col0 + 64 * wc + 32 * bj + 8 * fq);
#pragma unroll
    for (int ai = 0; ai < 2; ++ai)
#pragma unroll
      for (int m = 0; m < 4; ++m) {
        float v = 0.f;
#pragma unroll
        for (int bj = 0; bj < 2; ++bj)
#pragma unroll
          for (int n = 0; n < 2; ++n)
#pragma unroll
            for (int e = 0; e < 4; ++e) v += acc[ai][bj][m][n][e] * acc[ai][bj][m][n][e];
        v = rowsum4(v);
        if (fq == 0) ssw[wc * 256 + ai * 128 + wr * 64 + m * 16 + fr] = v;
      }
    __syncthreads();
    if (tid < 256) __hip_atomic_store(part + (size_t)(pm * 4 + pn) * 256 + tid, (ssw[tid] + ssw[256 + tid]) + (ssw[512 + tid] + ssw[768 + tid]), __ATOMIC_RELAXED, __HIP_MEMORY_SCOPE_AGENT);
    asm volatile("s_waitcnt vmcnt(0)" ::: "memory");
    __syncthreads();
    if (tid == 0) {
      __hip_atomic_fetch_add(cnt + pm, 1u, __ATOMIC_RELAXED, __HIP_MEMORY_SCOPE_AGENT);
      while (__hip_atomic_load(cnt + pm, __ATOMIC_RELAXED, __HIP_MEMORY_SCOPE_AGENT) < 4u) { }
    }
    __syncthreads();
    if (tid < 256) {
      const float* pp = part + (size_t)pm * 1024 + tid;
      const float t0 = __hip_atomic_load(pp, __ATOMIC_RELAXED, __HIP_MEMORY_SCOPE_AGENT), t1 = __hip_atomic_load(pp + 256, __ATOMIC_RELAXED, __HIP_MEMORY_SCOPE_AGENT);
      const float t2 = __hip_atomic_load(pp + 512, __ATOMIC_RELAXED, __HIP_MEMORY_SCOPE_AGENT), t3 = __hip_atomic_load(pp + 768, __ATOMIC_RELAXED, __HIP_MEMORY_SCOPE_AGENT);
      rsl[tid] = rsqrtf(((t0 + t1) + (t2 + t3)) * (1.f / DM) + EPS);
    }
    __syncthreads();
    float ss1[8];
#pragma unroll
    for (int i = 0; i < 8; ++i) {
      const int ai = i >> 2, m = i & 3;
      const int r = ai * 128 + wr * 64 + m * 16 + fr;
      const float rs = rsl[r];
      const size_t off = (size_t)(row0 + r) * DM + col0 + 64 * wc + 8 * fq;
      f32x4 x[2][2];
      float s1 = 0.f;
#pragma unroll
      for (int bj = 0; bj < 2; ++bj)
#pragma unroll
        for (int n = 0; n < 2; ++n) {
#pragma unroll
          for (int e = 0; e < 4; ++e) { const float v = (float)bcur[bj][4 * n + e] + acc[ai][bj][m][n][e] * rs * gw[bj][n][e]; x[bj][n][e] = v; s1 += v * v; }
        }
      ss1[i] = s1;
      if (i + 1 < 8) {
        const int rn = ((i + 1) >> 2) * 128 + wr * 64 + ((i + 1) & 3) * 16 + fr;
#pragma unroll
        for (int bj = 0; bj < 2; ++bj) bcur[bj] = *(const half8*)(base + (size_t)(row0 + rn) * DM + col0 + 64 * wc + 32 * bj + 8 * fq);
      }
#pragma unroll
      for (int bj = 0; bj < 2; ++bj) {
        if (FINAL) { *(f32x4*)(out + off + 32 * bj) = x[bj][0]; *(f32x4*)(out + off + 32 * bj + 4) = x[bj][1]; }
        else *(half8*)(xo + off + 32 * bj) = pack8(x[bj][0], x[bj][1]);
      }
    }
    if (!FINAL) {
#pragma unroll
      for (int i = 0; i < 8; ++i) {
        const float v = rowsum4(ss1[i]);
        if (fq == 0) ssw[wc * 256 + (i >> 2) * 128 + wr * 64 + (i & 3) * 16 + fr] = v;
      }
      __syncthreads();
      if (tid < 256) rs4[(size_t)(row0 + tid) * 4 + pn] = (ssw[tid] + ssw[256 + tid]) + (ssw[512 + tid] + ssw[768 + tid]);
    }
  }
};
struct EpiCmpHid8 {
  half_t* hid; const float* bias;
  __device__ __forceinline__ void operator()(const Acc& acc, int row0, int col0, int wr, int wc, int fr, int fq) const {
    const int which = row0 >> 13;
#pragma unroll
    for (int bj = 0; bj < 2; ++bj) {
      const int col = col0 + 64 * wc + 32 * bj + 8 * fq;
      const f32x4 b0 = *(const f32x4*)(bias + which * 256 + col), b1 = *(const f32x4*)(bias + which * 256 + col + 4);
#pragma unroll
      for (int ai = 0; ai < 2; ++ai)
#pragma unroll
        for (int m = 0; m < 4; ++m) {
          const int row = row0 + ai * 128 + wr * 64 + m * 16 + fr;
          f32x4 v0 = acc[ai][bj][m][0] + b0, v1 = acc[ai][bj][m][1] + b1;
#pragma unroll
          for (int e = 0; e < 4; ++e) { v0[e] = siluf(v0[e]); v1[e] = siluf(v1[e]); }
          *(half8*)(hid + (size_t)row * 256 + col) = pack8(v0, v1);
        }
    }
  }
};
struct EpiCmpPart8 {
  half_t* part; unsigned* done;
  __device__ __forceinline__ void operator()(const Acc& acc, int row0, int col0, int wr, int wc, int fr, int fq) const {
    half_t* base = part + (size_t)(col0 >> 8) * 16384 * 256;
#pragma unroll
    for (int ai = 0; ai < 2; ++ai)
#pragma unroll
      for (int m = 0; m < 4; ++m) {
        half_t* rowp = base + (size_t)(row0 + ai * 128 + wr * 64 + m * 16 + fr) * 256 + 64 * wc + 8 * fq;
#pragma unroll
        for (int bj = 0; bj < 2; ++bj) *(half8*)(rowp + 32 * bj) = pack8(acc[ai][bj][m][0], acc[ai][bj][m][1]);
      }
    asm volatile("s_waitcnt vmcnt(0)" ::: "memory");
    __syncthreads();
    if (wr == 0 && wc == 0 && lane_id() == 0) {
      __builtin_amdgcn_fence(__ATOMIC_RELEASE, "agent");
      __hip_atomic_fetch_add(done + (row0 >> 8), 1u, __ATOMIC_RELAXED, __HIP_MEMORY_SCOPE_AGENT);
    }
  }
};
struct EpiCmpOut8 {
  half_t* kcmp; half_t* vcmp; unsigned* kmaxc;
  __device__ __forceinline__ void operator()(const Acc& acc, int row0, int col0, int wr, int wc, int fr, int fq) const {
    if (wc != 0) return;
#pragma unroll
    for (int ai = 0; ai < 2; ++ai)
#pragma unroll
      for (int m = 0; m < 4; ++m) {
        const int row = row0 + ai * 128 + wr * 64 + m * 16 + fr;
        const int which = row >> 13, r = row & 8191;
        half_t* dst = (which ? vcmp : kcmp) + (size_t)r * 64 + 8 * fq;
        const bool dead = (r & 255) == 255;
        float ss = 0.f;
#pragma unroll
        for (int bj = 0; bj < 2; ++bj) {
          half8 hv = pack8(acc[ai][bj][m][0], acc[ai][bj][m][1]);
          if (dead) hv = (half8){(half_t)0.f, (half_t)0.f, (half_t)0.f, (half_t)0.f, (half_t)0.f, (half_t)0.f, (half_t)0.f, (half_t)0.f};
#pragma unroll
          for (int e = 0; e < 8; ++e) ss += (float)hv[e] * (float)hv[e];
          *(half8*)(dst + 32 * bj) = hv;
        }
        if (which == 0) {
          ss = rowsum4(ss);
          ss = wave_max(ss);
          if (lane_id() == 0) __hip_atomic_fetch_max(&kmaxc[r >> 8], __float_as_uint(ss), __ATOMIC_RELAXED, __HIP_MEMORY_SCOPE_AGENT);
        }
      }
  }
};

template <class Src, class Epi>
__device__ void gemm(const Src& src, int M, int N, int K, const Epi& epi, char* smem, int wvs) {
  const int tid = otid(wvs), wid = __builtin_amdgcn_readfirstlane(tid >> 6), lane = tid & 63, wr = wid >> 2, wc = wid & 3, fr = lane & 15, fq = lane >> 4;
  const int nM = M / 256, nN = N / 256, nwg = nM * nN, G = gridDim.x, nt = K / BK;
  int sr0, sc0, sr1, sc1;
  stage_rc(tid * 16, sr0, sc0); stage_rc(tid * 16 + 8192, sr1, sc1);
  const int a_base = lds_byte(wr * 64 + fr, fq * 8);
  int b_base = 65536 + lds_byte(wc * 32 + fr, fq * 8);
  asm volatile("" : "+v"(b_base));
#define SA8(b, h) (smem + ((b) * 2 + (h)) * HTB)
#define SB8(b, h) (smem + (4 + (b) * 2 + (h)) * HTB)
#define STAGE_A(P, h, kt) { const char* g_ = (const char*)(Ag + (size_t)(h) * 128 * lda + (size_t)(kt) * a_ks); \
    __builtin_amdgcn_global_load_lds((gbl_void*)(g_ + aob0), (lds_void*)((P) + wid * 1024), 16, 0, 0); \
    __builtin_amdgcn_global_load_lds((gbl_void*)(g_ + aob1), (lds_void*)((P) + 8192 + wid * 1024), 16, 0, 0); }
#define STAGE_B(P, h, kt) { const char* g_ = (const char*)(Bg + (size_t)(h) * 32 * ldb + (size_t)(kt) * 64);     \
    __builtin_amdgcn_global_load_lds((gbl_void*)(g_ + bob0), (lds_void*)((P) + wid * 1024), 16, 0, 0); \
    __builtin_amdgcn_global_load_lds((gbl_void*)(g_ + bob1), (lds_void*)((P) + 8192 + wid * 1024), 16, 0, 0); }
#define LDA8(dst, b, h) { _Pragma("unroll") for (int m = 0; m < 4; ++m) _Pragma("unroll") for (int k = 0; k < 2; ++k) dst[m][k] = *(const half8*)(SA8(b, h) + a_base + m * 2048 + k * 1024); }
#define LDB8(dst, b, h) { _Pragma("unroll") for (int n = 0; n < 2; ++n) _Pragma("unroll") for (int k = 0; k < 2; ++k) dst[n][k] = *(const half8*)(smem + ((b) * 2 + (h)) * HTB + b_base + n * 2048 + k * 1024); }
#define MMA8(ai, bj, At, Bx) { __builtin_amdgcn_s_setprio(1); \
    _Pragma("unroll") for (int m = 0; m < 4; ++m) _Pragma("unroll") for (int n = 0; n < 2; ++n) _Pragma("unroll") for (int k = 0; k < 2; ++k) \
      acc[ai][bj][m][n] = __builtin_amdgcn_mfma_f32_16x16x32_f16(Bx[n][k], At[m][k], acc[ai][bj][m][n], 0, 0, 0); \
    __builtin_amdgcn_s_setprio(0); }
#define WAIT_V(n) asm volatile("s_waitcnt vmcnt(" #n ")" ::: "memory")
#define WAIT_L(n) asm volatile("s_waitcnt lgkmcnt(" #n ")" ::: "memory")
#define BAR __builtin_amdgcn_s_barrier()
#define SCHED __builtin_amdgcn_sched_barrier(0)
  for (int it = 0;; ++it) {
    const int L = it * G + (int)blockIdx.x;
    if (L >= nwg) break;
    int wgid;
    { const int q = nwg / 8, r = nwg % 8, xcd = L % 8, off = L / 8; wgid = (xcd < r ? xcd * (q + 1) : r * (q + 1) + (xcd - r) * q) + off; }
    const int nig = 8 * nN, gid = wgid / nig, fm = gid * 8, gsz = (nM - fm) < 8 ? (nM - fm) : 8;
    const int pm = fm + ((wgid % nig) % gsz), pn = (wgid % nig) / gsz;
    const half_t* Ag; const half_t* Bg; size_t lda; int a_ks;
    src.get(pm, pn, Ag, Bg, lda, a_ks);
    const unsigned aob0 = (unsigned)(((size_t)sr0 * lda + sc0) * 2), aob1 = (unsigned)(((size_t)sr1 * lda + sc1) * 2);
    const int pr0 = 64 * (sr0 >> 5) + 8 * ((sr0 & 15) >> 2) + 4 * ((sr0 >> 4) & 1) + (sr0 & 3), pr1 = 64 * (sr1 >> 5) + 8 * ((sr1 & 15) >> 2) + 4 * ((sr1 >> 4) & 1) + (sr1 & 3);
    const int ldb = src.ldb(K);
    const unsigned bob0 = (unsigned)((pr0 * ldb + sc0) * 2), bob1 = (unsigned)((pr1 * ldb + sc1) * 2);
    Acc acc;
#pragma unroll
    for (int a = 0; a < 2; ++a)
#pragma unroll
      for (int b = 0; b < 2; ++b)
#pragma unroll
        for (int m = 0; m < 4; ++m)
#pragma unroll
          for (int n = 0; n < 2; ++n) acc[a][b][m][n] = (f32x4){0.f, 0.f, 0.f, 0.f};
    half8 At[4][2], B0[2][2], B1[2][2];
    STAGE_B(SB8(0, 0), 0, 0) STAGE_B(SB8(0, 1), 1, 0) STAGE_A(SA8(0, 0), 0, 0) STAGE_A(SA8(0, 1), 1, 0)
    if (wr == 1) BAR;
    WAIT_V(2); BAR;
    STAGE_B(SB8(1, 0), 0, 1) STAGE_A(SA8(1, 0), 0, 1) STAGE_B(SB8(1, 1), 1, 1)
    WAIT_V(6); BAR;
#pragma unroll 1
    for (int t = 0; t < nt - 2; t += 2) {
      LDB8(B0, 0, 0) LDB8(B1, 0, 1) SCHED; LDA8(At, 0, 0) STAGE_A(SA8(1, 1), 1, t + 1)
      WAIT_V(8); WAIT_L(0); BAR; MMA8(0, 0, At, B0) MMA8(0, 1, At, B1) BAR; SCHED;
      LDA8(At, 0, 1) STAGE_B(SB8(0, 0), 0, t + 2) STAGE_B(SB8(0, 1), 1, t + 2) STAGE_A(SA8(0, 0), 0, t + 2)
      WAIT_V(8); WAIT_L(0); BAR; MMA8(1, 0, At, B0) MMA8(1, 1, At, B1) BAR; SCHED;
      LDB8(B0, 1, 0) LDB8(B1, 1, 1) SCHED; LDA8(At, 1, 0) STAGE_A(SA8(0, 1), 1, t + 2)
      WAIT_V(8); WAIT_L(0); BAR; MMA8(0, 0, At, B0) MMA8(0, 1, At, B1) BAR; SCHED;
      LDA8(At, 1, 1) STAGE_B(SB8(1, 0), 0, t + 3) STAGE_B(SB8(1, 1), 1, t + 3) STAGE_A(SA8(1, 0), 0, t + 3)
      WAIT_V(8); WAIT_L(0); BAR; MMA8(1, 0, At, B0) MMA8(1, 1, At, B1) BAR; SCHED;
    }
    {
      LDB8(B0, 0, 0) LDB8(B1, 0, 1) SCHED; LDA8(At, 0, 0) STAGE_A(SA8(1, 1), 1, nt - 1)
      WAIT_V(8); WAIT_L(0); BAR; MMA8(0, 0, At, B0) MMA8(0, 1, At, B1) BAR; SCHED;
      LDA8(At, 0, 1)
      WAIT_V(2); WAIT_L(0); BAR; MMA8(1, 0, At, B0) MMA8(1, 1, At, B1) BAR; SCHED;
      LDB8(B0, 1, 0) LDB8(B1, 1, 1) SCHED; LDA8(At, 1, 0)
      WAIT_V(0); WAIT_L(0); BAR; MMA8(0, 0, At, B0) MMA8(0, 1, At, B1) BAR; SCHED;
      LDA8(At, 1, 1)
      WAIT_L(0); BAR; MMA8(1, 0, At, B0) MMA8(1, 1, At, B1) BAR; SCHED;
    }
    if (wr == 0) BAR;
    { int fr2 = fr, fq2 = fq; asm volatile("" : "+v"(fr2), "+v"(fq2)); epi(acc, pm * 256, pn * 256, wr, wc, fr2, fq2); }
  }
#undef SA8
#undef SB8
#undef STAGE_A
#undef STAGE_B
#undef LDA8
#undef LDB8
#undef MMA8
#undef WAIT_V
#undef WAIT_L
#undef BAR
#undef SCHED
}
}

struct GlaPrepOps { half8 q0, k0, q1, k1; float w[16]; float bb; };
__device__ void ph_gla_prep(const Params& P, float* sm, int wvs) {
  float(*glr)[16] = (float(*)[16])sm;
  float(*tot)[128] = (float(*)[128])(sm + 1024);
  float(*exl)[132] = (float(*)[132])(sm + 1536);
  const int tid = otid(wvs);
  const int tq = tid >> 7, c = tid & 127;
  const int tp = tid >> 4, co = tid & 15;
  const float scale = 0.08838834764831845f;
  const int nchunks = T_TOK / 64, G = gridDim.x;
  const int nj = (((nchunks - 1 - (int)blockIdx.x) / G) + 1) * 4;
  GlaPrepOps nxt; f32x4 gnx = {};
#define GLA_PREP_LOAD(j_) { const int chunk_ = (int)blockIdx.x + ((j_) >> 2) * G, h_ = (j_) & 3, ch_ = h_ * 128 + c; \
    const half_t* qp_ = P.p + (size_t)(chunk_ * 64 + 2 * tp) * LD0 + h_ * 128 + co * 8; \
    nxt.q0 = *(const half8*)(qp_); nxt.k0 = *(const half8*)(qp_ + 512); nxt.q1 = *(const half8*)(qp_ + LD0); nxt.k1 = *(const half8*)(qp_ + LD0 + 512); \
    _Pragma("unroll") for (int r = 0; r < 16; ++r) nxt.w[r] = P.gla_w_gk_up[r * 512 + ch_]; \
    nxt.bb = P.gla_b_gk[ch_]; \
    if (h_ == 0 && tid < 256) gnx = *(const f32x4*)(P.glr + (size_t)(chunk_ * 64) * 16 + tid * 4); }
  GLA_PREP_LOAD(0)
#pragma unroll 1
  for (int j = 0; j < nj; ++j) {
    const int chunk = (int)blockIdx.x + (j >> 2) * G, h = j & 3;
    const int t0 = chunk * 64, ch = h * 128 + c;
    const GlaPrepOps cur = nxt;
    __syncthreads();
    if (h == 0 && tid < 256) *(f32x4*)(sm + tid * 4) = gnx;
    if (j + 1 < nj) GLA_PREP_LOAD(j + 1)
    __syncthreads();
    float pre[16]; float cum = 0.f;
#pragma unroll
    for (int i = 0; i < 16; ++i) {
      float u = cur.bb;
#pragma unroll
      for (int r = 0; r < 16; ++r) u += glr[tq * 16 + i][r] * cur.w[r];
      cum += logsigmoidf(u) * (1.f / 16.f);
      pre[i] = cum;
    }
    tot[tq][c] = cum;
    __syncthreads();
    float off = 0.f;
#pragma unroll
    for (int t = 0; t < 3; ++t) if (t < tq) off += tot[t][c];
#pragma unroll
    for (int i = 0; i < 16; ++i) {
      const float ex = fast_exp2((pre[i] + off) * LOG2E);
      exl[tq * 16 + i][c] = ex;
      if (tq == 3 && i == 15) P.bcum[(size_t)chunk * 512 + ch] = ex;
    }
    __syncthreads();
    {
      half_t* qp = P.p + (size_t)(t0 + 2 * tp) * LD0 + h * 128 + co * 8;
      const f32x4 e00 = *(const f32x4*)&exl[2 * tp][co * 8], e01 = *(const f32x4*)&exl[2 * tp][co * 8 + 4];
      const f32x4 e10 = *(const f32x4*)&exl[2 * tp + 1][co * 8], e11 = *(const f32x4*)&exl[2 * tp + 1][co * 8 + 4];
      half8 oq0, ok0, oq1, ok1;
#pragma unroll
      for (int e = 0; e < 8; ++e) {
        const float x0 = e < 4 ? e00[e] : e01[e - 4], x1 = e < 4 ? e10[e] : e11[e - 4];
        oq0[e] = (half_t)((float)cur.q0[e] * scale * x0); ok0[e] = (half_t)((float)cur.k0[e] * __builtin_amdgcn_rcpf(x0));
        oq1[e] = (half_t)((float)cur.q1[e] * scale * x1); ok1[e] = (half_t)((float)cur.k1[e] * __builtin_amdgcn_rcpf(x1));
      }
      *(half8*)(qp) = oq0; *(half8*)(qp + 512) = ok0; *(half8*)(qp + LD0) = oq1; *(half8*)(qp + LD0 + 512) = ok1;
    }
  }
#undef GLA_PREP_LOAD
}

constexpr int GLA_QE = 0, GLA_KE = 16384, GLA_V = 32768, GLA_DEC = 49152, GLA_BUF = 53248;
#define GLA_TR4(d0, d1, d2, d3, addr, o0, o1, o2, o3) \
  asm volatile("ds_read_b64_tr_b16 %0, %4 offset:%5\n\tds_read_b64_tr_b16 %1, %4 offset:%6\n\tds_read_b64_tr_b16 %2, %4 offset:%7\n\tds_read_b64_tr_b16 %3, %4 offset:%8" \
               : "=&v"(d0), "=&v"(d1), "=&v"(d2), "=&v"(d3) : "v"(addr), "n"(o0), "n"(o1), "n"(o2), "n"(o3) : "memory")
__device__ __forceinline__ half8 pack_h8(const v2i a, const v2i b) { const v4i p = (v4i){a[0], a[1], b[0], b[1]}; return __builtin_bit_cast(half8, p); }

template <bool STATE_ONLY>
__device__ void ph_gla_mfma(const Params& P, char* smem, int wvs) {
  const int tid = otid(wvs);
  const int lane = tid & 63, wave = __builtin_amdgcn_readfirstlane(tid >> 6), r15 = lane & 15, q = lane >> 4;
  const int qp = r15 >> 2, pp = lane & 3;
  const int srow = tid >> 4, sslot = tid & 15;
  const int src_q = (sslot ^ (srow & 15)) * 8, src_kv = (sslot ^ ((srow & 7) << 1)) * 8;
  const int fk = ((4 * (q & 1) + qp) & 7) << 1;
  const unsigned tr_row = (unsigned)((4 * q + qp) * 256 + 8 * (pp & 1) + ((pp >> 1) << 4));
  constexpr int NLOAD = STATE_ONLY ? 5 : 7;
  for (int wg = blockIdx.x; wg < (STATE_ONLY ? 3 : 4) * 64; wg += gridDim.x) {
    const int pr_ = ((wg >> 4) << 3) | (wg & 7), item = ((pr_ >> 5) << 6) | ((pr_ & 31) << 1) | ((wg >> 3) & 1);
    const int seg = item >> 6, base = item & 63, b = base >> 3, h = (base >> 1) & 3, vs = base & 1;
    const int c0 = seg * 16;
    f32x4 S[8], Dacc[8];
#pragma unroll
    for (int df = 0; df < 8; ++df) { S[df] = (f32x4){0.f, 0.f, 0.f, 0.f}; Dacc[df] = (f32x4){1.f, 1.f, 1.f, 1.f}; }
    f32x4* stL = (f32x4*)P.gla_state + ((size_t)base * 8 + wave) * 8 * 64 + lane;
    f32x4* stD = stL + (size_t)3 * 64 * 8 * 8 * 64;
    if (!STATE_ONLY) {
      for (int k = 0; k < seg; ++k) {
#pragma unroll
        for (int df = 0; df < 8; ++df) {
          const f32x4 Lk = stL[((size_t)k * 64 * 8 * 8 + df) * 64];
          if (k == 0) S[df] = Lk;
          else { const f32x4 Dk = stD[((size_t)k * 64 * 8 * 8 + df) * 64]; S[df] = Dk * S[df] + Lk; }
        }
      }
    }
    const half_t* qsrc = P.p + (size_t)(b * SEQ + srow) * LD0 + h * 128;
    const half_t* vsrc = P.p + (size_t)(b * SEQ + srow) * LD0 + 1024 + h * 256 + vs * 128 + src_kv;
    const float* dsrc = P.bcum + (size_t)(b * 64 + c0) * 512 + h * 128 + (lane & 31) * 4;
#define G_ISSUE(N, BUF) { char* lb_ = smem + (BUF) * GLA_BUF + wave * 1024; const size_t ro_ = (size_t)(c0 + (N)) * 64 * LD0; \
      if (!STATE_ONLY) { __builtin_amdgcn_global_load_lds((gbl_void*)(qsrc + ro_ + src_q), (lds_void*)(lb_ + GLA_QE), 16, 0, 0); \
      __builtin_amdgcn_global_load_lds((gbl_void*)(qsrc + ro_ + (size_t)32 * LD0 + src_q), (lds_void*)(lb_ + GLA_QE + 8192), 16, 0, 0); } \
      __builtin_amdgcn_global_load_lds((gbl_void*)(qsrc + ro_ + 512 + src_kv), (lds_void*)(lb_ + GLA_KE), 16, 0, 0); \
      __builtin_amdgcn_global_load_lds((gbl_void*)(qsrc + ro_ + (size_t)32 * LD0 + 512 + src_kv), (lds_void*)(lb_ + GLA_KE + 8192), 16, 0, 0); \
      __builtin_amdgcn_global_load_lds((gbl_void*)(vsrc + ro_), (lds_void*)(lb_ + GLA_V), 16, 0, 0); \
      __builtin_amdgcn_global_load_lds((gbl_void*)(vsrc + ro_ + (size_t)32 * LD0), (lds_void*)(lb_ + GLA_V + 8192), 16, 0, 0); \
      if (lane < 32) __builtin_amdgcn_global_load_lds((gbl_void*)(dsrc + (size_t)(N) * 512), (lds_void*)(smem + (BUF) * GLA_BUF + GLA_DEC + wave * 512), 16, 0, 0); }
    G_ISSUE(0, 0)
    G_ISSUE(1, 1)
#pragma unroll 1
    for (int n = 0; n < 16; ++n) {
      if (n + 1 < 16) wait_vmcnt<NLOAD>(); else wait_vmcnt<0>();
      __builtin_amdgcn_s_barrier();
      if (n + 2 < 16) G_ISSUE(n + 2, (n + 2) % 3)
      const char* cb = smem + (n % 3) * GLA_BUF;
      f32x4 aT[4][4];
      if (!STATE_ONLY) {
#pragma unroll
      for (int kf = 0; kf < 4; ++kf)
#pragma unroll
        for (int tf = 0; tf < 4; ++tf) aT[kf][tf] = (f32x4){0.f, 0.f, 0.f, 0.f};
      half8 kef[2][4], qef[2][4];
#define GLA_AT_LOAD(KS, SL) { _Pragma("unroll") for (int f = 0; f < 4; ++f) { \
          kef[SL][f] = *(const half8*)(cb + GLA_KE + (16 * f + r15) * 256 + (((4 * (KS) + q) ^ ((r15 & 7) << 1)) << 4)); \
          qef[SL][f] = *(const half8*)(cb + GLA_QE + (16 * f + r15) * 256 + (((4 * (KS) + q) ^ r15) << 4)); } }
      GLA_AT_LOAD(0, 0)
#pragma unroll
      for (int ks = 0; ks < 4; ++ks) {
        if (ks + 1 < 4) GLA_AT_LOAD(ks + 1, (ks + 1) & 1)
#pragma unroll
        for (int kf = 0; kf < 4; ++kf)
#pragma unroll
          for (int tf = kf; tf < 4; ++tf) aT[kf][tf] = __builtin_amdgcn_mfma_f32_16x16x32_f16(kef[ks & 1][kf], qef[ks & 1][tf], aT[kf][tf], 0, 0, 0);
      }
#undef GLA_AT_LOAD
#pragma unroll
      for (int f = 0; f < 4; ++f)
#pragma unroll
        for (int r = 0; r < 4; ++r) if (4 * q + r > r15) aT[f][f][r] = 0.f;
      }
      const unsigned lds0 = (unsigned)(size_t)cb;
      const unsigned va = lds0 + GLA_V + tr_row + ((((2 * wave) ^ fk)) << 4);
      v2i v00, v01, v10, v11;
      GLA_TR4(v00, v01, v10, v11, va, 0, 4096, 8192, 12288);
      const unsigned ka = lds0 + GLA_KE + tr_row;
      v2i k0[4][4];
#pragma unroll
      for (int df = 0; df < 4; ++df) { const unsigned a_ = ka + ((((2 * df) ^ fk)) << 4); GLA_TR4(k0[df][0], k0[df][1], k0[df][2], k0[df][3], a_, 0, 4096, 8192, 12288); }
      asm volatile("s_waitcnt lgkmcnt(15)" : "+v"(v00), "+v"(v01), "+v"(v10), "+v"(v11) :: "memory");
      __builtin_amdgcn_sched_barrier(0);
      half8 vf[2];
      vf[0] = pack_h8(v00, v01); vf[1] = pack_h8(v10, v11);
      if (!STATE_ONLY) {
      f32x4 o[4];
#pragma unroll
      for (int tf = 0; tf < 4; ++tf) o[tf] = (f32x4){0.f, 0.f, 0.f, 0.f};
#pragma unroll
      for (int ks2 = 0; ks2 < 2; ++ks2)
#pragma unroll
        for (int tf = 2 * ks2; tf < 4; ++tf) {
          half8 pk;
#pragma unroll
          for (int r = 0; r < 4; ++r) { pk[r] = (half_t)aT[2 * ks2][tf][r]; pk[4 + r] = (half_t)aT[2 * ks2 + 1][tf][r]; }
          o[tf] = __builtin_amdgcn_mfma_f32_16x16x32_f16(vf[ks2], pk, o[tf], 0, 0, 0);
        }
      half4 qa[2][4], qb[2][4];
#define GLA_Q_LOAD(KS, SL) { _Pragma("unroll") for (int tf = 0; tf < 4; ++tf) { const int row_ = 16 * tf + r15; \
          qa[SL][tf] = *(const half4*)(cb + GLA_QE + row_ * 256 + (((4 * (KS) + (q >> 1)) ^ r15) << 4) + (q & 1) * 8); \
          qb[SL][tf] = *(const half4*)(cb + GLA_QE + row_ * 256 + (((4 * (KS) + 2 + (q >> 1)) ^ r15) << 4) + (q & 1) * 8); } }
      GLA_Q_LOAD(0, 0)
#pragma unroll
      for (int ks = 0; ks < 4; ++ks) {
        if (ks + 1 < 4) GLA_Q_LOAD(ks + 1, (ks + 1) & 1)
        half8 sf;
#pragma unroll
        for (int r = 0; r < 4; ++r) { sf[r] = (half_t)S[2 * ks][r]; sf[4 + r] = (half_t)S[2 * ks + 1][r]; }
#pragma unroll
        for (int tf = 0; tf < 4; ++tf) {
          half8 qv;
#pragma unroll
          for (int e = 0; e < 4; ++e) { qv[e] = qa[ks & 1][tf][e]; qv[4 + e] = qb[ks & 1][tf][e]; }
          o[tf] = __builtin_amdgcn_mfma_f32_16x16x32_f16(sf, qv, o[tf], 0, 0, 0);
        }
      }
#undef GLA_Q_LOAD
      {
        const size_t t0 = (size_t)(b * SEQ + (c0 + n) * 64);
#pragma unroll
        for (int tf = 0; tf < 4; ++tf) {
          half4 hv; hv[0] = (half_t)o[tf][0]; hv[1] = (half_t)o[tf][1]; hv[2] = (half_t)o[tf][2]; hv[3] = (half_t)o[tf][3];
          *(half4*)(P.og + (t0 + 16 * tf + r15) * DM + h * 256 + vs * 128 + 16 * wave + 4 * q) = hv;
        }
      }
      }
      v2i k1[4][4];
#pragma unroll
      for (int df = 0; df < 4; ++df) { const unsigned a_ = ka + ((((2 * (df + 4)) ^ fk)) << 4); GLA_TR4(k1[df][0], k1[df][1], k1[df][2], k1[df][3], a_, 0, 4096, 8192, 12288); }
      asm volatile("s_waitcnt lgkmcnt(15)"
                   : "+v"(k0[0][0]), "+v"(k0[0][1]), "+v"(k0[0][2]), "+v"(k0[0][3]), "+v"(k0[1][0]), "+v"(k0[1][1]), "+v"(k0[1][2]), "+v"(k0[1][3]),
                     "+v"(k0[2][0]), "+v"(k0[2][1]), "+v"(k0[2][2]), "+v"(k0[2][3]), "+v"(k0[3][0]), "+v"(k0[3][1]), "+v"(k0[3][2]), "+v"(k0[3][3]) :: "memory");
      __builtin_amdgcn_sched_barrier(0);
#pragma unroll
      for (int df = 0; df < 4; ++df) {
        S[df] = __builtin_amdgcn_mfma_f32_16x16x32_f16(pack_h8(k0[df][0], k0[df][1]), vf[0], S[df], 0, 0, 0);
        S[df] = __builtin_amdgcn_mfma_f32_16x16x32_f16(pack_h8(k0[df][2], k0[df][3]), vf[1], S[df], 0, 0, 0);
      }
      asm volatile("s_waitcnt lgkmcnt(0)"
                   : "+v"(k1[0][0]), "+v"(k1[0][1]), "+v"(k1[0][2]), "+v"(k1[0][3]), "+v"(k1[1][0]), "+v"(k1[1][1]), "+v"(k1[1][2]), "+v"(k1[1][3]),
                     "+v"(k1[2][0]), "+v"(k1[2][1]), "+v"(k1[2][2]), "+v"(k1[2][3]), "+v"(k1[3][0]), "+v"(k1[3][1]), "+v"(k1[3][2]), "+v"(k1[3][3]) :: "memory");
      __builtin_amdgcn_sched_barrier(0);
#pragma unroll
      for (int df = 0; df < 4; ++df) {
        S[df + 4] = __builtin_amdgcn_mfma_f32_16x16x32_f16(pack_h8(k1[df][0], k1[df][1]), vf[0], S[df + 4], 0, 0, 0);
        S[df + 4] = __builtin_amdgcn_mfma_f32_16x16x32_f16(pack_h8(k1[df][2], k1[df][3]), vf[1], S[df + 4], 0, 0, 0);
      }
      {
        f32x4 dc[8];
#pragma unroll
        for (int df = 0; df < 8; ++df) dc[df] = *(const f32x4*)(cb + GLA_DEC + wave * 512 + (16 * df + 4 * q) * 4);
#pragma unroll
        for (int df = 0; df < 8; ++df) { S[df] *= dc[df]; if (STATE_ONLY) Dacc[df] *= dc[df]; }
      }
    }
    if (STATE_ONLY) {
#pragma unroll
      for (int df = 0; df < 8; ++df) { stL[((size_t)seg * 64 * 8 * 8 + df) * 64] = S[df]; stD[((size_t)seg * 64 * 8 * 8 + df) * 64] = Dacc[df]; }
    }
    asm volatile("s_waitcnt vmcnt(0)" ::: "memory");
    __builtin_amdgcn_s_barrier();
#undef G_ISSUE
  }
}

__device__ void ph_gla_post(const Params& P, int wvs) {
  const int tid_ = otid(wvs); const int lane = tid_ & 63, sub = lane & 31;
  const int u0 = blockIdx.x * 16 + (tid_ >> 5);
  const float4 hn0 = ((const float4*)P.gla_head_norm)[sub * 2], hn1 = ((const float4*)P.gla_head_norm)[sub * 2 + 1];
  constexpr int UW = 4;
  const int ustride = gridDim.x * 16;
#pragma unroll 1
  for (int ub = u0; ub < T_TOK * 4; ub += ustride * UW) {
    half8 hv[UW], z[UW];
#pragma unroll
    for (int r = 0; r < UW; ++r) {
      const int u = ub + r * ustride, t = u >> 2, h = u & 3;
      hv[r] = *((const half8*)(P.og + (size_t)t * DM + h * 256) + sub);
      z[r] = *((const half8*)(P.p + (size_t)t * LD0 + 2048 + h * 256) + sub);
    }
#pragma unroll
    for (int r = 0; r < UW; ++r) {
      const int u = ub + r * ustride, t = u >> 2, h = u & 3;
      float v[8]; float ss = 0.f;
#pragma unroll
      for (int e = 0; e < 8; ++e) { v[e] = (float)hv[r][e]; ss += v[e] * v[e]; }
#pragma unroll
      for (int o = 16; o > 0; o >>= 1) ss += __shfl_xor(ss, o);
      const float rr = rsqrtf(ss * (1.f / 256.f) + EPS);
      const float hn[8] = {hn0.x, hn0.y, hn0.z, hn0.w, hn1.x, hn1.y, hn1.z, hn1.w};
      half8 o;
#pragma unroll
      for (int e = 0; e < 8; ++e) o[e] = (half_t)(v[e] * rr * hn[e] * siluf((float)z[r][e]));
      *((half8*)(P.og + (size_t)t * DM + h * 256) + sub) = o;
    }
  }
}

template <bool FINAL>
__device__ void ph_post(const half_t* baseh, const half_t* y, const float* g, float* dst, half_t* dsth, float* rstd_out, int wvs) {
  const int tid_ = otid(wvs); const int lane = tid_ & 63, w = tid_ >> 6;
  constexpr int RW = 4;
  const int rstride = gridDim.x * NWAVES;
  float4 gg4[4];
#pragma unroll
  for (int i = 0; i < 4; ++i) gg4[i] = ((const float4*)g)[lane + 64 * i];
#pragma unroll 1
  for (int row0 = blockIdx.x * NWAVES + w; row0 < T_TOK; row0 += rstride * RW) {
    half4 yv[RW][4], bv[RW][4];
#pragma unroll
    for (int r = 0; r < RW; ++r)
#pragma unroll
      for (int i = 0; i < 4; ++i) yv[r][i] = ((const half4*)(y + (size_t)(row0 + r * rstride) * DM))[lane + 64 * i];
#pragma unroll
    for (int r = 0; r < RW; ++r)
#pragma unroll
      for (int i = 0; i < 4; ++i) bv[r][i] = ((const half4*)(baseh + (size_t)(row0 + r * rstride) * DM))[lane + 64 * i];
#pragma unroll
    for (int r = 0; r < RW; ++r) {
      const int row = row0 + r * rstride;
      float ss = 0.f;
#pragma unroll
      for (int i = 0; i < 4; ++i)
#pragma unroll
        for (int e = 0; e < 4; ++e) { const float t = (float)yv[r][i][e]; ss += t * t; }
      ss = wave_sum(ss);
      const float rr = rsqrtf(ss * (1.f / DM) + EPS);
      float s2 = 0.f;
#pragma unroll
      for (int i = 0; i < 4; ++i) {
        const float4 gg = gg4[i];
        float4 o;
        o.x = (float)bv[r][i][0] + (float)yv[r][i][0] * rr * gg.x; o.y = (float)bv[r][i][1] + (float)yv[r][i][1] * rr * gg.y;
        o.z = (float)bv[r][i][2] + (float)yv[r][i][2] * rr * gg.z; o.w = (float)bv[r][i][3] + (float)yv[r][i][3] * rr * gg.w;
        if (FINAL) ((float4*)(dst + (size_t)row * DM))[lane + 64 * i] = o;
        else {
          s2 += o.x * o.x + o.y * o.y + o.z * o.z + o.w * o.w;
          half4 hv; hv[0] = (half_t)o.x; hv[1] = (half_t)o.y; hv[2] = (half_t)o.z; hv[3] = (half_t)o.w;
          ((half4*)(dsth + (size_t)row * DM))[lane + 64 * i] = hv;
        }
      }
      if (!FINAL) { s2 = wave_sum(s2); if (lane == 0) rstd_out[row] = rsqrtf(s2 * (1.f / DM) + EPS); }
    }
  }
}

template <int NF>
__device__ void ph_rowproj(const Params& P, const half_t* Wt, float* out, char* smem, int wvs, int first_block) {
  const int tid = otid(wvs), lane = tid & 63, wave = tid >> 6, r15 = lane & 15, q = lane >> 4;
  const int nb = gridDim.x - first_block;
  if ((int)blockIdx.x < first_block) return;
  __syncthreads();
  for (int c = tid; c < 16 * NF * 128; c += NTHREADS) {
    const int row = c >> 7, ch = c & 127;
    *(uint4*)(smem + row * 2064 + ch * 16) = *(const uint4*)(Wt + (size_t)row * DM + ch * 8);
  }
  __syncthreads();
  for (int tile = (int)blockIdx.x - first_block; tile < T_TOK / 128; tile += nb) {
    const int tok = tile * 128 + wave * 16 + r15;
    const half_t* ap = P.xh + (size_t)tok * DM + 8 * q;
    const char* bp = smem + r15 * 2064 + 16 * q;
    f32x4 acc[NF];
#pragma unroll
    for (int n = 0; n < NF; ++n) acc[n] = (f32x4){0.f, 0.f, 0.f, 0.f};
#pragma unroll 1
    for (int s0 = 0; s0 < 32; s0 += 16) {
      half8 a[16];
#pragma unroll
      for (int i = 0; i < 16; ++i) a[i] = *(const half8*)(ap + 32 * (s0 + i));
#pragma unroll
      for (int i = 0; i < 16; ++i) {
#pragma unroll
        for (int n = 0; n < NF; ++n) {
          const half8 bw = *(const half8*)(bp + n * 16 * 2064 + (s0 + i) * 64);
          acc[n] = __builtin_amdgcn_mfma_f32_16x16x32_f16(bw, a[i], acc[n], 0, 0, 0);
        }
      }
    }
    const float rs = P.rstd[tok];
#pragma unroll
    for (int n = 0; n < NF; ++n) *(f32x4*)(out + (size_t)tok * (16 * NF) + 16 * n + 4 * q) = acc[n] * rs;
  }
  __syncthreads();
}

__device__ void ph_kmax(const Params& P, int wvs, int first_block) {
  const int tid = otid(wvs);
  for (int task = (int)blockIdx.x - first_block; task < NBATCH * 4 * 2 * 8; task += gridDim.x - first_block) {
    const int chunk = task & 7, br = (task >> 3) & 1, bg = task >> 4, b = bg >> 2, g = bg & 3;
    const half_t* kp = P.p + (size_t)(b * SEQ + chunk * 512 + tid) * LD1 + (br ? 2048 : 1536) + g * 64;
    float ss = 0.f;
#pragma unroll
    for (int c = 0; c < 8; ++c) {
      const half8 v = *(const half8*)(kp + c * 8);
#pragma unroll
      for (int e = 0; e < 8; ++e) ss += (float)v[e] * (float)v[e];
    }
    ss = wave_max(ss);
    if ((tid & 63) == 0) __hip_atomic_fetch_max(&P.kmax2[bg * 2 + br], __float_as_uint(ss), __ATOMIC_RELAXED, __HIP_MEMORY_SCOPE_AGENT);
  }
}

constexpr int ATT_NB = 6, ATT_D = 5;
constexpr int ATT_K = 0, ATT_V = ATT_NB * 8192, ATT_Z = 2 * ATT_NB * 8192, ATT_IMP = ATT_Z + 32768, ATT_SELM = ATT_IMP + 64 * 68 * 4;
constexpr int IMPS = 68;
constexpr int ATT_GATE = ATT_SELM + 512;

__device__ __forceinline__ void attn_issue(char* smem, const half_t* kbase, const half_t* vbase, int ld, int tile_lo, int tile_hi, int wvs, int rot = 0) {
  const int tid = otid(wvs);
  const int lrow = tid >> 3, lch = tid & 7;
  const int ksrc = (lch ^ ((lrow >> 1) & 7)) * 8, vsrc = (lch ^ (((lrow >> 1) & 3) << 1)) * 8;
  const int wbase = __builtin_amdgcn_readfirstlane(tid >> 6) * 1024;
#pragma unroll
  for (int i = 0; i < ATT_D; ++i) if (tile_lo + i <= tile_hi) {
    const int nt_ = tile_hi - tile_lo + 1, tr_ = tile_lo + ((rot + i >= nt_) ? rot + i - nt_ : rot + i);
    const half_t* kp_ = kbase + (size_t)(tr_ * 64 + lrow) * ld + ksrc;
    const half_t* vp_ = vbase + (size_t)(tr_ * 64 + lrow) * ld + vsrc;
    __builtin_amdgcn_global_load_lds((gbl_void*)kp_, (lds_void*)(smem + ATT_K + i * 8192 + wbase), 16, 0, 0);
    __builtin_amdgcn_global_load_lds((gbl_void*)vp_, (lds_void*)(smem + ATT_V + i * 8192 + wbase), 16, 0, 0);
  }
}

template <int MODE, bool PREISSUED = false>
__device__ __forceinline__ void attn_branch(char* smem, const half_t* kbase, const half_t* vbase, int ld, int tile_lo, int tile_hi, int n, int th,
                                            const half8 (&qf)[2][2], float (&m)[2], float (&l)[2], f32x4 (&o)[4][2],
                                            const unsigned long long (&selm)[2], int wvs) {
  const int tid = otid(wvs);
  const int lane = tid & 63, r15 = lane & 15, q = lane >> 4;
  const int lrow = tid >> 3, lch = tid & 7;
  const int k_rd = r15 * 128, kswz = r15 >> 1;
  const int qp = r15 >> 2, pp = lane & 3;
  const int fx = ((2 * q + (qp >> 1)) & 3) << 1;
  const int v_rd = (4 * q + qp) * 128 + 8 * (pp & 1) + ((pp >> 1) << 4);
  unsigned int* impu = (unsigned int*)(smem + ATT_IMP);
  const int ksrc = (lch ^ ((lrow >> 1) & 7)) * 8, vsrc = (lch ^ (((lrow >> 1) & 3) << 1)) * 8;
  const int wbase = __builtin_amdgcn_readfirstlane(tid >> 6) * 1024;
#define A_GLOAD(TI, BUF) { const half_t* kp_ = kbase + (size_t)((TI) * 64 + lrow) * ld + ksrc; \
    __builtin_amdgcn_global_load_lds((gbl_void*)kp_, (lds_void*)(smem + ATT_K + (BUF) * 8192 + wbase), 16, 0, 0); \
    { const half_t* vp_ = vbase + (size_t)((TI) * 64 + lrow) * ld + vsrc; \
      __builtin_amdgcn_global_load_lds((gbl_void*)vp_, (lds_void*)(smem + ATT_V + (BUF) * 8192 + wbase), 16, 0, 0); } }
  constexpr int GPT = 2;
  f32x4 lacc[2] = {(f32x4){0.f, 0.f, 0.f, 0.f}, (f32x4){0.f, 0.f, 0.f, 0.f}};
  if (MODE != 1 && !PREISSUED) {
#pragma unroll
    for (int i = 0; i < ATT_D; ++i) if (tile_lo + i <= tile_hi) A_GLOAD(tile_lo + i, i)
  }
#pragma unroll 1
  for (int ti = tile_lo; ti <= tile_hi; ++ti) {
    const int it = ti - tile_lo, cur = it % ATT_NB;
    if (MODE != 1) {
      const int rem = tile_hi - ti;
      if (rem >= 4) wait_vmcnt<4 * GPT>(); else if (rem == 3) wait_vmcnt<3 * GPT>(); else if (rem == 2) wait_vmcnt<2 * GPT>();
      else if (rem == 1) wait_vmcnt<1 * GPT>(); else wait_vmcnt<0>();
    }
    __builtin_amdgcn_s_barrier();
    if (MODE != 1) { if (ti + ATT_D <= tile_hi) A_GLOAD(ti + ATT_D, (it + ATT_D) % ATT_NB) }
    const char* kb = smem + ATT_K + cur * 8192 + k_rd;
    const unsigned vbl = (unsigned)(size_t)(smem + ATT_V + cur * 8192 + v_rd);
    bool need_mask;
    if (MODE <= 1) need_mask = (ti * 64 + 63 > 4 * n - 2);
    else if (MODE == 2) need_mask = (ti == n);
    else need_mask = (ti == n) || (ti == n - 8);
    f32x4 s[4][2];
#pragma unroll
    for (int t2 = 0; t2 < 2; ++t2) {
      float c0 = 0.f;
      if (MODE >= 2) { c0 = -m[t2]; if (MODE == 2 && !((selm[t2] >> ti) & 1ull)) c0 = -INFINITY; }
#pragma unroll
      for (int kf = 0; kf < 4; ++kf) s[kf][t2] = (f32x4){c0, c0, c0, c0};
    }
#pragma unroll
    for (int ks = 0; ks < 2; ++ks) {
      const int co = ((4 * ks + q) ^ kswz) << 4;
#pragma unroll
      for (int kf = 0; kf < 4; ++kf) {
        const half8 kfr = *(const half8*)(kb + kf * 2048 + co);
#pragma unroll
        for (int t2 = 0; t2 < 2; ++t2) s[kf][t2] = __builtin_amdgcn_mfma_f32_16x16x32_f16(kfr, qf[t2][ks], s[kf][t2], 0, 0, 0);
      }
    }
    v2i vr[4][4];
    if (MODE != 0) {
      const unsigned va0 = vbl + (((0) ^ fx) << 4), va1 = vbl + (((2) ^ fx) << 4), va2 = vbl + (((4) ^ fx) << 4), va3 = vbl + (((6) ^ fx) << 4);
      asm volatile(
          "ds_read_b64_tr_b16 %0, %16\n\tds_read_b64_tr_b16 %1, %16 offset:2048\n\tds_read_b64_tr_b16 %2, %16 offset:4096\n\tds_read_b64_tr_b16 %3, %16 offset:6144\n\t"
          "ds_read_b64_tr_b16 %4, %17\n\tds_read_b64_tr_b16 %5, %17 offset:2048\n\tds_read_b64_tr_b16 %6, %17 offset:4096\n\tds_read_b64_tr_b16 %7, %17 offset:6144\n\t"
          "ds_read_b64_tr_b16 %8, %18\n\tds_read_b64_tr_b16 %9, %18 offset:2048\n\tds_read_b64_tr_b16 %10, %18 offset:4096\n\tds_read_b64_tr_b16 %11, %18 offset:6144\n\t"
          "ds_read_b64_tr_b16 %12, %19\n\tds_read_b64_tr_b16 %13, %19 offset:2048\n\tds_read_b64_tr_b16 %14, %19 offset:4096\n\tds_read_b64_tr_b16 %15, %19 offset:6144"
          : "=&v"(vr[0][0]), "=&v"(vr[0][1]), "=&v"(vr[0][2]), "=&v"(vr[0][3]), "=&v"(vr[1][0]), "=&v"(vr[1][1]), "=&v"(vr[1][2]), "=&v"(vr[1][3]),
            "=&v"(vr[2][0]), "=&v"(vr[2][1]), "=&v"(vr[2][2]), "=&v"(vr[2][3]), "=&v"(vr[3][0]), "=&v"(vr[3][1]), "=&v"(vr[3][2]), "=&v"(vr[3][3])
          : "v"(va0), "v"(va1), "v"(va2), "v"(va3)
          : "memory");
    }
    if (need_mask) {
#pragma unroll
      for (int t2 = 0; t2 < 2; ++t2) {
        const int tok = th * 32 + t2 * 16 + r15;
        int lo = 0, hi = 63;
        if (MODE <= 1) { hi = 4 * n + ((tok - 31) >> 4) - ti * 64; }
        else if (MODE == 2) { hi = tok; }
        else { if (ti == n) hi = tok; else lo = tok + 1; }
#pragma unroll
        for (int kf = 0; kf < 4; ++kf)
#pragma unroll
          for (int r = 0; r < 4; ++r) {
            const int kk = kf * 16 + 4 * q + r;
            if (kk < lo || kk > hi) s[kf][t2][r] = -INFINITY;
          }
      }
    }
    half8 pf[2][2];
#pragma unroll
    for (int t2 = 0; t2 < 2; ++t2) {
      float mb = 0.f, scale_p = 1.f;
      if (MODE == 1) {
        mb = m[t2]; scale_p = l[t2];
      } else if (MODE == 0) {
        float tm = s[0][t2][0];
#pragma unroll
        for (int kf = 0; kf < 4; ++kf)
#pragma unroll
          for (int r = 0; r < 4; ++r) tm = fmaxf(tm, s[kf][t2][r]);
        tm = rowmax4(tm);
        const float mn = fmaxf(m[t2], tm);
        const float alpha = fexp2(m[t2] - mn);
        m[t2] = mn; mb = mn;
        l[t2] *= alpha;
      }
      float lsum = 0.f;
#pragma unroll
      for (int kf = 0; kf < 4; ++kf) {
#pragma unroll
        for (int r = 0; r < 4; ++r) {
          float pv = (MODE >= 2) ? fexp2(s[kf][t2][r]) : fexp2(s[kf][t2][r] - mb);
          if (MODE == 1) pv *= scale_p;
          s[kf][t2][r] = pv; if (MODE == 0) lsum += pv;
        }
      }
      if (MODE == 0) l[t2] += lsum;
      if (MODE == 1) {
        const int tok = th * 32 + t2 * 16 + r15;
#pragma unroll
        for (int kf = 0; kf < 4; ++kf) {
          const int j = 16 * ti + 4 * kf + q;
          const unsigned int u0 = (unsigned int)(s[kf][t2][0] * 134217728.f + 0.5f), u1 = (unsigned int)(s[kf][t2][1] * 134217728.f + 0.5f);
          const unsigned int u2 = (unsigned int)(s[kf][t2][2] * 134217728.f + 0.5f), u3 = (unsigned int)(s[kf][t2][3] * 134217728.f + 0.5f);
          if (j < 64) {
            atomicAdd(&impu[tok * IMPS + j], u0 + u1 + u2 + u3);
            atomicAdd(&impu[tok * IMPS + j + 1], u3);
          }
        }
      }
      if (MODE != 0) {
#pragma unroll
        for (int ks = 0; ks < 2; ++ks) {
          half8 pk;
#pragma unroll
          for (int r = 0; r < 4; ++r) { pk[r] = (half_t)s[2 * ks][t2][r]; pk[4 + r] = (half_t)s[2 * ks + 1][t2][r]; }
          pf[t2][ks] = pk;
        }
      }
    }
    if (MODE != 0) {
      asm volatile("s_waitcnt lgkmcnt(0)"
                   : "+v"(vr[0][0]), "+v"(vr[0][1]), "+v"(vr[0][2]), "+v"(vr[0][3]), "+v"(vr[1][0]), "+v"(vr[1][1]), "+v"(vr[1][2]), "+v"(vr[1][3]),
                     "+v"(vr[2][0]), "+v"(vr[2][1]), "+v"(vr[2][2]), "+v"(vr[2][3]), "+v"(vr[3][0]), "+v"(vr[3][1]), "+v"(vr[3][2]), "+v"(vr[3][3])
                   :: "memory");
      __builtin_amdgcn_sched_barrier(0);
#pragma unroll
      for (int df = 0; df < 4; ++df) {
#pragma unroll
        for (int ks = 0; ks < 2; ++ks) {
          const v2i lo2 = vr[df][2 * ks], hi2 = vr[df][2 * ks + 1];
          const v4i pk4 = (v4i){lo2[0], lo2[1], hi2[0], hi2[1]};
          const half8 vf = __builtin_bit_cast(half8, pk4);
#pragma unroll
          for (int t2 = 0; t2 < 2; ++t2) o[df][t2] = __builtin_amdgcn_mfma_f32_16x16x32_f16(vf, pf[t2][ks], o[df][t2], 0, 0, 0);
        }
      }
      if (MODE >= 2) {
        const half8 ones = (half8){(half_t)1.f, (half_t)1.f, (half_t)1.f, (half_t)1.f, (half_t)1.f, (half_t)1.f, (half_t)1.f, (half_t)1.f};
#pragma unroll
        for (int ks = 0; ks < 2; ++ks)
#pragma unroll
          for (int t2 = 0; t2 < 2; ++t2) lacc[t2] = __builtin_amdgcn_mfma_f32_16x16x32_f16(ones, pf[t2][ks], lacc[t2], 0, 0, 0);
      }
    }
  }
  if (MODE >= 2) { l[0] = lacc[0][0]; l[1] = lacc[1][0]; }
  __syncthreads();
#undef A_GLOAD
}

__device__ __forceinline__ void attn_cmp(char* smem, int tile_hi, int n, int th, const half8 (&qf)[2][2], const float (&moff)[2], f32x4 (&o)[4][2], int wvs) {
  const int tid = otid(wvs);
  const int lane = tid & 63, r15 = lane & 15, q = lane >> 4;
  const int k_rd = r15 * 128, kswz = r15 >> 1;
  const int qp = r15 >> 2, pp = lane & 3;
  const int fx = ((2 * q + (qp >> 1)) & 3) << 1;
  const int v_rd = (4 * q + qp) * 128 + 8 * (pp & 1) + ((pp >> 1) << 4);
  unsigned int* impu = (unsigned int*)(smem + ATT_IMP);
  float lsum[2] = {0.f, 0.f};
  float usum[4][4][2], carry[2] = {0.f, 0.f};
#pragma unroll
  for (int ti = 0; ti < 4; ++ti) {
    if (ti <= tile_hi) {
      const int rem = tile_hi - ti;
      if (rem >= 3) wait_vmcnt<6>(); else if (rem == 2) wait_vmcnt<4>(); else if (rem == 1) wait_vmcnt<2>(); else wait_vmcnt<0>();
      __builtin_amdgcn_s_barrier();
      const char* kb = smem + ATT_K + ti * 8192 + k_rd;
      const unsigned vbl = (unsigned)(size_t)(smem + ATT_V + ti * 8192 + v_rd);
      f32x4 s[4][2];
#pragma unroll
      for (int t2 = 0; t2 < 2; ++t2) {
        const float c0 = -moff[t2];
#pragma unroll
        for (int kf = 0; kf < 4; ++kf) s[kf][t2] = (f32x4){c0, c0, c0, c0};
      }
#pragma unroll
      for (int ks = 0; ks < 2; ++ks) {
        const int co = ((4 * ks + q) ^ kswz) << 4;
#pragma unroll
        for (int kf = 0; kf < 4; ++kf) {
          const half8 kfr = *(const half8*)(kb + kf * 2048 + co);
#pragma unroll
          for (int t2 = 0; t2 < 2; ++t2) s[kf][t2] = __builtin_amdgcn_mfma_f32_16x16x32_f16(kfr, qf[t2][ks], s[kf][t2], 0, 0, 0);
        }
      }
      if (ti * 64 + 63 > 4 * n - 2) {
#pragma unroll
        for (int t2 = 0; t2 < 2; ++t2) {
          const int tok = th * 32 + t2 * 16 + r15;
          const int hi = 4 * n + ((tok - 31) >> 4) - ti * 64;
#pragma unroll
          for (int kf = 0; kf < 4; ++kf)
#pragma unroll
            for (int r = 0; r < 4; ++r) if (kf * 16 + 4 * q + r > hi) s[kf][t2][r] = -INFINITY;
        }
      }
      half8 pf[2][2];
#pragma unroll
      for (int t2 = 0; t2 < 2; ++t2) {
        float sh[4];
#pragma unroll
        for (int kf = 0; kf < 4; ++kf) {
#pragma unroll
          for (int r = 0; r < 4; ++r) s[kf][t2][r] = fexp2(s[kf][t2][r]);
          sh[kf] = __shfl(s[kf][t2][3], (lane + 48) & 63);
        }
#pragma unroll
        for (int kf = 0; kf < 4; ++kf) {
          const float u = (s[kf][t2][0] + s[kf][t2][1]) + (s[kf][t2][2] + s[kf][t2][3]);
          const float prev = q > 0 ? sh[kf] : (kf > 0 ? sh[kf - 1] : carry[t2]);
          usum[ti][kf][t2] = u + prev;
          lsum[t2] += u;
        }
        carry[t2] = sh[3];
#pragma unroll
        for (int ks = 0; ks < 2; ++ks) {
          half8 pk;
#pragma unroll
          for (int r = 0; r < 4; ++r) { pk[r] = (half_t)s[2 * ks][t2][r]; pk[4 + r] = (half_t)s[2 * ks + 1][t2][r]; }
          pf[t2][ks] = pk;
        }
      }
      v2i vr[4][4];
      {
        const unsigned va0 = vbl + (((0) ^ fx) << 4), va1 = vbl + (((2) ^ fx) << 4), va2 = vbl + (((4) ^ fx) << 4), va3 = vbl + (((6) ^ fx) << 4);
        asm volatile(
            "ds_read_b64_tr_b16 %0, %16\n\tds_read_b64_tr_b16 %1, %16 offset:2048\n\tds_read_b64_tr_b16 %2, %16 offset:4096\n\tds_read_b64_tr_b16 %3, %16 offset:6144\n\t"
            "ds_read_b64_tr_b16 %4, %17\n\tds_read_b64_tr_b16 %5, %17 offset:2048\n\tds_read_b64_tr_b16 %6, %17 offset:4096\n\tds_read_b64_tr_b16 %7, %17 offset:6144\n\t"
            "ds_read_b64_tr_b16 %8, %18\n\tds_read_b64_tr_b16 %9, %18 offset:2048\n\tds_read_b64_tr_b16 %10, %18 offset:4096\n\tds_read_b64_tr_b16 %11, %18 offset:6144\n\t"
            "ds_read_b64_tr_b16 %12, %19\n\tds_read_b64_tr_b16 %13, %19 offset:2048\n\tds_read_b64_tr_b16 %14, %19 offset:4096\n\tds_read_b64_tr_b16 %15, %19 offset:6144"
            : "=&v"(vr[0][0]), "=&v"(vr[0][1]), "=&v"(vr[0][2]), "=&v"(vr[0][3]), "=&v"(vr[1][0]), "=&v"(vr[1][1]), "=&v"(vr[1][2]), "=&v"(vr[1][3]),
              "=&v"(vr[2][0]), "=&v"(vr[2][1]), "=&v"(vr[2][2]), "=&v"(vr[2][3]), "=&v"(vr[3][0]), "=&v"(vr[3][1]), "=&v"(vr[3][2]), "=&v"(vr[3][3])
            : "v"(va0), "v"(va1), "v"(va2), "v"(va3)
            : "memory");
      }
      asm volatile("s_waitcnt lgkmcnt(0)"
                   : "+v"(vr[0][0]), "+v"(vr[0][1]), "+v"(vr[0][2]), "+v"(vr[0][3]), "+v"(vr[1][0]), "+v"(vr[1][1]), "+v"(vr[1][2]), "+v"(vr[1][3]),
                     "+v"(vr[2][0]), "+v"(vr[2][1]), "+v"(vr[2][2]), "+v"(vr[2][3]), "+v"(vr[3][0]), "+v"(vr[3][1]), "+v"(vr[3][2]), "+v"(vr[3][3])
                   :: "memory");
      __builtin_amdgcn_sched_barrier(0);
#pragma unroll
      for (int df = 0; df < 4; ++df)
#pragma unroll
        for (int ks = 0; ks < 2; ++ks) {
          const v2i lo2 = vr[df][2 * ks], hi2 = vr[df][2 * ks + 1];
          const v4i pk4 = (v4i){lo2[0], lo2[1], hi2[0], hi2[1]};
          const half8 vf = __builtin_bit_cast(half8, pk4);
#pragma unroll
          for (int t2 = 0; t2 < 2; ++t2) o[df][t2] = __builtin_amdgcn_mfma_f32_16x16x32_f16(vf, pf[t2][ks], o[df][t2], 0, 0, 0);
        }
    }
  }
#pragma unroll
  for (int t2 = 0; t2 < 2; ++t2) {
    const float lt = rowsum4(lsum[t2]);
    const float inv = lt > 0.f ? 1.f / lt : 0.f;
#pragma unroll
    for (int df = 0; df < 4; ++df) o[df][t2] *= inv;
    const int tok = th * 32 + t2 * 16 + r15;
    const float isc = inv * 134217728.f;
#pragma unroll
    for (int ti = 0; ti < 4; ++ti) {
      if (ti <= tile_hi) {
#pragma unroll
        for (int kf = 0; kf < 4; ++kf) {
          const int j = 16 * ti + 4 * kf + q;
          if (j < 64) atomicAdd(&impu[tok * IMPS + j], (unsigned int)(usum[ti][kf][t2] * isc + 0.5f));
        }
      }
    }
  }
  __syncthreads();
}

template <int MODE, bool PREISSUED>
__device__ __forceinline__ void attn_branch_pp(char* smem, const half_t* kbase, const half_t* vbase, int ld, int tile_lo, int tile_hi, int n, int th,
                                               const half8 (&qf)[2][2], const float (&m)[2], float (&l)[2], f32x4 (&o)[4][2],
                                               const unsigned long long (&selm)[2], int wvs, int rot) {
  const int tid = otid(wvs);
  const int lane = tid & 63, r15 = lane & 15, q = lane >> 4;
  const int lrow = tid >> 3, lch = tid & 7;
  const int k_rd = r15 * 128, kswz = r15 >> 1;
  const int qp = r15 >> 2, pp = lane & 3;
  const int fx = ((2 * q + (qp >> 1)) & 3) << 1;
  const int v_rd = (4 * q + qp) * 128 + 8 * (pp & 1) + ((pp >> 1) << 4);
  const int ksrc = (lch ^ ((lrow >> 1) & 7)) * 8, vsrc = (lch ^ (((lrow >> 1) & 3) << 1)) * 8;
  const int wbase = __builtin_amdgcn_readfirstlane(tid >> 6) * 1024;
#define A_GLOAD(TI, BUF) { const half_t* kp_ = kbase + (size_t)((TI) * 64 + lrow) * ld + ksrc; \
    __builtin_amdgcn_global_load_lds((gbl_void*)kp_, (lds_void*)(smem + ATT_K + (BUF) * 8192 + wbase), 16, 0, 0); \
    { const half_t* vp_ = vbase + (size_t)((TI) * 64 + lrow) * ld + vsrc; \
      __builtin_amdgcn_global_load_lds((gbl_void*)vp_, (lds_void*)(smem + ATT_V + (BUF) * 8192 + wbase), 16, 0, 0); } }
#define PP_BAR { __builtin_amdgcn_sched_barrier(0); __builtin_amdgcn_s_barrier(); __builtin_amdgcn_sched_barrier(0); }
  const int nt = tile_hi - tile_lo + 1;
  f32x4 lacc[2] = {(f32x4){0.f, 0.f, 0.f, 0.f}, (f32x4){0.f, 0.f, 0.f, 0.f}};
  if (!PREISSUED) {
#pragma unroll
    for (int i = 0; i < ATT_D; ++i) if (i < nt) A_GLOAD(tile_lo + ((rot + i >= nt) ? rot + i - nt : rot + i), i)
  }
  { const int r = nt - 1;
    if (r >= 4) wait_vmcnt<8>(); else if (r == 3) wait_vmcnt<6>(); else if (r == 2) wait_vmcnt<4>(); else if (r == 1) wait_vmcnt<2>(); else wait_vmcnt<0>(); }
  half8 pf[2][2];
  v2i vr[4][4];
#pragma unroll
  for (int a = 0; a < 2; ++a)
#pragma unroll
    for (int b = 0; b < 2; ++b) pf[a][b] = (half8){(half_t)0.f, (half_t)0.f, (half_t)0.f, (half_t)0.f, (half_t)0.f, (half_t)0.f, (half_t)0.f, (half_t)0.f};
#pragma unroll
  for (int a = 0; a < 4; ++a)
#pragma unroll
    for (int b = 0; b < 4; ++b) vr[a][b] = (v2i){0, 0};
  const half8 ones = (half8){(half_t)1.f, (half_t)1.f, (half_t)1.f, (half_t)1.f, (half_t)1.f, (half_t)1.f, (half_t)1.f, (half_t)1.f};
#define PP_PV { _Pragma("unroll") for (int df = 0; df < 4; ++df) _Pragma("unroll") for (int ks = 0; ks < 2; ++ks) { \
      const v2i lo2 = vr[df][2 * ks], hi2 = vr[df][2 * ks + 1]; const v4i pk4 = (v4i){lo2[0], lo2[1], hi2[0], hi2[1]}; const half8 vf = __builtin_bit_cast(half8, pk4); \
      _Pragma("unroll") for (int t2 = 0; t2 < 2; ++t2) o[df][t2] = __builtin_amdgcn_mfma_f32_16x16x32_f16(vf, pf[t2][ks], o[df][t2], 0, 0, 0); } \
    _Pragma("unroll") for (int ks = 0; ks < 2; ++ks) _Pragma("unroll") for (int t2 = 0; t2 < 2; ++t2) lacc[t2] = __builtin_amdgcn_mfma_f32_16x16x32_f16(ones, pf[t2][ks], lacc[t2], 0, 0, 0); }
  __builtin_amdgcn_sched_barrier(0);
  if (th == 1) __builtin_amdgcn_s_barrier();
  __builtin_amdgcn_sched_barrier(0);
  int trel = rot, tpf = rot + ATT_D; while (tpf >= nt) tpf -= nt;
#pragma unroll 1
  for (int it = 0; it < nt; ++it) {
    const int ti = tile_lo + trel, cur = it % ATT_NB;
    trel = (trel + 1 == nt) ? 0 : trel + 1;
    PP_BAR
    f32x4 s[4][2];
    const char* kb = smem + ATT_K + cur * 8192 + k_rd;
    __builtin_amdgcn_s_setprio(1);
    PP_PV
#pragma unroll
    for (int t2 = 0; t2 < 2; ++t2) {
      float c0 = -m[t2];
      if (MODE == 2 && !((selm[t2] >> ti) & 1ull)) c0 = -INFINITY;
#pragma unroll
      for (int kf = 0; kf < 4; ++kf) s[kf][t2] = (f32x4){c0, c0, c0, c0};
    }
#pragma unroll
    for (int ks = 0; ks < 2; ++ks) {
      const int co = ((4 * ks + q) ^ kswz) << 4;
#pragma unroll
      for (int kf = 0; kf < 4; ++kf) {
        const half8 kfr = *(const half8*)(kb + kf * 2048 + co);
#pragma unroll
        for (int t2 = 0; t2 < 2; ++t2) s[kf][t2] = __builtin_amdgcn_mfma_f32_16x16x32_f16(kfr, qf[t2][ks], s[kf][t2], 0, 0, 0);
      }
    }
    __builtin_amdgcn_s_setprio(0);
    { const int r = nt - 2 - it;
      if (r >= 3) wait_vmcnt<6>(); else if (r == 2) wait_vmcnt<4>(); else if (r == 1) wait_vmcnt<2>(); else wait_vmcnt<0>(); }
    PP_BAR
    if (it + ATT_D < nt) A_GLOAD(tile_lo + tpf, (it + ATT_D) % ATT_NB)
    tpf = (tpf + 1 == nt) ? 0 : tpf + 1;
    {
      const unsigned vbl = (unsigned)(size_t)(smem + ATT_V + cur * 8192 + v_rd);
      const unsigned va0 = vbl + (((0) ^ fx) << 4), va1 = vbl + (((2) ^ fx) << 4), va2 = vbl + (((4) ^ fx) << 4), va3 = vbl + (((6) ^ fx) << 4);
      asm volatile(
          "ds_read_b64_tr_b16 %0, %16\n\tds_read_b64_tr_b16 %1, %16 offset:2048\n\tds_read_b64_tr_b16 %2, %16 offset:4096\n\tds_read_b64_tr_b16 %3, %16 offset:6144\n\t"
          "ds_read_b64_tr_b16 %4, %17\n\tds_read_b64_tr_b16 %5, %17 offset:2048\n\tds_read_b64_tr_b16 %6, %17 offset:4096\n\tds_read_b64_tr_b16 %7, %17 offset:6144\n\t"
          "ds_read_b64_tr_b16 %8, %18\n\tds_read_b64_tr_b16 %9, %18 offset:2048\n\tds_read_b64_tr_b16 %10, %18 offset:4096\n\tds_read_b64_tr_b16 %11, %18 offset:6144\n\t"
          "ds_read_b64_tr_b16 %12, %19\n\tds_read_b64_tr_b16 %13, %19 offset:2048\n\tds_read_b64_tr_b16 %14, %19 offset:4096\n\tds_read_b64_tr_b16 %15, %19 offset:6144"
          : "=&v"(vr[0][0]), "=&v"(vr[0][1]), "=&v"(vr[0][2]), "=&v"(vr[0][3]), "=&v"(vr[1][0]), "=&v"(vr[1][1]), "=&v"(vr[1][2]), "=&v"(vr[1][3]),
            "=&v"(vr[2][0]), "=&v"(vr[2][1]), "=&v"(vr[2][2]), "=&v"(vr[2][3]), "=&v"(vr[3][0]), "=&v"(vr[3][1]), "=&v"(vr[3][2]), "=&v"(vr[3][3])
          : "v"(va0), "v"(va1), "v"(va2), "v"(va3)
          : "memory");
    }
    bool need_mask;
    if (MODE == 2) need_mask = (ti == n); else need_mask = (ti == n) || (ti == n - 8);
    if (need_mask) {
#pragma unroll
      for (int t2 = 0; t2 < 2; ++t2) {
        const int tok = th * 32 + t2 * 16 + r15;
        int lo = 0, hi = 63;
        if (MODE == 2) { hi = tok; }
        else { if (ti == n) hi = tok; else lo = tok + 1; }
#pragma unroll
        for (int kf = 0; kf < 4; ++kf)
#pragma unroll
          for (int r = 0; r < 4; ++r) {
            const int kk = kf * 16 + 4 * q + r;
            if (kk < lo || kk > hi) s[kf][t2][r] = -INFINITY;
          }
      }
    }
#pragma unroll
    for (int t2 = 0; t2 < 2; ++t2) {
#pragma unroll
      for (int kf = 0; kf < 4; ++kf)
#pragma unroll
        for (int r = 0; r < 4; ++r) s[kf][t2][r] = fexp2(s[kf][t2][r]);
#pragma unroll
      for (int ks = 0; ks < 2; ++ks) {
        half8 pk;
#pragma unroll
        for (int r = 0; r < 4; ++r) { pk[r] = (half_t)s[2 * ks][t2][r]; pk[4 + r] = (half_t)s[2 * ks + 1][t2][r]; }
        pf[t2][ks] = pk;
      }
    }
    asm volatile("s_waitcnt lgkmcnt(0)"
                 : "+v"(vr[0][0]), "+v"(vr[0][1]), "+v"(vr[0][2]), "+v"(vr[0][3]), "+v"(vr[1][0]), "+v"(vr[1][1]), "+v"(vr[1][2]), "+v"(vr[1][3]),
                   "+v"(vr[2][0]), "+v"(vr[2][1]), "+v"(vr[2][2]), "+v"(vr[2][3]), "+v"(vr[3][0]), "+v"(vr[3][1]), "+v"(vr[3][2]), "+v"(vr[3][3])
                 :: "memory");
  }
  PP_BAR
  PP_PV
  __builtin_amdgcn_sched_barrier(0);
  if (th == 0) __builtin_amdgcn_s_barrier();
  __builtin_amdgcn_sched_barrier(0);
  l[0] = lacc[0][0]; l[1] = lacc[1][0];
  __syncthreads();
#undef A_GLOAD
#undef PP_BAR
#undef PP_PV
}

__device__ void ph_attn_mfma(const Params& P, char* smem, int wvs) {
  unsigned int* impu = (unsigned int*)(smem + ATT_IMP);
  unsigned long long* selmask = (unsigned long long*)(smem + ATT_SELM);
  const int G = gridDim.x, nrounds = (2048 + G - 1) / G;
  for (int rd = 0; rd < nrounds; ++rd) {
    const int idx = rd * G + ((rd & 1) ? (G - 1 - (int)blockIdx.x) : (int)blockIdx.x);
    if (idx >= 2048) continue;
    const int tid = otid(wvs), lane = tid & 63, r15 = lane & 15, q = lane >> 4;
    const int n = 63 - (idx >> 5), bg = idx & 31, b = bg >> 2, g = bg & 3;
    const int wv = __builtin_amdgcn_readfirstlane(otid(wvs) >> 6);
    const int hd = g * 4 + (wv & 3), th = wv >> 2;
    const int t0 = b * SEQ + n * 64 + th * 32;
    const half_t* kc = P.kcmp + (size_t)bg * 256 * 64;
    const half_t* vc = P.vcmp + (size_t)bg * 256 * 64;
    const int nct = (4 * n + 2) / 64;
    attn_issue(smem, kc, vc, 64, 0, nct, wvs);
    const float kmc = __uint_as_float(P.kmax2[64 + bg]), kms = __uint_as_float(P.kmax2[bg * 2 + 0]), kmw = __uint_as_float(P.kmax2[bg * 2 + 1]);
    half8 qf[2][2];
#pragma unroll
    for (int t2 = 0; t2 < 2; ++t2)
#pragma unroll
      for (int ks = 0; ks < 2; ++ks) qf[t2][ks] = *(const half8*)(P.p + (size_t)(t0 + t2 * 16 + r15) * LD1 + hd * 64 + 32 * ks + 8 * q);
    float* gate_l = (float*)(smem + ATT_GATE) + wv * 128;
    if (q == 0) {
#pragma unroll
      for (int t2 = 0; t2 < 2; ++t2) {
        const float* pr = P.gl + (size_t)(t0 + t2 * 16 + r15) * 48 + hd * 3;
        f32x4 gv;
#pragma unroll
        for (int c = 0; c < 3; ++c) gv[c] = sigmoidf(pr[c] + P.nsa_b_gate[hd * 3 + c]);
        gv[3] = 0.f;
        *(f32x4*)(gate_l + (t2 * 16 + r15) * 4) = gv;
      }
    }
    { const int tz = otid(wvs); for (int i = tz; i < 64 * IMPS + 128; i += NTHREADS) impu[i] = 0u; }
    float m[2], l[2]; f32x4 o[4][2]; unsigned long long selm[2] = {0ull, 0ull};
#pragma unroll
    for (int t2 = 0; t2 < 2; ++t2) { m[t2] = -1e30f; l[t2] = 0.f; }
#pragma unroll
    for (int df = 0; df < 4; ++df)
#pragma unroll
      for (int t2 = 0; t2 < 2; ++t2) o[df][t2] = (f32x4){0.f, 0.f, 0.f, 0.f};
    float qn2[2];
#pragma unroll
    for (int t2 = 0; t2 < 2; ++t2) {
      float a = 0.f;
#pragma unroll
      for (int ks = 0; ks < 2; ++ks)
#pragma unroll
        for (int e = 0; e < 8; ++e) a += (float)qf[t2][ks][e] * (float)qf[t2][ks][e];
      qn2[t2] = rowsum4(a);
    }
    {
#pragma unroll
      for (int t2 = 0; t2 < 2; ++t2) m[t2] = sqrtf(qn2[t2] * kmc) * 1.001f - 5.0f * LOG2E; }
    attn_cmp(smem, nct, n, th, qf, m, o, wvs);
    f32x4 oacc[4][2];
#pragma unroll
    for (int t2 = 0; t2 < 2; ++t2) {
      const float gc = gate_l[(t2 * 16 + r15) * 4 + 0];
#pragma unroll
      for (int df = 0; df < 4; ++df) oacc[df][t2] = o[df][t2] * gc;
    }
    {
      const int tz = otid(wvs), lz = tz & 63;
#pragma unroll
      for (int i = 0; i < 4; ++i) {
        const int slab = i * 8 + wv, tokz = slab * 2 + (lz >> 5), cz = (lz & 31) ^ (tokz & 15);
        const half_t* zp = P.p + (size_t)(b * SEQ + n * 64 + tokz) * LD1 + 2560 + g * 256 + cz * 8;
        __builtin_amdgcn_global_load_lds((gbl_void*)zp, (lds_void*)(smem + ATT_Z + slab * 1024), 16, 0, 0);
      }
    }
    const int shr = ((int)blockIdx.x >> 5) & 7;
    const int rot_s = (shr * (n + 1)) >> 3;
    attn_issue(smem, P.p + (size_t)b * SEQ * LD1 + 1536 + g * 64, P.p + (size_t)b * SEQ * LD1 + 1792 + g * 64, LD1, 0, n, wvs, rot_s);
    {
      const int tid2 = otid(wvs);
      const int tok = tid2 >> 3, part = tid2 & 7;
      unsigned long long msk;
      if (n + 1 <= 16) {
        msk = (1ull << (n + 1)) - 1ull;
      } else {
        const uint4* rowp = (const uint4*)(impu + tok * IMPS);
        unsigned own[8];
        { const uint4 a = rowp[part * 2], b2 = rowp[part * 2 + 1];
          own[0] = a.x; own[1] = a.y; own[2] = a.z; own[3] = a.w; own[4] = b2.x; own[5] = b2.y; own[6] = b2.z; own[7] = b2.w; }
        int rank[8];
#pragma unroll
        for (int jj = 0; jj < 8; ++jj) {
          const int j = part * 8 + jj;
          own[jj] = (j >= 1 && j <= n - 2) ? ((own[jj] & ~63u) | (unsigned)(63 - j)) : 0xffffffffu;
          rank[jj] = 0;
        }
#pragma unroll 2
        for (int c4 = 0; c4 < ((n - 2) >> 2) + 1; ++c4) {
          const uint4 v = rowp[c4];
          unsigned kv[4] = {v.x, v.y, v.z, v.w};
#pragma unroll
          for (int e = 0; e < 4; ++e) {
            const int j2 = c4 * 4 + e;
            const unsigned key2 = (j2 >= 1 && j2 <= n - 2) ? ((kv[e] & ~63u) | (unsigned)(63 - j2)) : 0u;
#pragma unroll
            for (int jj = 0; jj < 8; ++jj) rank[jj] += (key2 > own[jj]) ? 1 : 0;
          }
        }
        unsigned int bits = 0;
#pragma unroll
        for (int jj = 0; jj < 8; ++jj) if (rank[jj] < 13 && own[jj] != 0xffffffffu) bits |= 1u << jj;
        unsigned* sel32 = (unsigned*)selmask;
        if (bits) atomicOr(&sel32[tok * 2 + (part >> 2)], bits << (8 * (part & 3)));
        msk = 1ull | (1ull << n) | (1ull << (n - 1));
        if (part == 0) { atomicOr(&sel32[tok * 2], (unsigned)msk); atomicOr(&sel32[tok * 2 + 1], (unsigned)(msk >> 32)); }
      }
      if (n + 1 <= 16 && part == 0) selmask[tok] = msk;
    }
    __syncthreads();
#pragma unroll
    for (int t2 = 0; t2 < 2; ++t2) selm[t2] = selmask[th * 32 + t2 * 16 + r15];
    {
#pragma unroll
      for (int t2 = 0; t2 < 2; ++t2) { m[t2] = sqrtf(qn2[t2] * kms) * 1.001f - 5.0f * LOG2E; l[t2] = 0.f; } }
#pragma unroll
    for (int df = 0; df < 4; ++df)
#pragma unroll
      for (int t2 = 0; t2 < 2; ++t2) o[df][t2] = (f32x4){0.f, 0.f, 0.f, 0.f};
    attn_branch_pp<2, true>(smem, P.p + (size_t)b * SEQ * LD1 + 1536 + g * 64, P.p + (size_t)b * SEQ * LD1 + 1792 + g * 64, LD1, 0, n, n, th, qf, m, l, o, selm, wvs, rot_s);
#pragma unroll
    for (int t2 = 0; t2 < 2; ++t2) {
      const float gs = gate_l[(t2 * 16 + r15) * 4 + 1] / l[t2];
#pragma unroll
      for (int df = 0; df < 4; ++df) oacc[df][t2] += o[df][t2] * gs;
    }
    {
#pragma unroll
      for (int t2 = 0; t2 < 2; ++t2) { m[t2] = sqrtf(qn2[t2] * kmw) * 1.001f - 5.0f * LOG2E; l[t2] = 0.f; } }
#pragma unroll
    for (int df = 0; df < 4; ++df)
#pragma unroll
      for (int t2 = 0; t2 < 2; ++t2) o[df][t2] = (f32x4){0.f, 0.f, 0.f, 0.f};
    attn_branch_pp<3, false>(smem, P.p + (size_t)b * SEQ * LD1 + 2048 + g * 64, P.p + (size_t)b * SEQ * LD1 + 2304 + g * 64, LD1, (n > 8 ? n - 8 : 0), n, n, th, qf, m, l, o, selm, wvs, ((7 - shr) * (n > 8 ? 9 : n + 1)) >> 3);
    {
      int tbase = t0 + r15; asm volatile("" : "+v"(tbase));
#pragma unroll
      for (int t2 = 0; t2 < 2; ++t2) {
        const size_t tok = (size_t)(tbase + t2 * 16);
        const float gw = gate_l[(t2 * 16 + r15) * 4 + 2] / l[t2];
#pragma unroll
        for (int df = 0; df < 4; ++df) {
          const f32x4 v = oacc[df][t2] + o[df][t2] * gw;
          const int tokl = th * 32 + t2 * 16 + r15, cz = (wv & 3) * 8 + df * 2 + (q >> 1);
          const half4 z = *(const half4*)(smem + ATT_Z + tokl * 512 + ((cz ^ (tokl & 15)) << 4) + (q & 1) * 8);
          half4 hv;
#pragma unroll
          for (int e = 0; e < 4; ++e) hv[e] = (half_t)(v[e] * siluf((float)z[e]));
          *(half4*)(P.og + tok * DM + hd * 64 + df * 16 + 4 * q) = hv;
        }
      }
    }
  }
}

constexpr int NPHASES = 13;
__device__ __forceinline__ void run_phase(int ph, const Params& P, char* smem, int wvs) {
  float* sm = (float*)smem;
  switch (ph) {
    case 0:
      if (blockIdx.x == 0 && otid(wvs) < 448) P.kmax2[otid(wvs)] = 0u;
      ph_xh_rstd(P, wvs);
      prep_weights(P, sm, wvs);
      break;
    case 1:
      g8::gemm(g8::SrcPlain8{P.xh, DM, P.W0t, DM}, T_TOK, LD0, DM, g8::EpiStore8{P.p, LD0, P.rstd}, smem, wvs);
      ph_rowproj<1>(P, P.WglrT, P.glr, smem, wvs, 0);
      break;
    case 2: ph_gla_prep(P, sm, wvs); break;
    case 13: ph_gla_mfma<true>(P, smem, wvs); prep_cbias_reduce(P, wvs, (int)gridDim.x - 2); break;
    case 3: ph_gla_mfma<false>(P, smem, wvs); break;
    case 4: ph_gla_post(P, wvs); break;
    case 5: g8::gemm(g8::SrcPlain8{P.og, DM, P.Wo0t, DM}, T_TOK, DM, DM, g8::EpiPost8<false>{P.xh, P.post_norm, nullptr, P.xh, P.ppart, P.rs4, P.kmax2 + 192, smem}, smem, wvs); break;
    case 7: g8::gemm(g8::SrcPlain8{P.xh, DM, P.W1t, DM}, T_TOK, LD1, DM, g8::EpiRope8{P.p, LD1, P.rs4, P.ropetab, P.rstd}, smem, wvs); break;
    case 8: {
      if (blockIdx.x >= 128) { ph_kmax(P, wvs, 128); ph_rowproj<3>(P, P.WglT, P.gl, smem, wvs, 128); }
      g8::gemm(g8::SrcCmp1h8{P.p, P.cw1t}, 16384, 512, 1024, g8::EpiCmpPart8{P.part, P.kmax2 + 128}, smem, wvs);
      if (blockIdx.x < 64) {
        const int tid = otid(wvs);
        const int pm2 = ((int)blockIdx.x & 7) * 8 + ((int)blockIdx.x >> 3);
        if (tid == 0) {
          while (__hip_atomic_load(P.kmax2 + 128 + pm2, __ATOMIC_RELAXED, __HIP_MEMORY_SCOPE_AGENT) < 2u) { }
          __builtin_amdgcn_fence(__ATOMIC_ACQUIRE, "agent");
        }
        __syncthreads();
        const int cg = tid & 31, rr = tid >> 5;
        const float* bp = P.cbias + (pm2 >> 5) * 256 + cg * 8;
        const f32x4 b0 = *(const f32x4*)bp, b1 = *(const f32x4*)(bp + 4);
        const half_t* pa = P.part + (size_t)pm2 * 256 * 256 + cg * 8;
        const half_t* pb = P.part + (size_t)16384 * 256 + (size_t)pm2 * 256 * 256 + cg * 8;
        half_t* hp = P.hid + (size_t)pm2 * 256 * 256 + cg * 8;
#pragma unroll 1
        for (int r0 = 0; r0 < 256; r0 += 128) {
          half8 av[8], bv[8];
#pragma unroll
          for (int i = 0; i < 8; ++i) {
            const int c = r0 + i * 16 + rr, c1 = c < 255 ? c + 1 : 255;
            av[i] = *(const half8*)(pa + (size_t)c * 256); bv[i] = *(const half8*)(pb + (size_t)c1 * 256);
          }
#pragma unroll
          for (int i = 0; i < 8; ++i) {
            const int c = r0 + i * 16 + rr;
            half8 hv;
#pragma unroll
            for (int e = 0; e < 8; ++e) hv[e] = (half_t)siluf((float)av[i][e] + (float)bv[i][e] + (e < 4 ? b0[e] : b1[e - 4]));
            *(half8*)(hp + (size_t)c * 256) = hv;
          }
        }
      }
      asm volatile("s_waitcnt vmcnt(0)" ::: "memory");
      __syncthreads();
      g8::gemm(g8::SrcCmp2_8{P.hid, P.cw2t}, 16384, 256, 256, g8::EpiCmpOut8{P.kcmp, P.vcmp, P.kmax2 + 64}, smem, wvs);
      break;
    }
    case 10: ph_attn_mfma(P, smem, wvs); break;
    case 11: g8::gemm(g8::SrcPlain8{P.og, DM, P.Wo1t, DM}, T_TOK, DM, DM, g8::EpiPost8<true>{P.x1h, P.post_norm + DM, P.out, nullptr, P.ppart + 128 * 1024, nullptr, P.kmax2 + 320, smem}, smem, wvs); break;
  }
}

template <int PH>
__global__ void __launch_bounds__(NTHREADS, 2) k_phase(Params P) {
  __shared__ __attribute__((aligned(16))) char smem[SMEM_BYTES];
  run_phase(PH, P, smem, __builtin_amdgcn_readfirstlane(threadIdx.x >> 6));
}
template <int PH>
static void launch_phases(const Params& P, hipStream_t stream) {
  hipLaunchKernelGGL((k_phase<PH>), dim3(256), dim3(NTHREADS), 0, stream, P);
  if constexpr (PH + 1 < NPHASES) launch_phases<PH + 1>(P, stream);
}

#if MEGA
__global__ void __launch_bounds__(NTHREADS, 2) k_mega(Params P) {
  __shared__ __attribute__((aligned(16))) char smem[SMEM_BYTES];
  cg::grid_group grid = cg::this_grid();
  if (P.use_cg_sync) grid.sync();
  unsigned bt = 0;
  const int wvs = __builtin_amdgcn_readfirstlane(threadIdx.x >> 6);
  run_phase(0, P, smem, wvs); fast_barrier(P.bar, bt, wvs);
  run_phase(1, P, smem, wvs); fast_barrier(P.bar, bt, wvs);
  run_phase(2, P, smem, wvs); fast_barrier(P.bar, bt, wvs);
  run_phase(13, P, smem, wvs); fast_barrier(P.bar, bt, wvs);
  run_phase(3, P, smem, wvs); fast_barrier(P.bar, bt, wvs);
  run_phase(4, P, smem, wvs); fast_barrier(P.bar, bt, wvs);
  run_phase(5, P, smem, wvs); fast_barrier(P.bar, bt, wvs);
  run_phase(7, P, smem, wvs); fast_barrier(P.bar, bt, wvs);
  run_phase(8, P, smem, wvs); fast_barrier(P.bar, bt, wvs);
  run_phase(10, P, smem, wvs); fast_barrier(P.bar, bt, wvs);
  run_phase(11, P, smem, wvs);
}
#endif

extern "C" void kernel_launch(void* const* d_in, const int* in_sizes, int n_in, void* d_out, int out_size, void* d_ws, size_t ws_size,
                              hipStream_t stream) {
  Params P{};
  P.x = (const float*)d_in[0]; P.pos = (const int*)d_in[1]; P.pre_norm = (const float*)d_in[2]; P.post_norm = (const float*)d_in[3];
  P.gla_w_in = (const float*)d_in[4]; P.gla_w_gk_up = (const float*)d_in[5]; P.gla_b_gk = (const float*)d_in[6];
  P.gla_head_norm = (const float*)d_in[7]; P.gla_w_out = (const float*)d_in[8];
  P.nsa_w_in = (const float*)d_in[9]; P.nsa_b_gate = (const float*)d_in[10]; P.nsa_pe_k = (const float*)d_in[11]; P.nsa_pe_v = (const float*)d_in[12];
  P.ck_w1 = (const float*)d_in[13]; P.ck_w2 = (const float*)d_in[14]; P.cv_w1 = (const float*)d_in[15]; P.cv_w2 = (const float*)d_in[16];
  P.nsa_w_out = (const float*)d_in[17];
  P.out = (float*)d_out;
  char* ws = (char*)d_ws;
  const size_t MB = 1024 * 1024;
  P.W0t = (half_t*)(ws);
  P.Wo0t = (half_t*)(ws + 7 * MB);
  P.W1t = (half_t*)(ws + 9 * MB);
  P.Wo1t = (half_t*)(ws + 17 * MB);
  P.cw1t = (half_t*)(ws + 19 * MB);
  P.cw2t = (half_t*)(ws + 21 * MB);
  P.cbias = (float*)(ws + 22 * MB);
  P.cbias_part = (float*)(ws + 22 * MB + 4096);
  P.bar = (unsigned*)(ws + 23 * MB);
  P.use_cg_sync = 0;
  P.kmax2 = (unsigned*)(ws + 22 * MB + 512 * 1024);
  P.xh = (half_t*)(ws + 24 * MB);
  P.x1h = P.xh;
  P.p = (half_t*)(ws + 88 * MB);
  P.y = (half_t*)(ws + 88 * MB);
  P.og = (half_t*)(ws + 328 * MB);
  P.bcum = (float*)(ws + 392 * MB);
  P.rstd = (float*)(ws + 456 * MB);
  P.kcmp = (half_t*)(ws + 457 * MB);
  P.vcmp = (half_t*)(ws + 458 * MB);
  P.ropetab = (float*)(ws + 459 * MB);
  P.hid = (half_t*)(ws + 467 * MB);
  P.WglT = (half_t*)(ws + 22 * MB + 768 * 1024);
  P.WglrT = (half_t*)(ws + 22 * MB + 896 * 1024);
  P.glr = (float*)(ws + 509 * MB);
  P.gl = (float*)(ws + 503 * MB);
  P.gla_state = (float*)(ws + 476 * MB);
  P.ppart = (float*)(ws + 416 * MB);
  P.rs4 = (float*)(ws + 418 * MB);
  P.part = (half_t*)(ws + 400 * MB);
  if (ws_size < 512 * MB) { fprintf(stderr, "ws too small: %zu\n", ws_size); return; }
#if MEGA
  static int grid_blocks = 0;
  if (!grid_blocks) {
    int dev = 0, cus = 0, per_cu = 0;
    hipGetDevice(&dev);
    hipDeviceGetAttribute(&cus, hipDeviceAttributeMultiprocessorCount, dev);
    hipOccupancyMaxActiveBlocksPerMultiprocessor(&per_cu, k_mega, NTHREADS, 0);
    if (per_cu < 1) per_cu = 1;
    if (per_cu > 1) per_cu = 1;
    grid_blocks = cus * per_cu;
  }
  hipMemsetAsync(ws + 23 * MB, 0, 16384, stream);
  void* args[] = {&P};
  hipError_t e = hipLaunchCooperativeKernel((void*)k_mega, dim3(grid_blocks), dim3(NTHREADS), args, 0, stream);
  if (e != hipSuccess) fprintf(stderr, "cooperative launch failed: %s (grid %d)\n", hipGetErrorString(e), grid_blocks);
#else
  launch_phases<0>(P, stream);
#endif
}
```
